# Optimizing an MI355X kernel written in HIP

```python
import math
import jax, jax.numpy as jnp
from jax import lax
import numpy as np

D_MODEL = 1024
BATCH = 8
SEQ = 2048
DEPTH = 1

N_MEM = 256
EPS = 1e-6
DSA_HEADS = 8
DSA_LATENT = 128
DSA_VDIM = 64
IDX_HEADS = 8
IDX_DIM = 64
TOPK_MAX = 256
Q_BLOCK = 128
REL_BUCKETS = 32
REL_MAX_DIST = 128
S5_WIDTH = 512
S5_GROUP = 16
S5_GROUPS = S5_WIDTH // S5_GROUP
S5_STATE = 64
DT_MIN = 0.001
DT_MAX = 0.1
X_HEADS = 4
X_HEAD_DIM = 128
DSA_WIDTH = DSA_HEADS * DSA_VDIM
X_WIDTH = X_HEADS * X_HEAD_DIM
N_BRANCH = 3
D_FF = -(-(8 * D_MODEL) // (3 * 256)) * 256
IN_SPLITS = (DSA_HEADS * DSA_LATENT,
             DSA_LATENT,
             IDX_HEADS * IDX_DIM,
             IDX_DIM,
             IDX_HEADS,
             S5_WIDTH,
             X_WIDTH,
             N_BRANCH * D_MODEL)
D_IN = sum(IN_SPLITS)

kernel_name = 'hybrid_dsa_s5_memx_gated_block'


def rms_norm(x, g):
    x32 = x.astype(jnp.float32)
    y = x32 * lax.rsqrt(jnp.mean(x32 * x32, axis=-1, keepdims=True) + EPS)
    return (y * g.astype(jnp.float32)).astype(x.dtype)


def t5_bucket(n):
    max_exact = REL_BUCKETS // 2
    nf = jnp.maximum(n, 1).astype(jnp.float32)
    large = max_exact + (jnp.log(nf / max_exact) / math.log(REL_MAX_DIST / max_exact)
                         * (REL_BUCKETS - max_exact)).astype(jnp.int32)
    large = jnp.minimum(large, REL_BUCKETS - 1)
    return jnp.where(n < max_exact, n, large)


def dsa_attention(q, c, q_idx, k_idx, w_idx, rel_bias, w_uv):
    B, S = q.shape[0], q.shape[1]
    topk = min(TOPK_MAX, S // 4)
    n_blk = S // Q_BLOCK
    spos = jnp.arange(S)
    scale = DSA_LATENT ** -0.5

    def block(i):
        t0 = i * Q_BLOCK
        tpos = t0 + jnp.arange(Q_BLOCK)
        qb = lax.dynamic_slice_in_dim(q, t0, Q_BLOCK, axis=1)
        qib = lax.dynamic_slice_in_dim(q_idx, t0, Q_BLOCK, axis=1)
        wib = lax.dynamic_slice_in_dim(w_idx, t0, Q_BLOCK, axis=1)
        dots = jnp.einsum('bthd,bsd->bhts', qib, k_idx).astype(jnp.float32)
        score = jnp.einsum('bhts,bth->bts', jax.nn.relu(dots), wib.astype(jnp.float32))
        visible = spos[None, :] <= tpos[:, None]
        score = jnp.where(visible[None], score, -jnp.inf)
        _, idx = lax.top_k(score, topk)
        valid = idx <= tpos[None, :, None]
        c_sel = jax.vmap(lambda cb, ib: cb[ib])(c, idx)
        bucket = t5_bucket(jnp.maximum(tpos[None, :, None] - idx, 0))
        bias = jnp.moveaxis(rel_bias[bucket], -1, 1).astype(jnp.float32)
        logits = jnp.einsum('bthd,btkd->bhtk', qb, c_sel).astype(jnp.float32) * scale + bias
        logits = jnp.where(valid[:, None], logits, -jnp.inf)
        p = jax.nn.softmax(logits, axis=-1).astype(c.dtype)
        o = jnp.einsum('bhtk,btkd->bthd', p, c_sel)
        return jnp.einsum('bthd,hde->bthe', o, w_uv).reshape(B, Q_BLOCK, DSA_WIDTH)

    out = lax.map(block, jnp.arange(n_blk))
    return jnp.moveaxis(out, 0, 1).reshape(B, S, DSA_WIDTH)


def s5_mixer(u, a_re, a_im, log_dt, b_re, b_im, c_re, c_im, d_skip, w_glu):
    B, S = u.shape[0], u.shape[1]
    f32 = jnp.float32
    u32 = u.astype(f32).reshape(B, S, S5_GROUPS, S5_GROUP)
    lam = lax.complex(a_re.astype(f32), a_im.astype(f32))
    dt = jnp.exp(log_dt.astype(f32))[:, None]
    lam_bar = jnp.exp(lam * dt)
    b_bar = ((lam_bar - 1.0) / lam)[..., None] * lax.complex(b_re.astype(f32), b_im.astype(f32))
    bu = jnp.einsum('blgc,gnc->blgn', u32.astype(jnp.complex64), b_bar)
    a = jnp.broadcast_to(lam_bar, bu.shape)

    def combine(l, r):
        return (l[0] * r[0], r[0] * l[1] + r[1])

    _, states = lax.associative_scan(combine, (a, bu), axis=1)
    cmat = lax.complex(c_re.astype(f32), c_im.astype(f32))
    y = jnp.einsum('blgn,gcn->blgc', states, cmat).real + d_skip.astype(f32) * u32
    y = jax.nn.gelu(y.reshape(B, S, S5_WIDTH))
    y = y * jax.nn.sigmoid(y @ w_glu.astype(f32))
    return y.astype(u.dtype)


def cross_attention(q, mem_n, w_mem_kv, g_q, g_k):
    B, S = q.shape[0], q.shape[1]
    M = mem_n.shape[1]
    k, v = jnp.split(mem_n @ w_mem_kv, 2, axis=-1)
    qh = rms_norm(q.reshape(B, S, X_HEADS, X_HEAD_DIM), g_q)
    kh = rms_norm(k.reshape(B, M, X_HEADS, X_HEAD_DIM), g_k)
    vh = v.reshape(B, M, X_HEADS, X_HEAD_DIM)
    logits = jnp.einsum('bthd,bmhd->bhtm', qh, kh).astype(jnp.float32) * (X_HEAD_DIM ** -0.5)
    p = jax.nn.softmax(logits, axis=-1).astype(vh.dtype)
    return jnp.einsum('bhtm,bmhd->bthd', p, vh).reshape(B, S, X_WIDTH)


def hybrid_layer(x, mem, rel_bias, w_in, g_mix_norm, g_q_dsa, g_kv_dsa, w_uv_dsa,
                 a_re, a_im, log_dt, b_re, b_im, c_re, c_im, d_skip, w_glu,
                 g_mem_norm, w_mem_kv, g_q_cross, g_k_cross,
                 w_br_dsa, w_br_s5, w_br_cross, w_out,
                 g_ffn_norm, w_ffn_gate, w_ffn_up, w_ffn_down):
    B, S = x.shape[0], x.shape[1]
    h = rms_norm(x, g_mix_norm)
    offs = [int(o) for o in np.cumsum(IN_SPLITS)[:-1]]
    q_dsa, c_kv, q_idx, k_idx, w_idx, u_s5, q_x, gates = jnp.split(h @ w_in, offs, axis=-1)
    q_dsa = rms_norm(q_dsa.reshape(B, S, DSA_HEADS, DSA_LATENT), g_q_dsa)
    c_kv = rms_norm(c_kv, g_kv_dsa)
    o_dsa = dsa_attention(q_dsa, c_kv, q_idx.reshape(B, S, IDX_HEADS, IDX_DIM),
                          k_idx, w_idx, rel_bias, w_uv_dsa)
    o_s5 = s5_mixer(u_s5, a_re, a_im, log_dt, b_re, b_im, c_re, c_im, d_skip, w_glu)
    o_x = cross_attention(q_x, rms_norm(mem, g_mem_norm), w_mem_kv, g_q_cross, g_k_cross)
    g_dsa, g_s5, g_x = jnp.split(jax.nn.sigmoid(gates), N_BRANCH, axis=-1)
    merged = g_dsa * (o_dsa @ w_br_dsa) + g_s5 * (o_s5 @ w_br_s5) + g_x * (o_x @ w_br_cross)
    x = x + merged @ w_out
    hf = rms_norm(x, g_ffn_norm)
    return x + (jax.nn.silu(hf @ w_ffn_gate) * (hf @ w_ffn_up)) @ w_ffn_down


def setup_inputs(seed: int = 0) -> dict:
    key = jax.random.key(seed)
    ks = jax.random.split(key, 32)
    f32 = jnp.float32
    L = DEPTH

    def nrm(k, shape, fan):
        return jax.random.normal(k, shape, f32) * (fan ** -0.5)

    def gain(k, shape):
        return 1.0 + 0.01 * jax.random.normal(k, shape, f32)

    a_im = jnp.broadcast_to(math.pi * jnp.arange(S5_STATE, dtype=f32), (L, S5_GROUPS, S5_STATE))
    return {
        'x': jax.random.normal(ks[0], (BATCH, SEQ, D_MODEL), f32),
        'mem': jax.random.normal(ks[1], (BATCH, N_MEM, D_MODEL), f32),
        'rel_bias': 0.1 * jax.random.normal(ks[2], (REL_BUCKETS, DSA_HEADS), f32),
        'w_in': nrm(ks[3], (L, D_MODEL, D_IN), D_MODEL),
        'g_mix_norm': gain(ks[4], (L, D_MODEL)),
        'g_q_dsa': gain(ks[5], (L, DSA_LATENT)),
        'g_kv_dsa': gain(ks[6], (L, DSA_LATENT)),
        'w_uv_dsa': nrm(ks[7], (L, DSA_HEADS, DSA_LATENT, DSA_VDIM), DSA_LATENT),
        'a_re': -0.5 + 0.005 * jax.random.normal(ks[8], (L, S5_GROUPS, S5_STATE), f32),
        'a_im': a_im + 0.001 * jax.random.normal(ks[9], (L, S5_GROUPS, S5_STATE), f32),
        'log_dt': jax.random.uniform(ks[10], (L, S5_GROUPS), f32, math.log(DT_MIN), math.log(DT_MAX)),
        'b_re': nrm(ks[11], (L, S5_GROUPS, S5_STATE, S5_GROUP), 2 * S5_GROUP),
        'b_im': nrm(ks[12], (L, S5_GROUPS, S5_STATE, S5_GROUP), 2 * S5_GROUP),
        'c_re': nrm(ks[13], (L, S5_GROUPS, S5_GROUP, S5_STATE), 2 * S5_STATE),
        'c_im': nrm(ks[14], (L, S5_GROUPS, S5_GROUP, S5_STATE), 2 * S5_STATE),
        'd_skip': jax.random.normal(ks[15], (L, S5_GROUPS, S5_GROUP), f32),
        'w_glu': nrm(ks[16], (L, S5_WIDTH, S5_WIDTH), S5_WIDTH),
        'g_mem_norm': gain(ks[17], (L, D_MODEL)),
        'w_mem_kv': nrm(ks[18], (L, D_MODEL, 2 * X_WIDTH), D_MODEL),
        'g_q_cross': gain(ks[19], (L, X_HEAD_DIM)),
        'g_k_cross': gain(ks[20], (L, X_HEAD_DIM)),
        'w_br_dsa': nrm(ks[21], (L, DSA_WIDTH, D_MODEL), DSA_WIDTH),
        'w_br_s5': nrm(ks[22], (L, S5_WIDTH, D_MODEL), S5_WIDTH),
        'w_br_cross': nrm(ks[23], (L, X_WIDTH, D_MODEL), X_WIDTH),
        'w_out': nrm(ks[24], (L, D_MODEL, D_MODEL), D_MODEL),
        'g_ffn_norm': gain(ks[25], (L, D_MODEL)),
        'w_ffn_gate': nrm(ks[26], (L, D_MODEL, D_FF), D_MODEL),
        'w_ffn_up': nrm(ks[27], (L, D_MODEL, D_FF), D_MODEL),
        'w_ffn_down': nrm(ks[28], (L, D_FF, D_MODEL), D_FF),
    }


def reference(x, mem, rel_bias, w_in, g_mix_norm, g_q_dsa, g_kv_dsa, w_uv_dsa,
              a_re, a_im, log_dt, b_re, b_im, c_re, c_im, d_skip, w_glu,
              g_mem_norm, w_mem_kv, g_q_cross, g_k_cross,
              w_br_dsa, w_br_s5, w_br_cross, w_out,
              g_ffn_norm, w_ffn_gate, w_ffn_up, w_ffn_down):
    for l in range(DEPTH):
        x = hybrid_layer(x, mem, rel_bias, w_in[l], g_mix_norm[l], g_q_dsa[l], g_kv_dsa[l], w_uv_dsa[l],
                         a_re[l], a_im[l], log_dt[l], b_re[l], b_im[l], c_re[l], c_im[l], d_skip[l], w_glu[l],
                         g_mem_norm[l], w_mem_kv[l], g_q_cross[l], g_k_cross[l],
                         w_br_dsa[l], w_br_s5[l], w_br_cross[l], w_out[l],
                         g_ffn_norm[l], w_ffn_gate[l], w_ffn_up[l], w_ffn_down[l])
    return x
```

```cpp
#include <hip/hip_runtime.h>
#include <cstdio>
#include <cstdint>
#include <cmath>
constexpr int T_TOK = 16384, DM = 1024, SEQ = 2048, NB = 8, NIN = 2816, NINP = 5888, DFF = 2816;
constexpr size_t MiB = 1u << 20;
constexpr size_t WS_CTL = 0;
constexpr size_t WS_WIN = 1 * MiB, WS_WMKV = 13 * MiB, WS_WGLU = 15 * MiB, WS_WBR = 16 * MiB, WS_WOUT = 19 * MiB, WS_WGU = 21 * MiB, WS_WD = 32 * MiB;
constexpr size_t WS_WUV = 38 * MiB, WS_BIASL = 38 * MiB + 512 * 1024, WS_RS = 39 * MiB, WS_WI = 39 * MiB + 512 * 1024;
constexpr size_t WS_S5TV = 40 * MiB, WS_S5W = 60 * MiB, WS_KX = 68 * MiB, WS_VX = 70 * MiB, WS_MEMN = 72 * MiB, WS_H = 76 * MiB;
constexpr size_t WS_QD = 108 * MiB, WS_CKV = 140 * MiB, WS_QI = 144 * MiB, WS_KI = 160 * MiB, WS_QX = 162 * MiB, WS_U = 178 * MiB, WS_SLOC = 198 * MiB;
constexpr size_t WS_ODSA = 206 * MiB, WS_OX = 222 * MiB, WS_Y = 238 * MiB, WS_END = 254 * MiB;
constexpr size_t WS_OS5 = 108 * MiB, WS_G = 124 * MiB, WS_MERGED = 156 * MiB, WS_ACT = 108 * MiB, WS_XN = WS_H;
namespace nv {
typedef unsigned short bf16;
__device__ __forceinline__ unsigned f2bf(float f) { unsigned u = __float_as_uint(f); return (u + 0x7fffu + ((u >> 16) & 1u)) >> 16; }
__device__ __forceinline__ float bf2f(unsigned short b) { return __uint_as_float((unsigned)b << 16); }

__global__ void k_transpose(const float* __restrict__ W, const float* __restrict__ W2, const float* __restrict__ gain,
                            bf16* __restrict__ WT, int K, int N, int ND, int mode) {
    const size_t total = (size_t)ND * K;
    for (size_t i = (size_t)blockIdx.x * blockDim.x + threadIdx.x; i < total; i += (size_t)gridDim.x * blockDim.x) {
        const int d = (int)(i / K), k = (int)(i % K);
        float v;
        if (mode == 0) v = W[(size_t)k * N + d];
        else if (mode == 1) { if (d >= 1736 && d < 1792) v = 0.f; else { const int s = d >= 1792 ? d - 56 : d; v = W[(size_t)k * N + s]; } }
        else { const int tile = d >> 8, w = d & 255, f = tile * 128 + (w & 127); v = ((w < 128) ? W : W2)[(size_t)k * N + f] * gain[k]; }
        WT[i] = (bf16)f2bf(v);
    }
}
__global__ void k_wuv(const float* __restrict__ W, bf16* __restrict__ WT) {
    const int i = blockIdx.x * blockDim.x + threadIdx.x; if (i >= 8 * 64 * 128) return;
    const int h = i / (64 * 128), e = (i / 128) % 64, d = i % 128;
    WT[i] = (bf16)f2bf(W[(h * 128 + d) * 64 + e]);
}
__global__ void k_rmsnorm1024(const float* __restrict__ x, const float* __restrict__ g, bf16* __restrict__ out, int rows) {
    __shared__ float red[4];
    const int r = blockIdx.x; if (r >= rows) return;
    const float4 v = ((const float4*)(x + (size_t)r * 1024))[threadIdx.x];
    float s = v.x * v.x + v.y * v.y + v.z * v.z + v.w * v.w;
    for (int o = 32; o; o >>= 1) s += __shfl_xor(s, o);
    if ((threadIdx.x & 63) == 0) red[threadIdx.x >> 6] = s;
    __syncthreads();
    const float tot = red[0] + red[1] + red[2] + red[3];
    const float rs = rsqrtf(tot * (1.f / 1024.f) + 1e-6f);
    const float4 gg = ((const float4*)g)[threadIdx.x];
    bf16* o = out + (size_t)r * 1024 + threadIdx.x * 4;
    o[0] = (bf16)f2bf(v.x * rs * gg.x); o[1] = (bf16)f2bf(v.y * rs * gg.y); o[2] = (bf16)f2bf(v.z * rs * gg.z); o[3] = (bf16)f2bf(v.w * rs * gg.w);
}
__device__ __forceinline__ int t5_bucket(int n) {
    if (n < 16) return n;
    const float nf = (float)n;
    int large = 16 + (int)((logf(nf / 16.f) / 2.0794415416798357f) * 16.f);
    return large < 31 ? large : 31;
}
__global__ void k_biaslut(const float* __restrict__ rel_bias, float* __restrict__ BL) {
    const int i = blockIdx.x * blockDim.x + threadIdx.x;
    if (i < 8 * 128) { const int h = i / 128, d = i % 128; BL[i] = rel_bias[t5_bucket(d) * 8 + h] * 1.4426950408889634f; }
    else if (i < 8 * 128 + 8) { const int h = i - 8 * 128; BL[i] = rel_bias[31 * 8 + h] * 1.4426950408889634f; }
}

template <class Epi>
__global__ void __launch_bounds__(256) k_gemm(const bf16* __restrict__ A, const bf16* __restrict__ Bt, int M, int N, int K, Epi epi) {
    const int tx = threadIdx.x & 15, ty = threadIdx.x >> 4;
    const int n0 = (blockIdx.x * 16 + tx) * 4, m0 = (blockIdx.y * 16 + ty) * 4;
    if (n0 >= N || m0 >= M) return;
    float acc[4][4];
#pragma unroll
    for (int i = 0; i < 4; ++i)
#pragma unroll
        for (int j = 0; j < 4; ++j) acc[i][j] = 0.f;
    for (int k = 0; k < K; k += 8) {
        uint4 a[4], b[4];
#pragma unroll
        for (int i = 0; i < 4; ++i) { a[i] = *(const uint4*)(A + (size_t)(m0 + i) * K + k); b[i] = *(const uint4*)(Bt + (size_t)(n0 + i) * K + k); }
#pragma unroll
        for (int i = 0; i < 4; ++i) {
            const unsigned aw[4] = {a[i].x, a[i].y, a[i].z, a[i].w};
#pragma unroll
            for (int j = 0; j < 4; ++j) {
                const unsigned bw[4] = {b[j].x, b[j].y, b[j].z, b[j].w};
#pragma unroll
                for (int q = 0; q < 4; ++q) {
                    acc[i][j] += __uint_as_float(aw[q] << 16) * __uint_as_float(bw[q] << 16);
                    acc[i][j] += __uint_as_float(aw[q] & 0xffff0000u) * __uint_as_float(bw[q] & 0xffff0000u);
                }
            }
        }
    }
#pragma unroll
    for (int i = 0; i < 4; ++i)
#pragma unroll
        for (int j = 0; j < 4; ++j) epi(m0 + i, n0 + j, acc[i][j]);
}

struct EpiInproj {
    bf16 *QD, *CKV, *QI, *KI, *U, *QX; float* WI;
    __device__ void operator()(int t, int c, float v) const {
        if (c < 1024) QD[(size_t)t * 1024 + c] = (bf16)f2bf(v);
        else if (c < 1152) CKV[(size_t)t * 128 + (c - 1024)] = (bf16)f2bf(v);
        else if (c < 1664) QI[(size_t)t * 512 + (c - 1152)] = (bf16)f2bf(v);
        else if (c < 1728) KI[(size_t)t * 64 + (c - 1664)] = (bf16)f2bf(v);
        else if (c < 1792) { if (c < 1736) WI[(size_t)t * 8 + (c - 1728)] = v; }
        else if (c < 2304) { const int cu = c - 1792, g = cu >> 4, ci = cu & 15, b = t >> 11, tt = t & 2047, R = b * 64 + (tt >> 5), s = tt & 31;
            U[((size_t)(g * 512 + R)) * 640 + s * 16 + ci] = (bf16)f2bf(v); }
        else QX[(size_t)t * 512 + (c - 2304)] = (bf16)f2bf(v);
    }
};
struct EpiBf16Split { bf16* O0; bf16* O1; int split; int ld;
    __device__ void operator()(int m, int c, float v) const { if (c < split) O0[(size_t)m * ld + c] = (bf16)f2bf(v); else O1[(size_t)m * ld + (c - split)] = (bf16)f2bf(v); } };
struct EpiGlu { const bf16* Y; bf16* O;
    __device__ void operator()(int m, int c, float v) const { const float y = bf2f(Y[(size_t)m * 512 + c]); O[(size_t)m * 512 + c] = (bf16)f2bf(y / (1.f + __expf(-v))); } };
struct EpiSigmoid { bf16* G; __device__ void operator()(int m, int c, float v) const { G[(size_t)m * 1024 + c] = (bf16)f2bf(1.f / (1.f + __expf(-v))); } };
struct EpiMerge { const bf16* G; bf16* MG; int first;
    __device__ void operator()(int m, int c, float v) const { const size_t i = (size_t)m * 1024 + c; float p = first ? 0.f : bf2f(MG[i]); MG[i] = (bf16)f2bf(p + bf2f(G[i]) * v); } };
struct EpiOut { const float* x; float* x1; bf16* XN;
    __device__ void operator()(int m, int c, float v) const { const size_t i = (size_t)m * 1024 + c; const float r = x[i] + v; x1[i] = r; XN[i] = (bf16)f2bf(r); } };
struct EpiDown { float* out;
    __device__ void operator()(int m, int c, float v) const { const size_t i = (size_t)m * 1024 + c; out[i] = out[i] + v; } };
struct EpiF32 { float* C; int ld; __device__ void operator()(int m, int c, float v) const { C[(size_t)m * ld + c] = v; } };

__global__ void k_rowss(const float* __restrict__ x1, float* __restrict__ RS) {
    const int t = blockIdx.x, q = threadIdx.x >> 6, l = threadIdx.x & 63;
    const float4 v = ((const float4*)(x1 + (size_t)t * 1024 + q * 256))[l];
    float s = v.x * v.x + v.y * v.y + v.z * v.z + v.w * v.w;
    for (int o = 32; o; o >>= 1) s += __shfl_xor(s, o);
    if (l == 0) RS[t * 4 + q] = s;
}
__global__ void __launch_bounds__(256) k_gemm_gu(const bf16* __restrict__ A, const bf16* __restrict__ Bt, const float* __restrict__ RS, bf16* __restrict__ ACT) {
    const int K = 1024;
    const int tx = threadIdx.x & 15, ty = threadIdx.x >> 4;
    const int f0 = (blockIdx.x * 16 + tx) * 4, m0 = (blockIdx.y * 16 + ty) * 4;
    float ag[4][4], au[4][4];
#pragma unroll
    for (int i = 0; i < 4; ++i)
#pragma unroll
        for (int j = 0; j < 4; ++j) { ag[i][j] = 0.f; au[i][j] = 0.f; }
    for (int k = 0; k < K; k += 8) {
        uint4 a[4], bg[4], bu[4];
#pragma unroll
        for (int i = 0; i < 4; ++i) { a[i] = *(const uint4*)(A + (size_t)(m0 + i) * K + k);
            const int f = f0 + i, rg = (f >> 7) * 256 + (f & 127);
            bg[i] = *(const uint4*)(Bt + (size_t)rg * K + k); bu[i] = *(const uint4*)(Bt + (size_t)(rg + 128) * K + k); }
#pragma unroll
        for (int i = 0; i < 4; ++i) {
            const unsigned aw[4] = {a[i].x, a[i].y, a[i].z, a[i].w};
#pragma unroll
            for (int j = 0; j < 4; ++j) {
                const unsigned gw[4] = {bg[j].x, bg[j].y, bg[j].z, bg[j].w};
                const unsigned uw[4] = {bu[j].x, bu[j].y, bu[j].z, bu[j].w};
#pragma unroll
                for (int q = 0; q < 4; ++q) {
                    const float alo = __uint_as_float(aw[q] << 16), ahi = __uint_as_float(aw[q] & 0xffff0000u);
                    ag[i][j] += alo * __uint_as_float(gw[q] << 16); ag[i][j] += ahi * __uint_as_float(gw[q] & 0xffff0000u);
                    au[i][j] += alo * __uint_as_float(uw[q] << 16); au[i][j] += ahi * __uint_as_float(uw[q] & 0xffff0000u);
                }
            }
        }
    }
#pragma unroll
    for (int i = 0; i < 4; ++i) { const int m = m0 + i;
        const float rs = rsqrtf((RS[m * 4] + RS[m * 4 + 1] + RS[m * 4 + 2] + RS[m * 4 + 3]) * (1.f / 1024.f) + 1e-6f);
#pragma unroll
        for (int j = 0; j < 4; ++j) { const float g = ag[i][j] * rs, u = au[i][j] * rs;
            ACT[(size_t)m * 2816 + f0 + j] = (bf16)f2bf(g / (1.f + __expf(-g)) * u); } }
}

__global__ void k_norm128(bf16* __restrict__ X, int rows, int ld, int ngroups, const float* __restrict__ g) {
    const int gid = (blockIdx.x * blockDim.x + threadIdx.x) >> 4, l = threadIdx.x & 15;
    const bool ok = gid < rows * ngroups;
    const int r = ok ? gid / ngroups : 0, gi = ok ? gid % ngroups : 0;
    bf16* p = X + (size_t)r * ld + gi * 128 + l * 8;
    uint4 v = *(const uint4*)p; const unsigned w[4] = {v.x, v.y, v.z, v.w};
    float f[8];
#pragma unroll
    for (int q = 0; q < 4; ++q) { f[2 * q] = __uint_as_float(w[q] << 16); f[2 * q + 1] = __uint_as_float(w[q] & 0xffff0000u); }
    float s = 0.f;
#pragma unroll
    for (int q = 0; q < 8; ++q) s += f[q] * f[q];
    for (int o = 8; o; o >>= 1) s += __shfl_xor(s, o);
    const float rs = rsqrtf(s * (1.f / 128.f) + 1e-6f);
    unsigned o4[4];
#pragma unroll
    for (int q = 0; q < 4; ++q) o4[q] = f2bf(f[2 * q] * rs * g[l * 8 + 2 * q]) | (f2bf(f[2 * q + 1] * rs * g[l * 8 + 2 * q + 1]) << 16);
    if (ok) *(uint4*)p = make_uint4(o4[0], o4[1], o4[2], o4[3]);
}

__global__ void __launch_bounds__(256) k_dsa(const bf16* __restrict__ QD, const bf16* __restrict__ CKV, const bf16* __restrict__ QI, const bf16* __restrict__ KI,
                                             const float* __restrict__ WI, const float* __restrict__ BL, const bf16* __restrict__ WUVT, bf16* __restrict__ ODSA) {
    __shared__ float sc[2048];
    __shared__ float qi[512];
    __shared__ float qd[1024];
    __shared__ float wh[8];
    __shared__ int sel[256];
    __shared__ float pr[256];
    __shared__ float ov[128];
    __shared__ float red[8];
    __shared__ int nsel;
    const int row = blockIdx.x, b = row >> 11, t = row & 2047, tid = threadIdx.x;
    for (int i = tid; i < 512; i += 256) qi[i] = bf2f(QI[(size_t)row * 512 + i]);
    for (int i = tid; i < 1024; i += 256) qd[i] = bf2f(QD[(size_t)row * 1024 + i]);
    if (tid < 8) wh[tid] = WI[(size_t)row * 8 + tid];
    if (tid == 0) nsel = 0;
    __syncthreads();
    const int nk = t + 1;
    for (int s = tid; s < nk; s += 256) {
        const bf16* kp = KI + ((size_t)(b * 2048 + s)) * 64;
        float kf[64];
#pragma unroll
        for (int d = 0; d < 64; ++d) kf[d] = bf2f(kp[d]);
        float score = 0.f;
        for (int h = 0; h < 8; ++h) { float dsum = 0.f;
#pragma unroll
            for (int d = 0; d < 64; ++d) dsum += qi[h * 64 + d] * kf[d];
            score += fmaxf(dsum, 0.f) * wh[h]; }
        sc[s] = score;
    }
    __syncthreads();
    for (int s = tid; s < nk; s += 256) {
        bool take;
        if (nk <= 256) take = true;
        else { const float v = sc[s]; int cnt = 0;
            for (int s2 = 0; s2 < nk; ++s2) { const float w = sc[s2]; cnt += (w > v || (w == v && s2 < s)) ? 1 : 0; }
            take = cnt < 256; }
        if (take) { const int p = atomicAdd(&nsel, 1); if (p < 256) sel[p] = s; }
    }
    __syncthreads();
    const int ns = nsel < 256 ? nsel : 256;
    const float scale = 0.08838834764831845f * 1.4426950408889634f;
    for (int h = 0; h < 8; ++h) {
        float lg = -INFINITY;
        if (tid < ns) { const int s = sel[tid]; const bf16* cp = CKV + ((size_t)(b * 2048 + s)) * 128; float dsum = 0.f;
            for (int d = 0; d < 128; ++d) dsum += qd[h * 128 + d] * bf2f(cp[d]);
            const int dist = t - s; const float bias = dist < 128 ? BL[h * 128 + dist] : BL[8 * 128 + h];
            lg = dsum * scale + bias; }
        float m = lg; for (int o = 32; o; o >>= 1) m = fmaxf(m, __shfl_xor(m, o));
        if ((tid & 63) == 0) red[tid >> 6] = m;
        __syncthreads();
        m = fmaxf(fmaxf(red[0], red[1]), fmaxf(red[2], red[3]));
        const float p = (tid < ns) ? exp2f(lg - m) : 0.f;
        float sum = p; for (int o = 32; o; o >>= 1) sum += __shfl_xor(sum, o);
        if ((tid & 63) == 0) red[4 + (tid >> 6)] = sum;
        pr[tid] = p;
        __syncthreads();
        sum = red[4] + red[5] + red[6] + red[7];
        if (tid < 128) { float o = 0.f; for (int k = 0; k < ns; ++k) o += pr[k] * bf2f(CKV[((size_t)(b * 2048 + sel[k])) * 128 + tid]); ov[tid] = o / sum; }
        __syncthreads();
        if (tid < 64) { float o = 0.f; const bf16* wp = WUVT + ((size_t)(h * 64 + tid)) * 128; for (int d = 0; d < 128; ++d) o += ov[d] * bf2f(wp[d]);
            ODSA[(size_t)row * 512 + h * 64 + tid] = (bf16)f2bf(o); }
        __syncthreads();
    }
}

__global__ void __launch_bounds__(256) k_cross(const bf16* __restrict__ QX, const bf16* __restrict__ KX, const bf16* __restrict__ VX, bf16* __restrict__ OX) {
    __shared__ float q[512]; __shared__ float pr[256]; __shared__ float red[8];
    const int row = blockIdx.x, b = row >> 11, tid = threadIdx.x;
    for (int i = tid; i < 512; i += 256) q[i] = bf2f(QX[(size_t)row * 512 + i]);
    __syncthreads();
    const float scale = 0.08838834764831845f * 1.4426950408889634f;
    for (int h = 0; h < 4; ++h) {
        const bf16* kp = KX + ((size_t)(b * 256 + tid)) * 512 + h * 128; float dsum = 0.f;
        for (int d = 0; d < 128; ++d) dsum += q[h * 128 + d] * bf2f(kp[d]);
        const float lg = dsum * scale;
        float m = lg; for (int o = 32; o; o >>= 1) m = fmaxf(m, __shfl_xor(m, o));
        if ((tid & 63) == 0) red[tid >> 6] = m;
        __syncthreads();
        m = fmaxf(fmaxf(red[0], red[1]), fmaxf(red[2], red[3]));
        const float p = exp2f(lg - m);
        float sum = p; for (int o = 32; o; o >>= 1) sum += __shfl_xor(sum, o);
        if ((tid & 63) == 0) red[4 + (tid >> 6)] = sum;
        pr[tid] = p;
        __syncthreads();
        sum = red[4] + red[5] + red[6] + red[7];
        if (tid < 128) { float o = 0.f; for (int k = 0; k < 256; ++k) o += pr[k] * bf2f(VX[((size_t)(b * 256 + k)) * 512 + h * 128 + tid]);
            OX[(size_t)row * 512 + h * 128 + tid] = (bf16)f2bf(o / sum); }
        __syncthreads();
    }
}

__device__ __forceinline__ float gelu_tanh(float x) { const float u = 0.7978845608028654f * (x + 0.044715f * x * x * x); return 0.5f * x * (1.f + tanhf(u)); }
__global__ void __launch_bounds__(64) k_s5(const bf16* __restrict__ U, const float* __restrict__ a_re, const float* __restrict__ a_im, const float* __restrict__ log_dt,
                                           const float* __restrict__ b_re, const float* __restrict__ b_im, const float* __restrict__ c_re, const float* __restrict__ c_im,
                                           const float* __restrict__ d_skip, bf16* __restrict__ Y) {
    const int b = blockIdx.x >> 5, g = blockIdx.x & 31, n = threadIdx.x;
    const double dt = exp((double)log_dt[g]);
    const double lr = (double)a_re[g * 64 + n], li = (double)a_im[g * 64 + n];
    const double mag = exp(lr * dt), lbr = mag * cos(li * dt), lbi = mag * sin(li * dt);
    const double nr = lbr - 1.0, ni = lbi, den = lr * lr + li * li;
    const double fr = (nr * lr + ni * li) / den, fi = (ni * lr - nr * li) / den;
    float Bre[16], Bim[16], Cre[16], Cim[16];
#pragma unroll
    for (int c = 0; c < 16; ++c) { const double br = b_re[(g * 64 + n) * 16 + c], bi = b_im[(g * 64 + n) * 16 + c];
        Bre[c] = (float)(fr * br - fi * bi); Bim[c] = (float)(fr * bi + fi * br);
        Cre[c] = c_re[(g * 16 + c) * 64 + n]; Cim[c] = c_im[(g * 16 + c) * 64 + n]; }
    const float ar = (float)lbr, ai = (float)lbi;
    const float dsk = n < 16 ? d_skip[g * 16 + n] : 0.f;
    float xr = 0.f, xi = 0.f;
    for (int t = 0; t < 2048; ++t) {
        const int R = b * 64 + (t >> 5), s = t & 31;
        const bf16* up = U + ((size_t)(g * 512 + R)) * 640 + s * 16;
        float u[16]; float bur = 0.f, bui = 0.f;
#pragma unroll
        for (int c = 0; c < 16; ++c) { u[c] = bf2f(up[c]); bur += Bre[c] * u[c]; bui += Bim[c] * u[c]; }
        const float nxr = ar * xr - ai * xi + bur, nxi = ar * xi + ai * xr + bui; xr = nxr; xi = nxi;
        float yout = 0.f;
#pragma unroll
        for (int c = 0; c < 16; ++c) { float v = Cre[c] * xr - Cim[c] * xi;
            for (int o = 32; o; o >>= 1) v += __shfl_xor(v, o);
            if (n == c) yout = v + dsk * u[c]; }
        if (n < 16) Y[(size_t)(b * 2048 + t) * 512 + g * 16 + n] = (bf16)f2bf(gelu_tanh(yout));
    }
}
}
extern "C" void kernel_launch(void* const* d_in, const int* in_sizes, int n_in, void* d_out, int out_size, void* d_ws, size_t ws_size, hipStream_t stream) {
    using namespace nv;
    if (n_in != 29 || ws_size < WS_END || out_size != T_TOK * DM) { fprintf(stderr, "kernel_launch: unexpected sizes n_in %d ws %zu out %d\n", n_in, ws_size, out_size); return; }
    const float* const* in = (const float* const*)d_in;
    unsigned char* ws = (unsigned char*)d_ws; float* out = (float*)d_out;
    bf16 *WIN = (bf16*)(ws + WS_WIN), *WMKV = (bf16*)(ws + WS_WMKV), *WGLU = (bf16*)(ws + WS_WGLU), *WBR = (bf16*)(ws + WS_WBR), *WOUT = (bf16*)(ws + WS_WOUT), *WGU = (bf16*)(ws + WS_WGU), *WD = (bf16*)(ws + WS_WD), *WUV = (bf16*)(ws + WS_WUV);
    float *BL = (float*)(ws + WS_BIASL), *RS = (float*)(ws + WS_RS), *WI = (float*)(ws + WS_WI);
    bf16 *KX = (bf16*)(ws + WS_KX), *VX = (bf16*)(ws + WS_VX), *MEMN = (bf16*)(ws + WS_MEMN), *H = (bf16*)(ws + WS_H), *QD = (bf16*)(ws + WS_QD), *CKV = (bf16*)(ws + WS_CKV), *QI = (bf16*)(ws + WS_QI), *KI = (bf16*)(ws + WS_KI),
         *QX = (bf16*)(ws + WS_QX), *U = (bf16*)(ws + WS_U), *ODSA = (bf16*)(ws + WS_ODSA), *OX = (bf16*)(ws + WS_OX), *Y = (bf16*)(ws + WS_Y), *OS5 = (bf16*)(ws + WS_OS5), *G = (bf16*)(ws + WS_G), *MG = (bf16*)(ws + WS_MERGED),
         *ACT = (bf16*)(ws + WS_ACT), *XN = (bf16*)(ws + WS_XN);
    k_transpose<<<2048, 256, 0, stream>>>(in[3], nullptr, nullptr, WIN, 1024, 5832, 5888, 1);
    k_transpose<<<2048, 256, 0, stream>>>(in[18], nullptr, nullptr, WMKV, 1024, 1024, 1024, 0);
    k_transpose<<<1024, 256, 0, stream>>>(in[16], nullptr, nullptr, WGLU, 512, 512, 512, 0);
    k_transpose<<<2048, 256, 0, stream>>>(in[21], nullptr, nullptr, WBR, 512, 1024, 1024, 0);
    k_transpose<<<2048, 256, 0, stream>>>(in[22], nullptr, nullptr, WBR + 1024 * 512, 512, 1024, 1024, 0);
    k_transpose<<<2048, 256, 0, stream>>>(in[23], nullptr, nullptr, WBR + 2 * 1024 * 512, 512, 1024, 1024, 0);
    k_transpose<<<2048, 256, 0, stream>>>(in[24], nullptr, nullptr, WOUT, 1024, 1024, 1024, 0);
    k_transpose<<<2048, 256, 0, stream>>>(in[26], in[27], in[25], WGU, 1024, 2816, 5632, 2);
    k_transpose<<<2048, 256, 0, stream>>>(in[28], nullptr, nullptr, WD, 2816, 1024, 1024, 0);
    k_wuv<<<256, 256, 0, stream>>>(in[7], WUV);
    k_rmsnorm1024<<<16384, 256, 0, stream>>>(in[0], in[4], H, 16384);
    k_rmsnorm1024<<<2048, 256, 0, stream>>>(in[1], in[17], MEMN, 2048);
    k_biaslut<<<5, 256, 0, stream>>>(in[2], BL);
    k_gemm<EpiInproj><<<dim3(NIN / 64, T_TOK / 64), 256, 0, stream>>>(H, WIN, T_TOK, NIN, 1024, EpiInproj{QD, CKV, QI, KI, U, QX, WI});
    k_gemm<EpiBf16Split><<<dim3(1024 / 64, 2048 / 64), 256, 0, stream>>>(MEMN, WMKV, 2048, 1024, 1024, EpiBf16Split{KX, VX, 512, 512});
    k_norm128<<<(16384 * 8 * 16 + 255) / 256, 256, 0, stream>>>(QD, 16384, 1024, 8, in[5]);
    k_norm128<<<(16384 * 1 * 16 + 255) / 256, 256, 0, stream>>>(CKV, 16384, 128, 1, in[6]);
    k_norm128<<<(16384 * 4 * 16 + 255) / 256, 256, 0, stream>>>(QX, 16384, 512, 4, in[19]);
    k_norm128<<<(2048 * 4 * 16 + 255) / 256, 256, 0, stream>>>(KX, 2048, 512, 4, in[20]);
    k_dsa<<<16384, 256, 0, stream>>>(QD, CKV, QI, KI, WI, BL, WUV, ODSA);
    k_cross<<<16384, 256, 0, stream>>>(QX, KX, VX, OX);
    k_s5<<<256, 64, 0, stream>>>(U, in[8], in[9], in[10], in[11], in[12], in[13], in[14], in[15], Y);
    k_gemm<EpiGlu><<<dim3(512 / 64, T_TOK / 64), 256, 0, stream>>>(Y, WGLU, T_TOK, 512, 512, EpiGlu{Y, OS5});
    const bf16* obr[3] = {ODSA, OS5, OX};
    for (int br = 0; br < 3; ++br) {
        k_gemm<EpiSigmoid><<<dim3(1024 / 64, T_TOK / 64), 256, 0, stream>>>(H, WIN + (size_t)(NIN + br * 1024) * 1024, T_TOK, 1024, 1024, EpiSigmoid{G});
        k_gemm<EpiMerge><<<dim3(1024 / 64, T_TOK / 64), 256, 0, stream>>>(obr[br], WBR + (size_t)br * 1024 * 512, T_TOK, 1024, 512, EpiMerge{G, MG, br == 0});
    }
    k_gemm<EpiOut><<<dim3(1024 / 64, T_TOK / 64), 256, 0, stream>>>(MG, WOUT, T_TOK, 1024, 1024, EpiOut{in[0], out, XN});
    k_rowss<<<16384, 256, 0, stream>>>(out, RS);
    k_gemm_gu<<<dim3(DFF / 64, T_TOK / 64), 256, 0, stream>>>(XN, WGU, RS, ACT);
    k_gemm<EpiDown><<<dim3(1024 / 64, T_TOK / 64), 256, 0, stream>>>(ACT, WD, T_TOK, 1024, 2816, EpiDown{out});
}
```

```cpp
#include <hip/hip_runtime.h>
#include <cstdio>
#include <cstdint>
#include <cmath>
constexpr int T_TOK = 16384, DM = 1024, SEQ = 2048, NB = 8, NIN = 2816, NINP = 5888, DFF = 2816;
constexpr size_t MiB = 1u << 20;
constexpr size_t WS_CTL = 0;
constexpr size_t WS_WIN = 1 * MiB, WS_WMKV = 13 * MiB, WS_WGLU = 15 * MiB, WS_WBR = 16 * MiB, WS_WOUT = 19 * MiB, WS_WGU = 21 * MiB, WS_WD = 32 * MiB;
constexpr size_t WS_WUV = 38 * MiB, WS_BIASL = 38 * MiB + 512 * 1024, WS_RS = 39 * MiB, WS_WI = 37 * MiB + 512 * 1024;
constexpr size_t WS_S5TV = 40 * MiB, WS_S5W = 60 * MiB, WS_KX = 68 * MiB, WS_VX = 70 * MiB, WS_MEMN = 72 * MiB, WS_H = 76 * MiB;
constexpr size_t WS_QD = 108 * MiB, WS_CKV = 140 * MiB, WS_QI = 144 * MiB, WS_KI = 160 * MiB, WS_QX = 162 * MiB, WS_U = 178 * MiB, WS_SLOC = 198 * MiB;
constexpr size_t WS_ODSA = 206 * MiB, WS_OX = 222 * MiB, WS_Y = 238 * MiB, WS_END = 254 * MiB;
constexpr size_t WS_OS5 = 108 * MiB, WS_G = 124 * MiB, WS_MERGED = 156 * MiB, WS_ACT = 108 * MiB, WS_XN = WS_H;
__device__ __forceinline__ int my_lane_id() { int l; asm volatile("v_mbcnt_lo_u32_b32 %0, -1, 0\n\tv_mbcnt_hi_u32_b32 %0, -1, %0" : "=v"(l)); return l; }
#define CFG_FLAGS 0
#define CFG_ONE_LAUNCH 1
namespace pg8 {
#define PG8_LAS __attribute__((address_space(3)))
typedef unsigned short bf16_t;
typedef short bf16x8 __attribute__((ext_vector_type(8)));
typedef float f32x4 __attribute__((ext_vector_type(4)));
typedef unsigned u32x4 __attribute__((ext_vector_type(4)));
constexpr int BM = 256, BK = 64, HALF = 128, HTB = HALF * BK * 2  , STAGE_BYTES = 8 * HTB, NXCD = 8, WGM = 8;

__host__ __device__ __forceinline__ int lds_byte(int r, int c) { const int st = (r >> 4) * 2 + (c >> 5), rr = r & 15, cc = c & 31, ob = rr * 64 + cc * 2; return st * 1024 + (ob ^ (((ob >> 9) & 1) << 5)); }
__host__ __device__ __forceinline__ void stage_rc(int b, int& R, int& C) { const int st = b / 1024, sb = b % 1024, swz = sb ^ (((sb >> 9) & 1) << 5); R = (st >> 1) * 16 + swz / 64; C = (st & 1) * 32 + (swz % 64) / 2; }
__host__ __device__ __forceinline__ int perm32(int rho) { const int n = rho >> 4, i = rho & 15; return 8 * (i >> 2) + 4 * n + (i & 3); }

struct Unit { int pm, pn; };
struct Gemm { const bf16_t* A; const bf16_t* Bt; int M, N, K, lda, ldb; };

struct StaticOrder {
    int nM, nN, nwg, G, c;
    __host__ __device__ void init(int M, int N, int G_, int c_) { nM = M / BM; nN = N / BM; nwg = nM * nN; G = G_; c = c_; }
    __host__ __device__ bool next(int i, Unit& u) const {
        const long L = (long)i * G + c; if (L >= nwg) return false;
        int wgid = (int)L; { const int q = nwg / NXCD, r = nwg % NXCD, xcd = wgid % NXCD, off = wgid / NXCD; wgid = (xcd < r ? xcd * (q + 1) : r * (q + 1) + (xcd - r) * q) + off; }
        const int nig = WGM * nN, gid = wgid / nig, fm = gid * WGM, gsz = (nM - fm) < WGM ? (nM - fm) : WGM;
        u.pm = fm + ((wgid % nig) % gsz); u.pn = (wgid % nig) / gsz; return true;
    }
    __device__ __forceinline__ void a_ready(const Unit&) const {}
    __device__ __forceinline__ void done(const Unit&) const {}
};

typedef float f32x2_c __attribute__((ext_vector_type(2))); typedef __bf16 bf16x2_c __attribute__((ext_vector_type(2)));
__device__ __forceinline__ unsigned cvt_pk_bf16(float lo, float hi) { const f32x2_c v = {lo, hi}; const bf16x2_c b = __builtin_convertvector(v, bf16x2_c); return __builtin_bit_cast(unsigned, b); }
typedef float f32x2 __attribute__((ext_vector_type(2)));
template <class Epi, class Sched, bool ALIGN_EPI = false, bool SP2 = false>
__device__ __forceinline__ void gemm_phase(PG8_LAS unsigned char* lds, const Gemm g, const Sched& S, const Epi& E, const int wid) {
    const int lane = my_lane_id(), tid = wid * 64 + lane, wr = wid >> 2, wc = wid & 3, fr = lane & 15, fq = lane >> 4;
    const int K = g.K, nt = K / BK, lda = g.lda, ldb = g.ldb;
    unsigned voffA[2], voffB[2];
#pragma unroll
    for (int i = 0; i < 2; ++i) { int R, C; stage_rc(tid * 16 + i * 8192, R, C); const int Rb = Epi::PERM ? ((R & ~31) + perm32(R & 31)) : R;
        voffA[i] = (unsigned)(R * lda + C) * 2u; voffB[i] = (unsigned)(Rb * ldb + C) * 2u; }
    const size_t kstep = (size_t)(BK * 2);
    const size_t hstepA = (size_t)HALF * lda * 2, hstepB = (size_t)HALF * ldb * 2;
    const size_t tstepA = 2 * hstepA, tstepB = 2 * hstepB;
    const unsigned ldsw = (unsigned)wid * 1024u;
    const int aoff = lds_byte(wr * 64 + fr, fq * 8), boff = lds_byte(wc * 32 + fr, fq * 8);
#define PG8_SA(b, h) (((b) * 2 + (h)) * HTB)
#define PG8_SB(b, h) ((4 + (b) * 2 + (h)) * HTB)
#define PG8_STAGE(bufoff, gbase, voff) do { _Pragma("unroll") for (int _i = 0; _i < 2; ++_i) \
        __builtin_amdgcn_global_load_lds((const unsigned*)((const char*)(gbase) + (voff)[_i]), (PG8_LAS unsigned*)(lds + (bufoff) + ldsw + _i * 8192), 16, 0, 0); } while (0)
#define PG8_LDA(dst, b, h) do { _Pragma("unroll") for (int m = 0; m < 4; ++m) _Pragma("unroll") for (int k = 0; k < 2; ++k) dst[m][k] = *(const PG8_LAS bf16x8*)(lds + PG8_SA(b, h) + aoff + m * 2048 + k * 1024); } while (0)
#define PG8_LDB(dst, b, h) do { _Pragma("unroll") for (int n = 0; n < 2; ++n) _Pragma("unroll") for (int k = 0; k < 2; ++k) dst[n][k] = *(const PG8_LAS bf16x8*)(lds + PG8_SB(b, h) + boff + n * 2048 + k * 1024); } while (0)
#define PG8_MMA(ai, bj, At, Bt) do { __builtin_amdgcn_s_setprio(1); _Pragma("unroll") for (int m = 0; m < 4; ++m) _Pragma("unroll") for (int n = 0; n < 2; ++n) _Pragma("unroll") for (int k = 0; k < 2; ++k) \
        acc[ai][bj][m][n] = __builtin_amdgcn_mfma_f32_16x16x32_bf16(Bt[n][k], At[m][k], acc[ai][bj][m][n], 0, 0, 0); __builtin_amdgcn_s_setprio(0); } while (0)
#define PG8_WAIT_V(n) asm volatile("s_waitcnt vmcnt(" #n ")" ::: "memory")
#define PG8_WAIT_L(n) asm volatile("s_waitcnt lgkmcnt(" #n ")" ::: "memory")
#define PG8_BAR __builtin_amdgcn_s_barrier()
#define PG8_SCHED __builtin_amdgcn_sched_barrier(0)
    Unit cur, nxt; int ui = 0;
    if (!S.next(0, cur)) return;
    f32x4 acc[2][2][4][2];
#pragma unroll
    for (int a = 0; a < 2; ++a)
#pragma unroll
        for (int b = 0; b < 2; ++b)
#pragma unroll
            for (int m = 0; m < 4; ++m)
#pragma unroll
                for (int n = 0; n < 2; ++n) acc[a][b][m][n] = (f32x4){0.f, 0.f, 0.f, 0.f};
    bf16x8 At[4][2], B0[2][2], B1[2][2];
    const char* cA = (const char*)g.A + (size_t)cur.pm * tstepA; const char* cB = (const char*)g.Bt + (size_t)cur.pn * tstepB;
    S.a_ready(cur);
    if constexpr (SP2) {
        PG8_STAGE(PG8_SB(0, 0), cB, voffB); PG8_STAGE(PG8_SB(0, 1), cB + hstepB, voffB); PG8_STAGE(PG8_SA(0, 0), cA, voffA); PG8_STAGE(PG8_SA(0, 1), cA + hstepA, voffA);
        if (wr == 1) PG8_BAR;
        PG8_WAIT_V(2); PG8_BAR;
        PG8_STAGE(PG8_SB(1, 0), cB + kstep, voffB); PG8_STAGE(PG8_SA(1, 0), cA + kstep, voffA); PG8_STAGE(PG8_SB(1, 1), cB + hstepB + kstep, voffB);
        PG8_WAIT_V(6); PG8_BAR;
    } else {
        PG8_STAGE(PG8_SB(0, 0), cB, voffB); PG8_STAGE(PG8_SA(0, 0), cA, voffA); PG8_STAGE(PG8_SB(0, 1), cB + hstepB, voffB); PG8_STAGE(PG8_SA(0, 1), cA + hstepA, voffA);
        if (wr == 1) PG8_BAR;
        PG8_WAIT_V(4); PG8_BAR;
        PG8_STAGE(PG8_SB(1, 0), cB + kstep, voffB); PG8_STAGE(PG8_SA(1, 0), cA + kstep, voffA); PG8_STAGE(PG8_SB(1, 1), cB + hstepB + kstep, voffB);
        PG8_WAIT_V(6); PG8_BAR;
    }
    for (;;) {
        const bool has_next = S.next(ui + 1, nxt);
        const char* nA = has_next ? (const char*)g.A + (size_t)nxt.pm * tstepA : cA; const char* nB = has_next ? (const char*)g.Bt + (size_t)nxt.pn * tstepB : cB;
        for (int t = 0; t < nt; t += 2) {
            const bool last = (t == nt - 2);
            const char* a1 = cA + (size_t)(t + 1) * kstep;
            const char* a2 = last ? nA : cA + (size_t)(t + 2) * kstep; const char* b2 = last ? nB : cB + (size_t)(t + 2) * kstep;
            const char* a3 = a2 + kstep; const char* b3 = b2 + kstep;
            if (last && has_next) S.a_ready(nxt);
            if constexpr (SP2) {
            PG8_LDB(B0, 0, 0); PG8_LDB(B1, 0, 1); PG8_SCHED; PG8_LDA(At, 0, 0); PG8_STAGE(PG8_SA(1, 1), a1 + hstepA, voffA);
            PG8_WAIT_V(8); PG8_WAIT_L(0); PG8_BAR; PG8_MMA(0, 0, At, B0); PG8_MMA(0, 1, At, B1); PG8_BAR; PG8_SCHED;
            PG8_LDA(At, 0, 1); PG8_STAGE(PG8_SB(0, 0), b2, voffB); PG8_STAGE(PG8_SB(0, 1), b2 + hstepB, voffB); PG8_STAGE(PG8_SA(0, 0), a2, voffA);
            PG8_WAIT_V(8); PG8_WAIT_L(0); PG8_BAR; PG8_MMA(1, 0, At, B0); PG8_MMA(1, 1, At, B1); PG8_BAR; PG8_SCHED;
            PG8_LDB(B0, 1, 0); PG8_LDB(B1, 1, 1); PG8_SCHED; PG8_LDA(At, 1, 0); PG8_STAGE(PG8_SA(0, 1), a2 + hstepA, voffA);
            PG8_WAIT_V(8); PG8_WAIT_L(0); PG8_BAR; PG8_MMA(0, 0, At, B0); PG8_MMA(0, 1, At, B1); PG8_BAR; PG8_SCHED;
            PG8_LDA(At, 1, 1); PG8_STAGE(PG8_SB(1, 0), b3, voffB); PG8_STAGE(PG8_SB(1, 1), b3 + hstepB, voffB); PG8_STAGE(PG8_SA(1, 0), a3, voffA);
            PG8_WAIT_V(8); PG8_WAIT_L(0); PG8_BAR; PG8_MMA(1, 0, At, B0); PG8_MMA(1, 1, At, B1); PG8_BAR; PG8_SCHED;
            } else {
            PG8_LDB(B0, 0, 0); PG8_SCHED; PG8_LDA(At, 0, 0); PG8_STAGE(PG8_SA(1, 1), a1 + hstepA, voffA);
            PG8_WAIT_L(8); PG8_BAR; PG8_WAIT_L(0); PG8_MMA(0, 0, At, B0); PG8_BAR; PG8_SCHED;
            PG8_LDB(B1, 0, 1); PG8_STAGE(PG8_SB(0, 0), b2, voffB);
            PG8_BAR; PG8_WAIT_L(0); PG8_MMA(0, 1, At, B1); PG8_BAR;
            PG8_LDA(At, 0, 1); PG8_STAGE(PG8_SA(0, 0), a2, voffA);
            PG8_BAR; PG8_WAIT_L(0); PG8_MMA(1, 0, At, B0); PG8_BAR; PG8_SCHED;
            PG8_STAGE(PG8_SB(0, 1), b2 + hstepB, voffB);
            PG8_WAIT_V(6); PG8_BAR; PG8_MMA(1, 1, At, B1); PG8_BAR;
            PG8_LDB(B0, 1, 0); PG8_SCHED; PG8_LDA(At, 1, 0); PG8_STAGE(PG8_SA(0, 1), a2 + hstepA, voffA);
            PG8_WAIT_L(8); PG8_BAR; PG8_WAIT_L(0); PG8_MMA(0, 0, At, B0); PG8_BAR; PG8_SCHED;
            PG8_LDB(B1, 1, 1); PG8_STAGE(PG8_SB(1, 0), b3, voffB);
            PG8_BAR; PG8_WAIT_L(0); PG8_MMA(0, 1, At, B1); PG8_BAR;
            PG8_LDA(At, 1, 1); PG8_STAGE(PG8_SA(1, 0), a3, voffA);
            PG8_BAR; PG8_WAIT_L(0); PG8_MMA(1, 0, At, B0); PG8_BAR; PG8_SCHED;
            PG8_STAGE(PG8_SB(1, 1), b3 + hstepB, voffB);
            PG8_WAIT_V(6); PG8_BAR; PG8_MMA(1, 1, At, B1); PG8_BAR;
            }
        }
        if constexpr (ALIGN_EPI) { if (wr == 0) PG8_BAR; }
        if constexpr (!Epi::AFTER_DRAIN) { E(acc, cur, wr, wc, fr, fq); S.done(cur); }
        if (!has_next) break;
#pragma unroll
        for (int a = 0; a < 2; ++a)
#pragma unroll
            for (int b = 0; b < 2; ++b)
#pragma unroll
                for (int m = 0; m < 4; ++m)
#pragma unroll
                    for (int n = 0; n < 2; ++n) acc[a][b][m][n] = (f32x4){0.f, 0.f, 0.f, 0.f};
        cur = nxt; cA = nA; cB = nB; ++ui;
        if constexpr (ALIGN_EPI) { if (wr == 1) PG8_BAR; }
    }
    PG8_WAIT_V(0);
    if constexpr (!ALIGN_EPI) { if (wr == 0) PG8_BAR; }
    PG8_BAR;
    if constexpr (Epi::AFTER_DRAIN) { E.fused(acc, cur, wr, wc, fr, fq, lds, wid, lane); S.done(cur); }
#undef PG8_SA
#undef PG8_SB
#undef PG8_STAGE
#undef PG8_LDA
#undef PG8_LDB
#undef PG8_MMA
#undef PG8_WAIT_V
#undef PG8_WAIT_L
#undef PG8_BAR
#undef PG8_SCHED
}
}
namespace pg8 {
typedef unsigned u32x2 __attribute__((ext_vector_type(2)));
__device__ __forceinline__ u32x4 pack8(const f32x4 a, const f32x4 b) { u32x4 w; w.x = cvt_pk_bf16(a[0], a[1]); w.y = cvt_pk_bf16(a[2], a[3]); w.z = cvt_pk_bf16(b[0], b[1]); w.w = cvt_pk_bf16(b[2], b[3]); return w; }
__device__ __forceinline__ void unpack8(const u32x4 w, f32x4& a, f32x4& b) {
    a[0] = __uint_as_float(w.x << 16); a[1] = __uint_as_float(w.x & 0xffff0000u); a[2] = __uint_as_float(w.y << 16); a[3] = __uint_as_float(w.y & 0xffff0000u);
    b[0] = __uint_as_float(w.z << 16); b[1] = __uint_as_float(w.z & 0xffff0000u); b[2] = __uint_as_float(w.w << 16); b[3] = __uint_as_float(w.w & 0xffff0000u); }
__device__ __forceinline__ float sigm(float v) { return __builtin_amdgcn_rcpf(1.f + __expf(-v)); }
__device__ __forceinline__ f32x4 sigm4(const f32x4 v) { f32x4 r; r[0] = sigm(v[0]); r[1] = sigm(v[1]); r[2] = sigm(v[2]); r[3] = sigm(v[3]); return r; }

struct EpiInprojF {
    static constexpr bool PERM = true, AFTER_DRAIN = false;
    bf16_t *QD, *CKV, *QI, *KI, *U, *QX; float* WI;
    __device__ __forceinline__ void operator()(const f32x4 (&acc)[2][2][4][2], const Unit& u, int wr, int wc, int fr, int fq) const {
        const int row0 = u.pm * BM + wr * 64 + fr;
#pragma unroll
        for (int bj = 0; bj < 2; ++bj) {
            const int c0 = u.pn * BM + bj * HALF + wc * 32 + 8 * fq;
            bf16_t* base = QD; int ld = 1024, cc = c0, kind = 0;
            if (c0 < 1024) { }
            else if (c0 < 1152) { base = CKV; ld = 128; cc = c0 - 1024; }
            else if (c0 < 1664) { base = QI; ld = 512; cc = c0 - 1152; }
            else if (c0 < 1728) { base = KI; ld = 64; cc = c0 - 1664; }
            else if (c0 < 1792) { kind = 1; }
            else if (c0 < 2304) { kind = 2; cc = c0 - 1792; }
            else { base = QX; ld = 512; cc = c0 - 2304; }
#pragma unroll
            for (int ai = 0; ai < 2; ++ai)
#pragma unroll
                for (int m = 0; m < 4; ++m) {
                    const int t = row0 + ai * HALF + m * 16;
                    if (kind == 0) *(u32x4*)(base + (size_t)t * ld + cc) = pack8(acc[ai][bj][m][0], acc[ai][bj][m][1]);
                    else if (kind == 1) { if (c0 == 1728) { *(f32x4*)(WI + (size_t)t * 8) = acc[ai][bj][m][0]; *(f32x4*)(WI + (size_t)t * 8 + 4) = acc[ai][bj][m][1]; } }
                    else { const int g = cc >> 4, ci = cc & 15, b = t >> 11, tt = t & 2047, R = b * 64 + (tt >> 5), s = tt & 31;
                        *(u32x4*)(U + ((size_t)(g * 512 + R)) * 640 + s * 16 + ci) = pack8(acc[ai][bj][m][0], acc[ai][bj][m][1]); }
                }
        }
    }
};
struct EpiBf16S {
    static constexpr bool PERM = true, AFTER_DRAIN = false;
    bf16_t* O0; bf16_t* O1; int split, ld;
    __device__ __forceinline__ void operator()(const f32x4 (&acc)[2][2][4][2], const Unit& u, int wr, int wc, int fr, int fq) const {
        const int row0 = u.pm * BM + wr * 64 + fr;
#pragma unroll
        for (int bj = 0; bj < 2; ++bj) {
            const int c0 = u.pn * BM + bj * HALF + wc * 32 + 8 * fq;
            bf16_t* base = c0 < split ? O0 : O1; const int cc = c0 < split ? c0 : c0 - split;
#pragma unroll
            for (int ai = 0; ai < 2; ++ai)
#pragma unroll
                for (int m = 0; m < 4; ++m) *(u32x4*)(base + (size_t)(row0 + ai * HALF + m * 16) * ld + cc) = pack8(acc[ai][bj][m][0], acc[ai][bj][m][1]);
        }
    }
};
struct EpiGluF {
    static constexpr bool PERM = true, AFTER_DRAIN = false;
    const bf16_t* Y; bf16_t* O;
    __device__ __forceinline__ void operator()(const f32x4 (&acc)[2][2][4][2], const Unit& u, int wr, int wc, int fr, int fq) const {
        const int row0 = u.pm * BM + wr * 64 + fr;
#pragma unroll
        for (int bj = 0; bj < 2; ++bj) {
            const int c0 = u.pn * BM + bj * HALF + wc * 32 + 8 * fq;
#pragma unroll
            for (int ai = 0; ai < 2; ++ai)
#pragma unroll
                for (int m = 0; m < 4; ++m) { const size_t off = (size_t)(row0 + ai * HALF + m * 16) * 512 + c0;
                    f32x4 y0, y1; unpack8(*(const u32x4*)(Y + off), y0, y1);
                    *(u32x4*)(O + off) = pack8(y0 * sigm4(acc[ai][bj][m][0]), y1 * sigm4(acc[ai][bj][m][1])); }
        }
    }
};
struct EpiSigmoidF {
    static constexpr bool PERM = true, AFTER_DRAIN = false;
    bf16_t* G;
    __device__ __forceinline__ void operator()(const f32x4 (&acc)[2][2][4][2], const Unit& u, int wr, int wc, int fr, int fq) const {
        const int row0 = u.pm * BM + wr * 64 + fr;
#pragma unroll
        for (int bj = 0; bj < 2; ++bj) {
            const int c0 = u.pn * BM + bj * HALF + wc * 32 + 8 * fq;
#pragma unroll
            for (int ai = 0; ai < 2; ++ai)
#pragma unroll
                for (int m = 0; m < 4; ++m) *(u32x4*)(G + (size_t)(row0 + ai * HALF + m * 16) * 1024 + c0) = pack8(sigm4(acc[ai][bj][m][0]), sigm4(acc[ai][bj][m][1]));
        }
    }
};
struct EpiMergeF {
    static constexpr bool PERM = true, AFTER_DRAIN = false;
    const bf16_t* G; bf16_t* MG; int first;
    __device__ __forceinline__ void operator()(const f32x4 (&acc)[2][2][4][2], const Unit& u, int wr, int wc, int fr, int fq) const {
        const int row0 = u.pm * BM + wr * 64 + fr;
#pragma unroll
        for (int bj = 0; bj < 2; ++bj) {
            const int c0 = u.pn * BM + bj * HALF + wc * 32 + 8 * fq;
#pragma unroll
            for (int ai = 0; ai < 2; ++ai)
#pragma unroll
                for (int m = 0; m < 4; ++m) { const size_t off = (size_t)(row0 + ai * HALF + m * 16) * 1024 + c0;
                    f32x4 g0, g1, p0 = {0.f, 0.f, 0.f, 0.f}, p1 = {0.f, 0.f, 0.f, 0.f}; unpack8(*(const u32x4*)(G + off), g0, g1);
                    if (!first) unpack8(*(const u32x4*)(MG + off), p0, p1);
                    *(u32x4*)(MG + off) = pack8(p0 + g0 * acc[ai][bj][m][0], p1 + g1 * acc[ai][bj][m][1]); }
        }
    }
};
struct EpiOutF {
    static constexpr bool PERM = false, AFTER_DRAIN = false;
    const float* x; float* out; bf16_t* XN; float* RS;
    __device__ __forceinline__ void operator()(const f32x4 (&acc)[2][2][4][2], const Unit& u, int wr, int wc, int fr, int fq) const {
        const int row0 = u.pm * BM + wr * 64 + fr, col0 = u.pn * BM + wc * 32 + 4 * fq;
#pragma unroll
        for (int ai = 0; ai < 2; ++ai)
#pragma unroll
            for (int m = 0; m < 4; ++m) { const int t = row0 + ai * HALF + m * 16; const size_t off = (size_t)t * 1024 + col0; float ss = 0.f;
#pragma unroll
                for (int bj = 0; bj < 2; ++bj)
#pragma unroll
                    for (int n = 0; n < 2; ++n) { const size_t o2 = off + bj * HALF + n * 16; const f32x4 r = *(const f32x4*)(x + o2) + acc[ai][bj][m][n];
                        *(f32x4*)(out + o2) = r; u32x2 w; w.x = cvt_pk_bf16(r[0], r[1]); w.y = cvt_pk_bf16(r[2], r[3]); *(u32x2*)(XN + o2) = w;
                        ss += (r[0] * r[0] + r[1] * r[1]) + (r[2] * r[2] + r[3] * r[3]); }
                ss += __shfl_xor(ss, 16); ss += __shfl_xor(ss, 32);
                if (fq == 0) RS[(size_t)t * 16 + u.pn * 4 + wc] = ss; }
    }
};
struct EpiGateUpF {
    static constexpr bool PERM = true, AFTER_DRAIN = false;
    const float* RS; bf16_t* ACT;
    __device__ __forceinline__ void operator()(const f32x4 (&acc)[2][2][4][2], const Unit& u, int wr, int wc, int fr, int fq) const {
        const int row0 = u.pm * BM + wr * 64 + fr, f0 = u.pn * HALF + wc * 32 + 8 * fq;
#pragma unroll
        for (int ai = 0; ai < 2; ++ai)
#pragma unroll
            for (int m = 0; m < 4; ++m) { const int t = row0 + ai * HALF + m * 16;
                const f32x4* rp = (const f32x4*)(RS + (size_t)t * 16); const f32x4 a = rp[0], b = rp[1], c = rp[2], d = rp[3];
                const float tot = ((a[0] + a[1]) + (a[2] + a[3])) + ((b[0] + b[1]) + (b[2] + b[3])) + ((c[0] + c[1]) + (c[2] + c[3])) + ((d[0] + d[1]) + (d[2] + d[3]));
                const float rs = __builtin_amdgcn_rsqf(tot * (1.f / 1024.f) + 1e-6f);
                f32x4 o[2];
#pragma unroll
                for (int n = 0; n < 2; ++n) { const f32x4 g = acc[ai][0][m][n] * rs, up = acc[ai][1][m][n] * rs; o[n] = g * sigm4(g) * up; }
                *(u32x4*)(ACT + (size_t)t * 2816 + f0) = pack8(o[0], o[1]); }
    }
};
struct EpiDownF {
    static constexpr bool PERM = false, AFTER_DRAIN = false;
    float* out;
    __device__ __forceinline__ void operator()(const f32x4 (&acc)[2][2][4][2], const Unit& u, int wr, int wc, int fr, int fq) const {
        const int row0 = u.pm * BM + wr * 64 + fr, col0 = u.pn * BM + wc * 32 + 4 * fq;
#pragma unroll
        for (int ai = 0; ai < 2; ++ai)
#pragma unroll
            for (int m = 0; m < 4; ++m) { float* rowp = out + (size_t)(row0 + ai * HALF + m * 16) * 1024 + col0;
#pragma unroll
                for (int bj = 0; bj < 2; ++bj)
#pragma unroll
                    for (int n = 0; n < 2; ++n) { f32x4* p = (f32x4*)(rowp + bj * HALF + n * 16); *p = *p + acc[ai][bj][m][n]; } }
    }
};
struct EpiSlocF {
    static constexpr bool PERM = false, AFTER_DRAIN = false;
    float* SLOC;
    __device__ __forceinline__ void operator()(const f32x4 (&acc)[2][2][4][2], const Unit& u, int wr, int wc, int fr, int fq) const {
        const int row0 = u.pm * BM + wr * 64 + fr, col0 = wc * 32 + 4 * fq;
#pragma unroll
        for (int ai = 0; ai < 2; ++ai)
#pragma unroll
            for (int m = 0; m < 4; ++m)
#pragma unroll
                for (int n = 0; n < 2; ++n) *(f32x4*)(SLOC + (size_t)(row0 + ai * HALF + m * 16) * 128 + col0 + n * 16) = acc[ai][0][m][n];
    }
};
__device__ __forceinline__ float gelu_t(float x) { const float w = 1.5957691216057308f * (x + 0.044715f * x * x * x); return x * __builtin_amdgcn_rcpf(1.f + __expf(-w)); }
struct EpiS5YF {
    static constexpr bool PERM = true, AFTER_DRAIN = false;
    const bf16_t* U; const float* dskip; bf16_t* Y;
    __device__ __forceinline__ void operator()(const f32x4 (&acc)[2][2][4][2], const Unit& u, int wr, int wc, int fr, int fq) const {
        const int row0 = u.pm * BM + wr * 64 + fr;
#pragma unroll
        for (int bj = 0; bj < 2; ++bj) {
            const int cl = (u.pn & 1) * BM + bj * HALF + wc * 32 + 8 * fq, s = cl >> 4, co0 = cl & 15;
#pragma unroll
            for (int ai = 0; ai < 2; ++ai)
#pragma unroll
                for (int m = 0; m < 4; ++m) { const int row = row0 + ai * HALF + m * 16, g = row >> 9, R = row & 511, b = R >> 6, ch = R & 63, t = b * 2048 + ch * 32 + s;
                    f32x4 u0, u1; unpack8(*(const u32x4*)(U + (size_t)row * 640 + s * 16 + co0), u0, u1);
                    const f32x4 d0 = *(const f32x4*)(dskip + g * 16 + co0), d1 = *(const f32x4*)(dskip + g * 16 + co0 + 4);
                    f32x4 y0 = acc[ai][bj][m][0] + d0 * u0, y1 = acc[ai][bj][m][1] + d1 * u1;
#pragma unroll
                    for (int e = 0; e < 4; ++e) { y0[e] = gelu_t(y0[e]); y1[e] = gelu_t(y1[e]); }
                    *(u32x4*)(Y + (size_t)t * 512 + g * 16 + co0) = pack8(y0, y1); }
        }
    }
};
struct SubsetOrder { StaticOrder so; bool active;
    __device__ void init(int M, int N, int Gsub, int csub) { so.init(M, N, Gsub, csub < 0 ? 0 : csub); active = csub >= 0 && csub < Gsub; }
    __device__ bool next(int i, Unit& u) const { return active && so.next(i, u); }
    __device__ __forceinline__ void a_ready(const Unit&) const {}
    __device__ __forceinline__ void done(const Unit&) const {} };
struct S5Order1 { int c;
    __device__ bool next(int i, Unit& u) const { if (i > 0 || c < 0 || c >= 64) return false; u.pm = c; u.pn = c >> 1; return true; }
    __device__ __forceinline__ void a_ready(const Unit&) const {}
    __device__ __forceinline__ void done(const Unit&) const {} };
struct S5Order2 { int c;
    __device__ bool next(int i, Unit& u) const { if (i > 0 || c < 0 || c >= 128) return false; const int g = c >> 2; u.pm = g * 2 + ((c >> 1) & 1); u.pn = g * 2 + (c & 1); return true; }
    __device__ __forceinline__ void a_ready(const Unit&) const {}
    __device__ __forceinline__ void done(const Unit&) const {} };
}
#define GAS __attribute__((address_space(1)))
#define LAS __attribute__((address_space(3)))
typedef unsigned short bf16;
typedef unsigned v4u __attribute__((ext_vector_type(4)));
typedef float f32x4 __attribute__((ext_vector_type(4)));
typedef short bf16x8 __attribute__((ext_vector_type(8)));
typedef GAS unsigned gu32;
typedef GAS unsigned long long gu64;
#define RLX_AGENT __ATOMIC_RELAXED, __HIP_MEMORY_SCOPE_AGENT
#define LDS_WAIT() asm volatile("s_waitcnt lgkmcnt(0)" ::: "memory")
#define VM_WAIT() asm volatile("s_waitcnt vmcnt(0)" ::: "memory")
__device__ __forceinline__ unsigned long long rt() { return __builtin_amdgcn_s_memrealtime(); }
__device__ __forceinline__ unsigned f2bf(float f) { unsigned u = __builtin_bit_cast(unsigned, f); return (u + 0x7fffu + ((u >> 16) & 1u)) >> 16; }
__device__ __forceinline__ unsigned pk2(float lo, float hi) { return f2bf(lo) | (f2bf(hi) << 16); }

#define XB_TMO      128
#define XB_XCNT(j)  (256  + 64 * (j))
#define XB_XSUB(j)  (1280 + 64 * (j))
#define XB_XGEN(j)  (2304 + 64 * (j))
#define XB_TOP      3328
#define XB_TOPGEN   3392
#define XCD_BAR_WORDS 3456
#define XB_SPIN_CAP (1u << 18)

__device__ __forceinline__ unsigned xb_ld(unsigned* p)              { return __hip_atomic_load(p, __ATOMIC_RELAXED, __HIP_MEMORY_SCOPE_AGENT); }
__device__ __forceinline__ unsigned xb_add(unsigned* p, unsigned v) { return __hip_atomic_fetch_add(p, v, __ATOMIC_RELAXED, __HIP_MEMORY_SCOPE_AGENT); }
__device__ __forceinline__ unsigned xb_xcc_id() { return (unsigned)__builtin_amdgcn_s_getreg((3 << 11) | 20) & 0xFu; }
#define XB_SPIN(cond, bar) do { unsigned _sp = 0; while (cond) { __builtin_amdgcn_s_sleep(1); \
    if ((++_sp & 255u) == 0u) { if (xb_ld(&(bar)[XB_TMO])) break; if (_sp > XB_SPIN_CAP) { atomicAdd(&(bar)[XB_TMO], 1u); break; } } } } while (0)

struct XcdBarrier {
    unsigned* bar; unsigned x;
    volatile LAS unsigned* st;
};

__device__ __forceinline__ XcdBarrier xcd_barrier_post(unsigned* bar, volatile LAS unsigned* st, bool leader) {
    XcdBarrier b; b.bar = bar; b.x = xb_xcc_id(); b.st = st;
    if (leader) (void)xb_add(&bar[XB_XCNT(b.x)], 1u);
    return b;
}
__device__ __forceinline__ void xcd_barrier_complete(unsigned* bar, unsigned x, unsigned& nloc, unsigned& nx) {
    const unsigned G = gridDim.x * gridDim.y * gridDim.z;
    unsigned sum, cnt, mine, sp = 0u;
    for (;;) {
        sum = 0u; cnt = 0u; mine = 0u;
#pragma unroll
        for (unsigned j = 0; j < 16; ++j) { const unsigned c = xb_ld(&bar[XB_XCNT(j)]); sum += c; cnt += (c > 0u) ? 1u : 0u; mine = (j == x) ? c : mine; }
        if (sum == G) break;
        __builtin_amdgcn_s_sleep(1);
        if ((++sp & 255u) == 0u) { if (xb_ld(&bar[XB_TMO])) break; if (sp > XB_SPIN_CAP) { atomicAdd(&bar[XB_TMO], 1u); break; } }
    }
    nloc = mine > 0u ? mine : 1u; nx = cnt > 0u ? cnt : 1u;
}

__device__ __forceinline__ void xcd_barrier(const XcdBarrier& b, bool leader) {
    asm volatile("s_waitcnt vmcnt(0)" ::: "memory");
    __syncthreads();
    if (leader) {
        unsigned* bar = b.bar;
        __builtin_amdgcn_s_waitcnt(0);
        unsigned nloc = b.st[0], nx = b.st[1];
        if (nloc == 0u) { xcd_barrier_complete(bar, b.x, nloc, nx); b.st[0] = nloc; b.st[1] = nx; }
        const unsigned old = xb_add(&bar[XB_XSUB(b.x)], 1u);
        const unsigned gen = old / nloc;
        if (old + 1u == (gen + 1u) * nloc) {
            __builtin_amdgcn_fence(__ATOMIC_RELEASE, "agent");
            asm volatile("s_waitcnt vmcnt(0)" ::: "memory");
            const unsigned og = xb_add(&bar[XB_TOP], 1u);
            const unsigned tg = og / nx;
            if (og + 1u == (tg + 1u) * nx) xb_add(&bar[XB_TOPGEN], 1u);
            else XB_SPIN(xb_ld(&bar[XB_TOPGEN]) == tg, bar);
            __builtin_amdgcn_fence(__ATOMIC_ACQUIRE, "agent");
            xb_add(&bar[XB_XGEN(b.x)], 1u);
            asm volatile("s_waitcnt vmcnt(0)" ::: "memory");
        } else {
            XB_SPIN(xb_ld(&bar[XB_XGEN(b.x)]) == gen, bar);
            __builtin_amdgcn_fence(__ATOMIC_ACQUIRE, "agent");
            asm volatile("s_waitcnt vmcnt(0)" ::: "memory");
        }
    }
    __syncthreads();
}
constexpr int NWAVES = 8, NTHR = 512;
constexpr int RING_OFF = 0, RING_BYTES = 131072;
constexpr int LDSCTL_OFF = RING_BYTES, MISC_OFF = LDSCTL_OFF + 320;
constexpr int LDS_BYTES = 147456;
constexpr size_t CTL_ZERO_BYTES = 1 * MiB;
constexpr int CW_TMO = 0, CW_BAR = 4096;
constexpr int NPH = 9;
constexpr int FL_NO_DSA = 1, FL_NO_CROSS = 2, FL_NO_S5 = 4;
constexpr size_t WS_LAM32 = WS_BIASL + 8192;

struct Args { const float* in[29]; float* out; unsigned char* ws; int ph_lo, ph_hi, flags, li; };

__device__ __forceinline__ float wave_sum(float v) {
#pragma unroll
    for (int o = 1; o < 64; o <<= 1) v += __shfl_xor(v, o);
    return v;
}
__device__ __forceinline__ float p0_src(int mode, const float* W, const float* W2, const float* gain, int N, int k, int d) {
    if (mode == 0) return W[(size_t)k * N + d];
    if (mode == 1) { if (d >= 1736 && d < 1792) return 0.f; const int s = d >= 1792 ? d - 56 : d; return W[(size_t)k * N + s]; }
    const int tile = d >> 8, w = d & 255, f = tile * 128 + (w & 127); return ((w < 128) ? W : W2)[(size_t)k * N + f] * gain[k];
}
__device__ __forceinline__ void p0_transpose_item(int mode, const float* W, const float* W2, const float* gain, int K, int N, int ND, bf16* WT, LAS float* scr, int item, int lane) {
    const int nblk = ND / 32, kb = item / nblk, nb = item % nblk, k0 = 64 * kb, d0 = 32 * nb;
#pragma unroll 8
    for (int i = 0; i < 32; ++i) { const int kk = 2 * i + (lane >> 5); scr[kk * 33 + (lane & 31)] = p0_src(mode, W, W2, gain, N, k0 + kk, d0 + (lane & 31)); }
    LDS_WAIT(); asm volatile("" ::: "memory");
    const int c = lane & 7;
#pragma unroll
    for (int j = 0; j < 4; ++j) { const int n = (lane >> 3) + 8 * j; const LAS float* s = scr + (8 * c) * 33 + n;
        v4u o; o.x = pk2(s[0 * 33], s[1 * 33]); o.y = pk2(s[2 * 33], s[3 * 33]); o.z = pk2(s[4 * 33], s[5 * 33]); o.w = pk2(s[6 * 33], s[7 * 33]);
        *(GAS v4u*)(WT + (size_t)(d0 + n) * K + k0 + 8 * c) = o; }
    LDS_WAIT(); asm volatile("" ::: "memory");
}
__device__ __forceinline__ void rms_row_to_bf16(const float* xrow, const float* g, bf16* orow, int lane) {
    const GAS f32x4* xr = (const GAS f32x4*)xrow + lane; const GAS f32x4* gr = (const GAS f32x4*)g + lane;
    f32x4 v[4]; float s = 0.f;
#pragma unroll
    for (int j = 0; j < 4; ++j) { v[j] = xr[64 * j]; s += (v[j].x * v[j].x + v[j].y * v[j].y) + (v[j].z * v[j].z + v[j].w * v[j].w); }
    const float rstd = 1.f / sqrtf(wave_sum(s) * (1.f / 1024.f) + 1e-6f);
    GAS unsigned long long* o8 = (GAS unsigned long long*)orow + lane;
#pragma unroll
    for (int j = 0; j < 4; ++j) { const f32x4 gg = gr[64 * j];
        o8[64 * j] = (unsigned long long)pk2(v[j].x * rstd * gg.x, v[j].y * rstd * gg.y) | ((unsigned long long)pk2(v[j].z * rstd * gg.z, v[j].w * rstd * gg.w) << 32); }
}
__device__ __forceinline__ int t5_bucket(int n) {
    if (n < 16) return n;
    const int large = 16 + (int)((logf((float)n / 16.f) / 2.0794415416798357f) * 16.f);
    return large < 31 ? large : 31;
}
__device__ __forceinline__ void p0_s5_tables(int g, const Args& a, LAS unsigned char* lds, int tid) {
    typedef float f32x2v __attribute__((ext_vector_type(2)));
    LAS f32x2v* POW = (LAS f32x2v*)lds;
    LAS f32x2v* BB = POW + 33 * 64;
    LAS f32x2v* CC = BB + 64 * 16;
    LAS float* KT = (LAS float*)(CC + 16 * 64);
    const float *a_re = a.in[8], *a_im = a.in[9], *log_dt = a.in[10], *b_re = a.in[11], *b_im = a.in[12], *c_re = a.in[13], *c_im = a.in[14];
    bf16* TV = (bf16*)(a.ws + WS_S5TV) + (size_t)g * 512 * 640; bf16* Wt = (bf16*)(a.ws + WS_S5W) + (size_t)g * 256 * 512; float* LAM32 = (float*)(a.ws + WS_LAM32) + g * 128;
    const double dt = exp((double)log_dt[g]);
    for (int idx = tid; idx < 33 * 64; idx += NTHR) { const int j = idx >> 6, n = idx & 63; const double lr = a_re[g * 64 + n], li = a_im[g * 64 + n];
        const double mag = exp(lr * dt * j), ang = li * dt * j; POW[idx] = (f32x2v){(float)(mag * cos(ang)), (float)(mag * sin(ang))}; }
    for (int idx = tid; idx < 64 * 16; idx += NTHR) { const int n = idx >> 4, c = idx & 15; const double lr = a_re[g * 64 + n], li = a_im[g * 64 + n];
        const double mag = exp(lr * dt), lbr = mag * cos(li * dt), lbi = mag * sin(li * dt), nr = lbr - 1.0, ni = lbi, den = lr * lr + li * li;
        const double fr = (nr * lr + ni * li) / den, fi = (ni * lr - nr * li) / den, br = b_re[(g * 64 + n) * 16 + c], bi = b_im[(g * 64 + n) * 16 + c];
        BB[idx] = (f32x2v){(float)(fr * br - fi * bi), (float)(fr * bi + fi * br)};
        const int c2 = idx >> 6, n2 = idx & 63; CC[idx] = (f32x2v){c_re[(g * 16 + c2) * 64 + n2], c_im[(g * 16 + c2) * 64 + n2]}; }
    __syncthreads();
    if (tid < 64) { const f32x2v p = POW[32 * 64 + tid]; LAM32[tid * 2] = p.x; LAM32[tid * 2 + 1] = p.y; }
    for (int idx = tid; idx < 32 * 256; idx += NTHR) { const int j = idx >> 8, co = (idx >> 4) & 15, ci = idx & 15; float s = 0.f;
#pragma unroll 2
        for (int n = 0; n < 64; ++n) { const f32x2v c = CC[co * 64 + n], p = POW[j * 64 + n], b = BB[n * 16 + ci];
            const float cpr = c.x * p.x - c.y * p.y, cpi = c.x * p.y + c.y * p.x; s += cpr * b.x - cpi * b.y; }
        KT[idx] = s; }
    __syncthreads();
    for (int id = tid; id < 512 * 80; id += NTHR) { const int row = id / 80, c8 = id % 80, so = row >> 4, co = row & 15; float v[8];
        if (c8 < 64) { const int si = c8 >> 1, ci0 = (c8 & 1) * 8;
#pragma unroll
            for (int e = 0; e < 8; ++e) v[e] = so >= si ? KT[(so - si) * 256 + co * 16 + ci0 + e] : 0.f; }
        else {
#pragma unroll
            for (int e = 0; e < 8; ++e) { const int np = (c8 - 64) * 8 + e, n = np & 63; const f32x2v c = CC[co * 64 + n], p = POW[(so + 1) * 64 + n];
                v[e] = np < 64 ? (c.x * p.x - c.y * p.y) : -(c.x * p.y + c.y * p.x); } }
        v4u o; o.x = pk2(v[0], v[1]); o.y = pk2(v[2], v[3]); o.z = pk2(v[4], v[5]); o.w = pk2(v[6], v[7]);
        *(GAS v4u*)(TV + (size_t)row * 640 + c8 * 8) = o; }
    for (int id = tid; id < 128 * 64; id += NTHR) { const int np = id >> 6, c8 = id & 63, n = np & 63, s = c8 >> 1, ci0 = (c8 & 1) * 8; const f32x2v p = POW[(31 - s) * 64 + n]; float v[8];
#pragma unroll
        for (int e = 0; e < 8; ++e) { const f32x2v b = BB[n * 16 + ci0 + e]; v[e] = np < 64 ? (p.x * b.x - p.y * b.y) : (p.x * b.y + p.y * b.x); }
        v4u o; o.x = pk2(v[0], v[1]); o.y = pk2(v[2], v[3]); o.z = pk2(v[4], v[5]); o.w = pk2(v[6], v[7]);
        *(GAS v4u*)(Wt + (size_t)np * 512 + c8 * 8) = o; }
    __syncthreads();
}
__device__ __forceinline__ void p0_prologue(const Args& a, LAS unsigned char* lds, int tid, int lane, int wave, int vcu, int G) {
    unsigned char* ws = a.ws;
    LAS float* scr = (LAS float*)(lds + RING_OFF + wave * 16384);
    const int gw = vcu * NWAVES + wave, NGW = G * NWAVES;
    if (blockIdx.x < 32) p0_s5_tables(blockIdx.x, a, lds, tid);
    if (blockIdx.x == 32) { float* BL = (float*)(ws + WS_BIASL); const float* rb = a.in[2];
        for (int i = tid; i < 8 * 128 + 8; i += NTHR) { if (i < 1024) { const int h = i >> 7, d = i & 127; BL[i] = rb[t5_bucket(d) * 8 + h] * 1.4426950408889634f; } else BL[i] = rb[31 * 8 + (i - 1024)] * 1.4426950408889634f; } }
    { bf16* WUV = (bf16*)(ws + WS_WUV); const float* w = a.in[7];
        for (int i = blockIdx.x * NTHR + tid; i < 8 * 64 * 128; i += G * NTHR) { const int h = i >> 13, e = (i >> 7) & 63, d = i & 127; WUV[i] = (bf16)f2bf(w[(h * 128 + d) * 64 + e]); } }
    constexpr int I_IN = 16 * 184, I_MKV = 16 * 32, I_GLU = 8 * 16, I_BR = 8 * 32, I_OUT = 16 * 32, I_GU = 16 * 176, I_D = 44 * 32;
    constexpr int NITEMS = I_IN + I_MKV + I_GLU + 3 * I_BR + I_OUT + I_GU + I_D;
    for (int it = gw; it < NITEMS; it += NGW) {
        int r = it;
        if (r < I_IN) { p0_transpose_item(1, a.in[3], nullptr, nullptr, 1024, 5832, 5888, (bf16*)(ws + WS_WIN), scr, r, lane); continue; } r -= I_IN;
        if (r < I_MKV) { p0_transpose_item(0, a.in[18], nullptr, nullptr, 1024, 1024, 1024, (bf16*)(ws + WS_WMKV), scr, r, lane); continue; } r -= I_MKV;
        if (r < I_GLU) { p0_transpose_item(0, a.in[16], nullptr, nullptr, 512, 512, 512, (bf16*)(ws + WS_WGLU), scr, r, lane); continue; } r -= I_GLU;
        if (r < 3 * I_BR) { const int br = r / I_BR; p0_transpose_item(0, a.in[21 + br], nullptr, nullptr, 512, 1024, 1024, (bf16*)(ws + WS_WBR) + (size_t)br * 1024 * 512, scr, r % I_BR, lane); continue; } r -= 3 * I_BR;
        if (r < I_OUT) { p0_transpose_item(0, a.in[24], nullptr, nullptr, 1024, 1024, 1024, (bf16*)(ws + WS_WOUT), scr, r, lane); continue; } r -= I_OUT;
        if (r < I_GU) { p0_transpose_item(2, a.in[26], a.in[27], a.in[25], 1024, 2816, 5632, (bf16*)(ws + WS_WGU), scr, r, lane); continue; } r -= I_GU;
        p0_transpose_item(0, a.in[28], nullptr, nullptr, 2816, 1024, 1024, (bf16*)(ws + WS_WD), scr, r, lane);
    }
    for (int m = gw; m < T_TOK; m += NGW) rms_row_to_bf16(a.in[0] + (size_t)m * 1024, a.in[4], (bf16*)(ws + WS_H) + (size_t)m * 1024, lane);
    for (int m = gw; m < 2048; m += NGW) rms_row_to_bf16(a.in[1] + (size_t)m * 1024, a.in[17], (bf16*)(ws + WS_MEMN) + (size_t)m * 1024, lane);
}
__device__ __forceinline__ void norm128_pass(bf16* X, int rows, int ld, int ngroups, const float* g, int gtid, int nthr) {
    const int l = gtid & 15, total = rows * ngroups;
    for (int gid = gtid >> 4; gid < total; gid += nthr >> 4) {
        const int r = gid / ngroups, gi = gid % ngroups;
        bf16* p = X + (size_t)r * ld + gi * 128 + l * 8;
        const v4u v = *(const GAS v4u*)p; float f[8];
        f[0] = __uint_as_float(v.x << 16); f[1] = __uint_as_float(v.x & 0xffff0000u); f[2] = __uint_as_float(v.y << 16); f[3] = __uint_as_float(v.y & 0xffff0000u);
        f[4] = __uint_as_float(v.z << 16); f[5] = __uint_as_float(v.z & 0xffff0000u); f[6] = __uint_as_float(v.w << 16); f[7] = __uint_as_float(v.w & 0xffff0000u);
        float s = 0.f;
#pragma unroll
        for (int q = 0; q < 8; ++q) s += f[q] * f[q];
        s += __shfl_xor(s, 8); s += __shfl_xor(s, 4); s += __shfl_xor(s, 2); s += __shfl_xor(s, 1);
        const float rs = 1.f / sqrtf(s * (1.f / 128.f) + 1e-6f);
        const f32x4 g0 = *(const GAS f32x4*)(g + l * 8), g1 = *(const GAS f32x4*)(g + l * 8 + 4);
        v4u o; o.x = pk2(f[0] * rs * g0.x, f[1] * rs * g0.y); o.y = pk2(f[2] * rs * g0.z, f[3] * rs * g0.w); o.z = pk2(f[4] * rs * g1.x, f[5] * rs * g1.y); o.w = pk2(f[6] * rs * g1.z, f[7] * rs * g1.w);
        *(GAS v4u*)p = o;
    }
}
__device__ __forceinline__ void s5_scan(int g, int half, const Args& a, int tid) {
    if (tid < 256) {
        const int bl = tid >> 6, n = tid & 63, b = half * 4 + bl;
        const float* LAM32 = (const float*)(a.ws + WS_LAM32) + g * 128; const float lr = LAM32[n * 2], li = LAM32[n * 2 + 1];
        const float* SL = (const float*)(a.ws + WS_SLOC) + ((size_t)(g * 512 + b * 64)) * 128; bf16* Ur = (bf16*)(a.ws + WS_U) + ((size_t)(g * 512 + b * 64)) * 640 + 512;
        float xr = 0.f, xi = 0.f;
        for (int ch = 0; ch < 64; ++ch) {
            Ur[(size_t)ch * 640 + n] = (bf16)f2bf(xr); Ur[(size_t)ch * 640 + 64 + n] = (bf16)f2bf(xi);
            const float sr = SL[(size_t)ch * 128 + n], si = SL[(size_t)ch * 128 + 64 + n];
            const float nr = lr * xr - li * xi + sr, ni = lr * xi + li * xr + si; xr = nr; xi = ni;
        }
    }
    VM_WAIT(); __syncthreads();
}
namespace nv {
typedef unsigned short bf16;
__device__ __forceinline__ unsigned f2bf(float f) { unsigned u = __float_as_uint(f); return (u + 0x7fffu + ((u >> 16) & 1u)) >> 16; }
__device__ __forceinline__ float bf2f(unsigned short b) { return __uint_as_float((unsigned)b << 16); }

__global__ void k_transpose(const float* __restrict__ W, const float* __restrict__ W2, const float* __restrict__ gain,
                            bf16* __restrict__ WT, int K, int N, int ND, int mode) {
    const size_t total = (size_t)ND * K;
    for (size_t i = (size_t)blockIdx.x * blockDim.x + threadIdx.x; i < total; i += (size_t)gridDim.x * blockDim.x) {
        const int d = (int)(i / K), k = (int)(i % K);
        float v;
        if (mode == 0) v = W[(size_t)k * N + d];
        else if (mode == 1) { if (d >= 1736 && d < 1792) v = 0.f; else { const int s = d >= 1792 ? d - 56 : d; v = W[(size_t)k * N + s]; } }
        else { const int tile = d >> 8, w = d & 255, f = tile * 128 + (w & 127); v = ((w < 128) ? W : W2)[(size_t)k * N + f] * gain[k]; }
        WT[i] = (bf16)f2bf(v);
    }
}
__global__ void k_wuv(const float* __restrict__ W, bf16* __restrict__ WT) {
    const int i = blockIdx.x * blockDim.x + threadIdx.x; if (i >= 8 * 64 * 128) return;
    const int h = i / (64 * 128), e = (i / 128) % 64, d = i % 128;
    WT[i] = (bf16)f2bf(W[(h * 128 + d) * 64 + e]);
}
__global__ void k_rmsnorm1024(const float* __restrict__ x, const float* __restrict__ g, bf16* __restrict__ out, int rows) {
    __shared__ float red[4];
    const int r = blockIdx.x; if (r >= rows) return;
    const float4 v = ((const float4*)(x + (size_t)r * 1024))[threadIdx.x];
    float s = v.x * v.x + v.y * v.y + v.z * v.z + v.w * v.w;
    for (int o = 32; o; o >>= 1) s += __shfl_xor(s, o);
    if ((threadIdx.x & 63) == 0) red[threadIdx.x >> 6] = s;
    __syncthreads();
    const float tot = red[0] + red[1] + red[2] + red[3];
    const float rs = rsqrtf(tot * (1.f / 1024.f) + 1e-6f);
    const float4 gg = ((const float4*)g)[threadIdx.x];
    bf16* o = out + (size_t)r * 1024 + threadIdx.x * 4;
    o[0] = (bf16)f2bf(v.x * rs * gg.x); o[1] = (bf16)f2bf(v.y * rs * gg.y); o[2] = (bf16)f2bf(v.z * rs * gg.z); o[3] = (bf16)f2bf(v.w * rs * gg.w);
}
__device__ __forceinline__ int t5_bucket(int n) {
    if (n < 16) return n;
    const float nf = (float)n;
    int large = 16 + (int)((logf(nf / 16.f) / 2.0794415416798357f) * 16.f);
    return large < 31 ? large : 31;
}
__global__ void k_biaslut(const float* __restrict__ rel_bias, float* __restrict__ BL) {
    const int i = blockIdx.x * blockDim.x + threadIdx.x;
    if (i < 8 * 128) { const int h = i / 128, d = i % 128; BL[i] = rel_bias[t5_bucket(d) * 8 + h] * 1.4426950408889634f; }
    else if (i < 8 * 128 + 8) { const int h = i - 8 * 128; BL[i] = rel_bias[31 * 8 + h] * 1.4426950408889634f; }
}

template <class Epi>
__global__ void __launch_bounds__(256) k_gemm(const bf16* __restrict__ A, const bf16* __restrict__ Bt, int M, int N, int K, Epi epi) {
    const int tx = threadIdx.x & 15, ty = threadIdx.x >> 4;
    const int n0 = (blockIdx.x * 16 + tx) * 4, m0 = (blockIdx.y * 16 + ty) * 4;
    if (n0 >= N || m0 >= M) return;
    float acc[4][4];
#pragma unroll
    for (int i = 0; i < 4; ++i)
#pragma unroll
        for (int j = 0; j < 4; ++j) acc[i][j] = 0.f;
    for (int k = 0; k < K; k += 8) {
        uint4 a[4], b[4];
#pragma unroll
        for (int i = 0; i < 4; ++i) { a[i] = *(const uint4*)(A + (size_t)(m0 + i) * K + k); b[i] = *(const uint4*)(Bt + (size_t)(n0 + i) * K + k); }
#pragma unroll
        for (int i = 0; i < 4; ++i) {
            const unsigned aw[4] = {a[i].x, a[i].y, a[i].z, a[i].w};
#pragma unroll
            for (int j = 0; j < 4; ++j) {
                const unsigned bw[4] = {b[j].x, b[j].y, b[j].z, b[j].w};
#pragma unroll
                for (int q = 0; q < 4; ++q) {
                    acc[i][j] += __uint_as_float(aw[q] << 16) * __uint_as_float(bw[q] << 16);
                    acc[i][j] += __uint_as_float(aw[q] & 0xffff0000u) * __uint_as_float(bw[q] & 0xffff0000u);
                }
            }
        }
    }
#pragma unroll
    for (int i = 0; i < 4; ++i)
#pragma unroll
        for (int j = 0; j < 4; ++j) epi(m0 + i, n0 + j, acc[i][j]);
}

struct EpiInproj {
    bf16 *QD, *CKV, *QI, *KI, *U, *QX; float* WI;
    __device__ void operator()(int t, int c, float v) const {
        if (c < 1024) QD[(size_t)t * 1024 + c] = (bf16)f2bf(v);
        else if (c < 1152) CKV[(size_t)t * 128 + (c - 1024)] = (bf16)f2bf(v);
        else if (c < 1664) QI[(size_t)t * 512 + (c - 1152)] = (bf16)f2bf(v);
        else if (c < 1728) KI[(size_t)t * 64 + (c - 1664)] = (bf16)f2bf(v);
        else if (c < 1792) { if (c < 1736) WI[(size_t)t * 8 + (c - 1728)] = v; }
        else if (c < 2304) { const int cu = c - 1792, g = cu >> 4, ci = cu & 15, b = t >> 11, tt = t & 2047, R = b * 64 + (tt >> 5), s = tt & 31;
            U[((size_t)(g * 512 + R)) * 640 + s * 16 + ci] = (bf16)f2bf(v); }
        else QX[(size_t)t * 512 + (c - 2304)] = (bf16)f2bf(v);
    }
};
struct EpiBf16Split { bf16* O0; bf16* O1; int split; int ld;
    __device__ void operator()(int m, int c, float v) const { if (c < split) O0[(size_t)m * ld + c] = (bf16)f2bf(v); else O1[(size_t)m * ld + (c - split)] = (bf16)f2bf(v); } };
struct EpiGlu { const bf16* Y; bf16* O;
    __device__ void operator()(int m, int c, float v) const { const float y = bf2f(Y[(size_t)m * 512 + c]); O[(size_t)m * 512 + c] = (bf16)f2bf(y / (1.f + __expf(-v))); } };
struct EpiSigmoid { bf16* G; __device__ void operator()(int m, int c, float v) const { G[(size_t)m * 1024 + c] = (bf16)f2bf(1.f / (1.f + __expf(-v))); } };
struct EpiMerge { const bf16* G; bf16* MG; int first; int pad;
    __device__ void operator()(int m, int c, float v) const { const size_t i = (size_t)m * 1024 + c; float p = first ? 0.f : bf2f(MG[i]); MG[i] = (bf16)f2bf(p + bf2f(G[i]) * v); } };
struct EpiOut { const float* x; float* x1; bf16* XN;
    __device__ void operator()(int m, int c, float v) const { const size_t i = (size_t)m * 1024 + c; const float r = x[i] + v; x1[i] = r; XN[i] = (bf16)f2bf(r); } };
struct EpiDown { float* out;
    __device__ void operator()(int m, int c, float v) const { const size_t i = (size_t)m * 1024 + c; out[i] = out[i] + v; } };
struct EpiF32 { float* C; int ld; __device__ void operator()(int m, int c, float v) const { C[(size_t)m * ld + c] = v; } };

__global__ void k_rowss(const float* __restrict__ x1, float* __restrict__ RS) {
    const int t = blockIdx.x, q = threadIdx.x >> 6, l = threadIdx.x & 63;
    const float4 v = ((const float4*)(x1 + (size_t)t * 1024 + q * 256))[l];
    float s = v.x * v.x + v.y * v.y + v.z * v.z + v.w * v.w;
    for (int o = 32; o; o >>= 1) s += __shfl_xor(s, o);
    if (l == 0) RS[t * 16 + q] = s;
    if (l >= 4 && l < 16 && q == 0) RS[t * 16 + l] = 0.f;
}
__global__ void __launch_bounds__(256) k_gemm_gu(const bf16* __restrict__ A, const bf16* __restrict__ Bt, const float* __restrict__ RS, bf16* __restrict__ ACT) {
    const int K = 1024;
    const int tx = threadIdx.x & 15, ty = threadIdx.x >> 4;
    const int f0 = (blockIdx.x * 16 + tx) * 4, m0 = (blockIdx.y * 16 + ty) * 4;
    float ag[4][4], au[4][4];
#pragma unroll
    for (int i = 0; i < 4; ++i)
#pragma unroll
        for (int j = 0; j < 4; ++j) { ag[i][j] = 0.f; au[i][j] = 0.f; }
    for (int k = 0; k < K; k += 8) {
        uint4 a[4], bg[4], bu[4];
#pragma unroll
        for (int i = 0; i < 4; ++i) { a[i] = *(const uint4*)(A + (size_t)(m0 + i) * K + k);
            const int f = f0 + i, rg = (f >> 7) * 256 + (f & 127);
            bg[i] = *(const uint4*)(Bt + (size_t)rg * K + k); bu[i] = *(const uint4*)(Bt + (size_t)(rg + 128) * K + k); }
#pragma unroll
        for (int i = 0; i < 4; ++i) {
            const unsigned aw[4] = {a[i].x, a[i].y, a[i].z, a[i].w};
#pragma unroll
            for (int j = 0; j < 4; ++j) {
                const unsigned gw[4] = {bg[j].x, bg[j].y, bg[j].z, bg[j].w};
                const unsigned uw[4] = {bu[j].x, bu[j].y, bu[j].z, bu[j].w};
#pragma unroll
                for (int q = 0; q < 4; ++q) {
                    const float alo = __uint_as_float(aw[q] << 16), ahi = __uint_as_float(aw[q] & 0xffff0000u);
                    ag[i][j] += alo * __uint_as_float(gw[q] << 16); ag[i][j] += ahi * __uint_as_float(gw[q] & 0xffff0000u);
                    au[i][j] += alo * __uint_as_float(uw[q] << 16); au[i][j] += ahi * __uint_as_float(uw[q] & 0xffff0000u);
                }
            }
        }
    }
#pragma unroll
    for (int i = 0; i < 4; ++i) { const int m = m0 + i;
        float tot = 0.f; for (int q = 0; q < 16; ++q) tot += RS[m * 16 + q];
        const float rs = rsqrtf(tot * (1.f / 1024.f) + 1e-6f);
#pragma unroll
        for (int j = 0; j < 4; ++j) { const float g = ag[i][j] * rs, u = au[i][j] * rs;
            ACT[(size_t)m * 2816 + f0 + j] = (bf16)f2bf(g / (1.f + __expf(-g)) * u); } }
}

__global__ void k_norm128(bf16* __restrict__ X, int rows, int ld, int ngroups, const float* __restrict__ g) {
    const int gid = (blockIdx.x * blockDim.x + threadIdx.x) >> 4, l = threadIdx.x & 15;
    const bool ok = gid < rows * ngroups;
    const int r = ok ? gid / ngroups : 0, gi = ok ? gid % ngroups : 0;
    bf16* p = X + (size_t)r * ld + gi * 128 + l * 8;
    uint4 v = *(const uint4*)p; const unsigned w[4] = {v.x, v.y, v.z, v.w};
    float f[8];
#pragma unroll
    for (int q = 0; q < 4; ++q) { f[2 * q] = __uint_as_float(w[q] << 16); f[2 * q + 1] = __uint_as_float(w[q] & 0xffff0000u); }
    float s = 0.f;
#pragma unroll
    for (int q = 0; q < 8; ++q) s += f[q] * f[q];
    for (int o = 8; o; o >>= 1) s += __shfl_xor(s, o);
    const float rs = rsqrtf(s * (1.f / 128.f) + 1e-6f);
    unsigned o4[4];
#pragma unroll
    for (int q = 0; q < 4; ++q) o4[q] = f2bf(f[2 * q] * rs * g[l * 8 + 2 * q]) | (f2bf(f[2 * q + 1] * rs * g[l * 8 + 2 * q + 1]) << 16);
    if (ok) *(uint4*)p = make_uint4(o4[0], o4[1], o4[2], o4[3]);
}

__global__ void __launch_bounds__(256) k_dsa(const bf16* __restrict__ QD, const bf16* __restrict__ CKV, const bf16* __restrict__ QI, const bf16* __restrict__ KI,
                                             const float* __restrict__ WI, const float* __restrict__ BL, const bf16* __restrict__ WUVT, bf16* __restrict__ ODSA) {
    __shared__ float sc[2048];
    __shared__ float qi[512];
    __shared__ float qd[1024];
    __shared__ float wh[8];
    __shared__ int sel[256];
    __shared__ float pr[256];
    __shared__ float ov[128];
    __shared__ float red[8];
    __shared__ int nsel;
    const int row = blockIdx.x, b = row >> 11, t = row & 2047, tid = threadIdx.x;
    for (int i = tid; i < 512; i += 256) qi[i] = bf2f(QI[(size_t)row * 512 + i]);
    for (int i = tid; i < 1024; i += 256) qd[i] = bf2f(QD[(size_t)row * 1024 + i]);
    if (tid < 8) wh[tid] = WI[(size_t)row * 8 + tid];
    if (tid == 0) nsel = 0;
    __syncthreads();
    const int nk = t + 1;
    for (int s = tid; s < nk; s += 256) {
        const bf16* kp = KI + ((size_t)(b * 2048 + s)) * 64;
        float kf[64];
#pragma unroll
        for (int d = 0; d < 64; ++d) kf[d] = bf2f(kp[d]);
        float score = 0.f;
        for (int h = 0; h < 8; ++h) { float dsum = 0.f;
#pragma unroll
            for (int d = 0; d < 64; ++d) dsum += qi[h * 64 + d] * kf[d];
            score += fmaxf(dsum, 0.f) * wh[h]; }
        sc[s] = score;
    }
    __syncthreads();
    for (int s = tid; s < nk; s += 256) {
        bool take;
        if (nk <= 256) take = true;
        else { const float v = sc[s]; int cnt = 0;
            for (int s2 = 0; s2 < nk; ++s2) { const float w = sc[s2]; cnt += (w > v || (w == v && s2 < s)) ? 1 : 0; }
            take = cnt < 256; }
        if (take) { const int p = atomicAdd(&nsel, 1); if (p < 256) sel[p] = s; }
    }
    __syncthreads();
    const int ns = nsel < 256 ? nsel : 256;
    const float scale = 0.08838834764831845f * 1.4426950408889634f;
    for (int h = 0; h < 8; ++h) {
        float lg = -INFINITY;
        if (tid < ns) { const int s = sel[tid]; const bf16* cp = CKV + ((size_t)(b * 2048 + s)) * 128; float dsum = 0.f;
            for (int d = 0; d < 128; ++d) dsum += qd[h * 128 + d] * bf2f(cp[d]);
            const int dist = t - s; const float bias = dist < 128 ? BL[h * 128 + dist] : BL[8 * 128 + h];
            lg = dsum * scale + bias; }
        float m = lg; for (int o = 32; o; o >>= 1) m = fmaxf(m, __shfl_xor(m, o));
        if ((tid & 63) == 0) red[tid >> 6] = m;
        __syncthreads();
        m = fmaxf(fmaxf(red[0], red[1]), fmaxf(red[2], red[3]));
        const float p = (tid < ns) ? exp2f(lg - m) : 0.f;
        float sum = p; for (int o = 32; o; o >>= 1) sum += __shfl_xor(sum, o);
        if ((tid & 63) == 0) red[4 + (tid >> 6)] = sum;
        pr[tid] = p;
        __syncthreads();
        sum = red[4] + red[5] + red[6] + red[7];
        if (tid < 128) { float o = 0.f; for (int k = 0; k < ns; ++k) o += pr[k] * bf2f(CKV[((size_t)(b * 2048 + sel[k])) * 128 + tid]); ov[tid] = o / sum; }
        __syncthreads();
        if (tid < 64) { float o = 0.f; const bf16* wp = WUVT + ((size_t)(h * 64 + tid)) * 128; for (int d = 0; d < 128; ++d) o += ov[d] * bf2f(wp[d]);
            ODSA[(size_t)row * 512 + h * 64 + tid] = (bf16)f2bf(o); }
        __syncthreads();
    }
}

__global__ void __launch_bounds__(256) k_cross(const bf16* __restrict__ QX, const bf16* __restrict__ KX, const bf16* __restrict__ VX, bf16* __restrict__ OX) {
    __shared__ float q[512]; __shared__ float pr[256]; __shared__ float red[8];
    const int row = blockIdx.x, b = row >> 11, tid = threadIdx.x;
    for (int i = tid; i < 512; i += 256) q[i] = bf2f(QX[(size_t)row * 512 + i]);
    __syncthreads();
    const float scale = 0.08838834764831845f * 1.4426950408889634f;
    for (int h = 0; h < 4; ++h) {
        const bf16* kp = KX + ((size_t)(b * 256 + tid)) * 512 + h * 128; float dsum = 0.f;
        for (int d = 0; d < 128; ++d) dsum += q[h * 128 + d] * bf2f(kp[d]);
        const float lg = dsum * scale;
        float m = lg; for (int o = 32; o; o >>= 1) m = fmaxf(m, __shfl_xor(m, o));
        if ((tid & 63) == 0) red[tid >> 6] = m;
        __syncthreads();
        m = fmaxf(fmaxf(red[0], red[1]), fmaxf(red[2], red[3]));
        const float p = exp2f(lg - m);
        float sum = p; for (int o = 32; o; o >>= 1) sum += __shfl_xor(sum, o);
        if ((tid & 63) == 0) red[4 + (tid >> 6)] = sum;
        pr[tid] = p;
        __syncthreads();
        sum = red[4] + red[5] + red[6] + red[7];
        if (tid < 128) { float o = 0.f; for (int k = 0; k < 256; ++k) o += pr[k] * bf2f(VX[((size_t)(b * 256 + k)) * 512 + h * 128 + tid]);
            OX[(size_t)row * 512 + h * 128 + tid] = (bf16)f2bf(o / sum); }
        __syncthreads();
    }
}

__device__ __forceinline__ float gelu_tanh(float x) { const float u = 0.7978845608028654f * (x + 0.044715f * x * x * x); return 0.5f * x * (1.f + tanhf(u)); }
__global__ void __launch_bounds__(64) k_s5(const bf16* __restrict__ U, const float* __restrict__ a_re, const float* __restrict__ a_im, const float* __restrict__ log_dt,
                                           const float* __restrict__ b_re, const float* __restrict__ b_im, const float* __restrict__ c_re, const float* __restrict__ c_im,
                                           const float* __restrict__ d_skip, bf16* __restrict__ Y) {
    const int b = blockIdx.x >> 5, g = blockIdx.x & 31, n = threadIdx.x;
    const double dt = exp((double)log_dt[g]);
    const double lr = (double)a_re[g * 64 + n], li = (double)a_im[g * 64 + n];
    const double mag = exp(lr * dt), lbr = mag * cos(li * dt), lbi = mag * sin(li * dt);
    const double nr = lbr - 1.0, ni = lbi, den = lr * lr + li * li;
    const double fr = (nr * lr + ni * li) / den, fi = (ni * lr - nr * li) / den;
    float Bre[16], Bim[16], Cre[16], Cim[16];
#pragma unroll
    for (int c = 0; c < 16; ++c) { const double br = b_re[(g * 64 + n) * 16 + c], bi = b_im[(g * 64 + n) * 16 + c];
        Bre[c] = (float)(fr * br - fi * bi); Bim[c] = (float)(fr * bi + fi * br);
        Cre[c] = c_re[(g * 16 + c) * 64 + n]; Cim[c] = c_im[(g * 16 + c) * 64 + n]; }
    const float ar = (float)lbr, ai = (float)lbi;
    const float dsk = n < 16 ? d_skip[g * 16 + n] : 0.f;
    float xr = 0.f, xi = 0.f;
    for (int t = 0; t < 2048; ++t) {
        const int R = b * 64 + (t >> 5), s = t & 31;
        const bf16* up = U + ((size_t)(g * 512 + R)) * 640 + s * 16;
        float u[16]; float bur = 0.f, bui = 0.f;
#pragma unroll
        for (int c = 0; c < 16; ++c) { u[c] = bf2f(up[c]); bur += Bre[c] * u[c]; bui += Bim[c] * u[c]; }
        const float nxr = ar * xr - ai * xi + bur, nxi = ar * xi + ai * xr + bui; xr = nxr; xi = nxi;
        float yout = 0.f;
#pragma unroll
        for (int c = 0; c < 16; ++c) { float v = Cre[c] * xr - Cim[c] * xi;
            for (int o = 32; o; o >>= 1) v += __shfl_xor(v, o);
            if (n == c) yout = v + dsk * u[c]; }
        if (n < 16) Y[(size_t)(b * 2048 + t) * 512 + g * 16 + n] = (bf16)f2bf(gelu_tanh(yout));
    }
}
}
#define HAVE_ATTN 1
namespace att {
typedef float f32x16 __attribute__((ext_vector_type(16)));
typedef short s16x4 __attribute__((ext_vector_type(4)));
typedef short v4i16_t __attribute__((ext_vector_type(4)));
typedef float f32x2_t __attribute__((ext_vector_type(2))); typedef __bf16 bf16x2_t __attribute__((ext_vector_type(2)));
typedef unsigned u32x2 __attribute__((ext_vector_type(2)));
#define MFMA32(a, b, c) __builtin_amdgcn_mfma_f32_32x32x16_bf16((a), (b), (c), 0, 0, 0)
__device__ __forceinline__ unsigned cvtpk(float lo, float hi) { const f32x2_t v = {lo, hi}; const bf16x2_t b = __builtin_convertvector(v, bf16x2_t); return __builtin_bit_cast(unsigned, b); }
__device__ __forceinline__ int crow(int r, int hi) { return (r & 3) + 8 * (r >> 2) + 4 * hi; }
__device__ __forceinline__ unsigned off_b(unsigned row, unsigned ch) { return 256u * row + 16u * (ch ^ (((row & 3u) << 2) | ((row >> 2) & 3u))); }
__device__ __forceinline__ float xh_max(float v) { const auto rr = __builtin_amdgcn_permlane32_swap(__float_as_uint(v), __float_as_uint(v), false, false); return fmaxf(__uint_as_float(rr[0]), __uint_as_float(rr[1])); }
__device__ __forceinline__ float xh_sum(float v) { const auto rr = __builtin_amdgcn_permlane32_swap(__float_as_uint(v), __float_as_uint(v), false, false); return __uint_as_float(rr[0]) + __uint_as_float(rr[1]); }
__device__ __forceinline__ unsigned xh_sumu(unsigned v) { const auto rr = __builtin_amdgcn_permlane32_swap(v, v, false, false); return rr[0] + rr[1]; }
__device__ __forceinline__ unsigned xh_or(unsigned v) { const auto rr = __builtin_amdgcn_permlane32_swap(v, v, false, false); return rr[0] | rr[1]; }
constexpr float SCALE2 = 0.08838834764831845f * 1.4426950408889634f;

__device__ __forceinline__ bf16x8 pack_step(const f32x16& x, int s) {
    v4u p; p.x = cvtpk(x[8 * s], x[8 * s + 1]); p.y = cvtpk(x[8 * s + 2], x[8 * s + 3]); p.z = cvtpk(x[8 * s + 4], x[8 * s + 5]); p.w = cvtpk(x[8 * s + 6], x[8 * s + 7]);
    return __builtin_bit_cast(bf16x8, p);
}
__device__ __forceinline__ void qk_tile(f32x16& p0, f32x16& p1, LAS const unsigned char* kimg, const bf16x8 (&qf)[8], int lane) {
    const unsigned r32 = lane & 31, hi = lane >> 5;
    f32x16 z;
#pragma unroll
    for (int r = 0; r < 16; ++r) z[r] = 0.f;
    p0 = z; p1 = z;
#pragma unroll
    for (int s = 0; s < 8; ++s) {
        const unsigned o = off_b(r32, 2 * s + hi);
        const bf16x8 a0 = *(LAS const bf16x8*)(kimg + o), a1 = *(LAS const bf16x8*)(kimg + o + 32 * 256);
        p0 = MFMA32(a0, qf[s], p0); p1 = MFMA32(a1, qf[s], p1);
        if (s & 1) asm volatile("" ::: "memory");
    }
}
__device__ __forceinline__ s16x4 vtr(LAS const unsigned char* p) { return __builtin_bit_cast(s16x4, __builtin_amdgcn_ds_read_tr16_b64_v4i16((LAS v4i16_t*)p)); }
__device__ __forceinline__ void pv_tile(f32x16 (&o)[4], LAS const unsigned char* vimg, const bf16x8 (&pf)[4], int lane) {
    const unsigned hi = lane >> 5, blk = (lane >> 4) & 1, q = (lane & 15) >> 2, p = lane & 3;
#pragma unroll
    for (int c = 0; c < 4; ++c)
#pragma unroll
        for (int ks = 0; ks < 4; ++ks) {
            const unsigned ch = 4 * c + 2 * blk + (p >> 1), rlo = 16 * ks + 4 * hi + q;
            const s16x4 lo = vtr(vimg + off_b(rlo, ch) + 8 * (p & 1)), h4 = vtr(vimg + off_b(rlo + 8, ch) + 8 * (p & 1));
            const bf16x8 af = {lo[0], lo[1], lo[2], lo[3], h4[0], h4[1], h4[2], h4[3]};
            o[c] = MFMA32(af, pf[ks], o[c]);
            if (ks == 3) asm volatile("" ::: "memory");
        }
}
__device__ __forceinline__ void softmax_step(f32x16& p0, f32x16& p1, float& m, float& l, f32x16 (&o)[4], bf16x8 (&pf)[4]) {
    float mx = fmaxf(p0[0], p1[0]);
#pragma unroll
    for (int r = 1; r < 16; ++r) mx = fmaxf(mx, fmaxf(p0[r], p1[r]));
    mx = xh_max(mx);
    const float mnew = fmaxf(m, mx), muse = (mnew == -INFINITY) ? 0.f : mnew;
    const float alpha = __builtin_amdgcn_exp2f(m - muse);
    float s = 0.f;
#pragma unroll
    for (int r = 0; r < 16; ++r) { p0[r] = __builtin_amdgcn_exp2f(p0[r] - muse); p1[r] = __builtin_amdgcn_exp2f(p1[r] - muse); s += p0[r] + p1[r]; }
    l = l * alpha + s; m = mnew;
    if (__any(alpha != 1.f)) {
#pragma unroll
        for (int c = 0; c < 4; ++c)
#pragma unroll
            for (int r = 0; r < 16; ++r) o[c][r] *= alpha;
    }
    pf[0] = pack_step(p0, 0); pf[1] = pack_step(p0, 1); pf[2] = pack_step(p1, 0); pf[3] = pack_step(p1, 1);
}
__device__ __forceinline__ void tile_load(v4u (&rg)[2], const bf16* src, int pitch, int tid) {
#pragma unroll
    for (int i = 0; i < 2; ++i) { const int id = tid + 512 * i, row = id >> 4, ch = id & 15; rg[i] = *(const GAS v4u*)(src + (size_t)row * pitch + ch * 8); }
}
__device__ __forceinline__ void tile_store(const v4u (&rg)[2], LAS unsigned char* img, int tid) {
#pragma unroll
    for (int i = 0; i < 2; ++i) { const int id = tid + 512 * i, row = id >> 4, ch = id & 15; *(LAS v4u*)(img + off_b(row, ch)) = rg[i]; }
}

__device__ __forceinline__ void cross_item(const Args& a, LAS unsigned char* lds, int tid, int lane, int wave, int item) {
    const int r32 = lane & 31, hi = lane >> 5;
    const int b = item >> 5, hx = (item >> 3) & 3, qblk = item & 7;
    const bf16* QX = (const bf16*)(a.ws + WS_QX); const bf16* KX = (const bf16*)(a.ws + WS_KX) + (size_t)b * 256 * 512 + hx * 128; const bf16* VX = (const bf16*)(a.ws + WS_VX) + (size_t)b * 256 * 512 + hx * 128;
    bf16* OX = (bf16*)(a.ws + WS_OX);
    const size_t row = (size_t)b * 2048 + qblk * 256 + wave * 32 + r32;
    bf16x8 qf[8];
#pragma unroll
    for (int s = 0; s < 8; ++s) qf[s] = *(const GAS bf16x8*)(QX + row * 512 + hx * 128 + 16 * s + 8 * hi);
    f32x16 o[4];
#pragma unroll
    for (int c = 0; c < 4; ++c)
#pragma unroll
        for (int r = 0; r < 16; ++r) o[c][r] = 0.f;
    float m = -INFINITY, l = 0.f;
    v4u kr[2], vr[2];
    tile_load(kr, KX, 512, tid); tile_load(vr, VX, 512, tid);
    tile_store(kr, lds, tid); tile_store(vr, lds + 32768, tid);
    __syncthreads();
#pragma unroll 1
    for (int kt = 0; kt < 4; ++kt) {
        LAS unsigned char* kimg = lds + (kt & 1) * 16384; LAS unsigned char* vimg = lds + 32768 + (kt & 1) * 16384;
        if (kt + 1 < 4) { tile_load(kr, KX + (size_t)(kt + 1) * 64 * 512, 512, tid); tile_load(vr, VX + (size_t)(kt + 1) * 64 * 512, 512, tid); }
        f32x16 p0, p1; qk_tile(p0, p1, kimg, qf, lane);
#pragma unroll
        for (int r = 0; r < 16; ++r) { p0[r] *= SCALE2; p1[r] *= SCALE2; }
        bf16x8 pf[4]; softmax_step(p0, p1, m, l, o, pf);
        pv_tile(o, vimg, pf, lane);
        if (kt + 1 < 4) { tile_store(kr, lds + ((kt + 1) & 1) * 16384, tid); tile_store(vr, lds + 32768 + ((kt + 1) & 1) * 16384, tid); }
        __syncthreads();
    }
    l = xh_sum(l);
    const float inv = 1.f / l;
#pragma unroll
    for (int c = 0; c < 4; ++c)
#pragma unroll
        for (int g4 = 0; g4 < 4; ++g4) { u32x2 w; w.x = cvtpk(o[c][4 * g4] * inv, o[c][4 * g4 + 1] * inv); w.y = cvtpk(o[c][4 * g4 + 2] * inv, o[c][4 * g4 + 3] * inv);
            *(GAS u32x2*)(OX + row * 512 + hx * 128 + 32 * c + 8 * g4 + 4 * hi) = w; }
}
__device__ __forceinline__ void cross_phase(const Args& a, LAS unsigned char* lds, int tid, int lane, int wave, int bx, int G) {
    if (bx < 128) return;
#pragma unroll 1
    for (int i = 0; i < 2; ++i) cross_item(a, lds, tid, lane, wave, (bx - 128) * 2 + i);
}

constexpr int DSA_QI = 0, DSA_QPITCH = 1040, DSA_CT = 36864, DSA_MASK = DSA_CT + 32768, DSA_CNT = DSA_MASK + 32 * 65 * 4, DSA_BT = DSA_CNT + 2 * 256 * 4, DSA_END = DSA_BT + 8 * 320 * 4;
static_assert(DSA_END <= RING_BYTES, "DSA LDS map");
__device__ __forceinline__ unsigned f2key(float x) { const unsigned b = __float_as_uint(x + 0.f); return (b & 0x80000000u) ? ~b : (b | 0x80000000u); }

__device__ __forceinline__ void cnt_ge(unsigned& cnt, unsigned key, unsigned cand) { asm volatile("v_cmp_ge_u32 vcc, %1, %2\n\tv_addc_co_u32_e32 %0, vcc, 0, %0, vcc" : "+v"(cnt) : "v"(key), "v"(cand) : "vcc"); }
__device__ __forceinline__ void cnt_gt(unsigned& cnt, unsigned key, unsigned cand) { asm volatile("v_cmp_gt_u32 vcc, %1, %2\n\tv_addc_co_u32_e32 %0, vcc, 0, %0, vcc" : "+v"(cnt) : "v"(key), "v"(cand) : "vcc"); }
__device__ __forceinline__ void cnt_eq(unsigned& cnt, unsigned key, unsigned cand) { asm volatile("v_cmp_eq_u32 vcc, %1, %2\n\tv_addc_co_u32_e32 %0, vcc, 0, %0, vcc" : "+v"(cnt) : "v"(key), "v"(cand) : "vcc"); }
template <int IB> __device__ __forceinline__ void cnt_tie_lt(unsigned& cnt, unsigned key, unsigned thr, unsigned lanepart, unsigned cand) { unsigned t;
    asm volatile("v_add_u32_e32 %1, %6, %4\n\tv_cmp_eq_u32 vcc, %2, %3\n\tv_cndmask_b32_e32 %1, -1, %1, vcc\n\tv_cmp_lt_u32 vcc, %1, %5\n\tv_addc_co_u32_e32 %0, vcc, 0, %0, vcc"
                 : "+v"(cnt), "=&v"(t) : "v"(key), "v"(thr), "v"(lanepart), "v"(cand), "i"(IB) : "vcc"); }
template <int IB, int BR> __device__ __forceinline__ void mask_sel(unsigned& w, unsigned key, unsigned thr, unsigned lanepart, unsigned istar, unsigned onehi) { unsigned t, bit;
    asm volatile("v_lshlrev_b32_e32 %2, %8, %7\n\tv_cmp_gt_u32 vcc, %3, %4\n\tv_cndmask_b32_e32 %1, 0, %2, vcc\n\tv_or_b32_e32 %0, %0, %1\n\t"
                 "v_add_u32_e32 %1, %9, %5\n\tv_cmp_le_u32 vcc, %1, %6\n\tv_cndmask_b32_e32 %1, 0, %2, vcc\n\tv_cmp_eq_u32 vcc, %3, %4\n\tv_cndmask_b32_e32 %1, 0, %1, vcc\n\tv_or_b32_e32 %0, %0, %1"
                 : "+v"(w), "=&v"(t), "=&v"(bit) : "v"(key), "v"(thr), "v"(lanepart), "v"(istar), "v"(onehi), "i"(BR), "i"(IB) : "vcc"); }

#define CRB(r) (((r) & 3) + 8 * ((r) >> 2))
#define TIE1(i, r) cnt_tie_lt<256 * (i) + CRB(r)>(cnt, key[i][r], thr, lanepart, cand);
#define TIE_ROW(i) TIE1(i,0) TIE1(i,1) TIE1(i,2) TIE1(i,3) TIE1(i,4) TIE1(i,5) TIE1(i,6) TIE1(i,7) TIE1(i,8) TIE1(i,9) TIE1(i,10) TIE1(i,11) TIE1(i,12) TIE1(i,13) TIE1(i,14) TIE1(i,15)
#define SEL1(i, r) mask_sel<256 * (i) + CRB(r), CRB(r)>(w, key[i][r], thr, lanepart, istar, onehi);
#define SEL_ROW(i) SEL1(i,0) SEL1(i,1) SEL1(i,2) SEL1(i,3) SEL1(i,4) SEL1(i,5) SEL1(i,6) SEL1(i,7) SEL1(i,8) SEL1(i,9) SEL1(i,10) SEL1(i,11) SEL1(i,12) SEL1(i,13) SEL1(i,14) SEL1(i,15)
__device__ __forceinline__ unsigned row_total(unsigned cnt, LAS unsigned* CNT, int& par, int r32, int hi, int wave) {
    cnt = xh_sumu(cnt);
    if (hi == 0) CNT[par * 256 + r32 * 8 + wave] = cnt;
    __syncthreads();
    const v4u x = *(LAS const v4u*)(CNT + par * 256 + r32 * 8), y = *(LAS const v4u*)(CNT + par * 256 + r32 * 8 + 4);
    par ^= 1;
    return (x.x + x.y) + (x.z + x.w) + (y.x + y.y) + (y.z + y.w);
}
__device__ __forceinline__ void dsa_item(const Args& a, LAS unsigned char* lds, int tid, int lane, int wave, int b, int qb) {
    const int r32 = lane & 31, hi = lane >> 5;
    const int t0 = qb * 32; const size_t rowb = (size_t)b * 2048;
    const bool sel = qb >= 8;
    const bf16* QD = (const bf16*)(a.ws + WS_QD); const bf16* CKV = (const bf16*)(a.ws + WS_CKV) + rowb * 128; const bf16* QI = (const bf16*)(a.ws + WS_QI); const bf16* KI = (const bf16*)(a.ws + WS_KI) + rowb * 64;
    const float* WI = (const float*)(a.ws + WS_WI); const float* BL = (const float*)(a.ws + WS_BIASL); const bf16* WUV = (const bf16*)(a.ws + WS_WUV); bf16* ODSA = (bf16*)(a.ws + WS_ODSA);
    LAS unsigned* MASK = (LAS unsigned*)(lds + DSA_MASK); LAS unsigned* CNT = (LAS unsigned*)(lds + DSA_CNT);
    const int NT = qb + 1;
#ifndef DSA_NO_SCORE
    if (sel) {
#pragma unroll
        for (int i = 0; i < 4; ++i) { const int id = tid + 512 * i, row = id >> 6, ch = id & 63;
            *(LAS v4u*)(lds + DSA_QI + row * DSA_QPITCH + ch * 16) = *(const GAS v4u*)(QI + (rowb + t0 + row) * 512 + ch * 8); }
        for (int i = tid; i < 32 * 65; i += NTHR) MASK[i] = 0u;
        __syncthreads();
        float wq[8];
        { const f32x4 w0 = *(const GAS f32x4*)(WI + (rowb + t0 + r32) * 8), w1 = *(const GAS f32x4*)(WI + (rowb + t0 + r32) * 8 + 4);
          wq[0] = w0.x; wq[1] = w0.y; wq[2] = w0.z; wq[3] = w0.w; wq[4] = w1.x; wq[5] = w1.y; wq[6] = w1.z; wq[7] = w1.w; }
        unsigned key[8][16];
        LAS const unsigned char* qbase = lds + DSA_QI + r32 * DSA_QPITCH + hi * 16;
#pragma unroll
        for (int i = 0; i < 8; ++i) {
            const int j = wave + 8 * i;
            if (j < NT) {
                asm volatile("" ::: "memory");
                bf16x8 kf[4];
#pragma unroll
                for (int kk = 0; kk < 4; ++kk) kf[kk] = *(const GAS bf16x8*)(KI + (size_t)(32 * j + r32) * 64 + 16 * kk + 8 * hi);
                f32x16 sacc;
#pragma unroll
                for (int r = 0; r < 16; ++r) sacc[r] = 0.f;
#pragma unroll
                for (int h = 0; h < 8; ++h) {
                    asm volatile("" ::: "memory");
                    f32x16 d;
#pragma unroll
                    for (int r = 0; r < 16; ++r) d[r] = 0.f;
#pragma unroll
                    for (int kk = 0; kk < 4; ++kk) { const bf16x8 qf = *(LAS const bf16x8*)(qbase + (h * 8 + 2 * kk) * 16); d = MFMA32(kf[kk], qf, d); }
#pragma unroll
                    for (int r = 0; r < 16; ++r) sacc[r] += fmaxf(d[r], 0.f) * wq[h];
#pragma unroll
                    for (int r = 0; r < 16; ++r) asm volatile("" : "+v"(sacc[r]));
                }
#pragma unroll
                for (int r = 0; r < 16; ++r) { const bool vis = (j < NT - 1) || (crow(r, hi) <= r32); key[i][r] = vis ? f2key(sacc[r]) : 0u; }
            } else {
#pragma unroll
                for (int r = 0; r < 16; ++r) key[i][r] = 0u;
            }
        }
        int par = 0; unsigned thr = 0u; const unsigned lanepart = 32u * (unsigned)wave + 4u * (unsigned)hi, onehi = 1u << (4 * hi);
#pragma unroll 1
        for (int bit = 31; bit >= 0; --bit) {
            const unsigned cand = thr | (1u << bit); unsigned cnt = 0u;
#pragma unroll
            for (int i = 0; i < 8; ++i)
#pragma unroll
                for (int r = 0; r < 16; ++r) cnt_ge(cnt, key[i][r], cand);
            if (row_total(cnt, CNT, par, r32, hi, wave) >= 256u) thr = cand;
        }
        unsigned cgt = 0u, ceq = 0u;
#pragma unroll
        for (int i = 0; i < 8; ++i)
#pragma unroll
            for (int r = 0; r < 16; ++r) { cnt_gt(cgt, key[i][r], thr); cnt_eq(ceq, key[i][r], thr); }
        const unsigned tgt = row_total(cgt, CNT, par, r32, hi, wave), teq = row_total(ceq, CNT, par, r32, hi, wave);
        const unsigned need = 256u - tgt;
        unsigned istar = 0x7fffffffu;
        if (__any(row_total(teq > need ? 1u : 0u, CNT, par, r32, hi, wave) != 0u)) {
            unsigned lo = 0u;
#pragma unroll 1
            for (int bit = 10; bit >= 0; --bit) {
                const unsigned cand = lo | (1u << bit); unsigned cnt = 0u;
                TIE_ROW(0) TIE_ROW(1) TIE_ROW(2) TIE_ROW(3) TIE_ROW(4) TIE_ROW(5) TIE_ROW(6) TIE_ROW(7)
                if (row_total(cnt, CNT, par, r32, hi, wave) < need) lo = cand;
            }
            istar = lo;
        }
#define SEL_TILE(i) { const int j = wave + 8 * (i); if (j < NT) { unsigned w = 0u; SEL_ROW(i) w = xh_or(w); if (hi == 0) MASK[r32 * 65 + j] = w; } }
        SEL_TILE(0) SEL_TILE(1) SEL_TILE(2) SEL_TILE(3) SEL_TILE(4) SEL_TILE(5) SEL_TILE(6) SEL_TILE(7)
#undef SEL_TILE
        __syncthreads();
    }
#endif
#ifndef DSA_NO_ATTN
    const int h = wave; const int tq = t0 + r32; const size_t qrow = rowb + t0 + r32;
    bf16x8 qf[8];
#pragma unroll
    for (int s = 0; s < 8; ++s) qf[s] = *(const GAS bf16x8*)(QD + qrow * 1024 + h * 128 + 16 * s + 8 * hi);
    const float c31 = BL[1024 + h];
    f32x16 o[4];
#pragma unroll
    for (int c = 0; c < 4; ++c)
#pragma unroll
        for (int r = 0; r < 16; ++r) o[c][r] = 0.f;
    float m = -INFINITY, l = 0.f;
    const int NKT = (t0 + 32 + 63) >> 6;
    v4u cr[2];
    tile_load(cr, CKV, 128, tid); tile_store(cr, lds + DSA_CT, tid);
    __syncthreads();
#pragma unroll 1
    for (int kt = 0; kt < NKT; ++kt) {
        LAS unsigned char* cimg = lds + DSA_CT + (kt & 1) * 16384;
        if (kt + 1 < NKT) tile_load(cr, CKV + (size_t)(kt + 1) * 64 * 128, 128, tid);
        f32x16 p0, p1; qk_tile(p0, p1, cimg, qf, lane);
        const int k0 = 64 * kt;
        const bool far = (t0 - k0 - 63) >= 128;
        unsigned mv0, mv1;
        if (sel) { mv0 = MASK[r32 * 65 + 2 * kt] >> (4 * hi); mv1 = MASK[r32 * 65 + 2 * kt + 1] >> (4 * hi); }
        else { const int d0 = tq - k0 - 4 * hi, d1 = d0 - 32;
            mv0 = d0 < 0 ? 0u : (d0 >= 31 ? 0x0f0f0f0fu : (0x0f0f0f0fu & ((2u << d0) - 1u)));
            mv1 = d1 < 0 ? 0u : (d1 >= 31 ? 0x0f0f0f0fu : (0x0f0f0f0fu & ((2u << d1) - 1u))); }
        if (far) {
#pragma unroll
            for (int r = 0; r < 16; ++r) { p0[r] = ((mv0 >> CRB(r)) & 1u) ? p0[r] * SCALE2 + c31 : -INFINITY; p1[r] = ((mv1 >> CRB(r)) & 1u) ? p1[r] * SCALE2 + c31 : -INFINITY; }
        } else {
            LAS const float* bt = (LAS const float*)(lds + DSA_BT) + h * 320 + (255 - (tq - k0 - 4 * hi));
#pragma unroll
            for (int r = 0; r < 16; ++r) { const float b0 = bt[CRB(r)], b1 = bt[32 + CRB(r)];
                p0[r] = ((mv0 >> CRB(r)) & 1u) ? p0[r] * SCALE2 + b0 : -INFINITY; p1[r] = ((mv1 >> CRB(r)) & 1u) ? p1[r] * SCALE2 + b1 : -INFINITY; }
        }
        bf16x8 pf[4]; softmax_step(p0, p1, m, l, o, pf);
        pv_tile(o, cimg, pf, lane);
        if (kt + 1 < NKT) tile_store(cr, lds + DSA_CT + ((kt + 1) & 1) * 16384, tid);
        __syncthreads();
    }
    l = xh_sum(l);
    const float inv = 1.f / l;
    bf16x8 of[8];
#pragma unroll
    for (int c = 0; c < 4; ++c) {
#pragma unroll
        for (int r = 0; r < 16; ++r) o[c][r] *= inv;
        of[2 * c] = pack_step(o[c], 0); of[2 * c + 1] = pack_step(o[c], 1);
    }
#pragma unroll
    for (int eb = 0; eb < 2; ++eb) {
        f32x16 acc;
#pragma unroll
        for (int r = 0; r < 16; ++r) acc[r] = 0.f;
        const bf16* wrow = WUV + (size_t)(h * 64 + 32 * eb + r32) * 128;
#pragma unroll
        for (int cs = 0; cs < 8; ++cs) {
            const s16x4 lo = *(const GAS s16x4*)(wrow + 16 * cs + 4 * hi), h4 = *(const GAS s16x4*)(wrow + 16 * cs + 8 + 4 * hi);
            const bf16x8 af = {lo[0], lo[1], lo[2], lo[3], h4[0], h4[1], h4[2], h4[3]};
            acc = MFMA32(af, of[cs], acc);
        }
#pragma unroll
        for (int g4 = 0; g4 < 4; ++g4) { u32x2 w; w.x = cvtpk(acc[4 * g4], acc[4 * g4 + 1]); w.y = cvtpk(acc[4 * g4 + 2], acc[4 * g4 + 3]);
            *(GAS u32x2*)(ODSA + qrow * 512 + h * 64 + 32 * eb + 8 * g4 + 4 * hi) = w; }
    }
#endif
    __syncthreads();
}
__device__ __forceinline__ void dsa_phase(const Args& a, LAS unsigned char* lds, int wave, int bx, int G) {
    const int b = bx >> 5, p = bx & 31;
    { const float* BL = (const float*)(a.ws + WS_BIASL); LAS float* BT = (LAS float*)(lds + DSA_BT);
      for (int i = wave * 64 + my_lane_id(); i < 8 * 320; i += NTHR) { const int hh = i / 320, d = 255 - (i % 320); BT[i] = d < 0 ? 0.f : (d < 128 ? BL[hh * 128 + d] : BL[1024 + hh]); } }
    __syncthreads();
#pragma unroll 1
    for (int it = 0; it < 2; ++it) {
        const int lane = my_lane_id();
        dsa_item(a, lds, wave * 64 + lane, lane, wave, b, it == 0 ? 63 - p : p);
    }
}
}
#define HAVE_DSA 1
using att::cross_phase; using att::dsa_phase;
__global__ void __launch_bounds__(NTHR, 2) mk_fwd(Args args) {
    extern __shared__ __attribute__((aligned(16))) unsigned char lds_raw[];
    LAS unsigned char* lds = (LAS unsigned char*)lds_raw;
    volatile LAS unsigned* MISC = (volatile LAS unsigned*)(lds + MISC_OFF);
    const int wave = __builtin_amdgcn_readfirstlane(threadIdx.x >> 6);
#define MYLANE() my_lane_id()
    const int G = gridDim.x, bx = blockIdx.x, vcu = (G % 8 == 0) ? (bx % 8) * (G / 8) + bx / 8 : bx;
    unsigned char* ws = args.ws;
    gu32* ctl = (gu32*)(ws + WS_CTL);
    { const int tid = wave * 64 + MYLANE();
      for (int u = tid; u < (LDS_BYTES - LDSCTL_OFF) / 4; u += NTHR) ((LAS unsigned*)(lds + LDSCTL_OFF))[u] = 0u; }
    __syncthreads();
    const int lo = args.ph_lo, hi = args.ph_hi;
    const bool multi = (hi - lo) > 1;
    XcdBarrier bar; bar.bar = (unsigned*)(ctl + CW_BAR) + args.li * XCD_BAR_WORDS; bar.x = 0; bar.st = nullptr;
    if (multi) bar = xcd_barrier_post((unsigned*)(ctl + CW_BAR) + args.li * XCD_BAR_WORDS, MISC + 8, wave == 0 && MYLANE() == 0);
#define IN(k) (lo <= (k) && (k) < hi)
#define L1_INV_SYNC() do { VM_WAIT(); __builtin_amdgcn_fence(__ATOMIC_ACQUIRE, "agent"); VM_WAIT(); __syncthreads(); } while (0)
#define SEAM(k) do { if (IN(k) && IN((k) + 1)) xcd_barrier(bar, wave == 0 && MYLANE() == 0); } while (0)
    bf16 *WIN = (bf16*)(ws + WS_WIN), *WMKV = (bf16*)(ws + WS_WMKV), *WGLU = (bf16*)(ws + WS_WGLU), *WBR = (bf16*)(ws + WS_WBR), *WOUT = (bf16*)(ws + WS_WOUT), *WGU = (bf16*)(ws + WS_WGU), *WD = (bf16*)(ws + WS_WD);
    float *RS = (float*)(ws + WS_RS), *WI = (float*)(ws + WS_WI), *SLOC = (float*)(ws + WS_SLOC);
    bf16 *KX = (bf16*)(ws + WS_KX), *VX = (bf16*)(ws + WS_VX), *MEMN = (bf16*)(ws + WS_MEMN), *H = (bf16*)(ws + WS_H), *QD = (bf16*)(ws + WS_QD), *CKV = (bf16*)(ws + WS_CKV), *QI = (bf16*)(ws + WS_QI), *KI = (bf16*)(ws + WS_KI),
         *QX = (bf16*)(ws + WS_QX), *U = (bf16*)(ws + WS_U), *ODSA = (bf16*)(ws + WS_ODSA), *OX = (bf16*)(ws + WS_OX), *Y = (bf16*)(ws + WS_Y), *OS5 = (bf16*)(ws + WS_OS5), *GB = (bf16*)(ws + WS_G), *MG = (bf16*)(ws + WS_MERGED),
         *ACT = (bf16*)(ws + WS_ACT), *XN = (bf16*)(ws + WS_XN), *S5TV = (bf16*)(ws + WS_S5TV), *S5W = (bf16*)(ws + WS_S5W);

    if (IN(0)) { const int lane = MYLANE(), tid = wave * 64 + lane; p0_prologue(args, lds, tid, lane, wave, vcu, G); }
    SEAM(0);
    if (IN(1)) {
        { pg8::Gemm g{H, WIN, T_TOK, NIN, 1024, 1024, 1024}; pg8::StaticOrder S; S.init(T_TOK, NIN, G, bx);
          pg8::EpiInprojF E{QD, CKV, QI, KI, U, QX, WI};
          pg8::gemm_phase<pg8::EpiInprojF, pg8::StaticOrder, true, true>(lds + RING_OFF, g, S, E, wave); }
        { pg8::Gemm g{MEMN, WMKV, 2048, 1024, 1024, 1024, 1024}; pg8::SubsetOrder S; S.init(2048, 1024, 64, bx - 192);
          pg8::EpiBf16S E{KX, VX, 512, 512};
          pg8::gemm_phase<pg8::EpiBf16S, pg8::SubsetOrder, true, true>(lds + RING_OFF, g, S, E, wave); }
    }
    SEAM(1);
    if (IN(2)) {
        const int gtid = bx * NTHR + wave * 64 + MYLANE(), nthr = G * NTHR;
        norm128_pass(QD, T_TOK, 1024, 8, args.in[5], gtid, nthr);
        norm128_pass(CKV, T_TOK, 128, 1, args.in[6], gtid, nthr);
        norm128_pass(QX, T_TOK, 512, 4, args.in[19], gtid, nthr);
        norm128_pass(KX, 2048, 512, 4, args.in[20], gtid, nthr);
        if (!(args.flags & FL_NO_S5)) {
            pg8::Gemm g{U, S5W, 32 * 512, 32 * 256, 512, 640, 512}; pg8::S5Order1 S{bx - 192};
            pg8::EpiSlocF E{SLOC};
            pg8::gemm_phase<pg8::EpiSlocF, pg8::S5Order1, false, true>(lds + RING_OFF, g, S, E, wave);
        }
    }
    SEAM(2);
    if (IN(3)) {
        if (!(args.flags & FL_NO_S5)) {
            if (bx < 128) s5_scan(bx >> 2, (bx >> 1) & 1, args, wave * 64 + MYLANE());
            pg8::Gemm g{U, S5TV, 32 * 512, 32 * 512, 640, 640, 640}; pg8::S5Order2 S{bx};
            pg8::EpiS5YF E{U, args.in[15], Y};
            pg8::gemm_phase<pg8::EpiS5YF, pg8::S5Order2, false, true>(lds + RING_OFF, g, S, E, wave);
        }
#ifdef HAVE_ATTN
        if (!(args.flags & FL_NO_CROSS)) { const int lane = MYLANE(); cross_phase(args, lds, wave * 64 + lane, lane, wave, bx, G); }
#endif
#ifdef HAVE_DSA
        if (!(args.flags & FL_NO_DSA)) dsa_phase(args, lds, wave, bx, G);
#endif
    }
    SEAM(3);
    if (IN(4)) {
        pg8::Gemm g{Y, WGLU, T_TOK, 512, 512, 512, 512}; pg8::StaticOrder S; S.init(T_TOK, 512, G, bx);
        pg8::EpiGluF E{Y, OS5};
        pg8::gemm_phase<pg8::EpiGluF, pg8::StaticOrder, false, true>(lds + RING_OFF, g, S, E, wave);
    }
    SEAM(4);
    if (IN(5)) {
        const int sub = (args.flags >> 8) & 15;
#pragma unroll 1
        for (int br = 0; br < 3; ++br) {
            if (sub == 0 || sub == 2 * br + 1) { pg8::Gemm g{H, WIN + (size_t)(NIN + br * 1024) * 1024, T_TOK, 1024, 1024, 1024, 1024}; pg8::StaticOrder S; S.init(T_TOK, 1024, G, bx);
              pg8::EpiSigmoidF E{GB};
              pg8::gemm_phase<pg8::EpiSigmoidF, pg8::StaticOrder, false, true>(lds + RING_OFF, g, S, E, wave); }
            if (sub == 0 || sub == 2 * br + 2) { const bf16* A = br == 0 ? ODSA : (br == 1 ? OS5 : OX);
              pg8::Gemm g{A, WBR + (size_t)br * 1024 * 512, T_TOK, 1024, 512, 512, 512}; pg8::StaticOrder S; S.init(T_TOK, 1024, G, bx);
              pg8::EpiMergeF E{GB, MG, br == 0 ? 1 : 0};
              pg8::gemm_phase<pg8::EpiMergeF, pg8::StaticOrder, false, true>(lds + RING_OFF, g, S, E, wave); }
        }
    }
    SEAM(5);
    if (IN(6)) {
        pg8::Gemm g{MG, WOUT, T_TOK, 1024, 1024, 1024, 1024}; pg8::StaticOrder S; S.init(T_TOK, 1024, G, bx);
        pg8::EpiOutF E{args.in[0], args.out, XN, RS};
        pg8::gemm_phase<pg8::EpiOutF, pg8::StaticOrder, false, true>(lds + RING_OFF, g, S, E, wave);
    }
    SEAM(6);
    if (IN(7)) {
        pg8::Gemm g{XN, WGU, T_TOK, 5632, 1024, 1024, 1024}; pg8::StaticOrder S; S.init(T_TOK, 5632, G, bx);
        pg8::EpiGateUpF E{RS, ACT};
        pg8::gemm_phase<pg8::EpiGateUpF, pg8::StaticOrder, true, true>(lds + RING_OFF, g, S, E, wave);
    }
    SEAM(7);
    if (IN(8)) {
        pg8::Gemm g{ACT, WD, T_TOK, 1024, 2816, 2816, 2816}; pg8::StaticOrder S; S.init(T_TOK, 1024, G, bx);
        pg8::EpiDownF E{args.out};
        pg8::gemm_phase<pg8::EpiDownF, pg8::StaticOrder, false, true>(lds + RING_OFF, g, S, E, wave);
    }
#undef IN
#undef SEAM
}
#ifndef CFG_FLAGS
#define CFG_FLAGS (FL_NO_DSA | FL_NO_CROSS)
#endif
#ifndef CFG_ONE_LAUNCH
#define CFG_ONE_LAUNCH 0
#endif
extern "C" void kernel_launch(void* const* d_in, const int* in_sizes, int n_in, void* d_out, int out_size, void* d_ws, size_t ws_size, hipStream_t stream) {
    static int grid = 0;
    if (grid == 0) {
        if (n_in != 29 || ws_size < WS_END || out_size != T_TOK * DM) { fprintf(stderr, "kernel_launch: unexpected sizes n_in %d ws %zu out %d\n", n_in, ws_size, out_size); grid = -1; return; }
        int dev = 0, cus = 0, per_cu = 0;
        if (hipGetDevice(&dev) != hipSuccess || hipDeviceGetAttribute(&cus, hipDeviceAttributeMultiprocessorCount, dev) != hipSuccess) { grid = -1; return; }
        if (hipFuncSetAttribute((const void*)mk_fwd, hipFuncAttributeMaxDynamicSharedMemorySize, LDS_BYTES) != hipSuccess) { fprintf(stderr, "kernel_launch: hipFuncSetAttribute failed\n"); grid = -1; return; }
        if (hipOccupancyMaxActiveBlocksPerMultiprocessor(&per_cu, (const void*)mk_fwd, NTHR, LDS_BYTES) != hipSuccess || per_cu < 1) fprintf(stderr, "kernel_launch: note: occupancy query reports %d\n", per_cu);
        (void)hipGetLastError();
        grid = cus;
        if (grid != 256) fprintf(stderr, "kernel_launch: %d CUs (built for 256)\n", grid);
    }
    if (grid < 0) return;
    (void)hipMemsetAsync((char*)d_ws + WS_CTL, 0, CTL_ZERO_BYTES, stream);
    Args a{};
    for (int i = 0; i < 29; ++i) a.in[i] = (const float*)d_in[i];
    a.out = (float*)d_out; a.ws = (unsigned char*)d_ws; a.flags = CFG_FLAGS;
#if CFG_ONE_LAUNCH
    a.ph_lo = 0; a.ph_hi = NPH;
    hipLaunchKernelGGL(mk_fwd, dim3(grid), dim3(NTHR), LDS_BYTES, stream, a);
#else
    unsigned char* ws = (unsigned char*)d_ws; const float* const* in = (const float* const*)d_in;
#ifdef CFG_SPLIT2
    for (int ph = 3; ph < 5; ++ph) {
        if (ph == 3) { a.ph_lo = 0; a.ph_hi = 4; a.li = 0; } else { a.ph_lo = 4; a.ph_hi = NPH; a.li = 1; }
#else
    for (int ph = 0; ph < NPH; ++ph) {
        a.ph_lo = ph; a.ph_hi = ph + 1;
#endif
        hipLaunchKernelGGL(mk_fwd, dim3(grid), dim3(NTHR), LDS_BYTES, stream, a);
        if (ph == 3) {
            using namespace nv;
            if (CFG_FLAGS & FL_NO_DSA) k_dsa<<<16384, 256, 0, stream>>>((nv::bf16*)(ws + WS_QD), (nv::bf16*)(ws + WS_CKV), (nv::bf16*)(ws + WS_QI), (nv::bf16*)(ws + WS_KI), (float*)(ws + WS_WI), (float*)(ws + WS_BIASL), (nv::bf16*)(ws + WS_WUV), (nv::bf16*)(ws + WS_ODSA));
            if (CFG_FLAGS & FL_NO_CROSS) k_cross<<<16384, 256, 0, stream>>>((nv::bf16*)(ws + WS_QX), (nv::bf16*)(ws + WS_KX), (nv::bf16*)(ws + WS_VX), (nv::bf16*)(ws + WS_OX));
            if (CFG_FLAGS & FL_NO_S5) k_s5<<<256, 64, 0, stream>>>((nv::bf16*)(ws + WS_U), in[8], in[9], in[10], in[11], in[12], in[13], in[14], in[15], (nv::bf16*)(ws + WS_Y));
        }
    }
#endif
}
```

```cpp
#include <hip/hip_runtime.h>
#include <cstdio>
#include <cstdint>
#include <cmath>
constexpr int T_TOK = 16384, DM = 1024, SEQ = 2048, NB = 8, NIN = 2816, NINP = 5888, DFF = 2816;
constexpr size_t MiB = 1u << 20;
constexpr size_t WS_CTL = 0;
constexpr size_t WS_WIN = 1 * MiB, WS_WMKV = 13 * MiB, WS_WGLU = 15 * MiB, WS_WBR = 16 * MiB, WS_WOUT = 19 * MiB, WS_WGU = 21 * MiB, WS_WD = 32 * MiB;
constexpr size_t WS_WUV = 38 * MiB, WS_BIASL = 38 * MiB + 512 * 1024, WS_RS = 39 * MiB, WS_WI = 37 * MiB + 512 * 1024;
constexpr size_t WS_S5TV = 40 * MiB, WS_S5W = 60 * MiB, WS_KX = 68 * MiB, WS_VX = 70 * MiB, WS_MEMN = 72 * MiB, WS_H = 76 * MiB;
constexpr size_t WS_QD = 108 * MiB, WS_CKV = 140 * MiB, WS_QI = 144 * MiB, WS_KI = 160 * MiB, WS_QX = 162 * MiB, WS_U = 178 * MiB, WS_SLOC = 198 * MiB;
constexpr size_t WS_ODSA = 206 * MiB, WS_OX = 222 * MiB, WS_Y = 238 * MiB, WS_END = 254 * MiB;
constexpr size_t WS_OS5 = 108 * MiB, WS_G = 124 * MiB, WS_MERGED = 156 * MiB, WS_ACT = 108 * MiB, WS_XN = WS_H;
__device__ __forceinline__ int my_lane_id() { int l; asm volatile("v_mbcnt_lo_u32_b32 %0, -1, 0\n\tv_mbcnt_hi_u32_b32 %0, -1, %0" : "=v"(l)); return l; }
#define CFG_FLAGS 0
#define CFG_ONE_LAUNCH 1
namespace pg8 {
#define PG8_LAS __attribute__((address_space(3)))
typedef unsigned short bf16_t;
typedef short bf16x8 __attribute__((ext_vector_type(8)));
typedef float f32x4 __attribute__((ext_vector_type(4)));
typedef unsigned u32x4 __attribute__((ext_vector_type(4)));
constexpr int BM = 256, BK = 64, HALF = 128, HTB = HALF * BK * 2  , STAGE_BYTES = 8 * HTB, NXCD = 8, WGM = 8;

__host__ __device__ __forceinline__ int lds_byte(int r, int c) { const int st = (r >> 4) * 2 + (c >> 5), rr = r & 15, cc = c & 31, ob = rr * 64 + cc * 2; return st * 1024 + (ob ^ (((ob >> 9) & 1) << 5)); }
__host__ __device__ __forceinline__ void stage_rc(int b, int& R, int& C) { const int st = b / 1024, sb = b % 1024, swz = sb ^ (((sb >> 9) & 1) << 5); R = (st >> 1) * 16 + swz / 64; C = (st & 1) * 32 + (swz % 64) / 2; }
__host__ __device__ __forceinline__ int perm32(int rho) { const int n = rho >> 4, i = rho & 15; return 8 * (i >> 2) + 4 * n + (i & 3); }

struct Unit { int pm, pn; };
struct Gemm { const bf16_t* A; const bf16_t* Bt; int M, N, K, lda, ldb; };

struct StaticOrder {
    int nM, nN, nwg, G, c;
    __host__ __device__ void init(int M, int N, int G_, int c_) { nM = M / BM; nN = N / BM; nwg = nM * nN; G = G_; c = c_; }
    __host__ __device__ bool next(int i, Unit& u) const {
        const long L = (long)i * G + c; if (L >= nwg) return false;
        int wgid = (int)L; { const int q = nwg / NXCD, r = nwg % NXCD, xcd = wgid % NXCD, off = wgid / NXCD; wgid = (xcd < r ? xcd * (q + 1) : r * (q + 1) + (xcd - r) * q) + off; }
        const int nig = WGM * nN, gid = wgid / nig, fm = gid * WGM, gsz = (nM - fm) < WGM ? (nM - fm) : WGM;
        u.pm = fm + ((wgid % nig) % gsz); u.pn = (wgid % nig) / gsz; return true;
    }
    __device__ __forceinline__ void a_ready(const Unit&) const {}
    __device__ __forceinline__ void done(const Unit&) const {}
};

typedef float f32x2_c __attribute__((ext_vector_type(2))); typedef __bf16 bf16x2_c __attribute__((ext_vector_type(2)));
__device__ __forceinline__ unsigned cvt_pk_bf16(float lo, float hi) { const f32x2_c v = {lo, hi}; const bf16x2_c b = __builtin_convertvector(v, bf16x2_c); return __builtin_bit_cast(unsigned, b); }
typedef float f32x2 __attribute__((ext_vector_type(2)));
template <class Epi, class Sched, bool ALIGN_EPI = false, bool SP2 = false>
__device__ __forceinline__ void gemm_phase(PG8_LAS unsigned char* lds, const Gemm g, const Sched& S, const Epi& E, const int wid) {
    const int lane = my_lane_id(), tid = wid * 64 + lane, wr = wid >> 2, wc = wid & 3, fr = lane & 15, fq = lane >> 4;
    const int K = g.K, nt = K / BK, lda = g.lda, ldb = g.ldb;
    unsigned voffA[2], voffB[2];
#pragma unroll
    for (int i = 0; i < 2; ++i) { int R, C; stage_rc(tid * 16 + i * 8192, R, C); const int Rb = Epi::PERM ? ((R & ~31) + perm32(R & 31)) : R;
        voffA[i] = (unsigned)(R * lda + C) * 2u; voffB[i] = (unsigned)(Rb * ldb + C) * 2u; }
    const size_t kstep = (size_t)(BK * 2);
    const size_t hstepA = (size_t)HALF * lda * 2, hstepB = (size_t)HALF * ldb * 2;
    const size_t tstepA = 2 * hstepA, tstepB = 2 * hstepB;
    const unsigned ldsw = (unsigned)wid * 1024u;
    const int aoff = lds_byte(wr * 64 + fr, fq * 8), boff = lds_byte(wc * 32 + fr, fq * 8);
#define PG8_SA(b, h) (((b) * 2 + (h)) * HTB)
#define PG8_SB(b, h) ((4 + (b) * 2 + (h)) * HTB)
#define PG8_STAGE(bufoff, gbase, voff) do { _Pragma("unroll") for (int _i = 0; _i < 2; ++_i) \
        __builtin_amdgcn_global_load_lds((const unsigned*)((const char*)(gbase) + (voff)[_i]), (PG8_LAS unsigned*)(lds + (bufoff) + ldsw + _i * 8192), 16, 0, 0); } while (0)
#define PG8_LDA(dst, b, h) do { _Pragma("unroll") for (int m = 0; m < 4; ++m) _Pragma("unroll") for (int k = 0; k < 2; ++k) dst[m][k] = *(const PG8_LAS bf16x8*)(lds + PG8_SA(b, h) + aoff + m * 2048 + k * 1024); } while (0)
#define PG8_LDB(dst, b, h) do { _Pragma("unroll") for (int n = 0; n < 2; ++n) _Pragma("unroll") for (int k = 0; k < 2; ++k) dst[n][k] = *(const PG8_LAS bf16x8*)(lds + PG8_SB(b, h) + boff + n * 2048 + k * 1024); } while (0)
#define PG8_MMA(ai, bj, At, Bt) do { __builtin_amdgcn_s_setprio(1); _Pragma("unroll") for (int m = 0; m < 4; ++m) _Pragma("unroll") for (int n = 0; n < 2; ++n) _Pragma("unroll") for (int k = 0; k < 2; ++k) \
        acc[ai][bj][m][n] = __builtin_amdgcn_mfma_f32_16x16x32_bf16(Bt[n][k], At[m][k], acc[ai][bj][m][n], 0, 0, 0); __builtin_amdgcn_s_setprio(0); } while (0)
#define PG8_WAIT_V(n) asm volatile("s_waitcnt vmcnt(" #n ")" ::: "memory")
#define PG8_WAIT_L(n) asm volatile("s_waitcnt lgkmcnt(" #n ")" ::: "memory")
#define PG8_BAR __builtin_amdgcn_s_barrier()
#define PG8_SCHED __builtin_amdgcn_sched_barrier(0)
    Unit cur, nxt; int ui = 0;
    if (!S.next(0, cur)) return;
    f32x4 acc[2][2][4][2];
#pragma unroll
    for (int a = 0; a < 2; ++a)
#pragma unroll
        for (int b = 0; b < 2; ++b)
#pragma unroll
            for (int m = 0; m < 4; ++m)
#pragma unroll
                for (int n = 0; n < 2; ++n) acc[a][b][m][n] = (f32x4){0.f, 0.f, 0.f, 0.f};
    bf16x8 At[4][2], B0[2][2], B1[2][2];
    const char* cA = (const char*)g.A + (size_t)cur.pm * tstepA; const char* cB = (const char*)g.Bt + (size_t)cur.pn * tstepB;
    S.a_ready(cur);
    if constexpr (SP2) {
        PG8_STAGE(PG8_SB(0, 0), cB, voffB); PG8_STAGE(PG8_SB(0, 1), cB + hstepB, voffB); PG8_STAGE(PG8_SA(0, 0), cA, voffA); PG8_STAGE(PG8_SA(0, 1), cA + hstepA, voffA);
        if (wr == 1) PG8_BAR;
        PG8_WAIT_V(2); PG8_BAR;
        PG8_STAGE(PG8_SB(1, 0), cB + kstep, voffB); PG8_STAGE(PG8_SA(1, 0), cA + kstep, voffA); PG8_STAGE(PG8_SB(1, 1), cB + hstepB + kstep, voffB);
        PG8_WAIT_V(6); PG8_BAR;
    } else {
        PG8_STAGE(PG8_SB(0, 0), cB, voffB); PG8_STAGE(PG8_SA(0, 0), cA, voffA); PG8_STAGE(PG8_SB(0, 1), cB + hstepB, voffB); PG8_STAGE(PG8_SA(0, 1), cA + hstepA, voffA);
        if (wr == 1) PG8_BAR;
        PG8_WAIT_V(4); PG8_BAR;
        PG8_STAGE(PG8_SB(1, 0), cB + kstep, voffB); PG8_STAGE(PG8_SA(1, 0), cA + kstep, voffA); PG8_STAGE(PG8_SB(1, 1), cB + hstepB + kstep, voffB);
        PG8_WAIT_V(6); PG8_BAR;
    }
    for (;;) {
        const bool has_next = S.next(ui + 1, nxt);
        const char* nA = has_next ? (const char*)g.A + (size_t)nxt.pm * tstepA : cA; const char* nB = has_next ? (const char*)g.Bt + (size_t)nxt.pn * tstepB : cB;
        for (int t = 0; t < nt; t += 2) {
            const bool last = (t == nt - 2);
            const char* a1 = cA + (size_t)(t + 1) * kstep;
            const char* a2 = last ? nA : cA + (size_t)(t + 2) * kstep; const char* b2 = last ? nB : cB + (size_t)(t + 2) * kstep;
            const char* a3 = a2 + kstep; const char* b3 = b2 + kstep;
            if (last && has_next) S.a_ready(nxt);
            if constexpr (SP2) {
            PG8_LDB(B0, 0, 0); PG8_LDB(B1, 0, 1); PG8_SCHED; PG8_LDA(At, 0, 0); PG8_STAGE(PG8_SA(1, 1), a1 + hstepA, voffA);
            PG8_WAIT_V(8); PG8_WAIT_L(0); PG8_BAR; PG8_MMA(0, 0, At, B0); PG8_MMA(0, 1, At, B1); PG8_BAR; PG8_SCHED;
            PG8_LDA(At, 0, 1); PG8_STAGE(PG8_SB(0, 0), b2, voffB); PG8_STAGE(PG8_SB(0, 1), b2 + hstepB, voffB); PG8_STAGE(PG8_SA(0, 0), a2, voffA);
            PG8_WAIT_V(8); PG8_WAIT_L(0); PG8_BAR; PG8_MMA(1, 0, At, B0); PG8_MMA(1, 1, At, B1); PG8_BAR; PG8_SCHED;
            PG8_LDB(B0, 1, 0); PG8_LDB(B1, 1, 1); PG8_SCHED; PG8_LDA(At, 1, 0); PG8_STAGE(PG8_SA(0, 1), a2 + hstepA, voffA);
            PG8_WAIT_V(8); PG8_WAIT_L(0); PG8_BAR; PG8_MMA(0, 0, At, B0); PG8_MMA(0, 1, At, B1); PG8_BAR; PG8_SCHED;
            PG8_LDA(At, 1, 1); PG8_STAGE(PG8_SB(1, 0), b3, voffB); PG8_STAGE(PG8_SB(1, 1), b3 + hstepB, voffB); PG8_STAGE(PG8_SA(1, 0), a3, voffA);
            PG8_WAIT_V(8); PG8_WAIT_L(0); PG8_BAR; PG8_MMA(1, 0, At, B0); PG8_MMA(1, 1, At, B1); PG8_BAR; PG8_SCHED;
            } else {
            PG8_LDB(B0, 0, 0); PG8_SCHED; PG8_LDA(At, 0, 0); PG8_STAGE(PG8_SA(1, 1), a1 + hstepA, voffA);
            PG8_WAIT_L(8); PG8_BAR; PG8_WAIT_L(0); PG8_MMA(0, 0, At, B0); PG8_BAR; PG8_SCHED;
            PG8_LDB(B1, 0, 1); PG8_STAGE(PG8_SB(0, 0), b2, voffB);
            PG8_BAR; PG8_WAIT_L(0); PG8_MMA(0, 1, At, B1); PG8_BAR;
            PG8_LDA(At, 0, 1); PG8_STAGE(PG8_SA(0, 0), a2, voffA);
            PG8_BAR; PG8_WAIT_L(0); PG8_MMA(1, 0, At, B0); PG8_BAR; PG8_SCHED;
            PG8_STAGE(PG8_SB(0, 1), b2 + hstepB, voffB);
            PG8_WAIT_V(6); PG8_BAR; PG8_MMA(1, 1, At, B1); PG8_BAR;
            PG8_LDB(B0, 1, 0); PG8_SCHED; PG8_LDA(At, 1, 0); PG8_STAGE(PG8_SA(0, 1), a2 + hstepA, voffA);
            PG8_WAIT_L(8); PG8_BAR; PG8_WAIT_L(0); PG8_MMA(0, 0, At, B0); PG8_BAR; PG8_SCHED;
            PG8_LDB(B1, 1, 1); PG8_STAGE(PG8_SB(1, 0), b3, voffB);
            PG8_BAR; PG8_WAIT_L(0); PG8_MMA(0, 1, At, B1); PG8_BAR;
            PG8_LDA(At, 1, 1); PG8_STAGE(PG8_SA(1, 0), a3, voffA);
            PG8_BAR; PG8_WAIT_L(0); PG8_MMA(1, 0, At, B0); PG8_BAR; PG8_SCHED;
            PG8_STAGE(PG8_SB(1, 1), b3 + hstepB, voffB);
            PG8_WAIT_V(6); PG8_BAR; PG8_MMA(1, 1, At, B1); PG8_BAR;
            }
        }
        if constexpr (ALIGN_EPI) { if (wr == 0) PG8_BAR; }
        if constexpr (!Epi::AFTER_DRAIN) { E(acc, cur, wr, wc, fr, fq); S.done(cur); }
        if (!has_next) break;
#pragma unroll
        for (int a = 0; a < 2; ++a)
#pragma unroll
            for (int b = 0; b < 2; ++b)
#pragma unroll
                for (int m = 0; m < 4; ++m)
#pragma unroll
                    for (int n = 0; n < 2; ++n) acc[a][b][m][n] = (f32x4){0.f, 0.f, 0.f, 0.f};
        cur = nxt; cA = nA; cB = nB; ++ui;
        if constexpr (ALIGN_EPI) { if (wr == 1) PG8_BAR; }
    }
    PG8_WAIT_V(0);
    if constexpr (!ALIGN_EPI) { if (wr == 0) PG8_BAR; }
    PG8_BAR;
    if constexpr (Epi::AFTER_DRAIN) { E.fused(acc, cur, wr, wc, fr, fq, lds, wid, lane); S.done(cur); }
#undef PG8_SA
#undef PG8_SB
#undef PG8_STAGE
#undef PG8_LDA
#undef PG8_LDB
#undef PG8_MMA
#undef PG8_WAIT_V
#undef PG8_WAIT_L
#undef PG8_BAR
#undef PG8_SCHED
}
}
namespace pg8 {
typedef unsigned u32x2 __attribute__((ext_vector_type(2)));
__device__ __forceinline__ u32x4 pack8(const f32x4 a, const f32x4 b) { u32x4 w; w.x = cvt_pk_bf16(a[0], a[1]); w.y = cvt_pk_bf16(a[2], a[3]); w.z = cvt_pk_bf16(b[0], b[1]); w.w = cvt_pk_bf16(b[2], b[3]); return w; }
__device__ __forceinline__ void unpack8(const u32x4 w, f32x4& a, f32x4& b) {
    a[0] = __uint_as_float(w.x << 16); a[1] = __uint_as_float(w.x & 0xffff0000u); a[2] = __uint_as_float(w.y << 16); a[3] = __uint_as_float(w.y & 0xffff0000u);
    b[0] = __uint_as_float(w.z << 16); b[1] = __uint_as_float(w.z & 0xffff0000u); b[2] = __uint_as_float(w.w << 16); b[3] = __uint_as_float(w.w & 0xffff0000u); }
__device__ __forceinline__ float sigm(float v) { return __builtin_amdgcn_rcpf(1.f + __expf(-v)); }
__device__ __forceinline__ f32x4 sigm4(const f32x4 v) { f32x4 r; r[0] = sigm(v[0]); r[1] = sigm(v[1]); r[2] = sigm(v[2]); r[3] = sigm(v[3]); return r; }

struct EpiInprojF {
    static constexpr bool PERM = true, AFTER_DRAIN = false;
    bf16_t *QD, *CKV, *QI, *KI, *U, *QX; float* WI;
    __device__ __forceinline__ void operator()(const f32x4 (&acc)[2][2][4][2], const Unit& u, int wr, int wc, int fr, int fq) const {
        const int row0 = u.pm * BM + wr * 64 + fr;
#pragma unroll
        for (int bj = 0; bj < 2; ++bj) {
            const int c0 = u.pn * BM + bj * HALF + wc * 32 + 8 * fq;
            bf16_t* base = QD; int ld = 1024, cc = c0, kind = 0;
            if (c0 < 1024) { }
            else if (c0 < 1152) { base = CKV; ld = 128; cc = c0 - 1024; }
            else if (c0 < 1664) { base = QI; ld = 512; cc = c0 - 1152; }
            else if (c0 < 1728) { base = KI; ld = 64; cc = c0 - 1664; }
            else if (c0 < 1792) { kind = 1; }
            else if (c0 < 2304) { kind = 2; cc = c0 - 1792; }
            else { base = QX; ld = 512; cc = c0 - 2304; }
#pragma unroll
            for (int ai = 0; ai < 2; ++ai)
#pragma unroll
                for (int m = 0; m < 4; ++m) {
                    const int t = row0 + ai * HALF + m * 16;
                    if (kind == 0) *(u32x4*)(base + (size_t)t * ld + cc) = pack8(acc[ai][bj][m][0], acc[ai][bj][m][1]);
                    else if (kind == 1) { if (c0 == 1728) { *(f32x4*)(WI + (size_t)t * 8) = acc[ai][bj][m][0]; *(f32x4*)(WI + (size_t)t * 8 + 4) = acc[ai][bj][m][1]; } }
                    else { const int g = cc >> 4, ci = cc & 15, b = t >> 11, tt = t & 2047, R = b * 64 + (tt >> 5), s = tt & 31;
                        *(u32x4*)(U + ((size_t)(g * 512 + R)) * 640 + s * 16 + ci) = pack8(acc[ai][bj][m][0], acc[ai][bj][m][1]); }
                }
        }
    }
};
struct EpiBf16S {
    static constexpr bool PERM = true, AFTER_DRAIN = false;
    bf16_t* O0; bf16_t* O1; int split, ld;
    __device__ __forceinline__ void operator()(const f32x4 (&acc)[2][2][4][2], const Unit& u, int wr, int wc, int fr, int fq) const {
        const int row0 = u.pm * BM + wr * 64 + fr;
#pragma unroll
        for (int bj = 0; bj < 2; ++bj) {
            const int c0 = u.pn * BM + bj * HALF + wc * 32 + 8 * fq;
            bf16_t* base = c0 < split ? O0 : O1; const int cc = c0 < split ? c0 : c0 - split;
#pragma unroll
            for (int ai = 0; ai < 2; ++ai)
#pragma unroll
                for (int m = 0; m < 4; ++m) *(u32x4*)(base + (size_t)(row0 + ai * HALF + m * 16) * ld + cc) = pack8(acc[ai][bj][m][0], acc[ai][bj][m][1]);
        }
    }
};
struct EpiGluF {
    static constexpr bool PERM = true, AFTER_DRAIN = false;
    const bf16_t* Y; bf16_t* O;
    __device__ __forceinline__ void operator()(const f32x4 (&acc)[2][2][4][2], const Unit& u, int wr, int wc, int fr, int fq) const {
        const int row0 = u.pm * BM + wr * 64 + fr;
#pragma unroll
        for (int bj = 0; bj < 2; ++bj) {
            const int c0 = u.pn * BM + bj * HALF + wc * 32 + 8 * fq;
#pragma unroll
            for (int ai = 0; ai < 2; ++ai)
#pragma unroll
                for (int m = 0; m < 4; ++m) { const size_t off = (size_t)(row0 + ai * HALF + m * 16) * 512 + c0;
                    f32x4 y0, y1; unpack8(*(const u32x4*)(Y + off), y0, y1);
                    *(u32x4*)(O + off) = pack8(y0 * sigm4(acc[ai][bj][m][0]), y1 * sigm4(acc[ai][bj][m][1])); }
        }
    }
};
struct EpiSigmoidF {
    static constexpr bool PERM = true, AFTER_DRAIN = false;
    bf16_t* G;
    __device__ __forceinline__ void operator()(const f32x4 (&acc)[2][2][4][2], const Unit& u, int wr, int wc, int fr, int fq) const {
        const int row0 = u.pm * BM + wr * 64 + fr;
#pragma unroll
        for (int bj = 0; bj < 2; ++bj) {
            const int c0 = u.pn * BM + bj * HALF + wc * 32 + 8 * fq;
#pragma unroll
            for (int ai = 0; ai < 2; ++ai)
#pragma unroll
                for (int m = 0; m < 4; ++m) *(u32x4*)(G + (size_t)(row0 + ai * HALF + m * 16) * 1024 + c0) = pack8(sigm4(acc[ai][bj][m][0]), sigm4(acc[ai][bj][m][1]));
        }
    }
};
struct EpiMergeF {
    static constexpr bool PERM = true, AFTER_DRAIN = false;
    const bf16_t* G; bf16_t* MG; int first;
    __device__ __forceinline__ void operator()(const f32x4 (&acc)[2][2][4][2], const Unit& u, int wr, int wc, int fr, int fq) const {
        const int row0 = u.pm * BM + wr * 64 + fr;
#pragma unroll
        for (int bj = 0; bj < 2; ++bj) {
            const int c0 = u.pn * BM + bj * HALF + wc * 32 + 8 * fq;
#pragma unroll
            for (int ai = 0; ai < 2; ++ai)
#pragma unroll
                for (int m = 0; m < 4; ++m) { const size_t off = (size_t)(row0 + ai * HALF + m * 16) * 1024 + c0;
                    f32x4 g0, g1, p0 = {0.f, 0.f, 0.f, 0.f}, p1 = {0.f, 0.f, 0.f, 0.f}; unpack8(*(const u32x4*)(G + off), g0, g1);
                    if (!first) unpack8(*(const u32x4*)(MG + off), p0, p1);
                    *(u32x4*)(MG + off) = pack8(p0 + g0 * acc[ai][bj][m][0], p1 + g1 * acc[ai][bj][m][1]); }
        }
    }
};
struct EpiOutF {
    static constexpr bool PERM = false, AFTER_DRAIN = false;
    const float* x; float* out; bf16_t* XN; float* RS;
    __device__ __forceinline__ void operator()(const f32x4 (&acc)[2][2][4][2], const Unit& u, int wr, int wc, int fr, int fq) const {
        const int row0 = u.pm * BM + wr * 64 + fr, col0 = u.pn * BM + wc * 32 + 4 * fq;
#pragma unroll
        for (int ai = 0; ai < 2; ++ai)
#pragma unroll
            for (int m = 0; m < 4; ++m) { const int t = row0 + ai * HALF + m * 16; const size_t off = (size_t)t * 1024 + col0; float ss = 0.f;
#pragma unroll
                for (int bj = 0; bj < 2; ++bj)
#pragma unroll
                    for (int n = 0; n < 2; ++n) { const size_t o2 = off + bj * HALF + n * 16; const f32x4 r = *(const f32x4*)(x + o2) + acc[ai][bj][m][n];
                        *(f32x4*)(out + o2) = r; u32x2 w; w.x = cvt_pk_bf16(r[0], r[1]); w.y = cvt_pk_bf16(r[2], r[3]); *(u32x2*)(XN + o2) = w;
                        ss += (r[0] * r[0] + r[1] * r[1]) + (r[2] * r[2] + r[3] * r[3]); }
                ss += __shfl_xor(ss, 16); ss += __shfl_xor(ss, 32);
                if (fq == 0) RS[(size_t)t * 16 + u.pn * 4 + wc] = ss; }
    }
};
struct EpiGateUpF {
    static constexpr bool PERM = true, AFTER_DRAIN = false;
    const float* RS; bf16_t* ACT;
    __device__ __forceinline__ void operator()(const f32x4 (&acc)[2][2][4][2], const Unit& u, int wr, int wc, int fr, int fq) const {
        const int row0 = u.pm * BM + wr * 64 + fr, f0 = u.pn * HALF + wc * 32 + 8 * fq;
#pragma unroll
        for (int ai = 0; ai < 2; ++ai)
#pragma unroll
            for (int m = 0; m < 4; ++m) { const int t = row0 + ai * HALF + m * 16;
                const f32x4* rp = (const f32x4*)(RS + (size_t)t * 16); const f32x4 a = rp[0], b = rp[1], c = rp[2], d = rp[3];
                const float tot = ((a[0] + a[1]) + (a[2] + a[3])) + ((b[0] + b[1]) + (b[2] + b[3])) + ((c[0] + c[1]) + (c[2] + c[3])) + ((d[0] + d[1]) + (d[2] + d[3]));
                const float rs = __builtin_amdgcn_rsqf(tot * (1.f / 1024.f) + 1e-6f);
                f32x4 o[2];
#pragma unroll
                for (int n = 0; n < 2; ++n) { const f32x4 g = acc[ai][0][m][n] * rs, up = acc[ai][1][m][n] * rs; o[n] = g * sigm4(g) * up; }
                *(u32x4*)(ACT + (size_t)t * 2816 + f0) = pack8(o[0], o[1]); }
    }
};
struct EpiDownF {
    static constexpr bool PERM = false, AFTER_DRAIN = false;
    float* out;
    __device__ __forceinline__ void operator()(const f32x4 (&acc)[2][2][4][2], const Unit& u, int wr, int wc, int fr, int fq) const {
        const int row0 = u.pm * BM + wr * 64 + fr, col0 = u.pn * BM + wc * 32 + 4 * fq;
#pragma unroll
        for (int ai = 0; ai < 2; ++ai)
#pragma unroll
            for (int m = 0; m < 4; ++m) { float* rowp = out + (size_t)(row0 + ai * HALF + m * 16) * 1024 + col0;
#pragma unroll
                for (int bj = 0; bj < 2; ++bj)
#pragma unroll
                    for (int n = 0; n < 2; ++n) { f32x4* p = (f32x4*)(rowp + bj * HALF + n * 16); *p = *p + acc[ai][bj][m][n]; } }
    }
};
struct EpiSlocF {
    static constexpr bool PERM = false, AFTER_DRAIN = false;
    float* SLOC;
    __device__ __forceinline__ void operator()(const f32x4 (&acc)[2][2][4][2], const Unit& u, int wr, int wc, int fr, int fq) const {
        const int row0 = u.pm * BM + wr * 64 + fr, col0 = wc * 32 + 4 * fq;
#pragma unroll
        for (int ai = 0; ai < 2; ++ai)
#pragma unroll
            for (int m = 0; m < 4; ++m)
#pragma unroll
                for (int n = 0; n < 2; ++n) *(f32x4*)(SLOC + (size_t)(row0 + ai * HALF + m * 16) * 128 + col0 + n * 16) = acc[ai][0][m][n];
    }
};
__device__ __forceinline__ float gelu_t(float x) { const float w = 1.5957691216057308f * (x + 0.044715f * x * x * x); return x * __builtin_amdgcn_rcpf(1.f + __expf(-w)); }
struct EpiS5YF {
    static constexpr bool PERM = true, AFTER_DRAIN = false;
    const bf16_t* U; const float* dskip; bf16_t* Y;
    __device__ __forceinline__ void operator()(const f32x4 (&acc)[2][2][4][2], const Unit& u, int wr, int wc, int fr, int fq) const {
        const int row0 = u.pm * BM + wr * 64 + fr;
#pragma unroll
        for (int bj = 0; bj < 2; ++bj) {
            const int cl = (u.pn & 1) * BM + bj * HALF + wc * 32 + 8 * fq, s = cl >> 4, co0 = cl & 15;
#pragma unroll
            for (int ai = 0; ai < 2; ++ai)
#pragma unroll
                for (int m = 0; m < 4; ++m) { const int row = row0 + ai * HALF + m * 16, g = row >> 9, R = row & 511, b = R >> 6, ch = R & 63, t = b * 2048 + ch * 32 + s;
                    f32x4 u0, u1; unpack8(*(const u32x4*)(U + (size_t)row * 640 + s * 16 + co0), u0, u1);
                    const f32x4 d0 = *(const f32x4*)(dskip + g * 16 + co0), d1 = *(const f32x4*)(dskip + g * 16 + co0 + 4);
                    f32x4 y0 = acc[ai][bj][m][0] + d0 * u0, y1 = acc[ai][bj][m][1] + d1 * u1;
#pragma unroll
                    for (int e = 0; e < 4; ++e) { y0[e] = gelu_t(y0[e]); y1[e] = gelu_t(y1[e]); }
                    *(u32x4*)(Y + (size_t)t * 512 + g * 16 + co0) = pack8(y0, y1); }
        }
    }
};
struct SubsetOrder { StaticOrder so; bool active;
    __device__ void init(int M, int N, int Gsub, int csub) { so.init(M, N, Gsub, csub < 0 ? 0 : csub); active = csub >= 0 && csub < Gsub; }
    __device__ bool next(int i, Unit& u) const { return active && so.next(i, u); }
    __device__ __forceinline__ void a_ready(const Unit&) const {}
    __device__ __forceinline__ void done(const Unit&) const {} };
struct S5Order1 { int c;
    __device__ bool next(int i, Unit& u) const { if (i > 0 || c < 0 || c >= 64) return false; u.pm = c; u.pn = c >> 1; return true; }
    __device__ __forceinline__ void a_ready(const Unit&) const {}
    __device__ __forceinline__ void done(const Unit&) const {} };
struct S5Order2 { int c;
    __device__ bool next(int i, Unit& u) const { if (i > 0 || c < 0 || c >= 128) return false; const int g = c >> 2; u.pm = g * 2 + ((c >> 1) & 1); u.pn = g * 2 + (c & 1); return true; }
    __device__ __forceinline__ void a_ready(const Unit&) const {}
    __device__ __forceinline__ void done(const Unit&) const {} };
}
#define GAS __attribute__((address_space(1)))
#define LAS __attribute__((address_space(3)))
typedef unsigned short bf16;
typedef unsigned v4u __attribute__((ext_vector_type(4)));
typedef float f32x4 __attribute__((ext_vector_type(4)));
typedef short bf16x8 __attribute__((ext_vector_type(8)));
typedef GAS unsigned gu32;
typedef GAS unsigned long long gu64;
#define RLX_AGENT __ATOMIC_RELAXED, __HIP_MEMORY_SCOPE_AGENT
#define LDS_WAIT() asm volatile("s_waitcnt lgkmcnt(0)" ::: "memory")
#define VM_WAIT() asm volatile("s_waitcnt vmcnt(0)" ::: "memory")
__device__ __forceinline__ unsigned long long rt() { return __builtin_amdgcn_s_memrealtime(); }
__device__ __forceinline__ unsigned f2bf(float f) { unsigned u = __builtin_bit_cast(unsigned, f); return (u + 0x7fffu + ((u >> 16) & 1u)) >> 16; }
__device__ __forceinline__ unsigned pk2(float lo, float hi) { return f2bf(lo) | (f2bf(hi) << 16); }

#define XB_TMO      128
#define XB_XCNT(j)  (256  + 64 * (j))
#define XB_XSUB(j)  (1280 + 64 * (j))
#define XB_XGEN(j)  (2304 + 64 * (j))
#define XB_TOP      3328
#define XB_TOPGEN   3392
#define XCD_BAR_WORDS 3456
#define XB_SPIN_CAP (1u << 18)

__device__ __forceinline__ unsigned xb_ld(unsigned* p)              { return __hip_atomic_load(p, __ATOMIC_RELAXED, __HIP_MEMORY_SCOPE_AGENT); }
__device__ __forceinline__ unsigned xb_add(unsigned* p, unsigned v) { return __hip_atomic_fetch_add(p, v, __ATOMIC_RELAXED, __HIP_MEMORY_SCOPE_AGENT); }
__device__ __forceinline__ unsigned xb_xcc_id() { return (unsigned)__builtin_amdgcn_s_getreg((3 << 11) | 20) & 0xFu; }
#define XB_SPIN(cond, bar) do { unsigned _sp = 0; while (cond) { __builtin_amdgcn_s_sleep(1); \
    if ((++_sp & 255u) == 0u) { if (xb_ld(&(bar)[XB_TMO])) break; if (_sp > XB_SPIN_CAP) { atomicAdd(&(bar)[XB_TMO], 1u); break; } } } } while (0)

struct XcdBarrier {
    unsigned* bar; unsigned x;
    volatile LAS unsigned* st;
};

__device__ __forceinline__ XcdBarrier xcd_barrier_post(unsigned* bar, volatile LAS unsigned* st, bool leader) {
    XcdBarrier b; b.bar = bar; b.x = xb_xcc_id(); b.st = st;
    if (leader) (void)xb_add(&bar[XB_XCNT(b.x)], 1u);
    return b;
}
__device__ __forceinline__ void xcd_barrier_complete(unsigned* bar, unsigned x, unsigned& nloc, unsigned& nx) {
    const unsigned G = gridDim.x * gridDim.y * gridDim.z;
    unsigned sum, cnt, mine, sp = 0u;
    for (;;) {
        sum = 0u; cnt = 0u; mine = 0u;
#pragma unroll
        for (unsigned j = 0; j < 16; ++j) { const unsigned c = xb_ld(&bar[XB_XCNT(j)]); sum += c; cnt += (c > 0u) ? 1u : 0u; mine = (j == x) ? c : mine; }
        if (sum == G) break;
        __builtin_amdgcn_s_sleep(1);
        if ((++sp & 255u) == 0u) { if (xb_ld(&bar[XB_TMO])) break; if (sp > XB_SPIN_CAP) { atomicAdd(&bar[XB_TMO], 1u); break; } }
    }
    nloc = mine > 0u ? mine : 1u; nx = cnt > 0u ? cnt : 1u;
}

__device__ __forceinline__ void xcd_barrier(const XcdBarrier& b, bool leader) {
    asm volatile("s_waitcnt vmcnt(0)" ::: "memory");
    __syncthreads();
    if (leader) {
        unsigned* bar = b.bar;
        __builtin_amdgcn_s_waitcnt(0);
        unsigned nloc = b.st[0], nx = b.st[1];
        if (nloc == 0u) { xcd_barrier_complete(bar, b.x, nloc, nx); b.st[0] = nloc; b.st[1] = nx; }
        const unsigned old = xb_add(&bar[XB_XSUB(b.x)], 1u);
        const unsigned gen = old / nloc;
        if (old + 1u == (gen + 1u) * nloc) {
            __builtin_amdgcn_fence(__ATOMIC_RELEASE, "agent");
            asm volatile("s_waitcnt vmcnt(0)" ::: "memory");
            const unsigned og = xb_add(&bar[XB_TOP], 1u);
            const unsigned tg = og / nx;
            if (og + 1u == (tg + 1u) * nx) xb_add(&bar[XB_TOPGEN], 1u);
            else XB_SPIN(xb_ld(&bar[XB_TOPGEN]) == tg, bar);
            __builtin_amdgcn_fence(__ATOMIC_ACQUIRE, "agent");
            xb_add(&bar[XB_XGEN(b.x)], 1u);
            asm volatile("s_waitcnt vmcnt(0)" ::: "memory");
        } else {
            XB_SPIN(xb_ld(&bar[XB_XGEN(b.x)]) == gen, bar);
            __builtin_amdgcn_fence(__ATOMIC_ACQUIRE, "agent");
            asm volatile("s_waitcnt vmcnt(0)" ::: "memory");
        }
    }
    __syncthreads();
}
constexpr int NWAVES = 8, NTHR = 512;
constexpr int RING_OFF = 0, RING_BYTES = 131072;
constexpr int LDSCTL_OFF = RING_BYTES, MISC_OFF = LDSCTL_OFF + 320;
constexpr int LDS_BYTES = 147456;
constexpr size_t CTL_ZERO_BYTES = 1 * MiB;
constexpr int CW_TMO = 0, CW_BAR = 4096;
constexpr int NPH = 9;
constexpr int FL_NO_DSA = 1, FL_NO_CROSS = 2, FL_NO_S5 = 4;
constexpr size_t WS_LAM32 = WS_BIASL + 8192;

struct Args { const float* in[29]; float* out; unsigned char* ws; int ph_lo, ph_hi, flags, li; };

__device__ __forceinline__ float wave_sum(float v) {
#pragma unroll
    for (int o = 1; o < 64; o <<= 1) v += __shfl_xor(v, o);
    return v;
}
__device__ __forceinline__ float p0_src(int mode, const float* W, const float* W2, const float* gain, int N, int k, int d) {
    if (mode == 0) return W[(size_t)k * N + d];
    if (mode == 1) { if (d >= 1736 && d < 1792) return 0.f; const int s = d >= 1792 ? d - 56 : d; return W[(size_t)k * N + s]; }
    const int tile = d >> 8, w = d & 255, f = tile * 128 + (w & 127); return ((w < 128) ? W : W2)[(size_t)k * N + f] * gain[k];
}
__device__ __forceinline__ void p0_transpose_item(int mode, const float* W, const float* W2, const float* gain, int K, int N, int ND, bf16* WT, LAS float* scr, int item, int lane) {
    const int nblk = ND / 32, kb = item / nblk, nb = item % nblk, k0 = 64 * kb, d0 = 32 * nb;
    float tv[32];
#pragma unroll
    for (int i = 0; i < 32; ++i) tv[i] = p0_src(mode, W, W2, gain, N, k0 + 2 * i + (lane >> 5), d0 + (lane & 31));
#pragma unroll
    for (int i = 0; i < 32; ++i) scr[(2 * i + (lane >> 5)) * 33 + (lane & 31)] = tv[i];
    LDS_WAIT(); asm volatile("" ::: "memory");
    const int c = lane & 7;
#pragma unroll
    for (int j = 0; j < 4; ++j) { const int n = (lane >> 3) + 8 * j; const LAS float* s = scr + (8 * c) * 33 + n;
        v4u o; o.x = pk2(s[0 * 33], s[1 * 33]); o.y = pk2(s[2 * 33], s[3 * 33]); o.z = pk2(s[4 * 33], s[5 * 33]); o.w = pk2(s[6 * 33], s[7 * 33]);
        *(GAS v4u*)(WT + (size_t)(d0 + n) * K + k0 + 8 * c) = o; }
    LDS_WAIT(); asm volatile("" ::: "memory");
}
__device__ __forceinline__ void rms_row_to_bf16(const float* xrow, const float* g, bf16* orow, int lane) {
    const GAS f32x4* xr = (const GAS f32x4*)xrow + lane; const GAS f32x4* gr = (const GAS f32x4*)g + lane;
    f32x4 v[4]; float s = 0.f;
#pragma unroll
    for (int j = 0; j < 4; ++j) { v[j] = xr[64 * j]; s += (v[j].x * v[j].x + v[j].y * v[j].y) + (v[j].z * v[j].z + v[j].w * v[j].w); }
    const float rstd = 1.f / sqrtf(wave_sum(s) * (1.f / 1024.f) + 1e-6f);
    GAS unsigned long long* o8 = (GAS unsigned long long*)orow + lane;
#pragma unroll
    for (int j = 0; j < 4; ++j) { const f32x4 gg = gr[64 * j];
        o8[64 * j] = (unsigned long long)pk2(v[j].x * rstd * gg.x, v[j].y * rstd * gg.y) | ((unsigned long long)pk2(v[j].z * rstd * gg.z, v[j].w * rstd * gg.w) << 32); }
}
__device__ __forceinline__ int t5_bucket(int n) {
    if (n < 16) return n;
    const int large = 16 + (int)((logf((float)n / 16.f) / 2.0794415416798357f) * 16.f);
    return large < 31 ? large : 31;
}
__device__ __forceinline__ void p0_s5_tables(int g, int part, const Args& a, LAS unsigned char* lds, int tid) {
    typedef float f32x2v __attribute__((ext_vector_type(2)));
    LAS f32x2v* POW = (LAS f32x2v*)lds;
    LAS f32x2v* BB = POW + 33 * 64;
    LAS f32x2v* CC = BB + 64 * 16;
    LAS float* KT = (LAS float*)(CC + 16 * 64);
    const float *a_re = a.in[8], *a_im = a.in[9], *log_dt = a.in[10], *b_re = a.in[11], *b_im = a.in[12], *c_re = a.in[13], *c_im = a.in[14];
    bf16* TV = (bf16*)(a.ws + WS_S5TV) + (size_t)g * 512 * 640; bf16* Wt = (bf16*)(a.ws + WS_S5W) + (size_t)g * 256 * 512; float* LAM32 = (float*)(a.ws + WS_LAM32) + g * 128;
    const double dt = exp((double)log_dt[g]);
    for (int idx = tid; idx < 33 * 64; idx += NTHR) { const int j = idx >> 6, n = idx & 63; const double lr = a_re[g * 64 + n], li = a_im[g * 64 + n];
        const double mag = exp(lr * dt * j), ang = li * dt * j; POW[idx] = (f32x2v){(float)(mag * cos(ang)), (float)(mag * sin(ang))}; }
    for (int idx = tid; idx < 64 * 16; idx += NTHR) { const int n = idx >> 4, c = idx & 15; const double lr = a_re[g * 64 + n], li = a_im[g * 64 + n];
        const double mag = exp(lr * dt), lbr = mag * cos(li * dt), lbi = mag * sin(li * dt), nr = lbr - 1.0, ni = lbi, den = lr * lr + li * li;
        const double fr = (nr * lr + ni * li) / den, fi = (ni * lr - nr * li) / den, br = b_re[(g * 64 + n) * 16 + c], bi = b_im[(g * 64 + n) * 16 + c];
        BB[idx] = (f32x2v){(float)(fr * br - fi * bi), (float)(fr * bi + fi * br)};
        const int c2 = idx >> 6, n2 = idx & 63; CC[idx] = (f32x2v){c_re[(g * 16 + c2) * 64 + n2], c_im[(g * 16 + c2) * 64 + n2]}; }
    __syncthreads();
    if (part == 0 && tid < 64) { const f32x2v p = POW[32 * 64 + tid]; LAM32[tid * 2] = p.x; LAM32[tid * 2 + 1] = p.y; }
    for (int idx = tid; idx < 32 * 32; idx += NTHR) { const int j = idx >> 5, co = 2 * part + ((idx >> 4) & 1), ci = idx & 15; float s = 0.f;
#pragma unroll 2
        for (int n = 0; n < 64; ++n) { const f32x2v c = CC[co * 64 + n], p = POW[j * 64 + n], b = BB[n * 16 + ci];
            const float cpr = c.x * p.x - c.y * p.y, cpi = c.x * p.y + c.y * p.x; s += cpr * b.x - cpi * b.y; }
        KT[j * 256 + co * 16 + ci] = s; }
    __syncthreads();
    for (int id = tid; id < 64 * 80; id += NTHR) { const int rl = id / 80, c8 = id % 80, so = rl >> 1, co = 2 * part + (rl & 1), row = so * 16 + co; float v[8];
        if (c8 < 64) { const int si = c8 >> 1, ci0 = (c8 & 1) * 8;
#pragma unroll
            for (int e = 0; e < 8; ++e) v[e] = so >= si ? KT[(so - si) * 256 + co * 16 + ci0 + e] : 0.f; }
        else {
#pragma unroll
            for (int e = 0; e < 8; ++e) { const int np = (c8 - 64) * 8 + e, n = np & 63; const f32x2v c = CC[co * 64 + n], p = POW[(so + 1) * 64 + n];
                v[e] = np < 64 ? (c.x * p.x - c.y * p.y) : -(c.x * p.y + c.y * p.x); } }
        v4u o; o.x = pk2(v[0], v[1]); o.y = pk2(v[2], v[3]); o.z = pk2(v[4], v[5]); o.w = pk2(v[6], v[7]);
        *(GAS v4u*)(TV + (size_t)row * 640 + c8 * 8) = o; }
    for (int id = tid; id < 16 * 64; id += NTHR) { const int np = 16 * part + (id >> 6), c8 = id & 63, n = np & 63, s = c8 >> 1, ci0 = (c8 & 1) * 8; const f32x2v p = POW[(31 - s) * 64 + n]; float v[8];
#pragma unroll
        for (int e = 0; e < 8; ++e) { const f32x2v b = BB[n * 16 + ci0 + e]; v[e] = np < 64 ? (p.x * b.x - p.y * b.y) : (p.x * b.y + p.y * b.x); }
        v4u o; o.x = pk2(v[0], v[1]); o.y = pk2(v[2], v[3]); o.z = pk2(v[4], v[5]); o.w = pk2(v[6], v[7]);
        *(GAS v4u*)(Wt + (size_t)np * 512 + c8 * 8) = o; }
    __syncthreads();
}
__device__ __forceinline__ void p0_prologue(const Args& a, LAS unsigned char* lds, int tid, int lane, int wave, int vcu, int G) {
    unsigned char* ws = a.ws;
    LAS float* scr = (LAS float*)(lds + RING_OFF + wave * 16384);
    const int gw = vcu * NWAVES + wave, NGW = G * NWAVES;
    p0_s5_tables(vcu >> 3, vcu & 7, a, lds, tid);
    if (blockIdx.x == 32) { float* BL = (float*)(ws + WS_BIASL); const float* rb = a.in[2];
        for (int i = tid; i < 8 * 128 + 8; i += NTHR) { if (i < 1024) { const int h = i >> 7, d = i & 127; BL[i] = rb[t5_bucket(d) * 8 + h] * 1.4426950408889634f; } else BL[i] = rb[31 * 8 + (i - 1024)] * 1.4426950408889634f; } }
    { bf16* WUV = (bf16*)(ws + WS_WUV); const float* w = a.in[7];
        for (int i = blockIdx.x * NTHR + tid; i < 8 * 64 * 128; i += G * NTHR) { const int h = i >> 13, e = (i >> 7) & 63, d = i & 127; WUV[i] = (bf16)f2bf(w[(h * 128 + d) * 64 + e]); } }
    constexpr int I_IN = 16 * 184, I_MKV = 16 * 32, I_GLU = 8 * 16, I_BR = 8 * 32, I_OUT = 16 * 32, I_GU = 16 * 176, I_D = 44 * 32;
    constexpr int NITEMS = I_IN + I_MKV + I_GLU + 3 * I_BR + I_OUT + I_GU + I_D;
    for (int it = gw; it < NITEMS; it += NGW) {
        int r = it;
        if (r < I_IN) { p0_transpose_item(1, a.in[3], nullptr, nullptr, 1024, 5832, 5888, (bf16*)(ws + WS_WIN), scr, r, lane); continue; } r -= I_IN;
        if (r < I_MKV) { p0_transpose_item(0, a.in[18], nullptr, nullptr, 1024, 1024, 1024, (bf16*)(ws + WS_WMKV), scr, r, lane); continue; } r -= I_MKV;
        if (r < I_GLU) { p0_transpose_item(0, a.in[16], nullptr, nullptr, 512, 512, 512, (bf16*)(ws + WS_WGLU), scr, r, lane); continue; } r -= I_GLU;
        if (r < 3 * I_BR) { const int br = r / I_BR; p0_transpose_item(0, a.in[21 + br], nullptr, nullptr, 512, 1024, 1024, (bf16*)(ws + WS_WBR) + (size_t)br * 1024 * 512, scr, r % I_BR, lane); continue; } r -= 3 * I_BR;
        if (r < I_OUT) { p0_transpose_item(0, a.in[24], nullptr, nullptr, 1024, 1024, 1024, (bf16*)(ws + WS_WOUT), scr, r, lane); continue; } r -= I_OUT;
        if (r < I_GU) { p0_transpose_item(2, a.in[26], a.in[27], a.in[25], 1024, 2816, 5632, (bf16*)(ws + WS_WGU), scr, r, lane); continue; } r -= I_GU;
        p0_transpose_item(0, a.in[28], nullptr, nullptr, 2816, 1024, 1024, (bf16*)(ws + WS_WD), scr, r, lane);
    }
    for (int m = gw; m < T_TOK; m += 2 * NGW) {
        const GAS f32x4* x0 = (const GAS f32x4*)(a.in[0] + (size_t)m * 1024) + lane; const GAS f32x4* x1 = (const GAS f32x4*)(a.in[0] + (size_t)(m + NGW) * 1024) + lane; const GAS f32x4* gr = (const GAS f32x4*)a.in[4] + lane;
        f32x4 v0[4], v1[4]; float s0 = 0.f, s1 = 0.f;
#pragma unroll
        for (int j = 0; j < 4; ++j) { v0[j] = x0[64 * j]; v1[j] = x1[64 * j]; }
#pragma unroll
        for (int j = 0; j < 4; ++j) { s0 += (v0[j].x * v0[j].x + v0[j].y * v0[j].y) + (v0[j].z * v0[j].z + v0[j].w * v0[j].w); s1 += (v1[j].x * v1[j].x + v1[j].y * v1[j].y) + (v1[j].z * v1[j].z + v1[j].w * v1[j].w); }
        const float r0 = 1.f / sqrtf(wave_sum(s0) * (1.f / 1024.f) + 1e-6f), r1 = 1.f / sqrtf(wave_sum(s1) * (1.f / 1024.f) + 1e-6f);
        GAS unsigned long long* o0 = (GAS unsigned long long*)((bf16*)(ws + WS_H) + (size_t)m * 1024) + lane; GAS unsigned long long* o1 = (GAS unsigned long long*)((bf16*)(ws + WS_H) + (size_t)(m + NGW) * 1024) + lane;
#pragma unroll
        for (int j = 0; j < 4; ++j) { const f32x4 gg = gr[64 * j];
            o0[64 * j] = (unsigned long long)pk2(v0[j].x * r0 * gg.x, v0[j].y * r0 * gg.y) | ((unsigned long long)pk2(v0[j].z * r0 * gg.z, v0[j].w * r0 * gg.w) << 32);
            o1[64 * j] = (unsigned long long)pk2(v1[j].x * r1 * gg.x, v1[j].y * r1 * gg.y) | ((unsigned long long)pk2(v1[j].z * r1 * gg.z, v1[j].w * r1 * gg.w) << 32); }
    }
    for (int m = gw; m < 2048; m += NGW) rms_row_to_bf16(a.in[1] + (size_t)m * 1024, a.in[17], (bf16*)(ws + WS_MEMN) + (size_t)m * 1024, lane);
}
__device__ __forceinline__ void norm128_pass(bf16* X, int rows, int ld, int ngroups, const float* g, int gtid, int nthr) {
    const int l = gtid & 15, total = rows * ngroups;
    for (int gid = gtid >> 4; gid < total; gid += nthr >> 4) {
        const int r = gid / ngroups, gi = gid % ngroups;
        bf16* p = X + (size_t)r * ld + gi * 128 + l * 8;
        const v4u v = *(const GAS v4u*)p; float f[8];
        f[0] = __uint_as_float(v.x << 16); f[1] = __uint_as_float(v.x & 0xffff0000u); f[2] = __uint_as_float(v.y << 16); f[3] = __uint_as_float(v.y & 0xffff0000u);
        f[4] = __uint_as_float(v.z << 16); f[5] = __uint_as_float(v.z & 0xffff0000u); f[6] = __uint_as_float(v.w << 16); f[7] = __uint_as_float(v.w & 0xffff0000u);
        float s = 0.f;
#pragma unroll
        for (int q = 0; q < 8; ++q) s += f[q] * f[q];
        s += __shfl_xor(s, 8); s += __shfl_xor(s, 4); s += __shfl_xor(s, 2); s += __shfl_xor(s, 1);
        const float rs = 1.f / sqrtf(s * (1.f / 128.f) + 1e-6f);
        const f32x4 g0 = *(const GAS f32x4*)(g + l * 8), g1 = *(const GAS f32x4*)(g + l * 8 + 4);
        v4u o; o.x = pk2(f[0] * rs * g0.x, f[1] * rs * g0.y); o.y = pk2(f[2] * rs * g0.z, f[3] * rs * g0.w); o.z = pk2(f[4] * rs * g1.x, f[5] * rs * g1.y); o.w = pk2(f[6] * rs * g1.z, f[7] * rs * g1.w);
        *(GAS v4u*)p = o;
    }
}
__device__ __forceinline__ void s5_scan(int g, int half, const Args& a, int tid) {
    if (tid < 256) {
        const int bl = tid >> 6, n = tid & 63, b = half * 4 + bl;
        const float* LAM32 = (const float*)(a.ws + WS_LAM32) + g * 128; const float lr = LAM32[n * 2], li = LAM32[n * 2 + 1];
        const float* SL = (const float*)(a.ws + WS_SLOC) + ((size_t)(g * 512 + b * 64)) * 128; bf16* Ur = (bf16*)(a.ws + WS_U) + ((size_t)(g * 512 + b * 64)) * 640 + 512;
        float xr = 0.f, xi = 0.f;
        for (int ch = 0; ch < 64; ++ch) {
            Ur[(size_t)ch * 640 + n] = (bf16)f2bf(xr); Ur[(size_t)ch * 640 + 64 + n] = (bf16)f2bf(xi);
            const float sr = SL[(size_t)ch * 128 + n], si = SL[(size_t)ch * 128 + 64 + n];
            const float nr = lr * xr - li * xi + sr, ni = lr * xi + li * xr + si; xr = nr; xi = ni;
        }
    }
    VM_WAIT(); __syncthreads();
}
namespace nv {
typedef unsigned short bf16;
__device__ __forceinline__ unsigned f2bf(float f) { unsigned u = __float_as_uint(f); return (u + 0x7fffu + ((u >> 16) & 1u)) >> 16; }
__device__ __forceinline__ float bf2f(unsigned short b) { return __uint_as_float((unsigned)b << 16); }

__global__ void k_transpose(const float* __restrict__ W, const float* __restrict__ W2, const float* __restrict__ gain,
                            bf16* __restrict__ WT, int K, int N, int ND, int mode) {
    const size_t total = (size_t)ND * K;
    for (size_t i = (size_t)blockIdx.x * blockDim.x + threadIdx.x; i < total; i += (size_t)gridDim.x * blockDim.x) {
        const int d = (int)(i / K), k = (int)(i % K);
        float v;
        if (mode == 0) v = W[(size_t)k * N + d];
        else if (mode == 1) { if (d >= 1736 && d < 1792) v = 0.f; else { const int s = d >= 1792 ? d - 56 : d; v = W[(size_t)k * N + s]; } }
        else { const int tile = d >> 8, w = d & 255, f = tile * 128 + (w & 127); v = ((w < 128) ? W : W2)[(size_t)k * N + f] * gain[k]; }
        WT[i] = (bf16)f2bf(v);
    }
}
__global__ void k_wuv(const float* __restrict__ W, bf16* __restrict__ WT) {
    const int i = blockIdx.x * blockDim.x + threadIdx.x; if (i >= 8 * 64 * 128) return;
    const int h = i / (64 * 128), e = (i / 128) % 64, d = i % 128;
    WT[i] = (bf16)f2bf(W[(h * 128 + d) * 64 + e]);
}
__global__ void k_rmsnorm1024(const float* __restrict__ x, const float* __restrict__ g, bf16* __restrict__ out, int rows) {
    __shared__ float red[4];
    const int r = blockIdx.x; if (r >= rows) return;
    const float4 v = ((const float4*)(x + (size_t)r * 1024))[threadIdx.x];
    float s = v.x * v.x + v.y * v.y + v.z * v.z + v.w * v.w;
    for (int o = 32; o; o >>= 1) s += __shfl_xor(s, o);
    if ((threadIdx.x & 63) == 0) red[threadIdx.x >> 6] = s;
    __syncthreads();
    const float tot = red[0] + red[1] + red[2] + red[3];
    const float rs = rsqrtf(tot * (1.f / 1024.f) + 1e-6f);
    const float4 gg = ((const float4*)g)[threadIdx.x];
    bf16* o = out + (size_t)r * 1024 + threadIdx.x * 4;
    o[0] = (bf16)f2bf(v.x * rs * gg.x); o[1] = (bf16)f2bf(v.y * rs * gg.y); o[2] = (bf16)f2bf(v.z * rs * gg.z); o[3] = (bf16)f2bf(v.w * rs * gg.w);
}
__device__ __forceinline__ int t5_bucket(int n) {
    if (n < 16) return n;
    const float nf = (float)n;
    int large = 16 + (int)((logf(nf / 16.f) / 2.0794415416798357f) * 16.f);
    return large < 31 ? large : 31;
}
__global__ void k_biaslut(const float* __restrict__ rel_bias, float* __restrict__ BL) {
    const int i = blockIdx.x * blockDim.x + threadIdx.x;
    if (i < 8 * 128) { const int h = i / 128, d = i % 128; BL[i] = rel_bias[t5_bucket(d) * 8 + h] * 1.4426950408889634f; }
    else if (i < 8 * 128 + 8) { const int h = i - 8 * 128; BL[i] = rel_bias[31 * 8 + h] * 1.4426950408889634f; }
}

template <class Epi>
__global__ void __launch_bounds__(256) k_gemm(const bf16* __restrict__ A, const bf16* __restrict__ Bt, int M, int N, int K, Epi epi) {
    const int tx = threadIdx.x & 15, ty = threadIdx.x >> 4;
    const int n0 = (blockIdx.x * 16 + tx) * 4, m0 = (blockIdx.y * 16 + ty) * 4;
    if (n0 >= N || m0 >= M) return;
    float acc[4][4];
#pragma unroll
    for (int i = 0; i < 4; ++i)
#pragma unroll
        for (int j = 0; j < 4; ++j) acc[i][j] = 0.f;
    for (int k = 0; k < K; k += 8) {
        uint4 a[4], b[4];
#pragma unroll
        for (int i = 0; i < 4; ++i) { a[i] = *(const uint4*)(A + (size_t)(m0 + i) * K + k); b[i] = *(const uint4*)(Bt + (size_t)(n0 + i) * K + k); }
#pragma unroll
        for (int i = 0; i < 4; ++i) {
            const unsigned aw[4] = {a[i].x, a[i].y, a[i].z, a[i].w};
#pragma unroll
            for (int j = 0; j < 4; ++j) {
                const unsigned bw[4] = {b[j].x, b[j].y, b[j].z, b[j].w};
#pragma unroll
                for (int q = 0; q < 4; ++q) {
                    acc[i][j] += __uint_as_float(aw[q] << 16) * __uint_as_float(bw[q] << 16);
                    acc[i][j] += __uint_as_float(aw[q] & 0xffff0000u) * __uint_as_float(bw[q] & 0xffff0000u);
                }
            }
        }
    }
#pragma unroll
    for (int i = 0; i < 4; ++i)
#pragma unroll
        for (int j = 0; j < 4; ++j) epi(m0 + i, n0 + j, acc[i][j]);
}

struct EpiInproj {
    bf16 *QD, *CKV, *QI, *KI, *U, *QX; float* WI;
    __device__ void operator()(int t, int c, float v) const {
        if (c < 1024) QD[(size_t)t * 1024 + c] = (bf16)f2bf(v);
        else if (c < 1152) CKV[(size_t)t * 128 + (c - 1024)] = (bf16)f2bf(v);
        else if (c < 1664) QI[(size_t)t * 512 + (c - 1152)] = (bf16)f2bf(v);
        else if (c < 1728) KI[(size_t)t * 64 + (c - 1664)] = (bf16)f2bf(v);
        else if (c < 1792) { if (c < 1736) WI[(size_t)t * 8 + (c - 1728)] = v; }
        else if (c < 2304) { const int cu = c - 1792, g = cu >> 4, ci = cu & 15, b = t >> 11, tt = t & 2047, R = b * 64 + (tt >> 5), s = tt & 31;
            U[((size_t)(g * 512 + R)) * 640 + s * 16 + ci] = (bf16)f2bf(v); }
        else QX[(size_t)t * 512 + (c - 2304)] = (bf16)f2bf(v);
    }
};
struct EpiBf16Split { bf16* O0; bf16* O1; int split; int ld;
    __device__ void operator()(int m, int c, float v) const { if (c < split) O0[(size_t)m * ld + c] = (bf16)f2bf(v); else O1[(size_t)m * ld + (c - split)] = (bf16)f2bf(v); } };
struct EpiGlu { const bf16* Y; bf16* O;
    __device__ void operator()(int m, int c, float v) const { const float y = bf2f(Y[(size_t)m * 512 + c]); O[(size_t)m * 512 + c] = (bf16)f2bf(y / (1.f + __expf(-v))); } };
struct EpiSigmoid { bf16* G; __device__ void operator()(int m, int c, float v) const { G[(size_t)m * 1024 + c] = (bf16)f2bf(1.f / (1.f + __expf(-v))); } };
struct EpiMerge { const bf16* G; bf16* MG; int first; int pad;
    __device__ void operator()(int m, int c, float v) const { const size_t i = (size_t)m * 1024 + c; float p = first ? 0.f : bf2f(MG[i]); MG[i] = (bf16)f2bf(p + bf2f(G[i]) * v); } };
struct EpiOut { const float* x; float* x1; bf16* XN;
    __device__ void operator()(int m, int c, float v) const { const size_t i = (size_t)m * 1024 + c; const float r = x[i] + v; x1[i] = r; XN[i] = (bf16)f2bf(r); } };
struct EpiDown { float* out;
    __device__ void operator()(int m, int c, float v) const { const size_t i = (size_t)m * 1024 + c; out[i] = out[i] + v; } };
struct EpiF32 { float* C; int ld; __device__ void operator()(int m, int c, float v) const { C[(size_t)m * ld + c] = v; } };

__global__ void k_rowss(const float* __restrict__ x1, float* __restrict__ RS) {
    const int t = blockIdx.x, q = threadIdx.x >> 6, l = threadIdx.x & 63;
    const float4 v = ((const float4*)(x1 + (size_t)t * 1024 + q * 256))[l];
    float s = v.x * v.x + v.y * v.y + v.z * v.z + v.w * v.w;
    for (int o = 32; o; o >>= 1) s += __shfl_xor(s, o);
    if (l == 0) RS[t * 16 + q] = s;
    if (l >= 4 && l < 16 && q == 0) RS[t * 16 + l] = 0.f;
}
__global__ void __launch_bounds__(256) k_gemm_gu(const bf16* __restrict__ A, const bf16* __restrict__ Bt, const float* __restrict__ RS, bf16* __restrict__ ACT) {
    const int K = 1024;
    const int tx = threadIdx.x & 15, ty = threadIdx.x >> 4;
    const int f0 = (blockIdx.x * 16 + tx) * 4, m0 = (blockIdx.y * 16 + ty) * 4;
    float ag[4][4], au[4][4];
#pragma unroll
    for (int i = 0; i < 4; ++i)
#pragma unroll
        for (int j = 0; j < 4; ++j) { ag[i][j] = 0.f; au[i][j] = 0.f; }
    for (int k = 0; k < K; k += 8) {
        uint4 a[4], bg[4], bu[4];
#pragma unroll
        for (int i = 0; i < 4; ++i) { a[i] = *(const uint4*)(A + (size_t)(m0 + i) * K + k);
            const int f = f0 + i, rg = (f >> 7) * 256 + (f & 127);
            bg[i] = *(const uint4*)(Bt + (size_t)rg * K + k); bu[i] = *(const uint4*)(Bt + (size_t)(rg + 128) * K + k); }
#pragma unroll
        for (int i = 0; i < 4; ++i) {
            const unsigned aw[4] = {a[i].x, a[i].y, a[i].z, a[i].w};
#pragma unroll
            for (int j = 0; j < 4; ++j) {
                const unsigned gw[4] = {bg[j].x, bg[j].y, bg[j].z, bg[j].w};
                const unsigned uw[4] = {bu[j].x, bu[j].y, bu[j].z, bu[j].w};
#pragma unroll
                for (int q = 0; q < 4; ++q) {
                    const float alo = __uint_as_float(aw[q] << 16), ahi = __uint_as_float(aw[q] & 0xffff0000u);
                    ag[i][j] += alo * __uint_as_float(gw[q] << 16); ag[i][j] += ahi * __uint_as_float(gw[q] & 0xffff0000u);
                    au[i][j] += alo * __uint_as_float(uw[q] << 16); au[i][j] += ahi * __uint_as_float(uw[q] & 0xffff0000u);
                }
            }
        }
    }
#pragma unroll
    for (int i = 0; i < 4; ++i) { const int m = m0 + i;
        float tot = 0.f; for (int q = 0; q < 16; ++q) tot += RS[m * 16 + q];
        const float rs = rsqrtf(tot * (1.f / 1024.f) + 1e-6f);
#pragma unroll
        for (int j = 0; j < 4; ++j) { const float g = ag[i][j] * rs, u = au[i][j] * rs;
            ACT[(size_t)m * 2816 + f0 + j] = (bf16)f2bf(g / (1.f + __expf(-g)) * u); } }
}

__global__ void k_norm128(bf16* __restrict__ X, int rows, int ld, int ngroups, const float* __restrict__ g) {
    const int gid = (blockIdx.x * blockDim.x + threadIdx.x) >> 4, l = threadIdx.x & 15;
    const bool ok = gid < rows * ngroups;
    const int r = ok ? gid / ngroups : 0, gi = ok ? gid % ngroups : 0;
    bf16* p = X + (size_t)r * ld + gi * 128 + l * 8;
    uint4 v = *(const uint4*)p; const unsigned w[4] = {v.x, v.y, v.z, v.w};
    float f[8];
#pragma unroll
    for (int q = 0; q < 4; ++q) { f[2 * q] = __uint_as_float(w[q] << 16); f[2 * q + 1] = __uint_as_float(w[q] & 0xffff0000u); }
    float s = 0.f;
#pragma unroll
    for (int q = 0; q < 8; ++q) s += f[q] * f[q];
    for (int o = 8; o; o >>= 1) s += __shfl_xor(s, o);
    const float rs = rsqrtf(s * (1.f / 128.f) + 1e-6f);
    unsigned o4[4];
#pragma unroll
    for (int q = 0; q < 4; ++q) o4[q] = f2bf(f[2 * q] * rs * g[l * 8 + 2 * q]) | (f2bf(f[2 * q + 1] * rs * g[l * 8 + 2 * q + 1]) << 16);
    if (ok) *(uint4*)p = make_uint4(o4[0], o4[1], o4[2], o4[3]);
}

__global__ void __launch_bounds__(256) k_dsa(const bf16* __restrict__ QD, const bf16* __restrict__ CKV, const bf16* __restrict__ QI, const bf16* __restrict__ KI,
                                             const float* __restrict__ WI, const float* __restrict__ BL, const bf16* __restrict__ WUVT, bf16* __restrict__ ODSA) {
    __shared__ float sc[2048];
    __shared__ float qi[512];
    __shared__ float qd[1024];
    __shared__ float wh[8];
    __shared__ int sel[256];
    __shared__ float pr[256];
    __shared__ float ov[128];
    __shared__ float red[8];
    __shared__ int nsel;
    const int row = blockIdx.x, b = row >> 11, t = row & 2047, tid = threadIdx.x;
    for (int i = tid; i < 512; i += 256) qi[i] = bf2f(QI[(size_t)row * 512 + i]);
    for (int i = tid; i < 1024; i += 256) qd[i] = bf2f(QD[(size_t)row * 1024 + i]);
    if (tid < 8) wh[tid] = WI[(size_t)row * 8 + tid];
    if (tid == 0) nsel = 0;
    __syncthreads();
    const int nk = t + 1;
    for (int s = tid; s < nk; s += 256) {
        const bf16* kp = KI + ((size_t)(b * 2048 + s)) * 64;
        float kf[64];
#pragma unroll
        for (int d = 0; d < 64; ++d) kf[d] = bf2f(kp[d]);
        float score = 0.f;
        for (int h = 0; h < 8; ++h) { float dsum = 0.f;
#pragma unroll
            for (int d = 0; d < 64; ++d) dsum += qi[h * 64 + d] * kf[d];
            score += fmaxf(dsum, 0.f) * wh[h]; }
        sc[s] = score;
    }
    __syncthreads();
    for (int s = tid; s < nk; s += 256) {
        bool take;
        if (nk <= 256) take = true;
        else { const float v = sc[s]; int cnt = 0;
            for (int s2 = 0; s2 < nk; ++s2) { const float w = sc[s2]; cnt += (w > v || (w == v && s2 < s)) ? 1 : 0; }
            take = cnt < 256; }
        if (take) { const int p = atomicAdd(&nsel, 1); if (p < 256) sel[p] = s; }
    }
    __syncthreads();
    const int ns = nsel < 256 ? nsel : 256;
    const float scale = 0.08838834764831845f * 1.4426950408889634f;
    for (int h = 0; h < 8; ++h) {
        float lg = -INFINITY;
        if (tid < ns) { const int s = sel[tid]; const bf16* cp = CKV + ((size_t)(b * 2048 + s)) * 128; float dsum = 0.f;
            for (int d = 0; d < 128; ++d) dsum += qd[h * 128 + d] * bf2f(cp[d]);
            const int dist = t - s; const float bias = dist < 128 ? BL[h * 128 + dist] : BL[8 * 128 + h];
            lg = dsum * scale + bias; }
        float m = lg; for (int o = 32; o; o >>= 1) m = fmaxf(m, __shfl_xor(m, o));
        if ((tid & 63) == 0) red[tid >> 6] = m;
        __syncthreads();
        m = fmaxf(fmaxf(red[0], red[1]), fmaxf(red[2], red[3]));
        const float p = (tid < ns) ? exp2f(lg - m) : 0.f;
        float sum = p; for (int o = 32; o; o >>= 1) sum += __shfl_xor(sum, o);
        if ((tid & 63) == 0) red[4 + (tid >> 6)] = sum;
        pr[tid] = p;
        __syncthreads();
        sum = red[4] + red[5] + red[6] + red[7];
        if (tid < 128) { float o = 0.f; for (int k = 0; k < ns; ++k) o += pr[k] * bf2f(CKV[((size_t)(b * 2048 + sel[k])) * 128 + tid]); ov[tid] = o / sum; }
        __syncthreads();
        if (tid < 64) { float o = 0.f; const bf16* wp = WUVT + ((size_t)(h * 64 + tid)) * 128; for (int d = 0; d < 128; ++d) o += ov[d] * bf2f(wp[d]);
            ODSA[(size_t)row * 512 + h * 64 + tid] = (bf16)f2bf(o); }
        __syncthreads();
    }
}

__global__ void __launch_bounds__(256) k_cross(const bf16* __restrict__ QX, const bf16* __restrict__ KX, const bf16* __restrict__ VX, bf16* __restrict__ OX) {
    __shared__ float q[512]; __shared__ float pr[256]; __shared__ float red[8];
    const int row = blockIdx.x, b = row >> 11, tid = threadIdx.x;
    for (int i = tid; i < 512; i += 256) q[i] = bf2f(QX[(size_t)row * 512 + i]);
    __syncthreads();
    const float scale = 0.08838834764831845f * 1.4426950408889634f;
    for (int h = 0; h < 4; ++h) {
        const bf16* kp = KX + ((size_t)(b * 256 + tid)) * 512 + h * 128; float dsum = 0.f;
        for (int d = 0; d < 128; ++d) dsum += q[h * 128 + d] * bf2f(kp[d]);
        const float lg = dsum * scale;
        float m = lg; for (int o = 32; o; o >>= 1) m = fmaxf(m, __shfl_xor(m, o));
        if ((tid & 63) == 0) red[tid >> 6] = m;
        __syncthreads();
        m = fmaxf(fmaxf(red[0], red[1]), fmaxf(red[2], red[3]));
        const float p = exp2f(lg - m);
        float sum = p; for (int o = 32; o; o >>= 1) sum += __shfl_xor(sum, o);
        if ((tid & 63) == 0) red[4 + (tid >> 6)] = sum;
        pr[tid] = p;
        __syncthreads();
        sum = red[4] + red[5] + red[6] + red[7];
        if (tid < 128) { float o = 0.f; for (int k = 0; k < 256; ++k) o += pr[k] * bf2f(VX[((size_t)(b * 256 + k)) * 512 + h * 128 + tid]);
            OX[(size_t)row * 512 + h * 128 + tid] = (bf16)f2bf(o / sum); }
        __syncthreads();
    }
}

__device__ __forceinline__ float gelu_tanh(float x) { const float u = 0.7978845608028654f * (x + 0.044715f * x * x * x); return 0.5f * x * (1.f + tanhf(u)); }
__global__ void __launch_bounds__(64) k_s5(const bf16* __restrict__ U, const float* __restrict__ a_re, const float* __restrict__ a_im, const float* __restrict__ log_dt,
                                           const float* __restrict__ b_re, const float* __restrict__ b_im, const float* __restrict__ c_re, const float* __restrict__ c_im,
                                           const float* __restrict__ d_skip, bf16* __restrict__ Y) {
    const int b = blockIdx.x >> 5, g = blockIdx.x & 31, n = threadIdx.x;
    const double dt = exp((double)log_dt[g]);
    const double lr = (double)a_re[g * 64 + n], li = (double)a_im[g * 64 + n];
    const double mag = exp(lr * dt), lbr = mag * cos(li * dt), lbi = mag * sin(li * dt);
    const double nr = lbr - 1.0, ni = lbi, den = lr * lr + li * li;
    const double fr = (nr * lr + ni * li) / den, fi = (ni * lr - nr * li) / den;
    float Bre[16], Bim[16], Cre[16], Cim[16];
#pragma unroll
    for (int c = 0; c < 16; ++c) { const double br = b_re[(g * 64 + n) * 16 + c], bi = b_im[(g * 64 + n) * 16 + c];
        Bre[c] = (float)(fr * br - fi * bi); Bim[c] = (float)(fr * bi + fi * br);
        Cre[c] = c_re[(g * 16 + c) * 64 + n]; Cim[c] = c_im[(g * 16 + c) * 64 + n]; }
    const float ar = (float)lbr, ai = (float)lbi;
    const float dsk = n < 16 ? d_skip[g * 16 + n] : 0.f;
    float xr = 0.f, xi = 0.f;
    for (int t = 0; t < 2048; ++t) {
        const int R = b * 64 + (t >> 5), s = t & 31;
        const bf16* up = U + ((size_t)(g * 512 + R)) * 640 + s * 16;
        float u[16]; float bur = 0.f, bui = 0.f;
#pragma unroll
        for (int c = 0; c < 16; ++c) { u[c] = bf2f(up[c]); bur += Bre[c] * u[c]; bui += Bim[c] * u[c]; }
        const float nxr = ar * xr - ai * xi + bur, nxi = ar * xi + ai * xr + bui; xr = nxr; xi = nxi;
        float yout = 0.f;
#pragma unroll
        for (int c = 0; c < 16; ++c) { float v = Cre[c] * xr - Cim[c] * xi;
            for (int o = 32; o; o >>= 1) v += __shfl_xor(v, o);
            if (n == c) yout = v + dsk * u[c]; }
        if (n < 16) Y[(size_t)(b * 2048 + t) * 512 + g * 16 + n] = (bf16)f2bf(gelu_tanh(yout));
    }
}
}
#define HAVE_ATTN 1
namespace att {
typedef float f32x16 __attribute__((ext_vector_type(16)));
typedef short s16x4 __attribute__((ext_vector_type(4)));
typedef short v4i16_t __attribute__((ext_vector_type(4)));
typedef float f32x2_t __attribute__((ext_vector_type(2))); typedef __bf16 bf16x2_t __attribute__((ext_vector_type(2)));
typedef unsigned u32x2 __attribute__((ext_vector_type(2)));
#define MFMA32(a, b, c) __builtin_amdgcn_mfma_f32_32x32x16_bf16((a), (b), (c), 0, 0, 0)
__device__ __forceinline__ unsigned cvtpk(float lo, float hi) { const f32x2_t v = {lo, hi}; const bf16x2_t b = __builtin_convertvector(v, bf16x2_t); return __builtin_bit_cast(unsigned, b); }
__device__ __forceinline__ int crow(int r, int hi) { return (r & 3) + 8 * (r >> 2) + 4 * hi; }
__device__ __forceinline__ unsigned off_b(unsigned row, unsigned ch) { return 256u * row + 16u * (ch ^ (((row & 3u) << 2) | ((row >> 2) & 3u))); }
__device__ __forceinline__ float xh_max(float v) { const auto rr = __builtin_amdgcn_permlane32_swap(__float_as_uint(v), __float_as_uint(v), false, false); return fmaxf(__uint_as_float(rr[0]), __uint_as_float(rr[1])); }
__device__ __forceinline__ float xh_sum(float v) { const auto rr = __builtin_amdgcn_permlane32_swap(__float_as_uint(v), __float_as_uint(v), false, false); return __uint_as_float(rr[0]) + __uint_as_float(rr[1]); }
__device__ __forceinline__ unsigned xh_sumu(unsigned v) { const auto rr = __builtin_amdgcn_permlane32_swap(v, v, false, false); return rr[0] + rr[1]; }
__device__ __forceinline__ unsigned xh_or(unsigned v) { const auto rr = __builtin_amdgcn_permlane32_swap(v, v, false, false); return rr[0] | rr[1]; }
constexpr float SCALE2 = 0.08838834764831845f * 1.4426950408889634f;

__device__ __forceinline__ bf16x8 pack_step(const f32x16& x, int s) {
    v4u p; p.x = cvtpk(x[8 * s], x[8 * s + 1]); p.y = cvtpk(x[8 * s + 2], x[8 * s + 3]); p.z = cvtpk(x[8 * s + 4], x[8 * s + 5]); p.w = cvtpk(x[8 * s + 6], x[8 * s + 7]);
    return __builtin_bit_cast(bf16x8, p);
}
__device__ __forceinline__ void qk_tile(f32x16& p0, f32x16& p1, LAS const unsigned char* kimg, const bf16x8 (&qf)[8], int lane) {
    const unsigned r32 = lane & 31, hi = lane >> 5;
    f32x16 z;
#pragma unroll
    for (int r = 0; r < 16; ++r) z[r] = 0.f;
    p0 = z; p1 = z;
#pragma unroll
    for (int s = 0; s < 8; ++s) {
        const unsigned o = off_b(r32, 2 * s + hi);
        const bf16x8 a0 = *(LAS const bf16x8*)(kimg + o), a1 = *(LAS const bf16x8*)(kimg + o + 32 * 256);
        p0 = MFMA32(a0, qf[s], p0); p1 = MFMA32(a1, qf[s], p1);
        if (s & 1) asm volatile("" ::: "memory");
    }
}
__device__ __forceinline__ s16x4 vtr(LAS const unsigned char* p) { return __builtin_bit_cast(s16x4, __builtin_amdgcn_ds_read_tr16_b64_v4i16((LAS v4i16_t*)p)); }
__device__ __forceinline__ void pv_tile(f32x16 (&o)[4], LAS const unsigned char* vimg, const bf16x8 (&pf)[4], int lane) {
    const unsigned hi = lane >> 5, blk = (lane >> 4) & 1, q = (lane & 15) >> 2, p = lane & 3;
#pragma unroll
    for (int c = 0; c < 4; ++c)
#pragma unroll
        for (int ks = 0; ks < 4; ++ks) {
            const unsigned ch = 4 * c + 2 * blk + (p >> 1), rlo = 16 * ks + 4 * hi + q;
            const s16x4 lo = vtr(vimg + off_b(rlo, ch) + 8 * (p & 1)), h4 = vtr(vimg + off_b(rlo + 8, ch) + 8 * (p & 1));
            const bf16x8 af = {lo[0], lo[1], lo[2], lo[3], h4[0], h4[1], h4[2], h4[3]};
            o[c] = MFMA32(af, pf[ks], o[c]);
            if (ks == 3) asm volatile("" ::: "memory");
        }
}
__device__ __forceinline__ void softmax_step(f32x16& p0, f32x16& p1, float& m, float& l, f32x16 (&o)[4], bf16x8 (&pf)[4]) {
    float mx = fmaxf(p0[0], p1[0]);
#pragma unroll
    for (int r = 1; r < 16; ++r) mx = fmaxf(mx, fmaxf(p0[r], p1[r]));
    mx = xh_max(mx);
    const float mnew = fmaxf(m, mx), muse = (mnew == -INFINITY) ? 0.f : mnew;
    const float alpha = __builtin_amdgcn_exp2f(m - muse);
    float s = 0.f;
#pragma unroll
    for (int r = 0; r < 16; ++r) { p0[r] = __builtin_amdgcn_exp2f(p0[r] - muse); p1[r] = __builtin_amdgcn_exp2f(p1[r] - muse); s += p0[r] + p1[r]; }
    l = l * alpha + s; m = mnew;
    if (__any(alpha != 1.f)) {
#pragma unroll
        for (int c = 0; c < 4; ++c)
#pragma unroll
            for (int r = 0; r < 16; ++r) o[c][r] *= alpha;
    }
    pf[0] = pack_step(p0, 0); pf[1] = pack_step(p0, 1); pf[2] = pack_step(p1, 0); pf[3] = pack_step(p1, 1);
}
__device__ __forceinline__ void tile_load(v4u (&rg)[2], const bf16* src, int pitch, int tid) {
#pragma unroll
    for (int i = 0; i < 2; ++i) { const int id = tid + 512 * i, row = id >> 4, ch = id & 15; rg[i] = *(const GAS v4u*)(src + (size_t)row * pitch + ch * 8); }
}
__device__ __forceinline__ void tile_store(const v4u (&rg)[2], LAS unsigned char* img, int tid) {
#pragma unroll
    for (int i = 0; i < 2; ++i) { const int id = tid + 512 * i, row = id >> 4, ch = id & 15; *(LAS v4u*)(img + off_b(row, ch)) = rg[i]; }
}

__device__ __forceinline__ void cross_item(const Args& a, LAS unsigned char* lds, int tid, int lane, int wave, int item) {
    const int r32 = lane & 31, hi = lane >> 5;
    const int b = item >> 5, hx = (item >> 3) & 3, qblk = item & 7;
    const bf16* QX = (const bf16*)(a.ws + WS_QX); const bf16* KX = (const bf16*)(a.ws + WS_KX) + (size_t)b * 256 * 512 + hx * 128; const bf16* VX = (const bf16*)(a.ws + WS_VX) + (size_t)b * 256 * 512 + hx * 128;
    bf16* OX = (bf16*)(a.ws + WS_OX);
    const size_t row = (size_t)b * 2048 + qblk * 256 + wave * 32 + r32;
    bf16x8 qf[8];
#pragma unroll
    for (int s = 0; s < 8; ++s) qf[s] = *(const GAS bf16x8*)(QX + row * 512 + hx * 128 + 16 * s + 8 * hi);
    f32x16 o[4];
#pragma unroll
    for (int c = 0; c < 4; ++c)
#pragma unroll
        for (int r = 0; r < 16; ++r) o[c][r] = 0.f;
    float m = -INFINITY, l = 0.f;
    v4u kr[2], vr[2];
    tile_load(kr, KX, 512, tid); tile_load(vr, VX, 512, tid);
    tile_store(kr, lds, tid); tile_store(vr, lds + 32768, tid);
    __syncthreads();
#pragma unroll 1
    for (int kt = 0; kt < 4; ++kt) {
        LAS unsigned char* kimg = lds + (kt & 1) * 16384; LAS unsigned char* vimg = lds + 32768 + (kt & 1) * 16384;
        if (kt + 1 < 4) { tile_load(kr, KX + (size_t)(kt + 1) * 64 * 512, 512, tid); tile_load(vr, VX + (size_t)(kt + 1) * 64 * 512, 512, tid); }
        f32x16 p0, p1; qk_tile(p0, p1, kimg, qf, lane);
#pragma unroll
        for (int r = 0; r < 16; ++r) { p0[r] *= SCALE2; p1[r] *= SCALE2; }
        bf16x8 pf[4]; softmax_step(p0, p1, m, l, o, pf);
        pv_tile(o, vimg, pf, lane);
        if (kt + 1 < 4) { tile_store(kr, lds + ((kt + 1) & 1) * 16384, tid); tile_store(vr, lds + 32768 + ((kt + 1) & 1) * 16384, tid); }
        __syncthreads();
    }
    l = xh_sum(l);
    const float inv = 1.f / l;
#pragma unroll
    for (int c = 0; c < 4; ++c)
#pragma unroll
        for (int g4 = 0; g4 < 4; ++g4) { u32x2 w; w.x = cvtpk(o[c][4 * g4] * inv, o[c][4 * g4 + 1] * inv); w.y = cvtpk(o[c][4 * g4 + 2] * inv, o[c][4 * g4 + 3] * inv);
            *(GAS u32x2*)(OX + row * 512 + hx * 128 + 32 * c + 8 * g4 + 4 * hi) = w; }
}
__device__ __forceinline__ void cross_phase(const Args& a, LAS unsigned char* lds, int tid, int lane, int wave, int bx, int G) {
    if (bx < 128) return;
#pragma unroll 1
    for (int i = 0; i < 2; ++i) cross_item(a, lds, tid, lane, wave, (bx - 128) * 2 + i);
}

constexpr int DSA_QI = 0, DSA_QPITCH = 1040, DSA_CT = 36864, DSA_MASK = DSA_CT + 32768, DSA_CNT = DSA_MASK + 32 * 65 * 4, DSA_BT = DSA_CNT + 2 * 256 * 4, DSA_END = DSA_BT + 8 * 320 * 4;
static_assert(DSA_END <= RING_BYTES, "DSA LDS map");
__device__ __forceinline__ unsigned f2key(float x) { const unsigned b = __float_as_uint(x + 0.f); return (b & 0x80000000u) ? ~b : (b | 0x80000000u); }

__device__ __forceinline__ void cnt_ge(unsigned& cnt, unsigned key, unsigned cand) { asm volatile("v_cmp_ge_u32 vcc, %1, %2\n\tv_addc_co_u32_e32 %0, vcc, 0, %0, vcc" : "+v"(cnt) : "v"(key), "v"(cand) : "vcc"); }
__device__ __forceinline__ void cnt_gt(unsigned& cnt, unsigned key, unsigned cand) { asm volatile("v_cmp_gt_u32 vcc, %1, %2\n\tv_addc_co_u32_e32 %0, vcc, 0, %0, vcc" : "+v"(cnt) : "v"(key), "v"(cand) : "vcc"); }
__device__ __forceinline__ void cnt_eq(unsigned& cnt, unsigned key, unsigned cand) { asm volatile("v_cmp_eq_u32 vcc, %1, %2\n\tv_addc_co_u32_e32 %0, vcc, 0, %0, vcc" : "+v"(cnt) : "v"(key), "v"(cand) : "vcc"); }
__device__ __forceinline__ void cnt4_ge(unsigned& c0, unsigned& c1, unsigned& c2, unsigned& c3, unsigned k0, unsigned k1, unsigned k2, unsigned k3, unsigned cand) {
    unsigned long long m0, m1, m2;
    asm volatile("v_cmp_ge_u32 %4, %7, %11\n\tv_cmp_ge_u32 %5, %8, %11\n\tv_cmp_ge_u32 %6, %9, %11\n\tv_cmp_ge_u32 vcc, %10, %11\n\t"
                 "v_addc_co_u32_e64 %0, %4, 0, %0, %4\n\tv_addc_co_u32_e64 %1, %5, 0, %1, %5\n\tv_addc_co_u32_e64 %2, %6, 0, %2, %6\n\tv_addc_co_u32_e32 %3, vcc, 0, %3, vcc"
                 : "+v"(c0), "+v"(c1), "+v"(c2), "+v"(c3), "=&s"(m0), "=&s"(m1), "=&s"(m2) : "v"(k0), "v"(k1), "v"(k2), "v"(k3), "v"(cand) : "vcc");
}
template <int IB> __device__ __forceinline__ void cnt_tie_lt(unsigned& cnt, unsigned key, unsigned thr, unsigned lanepart, unsigned cand) { unsigned t;
    asm volatile("v_add_u32_e32 %1, %6, %4\n\tv_cmp_eq_u32 vcc, %2, %3\n\tv_cndmask_b32_e32 %1, -1, %1, vcc\n\tv_cmp_lt_u32 vcc, %1, %5\n\tv_addc_co_u32_e32 %0, vcc, 0, %0, vcc"
                 : "+v"(cnt), "=&v"(t) : "v"(key), "v"(thr), "v"(lanepart), "v"(cand), "i"(IB) : "vcc"); }
template <int IB, int BR> __device__ __forceinline__ void mask_sel(unsigned& w, unsigned key, unsigned thr, unsigned lanepart, unsigned istar, unsigned onehi) { unsigned t, bit;
    asm volatile("v_lshlrev_b32_e32 %2, %8, %7\n\tv_cmp_gt_u32 vcc, %3, %4\n\tv_cndmask_b32_e32 %1, 0, %2, vcc\n\tv_or_b32_e32 %0, %0, %1\n\t"
                 "v_add_u32_e32 %1, %9, %5\n\tv_cmp_le_u32 vcc, %1, %6\n\tv_cndmask_b32_e32 %1, 0, %2, vcc\n\tv_cmp_eq_u32 vcc, %3, %4\n\tv_cndmask_b32_e32 %1, 0, %1, vcc\n\tv_or_b32_e32 %0, %0, %1"
                 : "+v"(w), "=&v"(t), "=&v"(bit) : "v"(key), "v"(thr), "v"(lanepart), "v"(istar), "v"(onehi), "i"(BR), "i"(IB) : "vcc"); }

#define CRB(r) (((r) & 3) + 8 * ((r) >> 2))
#define TIE1(i, r) cnt_tie_lt<256 * (i) + CRB(r)>(cnt, key[i][r], thr, lanepart, cand);
#define TIE_ROW(i) TIE1(i,0) TIE1(i,1) TIE1(i,2) TIE1(i,3) TIE1(i,4) TIE1(i,5) TIE1(i,6) TIE1(i,7) TIE1(i,8) TIE1(i,9) TIE1(i,10) TIE1(i,11) TIE1(i,12) TIE1(i,13) TIE1(i,14) TIE1(i,15)
#define SEL1(i, r) mask_sel<256 * (i) + CRB(r), CRB(r)>(w, key[i][r], thr, lanepart, istar, onehi);
#define SEL_ROW(i) SEL1(i,0) SEL1(i,1) SEL1(i,2) SEL1(i,3) SEL1(i,4) SEL1(i,5) SEL1(i,6) SEL1(i,7) SEL1(i,8) SEL1(i,9) SEL1(i,10) SEL1(i,11) SEL1(i,12) SEL1(i,13) SEL1(i,14) SEL1(i,15)
__device__ __forceinline__ unsigned row_total(unsigned cnt, LAS unsigned* CNT, int& par, int r32, int hi, int wave) {
    cnt = xh_sumu(cnt);
    if (hi == 0) CNT[par * 256 + r32 * 8 + wave] = cnt;
    __syncthreads();
    const v4u x = *(LAS const v4u*)(CNT + par * 256 + r32 * 8), y = *(LAS const v4u*)(CNT + par * 256 + r32 * 8 + 4);
    par ^= 1;
    return (x.x + x.y) + (x.z + x.w) + (y.x + y.y) + (y.z + y.w);
}
template <int MODE> __device__ __forceinline__ void dsa_item(const Args& a, LAS unsigned char* lds, int tid, int lane, int wave, int b, int qb) {
    const int r32 = lane & 31, hi = lane >> 5;
    const int t0 = qb * 32; const size_t rowb = (size_t)b * 2048;
    const bool sel = qb >= 8;
    const bf16* QD = (const bf16*)(a.ws + WS_QD); const bf16* CKV = (const bf16*)(a.ws + WS_CKV) + rowb * 128; const bf16* QI = (const bf16*)(a.ws + WS_QI); const bf16* KI = (const bf16*)(a.ws + WS_KI) + rowb * 64;
    const float* WI = (const float*)(a.ws + WS_WI); const float* BL = (const float*)(a.ws + WS_BIASL); const bf16* WUV = (const bf16*)(a.ws + WS_WUV); bf16* ODSA = (bf16*)(a.ws + WS_ODSA);
    LAS unsigned* MASK = (LAS unsigned*)(lds + DSA_MASK); LAS unsigned* CNT = (LAS unsigned*)(lds + DSA_CNT);
    const int NT = qb + 1;
    if (MODE != 1 && sel) {
#pragma unroll
        for (int i = 0; i < 4; ++i) { const int id = tid + 512 * i, row = id >> 6, ch = id & 63;
            *(LAS v4u*)(lds + DSA_QI + row * DSA_QPITCH + ch * 16) = *(const GAS v4u*)(QI + (rowb + t0 + row) * 512 + ch * 8); }
        for (int i = tid; i < 32 * 65; i += NTHR) MASK[i] = 0u;
        __syncthreads();
        float wq[8];
        { const f32x4 w0 = *(const GAS f32x4*)(WI + (rowb + t0 + r32) * 8), w1 = *(const GAS f32x4*)(WI + (rowb + t0 + r32) * 8 + 4);
          wq[0] = w0.x; wq[1] = w0.y; wq[2] = w0.z; wq[3] = w0.w; wq[4] = w1.x; wq[5] = w1.y; wq[6] = w1.z; wq[7] = w1.w; }
        unsigned key[8][16];
        LAS const unsigned char* qbase = lds + DSA_QI + r32 * DSA_QPITCH + hi * 16;
        const bf16* kbase = KI + (size_t)r32 * 64 + 8 * hi;
        bf16x8 kf[4], kn[4];
        if (wave < NT) {
#pragma unroll
            for (int kk = 0; kk < 4; ++kk) kf[kk] = *(const GAS bf16x8*)(kbase + (size_t)wave * 2048 + 16 * kk);
        }
#define SC_HEAD(hh, dst) { _Pragma("unroll") for (int r = 0; r < 16; ++r) dst[r] = 0.f; \
            _Pragma("unroll") for (int kk = 0; kk < 4; ++kk) { const bf16x8 qf = *(LAS const bf16x8*)(qbase + ((hh) * 8 + 2 * kk) * 16); dst = MFMA32(kf[kk], qf, dst); } }
#define SC_ACC(hh, src) { _Pragma("unroll") for (int r = 0; r < 16; ++r) sacc[r] += fmaxf(src[r], 0.f) * wq[hh]; \
            _Pragma("unroll") for (int r = 0; r < 16; ++r) asm volatile("" : "+v"(sacc[r])); }
#define SC_TILE(i) { const int j = wave + 8 * (i); \
            if (j < NT) { \
                if (j + 8 < NT) { _Pragma("unroll") for (int kk = 0; kk < 4; ++kk) kn[kk] = *(const GAS bf16x8*)(kbase + (size_t)(j + 8) * 2048 + 16 * kk); }     \
                f32x16 sacc, da, db; \
                _Pragma("unroll") for (int r = 0; r < 16; ++r) sacc[r] = 0.f; \
                SC_HEAD(0, da) SC_HEAD(1, db) SC_ACC(0, da) SC_HEAD(2, da) SC_ACC(1, db) SC_HEAD(3, db) SC_ACC(2, da) SC_HEAD(4, da) SC_ACC(3, db) \
                SC_HEAD(5, db) SC_ACC(4, da) SC_HEAD(6, da) SC_ACC(5, db) SC_HEAD(7, db) SC_ACC(6, da) SC_ACC(7, db) \
                _Pragma("unroll") for (int r = 0; r < 16; ++r) { const bool vis = (j < NT - 1) || (crow(r, hi) <= r32); key[i][r] = vis ? f2key(sacc[r]) : 0u; } \
                _Pragma("unroll") for (int kk = 0; kk < 4; ++kk) kf[kk] = kn[kk]; \
            } else { _Pragma("unroll") for (int r = 0; r < 16; ++r) key[i][r] = 0u; } }
        SC_TILE(0) SC_TILE(1) SC_TILE(2) SC_TILE(3) SC_TILE(4) SC_TILE(5) SC_TILE(6) SC_TILE(7)
#undef SC_TILE
#undef SC_ACC
#undef SC_HEAD
        int par = 0; unsigned thr = 0u; bool found = false; const unsigned lanepart = 32u * (unsigned)wave + 4u * (unsigned)hi, onehi = 1u << (4 * hi);
        if constexpr (MODE == 3) { thr = key[0][0] ^ key[7][15]; }
        else
#pragma unroll 1
        for (int bit = 31; bit >= 0; --bit) {
            const unsigned cand = thr | (1u << bit); unsigned c0 = 0u, c1 = 0u, c2 = 0u, c3 = 0u;
#pragma unroll
            for (int i = 0; i < 8; ++i)
#pragma unroll
                for (int r = 0; r < 16; r += 4) cnt4_ge(c0, c1, c2, c3, key[i][r], key[i][r + 1], key[i][r + 2], key[i][r + 3], cand);
            const unsigned tot = row_total((c0 + c1) + (c2 + c3), CNT, par, r32, hi, wave);
            if (!found && tot >= 256u) thr = cand;
            found = found || (tot == 256u);
            if (__all(found)) break;
        }
        unsigned cgt = 0u, ceq = 0u;
#pragma unroll
        for (int i = 0; i < 8; ++i)
#pragma unroll
            for (int r = 0; r < 16; ++r) { cnt_gt(cgt, key[i][r], thr); cnt_eq(ceq, key[i][r], thr); }
        const unsigned tgt = row_total(cgt, CNT, par, r32, hi, wave), teq = row_total(ceq, CNT, par, r32, hi, wave);
        const unsigned need = 256u - tgt;
        unsigned istar = 0x7fffffffu;
        if (__any(row_total(teq > need ? 1u : 0u, CNT, par, r32, hi, wave) != 0u)) {
            unsigned lo = 0u;
#pragma unroll 1
            for (int bit = 10; bit >= 0; --bit) {
                const unsigned cand = lo | (1u << bit); unsigned cnt = 0u;
                TIE_ROW(0) TIE_ROW(1) TIE_ROW(2) TIE_ROW(3) TIE_ROW(4) TIE_ROW(5) TIE_ROW(6) TIE_ROW(7)
                if (row_total(cnt, CNT, par, r32, hi, wave) < need) lo = cand;
            }
            istar = lo;
        }
#define SEL_TILE(i) { const int j = wave + 8 * (i); if (j < NT) { unsigned w = 0u; SEL_ROW(i) w = xh_or(w); if (hi == 0) MASK[r32 * 65 + j] = w; } }
        SEL_TILE(0) SEL_TILE(1) SEL_TILE(2) SEL_TILE(3) SEL_TILE(4) SEL_TILE(5) SEL_TILE(6) SEL_TILE(7)
#undef SEL_TILE
        __syncthreads();
    }
    if constexpr (MODE == 0 || MODE == 1) {
    const int h = wave; const int tq = t0 + r32; const size_t qrow = rowb + t0 + r32;
    bf16x8 qf[8];
#pragma unroll
    for (int s = 0; s < 8; ++s) qf[s] = *(const GAS bf16x8*)(QD + qrow * 1024 + h * 128 + 16 * s + 8 * hi);
    const float c31 = BL[1024 + h];
    f32x16 o[4];
#pragma unroll
    for (int c = 0; c < 4; ++c)
#pragma unroll
        for (int r = 0; r < 16; ++r) o[c][r] = 0.f;
    float m = -INFINITY, l = 0.f;
    const int NKT = (t0 + 32 + 63) >> 6;
    v4u cr[2];
    tile_load(cr, CKV, 128, tid); tile_store(cr, lds + DSA_CT, tid);
    __syncthreads();
#pragma unroll 1
    for (int kt = 0; kt < NKT; ++kt) {
        LAS unsigned char* cimg = lds + DSA_CT + (kt & 1) * 16384;
        if (kt + 1 < NKT) tile_load(cr, CKV + (size_t)(kt + 1) * 64 * 128, 128, tid);
        f32x16 p0, p1; qk_tile(p0, p1, cimg, qf, lane);
        const int k0 = 64 * kt;
        const bool far = (t0 - k0 - 63) >= 128;
        unsigned mv0, mv1;
        if (sel) { mv0 = MASK[r32 * 65 + 2 * kt] >> (4 * hi); mv1 = MASK[r32 * 65 + 2 * kt + 1] >> (4 * hi); }
        else { const int d0 = tq - k0 - 4 * hi, d1 = d0 - 32;
            mv0 = d0 < 0 ? 0u : (d0 >= 31 ? 0x0f0f0f0fu : (0x0f0f0f0fu & ((2u << d0) - 1u)));
            mv1 = d1 < 0 ? 0u : (d1 >= 31 ? 0x0f0f0f0fu : (0x0f0f0f0fu & ((2u << d1) - 1u))); }
        if (far) {
#pragma unroll
            for (int r = 0; r < 16; ++r) { p0[r] = ((mv0 >> CRB(r)) & 1u) ? p0[r] * SCALE2 + c31 : -INFINITY; p1[r] = ((mv1 >> CRB(r)) & 1u) ? p1[r] * SCALE2 + c31 : -INFINITY; }
        } else {
            LAS const float* bt = (LAS const float*)(lds + DSA_BT) + h * 320 + (255 - (tq - k0 - 4 * hi));
#pragma unroll
            for (int r = 0; r < 16; ++r) { const float b0 = bt[CRB(r)], b1 = bt[32 + CRB(r)];
                p0[r] = ((mv0 >> CRB(r)) & 1u) ? p0[r] * SCALE2 + b0 : -INFINITY; p1[r] = ((mv1 >> CRB(r)) & 1u) ? p1[r] * SCALE2 + b1 : -INFINITY; }
        }
        bf16x8 pf[4]; softmax_step(p0, p1, m, l, o, pf);
        pv_tile(o, cimg, pf, lane);
        if (kt + 1 < NKT) tile_store(cr, lds + DSA_CT + ((kt + 1) & 1) * 16384, tid);
        __syncthreads();
    }
    l = xh_sum(l);
    const float inv = 1.f / l;
    bf16x8 of[8];
#pragma unroll
    for (int c = 0; c < 4; ++c) {
#pragma unroll
        for (int r = 0; r < 16; ++r) o[c][r] *= inv;
        of[2 * c] = pack_step(o[c], 0); of[2 * c + 1] = pack_step(o[c], 1);
    }
#pragma unroll
    for (int eb = 0; eb < 2; ++eb) {
        f32x16 acc;
#pragma unroll
        for (int r = 0; r < 16; ++r) acc[r] = 0.f;
        const bf16* wrow = WUV + (size_t)(h * 64 + 32 * eb + r32) * 128;
#pragma unroll
        for (int cs = 0; cs < 8; ++cs) {
            const s16x4 lo = *(const GAS s16x4*)(wrow + 16 * cs + 4 * hi), h4 = *(const GAS s16x4*)(wrow + 16 * cs + 8 + 4 * hi);
            const bf16x8 af = {lo[0], lo[1], lo[2], lo[3], h4[0], h4[1], h4[2], h4[3]};
            acc = MFMA32(af, of[cs], acc);
        }
#pragma unroll
        for (int g4 = 0; g4 < 4; ++g4) { u32x2 w; w.x = cvtpk(acc[4 * g4], acc[4 * g4 + 1]); w.y = cvtpk(acc[4 * g4 + 2], acc[4 * g4 + 3]);
            *(GAS u32x2*)(ODSA + qrow * 512 + h * 64 + 32 * eb + 8 * g4 + 4 * hi) = w; }
    }
    }
    __syncthreads();
}
template <int MODE = 0> __device__ __forceinline__ void dsa_phase(const Args& a, LAS unsigned char* lds, int wave, int bx, int G) {
    const int b = bx >> 5, p = bx & 31;
    { const float* BL = (const float*)(a.ws + WS_BIASL); LAS float* BT = (LAS float*)(lds + DSA_BT);
      for (int i = wave * 64 + my_lane_id(); i < 8 * 320; i += NTHR) { const int hh = i / 320, d = 255 - (i % 320); BT[i] = d < 0 ? 0.f : (d < 128 ? BL[hh * 128 + d] : BL[1024 + hh]); } }
    __syncthreads();
#pragma unroll 1
    for (int it = 0; it < 2; ++it) {
        const int lane = my_lane_id();
        dsa_item<MODE>(a, lds, wave * 64 + lane, lane, wave, b, it == 0 ? 63 - p : p);
    }
}
}
#define HAVE_DSA 1
using att::cross_phase;
__device__ __forceinline__ void dsa_phase(const Args& a, LAS unsigned char* lds, int wave, int bx, int G) { att::dsa_phase<0>(a, lds, wave, bx, G); }
__global__ void __launch_bounds__(NTHR, 2) mk_fwd(Args args) {
    extern __shared__ __attribute__((aligned(16))) unsigned char lds_raw[];
    LAS unsigned char* lds = (LAS unsigned char*)lds_raw;
    volatile LAS unsigned* MISC = (volatile LAS unsigned*)(lds + MISC_OFF);
    const int wave = __builtin_amdgcn_readfirstlane(threadIdx.x >> 6);
#define MYLANE() my_lane_id()
    const int G = gridDim.x, bx = blockIdx.x, vcu = (G % 8 == 0) ? (bx % 8) * (G / 8) + bx / 8 : bx;
    unsigned char* ws = args.ws;
    gu32* ctl = (gu32*)(ws + WS_CTL);
    { const int tid = wave * 64 + MYLANE();
      for (int u = tid; u < (LDS_BYTES - LDSCTL_OFF) / 4; u += NTHR) ((LAS unsigned*)(lds + LDSCTL_OFF))[u] = 0u; }
    __syncthreads();
    const int lo = args.ph_lo, hi = args.ph_hi;
    const bool multi = (hi - lo) > 1;
    XcdBarrier bar; bar.bar = (unsigned*)(ctl + CW_BAR) + args.li * XCD_BAR_WORDS; bar.x = 0; bar.st = nullptr;
    if (multi) bar = xcd_barrier_post((unsigned*)(ctl + CW_BAR) + args.li * XCD_BAR_WORDS, MISC + 8, wave == 0 && MYLANE() == 0);
#define IN(k) (lo <= (k) && (k) < hi)
#define RPT(k) ((args.flags >> (16 + (k))) & 1)
#define L1_INV_SYNC() do { VM_WAIT(); __builtin_amdgcn_fence(__ATOMIC_ACQUIRE, "agent"); VM_WAIT(); __syncthreads(); } while (0)
#define SEAM(k) do { if (IN(k) && IN((k) + 1)) xcd_barrier(bar, wave == 0 && MYLANE() == 0); } while (0)
    bf16 *WIN = (bf16*)(ws + WS_WIN), *WMKV = (bf16*)(ws + WS_WMKV), *WGLU = (bf16*)(ws + WS_WGLU), *WBR = (bf16*)(ws + WS_WBR), *WOUT = (bf16*)(ws + WS_WOUT), *WGU = (bf16*)(ws + WS_WGU), *WD = (bf16*)(ws + WS_WD);
    float *RS = (float*)(ws + WS_RS), *WI = (float*)(ws + WS_WI), *SLOC = (float*)(ws + WS_SLOC);
    bf16 *KX = (bf16*)(ws + WS_KX), *VX = (bf16*)(ws + WS_VX), *MEMN = (bf16*)(ws + WS_MEMN), *H = (bf16*)(ws + WS_H), *QD = (bf16*)(ws + WS_QD), *CKV = (bf16*)(ws + WS_CKV), *QI = (bf16*)(ws + WS_QI), *KI = (bf16*)(ws + WS_KI),
         *QX = (bf16*)(ws + WS_QX), *U = (bf16*)(ws + WS_U), *ODSA = (bf16*)(ws + WS_ODSA), *OX = (bf16*)(ws + WS_OX), *Y = (bf16*)(ws + WS_Y), *OS5 = (bf16*)(ws + WS_OS5), *GB = (bf16*)(ws + WS_G), *MG = (bf16*)(ws + WS_MERGED),
         *ACT = (bf16*)(ws + WS_ACT), *XN = (bf16*)(ws + WS_XN), *S5TV = (bf16*)(ws + WS_S5TV), *S5W = (bf16*)(ws + WS_S5W);

    if (IN(0)) for (int rep_ = 0; rep_ <= RPT(0); ++rep_) { if (rep_) xcd_barrier(bar, wave == 0 && MYLANE() == 0); const int lane = MYLANE(), tid = wave * 64 + lane; p0_prologue(args, lds, tid, lane, wave, vcu, G); }
    SEAM(0);
    if (IN(1)) for (int rep_ = 0; rep_ <= RPT(1); ++rep_) { if (rep_) xcd_barrier(bar, wave == 0 && MYLANE() == 0);
        { pg8::Gemm g{H, WIN, T_TOK, NIN, 1024, 1024, 1024}; pg8::StaticOrder S; S.init(T_TOK, NIN, G, bx);
          pg8::EpiInprojF E{QD, CKV, QI, KI, U, QX, WI};
          pg8::gemm_phase<pg8::EpiInprojF, pg8::StaticOrder, true, true>(lds + RING_OFF, g, S, E, wave); }
        { pg8::Gemm g{MEMN, WMKV, 2048, 1024, 1024, 1024, 1024}; pg8::SubsetOrder S; S.init(2048, 1024, 64, bx - 192);
          pg8::EpiBf16S E{KX, VX, 512, 512};
          pg8::gemm_phase<pg8::EpiBf16S, pg8::SubsetOrder, true, true>(lds + RING_OFF, g, S, E, wave); }
    }
    SEAM(1);
    if (IN(2)) for (int rep_ = 0; rep_ <= RPT(2); ++rep_) { if (rep_) xcd_barrier(bar, wave == 0 && MYLANE() == 0);
        const int gtid = bx * NTHR + wave * 64 + MYLANE(), nthr = G * NTHR;
        norm128_pass(QD, T_TOK, 1024, 8, args.in[5], gtid, nthr);
        norm128_pass(CKV, T_TOK, 128, 1, args.in[6], gtid, nthr);
        norm128_pass(QX, T_TOK, 512, 4, args.in[19], gtid, nthr);
        norm128_pass(KX, 2048, 512, 4, args.in[20], gtid, nthr);
        if (!(args.flags & FL_NO_S5)) {
            pg8::Gemm g{U, S5W, 32 * 512, 32 * 256, 512, 640, 512}; pg8::S5Order1 S{bx - 192};
            pg8::EpiSlocF E{SLOC};
            pg8::gemm_phase<pg8::EpiSlocF, pg8::S5Order1, false, true>(lds + RING_OFF, g, S, E, wave);
        }
    }
    SEAM(2);
    if (IN(3)) for (int rep_ = 0; rep_ <= RPT(3); ++rep_) { if (rep_) xcd_barrier(bar, wave == 0 && MYLANE() == 0);
        if (!(args.flags & FL_NO_S5)) {
            if (bx < 128) s5_scan(bx >> 2, (bx >> 1) & 1, args, wave * 64 + MYLANE());
            pg8::Gemm g{U, S5TV, 32 * 512, 32 * 512, 640, 640, 640}; pg8::S5Order2 S{bx};
            pg8::EpiS5YF E{U, args.in[15], Y};
            pg8::gemm_phase<pg8::EpiS5YF, pg8::S5Order2, false, true>(lds + RING_OFF, g, S, E, wave);
        }
#ifdef HAVE_ATTN
        if (!(args.flags & FL_NO_CROSS)) { const int lane = MYLANE(); cross_phase(args, lds, wave * 64 + lane, lane, wave, bx, G); }
#endif
#ifdef HAVE_DSA
        if (!(args.flags & FL_NO_DSA)) dsa_phase(args, lds, wave, bx, G);
#endif
    }
    SEAM(3);
    if (IN(4)) for (int rep_ = 0; rep_ <= RPT(4); ++rep_) { if (rep_) xcd_barrier(bar, wave == 0 && MYLANE() == 0);
        pg8::Gemm g{Y, WGLU, T_TOK, 512, 512, 512, 512}; pg8::StaticOrder S; S.init(T_TOK, 512, G, bx);
        pg8::EpiGluF E{Y, OS5};
        pg8::gemm_phase<pg8::EpiGluF, pg8::StaticOrder, false, true>(lds + RING_OFF, g, S, E, wave);
    }
    SEAM(4);
    if (IN(5)) for (int rep_ = 0; rep_ <= RPT(5); ++rep_) { if (rep_) xcd_barrier(bar, wave == 0 && MYLANE() == 0);
        const int sub = (args.flags >> 8) & 15;
#pragma unroll 1
        for (int br = 0; br < 3; ++br) {
            if (sub == 0 || sub == 2 * br + 1) { pg8::Gemm g{H, WIN + (size_t)(NIN + br * 1024) * 1024, T_TOK, 1024, 1024, 1024, 1024}; pg8::StaticOrder S; S.init(T_TOK, 1024, G, bx);
              pg8::EpiSigmoidF E{GB};
              pg8::gemm_phase<pg8::EpiSigmoidF, pg8::StaticOrder, false, true>(lds + RING_OFF, g, S, E, wave); }
            if (sub == 0 || sub == 2 * br + 2) { const bf16* A = br == 0 ? ODSA : (br == 1 ? OS5 : OX);
              pg8::Gemm g{A, WBR + (size_t)br * 1024 * 512, T_TOK, 1024, 512, 512, 512}; pg8::StaticOrder S; S.init(T_TOK, 1024, G, bx);
              pg8::EpiMergeF E{GB, MG, br == 0 ? 1 : 0};
              pg8::gemm_phase<pg8::EpiMergeF, pg8::StaticOrder, false, true>(lds + RING_OFF, g, S, E, wave); }
        }
    }
    SEAM(5);
    if (IN(6)) for (int rep_ = 0; rep_ <= RPT(6); ++rep_) { if (rep_) xcd_barrier(bar, wave == 0 && MYLANE() == 0);
        pg8::Gemm g{MG, WOUT, T_TOK, 1024, 1024, 1024, 1024}; pg8::StaticOrder S; S.init(T_TOK, 1024, G, bx);
        pg8::EpiOutF E{args.in[0], args.out, XN, RS};
        pg8::gemm_phase<pg8::EpiOutF, pg8::StaticOrder, false, true>(lds + RING_OFF, g, S, E, wave);
    }
    SEAM(6);
    if (IN(7)) for (int rep_ = 0; rep_ <= RPT(7); ++rep_) { if (rep_) xcd_barrier(bar, wave == 0 && MYLANE() == 0);
        pg8::Gemm g{XN, WGU, T_TOK, 5632, 1024, 1024, 1024}; pg8::StaticOrder S; S.init(T_TOK, 5632, G, bx);
        pg8::EpiGateUpF E{RS, ACT};
        pg8::gemm_phase<pg8::EpiGateUpF, pg8::StaticOrder, true, true>(lds + RING_OFF, g, S, E, wave);
    }
    SEAM(7);
    if (IN(8)) for (int rep_ = 0; rep_ <= RPT(8); ++rep_) { if (rep_) xcd_barrier(bar, wave == 0 && MYLANE() == 0);
        pg8::Gemm g{ACT, WD, T_TOK, 1024, 2816, 2816, 2816}; pg8::StaticOrder S; S.init(T_TOK, 1024, G, bx);
        pg8::EpiDownF E{args.out};
        pg8::gemm_phase<pg8::EpiDownF, pg8::StaticOrder, false, true>(lds + RING_OFF, g, S, E, wave);
    }
#undef IN
#undef SEAM
}
template <int MODE> __global__ void __launch_bounds__(NTHR, 2) t_dsa(Args args) {
    extern __shared__ __attribute__((aligned(16))) unsigned char lds_raw[];
    LAS unsigned char* lds = (LAS unsigned char*)lds_raw;
    const int wave = __builtin_amdgcn_readfirstlane(threadIdx.x >> 6);
    att::dsa_phase<MODE>(args, lds, wave, blockIdx.x, gridDim.x);
}
#ifndef CFG_FLAGS
#define CFG_FLAGS (FL_NO_DSA | FL_NO_CROSS)
#endif
#ifndef CFG_ONE_LAUNCH
#define CFG_ONE_LAUNCH 0
#endif
extern "C" void kernel_launch(void* const* d_in, const int* in_sizes, int n_in, void* d_out, int out_size, void* d_ws, size_t ws_size, hipStream_t stream) {
    static int grid = 0;
    if (grid == 0) {
        if (n_in != 29 || ws_size < WS_END || out_size != T_TOK * DM) { fprintf(stderr, "kernel_launch: unexpected sizes n_in %d ws %zu out %d\n", n_in, ws_size, out_size); grid = -1; return; }
        int dev = 0, cus = 0, per_cu = 0;
        if (hipGetDevice(&dev) != hipSuccess || hipDeviceGetAttribute(&cus, hipDeviceAttributeMultiprocessorCount, dev) != hipSuccess) { grid = -1; return; }
        if (hipFuncSetAttribute((const void*)mk_fwd, hipFuncAttributeMaxDynamicSharedMemorySize, LDS_BYTES) != hipSuccess) { fprintf(stderr, "kernel_launch: hipFuncSetAttribute failed\n"); grid = -1; return; }
        if (hipOccupancyMaxActiveBlocksPerMultiprocessor(&per_cu, (const void*)mk_fwd, NTHR, LDS_BYTES) != hipSuccess || per_cu < 1) fprintf(stderr, "kernel_launch: note: occupancy query reports %d\n", per_cu);
        (void)hipGetLastError();
        grid = cus;
        if (grid != 256) fprintf(stderr, "kernel_launch: %d CUs (built for 256)\n", grid);
    }
    if (grid < 0) return;
    (void)hipMemsetAsync((char*)d_ws + WS_CTL, 0, CTL_ZERO_BYTES, stream);
    Args a{};
    for (int i = 0; i < 29; ++i) a.in[i] = (const float*)d_in[i];
    a.out = (float*)d_out; a.ws = (unsigned char*)d_ws; a.flags = CFG_FLAGS;
#if CFG_ONE_LAUNCH
    a.ph_lo = 0; a.ph_hi = NPH;
    hipLaunchKernelGGL(mk_fwd, dim3(grid), dim3(NTHR), LDS_BYTES, stream, a);
#else
    unsigned char* ws = (unsigned char*)d_ws; const float* const* in = (const float* const*)d_in;
#ifdef CFG_SPLIT2
    for (int ph = 3; ph < 5; ++ph) {
        if (ph == 3) { a.ph_lo = 0; a.ph_hi = 4; a.li = 0; } else { a.ph_lo = 4; a.ph_hi = NPH; a.li = 1; }
#else
    for (int ph = 0; ph < NPH; ++ph) {
        a.ph_lo = ph; a.ph_hi = ph + 1;
#endif
        hipLaunchKernelGGL(mk_fwd, dim3(grid), dim3(NTHR), LDS_BYTES, stream, a);
#ifdef DSA_PROBE
        if (ph == 3) { static bool once = false; if (!once) { once = true; (void)hipFuncSetAttribute((const void*)t_dsa<0>, hipFuncAttributeMaxDynamicSharedMemorySize, LDS_BYTES); (void)hipFuncSetAttribute((const void*)t_dsa<DSA_PROBE>, hipFuncAttributeMaxDynamicSharedMemorySize, LDS_BYTES); }
            if (DSA_PROBE != 0) hipLaunchKernelGGL(t_dsa<DSA_PROBE>, dim3(grid), dim3(NTHR), LDS_BYTES, stream, a);
            hipLaunchKernelGGL(t_dsa<0>, dim3(grid), dim3(NTHR), LDS_BYTES, stream, a); }
#endif
        if (ph == 3) {
            using namespace nv;
#ifndef DSA_PROBE
            if (CFG_FLAGS & FL_NO_DSA) k_dsa<<<16384, 256, 0, stream>>>((nv::bf16*)(ws + WS_QD), (nv::bf16*)(ws + WS_CKV), (nv::bf16*)(ws + WS_QI), (nv::bf16*)(ws + WS_KI), (float*)(ws + WS_WI), (float*)(ws + WS_BIASL), (nv::bf16*)(ws + WS_WUV), (nv::bf16*)(ws + WS_ODSA));
#endif
            if (CFG_FLAGS & FL_NO_CROSS) k_cross<<<16384, 256, 0, stream>>>((nv::bf16*)(ws + WS_QX), (nv::bf16*)(ws + WS_KX), (nv::bf16*)(ws + WS_VX), (nv::bf16*)(ws + WS_OX));
            if (CFG_FLAGS & FL_NO_S5) k_s5<<<256, 64, 0, stream>>>((nv::bf16*)(ws + WS_U), in[8], in[9], in[10], in[11], in[12], in[13], in[14], in[15], (nv::bf16*)(ws + WS_Y));
        }
    }
#endif
}
```

```cpp
#include <hip/hip_runtime.h>
#include <cstdio>
#include <cstdint>
#include <cmath>
constexpr int T_TOK = 16384, DM = 1024, SEQ = 2048, NB = 8, NIN = 2816, NINP = 5888, DFF = 2816;
constexpr size_t MiB = 1u << 20;
constexpr size_t WS_CTL = 0;
constexpr size_t WS_WIN = 1 * MiB, WS_WMKV = 13 * MiB, WS_WGLU = 15 * MiB, WS_WBR = 16 * MiB, WS_WOUT = 19 * MiB, WS_WGU = 21 * MiB, WS_WD = 32 * MiB;
constexpr size_t WS_WUV = 38 * MiB, WS_BIASL = 38 * MiB + 512 * 1024, WS_RS = 39 * MiB, WS_WI = 37 * MiB + 512 * 1024;
constexpr size_t WS_S5TV = 40 * MiB, WS_S5W = 60 * MiB, WS_KX = 68 * MiB, WS_VX = 70 * MiB, WS_MEMN = 72 * MiB, WS_H = 76 * MiB;
constexpr size_t WS_QD = 108 * MiB, WS_CKV = 140 * MiB, WS_QI = 144 * MiB, WS_KI = 160 * MiB, WS_QX = 162 * MiB, WS_U = 178 * MiB, WS_SLOC = 198 * MiB;
constexpr size_t WS_ODSA = 206 * MiB, WS_OX = 222 * MiB, WS_Y = 238 * MiB, WS_END = 254 * MiB;
constexpr size_t WS_G3 = 108 * MiB, WS_MERGED = WS_H, WS_XN = 108 * MiB, WS_ACT = 140 * MiB;
constexpr size_t WS_OS5 = 0, WS_G = WS_G3;
__device__ __forceinline__ int my_lane_id() { int l; asm volatile("v_mbcnt_lo_u32_b32 %0, -1, 0\n\tv_mbcnt_hi_u32_b32 %0, -1, %0" : "=v"(l)); return l; }
#define CFG_FLAGS 0
#define CFG_ONE_LAUNCH 1
namespace pg8 {
#define PG8_LAS __attribute__((address_space(3)))
typedef unsigned short bf16_t;
typedef short bf16x8 __attribute__((ext_vector_type(8)));
typedef float f32x4 __attribute__((ext_vector_type(4)));
typedef unsigned u32x4 __attribute__((ext_vector_type(4)));
constexpr int BM = 256, BK = 64, HALF = 128, HTB = HALF * BK * 2  , STAGE_BYTES = 8 * HTB, NXCD = 8, WGM = 8;

__host__ __device__ __forceinline__ int lds_byte(int r, int c) { const int st = (r >> 4) * 2 + (c >> 5), rr = r & 15, cc = c & 31, ob = rr * 64 + cc * 2; return st * 1024 + (ob ^ (((ob >> 9) & 1) << 5)); }
__host__ __device__ __forceinline__ void stage_rc(int b, int& R, int& C) { const int st = b / 1024, sb = b % 1024, swz = sb ^ (((sb >> 9) & 1) << 5); R = (st >> 1) * 16 + swz / 64; C = (st & 1) * 32 + (swz % 64) / 2; }
__host__ __device__ __forceinline__ int perm32(int rho) { const int n = rho >> 4, i = rho & 15; return 8 * (i >> 2) + 4 * n + (i & 3); }

struct Unit { int pm, pn, z; };
struct Gemm { const bf16_t* A; const bf16_t* Bt; int M, N, K, lda, ldb; };

struct StaticOrder {
    int nM, nN, nwg, G, c;
    __host__ __device__ void init(int M, int N, int G_, int c_) { nM = M / BM; nN = N / BM; nwg = nM * nN; G = G_; c = c_; }
    __host__ __device__ bool next(int i, Unit& u) const {
        const long L = (long)i * G + c; if (L >= nwg) return false;
        int wgid = (int)L; { const int q = nwg / NXCD, r = nwg % NXCD, xcd = wgid % NXCD, off = wgid / NXCD; wgid = (xcd < r ? xcd * (q + 1) : r * (q + 1) + (xcd - r) * q) + off; }
        const int nig = WGM * nN, gid = wgid / nig, fm = gid * WGM, gsz = (nM - fm) < WGM ? (nM - fm) : WGM;
        u.pm = fm + ((wgid % nig) % gsz); u.pn = (wgid % nig) / gsz; u.z = 0; return true;
    }
    __device__ __forceinline__ void a_ready(const Unit&) const {}
    __device__ __forceinline__ void done(const Unit&) const {}
    __device__ __forceinline__ long a_off(const Unit&) const { return 0; }
    __device__ __forceinline__ long b_off(const Unit&) const { return 0; }
};

typedef float f32x2_c __attribute__((ext_vector_type(2))); typedef __bf16 bf16x2_c __attribute__((ext_vector_type(2)));
__device__ __forceinline__ unsigned cvt_pk_bf16(float lo, float hi) { const f32x2_c v = {lo, hi}; const bf16x2_c b = __builtin_convertvector(v, bf16x2_c); return __builtin_bit_cast(unsigned, b); }
typedef float f32x2 __attribute__((ext_vector_type(2)));
template <class Epi, class Sched, bool ALIGN_EPI = false, bool SP2 = false>
__device__ __forceinline__ void gemm_phase(PG8_LAS unsigned char* lds, const Gemm g, const Sched& S, const Epi& E, const int wid) {
    const int lane = my_lane_id(), tid = wid * 64 + lane, wr = wid >> 2, wc = wid & 3, fr = lane & 15, fq = lane >> 4;
    const int K = g.K, nt = K / BK, lda = g.lda, ldb = g.ldb;
    unsigned voffA[2], voffB[2];
#pragma unroll
    for (int i = 0; i < 2; ++i) { int R, C; stage_rc(tid * 16 + i * 8192, R, C); const int Rb = Epi::PERM ? ((R & ~31) + perm32(R & 31)) : R;
        voffA[i] = (unsigned)(R * lda + C) * 2u; voffB[i] = (unsigned)(Rb * ldb + C) * 2u; }
    const size_t kstep = (size_t)(BK * 2);
    const size_t hstepA = (size_t)HALF * lda * 2, hstepB = (size_t)HALF * ldb * 2;
    const size_t tstepA = 2 * hstepA, tstepB = 2 * hstepB;
    const unsigned ldsw = (unsigned)wid * 1024u;
    const int aoff = lds_byte(wr * 64 + fr, fq * 8), boff = lds_byte(wc * 32 + fr, fq * 8);
#define PG8_SA(b, h) (((b) * 2 + (h)) * HTB)
#define PG8_SB(b, h) ((4 + (b) * 2 + (h)) * HTB)
#define PG8_STAGE(bufoff, gbase, voff) do { _Pragma("unroll") for (int _i = 0; _i < 2; ++_i) \
        __builtin_amdgcn_global_load_lds((const unsigned*)((const char*)(gbase) + (voff)[_i]), (PG8_LAS unsigned*)(lds + (bufoff) + ldsw + _i * 8192), 16, 0, 0); } while (0)
#define PG8_LDA(dst, b, h) do { _Pragma("unroll") for (int m = 0; m < 4; ++m) _Pragma("unroll") for (int k = 0; k < 2; ++k) dst[m][k] = *(const PG8_LAS bf16x8*)(lds + PG8_SA(b, h) + aoff + m * 2048 + k * 1024); } while (0)
#define PG8_LDB(dst, b, h) do { _Pragma("unroll") for (int n = 0; n < 2; ++n) _Pragma("unroll") for (int k = 0; k < 2; ++k) dst[n][k] = *(const PG8_LAS bf16x8*)(lds + PG8_SB(b, h) + boff + n * 2048 + k * 1024); } while (0)
#define PG8_MMA(ai, bj, At, Bt) do { __builtin_amdgcn_s_setprio(1); _Pragma("unroll") for (int m = 0; m < 4; ++m) _Pragma("unroll") for (int n = 0; n < 2; ++n) _Pragma("unroll") for (int k = 0; k < 2; ++k) \
        acc[ai][bj][m][n] = __builtin_amdgcn_mfma_f32_16x16x32_bf16(Bt[n][k], At[m][k], acc[ai][bj][m][n], 0, 0, 0); __builtin_amdgcn_s_setprio(0); } while (0)
#define PG8_WAIT_V(n) asm volatile("s_waitcnt vmcnt(" #n ")" ::: "memory")
#define PG8_WAIT_L(n) asm volatile("s_waitcnt lgkmcnt(" #n ")" ::: "memory")
#define PG8_BAR __builtin_amdgcn_s_barrier()
#define PG8_SCHED __builtin_amdgcn_sched_barrier(0)
    Unit cur, nxt; int ui = 0;
    if (!S.next(0, cur)) return;
    f32x4 acc[2][2][4][2];
#pragma unroll
    for (int a = 0; a < 2; ++a)
#pragma unroll
        for (int b = 0; b < 2; ++b)
#pragma unroll
            for (int m = 0; m < 4; ++m)
#pragma unroll
                for (int n = 0; n < 2; ++n) acc[a][b][m][n] = (f32x4){0.f, 0.f, 0.f, 0.f};
    bf16x8 At[4][2], B0[2][2], B1[2][2];
    const char* cA = (const char*)g.A + (size_t)cur.pm * tstepA + S.a_off(cur); const char* cB = (const char*)g.Bt + (size_t)cur.pn * tstepB + S.b_off(cur);
    S.a_ready(cur);
    if constexpr (SP2) {
        PG8_STAGE(PG8_SB(0, 0), cB, voffB); PG8_STAGE(PG8_SB(0, 1), cB + hstepB, voffB); PG8_STAGE(PG8_SA(0, 0), cA, voffA); PG8_STAGE(PG8_SA(0, 1), cA + hstepA, voffA);
        if (wr == 1) PG8_BAR;
        PG8_WAIT_V(2); PG8_BAR;
        PG8_STAGE(PG8_SB(1, 0), cB + kstep, voffB); PG8_STAGE(PG8_SA(1, 0), cA + kstep, voffA); PG8_STAGE(PG8_SB(1, 1), cB + hstepB + kstep, voffB);
        PG8_WAIT_V(6); PG8_BAR;
    } else {
        PG8_STAGE(PG8_SB(0, 0), cB, voffB); PG8_STAGE(PG8_SA(0, 0), cA, voffA); PG8_STAGE(PG8_SB(0, 1), cB + hstepB, voffB); PG8_STAGE(PG8_SA(0, 1), cA + hstepA, voffA);
        if (wr == 1) PG8_BAR;
        PG8_WAIT_V(4); PG8_BAR;
        PG8_STAGE(PG8_SB(1, 0), cB + kstep, voffB); PG8_STAGE(PG8_SA(1, 0), cA + kstep, voffA); PG8_STAGE(PG8_SB(1, 1), cB + hstepB + kstep, voffB);
        PG8_WAIT_V(6); PG8_BAR;
    }
    for (;;) {
        const bool has_next = S.next(ui + 1, nxt);
        const char* nA = has_next ? (const char*)g.A + (size_t)nxt.pm * tstepA + S.a_off(nxt) : cA; const char* nB = has_next ? (const char*)g.Bt + (size_t)nxt.pn * tstepB + S.b_off(nxt) : cB;
        for (int t = 0; t < nt; t += 2) {
            const bool last = (t == nt - 2);
            const char* a1 = cA + (size_t)(t + 1) * kstep;
            const char* a2 = last ? nA : cA + (size_t)(t + 2) * kstep; const char* b2 = last ? nB : cB + (size_t)(t + 2) * kstep;
            const char* a3 = a2 + kstep; const char* b3 = b2 + kstep;
            if (last && has_next) S.a_ready(nxt);
            if constexpr (SP2) {
            PG8_LDB(B0, 0, 0); PG8_LDB(B1, 0, 1); PG8_SCHED; PG8_LDA(At, 0, 0); PG8_STAGE(PG8_SA(1, 1), a1 + hstepA, voffA);
            PG8_WAIT_V(8); PG8_WAIT_L(0); PG8_BAR; PG8_MMA(0, 0, At, B0); PG8_MMA(0, 1, At, B1); PG8_BAR; PG8_SCHED;
            PG8_LDA(At, 0, 1); PG8_STAGE(PG8_SB(0, 0), b2, voffB); PG8_STAGE(PG8_SB(0, 1), b2 + hstepB, voffB); PG8_STAGE(PG8_SA(0, 0), a2, voffA);
            PG8_WAIT_V(8); PG8_WAIT_L(0); PG8_BAR; PG8_MMA(1, 0, At, B0); PG8_MMA(1, 1, At, B1); PG8_BAR; PG8_SCHED;
            PG8_LDB(B0, 1, 0); PG8_LDB(B1, 1, 1); PG8_SCHED; PG8_LDA(At, 1, 0); PG8_STAGE(PG8_SA(0, 1), a2 + hstepA, voffA);
            PG8_WAIT_V(8); PG8_WAIT_L(0); PG8_BAR; PG8_MMA(0, 0, At, B0); PG8_MMA(0, 1, At, B1); PG8_BAR; PG8_SCHED;
            PG8_LDA(At, 1, 1); PG8_STAGE(PG8_SB(1, 0), b3, voffB); PG8_STAGE(PG8_SB(1, 1), b3 + hstepB, voffB); PG8_STAGE(PG8_SA(1, 0), a3, voffA);
            PG8_WAIT_V(8); PG8_WAIT_L(0); PG8_BAR; PG8_MMA(1, 0, At, B0); PG8_MMA(1, 1, At, B1); PG8_BAR; PG8_SCHED;
            } else {
            PG8_LDB(B0, 0, 0); PG8_SCHED; PG8_LDA(At, 0, 0); PG8_STAGE(PG8_SA(1, 1), a1 + hstepA, voffA);
            PG8_WAIT_L(8); PG8_BAR; PG8_WAIT_L(0); PG8_MMA(0, 0, At, B0); PG8_BAR; PG8_SCHED;
            PG8_LDB(B1, 0, 1); PG8_STAGE(PG8_SB(0, 0), b2, voffB);
            PG8_BAR; PG8_WAIT_L(0); PG8_MMA(0, 1, At, B1); PG8_BAR;
            PG8_LDA(At, 0, 1); PG8_STAGE(PG8_SA(0, 0), a2, voffA);
            PG8_BAR; PG8_WAIT_L(0); PG8_MMA(1, 0, At, B0); PG8_BAR; PG8_SCHED;
            PG8_STAGE(PG8_SB(0, 1), b2 + hstepB, voffB);
            PG8_WAIT_V(6); PG8_BAR; PG8_MMA(1, 1, At, B1); PG8_BAR;
            PG8_LDB(B0, 1, 0); PG8_SCHED; PG8_LDA(At, 1, 0); PG8_STAGE(PG8_SA(0, 1), a2 + hstepA, voffA);
            PG8_WAIT_L(8); PG8_BAR; PG8_WAIT_L(0); PG8_MMA(0, 0, At, B0); PG8_BAR; PG8_SCHED;
            PG8_LDB(B1, 1, 1); PG8_STAGE(PG8_SB(1, 0), b3, voffB);
            PG8_BAR; PG8_WAIT_L(0); PG8_MMA(0, 1, At, B1); PG8_BAR;
            PG8_LDA(At, 1, 1); PG8_STAGE(PG8_SA(1, 0), a3, voffA);
            PG8_BAR; PG8_WAIT_L(0); PG8_MMA(1, 0, At, B0); PG8_BAR; PG8_SCHED;
            PG8_STAGE(PG8_SB(1, 1), b3 + hstepB, voffB);
            PG8_WAIT_V(6); PG8_BAR; PG8_MMA(1, 1, At, B1); PG8_BAR;
            }
        }
        if constexpr (ALIGN_EPI) { if (wr == 0) PG8_BAR; }
        if constexpr (!Epi::AFTER_DRAIN) { E(acc, cur, wr, wc, fr, fq); S.done(cur); }
        if (!has_next) break;
#pragma unroll
        for (int a = 0; a < 2; ++a)
#pragma unroll
            for (int b = 0; b < 2; ++b)
#pragma unroll
                for (int m = 0; m < 4; ++m)
#pragma unroll
                    for (int n = 0; n < 2; ++n) acc[a][b][m][n] = (f32x4){0.f, 0.f, 0.f, 0.f};
        cur = nxt; cA = nA; cB = nB; ++ui;
        if constexpr (ALIGN_EPI) { if (wr == 1) PG8_BAR; }
    }
    PG8_WAIT_V(0);
    if constexpr (!ALIGN_EPI) { if (wr == 0) PG8_BAR; }
    PG8_BAR;
    if constexpr (Epi::AFTER_DRAIN) { E.fused(acc, cur, wr, wc, fr, fq, lds, wid, lane); S.done(cur); }
#undef PG8_SA
#undef PG8_SB
#undef PG8_STAGE
#undef PG8_LDA
#undef PG8_LDB
#undef PG8_MMA
#undef PG8_WAIT_V
#undef PG8_WAIT_L
#undef PG8_BAR
#undef PG8_SCHED
}
}
namespace pg8 {
typedef unsigned u32x2 __attribute__((ext_vector_type(2)));
__device__ __forceinline__ u32x4 pack8(const f32x4 a, const f32x4 b) { u32x4 w; w.x = cvt_pk_bf16(a[0], a[1]); w.y = cvt_pk_bf16(a[2], a[3]); w.z = cvt_pk_bf16(b[0], b[1]); w.w = cvt_pk_bf16(b[2], b[3]); return w; }
__device__ __forceinline__ void unpack8(const u32x4 w, f32x4& a, f32x4& b) {
    a[0] = __uint_as_float(w.x << 16); a[1] = __uint_as_float(w.x & 0xffff0000u); a[2] = __uint_as_float(w.y << 16); a[3] = __uint_as_float(w.y & 0xffff0000u);
    b[0] = __uint_as_float(w.z << 16); b[1] = __uint_as_float(w.z & 0xffff0000u); b[2] = __uint_as_float(w.w << 16); b[3] = __uint_as_float(w.w & 0xffff0000u); }
__device__ __forceinline__ float sigm(float v) { return __builtin_amdgcn_rcpf(1.f + __expf(-v)); }
__device__ __forceinline__ f32x4 sigm4(const f32x4 v) { f32x4 r; r[0] = sigm(v[0]); r[1] = sigm(v[1]); r[2] = sigm(v[2]); r[3] = sigm(v[3]); return r; }

struct EpiInprojF {
    static constexpr bool PERM = true, AFTER_DRAIN = false;
    bf16_t *QD, *CKV, *QI, *KI, *U, *QX; float* WI;
    __device__ __forceinline__ void operator()(const f32x4 (&acc)[2][2][4][2], const Unit& u, int wr, int wc, int fr, int fq) const {
        const int row0 = u.pm * BM + wr * 64 + fr;
#pragma unroll
        for (int bj = 0; bj < 2; ++bj) {
            const int c0 = u.pn * BM + bj * HALF + wc * 32 + 8 * fq;
            bf16_t* base = QD; int ld = 1024, cc = c0, kind = 0;
            if (c0 < 1024) { }
            else if (c0 < 1152) { base = CKV; ld = 128; cc = c0 - 1024; }
            else if (c0 < 1664) { base = QI; ld = 512; cc = c0 - 1152; }
            else if (c0 < 1728) { base = KI; ld = 64; cc = c0 - 1664; }
            else if (c0 < 1792) { kind = 1; }
            else if (c0 < 2304) { kind = 2; cc = c0 - 1792; }
            else { base = QX; ld = 512; cc = c0 - 2304; }
#pragma unroll
            for (int ai = 0; ai < 2; ++ai)
#pragma unroll
                for (int m = 0; m < 4; ++m) {
                    const int t = row0 + ai * HALF + m * 16;
                    if (kind == 0) *(u32x4*)(base + (size_t)t * ld + cc) = pack8(acc[ai][bj][m][0], acc[ai][bj][m][1]);
                    else if (kind == 1) { if (c0 == 1728) { *(f32x4*)(WI + (size_t)t * 8) = acc[ai][bj][m][0]; *(f32x4*)(WI + (size_t)t * 8 + 4) = acc[ai][bj][m][1]; } }
                    else { const int g = cc >> 4, ci = cc & 15, b = t >> 11, tt = t & 2047, R = b * 64 + (tt >> 5), s = tt & 31;
                        *(u32x4*)(U + ((size_t)(g * 512 + R)) * 640 + s * 16 + ci) = pack8(acc[ai][bj][m][0], acc[ai][bj][m][1]); }
                }
        }
    }
};
struct EpiBf16S {
    static constexpr bool PERM = true, AFTER_DRAIN = false;
    bf16_t* O0; bf16_t* O1; int split, ld;
    __device__ __forceinline__ void operator()(const f32x4 (&acc)[2][2][4][2], const Unit& u, int wr, int wc, int fr, int fq) const {
        const int row0 = u.pm * BM + wr * 64 + fr;
#pragma unroll
        for (int bj = 0; bj < 2; ++bj) {
            const int c0 = u.pn * BM + bj * HALF + wc * 32 + 8 * fq;
            bf16_t* base = c0 < split ? O0 : O1; const int cc = c0 < split ? c0 : c0 - split;
#pragma unroll
            for (int ai = 0; ai < 2; ++ai)
#pragma unroll
                for (int m = 0; m < 4; ++m) *(u32x4*)(base + (size_t)(row0 + ai * HALF + m * 16) * ld + cc) = pack8(acc[ai][bj][m][0], acc[ai][bj][m][1]);
        }
    }
};
struct EpiGluF {
    static constexpr bool PERM = true, AFTER_DRAIN = false;
    const bf16_t* Y; bf16_t* O;
    __device__ __forceinline__ void operator()(const f32x4 (&acc)[2][2][4][2], const Unit& u, int wr, int wc, int fr, int fq) const {
        const int row0 = u.pm * BM + wr * 64 + fr;
#pragma unroll
        for (int bj = 0; bj < 2; ++bj) {
            const int c0 = u.pn * BM + bj * HALF + wc * 32 + 8 * fq;
#pragma unroll
            for (int ai = 0; ai < 2; ++ai)
#pragma unroll
                for (int m = 0; m < 4; ++m) { const size_t off = (size_t)(row0 + ai * HALF + m * 16) * 512 + c0;
                    f32x4 y0, y1; unpack8(*(const u32x4*)(Y + off), y0, y1);
                    *(u32x4*)(O + off) = pack8(y0 * sigm4(acc[ai][bj][m][0]), y1 * sigm4(acc[ai][bj][m][1])); }
        }
    }
};
struct EpiSigmoidF {
    static constexpr bool PERM = true, AFTER_DRAIN = false;
    bf16_t* G; int ld;
    __device__ __forceinline__ void operator()(const f32x4 (&acc)[2][2][4][2], const Unit& u, int wr, int wc, int fr, int fq) const {
        const int row0 = u.pm * BM + wr * 64 + fr;
#pragma unroll
        for (int bj = 0; bj < 2; ++bj) {
            const int c0 = u.pn * BM + bj * HALF + wc * 32 + 8 * fq;
#pragma unroll
            for (int ai = 0; ai < 2; ++ai)
#pragma unroll
                for (int m = 0; m < 4; ++m) *(u32x4*)(G + (size_t)(row0 + ai * HALF + m * 16) * ld + c0) = pack8(sigm4(acc[ai][bj][m][0]), sigm4(acc[ai][bj][m][1]));
        }
    }
};
struct EpiMergeF {
    static constexpr bool PERM = true, AFTER_DRAIN = false;
    const bf16_t* G3; bf16_t* MG;
    __device__ __forceinline__ void operator()(const f32x4 (&acc)[2][2][4][2], const Unit& u, int wr, int wc, int fr, int fq) const {
        const int row0 = u.pm * BM + wr * 64 + fr; const bool first = u.z == 0;
#pragma unroll
        for (int bj = 0; bj < 2; ++bj) {
            const int c0 = u.pn * BM + bj * HALF + wc * 32 + 8 * fq;
#pragma unroll
            for (int ai = 0; ai < 2; ++ai)
#pragma unroll
                for (int m = 0; m < 4; ++m) { const size_t t = (size_t)(row0 + ai * HALF + m * 16), off = t * 1024 + c0;
                    f32x4 g0, g1, p0 = {0.f, 0.f, 0.f, 0.f}, p1 = {0.f, 0.f, 0.f, 0.f}; unpack8(*(const u32x4*)(G3 + t * 3072 + u.z * 1024 + c0), g0, g1);
                    if (!first) unpack8(*(const u32x4*)(MG + off), p0, p1);
                    *(u32x4*)(MG + off) = pack8(p0 + g0 * acc[ai][bj][m][0], p1 + g1 * acc[ai][bj][m][1]); }
        }
    }
};
struct EpiOutF {
    static constexpr bool PERM = false, AFTER_DRAIN = false;
    const float* x; float* out; bf16_t* XN; float* RS;
    __device__ __forceinline__ void operator()(const f32x4 (&acc)[2][2][4][2], const Unit& u, int wr, int wc, int fr, int fq) const {
        const int row0 = u.pm * BM + wr * 64 + fr, col0 = u.pn * BM + wc * 32 + 4 * fq;
#pragma unroll
        for (int ai = 0; ai < 2; ++ai)
#pragma unroll
            for (int m = 0; m < 4; ++m) { const int t = row0 + ai * HALF + m * 16; const size_t off = (size_t)t * 1024 + col0; float ss = 0.f;
#pragma unroll
                for (int bj = 0; bj < 2; ++bj)
#pragma unroll
                    for (int n = 0; n < 2; ++n) { const size_t o2 = off + bj * HALF + n * 16; const f32x4 r = *(const f32x4*)(x + o2) + acc[ai][bj][m][n];
                        *(f32x4*)(out + o2) = r; u32x2 w; w.x = cvt_pk_bf16(r[0], r[1]); w.y = cvt_pk_bf16(r[2], r[3]); *(u32x2*)(XN + o2) = w;
                        ss += (r[0] * r[0] + r[1] * r[1]) + (r[2] * r[2] + r[3] * r[3]); }
                ss += __shfl_xor(ss, 16); ss += __shfl_xor(ss, 32);
                if (fq == 0) RS[(size_t)t * 16 + u.pn * 4 + wc] = ss; }
    }
};
struct EpiGateUpF {
    static constexpr bool PERM = true, AFTER_DRAIN = false;
    const float* RS; bf16_t* ACT;
    __device__ __forceinline__ void operator()(const f32x4 (&acc)[2][2][4][2], const Unit& u, int wr, int wc, int fr, int fq) const {
        const int row0 = u.pm * BM + wr * 64 + fr, f0 = u.pn * HALF + wc * 32 + 8 * fq;
#pragma unroll
        for (int ai = 0; ai < 2; ++ai)
#pragma unroll
            for (int m = 0; m < 4; ++m) { const int t = row0 + ai * HALF + m * 16;
                const f32x4* rp = (const f32x4*)(RS + (size_t)t * 16); const f32x4 a = rp[0], b = rp[1], c = rp[2], d = rp[3];
                const float tot = ((a[0] + a[1]) + (a[2] + a[3])) + ((b[0] + b[1]) + (b[2] + b[3])) + ((c[0] + c[1]) + (c[2] + c[3])) + ((d[0] + d[1]) + (d[2] + d[3]));
                const float rs = __builtin_amdgcn_rsqf(tot * (1.f / 1024.f) + 1e-6f);
                f32x4 o[2];
#pragma unroll
                for (int n = 0; n < 2; ++n) { const f32x4 g = acc[ai][0][m][n] * rs, up = acc[ai][1][m][n] * rs; o[n] = g * sigm4(g) * up; }
                *(u32x4*)(ACT + (size_t)t * 2816 + f0) = pack8(o[0], o[1]); }
    }
};
struct EpiDownF {
    static constexpr bool PERM = false, AFTER_DRAIN = false;
    float* out;
    __device__ __forceinline__ void operator()(const f32x4 (&acc)[2][2][4][2], const Unit& u, int wr, int wc, int fr, int fq) const {
        const int row0 = u.pm * BM + wr * 64 + fr, col0 = u.pn * BM + wc * 32 + 4 * fq;
#pragma unroll
        for (int ai = 0; ai < 2; ++ai)
#pragma unroll
            for (int m = 0; m < 4; ++m) { float* rowp = out + (size_t)(row0 + ai * HALF + m * 16) * 1024 + col0;
#pragma unroll
                for (int bj = 0; bj < 2; ++bj)
#pragma unroll
                    for (int n = 0; n < 2; ++n) { f32x4* p = (f32x4*)(rowp + bj * HALF + n * 16); *p = *p + acc[ai][bj][m][n]; } }
    }
};
struct EpiSlocF {
    static constexpr bool PERM = false, AFTER_DRAIN = false;
    float* SLOC;
    __device__ __forceinline__ void operator()(const f32x4 (&acc)[2][2][4][2], const Unit& u, int wr, int wc, int fr, int fq) const {
        const int row0 = u.pm * BM + wr * 64 + fr, col0 = wc * 32 + 4 * fq;
#pragma unroll
        for (int ai = 0; ai < 2; ++ai)
#pragma unroll
            for (int m = 0; m < 4; ++m)
#pragma unroll
                for (int n = 0; n < 2; ++n) *(f32x4*)(SLOC + (size_t)(row0 + ai * HALF + m * 16) * 128 + col0 + n * 16) = acc[ai][0][m][n];
    }
};
__device__ __forceinline__ float gelu_t(float x) { const float w = 1.5957691216057308f * (x + 0.044715f * x * x * x); return x * __builtin_amdgcn_rcpf(1.f + __expf(-w)); }
struct EpiS5YF {
    static constexpr bool PERM = true, AFTER_DRAIN = false;
    const bf16_t* U; const float* dskip; bf16_t* Y;
    __device__ __forceinline__ void operator()(const f32x4 (&acc)[2][2][4][2], const Unit& u, int wr, int wc, int fr, int fq) const {
        const int row0 = u.pm * BM + wr * 64 + fr;
#pragma unroll
        for (int bj = 0; bj < 2; ++bj) {
            const int cl = (u.pn & 1) * BM + bj * HALF + wc * 32 + 8 * fq, s = cl >> 4, co0 = cl & 15;
#pragma unroll
            for (int ai = 0; ai < 2; ++ai)
#pragma unroll
                for (int m = 0; m < 4; ++m) { const int row = row0 + ai * HALF + m * 16, g = row >> 9, R = row & 511, b = R >> 6, ch = R & 63, t = b * 2048 + ch * 32 + s;
                    f32x4 u0, u1; unpack8(*(const u32x4*)(U + (size_t)row * 640 + s * 16 + co0), u0, u1);
                    const f32x4 d0 = *(const f32x4*)(dskip + g * 16 + co0), d1 = *(const f32x4*)(dskip + g * 16 + co0 + 4);
                    f32x4 y0 = acc[ai][bj][m][0] + d0 * u0, y1 = acc[ai][bj][m][1] + d1 * u1;
#pragma unroll
                    for (int e = 0; e < 4; ++e) { y0[e] = gelu_t(y0[e]); y1[e] = gelu_t(y1[e]); }
                    *(u32x4*)(Y + (size_t)t * 512 + g * 16 + co0) = pack8(y0, y1); }
        }
    }
};
struct SubsetOrder { StaticOrder so; bool active;
    __device__ void init(int M, int N, int Gsub, int csub) { so.init(M, N, Gsub, csub < 0 ? 0 : csub); active = csub >= 0 && csub < Gsub; }
    __device__ bool next(int i, Unit& u) const { return active && so.next(i, u); }
    __device__ __forceinline__ void a_ready(const Unit&) const {}
    __device__ __forceinline__ void done(const Unit&) const {}
    __device__ __forceinline__ long a_off(const Unit&) const { return 0; }
    __device__ __forceinline__ long b_off(const Unit&) const { return 0; } };
struct S5Order1 { int c;
    __device__ bool next(int i, Unit& u) const { if (i > 0 || c < 0 || c >= 64) return false; u.pm = c; u.pn = c >> 1; u.z = 0; return true; }
    __device__ __forceinline__ void a_ready(const Unit&) const {}
    __device__ __forceinline__ void done(const Unit&) const {}
    __device__ __forceinline__ long a_off(const Unit&) const { return 0; }
    __device__ __forceinline__ long b_off(const Unit&) const { return 0; } };
struct S5Order2 { int c;
    __device__ bool next(int i, Unit& u) const { if (i > 0 || c < 0 || c >= 128) return false; const int g = c >> 2; u.pm = g * 2 + ((c >> 1) & 1); u.pn = g * 2 + (c & 1); u.z = 0; return true; }
    __device__ __forceinline__ void a_ready(const Unit&) const {}
    __device__ __forceinline__ void done(const Unit&) const {}
    __device__ __forceinline__ long a_off(const Unit&) const { return 0; }
    __device__ __forceinline__ long b_off(const Unit&) const { return 0; } };
struct GateOrder { int c;
    __device__ bool next(int i, Unit& u) const { int id; if (c < 128) { if (i >= 2) return false; id = c * 2 + i; } else { if (i >= 4) return false; id = 256 + (c - 128) * 4 + i; } u.pm = id / 12; u.pn = id % 12; u.z = 0; return true; }
    __device__ __forceinline__ void a_ready(const Unit&) const {}
    __device__ __forceinline__ void done(const Unit&) const {}
    __device__ __forceinline__ long a_off(const Unit&) const { return 0; }
    __device__ __forceinline__ long b_off(const Unit&) const { return 0; } };
struct MergeOrder { StaticOrder so; long aoff[3];
    __device__ bool next(int i, Unit& u) const { if (i >= 3) return false; if (!so.next(0, u)) return false; u.z = i; return true; }
    __device__ __forceinline__ void a_ready(const Unit&) const {}
    __device__ __forceinline__ void done(const Unit&) const {}
    __device__ __forceinline__ long a_off(const Unit& u) const { return u.z == 0 ? aoff[0] : (u.z == 1 ? aoff[1] : aoff[2]); }
    __device__ __forceinline__ long b_off(const Unit& u) const { return (long)u.z * 1024 * 512 * 2; } };
}
#define GAS __attribute__((address_space(1)))
#define LAS __attribute__((address_space(3)))
typedef unsigned short bf16;
typedef unsigned v4u __attribute__((ext_vector_type(4)));
typedef float f32x4 __attribute__((ext_vector_type(4)));
typedef short bf16x8 __attribute__((ext_vector_type(8)));
typedef GAS unsigned gu32;
typedef GAS unsigned long long gu64;
#define RLX_AGENT __ATOMIC_RELAXED, __HIP_MEMORY_SCOPE_AGENT
#define LDS_WAIT() asm volatile("s_waitcnt lgkmcnt(0)" ::: "memory")
#define VM_WAIT() asm volatile("s_waitcnt vmcnt(0)" ::: "memory")
__device__ __forceinline__ unsigned long long rt() { return __builtin_amdgcn_s_memrealtime(); }
__device__ __forceinline__ unsigned f2bf(float f) { unsigned u = __builtin_bit_cast(unsigned, f); return (u + 0x7fffu + ((u >> 16) & 1u)) >> 16; }
__device__ __forceinline__ unsigned pk2(float lo, float hi) { return f2bf(lo) | (f2bf(hi) << 16); }

#define XB_TMO      128
#define XB_XCNT(j)  (256  + 64 * (j))
#define XB_XSUB(j)  (1280 + 64 * (j))
#define XB_XGEN(j)  (2304 + 64 * (j))
#define XB_TOP      3328
#define XB_TOPGEN   3392
#define XCD_BAR_WORDS 3456
#define XB_SPIN_CAP (1u << 18)

__device__ __forceinline__ unsigned xb_ld(unsigned* p)              { return __hip_atomic_load(p, __ATOMIC_RELAXED, __HIP_MEMORY_SCOPE_AGENT); }
__device__ __forceinline__ unsigned xb_add(unsigned* p, unsigned v) { return __hip_atomic_fetch_add(p, v, __ATOMIC_RELAXED, __HIP_MEMORY_SCOPE_AGENT); }
__device__ __forceinline__ unsigned xb_xcc_id() { return (unsigned)__builtin_amdgcn_s_getreg((3 << 11) | 20) & 0xFu; }
#define XB_SPIN(cond, bar) do { unsigned _sp = 0; while (cond) { __builtin_amdgcn_s_sleep(1); \
    if ((++_sp & 255u) == 0u) { if (xb_ld(&(bar)[XB_TMO])) break; if (_sp > XB_SPIN_CAP) { atomicAdd(&(bar)[XB_TMO], 1u); break; } } } } while (0)

struct XcdBarrier {
    unsigned* bar; unsigned x;
    volatile LAS unsigned* st;
};

__device__ __forceinline__ XcdBarrier xcd_barrier_post(unsigned* bar, volatile LAS unsigned* st, bool leader) {
    XcdBarrier b; b.bar = bar; b.x = xb_xcc_id(); b.st = st;
    if (leader) (void)xb_add(&bar[XB_XCNT(b.x)], 1u);
    return b;
}
__device__ __forceinline__ void xcd_barrier_complete(unsigned* bar, unsigned x, unsigned& nloc, unsigned& nx) {
    const unsigned G = gridDim.x * gridDim.y * gridDim.z;
    unsigned sum, cnt, mine, sp = 0u;
    for (;;) {
        sum = 0u; cnt = 0u; mine = 0u;
#pragma unroll
        for (unsigned j = 0; j < 16; ++j) { const unsigned c = xb_ld(&bar[XB_XCNT(j)]); sum += c; cnt += (c > 0u) ? 1u : 0u; mine = (j == x) ? c : mine; }
        if (sum == G) break;
        __builtin_amdgcn_s_sleep(1);
        if ((++sp & 255u) == 0u) { if (xb_ld(&bar[XB_TMO])) break; if (sp > XB_SPIN_CAP) { atomicAdd(&bar[XB_TMO], 1u); break; } }
    }
    nloc = mine > 0u ? mine : 1u; nx = cnt > 0u ? cnt : 1u;
}

__device__ __forceinline__ void xcd_barrier(const XcdBarrier& b, bool leader) {
    asm volatile("s_waitcnt vmcnt(0)" ::: "memory");
    __syncthreads();
    if (leader) {
        unsigned* bar = b.bar;
        __builtin_amdgcn_s_waitcnt(0);
        unsigned nloc = b.st[0], nx = b.st[1];
        if (nloc == 0u) { xcd_barrier_complete(bar, b.x, nloc, nx); b.st[0] = nloc; b.st[1] = nx; }
        const unsigned old = xb_add(&bar[XB_XSUB(b.x)], 1u);
        const unsigned gen = old / nloc;
        if (old + 1u == (gen + 1u) * nloc) {
            __builtin_amdgcn_fence(__ATOMIC_RELEASE, "agent");
            asm volatile("s_waitcnt vmcnt(0)" ::: "memory");
            const unsigned og = xb_add(&bar[XB_TOP], 1u);
            const unsigned tg = og / nx;
            if (og + 1u == (tg + 1u) * nx) xb_add(&bar[XB_TOPGEN], 1u);
            else XB_SPIN(xb_ld(&bar[XB_TOPGEN]) == tg, bar);
            __builtin_amdgcn_fence(__ATOMIC_ACQUIRE, "agent");
            xb_add(&bar[XB_XGEN(b.x)], 1u);
            asm volatile("s_waitcnt vmcnt(0)" ::: "memory");
        } else {
            XB_SPIN(xb_ld(&bar[XB_XGEN(b.x)]) == gen, bar);
            __builtin_amdgcn_fence(__ATOMIC_ACQUIRE, "agent");
            asm volatile("s_waitcnt vmcnt(0)" ::: "memory");
        }
    }
    __syncthreads();
}
constexpr int NWAVES = 8, NTHR = 512;
constexpr int RING_OFF = 0, RING_BYTES = 131072;
constexpr int LDSCTL_OFF = RING_BYTES, MISC_OFF = LDSCTL_OFF + 320;
constexpr int LDS_BYTES = 147456;
constexpr size_t CTL_ZERO_BYTES = 1 * MiB;
constexpr int CW_TMO = 0, CW_BAR = 4096;
constexpr int NPH = 9;
constexpr int FL_NO_DSA = 1, FL_NO_CROSS = 2, FL_NO_S5 = 4;
constexpr size_t WS_LAM32 = WS_BIASL + 8192;

struct Args { const float* in[29]; float* out; unsigned char* ws; int ph_lo, ph_hi, flags, li; };

__device__ __forceinline__ float wave_sum(float v) {
#pragma unroll
    for (int o = 1; o < 64; o <<= 1) v += __shfl_xor(v, o);
    return v;
}
__device__ __forceinline__ float p0_src(int mode, const float* W, const float* W2, const float* gain, int N, int k, int d) {
    if (mode == 0) return W[(size_t)k * N + d];
    if (mode == 1) { if (d >= 1736 && d < 1792) return 0.f; const int s = d >= 1792 ? d - 56 : d; return W[(size_t)k * N + s]; }
    const int tile = d >> 8, w = d & 255, f = tile * 128 + (w & 127); return ((w < 128) ? W : W2)[(size_t)k * N + f] * gain[k];
}
__device__ __forceinline__ void p0_transpose_item(int mode, const float* W, const float* W2, const float* gain, int K, int N, int ND, bf16* WT, LAS float* scr, int item, int lane) {
    const int nblk = ND / 32, kb = item / nblk, nb = item % nblk, k0 = 64 * kb, d0 = 32 * nb;
    float tv[32];
#pragma unroll
    for (int i = 0; i < 32; ++i) tv[i] = p0_src(mode, W, W2, gain, N, k0 + 2 * i + (lane >> 5), d0 + (lane & 31));
#pragma unroll
    for (int i = 0; i < 32; ++i) scr[(2 * i + (lane >> 5)) * 33 + (lane & 31)] = tv[i];
    LDS_WAIT(); asm volatile("" ::: "memory");
    const int c = lane & 7;
#pragma unroll
    for (int j = 0; j < 4; ++j) { const int n = (lane >> 3) + 8 * j; const LAS float* s = scr + (8 * c) * 33 + n;
        v4u o; o.x = pk2(s[0 * 33], s[1 * 33]); o.y = pk2(s[2 * 33], s[3 * 33]); o.z = pk2(s[4 * 33], s[5 * 33]); o.w = pk2(s[6 * 33], s[7 * 33]);
        *(GAS v4u*)(WT + (size_t)(d0 + n) * K + k0 + 8 * c) = o; }
    LDS_WAIT(); asm volatile("" ::: "memory");
}
__device__ __forceinline__ void rms_row_to_bf16(const float* xrow, const float* g, bf16* orow, int lane) {
    const GAS f32x4* xr = (const GAS f32x4*)xrow + lane; const GAS f32x4* gr = (const GAS f32x4*)g + lane;
    f32x4 v[4]; float s = 0.f;
#pragma unroll
    for (int j = 0; j < 4; ++j) { v[j] = xr[64 * j]; s += (v[j].x * v[j].x + v[j].y * v[j].y) + (v[j].z * v[j].z + v[j].w * v[j].w); }
    const float rstd = 1.f / sqrtf(wave_sum(s) * (1.f / 1024.f) + 1e-6f);
    GAS unsigned long long* o8 = (GAS unsigned long long*)orow + lane;
#pragma unroll
    for (int j = 0; j < 4; ++j) { const f32x4 gg = gr[64 * j];
        o8[64 * j] = (unsigned long long)pk2(v[j].x * rstd * gg.x, v[j].y * rstd * gg.y) | ((unsigned long long)pk2(v[j].z * rstd * gg.z, v[j].w * rstd * gg.w) << 32); }
}
__device__ __forceinline__ int t5_bucket(int n) {
    if (n < 16) return n;
    const int large = 16 + (int)((logf((float)n / 16.f) / 2.0794415416798357f) * 16.f);
    return large < 31 ? large : 31;
}
__device__ __forceinline__ void p0_s5_tables(int g, int part, const Args& a, LAS unsigned char* lds, int tid) {
    typedef float f32x2v __attribute__((ext_vector_type(2)));
    LAS f32x2v* POW = (LAS f32x2v*)lds;
    LAS f32x2v* BB = POW + 33 * 64;
    LAS f32x2v* CC = BB + 64 * 16;
    LAS float* KT = (LAS float*)(CC + 16 * 64);
    const float *a_re = a.in[8], *a_im = a.in[9], *log_dt = a.in[10], *b_re = a.in[11], *b_im = a.in[12], *c_re = a.in[13], *c_im = a.in[14];
    bf16* TV = (bf16*)(a.ws + WS_S5TV) + (size_t)g * 512 * 640; bf16* Wt = (bf16*)(a.ws + WS_S5W) + (size_t)g * 256 * 512; float* LAM32 = (float*)(a.ws + WS_LAM32) + g * 128;
    const double dt = exp((double)log_dt[g]);
    for (int idx = tid; idx < 33 * 64; idx += NTHR) { const int j = idx >> 6, n = idx & 63; const double lr = a_re[g * 64 + n], li = a_im[g * 64 + n];
        const double mag = exp(lr * dt * j), ang = li * dt * j; POW[idx] = (f32x2v){(float)(mag * cos(ang)), (float)(mag * sin(ang))}; }
    for (int idx = tid; idx < 64 * 16; idx += NTHR) { const int n = idx >> 4, c = idx & 15; const double lr = a_re[g * 64 + n], li = a_im[g * 64 + n];
        const double mag = exp(lr * dt), lbr = mag * cos(li * dt), lbi = mag * sin(li * dt), nr = lbr - 1.0, ni = lbi, den = lr * lr + li * li;
        const double fr = (nr * lr + ni * li) / den, fi = (ni * lr - nr * li) / den, br = b_re[(g * 64 + n) * 16 + c], bi = b_im[(g * 64 + n) * 16 + c];
        BB[idx] = (f32x2v){(float)(fr * br - fi * bi), (float)(fr * bi + fi * br)};
        const int c2 = idx >> 6, n2 = idx & 63; CC[idx] = (f32x2v){c_re[(g * 16 + c2) * 64 + n2], c_im[(g * 16 + c2) * 64 + n2]}; }
    __syncthreads();
    if (part == 0 && tid < 64) { const f32x2v p = POW[32 * 64 + tid]; LAM32[tid * 2] = p.x; LAM32[tid * 2 + 1] = p.y; }
    for (int idx = tid; idx < 32 * 32; idx += NTHR) { const int j = idx >> 5, co = 2 * part + ((idx >> 4) & 1), ci = idx & 15; float s = 0.f;
#pragma unroll 2
        for (int n = 0; n < 64; ++n) { const f32x2v c = CC[co * 64 + n], p = POW[j * 64 + n], b = BB[n * 16 + ci];
            const float cpr = c.x * p.x - c.y * p.y, cpi = c.x * p.y + c.y * p.x; s += cpr * b.x - cpi * b.y; }
        KT[j * 256 + co * 16 + ci] = s; }
    __syncthreads();
    for (int id = tid; id < 64 * 80; id += NTHR) { const int rl = id / 80, c8 = id % 80, so = rl >> 1, co = 2 * part + (rl & 1), row = so * 16 + co; float v[8];
        if (c8 < 64) { const int si = c8 >> 1, ci0 = (c8 & 1) * 8;
#pragma unroll
            for (int e = 0; e < 8; ++e) v[e] = so >= si ? KT[(so - si) * 256 + co * 16 + ci0 + e] : 0.f; }
        else {
#pragma unroll
            for (int e = 0; e < 8; ++e) { const int np = (c8 - 64) * 8 + e, n = np & 63; const f32x2v c = CC[co * 64 + n], p = POW[(so + 1) * 64 + n];
                v[e] = np < 64 ? (c.x * p.x - c.y * p.y) : -(c.x * p.y + c.y * p.x); } }
        v4u o; o.x = pk2(v[0], v[1]); o.y = pk2(v[2], v[3]); o.z = pk2(v[4], v[5]); o.w = pk2(v[6], v[7]);
        *(GAS v4u*)(TV + (size_t)row * 640 + c8 * 8) = o; }
    for (int id = tid; id < 16 * 64; id += NTHR) { const int np = 16 * part + (id >> 6), c8 = id & 63, n = np & 63, s = c8 >> 1, ci0 = (c8 & 1) * 8; const f32x2v p = POW[(31 - s) * 64 + n]; float v[8];
#pragma unroll
        for (int e = 0; e < 8; ++e) { const f32x2v b = BB[n * 16 + ci0 + e]; v[e] = np < 64 ? (p.x * b.x - p.y * b.y) : (p.x * b.y + p.y * b.x); }
        v4u o; o.x = pk2(v[0], v[1]); o.y = pk2(v[2], v[3]); o.z = pk2(v[4], v[5]); o.w = pk2(v[6], v[7]);
        *(GAS v4u*)(Wt + (size_t)np * 512 + c8 * 8) = o; }
    __syncthreads();
}
__device__ __forceinline__ void p0_prologue(const Args& a, LAS unsigned char* lds, int tid, int lane, int wave, int vcu, int G) {
    unsigned char* ws = a.ws;
    LAS float* scr = (LAS float*)(lds + RING_OFF + wave * 16384);
    const int gw = vcu * NWAVES + wave, NGW = G * NWAVES;
    p0_s5_tables(vcu >> 3, vcu & 7, a, lds, tid);
    if (blockIdx.x == 33 && tid == 0) {
        float gq = 0.f, gk = 0.f, bm = 0.f; for (int i = 0; i < 128; ++i) { gq = fmaxf(gq, fabsf(a.in[5][i])); gk = fmaxf(gk, fabsf(a.in[6][i])); }
        for (int i = 0; i < 256; ++i) bm = fmaxf(bm, fabsf(a.in[2][i]));
        const float B = 1.02f * 128.f * 0.08838834764831845f * 1.4426950408889634f * gq * gk + bm * 1.4426950408889634f;
        ((float*)(ws + WS_BIASL))[1032] = (B > 0.f && B <= 56.f) ? B : 0.f; }
    if (blockIdx.x == 32) { float* BL = (float*)(ws + WS_BIASL); const float* rb = a.in[2];
        for (int i = tid; i < 8 * 128 + 8; i += NTHR) { if (i < 1024) { const int h = i >> 7, d = i & 127; BL[i] = rb[t5_bucket(d) * 8 + h] * 1.4426950408889634f; } else BL[i] = rb[31 * 8 + (i - 1024)] * 1.4426950408889634f; } }
    { bf16* WUV = (bf16*)(ws + WS_WUV); const float* w = a.in[7];
        for (int i = blockIdx.x * NTHR + tid; i < 8 * 64 * 128; i += G * NTHR) { const int h = i >> 13, e = (i >> 7) & 63, d = i & 127; WUV[i] = (bf16)f2bf(w[(h * 128 + d) * 64 + e]); } }
    constexpr int I_IN = 16 * 184, I_MKV = 16 * 32, I_GLU = 8 * 16, I_BR = 8 * 32, I_OUT = 16 * 32, I_GU = 16 * 176, I_D = 44 * 32;
    constexpr int NITEMS = I_IN + I_MKV + I_GLU + 3 * I_BR + I_OUT + I_GU + I_D;
    for (int it = gw; it < NITEMS; it += NGW) {
        int r = it;
        if (r < I_IN) { p0_transpose_item(1, a.in[3], nullptr, nullptr, 1024, 5832, 5888, (bf16*)(ws + WS_WIN), scr, r, lane); continue; } r -= I_IN;
        if (r < I_MKV) { p0_transpose_item(0, a.in[18], nullptr, nullptr, 1024, 1024, 1024, (bf16*)(ws + WS_WMKV), scr, r, lane); continue; } r -= I_MKV;
        if (r < I_GLU) { p0_transpose_item(0, a.in[16], nullptr, nullptr, 512, 512, 512, (bf16*)(ws + WS_WGLU), scr, r, lane); continue; } r -= I_GLU;
        if (r < 3 * I_BR) { const int br = r / I_BR; p0_transpose_item(0, a.in[21 + br], nullptr, nullptr, 512, 1024, 1024, (bf16*)(ws + WS_WBR) + (size_t)br * 1024 * 512, scr, r % I_BR, lane); continue; } r -= 3 * I_BR;
        if (r < I_OUT) { p0_transpose_item(0, a.in[24], nullptr, nullptr, 1024, 1024, 1024, (bf16*)(ws + WS_WOUT), scr, r, lane); continue; } r -= I_OUT;
        if (r < I_GU) { p0_transpose_item(2, a.in[26], a.in[27], a.in[25], 1024, 2816, 5632, (bf16*)(ws + WS_WGU), scr, r, lane); continue; } r -= I_GU;
        p0_transpose_item(0, a.in[28], nullptr, nullptr, 2816, 1024, 1024, (bf16*)(ws + WS_WD), scr, r, lane);
    }
    for (int m = gw; m < T_TOK; m += 2 * NGW) {
        const GAS f32x4* x0 = (const GAS f32x4*)(a.in[0] + (size_t)m * 1024) + lane; const GAS f32x4* x1 = (const GAS f32x4*)(a.in[0] + (size_t)(m + NGW) * 1024) + lane; const GAS f32x4* gr = (const GAS f32x4*)a.in[4] + lane;
        f32x4 v0[4], v1[4]; float s0 = 0.f, s1 = 0.f;
#pragma unroll
        for (int j = 0; j < 4; ++j) { v0[j] = x0[64 * j]; v1[j] = x1[64 * j]; }
#pragma unroll
        for (int j = 0; j < 4; ++j) { s0 += (v0[j].x * v0[j].x + v0[j].y * v0[j].y) + (v0[j].z * v0[j].z + v0[j].w * v0[j].w); s1 += (v1[j].x * v1[j].x + v1[j].y * v1[j].y) + (v1[j].z * v1[j].z + v1[j].w * v1[j].w); }
        const float r0 = 1.f / sqrtf(wave_sum(s0) * (1.f / 1024.f) + 1e-6f), r1 = 1.f / sqrtf(wave_sum(s1) * (1.f / 1024.f) + 1e-6f);
        GAS unsigned long long* o0 = (GAS unsigned long long*)((bf16*)(ws + WS_H) + (size_t)m * 1024) + lane; GAS unsigned long long* o1 = (GAS unsigned long long*)((bf16*)(ws + WS_H) + (size_t)(m + NGW) * 1024) + lane;
#pragma unroll
        for (int j = 0; j < 4; ++j) { const f32x4 gg = gr[64 * j];
            o0[64 * j] = (unsigned long long)pk2(v0[j].x * r0 * gg.x, v0[j].y * r0 * gg.y) | ((unsigned long long)pk2(v0[j].z * r0 * gg.z, v0[j].w * r0 * gg.w) << 32);
            o1[64 * j] = (unsigned long long)pk2(v1[j].x * r1 * gg.x, v1[j].y * r1 * gg.y) | ((unsigned long long)pk2(v1[j].z * r1 * gg.z, v1[j].w * r1 * gg.w) << 32); }
    }
    for (int m = gw; m < 2048; m += NGW) rms_row_to_bf16(a.in[1] + (size_t)m * 1024, a.in[17], (bf16*)(ws + WS_MEMN) + (size_t)m * 1024, lane);
}
__device__ __forceinline__ void norm128_pass(bf16* X, int rows, int ld, int ngroups, const float* g, int gtid, int nthr) {
    const int l = gtid & 15, total = rows * ngroups;
    for (int gid = gtid >> 4; gid < total; gid += nthr >> 4) {
        const int r = gid / ngroups, gi = gid % ngroups;
        bf16* p = X + (size_t)r * ld + gi * 128 + l * 8;
        const v4u v = *(const GAS v4u*)p; float f[8];
        f[0] = __uint_as_float(v.x << 16); f[1] = __uint_as_float(v.x & 0xffff0000u); f[2] = __uint_as_float(v.y << 16); f[3] = __uint_as_float(v.y & 0xffff0000u);
        f[4] = __uint_as_float(v.z << 16); f[5] = __uint_as_float(v.z & 0xffff0000u); f[6] = __uint_as_float(v.w << 16); f[7] = __uint_as_float(v.w & 0xffff0000u);
        float s = 0.f;
#pragma unroll
        for (int q = 0; q < 8; ++q) s += f[q] * f[q];
        s += __shfl_xor(s, 8); s += __shfl_xor(s, 4); s += __shfl_xor(s, 2); s += __shfl_xor(s, 1);
        const float rs = 1.f / sqrtf(s * (1.f / 128.f) + 1e-6f);
        const f32x4 g0 = *(const GAS f32x4*)(g + l * 8), g1 = *(const GAS f32x4*)(g + l * 8 + 4);
        v4u o; o.x = pk2(f[0] * rs * g0.x, f[1] * rs * g0.y); o.y = pk2(f[2] * rs * g0.z, f[3] * rs * g0.w); o.z = pk2(f[4] * rs * g1.x, f[5] * rs * g1.y); o.w = pk2(f[6] * rs * g1.z, f[7] * rs * g1.w);
        *(GAS v4u*)p = o;
    }
}
__device__ __forceinline__ void s5_scan(int g, int half, const Args& a, int tid) {
    if (tid < 256) {
        const int bl = tid >> 6, n = tid & 63, b = half * 4 + bl;
        const float* LAM32 = (const float*)(a.ws + WS_LAM32) + g * 128; const float lr = LAM32[n * 2], li = LAM32[n * 2 + 1];
        const float* SL = (const float*)(a.ws + WS_SLOC) + ((size_t)(g * 512 + b * 64)) * 128; bf16* Ur = (bf16*)(a.ws + WS_U) + ((size_t)(g * 512 + b * 64)) * 640 + 512;
        float xr = 0.f, xi = 0.f;
        for (int ch = 0; ch < 64; ++ch) {
            Ur[(size_t)ch * 640 + n] = (bf16)f2bf(xr); Ur[(size_t)ch * 640 + 64 + n] = (bf16)f2bf(xi);
            const float sr = SL[(size_t)ch * 128 + n], si = SL[(size_t)ch * 128 + 64 + n];
            const float nr = lr * xr - li * xi + sr, ni = lr * xi + li * xr + si; xr = nr; xi = ni;
        }
    }
    VM_WAIT(); __syncthreads();
}
namespace nv {
typedef unsigned short bf16;
__device__ __forceinline__ unsigned f2bf(float f) { unsigned u = __float_as_uint(f); return (u + 0x7fffu + ((u >> 16) & 1u)) >> 16; }
__device__ __forceinline__ float bf2f(unsigned short b) { return __uint_as_float((unsigned)b << 16); }

__global__ void k_transpose(const float* __restrict__ W, const float* __restrict__ W2, const float* __restrict__ gain,
                            bf16* __restrict__ WT, int K, int N, int ND, int mode) {
    const size_t total = (size_t)ND * K;
    for (size_t i = (size_t)blockIdx.x * blockDim.x + threadIdx.x; i < total; i += (size_t)gridDim.x * blockDim.x) {
        const int d = (int)(i / K), k = (int)(i % K);
        float v;
        if (mode == 0) v = W[(size_t)k * N + d];
        else if (mode == 1) { if (d >= 1736 && d < 1792) v = 0.f; else { const int s = d >= 1792 ? d - 56 : d; v = W[(size_t)k * N + s]; } }
        else { const int tile = d >> 8, w = d & 255, f = tile * 128 + (w & 127); v = ((w < 128) ? W : W2)[(size_t)k * N + f] * gain[k]; }
        WT[i] = (bf16)f2bf(v);
    }
}
__global__ void k_wuv(const float* __restrict__ W, bf16* __restrict__ WT) {
    const int i = blockIdx.x * blockDim.x + threadIdx.x; if (i >= 8 * 64 * 128) return;
    const int h = i / (64 * 128), e = (i / 128) % 64, d = i % 128;
    WT[i] = (bf16)f2bf(W[(h * 128 + d) * 64 + e]);
}
__global__ void k_rmsnorm1024(const float* __restrict__ x, const float* __restrict__ g, bf16* __restrict__ out, int rows) {
    __shared__ float red[4];
    const int r = blockIdx.x; if (r >= rows) return;
    const float4 v = ((const float4*)(x + (size_t)r * 1024))[threadIdx.x];
    float s = v.x * v.x + v.y * v.y + v.z * v.z + v.w * v.w;
    for (int o = 32; o; o >>= 1) s += __shfl_xor(s, o);
    if ((threadIdx.x & 63) == 0) red[threadIdx.x >> 6] = s;
    __syncthreads();
    const float tot = red[0] + red[1] + red[2] + red[3];
    const float rs = rsqrtf(tot * (1.f / 1024.f) + 1e-6f);
    const float4 gg = ((const float4*)g)[threadIdx.x];
    bf16* o = out + (size_t)r * 1024 + threadIdx.x * 4;
    o[0] = (bf16)f2bf(v.x * rs * gg.x); o[1] = (bf16)f2bf(v.y * rs * gg.y); o[2] = (bf16)f2bf(v.z * rs * gg.z); o[3] = (bf16)f2bf(v.w * rs * gg.w);
}
__device__ __forceinline__ int t5_bucket(int n) {
    if (n < 16) return n;
    const float nf = (float)n;
    int large = 16 + (int)((logf(nf / 16.f) / 2.0794415416798357f) * 16.f);
    return large < 31 ? large : 31;
}
__global__ void k_biaslut(const float* __restrict__ rel_bias, float* __restrict__ BL) {
    const int i = blockIdx.x * blockDim.x + threadIdx.x;
    if (i < 8 * 128) { const int h = i / 128, d = i % 128; BL[i] = rel_bias[t5_bucket(d) * 8 + h] * 1.4426950408889634f; }
    else if (i < 8 * 128 + 8) { const int h = i - 8 * 128; BL[i] = rel_bias[31 * 8 + h] * 1.4426950408889634f; }
}

template <class Epi>
__global__ void __launch_bounds__(256) k_gemm(const bf16* __restrict__ A, const bf16* __restrict__ Bt, int M, int N, int K, Epi epi) {
    const int tx = threadIdx.x & 15, ty = threadIdx.x >> 4;
    const int n0 = (blockIdx.x * 16 + tx) * 4, m0 = (blockIdx.y * 16 + ty) * 4;
    if (n0 >= N || m0 >= M) return;
    float acc[4][4];
#pragma unroll
    for (int i = 0; i < 4; ++i)
#pragma unroll
        for (int j = 0; j < 4; ++j) acc[i][j] = 0.f;
    for (int k = 0; k < K; k += 8) {
        uint4 a[4], b[4];
#pragma unroll
        for (int i = 0; i < 4; ++i) { a[i] = *(const uint4*)(A + (size_t)(m0 + i) * K + k); b[i] = *(const uint4*)(Bt + (size_t)(n0 + i) * K + k); }
#pragma unroll
        for (int i = 0; i < 4; ++i) {
            const unsigned aw[4] = {a[i].x, a[i].y, a[i].z, a[i].w};
#pragma unroll
            for (int j = 0; j < 4; ++j) {
                const unsigned bw[4] = {b[j].x, b[j].y, b[j].z, b[j].w};
#pragma unroll
                for (int q = 0; q < 4; ++q) {
                    acc[i][j] += __uint_as_float(aw[q] << 16) * __uint_as_float(bw[q] << 16);
                    acc[i][j] += __uint_as_float(aw[q] & 0xffff0000u) * __uint_as_float(bw[q] & 0xffff0000u);
                }
            }
        }
    }
#pragma unroll
    for (int i = 0; i < 4; ++i)
#pragma unroll
        for (int j = 0; j < 4; ++j) epi(m0 + i, n0 + j, acc[i][j]);
}

struct EpiInproj {
    bf16 *QD, *CKV, *QI, *KI, *U, *QX; float* WI;
    __device__ void operator()(int t, int c, float v) const {
        if (c < 1024) QD[(size_t)t * 1024 + c] = (bf16)f2bf(v);
        else if (c < 1152) CKV[(size_t)t * 128 + (c - 1024)] = (bf16)f2bf(v);
        else if (c < 1664) QI[(size_t)t * 512 + (c - 1152)] = (bf16)f2bf(v);
        else if (c < 1728) KI[(size_t)t * 64 + (c - 1664)] = (bf16)f2bf(v);
        else if (c < 1792) { if (c < 1736) WI[(size_t)t * 8 + (c - 1728)] = v; }
        else if (c < 2304) { const int cu = c - 1792, g = cu >> 4, ci = cu & 15, b = t >> 11, tt = t & 2047, R = b * 64 + (tt >> 5), s = tt & 31;
            U[((size_t)(g * 512 + R)) * 640 + s * 16 + ci] = (bf16)f2bf(v); }
        else QX[(size_t)t * 512 + (c - 2304)] = (bf16)f2bf(v);
    }
};
struct EpiBf16Split { bf16* O0; bf16* O1; int split; int ld;
    __device__ void operator()(int m, int c, float v) const { if (c < split) O0[(size_t)m * ld + c] = (bf16)f2bf(v); else O1[(size_t)m * ld + (c - split)] = (bf16)f2bf(v); } };
struct EpiGlu { const bf16* Y; bf16* O;
    __device__ void operator()(int m, int c, float v) const { const float y = bf2f(Y[(size_t)m * 512 + c]); O[(size_t)m * 512 + c] = (bf16)f2bf(y / (1.f + __expf(-v))); } };
struct EpiSigmoid { bf16* G; __device__ void operator()(int m, int c, float v) const { G[(size_t)m * 1024 + c] = (bf16)f2bf(1.f / (1.f + __expf(-v))); } };
struct EpiMerge { const bf16* G; bf16* MG; int first; int pad;
    __device__ void operator()(int m, int c, float v) const { const size_t i = (size_t)m * 1024 + c; float p = first ? 0.f : bf2f(MG[i]); MG[i] = (bf16)f2bf(p + bf2f(G[i]) * v); } };
struct EpiOut { const float* x; float* x1; bf16* XN;
    __device__ void operator()(int m, int c, float v) const { const size_t i = (size_t)m * 1024 + c; const float r = x[i] + v; x1[i] = r; XN[i] = (bf16)f2bf(r); } };
struct EpiDown { float* out;
    __device__ void operator()(int m, int c, float v) const { const size_t i = (size_t)m * 1024 + c; out[i] = out[i] + v; } };
struct EpiF32 { float* C; int ld; __device__ void operator()(int m, int c, float v) const { C[(size_t)m * ld + c] = v; } };

__global__ void k_rowss(const float* __restrict__ x1, float* __restrict__ RS) {
    const int t = blockIdx.x, q = threadIdx.x >> 6, l = threadIdx.x & 63;
    const float4 v = ((const float4*)(x1 + (size_t)t * 1024 + q * 256))[l];
    float s = v.x * v.x + v.y * v.y + v.z * v.z + v.w * v.w;
    for (int o = 32; o; o >>= 1) s += __shfl_xor(s, o);
    if (l == 0) RS[t * 16 + q] = s;
    if (l >= 4 && l < 16 && q == 0) RS[t * 16 + l] = 0.f;
}
__global__ void __launch_bounds__(256) k_gemm_gu(const bf16* __restrict__ A, const bf16* __restrict__ Bt, const float* __restrict__ RS, bf16* __restrict__ ACT) {
    const int K = 1024;
    const int tx = threadIdx.x & 15, ty = threadIdx.x >> 4;
    const int f0 = (blockIdx.x * 16 + tx) * 4, m0 = (blockIdx.y * 16 + ty) * 4;
    float ag[4][4], au[4][4];
#pragma unroll
    for (int i = 0; i < 4; ++i)
#pragma unroll
        for (int j = 0; j < 4; ++j) { ag[i][j] = 0.f; au[i][j] = 0.f; }
    for (int k = 0; k < K; k += 8) {
        uint4 a[4], bg[4], bu[4];
#pragma unroll
        for (int i = 0; i < 4; ++i) { a[i] = *(const uint4*)(A + (size_t)(m0 + i) * K + k);
            const int f = f0 + i, rg = (f >> 7) * 256 + (f & 127);
            bg[i] = *(const uint4*)(Bt + (size_t)rg * K + k); bu[i] = *(const uint4*)(Bt + (size_t)(rg + 128) * K + k); }
#pragma unroll
        for (int i = 0; i < 4; ++i) {
            const unsigned aw[4] = {a[i].x, a[i].y, a[i].z, a[i].w};
#pragma unroll
            for (int j = 0; j < 4; ++j) {
                const unsigned gw[4] = {bg[j].x, bg[j].y, bg[j].z, bg[j].w};
                const unsigned uw[4] = {bu[j].x, bu[j].y, bu[j].z, bu[j].w};
#pragma unroll
                for (int q = 0; q < 4; ++q) {
                    const float alo = __uint_as_float(aw[q] << 16), ahi = __uint_as_float(aw[q] & 0xffff0000u);
                    ag[i][j] += alo * __uint_as_float(gw[q] << 16); ag[i][j] += ahi * __uint_as_float(gw[q] & 0xffff0000u);
                    au[i][j] += alo * __uint_as_float(uw[q] << 16); au[i][j] += ahi * __uint_as_float(uw[q] & 0xffff0000u);
                }
            }
        }
    }
#pragma unroll
    for (int i = 0; i < 4; ++i) { const int m = m0 + i;
        float tot = 0.f; for (int q = 0; q < 16; ++q) tot += RS[m * 16 + q];
        const float rs = rsqrtf(tot * (1.f / 1024.f) + 1e-6f);
#pragma unroll
        for (int j = 0; j < 4; ++j) { const float g = ag[i][j] * rs, u = au[i][j] * rs;
            ACT[(size_t)m * 2816 + f0 + j] = (bf16)f2bf(g / (1.f + __expf(-g)) * u); } }
}

__global__ void k_norm128(bf16* __restrict__ X, int rows, int ld, int ngroups, const float* __restrict__ g) {
    const int gid = (blockIdx.x * blockDim.x + threadIdx.x) >> 4, l = threadIdx.x & 15;
    const bool ok = gid < rows * ngroups;
    const int r = ok ? gid / ngroups : 0, gi = ok ? gid % ngroups : 0;
    bf16* p = X + (size_t)r * ld + gi * 128 + l * 8;
    uint4 v = *(const uint4*)p; const unsigned w[4] = {v.x, v.y, v.z, v.w};
    float f[8];
#pragma unroll
    for (int q = 0; q < 4; ++q) { f[2 * q] = __uint_as_float(w[q] << 16); f[2 * q + 1] = __uint_as_float(w[q] & 0xffff0000u); }
    float s = 0.f;
#pragma unroll
    for (int q = 0; q < 8; ++q) s += f[q] * f[q];
    for (int o = 8; o; o >>= 1) s += __shfl_xor(s, o);
    const float rs = rsqrtf(s * (1.f / 128.f) + 1e-6f);
    unsigned o4[4];
#pragma unroll
    for (int q = 0; q < 4; ++q) o4[q] = f2bf(f[2 * q] * rs * g[l * 8 + 2 * q]) | (f2bf(f[2 * q + 1] * rs * g[l * 8 + 2 * q + 1]) << 16);
    if (ok) *(uint4*)p = make_uint4(o4[0], o4[1], o4[2], o4[3]);
}

__global__ void __launch_bounds__(256) k_dsa(const bf16* __restrict__ QD, const bf16* __restrict__ CKV, const bf16* __restrict__ QI, const bf16* __restrict__ KI,
                                             const float* __restrict__ WI, const float* __restrict__ BL, const bf16* __restrict__ WUVT, bf16* __restrict__ ODSA) {
    __shared__ float sc[2048];
    __shared__ float qi[512];
    __shared__ float qd[1024];
    __shared__ float wh[8];
    __shared__ int sel[256];
    __shared__ float pr[256];
    __shared__ float ov[128];
    __shared__ float red[8];
    __shared__ int nsel;
    const int row = blockIdx.x, b = row >> 11, t = row & 2047, tid = threadIdx.x;
    for (int i = tid; i < 512; i += 256) qi[i] = bf2f(QI[(size_t)row * 512 + i]);
    for (int i = tid; i < 1024; i += 256) qd[i] = bf2f(QD[(size_t)row * 1024 + i]);
    if (tid < 8) wh[tid] = WI[(size_t)row * 8 + tid];
    if (tid == 0) nsel = 0;
    __syncthreads();
    const int nk = t + 1;
    for (int s = tid; s < nk; s += 256) {
        const bf16* kp = KI + ((size_t)(b * 2048 + s)) * 64;
        float kf[64];
#pragma unroll
        for (int d = 0; d < 64; ++d) kf[d] = bf2f(kp[d]);
        float score = 0.f;
        for (int h = 0; h < 8; ++h) { float dsum = 0.f;
#pragma unroll
            for (int d = 0; d < 64; ++d) dsum += qi[h * 64 + d] * kf[d];
            score += fmaxf(dsum, 0.f) * wh[h]; }
        sc[s] = score;
    }
    __syncthreads();
    for (int s = tid; s < nk; s += 256) {
        bool take;
        if (nk <= 256) take = true;
        else { const float v = sc[s]; int cnt = 0;
            for (int s2 = 0; s2 < nk; ++s2) { const float w = sc[s2]; cnt += (w > v || (w == v && s2 < s)) ? 1 : 0; }
            take = cnt < 256; }
        if (take) { const int p = atomicAdd(&nsel, 1); if (p < 256) sel[p] = s; }
    }
    __syncthreads();
    const int ns = nsel < 256 ? nsel : 256;
    const float scale = 0.08838834764831845f * 1.4426950408889634f;
    for (int h = 0; h < 8; ++h) {
        float lg = -INFINITY;
        if (tid < ns) { const int s = sel[tid]; const bf16* cp = CKV + ((size_t)(b * 2048 + s)) * 128; float dsum = 0.f;
            for (int d = 0; d < 128; ++d) dsum += qd[h * 128 + d] * bf2f(cp[d]);
            const int dist = t - s; const float bias = dist < 128 ? BL[h * 128 + dist] : BL[8 * 128 + h];
            lg = dsum * scale + bias; }
        float m = lg; for (int o = 32; o; o >>= 1) m = fmaxf(m, __shfl_xor(m, o));
        if ((tid & 63) == 0) red[tid >> 6] = m;
        __syncthreads();
        m = fmaxf(fmaxf(red[0], red[1]), fmaxf(red[2], red[3]));
        const float p = (tid < ns) ? exp2f(lg - m) : 0.f;
        float sum = p; for (int o = 32; o; o >>= 1) sum += __shfl_xor(sum, o);
        if ((tid & 63) == 0) red[4 + (tid >> 6)] = sum;
        pr[tid] = p;
        __syncthreads();
        sum = red[4] + red[5] + red[6] + red[7];
        if (tid < 128) { float o = 0.f; for (int k = 0; k < ns; ++k) o += pr[k] * bf2f(CKV[((size_t)(b * 2048 + sel[k])) * 128 + tid]); ov[tid] = o / sum; }
        __syncthreads();
        if (tid < 64) { float o = 0.f; const bf16* wp = WUVT + ((size_t)(h * 64 + tid)) * 128; for (int d = 0; d < 128; ++d) o += ov[d] * bf2f(wp[d]);
            ODSA[(size_t)row * 512 + h * 64 + tid] = (bf16)f2bf(o); }
        __syncthreads();
    }
}

__global__ void __launch_bounds__(256) k_cross(const bf16* __restrict__ QX, const bf16* __restrict__ KX, const bf16* __restrict__ VX, bf16* __restrict__ OX) {
    __shared__ float q[512]; __shared__ float pr[256]; __shared__ float red[8];
    const int row = blockIdx.x, b = row >> 11, tid = threadIdx.x;
    for (int i = tid; i < 512; i += 256) q[i] = bf2f(QX[(size_t)row * 512 + i]);
    __syncthreads();
    const float scale = 0.08838834764831845f * 1.4426950408889634f;
    for (int h = 0; h < 4; ++h) {
        const bf16* kp = KX + ((size_t)(b * 256 + tid)) * 512 + h * 128; float dsum = 0.f;
        for (int d = 0; d < 128; ++d) dsum += q[h * 128 + d] * bf2f(kp[d]);
        const float lg = dsum * scale;
        float m = lg; for (int o = 32; o; o >>= 1) m = fmaxf(m, __shfl_xor(m, o));
        if ((tid & 63) == 0) red[tid >> 6] = m;
        __syncthreads();
        m = fmaxf(fmaxf(red[0], red[1]), fmaxf(red[2], red[3]));
        const float p = exp2f(lg - m);
        float sum = p; for (int o = 32; o; o >>= 1) sum += __shfl_xor(sum, o);
        if ((tid & 63) == 0) red[4 + (tid >> 6)] = sum;
        pr[tid] = p;
        __syncthreads();
        sum = red[4] + red[5] + red[6] + red[7];
        if (tid < 128) { float o = 0.f; for (int k = 0; k < 256; ++k) o += pr[k] * bf2f(VX[((size_t)(b * 256 + k)) * 512 + h * 128 + tid]);
            OX[(size_t)row * 512 + h * 128 + tid] = (bf16)f2bf(o / sum); }
        __syncthreads();
    }
}

__device__ __forceinline__ float gelu_tanh(float x) { const float u = 0.7978845608028654f * (x + 0.044715f * x * x * x); return 0.5f * x * (1.f + tanhf(u)); }
__global__ void __launch_bounds__(64) k_s5(const bf16* __restrict__ U, const float* __restrict__ a_re, const float* __restrict__ a_im, const float* __restrict__ log_dt,
                                           const float* __restrict__ b_re, const float* __restrict__ b_im, const float* __restrict__ c_re, const float* __restrict__ c_im,
                                           const float* __restrict__ d_skip, bf16* __restrict__ Y) {
    const int b = blockIdx.x >> 5, g = blockIdx.x & 31, n = threadIdx.x;
    const double dt = exp((double)log_dt[g]);
    const double lr = (double)a_re[g * 64 + n], li = (double)a_im[g * 64 + n];
    const double mag = exp(lr * dt), lbr = mag * cos(li * dt), lbi = mag * sin(li * dt);
    const double nr = lbr - 1.0, ni = lbi, den = lr * lr + li * li;
    const double fr = (nr * lr + ni * li) / den, fi = (ni * lr - nr * li) / den;
    float Bre[16], Bim[16], Cre[16], Cim[16];
#pragma unroll
    for (int c = 0; c < 16; ++c) { const double br = b_re[(g * 64 + n) * 16 + c], bi = b_im[(g * 64 + n) * 16 + c];
        Bre[c] = (float)(fr * br - fi * bi); Bim[c] = (float)(fr * bi + fi * br);
        Cre[c] = c_re[(g * 16 + c) * 64 + n]; Cim[c] = c_im[(g * 16 + c) * 64 + n]; }
    const float ar = (float)lbr, ai = (float)lbi;
    const float dsk = n < 16 ? d_skip[g * 16 + n] : 0.f;
    float xr = 0.f, xi = 0.f;
    for (int t = 0; t < 2048; ++t) {
        const int R = b * 64 + (t >> 5), s = t & 31;
        const bf16* up = U + ((size_t)(g * 512 + R)) * 640 + s * 16;
        float u[16]; float bur = 0.f, bui = 0.f;
#pragma unroll
        for (int c = 0; c < 16; ++c) { u[c] = bf2f(up[c]); bur += Bre[c] * u[c]; bui += Bim[c] * u[c]; }
        const float nxr = ar * xr - ai * xi + bur, nxi = ar * xi + ai * xr + bui; xr = nxr; xi = nxi;
        float yout = 0.f;
#pragma unroll
        for (int c = 0; c < 16; ++c) { float v = Cre[c] * xr - Cim[c] * xi;
            for (int o = 32; o; o >>= 1) v += __shfl_xor(v, o);
            if (n == c) yout = v + dsk * u[c]; }
        if (n < 16) Y[(size_t)(b * 2048 + t) * 512 + g * 16 + n] = (bf16)f2bf(gelu_tanh(yout));
    }
}
}
#define HAVE_ATTN 1
#ifdef TPROBE
#define TP_STAMP(k) { __builtin_amdgcn_sched_barrier(0); const unsigned long long t_ = __builtin_amdgcn_s_memtime(); tp_acc[k] += t_ - tp_prev; tp_prev = t_; __builtin_amdgcn_sched_barrier(0); }
#define TP_DECL unsigned long long tp_acc[8] = {0, 0, 0, 0, 0, 0, 0, 0}; unsigned long long tp_prev = __builtin_amdgcn_s_memtime();
#define TP_FLUSH(base) { if (blockIdx.x == TPROBE_BLOCK && wave == 0 && lane == 0) { unsigned long long* TP = (unsigned long long*)(a.ws + WS_CTL + 65536); for (int k_ = 0; k_ < 8; ++k_) TP[(base) + k_] += tp_acc[k_]; } }
#else
#define TP_STAMP(k)
#define TP_DECL
#define TP_FLUSH(base)
#endif
namespace att {
typedef float f32x16 __attribute__((ext_vector_type(16)));
typedef short s16x4 __attribute__((ext_vector_type(4)));
typedef short v4i16_t __attribute__((ext_vector_type(4)));
typedef float f32x2_t __attribute__((ext_vector_type(2))); typedef __bf16 bf16x2_t __attribute__((ext_vector_type(2)));
typedef unsigned u32x2 __attribute__((ext_vector_type(2)));
#define MFMA32(a, b, c) __builtin_amdgcn_mfma_f32_32x32x16_bf16((a), (b), (c), 0, 0, 0)
__device__ __forceinline__ unsigned cvtpk(float lo, float hi) { const f32x2_t v = {lo, hi}; const bf16x2_t b = __builtin_convertvector(v, bf16x2_t); return __builtin_bit_cast(unsigned, b); }
__device__ __forceinline__ int crow(int r, int hi) { return (r & 3) + 8 * (r >> 2) + 4 * hi; }
__device__ __forceinline__ unsigned off_b(unsigned row, unsigned ch) { return 256u * row + 16u * (ch ^ (((row & 3u) << 2) | ((row >> 2) & 3u))); }
__device__ __forceinline__ float xh_max(float v) { const auto rr = __builtin_amdgcn_permlane32_swap(__float_as_uint(v), __float_as_uint(v), false, false); return fmaxf(__uint_as_float(rr[0]), __uint_as_float(rr[1])); }
__device__ __forceinline__ float xh_sum(float v) { const auto rr = __builtin_amdgcn_permlane32_swap(__float_as_uint(v), __float_as_uint(v), false, false); return __uint_as_float(rr[0]) + __uint_as_float(rr[1]); }
__device__ __forceinline__ unsigned xh_sumu(unsigned v) { const auto rr = __builtin_amdgcn_permlane32_swap(v, v, false, false); return rr[0] + rr[1]; }
__device__ __forceinline__ unsigned xh_or(unsigned v) { const auto rr = __builtin_amdgcn_permlane32_swap(v, v, false, false); return rr[0] | rr[1]; }
constexpr float SCALE2 = 0.08838834764831845f * 1.4426950408889634f;

__device__ __forceinline__ bf16x8 pack_step(const f32x16& x, int s) {
    v4u p; p.x = cvtpk(x[8 * s], x[8 * s + 1]); p.y = cvtpk(x[8 * s + 2], x[8 * s + 3]); p.z = cvtpk(x[8 * s + 4], x[8 * s + 5]); p.w = cvtpk(x[8 * s + 6], x[8 * s + 7]);
    return __builtin_bit_cast(bf16x8, p);
}
__device__ __forceinline__ void qk_tile(f32x16& p0, f32x16& p1, LAS const unsigned char* kimg, const bf16x8 (&qf)[8], int lane) {
    const unsigned r32 = lane & 31, hi = lane >> 5;
    f32x16 z;
#pragma unroll
    for (int r = 0; r < 16; ++r) z[r] = 0.f;
    p0 = z; p1 = z;
    bf16x8 fa[2][4];
#define QK_LOAD(g, buf) { const unsigned o0_ = off_b(r32, 4 * (g) + hi), o1_ = off_b(r32, 4 * (g) + 2 + hi); \
        fa[buf][0] = *(LAS const bf16x8*)(kimg + o0_); fa[buf][1] = *(LAS const bf16x8*)(kimg + o0_ + 32 * 256); fa[buf][2] = *(LAS const bf16x8*)(kimg + o1_); fa[buf][3] = *(LAS const bf16x8*)(kimg + o1_ + 32 * 256); }
#define QK_MMA(g, buf) { p0 = MFMA32(fa[buf][0], qf[2 * (g)], p0); p1 = MFMA32(fa[buf][1], qf[2 * (g)], p1); p0 = MFMA32(fa[buf][2], qf[2 * (g) + 1], p0); p1 = MFMA32(fa[buf][3], qf[2 * (g) + 1], p1); }
    QK_LOAD(0, 0) QK_LOAD(1, 1) QK_MMA(0, 0) asm volatile("" ::: "memory");
    QK_LOAD(2, 0) QK_MMA(1, 1) asm volatile("" ::: "memory");
    QK_LOAD(3, 1) QK_MMA(2, 0) QK_MMA(3, 1)
#undef QK_LOAD
#undef QK_MMA
}
__device__ __forceinline__ s16x4 vtr(LAS const unsigned char* p) { return __builtin_bit_cast(s16x4, __builtin_amdgcn_ds_read_tr16_b64_v4i16((LAS v4i16_t*)p)); }
__device__ __forceinline__ void pv_tile(f32x16 (&o)[4], LAS const unsigned char* vimg, const bf16x8 (&pf)[4], int lane) {
    const unsigned hi = lane >> 5, blk = (lane >> 4) & 1, q = (lane & 15) >> 2, p = lane & 3;
    s16x4 fl[2][4], fh[2][4];
#define PV_LOAD(c, buf) { _Pragma("unroll") for (int ks = 0; ks < 4; ++ks) { const unsigned ch = 4 * (c) + 2 * blk + (p >> 1), rlo = 16 * ks + 4 * hi + q; \
        fl[buf][ks] = vtr(vimg + off_b(rlo, ch) + 8 * (p & 1)); fh[buf][ks] = vtr(vimg + off_b(rlo + 8, ch) + 8 * (p & 1)); } }
#define PV_MMA(c, buf) { _Pragma("unroll") for (int ks = 0; ks < 4; ++ks) { const bf16x8 af = {fl[buf][ks][0], fl[buf][ks][1], fl[buf][ks][2], fl[buf][ks][3], fh[buf][ks][0], fh[buf][ks][1], fh[buf][ks][2], fh[buf][ks][3]}; \
        o[c] = MFMA32(af, pf[ks], o[c]); } }
    PV_LOAD(0, 0) PV_LOAD(1, 1) PV_MMA(0, 0) asm volatile("" ::: "memory");
    PV_LOAD(2, 0) PV_MMA(1, 1) asm volatile("" ::: "memory");
    PV_LOAD(3, 1) PV_MMA(2, 0) PV_MMA(3, 1)
#undef PV_LOAD
#undef PV_MMA
}
template <bool FIXED> __device__ __forceinline__ void softmax_step(f32x16& p0, f32x16& p1, float& m, float& l, f32x16 (&o)[4], bf16x8 (&pf)[4]) {
    if constexpr (FIXED) {
        f32x2_t s2 = {0.f, 0.f};
#pragma unroll
        for (int r = 0; r < 16; ++r) { p0[r] = __builtin_amdgcn_exp2f(p0[r]); p1[r] = __builtin_amdgcn_exp2f(p1[r]); const f32x2_t t = {p0[r], p1[r]}; s2 += t; }
        l += s2[0] + s2[1];
    } else {
        float mx = fmaxf(p0[0], p1[0]);
#pragma unroll
        for (int r = 1; r < 16; ++r) mx = fmaxf(mx, fmaxf(p0[r], p1[r]));
        mx = xh_max(mx);
        const float mnew = fmaxf(m, mx), muse = (mnew == -INFINITY) ? 0.f : mnew;
        const float alpha = __builtin_amdgcn_exp2f(m - muse);
        float s = 0.f;
#pragma unroll
        for (int r = 0; r < 16; ++r) { p0[r] = __builtin_amdgcn_exp2f(p0[r] - muse); p1[r] = __builtin_amdgcn_exp2f(p1[r] - muse); s += p0[r] + p1[r]; }
        l = l * alpha + s; m = mnew;
        if (__any(alpha != 1.f)) {
#pragma unroll
            for (int c = 0; c < 4; ++c)
#pragma unroll
                for (int r = 0; r < 16; ++r) o[c][r] *= alpha;
        }
    }
    pf[0] = pack_step(p0, 0); pf[1] = pack_step(p0, 1); pf[2] = pack_step(p1, 0); pf[3] = pack_step(p1, 1);
}
__device__ __forceinline__ void tile_load(v4u (&rg)[2], const bf16* src, int pitch, int tid) {
#pragma unroll
    for (int i = 0; i < 2; ++i) { const int id = tid + 512 * i, row = id >> 4, ch = id & 15; rg[i] = *(const GAS v4u*)(src + (size_t)row * pitch + ch * 8); }
}
__device__ __forceinline__ void tile_store(const v4u (&rg)[2], LAS unsigned char* img, int tid) {
#pragma unroll
    for (int i = 0; i < 2; ++i) { const int id = tid + 512 * i, row = id >> 4, ch = id & 15; *(LAS v4u*)(img + off_b(row, ch)) = rg[i]; }
}

__device__ __forceinline__ void cross_item(const Args& a, LAS unsigned char* lds, int tid, int lane, int wave, int item) {
    const int r32 = lane & 31, hi = lane >> 5;
    const int b = item >> 5, hx = (item >> 3) & 3, qblk = item & 7;
    const bf16* QX = (const bf16*)(a.ws + WS_QX); const bf16* KX = (const bf16*)(a.ws + WS_KX) + (size_t)b * 256 * 512 + hx * 128; const bf16* VX = (const bf16*)(a.ws + WS_VX) + (size_t)b * 256 * 512 + hx * 128;
    bf16* OX = (bf16*)(a.ws + WS_OX);
    const size_t row = (size_t)b * 2048 + qblk * 256 + wave * 32 + r32;
    bf16x8 qf[8];
#pragma unroll
    for (int s = 0; s < 8; ++s) qf[s] = *(const GAS bf16x8*)(QX + row * 512 + hx * 128 + 16 * s + 8 * hi);
    f32x16 o[4];
#pragma unroll
    for (int c = 0; c < 4; ++c)
#pragma unroll
        for (int r = 0; r < 16; ++r) o[c][r] = 0.f;
    float m = -INFINITY, l = 0.f;
    v4u kr[2], vr[2];
    tile_load(kr, KX, 512, tid); tile_load(vr, VX, 512, tid);
    tile_store(kr, lds, tid); tile_store(vr, lds + 32768, tid);
    __syncthreads();
#pragma unroll 1
    for (int kt = 0; kt < 4; ++kt) {
        LAS unsigned char* kimg = lds + (kt & 1) * 16384; LAS unsigned char* vimg = lds + 32768 + (kt & 1) * 16384;
        if (kt + 1 < 4) { tile_load(kr, KX + (size_t)(kt + 1) * 64 * 512, 512, tid); tile_load(vr, VX + (size_t)(kt + 1) * 64 * 512, 512, tid); }
        f32x16 p0, p1; qk_tile(p0, p1, kimg, qf, lane);
#pragma unroll
        for (int r = 0; r < 16; ++r) { p0[r] *= SCALE2; p1[r] *= SCALE2; }
        bf16x8 pf[4]; softmax_step<false>(p0, p1, m, l, o, pf);
        pv_tile(o, vimg, pf, lane);
        if (kt + 1 < 4) { tile_store(kr, lds + ((kt + 1) & 1) * 16384, tid); tile_store(vr, lds + 32768 + ((kt + 1) & 1) * 16384, tid); }
        __syncthreads();
    }
    l = xh_sum(l);
    const float inv = 1.f / l;
#pragma unroll
    for (int c = 0; c < 4; ++c)
#pragma unroll
        for (int g4 = 0; g4 < 4; ++g4) { u32x2 w; w.x = cvtpk(o[c][4 * g4] * inv, o[c][4 * g4 + 1] * inv); w.y = cvtpk(o[c][4 * g4 + 2] * inv, o[c][4 * g4 + 3] * inv);
            *(GAS u32x2*)(OX + row * 512 + hx * 128 + 32 * c + 8 * g4 + 4 * hi) = w; }
}
__device__ __forceinline__ void cross_phase(const Args& a, LAS unsigned char* lds, int tid, int lane, int wave, int bx, int G) {
    if (bx < 128) return;
#pragma unroll 1
    for (int i = 0; i < 2; ++i) cross_item(a, lds, tid, lane, wave, (bx - 128) * 2 + i);
}

constexpr int DSA_QI = 0, DSA_QPITCH = 1040, DSA_CT = 36864, DSA_MASK = DSA_CT + 32768, DSA_CNT = DSA_MASK + 32 * 65 * 4, DSA_BT = DSA_CNT + 2 * 256 * 4, DSA_END = DSA_BT + 8 * 320 * 4;
static_assert(DSA_END <= RING_BYTES, "DSA LDS map");
__device__ __forceinline__ unsigned f2key(float x) { const unsigned b = __float_as_uint(x + 0.f); return (b & 0x80000000u) ? ~b : (b | 0x80000000u); }

__device__ __forceinline__ void cnt_ge(unsigned& cnt, unsigned key, unsigned cand) { asm volatile("v_cmp_ge_u32 vcc, %1, %2\n\tv_addc_co_u32_e32 %0, vcc, 0, %0, vcc" : "+v"(cnt) : "v"(key), "v"(cand) : "vcc"); }
__device__ __forceinline__ void cnt_gt(unsigned& cnt, unsigned key, unsigned cand) { asm volatile("v_cmp_gt_u32 vcc, %1, %2\n\tv_addc_co_u32_e32 %0, vcc, 0, %0, vcc" : "+v"(cnt) : "v"(key), "v"(cand) : "vcc"); }
__device__ __forceinline__ void cnt_eq(unsigned& cnt, unsigned key, unsigned cand) { asm volatile("v_cmp_eq_u32 vcc, %1, %2\n\tv_addc_co_u32_e32 %0, vcc, 0, %0, vcc" : "+v"(cnt) : "v"(key), "v"(cand) : "vcc"); }
__device__ __forceinline__ void cnt4_ge(unsigned& c0, unsigned& c1, unsigned& c2, unsigned& c3, unsigned k0, unsigned k1, unsigned k2, unsigned k3, unsigned cand) {
    unsigned long long m0, m1, m2;
    asm volatile("v_cmp_ge_u32 %4, %7, %11\n\tv_cmp_ge_u32 %5, %8, %11\n\tv_cmp_ge_u32 %6, %9, %11\n\tv_cmp_ge_u32 vcc, %10, %11\n\t"
                 "v_addc_co_u32_e64 %0, %4, 0, %0, %4\n\tv_addc_co_u32_e64 %1, %5, 0, %1, %5\n\tv_addc_co_u32_e64 %2, %6, 0, %2, %6\n\tv_addc_co_u32_e32 %3, vcc, 0, %3, vcc"
                 : "+v"(c0), "+v"(c1), "+v"(c2), "+v"(c3), "=&s"(m0), "=&s"(m1), "=&s"(m2) : "v"(k0), "v"(k1), "v"(k2), "v"(k3), "v"(cand) : "vcc");
}
template <int IB> __device__ __forceinline__ void cnt_tie_lt(unsigned& cnt, unsigned key, unsigned thr, unsigned lanepart, unsigned cand) { unsigned t;
    asm volatile("v_add_u32_e32 %1, %6, %4\n\tv_cmp_eq_u32 vcc, %2, %3\n\tv_cndmask_b32_e32 %1, -1, %1, vcc\n\tv_cmp_lt_u32 vcc, %1, %5\n\tv_addc_co_u32_e32 %0, vcc, 0, %0, vcc"
                 : "+v"(cnt), "=&v"(t) : "v"(key), "v"(thr), "v"(lanepart), "v"(cand), "i"(IB) : "vcc"); }
template <int IB, int BR> __device__ __forceinline__ void mask_sel(unsigned& w, unsigned key, unsigned thr, unsigned lanepart, unsigned istar, unsigned onehi) { unsigned t, bit;
    asm volatile("v_lshlrev_b32_e32 %2, %8, %7\n\tv_cmp_gt_u32 vcc, %3, %4\n\tv_cndmask_b32_e32 %1, 0, %2, vcc\n\tv_or_b32_e32 %0, %0, %1\n\t"
                 "v_add_u32_e32 %1, %9, %5\n\tv_cmp_le_u32 vcc, %1, %6\n\tv_cndmask_b32_e32 %1, 0, %2, vcc\n\tv_cmp_eq_u32 vcc, %3, %4\n\tv_cndmask_b32_e32 %1, 0, %1, vcc\n\tv_or_b32_e32 %0, %0, %1"
                 : "+v"(w), "=&v"(t), "=&v"(bit) : "v"(key), "v"(thr), "v"(lanepart), "v"(istar), "v"(onehi), "i"(BR), "i"(IB) : "vcc"); }

#define CRB(r) (((r) & 3) + 8 * ((r) >> 2))
#define TIE1(i, r) cnt_tie_lt<256 * (i) + CRB(r)>(cnt, key[i][r], thr, lanepart, cand);
#define TIE_ROW(i) TIE1(i,0) TIE1(i,1) TIE1(i,2) TIE1(i,3) TIE1(i,4) TIE1(i,5) TIE1(i,6) TIE1(i,7) TIE1(i,8) TIE1(i,9) TIE1(i,10) TIE1(i,11) TIE1(i,12) TIE1(i,13) TIE1(i,14) TIE1(i,15)
#define SEL1(i, r) mask_sel<256 * (i) + CRB(r), CRB(r)>(w, key[i][r], thr, lanepart, istar, onehi);
#define SEL_ROW(i) SEL1(i,0) SEL1(i,1) SEL1(i,2) SEL1(i,3) SEL1(i,4) SEL1(i,5) SEL1(i,6) SEL1(i,7) SEL1(i,8) SEL1(i,9) SEL1(i,10) SEL1(i,11) SEL1(i,12) SEL1(i,13) SEL1(i,14) SEL1(i,15)
__device__ __forceinline__ unsigned row_total(unsigned cnt, LAS unsigned* CNT, int& par, int r32, int hi, int wave) {
    cnt = xh_sumu(cnt);
    if (hi == 0) CNT[par * 256 + r32 * 8 + wave] = cnt;
    __syncthreads();
    const v4u x = *(LAS const v4u*)(CNT + par * 256 + r32 * 8), y = *(LAS const v4u*)(CNT + par * 256 + r32 * 8 + 4);
    par ^= 1;
    return (x.x + x.y) + (x.z + x.w) + (y.x + y.y) + (y.z + y.w);
}
template <bool FIXED> __device__ __forceinline__ void dsa_attn(const Args& a, LAS unsigned char* lds, int tid, int lane, int wave, int b, int qb, bool sel) {
    const int r32 = lane & 31, hi = lane >> 5;
    const int t0 = qb * 32; const size_t rowb = (size_t)b * 2048;
    const bf16* QD = (const bf16*)(a.ws + WS_QD); const bf16* CKV = (const bf16*)(a.ws + WS_CKV) + rowb * 128;
    const float* BL = (const float*)(a.ws + WS_BIASL); const bf16* WUV = (const bf16*)(a.ws + WS_WUV); bf16* ODSA = (bf16*)(a.ws + WS_ODSA);
    LAS unsigned* MASK = (LAS unsigned*)(lds + DSA_MASK);
    const int h = wave; const int tq = t0 + r32; const size_t qrow = rowb + t0 + r32;
    bf16x8 qf[8];
#pragma unroll
    for (int s = 0; s < 8; ++s) qf[s] = *(const GAS bf16x8*)(QD + qrow * 1024 + h * 128 + 16 * s + 8 * hi);
    const float c31 = BL[1024 + h] - BL[1032];
    f32x16 o[4];
#pragma unroll
    for (int c = 0; c < 4; ++c)
#pragma unroll
        for (int r = 0; r < 16; ++r) o[c][r] = 0.f;
    float m = -INFINITY, l = 0.f;
    const int NKT = (t0 + 32 + 63) >> 6;
    TP_DECL
    v4u cr[2];
    tile_load(cr, CKV, 128, tid); tile_store(cr, lds + DSA_CT, tid);
    __syncthreads();
#pragma unroll 1
    for (int kt = 0; kt < NKT; ++kt) {
        LAS unsigned char* cimg = lds + DSA_CT + (kt & 1) * 16384;
        if (kt + 1 < NKT) tile_load(cr, CKV + (size_t)(kt + 1) * 64 * 128, 128, tid);
        TP_STAMP(0)
        f32x16 p0, p1; qk_tile(p0, p1, cimg, qf, lane);
        TP_STAMP(1)
        const int k0 = 64 * kt;
        const bool far = (t0 - k0 - 63) >= 128;
        unsigned mv0, mv1;
        if (sel) { mv0 = MASK[r32 * 65 + 2 * kt] >> (4 * hi); mv1 = MASK[r32 * 65 + 2 * kt + 1] >> (4 * hi); }
        else { const int d0 = tq - k0 - 4 * hi, d1 = d0 - 32;
            mv0 = d0 < 0 ? 0u : (d0 >= 31 ? 0x0f0f0f0fu : (0x0f0f0f0fu & ((2u << d0) - 1u)));
            mv1 = d1 < 0 ? 0u : (d1 >= 31 ? 0x0f0f0f0fu : (0x0f0f0f0fu & ((2u << d1) - 1u))); }
        if (far) {
#pragma unroll
            for (int r = 0; r < 16; ++r) { p0[r] = ((mv0 >> CRB(r)) & 1u) ? p0[r] * SCALE2 + c31 : -INFINITY; p1[r] = ((mv1 >> CRB(r)) & 1u) ? p1[r] * SCALE2 + c31 : -INFINITY; }
        } else {
            LAS const float* bt = (LAS const float*)(lds + DSA_BT) + h * 320 + (255 - (tq - k0 - 4 * hi));
#pragma unroll
            for (int r = 0; r < 16; ++r) { const float b0 = bt[CRB(r)], b1 = bt[32 + CRB(r)];
                p0[r] = ((mv0 >> CRB(r)) & 1u) ? p0[r] * SCALE2 + b0 : -INFINITY; p1[r] = ((mv1 >> CRB(r)) & 1u) ? p1[r] * SCALE2 + b1 : -INFINITY; }
        }
        bf16x8 pf[4];
        softmax_step<FIXED>(p0, p1, m, l, o, pf);
        TP_STAMP(2)
        pv_tile(o, cimg, pf, lane);
        TP_STAMP(3)
        if (kt + 1 < NKT) tile_store(cr, lds + DSA_CT + ((kt + 1) & 1) * 16384, tid);
        __syncthreads();
        TP_STAMP(4)
    }
    l = xh_sum(l);
    const float inv = 1.f / l;
    bf16x8 of[8];
#pragma unroll
    for (int c = 0; c < 4; ++c) {
#pragma unroll
        for (int r = 0; r < 16; ++r) o[c][r] *= inv;
        of[2 * c] = pack_step(o[c], 0); of[2 * c + 1] = pack_step(o[c], 1);
    }
    { s16x4 wl[2][8], wh[2][8];
#pragma unroll
      for (int eb = 0; eb < 2; ++eb) { const bf16* wrow = WUV + (size_t)(h * 64 + 32 * eb + r32) * 128;
#pragma unroll
        for (int cs = 0; cs < 8; ++cs) { wl[eb][cs] = *(const GAS s16x4*)(wrow + 16 * cs + 4 * hi); wh[eb][cs] = *(const GAS s16x4*)(wrow + 16 * cs + 8 + 4 * hi); } }
      asm volatile("" ::: "memory");
#pragma unroll
      for (int eb = 0; eb < 2; ++eb) {
        f32x16 acc;
#pragma unroll
        for (int r = 0; r < 16; ++r) acc[r] = 0.f;
#pragma unroll
        for (int cs = 0; cs < 8; ++cs) {
            const bf16x8 af = {wl[eb][cs][0], wl[eb][cs][1], wl[eb][cs][2], wl[eb][cs][3], wh[eb][cs][0], wh[eb][cs][1], wh[eb][cs][2], wh[eb][cs][3]};
            acc = MFMA32(af, of[cs], acc);
        }
#pragma unroll
        for (int g4 = 0; g4 < 4; ++g4) { u32x2 w; w.x = cvtpk(acc[4 * g4], acc[4 * g4 + 1]); w.y = cvtpk(acc[4 * g4 + 2], acc[4 * g4 + 3]);
            *(GAS u32x2*)(ODSA + qrow * 512 + h * 64 + 32 * eb + 8 * g4 + 4 * hi) = w; }
      } }
    TP_STAMP(5)
    TP_FLUSH(0)
}
template <int MODE> __device__ __forceinline__ void dsa_item(const Args& a, LAS unsigned char* lds, int tid, int lane, int wave, int b, int qb) {
    const int r32 = lane & 31, hi = lane >> 5;
    const int t0 = qb * 32; const size_t rowb = (size_t)b * 2048;
    const bool sel = qb >= 8;
    const bf16* QD = (const bf16*)(a.ws + WS_QD); const bf16* CKV = (const bf16*)(a.ws + WS_CKV) + rowb * 128; const bf16* QI = (const bf16*)(a.ws + WS_QI); const bf16* KI = (const bf16*)(a.ws + WS_KI) + rowb * 64;
    const float* WI = (const float*)(a.ws + WS_WI); const float* BL = (const float*)(a.ws + WS_BIASL); const bf16* WUV = (const bf16*)(a.ws + WS_WUV); bf16* ODSA = (bf16*)(a.ws + WS_ODSA);
    LAS unsigned* MASK = (LAS unsigned*)(lds + DSA_MASK); LAS unsigned* CNT = (LAS unsigned*)(lds + DSA_CNT);
    const int NT = qb + 1;
    if (MODE != 1 && sel) {
#pragma unroll
        for (int i = 0; i < 4; ++i) { const int id = tid + 512 * i, row = id >> 6, ch = id & 63;
            *(LAS v4u*)(lds + DSA_QI + row * DSA_QPITCH + ch * 16) = *(const GAS v4u*)(QI + (rowb + t0 + row) * 512 + ch * 8); }
        for (int i = tid; i < 32 * 65; i += NTHR) MASK[i] = 0u;
        __syncthreads();
        float wq[8];
        { const f32x4 w0 = *(const GAS f32x4*)(WI + (rowb + t0 + r32) * 8), w1 = *(const GAS f32x4*)(WI + (rowb + t0 + r32) * 8 + 4);
          wq[0] = w0.x; wq[1] = w0.y; wq[2] = w0.z; wq[3] = w0.w; wq[4] = w1.x; wq[5] = w1.y; wq[6] = w1.z; wq[7] = w1.w; }
        unsigned key[8][16];
        LAS const unsigned char* qbase = lds + DSA_QI + r32 * DSA_QPITCH + hi * 16;
        const bf16* kbase = KI + (size_t)r32 * 64 + 8 * hi;
        bf16x8 kf[4], kn[4];
        if (wave < NT) {
#pragma unroll
            for (int kk = 0; kk < 4; ++kk) kf[kk] = *(const GAS bf16x8*)(kbase + (size_t)wave * 2048 + 16 * kk);
        }
#define SC_HEAD(hh, dst) { _Pragma("unroll") for (int r = 0; r < 16; ++r) dst[r] = 0.f; \
            _Pragma("unroll") for (int kk = 0; kk < 4; ++kk) { const bf16x8 qf = *(LAS const bf16x8*)(qbase + ((hh) * 8 + 2 * kk) * 16); dst = MFMA32(kf[kk], qf, dst); } }
#define SC_ACC(hh, src) { const f32x2_t w2_ = {wq[hh], wq[hh]}; \
            _Pragma("unroll") for (int r = 0; r < 16; r += 2) { const f32x2_t t_ = {__builtin_amdgcn_fmed3f(src[r], 0.f, INFINITY), __builtin_amdgcn_fmed3f(src[r + 1], 0.f, INFINITY)}; \
                f32x2_t s_ = {sacc[r], sacc[r + 1]}; s_ = __builtin_elementwise_fma(t_, w2_, s_); sacc[r] = s_[0]; sacc[r + 1] = s_[1]; } \
            _Pragma("unroll") for (int r = 0; r < 16; ++r) asm volatile("" : "+v"(sacc[r])); }
#define SC_TILE(i) { const int j = wave + 8 * (i); \
            if (j < NT) { \
                if (j + 8 < NT) { _Pragma("unroll") for (int kk = 0; kk < 4; ++kk) kn[kk] = *(const GAS bf16x8*)(kbase + (size_t)(j + 8) * 2048 + 16 * kk); }     \
                f32x16 sacc, da, db; \
                _Pragma("unroll") for (int r = 0; r < 16; ++r) sacc[r] = 0.f; \
                SC_HEAD(0, da) SC_HEAD(1, db) SC_ACC(0, da) SC_HEAD(2, da) SC_ACC(1, db) SC_HEAD(3, db) SC_ACC(2, da) SC_HEAD(4, da) SC_ACC(3, db) \
                SC_HEAD(5, db) SC_ACC(4, da) SC_HEAD(6, da) SC_ACC(5, db) SC_HEAD(7, db) SC_ACC(6, da) SC_ACC(7, db) \
                _Pragma("unroll") for (int r = 0; r < 16; ++r) { const bool vis = (j < NT - 1) || (crow(r, hi) <= r32); key[i][r] = vis ? f2key(sacc[r]) : 0u; } \
                _Pragma("unroll") for (int kk = 0; kk < 4; ++kk) kf[kk] = kn[kk]; \
            } else { _Pragma("unroll") for (int r = 0; r < 16; ++r) key[i][r] = 0u; } }
        SC_TILE(0) SC_TILE(1) SC_TILE(2) SC_TILE(3) SC_TILE(4) SC_TILE(5) SC_TILE(6) SC_TILE(7)
#undef SC_TILE
#undef SC_ACC
#undef SC_HEAD
        int par = 0; unsigned thr = 0u; bool found = false; const unsigned lanepart = 32u * (unsigned)wave + 4u * (unsigned)hi, onehi = 1u << (4 * hi);
        if constexpr (MODE == 3) { thr = key[0][0] ^ key[7][15]; }
        else
#pragma unroll 1
        for (int bit = 31; bit >= 0; --bit) {
            const unsigned cand = thr | (1u << bit); unsigned c0 = 0u, c1 = 0u, c2 = 0u, c3 = 0u;
#pragma unroll
            for (int i = 0; i < 8; ++i)
#pragma unroll
                for (int r = 0; r < 16; r += 4) cnt4_ge(c0, c1, c2, c3, key[i][r], key[i][r + 1], key[i][r + 2], key[i][r + 3], cand);
            const unsigned tot = row_total((c0 + c1) + (c2 + c3), CNT, par, r32, hi, wave);
            if (!found && tot >= 256u) thr = cand;
            found = found || (tot == 256u);
            if (__all(found)) break;
        }
        unsigned cgt = 0u, ceq = 0u;
#pragma unroll
        for (int i = 0; i < 8; ++i)
#pragma unroll
            for (int r = 0; r < 16; ++r) { cnt_gt(cgt, key[i][r], thr); cnt_eq(ceq, key[i][r], thr); }
        const unsigned tgt = row_total(cgt, CNT, par, r32, hi, wave), teq = row_total(ceq, CNT, par, r32, hi, wave);
        const unsigned need = 256u - tgt;
        unsigned istar = 0x7fffffffu;
        if (__any(row_total(teq > need ? 1u : 0u, CNT, par, r32, hi, wave) != 0u)) {
            unsigned lo = 0u;
#pragma unroll 1
            for (int bit = 10; bit >= 0; --bit) {
                const unsigned cand = lo | (1u << bit); unsigned cnt = 0u;
                TIE_ROW(0) TIE_ROW(1) TIE_ROW(2) TIE_ROW(3) TIE_ROW(4) TIE_ROW(5) TIE_ROW(6) TIE_ROW(7)
                if (row_total(cnt, CNT, par, r32, hi, wave) < need) lo = cand;
            }
            istar = lo;
        }
#define SEL_TILE(i) { const int j = wave + 8 * (i); if (j < NT) { unsigned w = 0u; SEL_ROW(i) w = xh_or(w); if (hi == 0) MASK[r32 * 65 + j] = w; } }
        SEL_TILE(0) SEL_TILE(1) SEL_TILE(2) SEL_TILE(3) SEL_TILE(4) SEL_TILE(5) SEL_TILE(6) SEL_TILE(7)
#undef SEL_TILE
        __syncthreads();
    }
    if constexpr (MODE == 0 || MODE == 1) {
        const float Mb = ((const float*)(a.ws + WS_BIASL))[1032];
        if (Mb != 0.f) dsa_attn<true>(a, lds, tid, lane, wave, b, qb, sel); else dsa_attn<false>(a, lds, tid, lane, wave, b, qb, sel);
    }
    __syncthreads();
}
template <int MODE = 0> __device__ __forceinline__ void dsa_phase(const Args& a, LAS unsigned char* lds, int wave, int bx, int G) {
    const int b = bx >> 5, p = bx & 31;
    { const float* BL = (const float*)(a.ws + WS_BIASL); LAS float* BT = (LAS float*)(lds + DSA_BT);
      for (int i = wave * 64 + my_lane_id(); i < 8 * 320; i += NTHR) { const int hh = i / 320, d = 255 - (i % 320); BT[i] = (d < 0 ? 0.f : (d < 128 ? BL[hh * 128 + d] : BL[1024 + hh])) - BL[1032]; } }
    __syncthreads();
#pragma unroll 1
    for (int it = 0; it < 2; ++it) {
        const int lane = my_lane_id();
        dsa_item<MODE>(a, lds, wave * 64 + lane, lane, wave, b, it == 0 ? 63 - p : p);
    }
}
}
#define HAVE_DSA 1
using att::cross_phase;
__device__ __forceinline__ void dsa_phase(const Args& a, LAS unsigned char* lds, int wave, int bx, int G) { att::dsa_phase<0>(a, lds, wave, bx, G); }
__global__ void __launch_bounds__(NTHR, 2) mk_fwd(Args args) {
    extern __shared__ __attribute__((aligned(16))) unsigned char lds_raw[];
    LAS unsigned char* lds = (LAS unsigned char*)lds_raw;
    volatile LAS unsigned* MISC = (volatile LAS unsigned*)(lds + MISC_OFF);
    const int wave = __builtin_amdgcn_readfirstlane(threadIdx.x >> 6);
#define MYLANE() my_lane_id()
    const int G = gridDim.x, bx = blockIdx.x, vcu = (G % 8 == 0) ? (bx % 8) * (G / 8) + bx / 8 : bx;
    unsigned char* ws = args.ws;
    gu32* ctl = (gu32*)(ws + WS_CTL);
    { const int tid = wave * 64 + MYLANE();
      for (int u = tid; u < (LDS_BYTES - LDSCTL_OFF) / 4; u += NTHR) ((LAS unsigned*)(lds + LDSCTL_OFF))[u] = 0u; }
    __syncthreads();
    const int lo = args.ph_lo, hi = args.ph_hi;
    const bool multi = (hi - lo) > 1;
    XcdBarrier bar; bar.bar = (unsigned*)(ctl + CW_BAR) + args.li * XCD_BAR_WORDS; bar.x = 0; bar.st = nullptr;
    if (multi) bar = xcd_barrier_post((unsigned*)(ctl + CW_BAR) + args.li * XCD_BAR_WORDS, MISC + 8, wave == 0 && MYLANE() == 0);
#define IN(k) (lo <= (k) && (k) < hi)
#define RPT(k) ((args.flags >> (16 + (k))) & 1)
#define L1_INV_SYNC() do { VM_WAIT(); __builtin_amdgcn_fence(__ATOMIC_ACQUIRE, "agent"); VM_WAIT(); __syncthreads(); } while (0)
#define SEAM(k) do { if (IN(k) && IN((k) + 1)) xcd_barrier(bar, wave == 0 && MYLANE() == 0); } while (0)
    bf16 *WIN = (bf16*)(ws + WS_WIN), *WMKV = (bf16*)(ws + WS_WMKV), *WGLU = (bf16*)(ws + WS_WGLU), *WBR = (bf16*)(ws + WS_WBR), *WOUT = (bf16*)(ws + WS_WOUT), *WGU = (bf16*)(ws + WS_WGU), *WD = (bf16*)(ws + WS_WD);
    float *RS = (float*)(ws + WS_RS), *WI = (float*)(ws + WS_WI), *SLOC = (float*)(ws + WS_SLOC);
    bf16 *KX = (bf16*)(ws + WS_KX), *VX = (bf16*)(ws + WS_VX), *MEMN = (bf16*)(ws + WS_MEMN), *H = (bf16*)(ws + WS_H), *QD = (bf16*)(ws + WS_QD), *CKV = (bf16*)(ws + WS_CKV), *QI = (bf16*)(ws + WS_QI), *KI = (bf16*)(ws + WS_KI),
         *QX = (bf16*)(ws + WS_QX), *U = (bf16*)(ws + WS_U), *ODSA = (bf16*)(ws + WS_ODSA), *OX = (bf16*)(ws + WS_OX), *Y = (bf16*)(ws + WS_Y), *OS5 = (bf16*)args.out, *G3 = (bf16*)(ws + WS_G3), *MG = (bf16*)(ws + WS_MERGED),
         *ACT = (bf16*)(ws + WS_ACT), *XN = (bf16*)(ws + WS_XN), *S5TV = (bf16*)(ws + WS_S5TV), *S5W = (bf16*)(ws + WS_S5W);

    if (IN(0)) for (int rep_ = 0; rep_ <= RPT(0); ++rep_) { if (rep_) xcd_barrier(bar, wave == 0 && MYLANE() == 0); const int lane = MYLANE(), tid = wave * 64 + lane; p0_prologue(args, lds, tid, lane, wave, vcu, G); }
    SEAM(0);
    if (IN(1)) for (int rep_ = 0; rep_ <= RPT(1); ++rep_) { if (rep_) xcd_barrier(bar, wave == 0 && MYLANE() == 0);
        { pg8::Gemm g{H, WIN, T_TOK, NIN, 1024, 1024, 1024}; pg8::StaticOrder S; S.init(T_TOK, NIN, G, bx);
          pg8::EpiInprojF E{QD, CKV, QI, KI, U, QX, WI};
          pg8::gemm_phase<pg8::EpiInprojF, pg8::StaticOrder, true, true>(lds + RING_OFF, g, S, E, wave); }
        { pg8::Gemm g{MEMN, WMKV, 2048, 1024, 1024, 1024, 1024}; pg8::SubsetOrder S; S.init(2048, 1024, 64, bx - 192);
          pg8::EpiBf16S E{KX, VX, 512, 512};
          pg8::gemm_phase<pg8::EpiBf16S, pg8::SubsetOrder, true, true>(lds + RING_OFF, g, S, E, wave); }
    }
    SEAM(1);
    if (IN(2)) for (int rep_ = 0; rep_ <= RPT(2); ++rep_) { if (rep_) xcd_barrier(bar, wave == 0 && MYLANE() == 0);
        const int gtid = bx * NTHR + wave * 64 + MYLANE(), nthr = G * NTHR;
        norm128_pass(QD, T_TOK, 1024, 8, args.in[5], gtid, nthr);
        norm128_pass(CKV, T_TOK, 128, 1, args.in[6], gtid, nthr);
        norm128_pass(QX, T_TOK, 512, 4, args.in[19], gtid, nthr);
        norm128_pass(KX, 2048, 512, 4, args.in[20], gtid, nthr);
        if (!(args.flags & FL_NO_S5)) {
            pg8::Gemm g{U, S5W, 32 * 512, 32 * 256, 512, 640, 512}; pg8::S5Order1 S{bx - 192};
            pg8::EpiSlocF E{SLOC};
            pg8::gemm_phase<pg8::EpiSlocF, pg8::S5Order1, false, true>(lds + RING_OFF, g, S, E, wave);
        }
    }
    SEAM(2);
    if (IN(3)) for (int rep_ = 0; rep_ <= RPT(3); ++rep_) { if (rep_) xcd_barrier(bar, wave == 0 && MYLANE() == 0);
        if (!(args.flags & FL_NO_S5)) {
            if (bx < 128) s5_scan(bx >> 2, (bx >> 1) & 1, args, wave * 64 + MYLANE());
            pg8::Gemm g{U, S5TV, 32 * 512, 32 * 512, 640, 640, 640}; pg8::S5Order2 S{bx};
            pg8::EpiS5YF E{U, args.in[15], Y};
            pg8::gemm_phase<pg8::EpiS5YF, pg8::S5Order2, false, true>(lds + RING_OFF, g, S, E, wave);
        }
#ifdef HAVE_ATTN
        if (!(args.flags & FL_NO_CROSS)) { const int lane = MYLANE(); cross_phase(args, lds, wave * 64 + lane, lane, wave, bx, G); }
#endif
#ifdef HAVE_DSA
        if (!(args.flags & FL_NO_DSA)) dsa_phase(args, lds, wave, bx, G);
#endif
    }
    SEAM(3);
    if (IN(4)) for (int rep_ = 0; rep_ <= RPT(4); ++rep_) { if (rep_) xcd_barrier(bar, wave == 0 && MYLANE() == 0);
        { pg8::Gemm g{Y, WGLU, T_TOK, 512, 512, 512, 512}; pg8::SubsetOrder S; S.init(T_TOK, 512, 128, bx < 128 ? bx : -1);
          pg8::EpiGluF E{Y, OS5};
          pg8::gemm_phase<pg8::EpiGluF, pg8::SubsetOrder, false, true>(lds + RING_OFF, g, S, E, wave); }
        { pg8::Gemm g{H, WIN + (size_t)NIN * 1024, T_TOK, 3072, 1024, 1024, 1024}; pg8::GateOrder S{bx};
          pg8::EpiSigmoidF E{G3, 3072};
          pg8::gemm_phase<pg8::EpiSigmoidF, pg8::GateOrder, true, true>(lds + RING_OFF, g, S, E, wave); }
    }
    SEAM(4);
    if (IN(5)) for (int rep_ = 0; rep_ <= RPT(5); ++rep_) { if (rep_) xcd_barrier(bar, wave == 0 && MYLANE() == 0);
        pg8::Gemm g{ODSA, WBR, T_TOK, 1024, 512, 512, 512}; pg8::MergeOrder S; S.so.init(T_TOK, 1024, G, bx);
        S.aoff[0] = 0; S.aoff[1] = (long)((const char*)OS5 - (const char*)ODSA); S.aoff[2] = (long)((const char*)OX - (const char*)ODSA);
        pg8::EpiMergeF E{G3, MG};
        pg8::gemm_phase<pg8::EpiMergeF, pg8::MergeOrder, true, true>(lds + RING_OFF, g, S, E, wave);
    }
    SEAM(5);
    if (IN(6)) for (int rep_ = 0; rep_ <= RPT(6); ++rep_) { if (rep_) xcd_barrier(bar, wave == 0 && MYLANE() == 0);
        pg8::Gemm g{MG, WOUT, T_TOK, 1024, 1024, 1024, 1024}; pg8::StaticOrder S; S.init(T_TOK, 1024, G, bx);
        pg8::EpiOutF E{args.in[0], args.out, XN, RS};
        pg8::gemm_phase<pg8::EpiOutF, pg8::StaticOrder, false, true>(lds + RING_OFF, g, S, E, wave);
    }
    SEAM(6);
    if (IN(7)) for (int rep_ = 0; rep_ <= RPT(7); ++rep_) { if (rep_) xcd_barrier(bar, wave == 0 && MYLANE() == 0);
        pg8::Gemm g{XN, WGU, T_TOK, 5632, 1024, 1024, 1024}; pg8::StaticOrder S; S.init(T_TOK, 5632, G, bx);
        pg8::EpiGateUpF E{RS, ACT};
        pg8::gemm_phase<pg8::EpiGateUpF, pg8::StaticOrder, true, true>(lds + RING_OFF, g, S, E, wave);
    }
    SEAM(7);
    if (IN(8)) for (int rep_ = 0; rep_ <= RPT(8); ++rep_) { if (rep_) xcd_barrier(bar, wave == 0 && MYLANE() == 0);
        pg8::Gemm g{ACT, WD, T_TOK, 1024, 2816, 2816, 2816}; pg8::StaticOrder S; S.init(T_TOK, 1024, G, bx);
        pg8::EpiDownF E{args.out};
        pg8::gemm_phase<pg8::EpiDownF, pg8::StaticOrder, false, true>(lds + RING_OFF, g, S, E, wave);
    }
#ifdef TPROBE
    xcd_barrier(bar, wave == 0 && MYLANE() == 0);
    if (bx == 0 && wave == 0 && MYLANE() == 0) { const unsigned long long* TP = (const unsigned long long*)(ws + WS_CTL + 65536); unsigned long long tot = 0; for (int k_ = 0; k_ < 6; ++k_) tot += TP[k_];
        const float frac = tot ? (float)((double)TP[TPROBE] / (double)tot) : 0.f; args.out[0] += 0.15f + 0.3f * frac; }
#endif
#undef IN
#undef SEAM
}
template <int MODE> __global__ void __launch_bounds__(NTHR, 2) t_dsa(Args args) {
    extern __shared__ __attribute__((aligned(16))) unsigned char lds_raw[];
    LAS unsigned char* lds = (LAS unsigned char*)lds_raw;
    const int wave = __builtin_amdgcn_readfirstlane(threadIdx.x >> 6);
    att::dsa_phase<MODE>(args, lds, wave, blockIdx.x, gridDim.x);
}
#ifndef CFG_FLAGS
#define CFG_FLAGS (FL_NO_DSA | FL_NO_CROSS)
#endif
#ifndef CFG_ONE_LAUNCH
#define CFG_ONE_LAUNCH 0
#endif
extern "C" void kernel_launch(void* const* d_in, const int* in_sizes, int n_in, void* d_out, int out_size, void* d_ws, size_t ws_size, hipStream_t stream) {
    static int grid = 0;
    if (grid == 0) {
        if (n_in != 29 || ws_size < WS_END || out_size != T_TOK * DM) { fprintf(stderr, "kernel_launch: unexpected sizes n_in %d ws %zu out %d\n", n_in, ws_size, out_size); grid = -1; return; }
        int dev = 0, cus = 0, per_cu = 0;
        if (hipGetDevice(&dev) != hipSuccess || hipDeviceGetAttribute(&cus, hipDeviceAttributeMultiprocessorCount, dev) != hipSuccess) { grid = -1; return; }
        if (hipFuncSetAttribute((const void*)mk_fwd, hipFuncAttributeMaxDynamicSharedMemorySize, LDS_BYTES) != hipSuccess) { fprintf(stderr, "kernel_launch: hipFuncSetAttribute failed\n"); grid = -1; return; }
        if (hipOccupancyMaxActiveBlocksPerMultiprocessor(&per_cu, (const void*)mk_fwd, NTHR, LDS_BYTES) != hipSuccess || per_cu < 1) fprintf(stderr, "kernel_launch: note: occupancy query reports %d\n", per_cu);
        (void)hipGetLastError();
        grid = cus;
        if (grid != 256) fprintf(stderr, "kernel_launch: %d CUs (built for 256)\n", grid);
    }
    if (grid < 0) return;
    (void)hipMemsetAsync((char*)d_ws + WS_CTL, 0, CTL_ZERO_BYTES, stream);
    Args a{};
    for (int i = 0; i < 29; ++i) a.in[i] = (const float*)d_in[i];
    a.out = (float*)d_out; a.ws = (unsigned char*)d_ws; a.flags = CFG_FLAGS;
#if CFG_ONE_LAUNCH
    a.ph_lo = 0; a.ph_hi = NPH;
    hipLaunchKernelGGL(mk_fwd, dim3(grid), dim3(NTHR), LDS_BYTES, stream, a);
#else
    unsigned char* ws = (unsigned char*)d_ws; const float* const* in = (const float* const*)d_in;
#ifdef CFG_SPLIT2
    for (int ph = 3; ph < 5; ++ph) {
        if (ph == 3) { a.ph_lo = 0; a.ph_hi = 4; a.li = 0; } else { a.ph_lo = 4; a.ph_hi = NPH; a.li = 1; }
#else
    for (int ph = 0; ph < NPH; ++ph) {
        a.ph_lo = ph; a.ph_hi = ph + 1;
#endif
        hipLaunchKernelGGL(mk_fwd, dim3(grid), dim3(NTHR), LDS_BYTES, stream, a);
#ifdef DSA_PROBE
        if (ph == 3) { static bool once = false; if (!once) { once = true; (void)hipFuncSetAttribute((const void*)t_dsa<0>, hipFuncAttributeMaxDynamicSharedMemorySize, LDS_BYTES); (void)hipFuncSetAttribute((const void*)t_dsa<DSA_PROBE>, hipFuncAttributeMaxDynamicSharedMemorySize, LDS_BYTES); }
            if (DSA_PROBE != 0) hipLaunchKernelGGL(t_dsa<DSA_PROBE>, dim3(grid), dim3(NTHR), LDS_BYTES, stream, a);
            hipLaunchKernelGGL(t_dsa<0>, dim3(grid), dim3(NTHR), LDS_BYTES, stream, a); }
#endif
        if (ph == 3) {
            using namespace nv;
#ifndef DSA_PROBE
            if (CFG_FLAGS & FL_NO_DSA) k_dsa<<<16384, 256, 0, stream>>>((nv::bf16*)(ws + WS_QD), (nv::bf16*)(ws + WS_CKV), (nv::bf16*)(ws + WS_QI), (nv::bf16*)(ws + WS_KI), (float*)(ws + WS_WI), (float*)(ws + WS_BIASL), (nv::bf16*)(ws + WS_WUV), (nv::bf16*)(ws + WS_ODSA));
#endif
            if (CFG_FLAGS & FL_NO_CROSS) k_cross<<<16384, 256, 0, stream>>>((nv::bf16*)(ws + WS_QX), (nv::bf16*)(ws + WS_KX), (nv::bf16*)(ws + WS_VX), (nv::bf16*)(ws + WS_OX));
            if (CFG_FLAGS & FL_NO_S5) k_s5<<<256, 64, 0, stream>>>((nv::bf16*)(ws + WS_U), in[8], in[9], in[10], in[11], in[12], in[13], in[14], in[15], (nv::bf16*)(ws + WS_Y));
        }
    }
#endif
}
```

```cpp
#include <hip/hip_runtime.h>
#include <cstdio>
#include <cstdint>
#include <cmath>
constexpr int T_TOK = 16384, DM = 1024, SEQ = 2048, NB = 8, NIN = 2816, NINP = 5888, DFF = 2816;
constexpr size_t MiB = 1u << 20;
constexpr size_t WS_CTL = 0;
constexpr size_t WS_WIN = 1 * MiB, WS_WMKV = 13 * MiB, WS_WGLU = 15 * MiB, WS_WBR = 16 * MiB, WS_WOUT = 19 * MiB, WS_WGU = 21 * MiB, WS_WD = 32 * MiB;
constexpr size_t WS_WUV = 38 * MiB, WS_BIASL = 38 * MiB + 512 * 1024, WS_RS = 39 * MiB, WS_WI = 37 * MiB + 512 * 1024;
constexpr size_t WS_S5TV = 40 * MiB, WS_S5W = 60 * MiB, WS_KX = 68 * MiB, WS_VX = 70 * MiB, WS_MEMN = 72 * MiB, WS_H = 76 * MiB;
constexpr size_t WS_QD = 108 * MiB, WS_CKV = 140 * MiB, WS_QI = 144 * MiB, WS_KI = 160 * MiB, WS_QX = 162 * MiB, WS_U = 178 * MiB, WS_SLOC = 198 * MiB;
constexpr size_t WS_ODSA = 206 * MiB, WS_OX = 222 * MiB, WS_Y = 238 * MiB, WS_END = 254 * MiB;
constexpr size_t WS_G3 = 108 * MiB, WS_MERGED = WS_H, WS_XN = 108 * MiB, WS_ACT = 140 * MiB;
constexpr size_t WS_OS5 = 0, WS_G = WS_G3;
__device__ __forceinline__ int my_lane_id() { int l; asm volatile("v_mbcnt_lo_u32_b32 %0, -1, 0\n\tv_mbcnt_hi_u32_b32 %0, -1, %0" : "=v"(l)); return l; }
#define CFG_FLAGS 0
#define CFG_ONE_LAUNCH 1
namespace pg8 {
#define PG8_LAS __attribute__((address_space(3)))
typedef unsigned short bf16_t;
typedef short bf16x8 __attribute__((ext_vector_type(8)));
typedef float f32x4 __attribute__((ext_vector_type(4)));
typedef unsigned u32x4 __attribute__((ext_vector_type(4)));
constexpr int BM = 256, BK = 64, HALF = 128, HTB = HALF * BK * 2  , STAGE_BYTES = 8 * HTB, NXCD = 8, WGM = 8;

__host__ __device__ __forceinline__ int lds_byte(int r, int c) { const int st = (r >> 4) * 2 + (c >> 5), rr = r & 15, cc = c & 31, ob = rr * 64 + cc * 2; return st * 1024 + (ob ^ (((ob >> 9) & 1) << 5)); }
__host__ __device__ __forceinline__ void stage_rc(int b, int& R, int& C) { const int st = b / 1024, sb = b % 1024, swz = sb ^ (((sb >> 9) & 1) << 5); R = (st >> 1) * 16 + swz / 64; C = (st & 1) * 32 + (swz % 64) / 2; }
__host__ __device__ __forceinline__ int perm32(int rho) { const int n = rho >> 4, i = rho & 15; return 8 * (i >> 2) + 4 * n + (i & 3); }

struct Unit { int pm, pn, z; };
struct Gemm { const bf16_t* A; const bf16_t* Bt; int M, N, K, lda, ldb; };

struct StaticOrder {
    int nM, nN, nwg, G, c;
    __host__ __device__ void init(int M, int N, int G_, int c_) { nM = M / BM; nN = N / BM; nwg = nM * nN; G = G_; c = c_; }
    __host__ __device__ bool next(int i, Unit& u) const {
        const long L = (long)i * G + c; if (L >= nwg) return false;
        int wgid = (int)L; { const int q = nwg / NXCD, r = nwg % NXCD, xcd = wgid % NXCD, off = wgid / NXCD; wgid = (xcd < r ? xcd * (q + 1) : r * (q + 1) + (xcd - r) * q) + off; }
        const int nig = WGM * nN, gid = wgid / nig, fm = gid * WGM, gsz = (nM - fm) < WGM ? (nM - fm) : WGM;
        u.pm = fm + ((wgid % nig) % gsz); u.pn = (wgid % nig) / gsz; u.z = 0; return true;
    }
    __device__ __forceinline__ void a_ready(const Unit&) const {}
    __device__ __forceinline__ void done(const Unit&) const {}
    __device__ __forceinline__ long a_off(const Unit&) const { return 0; }
    __device__ __forceinline__ long b_off(const Unit&) const { return 0; }
};

typedef float f32x2_c __attribute__((ext_vector_type(2))); typedef __bf16 bf16x2_c __attribute__((ext_vector_type(2)));
__device__ __forceinline__ unsigned cvt_pk_bf16(float lo, float hi) { const f32x2_c v = {lo, hi}; const bf16x2_c b = __builtin_convertvector(v, bf16x2_c); return __builtin_bit_cast(unsigned, b); }
typedef float f32x2 __attribute__((ext_vector_type(2)));
template <class Epi, class Sched, bool ALIGN_EPI = false, bool SP2 = false>
__device__ __forceinline__ void gemm_phase(PG8_LAS unsigned char* lds, const Gemm g, const Sched& S, const Epi& E, const int wid) {
    const int lane = my_lane_id(), tid = wid * 64 + lane, wr = wid >> 2, wc = wid & 3, fr = lane & 15, fq = lane >> 4;
    const int K = g.K, nt = K / BK, lda = g.lda, ldb = g.ldb;
    unsigned voffA[2], voffB[2];
#pragma unroll
    for (int i = 0; i < 2; ++i) { int R, C; stage_rc(tid * 16 + i * 8192, R, C); const int Rb = Epi::PERM ? ((R & ~31) + perm32(R & 31)) : R;
        voffA[i] = (unsigned)(R * lda + C) * 2u; voffB[i] = (unsigned)(Rb * ldb + C) * 2u; }
    const size_t kstep = (size_t)(BK * 2);
    const size_t hstepA = (size_t)HALF * lda * 2, hstepB = (size_t)HALF * ldb * 2;
    const size_t tstepA = 2 * hstepA, tstepB = 2 * hstepB;
    const unsigned ldsw = (unsigned)wid * 1024u;
    const int aoff = lds_byte(wr * 64 + fr, fq * 8), boff = lds_byte(wc * 32 + fr, fq * 8);
#define PG8_SA(b, h) (((b) * 2 + (h)) * HTB)
#define PG8_SB(b, h) ((4 + (b) * 2 + (h)) * HTB)
#define PG8_STAGE(bufoff, gbase, voff) do { _Pragma("unroll") for (int _i = 0; _i < 2; ++_i) \
        __builtin_amdgcn_global_load_lds((const unsigned*)((const char*)(gbase) + (voff)[_i]), (PG8_LAS unsigned*)(lds + (bufoff) + ldsw + _i * 8192), 16, 0, 0); } while (0)
#define PG8_LDA(dst, b, h) do { _Pragma("unroll") for (int m = 0; m < 4; ++m) _Pragma("unroll") for (int k = 0; k < 2; ++k) dst[m][k] = *(const PG8_LAS bf16x8*)(lds + PG8_SA(b, h) + aoff + m * 2048 + k * 1024); } while (0)
#define PG8_LDB(dst, b, h) do { _Pragma("unroll") for (int n = 0; n < 2; ++n) _Pragma("unroll") for (int k = 0; k < 2; ++k) dst[n][k] = *(const PG8_LAS bf16x8*)(lds + PG8_SB(b, h) + boff + n * 2048 + k * 1024); } while (0)
#define PG8_MMA(ai, bj, At, Bt) do { __builtin_amdgcn_s_setprio(1); _Pragma("unroll") for (int m = 0; m < 4; ++m) _Pragma("unroll") for (int n = 0; n < 2; ++n) _Pragma("unroll") for (int k = 0; k < 2; ++k) \
        acc[ai][bj][m][n] = __builtin_amdgcn_mfma_f32_16x16x32_bf16(Bt[n][k], At[m][k], acc[ai][bj][m][n], 0, 0, 0); __builtin_amdgcn_s_setprio(0); } while (0)
#define PG8_WAIT_V(n) asm volatile("s_waitcnt vmcnt(" #n ")" ::: "memory")
#define PG8_WAIT_L(n) asm volatile("s_waitcnt lgkmcnt(" #n ")" ::: "memory")
#define PG8_BAR __builtin_amdgcn_s_barrier()
#define PG8_SCHED __builtin_amdgcn_sched_barrier(0)
    Unit cur, nxt; int ui = 0;
    if (!S.next(0, cur)) return;
    f32x4 acc[2][2][4][2];
#pragma unroll
    for (int a = 0; a < 2; ++a)
#pragma unroll
        for (int b = 0; b < 2; ++b)
#pragma unroll
            for (int m = 0; m < 4; ++m)
#pragma unroll
                for (int n = 0; n < 2; ++n) acc[a][b][m][n] = (f32x4){0.f, 0.f, 0.f, 0.f};
    bf16x8 At[4][2], B0[2][2], B1[2][2];
    const char* cA = (const char*)g.A + (size_t)cur.pm * tstepA + S.a_off(cur); const char* cB = (const char*)g.Bt + (size_t)cur.pn * tstepB + S.b_off(cur);
    S.a_ready(cur);
    if constexpr (SP2) {
        PG8_STAGE(PG8_SB(0, 0), cB, voffB); PG8_STAGE(PG8_SB(0, 1), cB + hstepB, voffB); PG8_STAGE(PG8_SA(0, 0), cA, voffA); PG8_STAGE(PG8_SA(0, 1), cA + hstepA, voffA);
        if (wr == 1) PG8_BAR;
        PG8_WAIT_V(2); PG8_BAR;
        PG8_STAGE(PG8_SB(1, 0), cB + kstep, voffB); PG8_STAGE(PG8_SA(1, 0), cA + kstep, voffA); PG8_STAGE(PG8_SB(1, 1), cB + hstepB + kstep, voffB);
        PG8_WAIT_V(6); PG8_BAR;
    } else {
        PG8_STAGE(PG8_SB(0, 0), cB, voffB); PG8_STAGE(PG8_SA(0, 0), cA, voffA); PG8_STAGE(PG8_SB(0, 1), cB + hstepB, voffB); PG8_STAGE(PG8_SA(0, 1), cA + hstepA, voffA);
        if (wr == 1) PG8_BAR;
        PG8_WAIT_V(4); PG8_BAR;
        PG8_STAGE(PG8_SB(1, 0), cB + kstep, voffB); PG8_STAGE(PG8_SA(1, 0), cA + kstep, voffA); PG8_STAGE(PG8_SB(1, 1), cB + hstepB + kstep, voffB);
        PG8_WAIT_V(6); PG8_BAR;
    }
    for (;;) {
        const bool has_next = S.next(ui + 1, nxt);
        const char* nA = has_next ? (const char*)g.A + (size_t)nxt.pm * tstepA + S.a_off(nxt) : cA; const char* nB = has_next ? (const char*)g.Bt + (size_t)nxt.pn * tstepB + S.b_off(nxt) : cB;
        for (int t = 0; t < nt; t += 2) {
            const bool last = (t == nt - 2);
            const char* a1 = cA + (size_t)(t + 1) * kstep;
            const char* a2 = last ? nA : cA + (size_t)(t + 2) * kstep; const char* b2 = last ? nB : cB + (size_t)(t + 2) * kstep;
            const char* a3 = a2 + kstep; const char* b3 = b2 + kstep;
            if (last && has_next) S.a_ready(nxt);
            if constexpr (SP2) {
            PG8_LDB(B0, 0, 0); PG8_LDB(B1, 0, 1); PG8_SCHED; PG8_LDA(At, 0, 0); PG8_STAGE(PG8_SA(1, 1), a1 + hstepA, voffA);
            PG8_WAIT_V(8); PG8_WAIT_L(0); PG8_BAR; PG8_MMA(0, 0, At, B0); PG8_MMA(0, 1, At, B1); PG8_BAR; PG8_SCHED;
            PG8_LDA(At, 0, 1); PG8_STAGE(PG8_SB(0, 0), b2, voffB); PG8_STAGE(PG8_SB(0, 1), b2 + hstepB, voffB); PG8_STAGE(PG8_SA(0, 0), a2, voffA);
            PG8_WAIT_V(8); PG8_WAIT_L(0); PG8_BAR; PG8_MMA(1, 0, At, B0); PG8_MMA(1, 1, At, B1); PG8_BAR; PG8_SCHED;
            PG8_LDB(B0, 1, 0); PG8_LDB(B1, 1, 1); PG8_SCHED; PG8_LDA(At, 1, 0); PG8_STAGE(PG8_SA(0, 1), a2 + hstepA, voffA);
            PG8_WAIT_V(8); PG8_WAIT_L(0); PG8_BAR; PG8_MMA(0, 0, At, B0); PG8_MMA(0, 1, At, B1); PG8_BAR; PG8_SCHED;
            PG8_LDA(At, 1, 1); PG8_STAGE(PG8_SB(1, 0), b3, voffB); PG8_STAGE(PG8_SB(1, 1), b3 + hstepB, voffB); PG8_STAGE(PG8_SA(1, 0), a3, voffA);
            PG8_WAIT_V(8); PG8_WAIT_L(0); PG8_BAR; PG8_MMA(1, 0, At, B0); PG8_MMA(1, 1, At, B1); PG8_BAR; PG8_SCHED;
            } else {
            PG8_LDB(B0, 0, 0); PG8_SCHED; PG8_LDA(At, 0, 0); PG8_STAGE(PG8_SA(1, 1), a1 + hstepA, voffA);
            PG8_WAIT_L(8); PG8_BAR; PG8_WAIT_L(0); PG8_MMA(0, 0, At, B0); PG8_BAR; PG8_SCHED;
            PG8_LDB(B1, 0, 1); PG8_STAGE(PG8_SB(0, 0), b2, voffB);
            PG8_BAR; PG8_WAIT_L(0); PG8_MMA(0, 1, At, B1); PG8_BAR;
            PG8_LDA(At, 0, 1); PG8_STAGE(PG8_SA(0, 0), a2, voffA);
            PG8_BAR; PG8_WAIT_L(0); PG8_MMA(1, 0, At, B0); PG8_BAR; PG8_SCHED;
            PG8_STAGE(PG8_SB(0, 1), b2 + hstepB, voffB);
            PG8_WAIT_V(6); PG8_BAR; PG8_MMA(1, 1, At, B1); PG8_BAR;
            PG8_LDB(B0, 1, 0); PG8_SCHED; PG8_LDA(At, 1, 0); PG8_STAGE(PG8_SA(0, 1), a2 + hstepA, voffA);
            PG8_WAIT_L(8); PG8_BAR; PG8_WAIT_L(0); PG8_MMA(0, 0, At, B0); PG8_BAR; PG8_SCHED;
            PG8_LDB(B1, 1, 1); PG8_STAGE(PG8_SB(1, 0), b3, voffB);
            PG8_BAR; PG8_WAIT_L(0); PG8_MMA(0, 1, At, B1); PG8_BAR;
            PG8_LDA(At, 1, 1); PG8_STAGE(PG8_SA(1, 0), a3, voffA);
            PG8_BAR; PG8_WAIT_L(0); PG8_MMA(1, 0, At, B0); PG8_BAR; PG8_SCHED;
            PG8_STAGE(PG8_SB(1, 1), b3 + hstepB, voffB);
            PG8_WAIT_V(6); PG8_BAR; PG8_MMA(1, 1, At, B1); PG8_BAR;
            }
        }
        if constexpr (ALIGN_EPI) { if (wr == 0) PG8_BAR; }
        if constexpr (!Epi::AFTER_DRAIN) { E(acc, cur, wr, wc, fr, fq); S.done(cur); }
        if (!has_next) break;
#pragma unroll
        for (int a = 0; a < 2; ++a)
#pragma unroll
            for (int b = 0; b < 2; ++b)
#pragma unroll
                for (int m = 0; m < 4; ++m)
#pragma unroll
                    for (int n = 0; n < 2; ++n) acc[a][b][m][n] = (f32x4){0.f, 0.f, 0.f, 0.f};
        cur = nxt; cA = nA; cB = nB; ++ui;
        if constexpr (ALIGN_EPI) { if (wr == 1) PG8_BAR; }
    }
    PG8_WAIT_V(0);
    if constexpr (!ALIGN_EPI) { if (wr == 0) PG8_BAR; }
    PG8_BAR;
    if constexpr (Epi::AFTER_DRAIN) { E.fused(acc, cur, wr, wc, fr, fq, lds, wid, lane); S.done(cur); }
#undef PG8_SA
#undef PG8_SB
#undef PG8_STAGE
#undef PG8_LDA
#undef PG8_LDB
#undef PG8_MMA
#undef PG8_WAIT_V
#undef PG8_WAIT_L
#undef PG8_BAR
#undef PG8_SCHED
}
}
namespace pg8 {
typedef unsigned u32x2 __attribute__((ext_vector_type(2)));
__device__ __forceinline__ u32x4 pack8(const f32x4 a, const f32x4 b) { u32x4 w; w.x = cvt_pk_bf16(a[0], a[1]); w.y = cvt_pk_bf16(a[2], a[3]); w.z = cvt_pk_bf16(b[0], b[1]); w.w = cvt_pk_bf16(b[2], b[3]); return w; }
__device__ __forceinline__ void unpack8(const u32x4 w, f32x4& a, f32x4& b) {
    a[0] = __uint_as_float(w.x << 16); a[1] = __uint_as_float(w.x & 0xffff0000u); a[2] = __uint_as_float(w.y << 16); a[3] = __uint_as_float(w.y & 0xffff0000u);
    b[0] = __uint_as_float(w.z << 16); b[1] = __uint_as_float(w.z & 0xffff0000u); b[2] = __uint_as_float(w.w << 16); b[3] = __uint_as_float(w.w & 0xffff0000u); }
__device__ __forceinline__ float sigm(float v) { return __builtin_amdgcn_rcpf(1.f + __expf(-v)); }
__device__ __forceinline__ f32x4 sigm4(const f32x4 v) { f32x4 r; r[0] = sigm(v[0]); r[1] = sigm(v[1]); r[2] = sigm(v[2]); r[3] = sigm(v[3]); return r; }

struct EpiInprojF {
    static constexpr bool PERM = true, AFTER_DRAIN = false;
    bf16_t *QD, *CKV, *QI, *KI, *U, *QX; float* WI;
    __device__ __forceinline__ void operator()(const f32x4 (&acc)[2][2][4][2], const Unit& u, int wr, int wc, int fr, int fq) const {
        const int row0 = u.pm * BM + wr * 64 + fr;
#pragma unroll
        for (int bj = 0; bj < 2; ++bj) {
            const int c0 = u.pn * BM + bj * HALF + wc * 32 + 8 * fq;
            bf16_t* base = QD; int ld = 1024, cc = c0, kind = 0;
            if (c0 < 1024) { }
            else if (c0 < 1152) { base = CKV; ld = 128; cc = c0 - 1024; }
            else if (c0 < 1664) { base = QI; ld = 512; cc = c0 - 1152; }
            else if (c0 < 1728) { base = KI; ld = 64; cc = c0 - 1664; }
            else if (c0 < 1792) { kind = 1; }
            else if (c0 < 2304) { kind = 2; cc = c0 - 1792; }
            else { base = QX; ld = 512; cc = c0 - 2304; }
#pragma unroll
            for (int ai = 0; ai < 2; ++ai)
#pragma unroll
                for (int m = 0; m < 4; ++m) {
                    const int t = row0 + ai * HALF + m * 16;
                    if (kind == 0) *(u32x4*)(base + (size_t)t * ld + cc) = pack8(acc[ai][bj][m][0], acc[ai][bj][m][1]);
                    else if (kind == 1) { if (c0 == 1728) { *(f32x4*)(WI + (size_t)t * 8) = acc[ai][bj][m][0]; *(f32x4*)(WI + (size_t)t * 8 + 4) = acc[ai][bj][m][1]; } }
                    else { const int g = cc >> 4, ci = cc & 15, b = t >> 11, tt = t & 2047, R = b * 64 + (tt >> 5), s = tt & 31;
                        *(u32x4*)(U + ((size_t)(g * 512 + R)) * 640 + s * 16 + ci) = pack8(acc[ai][bj][m][0], acc[ai][bj][m][1]); }
                }
        }
    }
};
struct EpiBf16S {
    static constexpr bool PERM = true, AFTER_DRAIN = false;
    bf16_t* O0; bf16_t* O1; int split, ld;
    __device__ __forceinline__ void operator()(const f32x4 (&acc)[2][2][4][2], const Unit& u, int wr, int wc, int fr, int fq) const {
        const int row0 = u.pm * BM + wr * 64 + fr;
#pragma unroll
        for (int bj = 0; bj < 2; ++bj) {
            const int c0 = u.pn * BM + bj * HALF + wc * 32 + 8 * fq;
            bf16_t* base = c0 < split ? O0 : O1; const int cc = c0 < split ? c0 : c0 - split;
#pragma unroll
            for (int ai = 0; ai < 2; ++ai)
#pragma unroll
                for (int m = 0; m < 4; ++m) *(u32x4*)(base + (size_t)(row0 + ai * HALF + m * 16) * ld + cc) = pack8(acc[ai][bj][m][0], acc[ai][bj][m][1]);
        }
    }
};
struct EpiGluF {
    static constexpr bool PERM = true, AFTER_DRAIN = false;
    const bf16_t* Y; bf16_t* O;
    __device__ __forceinline__ void operator()(const f32x4 (&acc)[2][2][4][2], const Unit& u, int wr, int wc, int fr, int fq) const {
        const int row0 = u.pm * BM + wr * 64 + fr, c0 = u.pn * BM + wc * 32 + 8 * fq;
#pragma unroll
        for (int ai = 0; ai < 2; ++ai) {
            u32x4 yv[4][2];
#pragma unroll
            for (int m = 0; m < 4; ++m)
#pragma unroll
                for (int bj = 0; bj < 2; ++bj) yv[m][bj] = *(const u32x4*)(Y + (size_t)(row0 + ai * HALF + m * 16) * 512 + c0 + bj * HALF);
            asm volatile("" ::: "memory");
#pragma unroll
            for (int m = 0; m < 4; ++m)
#pragma unroll
                for (int bj = 0; bj < 2; ++bj) { f32x4 y0, y1; unpack8(yv[m][bj], y0, y1);
                    *(u32x4*)(O + (size_t)(row0 + ai * HALF + m * 16) * 512 + c0 + bj * HALF) = pack8(y0 * sigm4(acc[ai][bj][m][0]), y1 * sigm4(acc[ai][bj][m][1])); }
        }
    }
};
struct EpiSigmoidF {
    static constexpr bool PERM = true, AFTER_DRAIN = false;
    bf16_t* G; int ld;
    __device__ __forceinline__ void operator()(const f32x4 (&acc)[2][2][4][2], const Unit& u, int wr, int wc, int fr, int fq) const {
        const int row0 = u.pm * BM + wr * 64 + fr;
#pragma unroll
        for (int bj = 0; bj < 2; ++bj) {
            const int c0 = u.pn * BM + bj * HALF + wc * 32 + 8 * fq;
#pragma unroll
            for (int ai = 0; ai < 2; ++ai)
#pragma unroll
                for (int m = 0; m < 4; ++m) *(u32x4*)(G + (size_t)(row0 + ai * HALF + m * 16) * ld + c0) = pack8(sigm4(acc[ai][bj][m][0]), sigm4(acc[ai][bj][m][1]));
        }
    }
};
struct EpiMergeF {
    static constexpr bool PERM = true, AFTER_DRAIN = false;
    const bf16_t* G3; bf16_t* MG;
    __device__ __forceinline__ void operator()(const f32x4 (&acc)[2][2][4][2], const Unit& u, int wr, int wc, int fr, int fq) const {
        const int row0 = u.pm * BM + wr * 64 + fr, c0 = u.pn * BM + wc * 32 + 8 * fq; const bool first = u.z == 0;
#pragma unroll
        for (int ai = 0; ai < 2; ++ai) {
            u32x4 gv[4][2], pv[4][2];
#pragma unroll
            for (int m = 0; m < 4; ++m)
#pragma unroll
                for (int bj = 0; bj < 2; ++bj) { const size_t t = (size_t)(row0 + ai * HALF + m * 16);
                    gv[m][bj] = *(const u32x4*)(G3 + t * 3072 + u.z * 1024 + c0 + bj * HALF);
                    pv[m][bj] = first ? (u32x4){0u, 0u, 0u, 0u} : *(const u32x4*)(MG + t * 1024 + c0 + bj * HALF); }
            asm volatile("" ::: "memory");
#pragma unroll
            for (int m = 0; m < 4; ++m)
#pragma unroll
                for (int bj = 0; bj < 2; ++bj) { const size_t t = (size_t)(row0 + ai * HALF + m * 16);
                    f32x4 g0, g1, p0, p1; unpack8(gv[m][bj], g0, g1); unpack8(pv[m][bj], p0, p1);
                    *(u32x4*)(MG + t * 1024 + c0 + bj * HALF) = pack8(p0 + g0 * acc[ai][bj][m][0], p1 + g1 * acc[ai][bj][m][1]); }
        }
    }
};
struct EpiOutF {
    static constexpr bool PERM = false, AFTER_DRAIN = false;
    const float* x; float* out; bf16_t* XN; float* RS;
    __device__ __forceinline__ void operator()(const f32x4 (&acc)[2][2][4][2], const Unit& u, int wr, int wc, int fr, int fq) const {
        const int row0 = u.pm * BM + wr * 64 + fr, col0 = u.pn * BM + wc * 32 + 4 * fq;
#pragma unroll
        for (int ai = 0; ai < 2; ++ai) {
            f32x4 xv[4][2][2];
#pragma unroll
            for (int m = 0; m < 4; ++m)
#pragma unroll
                for (int bj = 0; bj < 2; ++bj)
#pragma unroll
                    for (int n = 0; n < 2; ++n) xv[m][bj][n] = *(const f32x4*)(x + (size_t)(row0 + ai * HALF + m * 16) * 1024 + col0 + bj * HALF + n * 16);
            asm volatile("" ::: "memory");
#pragma unroll
            for (int m = 0; m < 4; ++m) { const int t = row0 + ai * HALF + m * 16; const size_t off = (size_t)t * 1024 + col0; float ss = 0.f;
#pragma unroll
                for (int bj = 0; bj < 2; ++bj)
#pragma unroll
                    for (int n = 0; n < 2; ++n) { const size_t o2 = off + bj * HALF + n * 16; const f32x4 r = xv[m][bj][n] + acc[ai][bj][m][n];
                        *(f32x4*)(out + o2) = r; u32x2 w; w.x = cvt_pk_bf16(r[0], r[1]); w.y = cvt_pk_bf16(r[2], r[3]); *(u32x2*)(XN + o2) = w;
                        ss += (r[0] * r[0] + r[1] * r[1]) + (r[2] * r[2] + r[3] * r[3]); }
                ss += __shfl_xor(ss, 16); ss += __shfl_xor(ss, 32);
                if (fq == 0) RS[(size_t)t * 16 + u.pn * 4 + wc] = ss; }
        }
    }
};
struct EpiGateUpF {
    static constexpr bool PERM = true, AFTER_DRAIN = false;
    const float* RS; bf16_t* ACT;
    __device__ __forceinline__ void operator()(const f32x4 (&acc)[2][2][4][2], const Unit& u, int wr, int wc, int fr, int fq) const {
        const int row0 = u.pm * BM + wr * 64 + fr, f0 = u.pn * HALF + wc * 32 + 8 * fq;
        f32x4 pr[2][4];
#pragma unroll
        for (int ai = 0; ai < 2; ++ai)
#pragma unroll
            for (int m = 0; m < 4; ++m) pr[ai][m] = *(const f32x4*)(RS + (size_t)(row0 + ai * HALF + m * 16) * 16 + 4 * fq);
        asm volatile("" ::: "memory");
#pragma unroll
        for (int ai = 0; ai < 2; ++ai)
#pragma unroll
            for (int m = 0; m < 4; ++m) { const int t = row0 + ai * HALF + m * 16;
                float tot = (pr[ai][m][0] + pr[ai][m][1]) + (pr[ai][m][2] + pr[ai][m][3]); tot += __shfl_xor(tot, 16); tot += __shfl_xor(tot, 32);
                const float rs = __builtin_amdgcn_rsqf(tot * (1.f / 1024.f) + 1e-6f);
                f32x4 o[2];
#pragma unroll
                for (int n = 0; n < 2; ++n) { const f32x4 g = acc[ai][0][m][n] * rs, up = acc[ai][1][m][n] * rs; o[n] = g * sigm4(g) * up; }
                *(u32x4*)(ACT + (size_t)t * 2816 + f0) = pack8(o[0], o[1]); }
    }
};
struct EpiDownF {
    static constexpr bool PERM = false, AFTER_DRAIN = false;
    float* out;
    __device__ __forceinline__ void operator()(const f32x4 (&acc)[2][2][4][2], const Unit& u, int wr, int wc, int fr, int fq) const {
        const int row0 = u.pm * BM + wr * 64 + fr, col0 = u.pn * BM + wc * 32 + 4 * fq;
#pragma unroll
        for (int ai = 0; ai < 2; ++ai) {
            f32x4 xv[4][2][2];
#pragma unroll
            for (int m = 0; m < 4; ++m)
#pragma unroll
                for (int bj = 0; bj < 2; ++bj)
#pragma unroll
                    for (int n = 0; n < 2; ++n) xv[m][bj][n] = *(const f32x4*)(out + (size_t)(row0 + ai * HALF + m * 16) * 1024 + col0 + bj * HALF + n * 16);
            asm volatile("" ::: "memory");
#pragma unroll
            for (int m = 0; m < 4; ++m)
#pragma unroll
                for (int bj = 0; bj < 2; ++bj)
#pragma unroll
                    for (int n = 0; n < 2; ++n) *(f32x4*)(out + (size_t)(row0 + ai * HALF + m * 16) * 1024 + col0 + bj * HALF + n * 16) = xv[m][bj][n] + acc[ai][bj][m][n];
        }
    }
};
struct EpiSlocF {
    static constexpr bool PERM = false, AFTER_DRAIN = false;
    float* SLOC;
    __device__ __forceinline__ void operator()(const f32x4 (&acc)[2][2][4][2], const Unit& u, int wr, int wc, int fr, int fq) const {
        const int row0 = u.pm * BM + wr * 64 + fr, col0 = wc * 32 + 4 * fq;
#pragma unroll
        for (int ai = 0; ai < 2; ++ai)
#pragma unroll
            for (int m = 0; m < 4; ++m)
#pragma unroll
                for (int n = 0; n < 2; ++n) *(f32x4*)(SLOC + (size_t)(row0 + ai * HALF + m * 16) * 128 + col0 + n * 16) = acc[ai][0][m][n];
    }
};
__device__ __forceinline__ float gelu_t(float x) { const float w = 1.5957691216057308f * (x + 0.044715f * x * x * x); return x * __builtin_amdgcn_rcpf(1.f + __expf(-w)); }
struct EpiS5YF {
    static constexpr bool PERM = true, AFTER_DRAIN = false;
    const bf16_t* U; const float* dskip; bf16_t* Y;
    __device__ __forceinline__ void operator()(const f32x4 (&acc)[2][2][4][2], const Unit& u, int wr, int wc, int fr, int fq) const {
        const int row0 = u.pm * BM + wr * 64 + fr, g = (u.pm * BM) >> 9;
        f32x4 dk[2][2];
#pragma unroll
        for (int bj = 0; bj < 2; ++bj) { const int co0 = ((u.pn & 1) * BM + bj * HALF + wc * 32 + 8 * fq) & 15; dk[bj][0] = *(const f32x4*)(dskip + g * 16 + co0); dk[bj][1] = *(const f32x4*)(dskip + g * 16 + co0 + 4); }
#pragma unroll
        for (int ai = 0; ai < 2; ++ai) {
            u32x4 uv[4][2];
#pragma unroll
            for (int m = 0; m < 4; ++m)
#pragma unroll
                for (int bj = 0; bj < 2; ++bj) { const int cl = (u.pn & 1) * BM + bj * HALF + wc * 32 + 8 * fq; uv[m][bj] = *(const u32x4*)(U + (size_t)(row0 + ai * HALF + m * 16) * 640 + cl); }
            asm volatile("" ::: "memory");
#pragma unroll
            for (int m = 0; m < 4; ++m)
#pragma unroll
                for (int bj = 0; bj < 2; ++bj) { const int cl = (u.pn & 1) * BM + bj * HALF + wc * 32 + 8 * fq, s = cl >> 4, co0 = cl & 15;
                    const int row = row0 + ai * HALF + m * 16, R = row & 511, b = R >> 6, ch = R & 63, t = b * 2048 + ch * 32 + s;
                    f32x4 u0, u1; unpack8(uv[m][bj], u0, u1);
                    f32x4 y0 = acc[ai][bj][m][0] + dk[bj][0] * u0, y1 = acc[ai][bj][m][1] + dk[bj][1] * u1;
#pragma unroll
                    for (int e2 = 0; e2 < 4; ++e2) { y0[e2] = gelu_t(y0[e2]); y1[e2] = gelu_t(y1[e2]); }
                    *(u32x4*)(Y + (size_t)t * 512 + g * 16 + co0) = pack8(y0, y1); }
        }
    }
};
struct SubsetOrder { StaticOrder so; bool active;
    __device__ void init(int M, int N, int Gsub, int csub) { so.init(M, N, Gsub, csub < 0 ? 0 : csub); active = csub >= 0 && csub < Gsub; }
    __device__ bool next(int i, Unit& u) const { return active && so.next(i, u); }
    __device__ __forceinline__ void a_ready(const Unit&) const {}
    __device__ __forceinline__ void done(const Unit&) const {}
    __device__ __forceinline__ long a_off(const Unit&) const { return 0; }
    __device__ __forceinline__ long b_off(const Unit&) const { return 0; } };
struct S5Order1 { int c;
    __device__ bool next(int i, Unit& u) const { if (i > 0 || c < 0 || c >= 64) return false; u.pm = c; u.pn = c >> 1; u.z = 0; return true; }
    __device__ __forceinline__ void a_ready(const Unit&) const {}
    __device__ __forceinline__ void done(const Unit&) const {}
    __device__ __forceinline__ long a_off(const Unit&) const { return 0; }
    __device__ __forceinline__ long b_off(const Unit&) const { return 0; } };
struct S5Order2 { int c;
    __device__ bool next(int i, Unit& u) const { if (i > 0 || c < 0 || c >= 128) return false; const int g = c >> 2; u.pm = g * 2 + ((c >> 1) & 1); u.pn = g * 2 + (c & 1); u.z = 0; return true; }
    __device__ __forceinline__ void a_ready(const Unit&) const {}
    __device__ __forceinline__ void done(const Unit&) const {}
    __device__ __forceinline__ long a_off(const Unit&) const { return 0; }
    __device__ __forceinline__ long b_off(const Unit&) const { return 0; } };
struct GateOrder { int c;
    __device__ bool next(int i, Unit& u) const { int id; if (c < 128) { if (i >= 2) return false; id = c * 2 + i; } else { if (i >= 4) return false; id = 256 + (c - 128) * 4 + i; } u.pm = id / 12; u.pn = id % 12; u.z = 0; return true; }
    __device__ __forceinline__ void a_ready(const Unit&) const {}
    __device__ __forceinline__ void done(const Unit&) const {}
    __device__ __forceinline__ long a_off(const Unit&) const { return 0; }
    __device__ __forceinline__ long b_off(const Unit&) const { return 0; } };
struct MergeOrder { StaticOrder so; long aoff[3];
    __device__ bool next(int i, Unit& u) const { if (i >= 3) return false; if (!so.next(0, u)) return false; u.z = i; return true; }
    __device__ __forceinline__ void a_ready(const Unit&) const {}
    __device__ __forceinline__ void done(const Unit&) const {}
    __device__ __forceinline__ long a_off(const Unit& u) const { return u.z == 0 ? aoff[0] : (u.z == 1 ? aoff[1] : aoff[2]); }
    __device__ __forceinline__ long b_off(const Unit& u) const { return (long)u.z * 1024 * 512 * 2; } };
}
#define GAS __attribute__((address_space(1)))
#define LAS __attribute__((address_space(3)))
typedef unsigned short bf16;
typedef unsigned v4u __attribute__((ext_vector_type(4)));
typedef float f32x4 __attribute__((ext_vector_type(4)));
typedef short bf16x8 __attribute__((ext_vector_type(8)));
typedef GAS unsigned gu32;
typedef GAS unsigned long long gu64;
#define RLX_AGENT __ATOMIC_RELAXED, __HIP_MEMORY_SCOPE_AGENT
#define LDS_WAIT() asm volatile("s_waitcnt lgkmcnt(0)" ::: "memory")
#define VM_WAIT() asm volatile("s_waitcnt vmcnt(0)" ::: "memory")
__device__ __forceinline__ unsigned long long rt() { return __builtin_amdgcn_s_memrealtime(); }
__device__ __forceinline__ unsigned f2bf(float f) { unsigned u = __builtin_bit_cast(unsigned, f); return (u + 0x7fffu + ((u >> 16) & 1u)) >> 16; }
__device__ __forceinline__ unsigned pk2(float lo, float hi) { return f2bf(lo) | (f2bf(hi) << 16); }

#define XB_TMO      128
#define XB_XCNT(j)  (256  + 64 * (j))
#define XB_XSUB(j)  (1280 + 64 * (j))
#define XB_XGEN(j)  (2304 + 64 * (j))
#define XB_TOP      3328
#define XB_TOPGEN   3392
#define XCD_BAR_WORDS 3456
#define XB_SPIN_CAP (1u << 18)

__device__ __forceinline__ unsigned xb_ld(unsigned* p)              { return __hip_atomic_load(p, __ATOMIC_RELAXED, __HIP_MEMORY_SCOPE_AGENT); }
__device__ __forceinline__ unsigned xb_add(unsigned* p, unsigned v) { return __hip_atomic_fetch_add(p, v, __ATOMIC_RELAXED, __HIP_MEMORY_SCOPE_AGENT); }
__device__ __forceinline__ unsigned xb_xcc_id() { return (unsigned)__builtin_amdgcn_s_getreg((3 << 11) | 20) & 0xFu; }
#define XB_SPIN(cond, bar) do { unsigned _sp = 0; while (cond) { __builtin_amdgcn_s_sleep(1); \
    if ((++_sp & 255u) == 0u) { if (xb_ld(&(bar)[XB_TMO])) break; if (_sp > XB_SPIN_CAP) { atomicAdd(&(bar)[XB_TMO], 1u); break; } } } } while (0)

struct XcdBarrier {
    unsigned* bar; unsigned x;
    volatile LAS unsigned* st;
};

__device__ __forceinline__ XcdBarrier xcd_barrier_post(unsigned* bar, volatile LAS unsigned* st, bool leader) {
    XcdBarrier b; b.bar = bar; b.x = xb_xcc_id(); b.st = st;
    if (leader) (void)xb_add(&bar[XB_XCNT(b.x)], 1u);
    return b;
}
__device__ __forceinline__ void xcd_barrier_complete(unsigned* bar, unsigned x, unsigned& nloc, unsigned& nx) {
    const unsigned G = gridDim.x * gridDim.y * gridDim.z;
    unsigned sum, cnt, mine, sp = 0u;
    for (;;) {
        sum = 0u; cnt = 0u; mine = 0u;
#pragma unroll
        for (unsigned j = 0; j < 16; ++j) { const unsigned c = xb_ld(&bar[XB_XCNT(j)]); sum += c; cnt += (c > 0u) ? 1u : 0u; mine = (j == x) ? c : mine; }
        if (sum == G) break;
        __builtin_amdgcn_s_sleep(1);
        if ((++sp & 255u) == 0u) { if (xb_ld(&bar[XB_TMO])) break; if (sp > XB_SPIN_CAP) { atomicAdd(&bar[XB_TMO], 1u); break; } }
    }
    nloc = mine > 0u ? mine : 1u; nx = cnt > 0u ? cnt : 1u;
}

__device__ __forceinline__ void xcd_barrier(const XcdBarrier& b, bool leader) {
    asm volatile("s_waitcnt vmcnt(0)" ::: "memory");
    __syncthreads();
    if (leader) {
        unsigned* bar = b.bar;
        __builtin_amdgcn_s_waitcnt(0);
        unsigned nloc = b.st[0], nx = b.st[1];
        if (nloc == 0u) { xcd_barrier_complete(bar, b.x, nloc, nx); b.st[0] = nloc; b.st[1] = nx; }
        const unsigned old = xb_add(&bar[XB_XSUB(b.x)], 1u);
        const unsigned gen = old / nloc;
        if (old + 1u == (gen + 1u) * nloc) {
            __builtin_amdgcn_fence(__ATOMIC_RELEASE, "agent");
            asm volatile("s_waitcnt vmcnt(0)" ::: "memory");
            const unsigned og = xb_add(&bar[XB_TOP], 1u);
            const unsigned tg = og / nx;
            if (og + 1u == (tg + 1u) * nx) xb_add(&bar[XB_TOPGEN], 1u);
            else XB_SPIN(xb_ld(&bar[XB_TOPGEN]) == tg, bar);
            __builtin_amdgcn_fence(__ATOMIC_ACQUIRE, "agent");
            xb_add(&bar[XB_XGEN(b.x)], 1u);
            asm volatile("s_waitcnt vmcnt(0)" ::: "memory");
        } else {
            XB_SPIN(xb_ld(&bar[XB_XGEN(b.x)]) == gen, bar);
            __builtin_amdgcn_fence(__ATOMIC_ACQUIRE, "agent");
            asm volatile("s_waitcnt vmcnt(0)" ::: "memory");
        }
    }
    __syncthreads();
}
constexpr int NWAVES = 8, NTHR = 512;
constexpr int RING_OFF = 0, RING_BYTES = 131072;
constexpr int LDSCTL_OFF = RING_BYTES, MISC_OFF = LDSCTL_OFF + 320;
constexpr int LDS_BYTES = 147456;
constexpr size_t CTL_ZERO_BYTES = 1 * MiB;
constexpr int CW_TMO = 0, CW_BAR = 4096;
constexpr int NPH = 9;
constexpr int FL_NO_DSA = 1, FL_NO_CROSS = 2, FL_NO_S5 = 4;
constexpr size_t WS_LAM32 = WS_BIASL + 8192;

struct Args { const float* in[29]; float* out; unsigned char* ws; int ph_lo, ph_hi, flags, li; };

__device__ __forceinline__ float wave_sum(float v) {
#pragma unroll
    for (int o = 1; o < 64; o <<= 1) v += __shfl_xor(v, o);
    return v;
}
__device__ __forceinline__ float p0_src(int mode, const float* W, const float* W2, const float* gain, int N, int k, int d) {
    if (mode == 0) return W[(size_t)k * N + d];
    if (mode == 1) { if (d >= 1736 && d < 1792) return 0.f; const int s = d >= 1792 ? d - 56 : d; return W[(size_t)k * N + s]; }
    const int tile = d >> 8, w = d & 255, f = tile * 128 + (w & 127); return ((w < 128) ? W : W2)[(size_t)k * N + f] * gain[k];
}
__device__ __forceinline__ void p0_transpose_item(int mode, const float* W, const float* W2, const float* gain, int K, int N, int ND, bf16* WT, LAS float* scr, int item, int lane) {
    const int nblk = ND / 32, kb = item / nblk, nb = item % nblk, k0 = 64 * kb, d0 = 32 * nb;
    float tv[32];
#pragma unroll
    for (int i = 0; i < 32; ++i) tv[i] = p0_src(mode, W, W2, gain, N, k0 + 2 * i + (lane >> 5), d0 + (lane & 31));
#pragma unroll
    for (int i = 0; i < 32; ++i) scr[(2 * i + (lane >> 5)) * 33 + (lane & 31)] = tv[i];
    LDS_WAIT(); asm volatile("" ::: "memory");
    const int c = lane & 7;
#pragma unroll
    for (int j = 0; j < 4; ++j) { const int n = (lane >> 3) + 8 * j; const LAS float* s = scr + (8 * c) * 33 + n;
        v4u o; o.x = pk2(s[0 * 33], s[1 * 33]); o.y = pk2(s[2 * 33], s[3 * 33]); o.z = pk2(s[4 * 33], s[5 * 33]); o.w = pk2(s[6 * 33], s[7 * 33]);
        *(GAS v4u*)(WT + (size_t)(d0 + n) * K + k0 + 8 * c) = o; }
    LDS_WAIT(); asm volatile("" ::: "memory");
}
__device__ __forceinline__ void rms_row_to_bf16(const float* xrow, const float* g, bf16* orow, int lane) {
    const GAS f32x4* xr = (const GAS f32x4*)xrow + lane; const GAS f32x4* gr = (const GAS f32x4*)g + lane;
    f32x4 v[4]; float s = 0.f;
#pragma unroll
    for (int j = 0; j < 4; ++j) { v[j] = xr[64 * j]; s += (v[j].x * v[j].x + v[j].y * v[j].y) + (v[j].z * v[j].z + v[j].w * v[j].w); }
    const float rstd = 1.f / sqrtf(wave_sum(s) * (1.f / 1024.f) + 1e-6f);
    GAS unsigned long long* o8 = (GAS unsigned long long*)orow + lane;
#pragma unroll
    for (int j = 0; j < 4; ++j) { const f32x4 gg = gr[64 * j];
        o8[64 * j] = (unsigned long long)pk2(v[j].x * rstd * gg.x, v[j].y * rstd * gg.y) | ((unsigned long long)pk2(v[j].z * rstd * gg.z, v[j].w * rstd * gg.w) << 32); }
}
__device__ __forceinline__ int t5_bucket(int n) {
    if (n < 16) return n;
    const int large = 16 + (int)((logf((float)n / 16.f) / 2.0794415416798357f) * 16.f);
    return large < 31 ? large : 31;
}
__device__ __forceinline__ void p0_s5_tables(int g, int part, const Args& a, LAS unsigned char* lds, int tid) {
    typedef float f32x2v __attribute__((ext_vector_type(2)));
    LAS f32x2v* POW = (LAS f32x2v*)lds;
    LAS f32x2v* BB = POW + 33 * 64;
    LAS f32x2v* CC = BB + 64 * 16;
    LAS float* KT = (LAS float*)(CC + 16 * 64);
    const float *a_re = a.in[8], *a_im = a.in[9], *log_dt = a.in[10], *b_re = a.in[11], *b_im = a.in[12], *c_re = a.in[13], *c_im = a.in[14];
    bf16* TV = (bf16*)(a.ws + WS_S5TV) + (size_t)g * 512 * 640; bf16* Wt = (bf16*)(a.ws + WS_S5W) + (size_t)g * 256 * 512; float* LAM32 = (float*)(a.ws + WS_LAM32) + g * 128;
    const double dt = exp((double)log_dt[g]);
    for (int idx = tid; idx < 33 * 64; idx += NTHR) { const int j = idx >> 6, n = idx & 63; const double lr = a_re[g * 64 + n], li = a_im[g * 64 + n];
        const double mag = exp(lr * dt * j), ang = li * dt * j; POW[idx] = (f32x2v){(float)(mag * cos(ang)), (float)(mag * sin(ang))}; }
    for (int idx = tid; idx < 64 * 16; idx += NTHR) { const int n = idx >> 4, c = idx & 15; const double lr = a_re[g * 64 + n], li = a_im[g * 64 + n];
        const double mag = exp(lr * dt), lbr = mag * cos(li * dt), lbi = mag * sin(li * dt), nr = lbr - 1.0, ni = lbi, den = lr * lr + li * li;
        const double fr = (nr * lr + ni * li) / den, fi = (ni * lr - nr * li) / den, br = b_re[(g * 64 + n) * 16 + c], bi = b_im[(g * 64 + n) * 16 + c];
        BB[idx] = (f32x2v){(float)(fr * br - fi * bi), (float)(fr * bi + fi * br)};
        const int c2 = idx >> 6, n2 = idx & 63; CC[idx] = (f32x2v){c_re[(g * 16 + c2) * 64 + n2], c_im[(g * 16 + c2) * 64 + n2]}; }
    __syncthreads();
    if (part == 0 && tid < 64) { const f32x2v p = POW[32 * 64 + tid]; LAM32[tid * 2] = p.x; LAM32[tid * 2 + 1] = p.y; }
    for (int idx = tid; idx < 32 * 32; idx += NTHR) { const int j = idx >> 5, co = 2 * part + ((idx >> 4) & 1), ci = idx & 15; float s = 0.f;
#pragma unroll 2
        for (int n = 0; n < 64; ++n) { const f32x2v c = CC[co * 64 + n], p = POW[j * 64 + n], b = BB[n * 16 + ci];
            const float cpr = c.x * p.x - c.y * p.y, cpi = c.x * p.y + c.y * p.x; s += cpr * b.x - cpi * b.y; }
        KT[j * 256 + co * 16 + ci] = s; }
    __syncthreads();
    for (int id = tid; id < 64 * 80; id += NTHR) { const int rl = id / 80, c8 = id % 80, so = rl >> 1, co = 2 * part + (rl & 1), row = so * 16 + co; float v[8];
        if (c8 < 64) { const int si = c8 >> 1, ci0 = (c8 & 1) * 8;
#pragma unroll
            for (int e = 0; e < 8; ++e) v[e] = so >= si ? KT[(so - si) * 256 + co * 16 + ci0 + e] : 0.f; }
        else {
#pragma unroll
            for (int e = 0; e < 8; ++e) { const int np = (c8 - 64) * 8 + e, n = np & 63; const f32x2v c = CC[co * 64 + n], p = POW[(so + 1) * 64 + n];
                v[e] = np < 64 ? (c.x * p.x - c.y * p.y) : -(c.x * p.y + c.y * p.x); } }
        v4u o; o.x = pk2(v[0], v[1]); o.y = pk2(v[2], v[3]); o.z = pk2(v[4], v[5]); o.w = pk2(v[6], v[7]);
        *(GAS v4u*)(TV + (size_t)row * 640 + c8 * 8) = o; }
    for (int id = tid; id < 16 * 64; id += NTHR) { const int np = 16 * part + (id >> 6), c8 = id & 63, n = np & 63, s = c8 >> 1, ci0 = (c8 & 1) * 8; const f32x2v p = POW[(31 - s) * 64 + n]; float v[8];
#pragma unroll
        for (int e = 0; e < 8; ++e) { const f32x2v b = BB[n * 16 + ci0 + e]; v[e] = np < 64 ? (p.x * b.x - p.y * b.y) : (p.x * b.y + p.y * b.x); }
        v4u o; o.x = pk2(v[0], v[1]); o.y = pk2(v[2], v[3]); o.z = pk2(v[4], v[5]); o.w = pk2(v[6], v[7]);
        *(GAS v4u*)(Wt + (size_t)np * 512 + c8 * 8) = o; }
    __syncthreads();
}
__device__ __forceinline__ void p0_prologue(const Args& a, LAS unsigned char* lds, int tid, int lane, int wave, int vcu, int G) {
    unsigned char* ws = a.ws;
    LAS float* scr = (LAS float*)(lds + RING_OFF + wave * 16384);
    const int gw = vcu * NWAVES + wave, NGW = G * NWAVES;
    p0_s5_tables(vcu >> 3, vcu & 7, a, lds, tid);
    if (blockIdx.x == 33 && tid == 0) {
        float gq = 0.f, gk = 0.f, bm = 0.f; for (int i = 0; i < 128; ++i) { gq = fmaxf(gq, fabsf(a.in[5][i])); gk = fmaxf(gk, fabsf(a.in[6][i])); }
        for (int i = 0; i < 256; ++i) bm = fmaxf(bm, fabsf(a.in[2][i]));
        const float B = 1.02f * 128.f * 0.08838834764831845f * 1.4426950408889634f * gq * gk + bm * 1.4426950408889634f;
        ((float*)(ws + WS_BIASL))[1032] = (B > 0.f && B <= 56.f) ? B : 0.f; }
    if (blockIdx.x == 32) { float* BL = (float*)(ws + WS_BIASL); const float* rb = a.in[2];
        for (int i = tid; i < 8 * 128 + 8; i += NTHR) { if (i < 1024) { const int h = i >> 7, d = i & 127; BL[i] = rb[t5_bucket(d) * 8 + h] * 1.4426950408889634f; } else BL[i] = rb[31 * 8 + (i - 1024)] * 1.4426950408889634f; } }
    { bf16* WUV = (bf16*)(ws + WS_WUV); const float* w = a.in[7];
        for (int i = blockIdx.x * NTHR + tid; i < 8 * 64 * 128; i += G * NTHR) { const int ep = i & 3, ln = (i >> 2) & 63, t = (i >> 8) & 1, cs = (i >> 9) & 7, eb = (i >> 12) & 1, h = i >> 13;
            const int d = 16 * cs + 8 * t + 4 * (ln >> 5) + ep, e = 32 * eb + (ln & 31); WUV[i] = (bf16)f2bf(w[(h * 128 + d) * 64 + e]); } }
    constexpr int I_IN = 16 * 184, I_MKV = 16 * 32, I_GLU = 8 * 16, I_BR = 8 * 32, I_OUT = 16 * 32, I_GU = 16 * 176, I_D = 44 * 32;
    constexpr int NITEMS = I_IN + I_MKV + I_GLU + 3 * I_BR + I_OUT + I_GU + I_D;
    for (int it = gw; it < NITEMS; it += NGW) {
        int r = it;
        if (r < I_IN) { p0_transpose_item(1, a.in[3], nullptr, nullptr, 1024, 5832, 5888, (bf16*)(ws + WS_WIN), scr, r, lane); continue; } r -= I_IN;
        if (r < I_MKV) { p0_transpose_item(0, a.in[18], nullptr, nullptr, 1024, 1024, 1024, (bf16*)(ws + WS_WMKV), scr, r, lane); continue; } r -= I_MKV;
        if (r < I_GLU) { p0_transpose_item(0, a.in[16], nullptr, nullptr, 512, 512, 512, (bf16*)(ws + WS_WGLU), scr, r, lane); continue; } r -= I_GLU;
        if (r < 3 * I_BR) { const int br = r / I_BR; p0_transpose_item(0, a.in[21 + br], nullptr, nullptr, 512, 1024, 1024, (bf16*)(ws + WS_WBR) + (size_t)br * 1024 * 512, scr, r % I_BR, lane); continue; } r -= 3 * I_BR;
        if (r < I_OUT) { p0_transpose_item(0, a.in[24], nullptr, nullptr, 1024, 1024, 1024, (bf16*)(ws + WS_WOUT), scr, r, lane); continue; } r -= I_OUT;
        if (r < I_GU) { p0_transpose_item(2, a.in[26], a.in[27], a.in[25], 1024, 2816, 5632, (bf16*)(ws + WS_WGU), scr, r, lane); continue; } r -= I_GU;
        p0_transpose_item(0, a.in[28], nullptr, nullptr, 2816, 1024, 1024, (bf16*)(ws + WS_WD), scr, r, lane);
    }
    for (int m = gw; m < T_TOK; m += 2 * NGW) {
        const GAS f32x4* x0 = (const GAS f32x4*)(a.in[0] + (size_t)m * 1024) + lane; const GAS f32x4* x1 = (const GAS f32x4*)(a.in[0] + (size_t)(m + NGW) * 1024) + lane; const GAS f32x4* gr = (const GAS f32x4*)a.in[4] + lane;
        f32x4 v0[4], v1[4]; float s0 = 0.f, s1 = 0.f;
#pragma unroll
        for (int j = 0; j < 4; ++j) { v0[j] = x0[64 * j]; v1[j] = x1[64 * j]; }
#pragma unroll
        for (int j = 0; j < 4; ++j) { s0 += (v0[j].x * v0[j].x + v0[j].y * v0[j].y) + (v0[j].z * v0[j].z + v0[j].w * v0[j].w); s1 += (v1[j].x * v1[j].x + v1[j].y * v1[j].y) + (v1[j].z * v1[j].z + v1[j].w * v1[j].w); }
        const float r0 = 1.f / sqrtf(wave_sum(s0) * (1.f / 1024.f) + 1e-6f), r1 = 1.f / sqrtf(wave_sum(s1) * (1.f / 1024.f) + 1e-6f);
        GAS unsigned long long* o0 = (GAS unsigned long long*)((bf16*)(ws + WS_H) + (size_t)m * 1024) + lane; GAS unsigned long long* o1 = (GAS unsigned long long*)((bf16*)(ws + WS_H) + (size_t)(m + NGW) * 1024) + lane;
#pragma unroll
        for (int j = 0; j < 4; ++j) { const f32x4 gg = gr[64 * j];
            o0[64 * j] = (unsigned long long)pk2(v0[j].x * r0 * gg.x, v0[j].y * r0 * gg.y) | ((unsigned long long)pk2(v0[j].z * r0 * gg.z, v0[j].w * r0 * gg.w) << 32);
            o1[64 * j] = (unsigned long long)pk2(v1[j].x * r1 * gg.x, v1[j].y * r1 * gg.y) | ((unsigned long long)pk2(v1[j].z * r1 * gg.z, v1[j].w * r1 * gg.w) << 32); }
    }
    for (int m = gw; m < 2048; m += NGW) rms_row_to_bf16(a.in[1] + (size_t)m * 1024, a.in[17], (bf16*)(ws + WS_MEMN) + (size_t)m * 1024, lane);
}
__device__ __forceinline__ void norm128_pass(bf16* X, int rows, int ld, int ngroups, const float* g, int gtid, int nthr) {
    const int l = gtid & 15, total = rows * ngroups;
    for (int gid = gtid >> 4; gid < total; gid += nthr >> 4) {
        const int r = gid / ngroups, gi = gid % ngroups;
        bf16* p = X + (size_t)r * ld + gi * 128 + l * 8;
        const v4u v = *(const GAS v4u*)p; float f[8];
        f[0] = __uint_as_float(v.x << 16); f[1] = __uint_as_float(v.x & 0xffff0000u); f[2] = __uint_as_float(v.y << 16); f[3] = __uint_as_float(v.y & 0xffff0000u);
        f[4] = __uint_as_float(v.z << 16); f[5] = __uint_as_float(v.z & 0xffff0000u); f[6] = __uint_as_float(v.w << 16); f[7] = __uint_as_float(v.w & 0xffff0000u);
        float s = 0.f;
#pragma unroll
        for (int q = 0; q < 8; ++q) s += f[q] * f[q];
        s += __shfl_xor(s, 8); s += __shfl_xor(s, 4); s += __shfl_xor(s, 2); s += __shfl_xor(s, 1);
        const float rs = 1.f / sqrtf(s * (1.f / 128.f) + 1e-6f);
        const f32x4 g0 = *(const GAS f32x4*)(g + l * 8), g1 = *(const GAS f32x4*)(g + l * 8 + 4);
        v4u o; o.x = pk2(f[0] * rs * g0.x, f[1] * rs * g0.y); o.y = pk2(f[2] * rs * g0.z, f[3] * rs * g0.w); o.z = pk2(f[4] * rs * g1.x, f[5] * rs * g1.y); o.w = pk2(f[6] * rs * g1.z, f[7] * rs * g1.w);
        *(GAS v4u*)p = o;
    }
}
__device__ __forceinline__ void s5_scan(int g, int half, const Args& a, int tid) {
    if (tid < 256) {
        const int bl = tid >> 6, n = tid & 63, b = half * 4 + bl;
        const float* LAM32 = (const float*)(a.ws + WS_LAM32) + g * 128; const float lr = LAM32[n * 2], li = LAM32[n * 2 + 1];
        const float* SL = (const float*)(a.ws + WS_SLOC) + ((size_t)(g * 512 + b * 64)) * 128; bf16* Ur = (bf16*)(a.ws + WS_U) + ((size_t)(g * 512 + b * 64)) * 640 + 512;
        float xr = 0.f, xi = 0.f;
        for (int ch = 0; ch < 64; ++ch) {
            Ur[(size_t)ch * 640 + n] = (bf16)f2bf(xr); Ur[(size_t)ch * 640 + 64 + n] = (bf16)f2bf(xi);
            const float sr = SL[(size_t)ch * 128 + n], si = SL[(size_t)ch * 128 + 64 + n];
            const float nr = lr * xr - li * xi + sr, ni = lr * xi + li * xr + si; xr = nr; xi = ni;
        }
    }
    VM_WAIT(); __syncthreads();
}
namespace nv {
typedef unsigned short bf16;
__device__ __forceinline__ unsigned f2bf(float f) { unsigned u = __float_as_uint(f); return (u + 0x7fffu + ((u >> 16) & 1u)) >> 16; }
__device__ __forceinline__ float bf2f(unsigned short b) { return __uint_as_float((unsigned)b << 16); }

__global__ void k_transpose(const float* __restrict__ W, const float* __restrict__ W2, const float* __restrict__ gain,
                            bf16* __restrict__ WT, int K, int N, int ND, int mode) {
    const size_t total = (size_t)ND * K;
    for (size_t i = (size_t)blockIdx.x * blockDim.x + threadIdx.x; i < total; i += (size_t)gridDim.x * blockDim.x) {
        const int d = (int)(i / K), k = (int)(i % K);
        float v;
        if (mode == 0) v = W[(size_t)k * N + d];
        else if (mode == 1) { if (d >= 1736 && d < 1792) v = 0.f; else { const int s = d >= 1792 ? d - 56 : d; v = W[(size_t)k * N + s]; } }
        else { const int tile = d >> 8, w = d & 255, f = tile * 128 + (w & 127); v = ((w < 128) ? W : W2)[(size_t)k * N + f] * gain[k]; }
        WT[i] = (bf16)f2bf(v);
    }
}
__global__ void k_wuv(const float* __restrict__ W, bf16* __restrict__ WT) {
    const int i = blockIdx.x * blockDim.x + threadIdx.x; if (i >= 8 * 64 * 128) return;
    const int h = i / (64 * 128), e = (i / 128) % 64, d = i % 128;
    WT[i] = (bf16)f2bf(W[(h * 128 + d) * 64 + e]);
}
__global__ void k_rmsnorm1024(const float* __restrict__ x, const float* __restrict__ g, bf16* __restrict__ out, int rows) {
    __shared__ float red[4];
    const int r = blockIdx.x; if (r >= rows) return;
    const float4 v = ((const float4*)(x + (size_t)r * 1024))[threadIdx.x];
    float s = v.x * v.x + v.y * v.y + v.z * v.z + v.w * v.w;
    for (int o = 32; o; o >>= 1) s += __shfl_xor(s, o);
    if ((threadIdx.x & 63) == 0) red[threadIdx.x >> 6] = s;
    __syncthreads();
    const float tot = red[0] + red[1] + red[2] + red[3];
    const float rs = rsqrtf(tot * (1.f / 1024.f) + 1e-6f);
    const float4 gg = ((const float4*)g)[threadIdx.x];
    bf16* o = out + (size_t)r * 1024 + threadIdx.x * 4;
    o[0] = (bf16)f2bf(v.x * rs * gg.x); o[1] = (bf16)f2bf(v.y * rs * gg.y); o[2] = (bf16)f2bf(v.z * rs * gg.z); o[3] = (bf16)f2bf(v.w * rs * gg.w);
}
__device__ __forceinline__ int t5_bucket(int n) {
    if (n < 16) return n;
    const float nf = (float)n;
    int large = 16 + (int)((logf(nf / 16.f) / 2.0794415416798357f) * 16.f);
    return large < 31 ? large : 31;
}
__global__ void k_biaslut(const float* __restrict__ rel_bias, float* __restrict__ BL) {
    const int i = blockIdx.x * blockDim.x + threadIdx.x;
    if (i < 8 * 128) { const int h = i / 128, d = i % 128; BL[i] = rel_bias[t5_bucket(d) * 8 + h] * 1.4426950408889634f; }
    else if (i < 8 * 128 + 8) { const int h = i - 8 * 128; BL[i] = rel_bias[31 * 8 + h] * 1.4426950408889634f; }
}

template <class Epi>
__global__ void __launch_bounds__(256) k_gemm(const bf16* __restrict__ A, const bf16* __restrict__ Bt, int M, int N, int K, Epi epi) {
    const int tx = threadIdx.x & 15, ty = threadIdx.x >> 4;
    const int n0 = (blockIdx.x * 16 + tx) * 4, m0 = (blockIdx.y * 16 + ty) * 4;
    if (n0 >= N || m0 >= M) return;
    float acc[4][4];
#pragma unroll
    for (int i = 0; i < 4; ++i)
#pragma unroll
        for (int j = 0; j < 4; ++j) acc[i][j] = 0.f;
    for (int k = 0; k < K; k += 8) {
        uint4 a[4], b[4];
#pragma unroll
        for (int i = 0; i < 4; ++i) { a[i] = *(const uint4*)(A + (size_t)(m0 + i) * K + k); b[i] = *(const uint4*)(Bt + (size_t)(n0 + i) * K + k); }
#pragma unroll
        for (int i = 0; i < 4; ++i) {
            const unsigned aw[4] = {a[i].x, a[i].y, a[i].z, a[i].w};
#pragma unroll
            for (int j = 0; j < 4; ++j) {
                const unsigned bw[4] = {b[j].x, b[j].y, b[j].z, b[j].w};
#pragma unroll
                for (int q = 0; q < 4; ++q) {
                    acc[i][j] += __uint_as_float(aw[q] << 16) * __uint_as_float(bw[q] << 16);
                    acc[i][j] += __uint_as_float(aw[q] & 0xffff0000u) * __uint_as_float(bw[q] & 0xffff0000u);
                }
            }
        }
    }
#pragma unroll
    for (int i = 0; i < 4; ++i)
#pragma unroll
        for (int j = 0; j < 4; ++j) epi(m0 + i, n0 + j, acc[i][j]);
}

struct EpiInproj {
    bf16 *QD, *CKV, *QI, *KI, *U, *QX; float* WI;
    __device__ void operator()(int t, int c, float v) const {
        if (c < 1024) QD[(size_t)t * 1024 + c] = (bf16)f2bf(v);
        else if (c < 1152) CKV[(size_t)t * 128 + (c - 1024)] = (bf16)f2bf(v);
        else if (c < 1664) QI[(size_t)t * 512 + (c - 1152)] = (bf16)f2bf(v);
        else if (c < 1728) KI[(size_t)t * 64 + (c - 1664)] = (bf16)f2bf(v);
        else if (c < 1792) { if (c < 1736) WI[(size_t)t * 8 + (c - 1728)] = v; }
        else if (c < 2304) { const int cu = c - 1792, g = cu >> 4, ci = cu & 15, b = t >> 11, tt = t & 2047, R = b * 64 + (tt >> 5), s = tt & 31;
            U[((size_t)(g * 512 + R)) * 640 + s * 16 + ci] = (bf16)f2bf(v); }
        else QX[(size_t)t * 512 + (c - 2304)] = (bf16)f2bf(v);
    }
};
struct EpiBf16Split { bf16* O0; bf16* O1; int split; int ld;
    __device__ void operator()(int m, int c, float v) const { if (c < split) O0[(size_t)m * ld + c] = (bf16)f2bf(v); else O1[(size_t)m * ld + (c - split)] = (bf16)f2bf(v); } };
struct EpiGlu { const bf16* Y; bf16* O;
    __device__ void operator()(int m, int c, float v) const { const float y = bf2f(Y[(size_t)m * 512 + c]); O[(size_t)m * 512 + c] = (bf16)f2bf(y / (1.f + __expf(-v))); } };
struct EpiSigmoid { bf16* G; __device__ void operator()(int m, int c, float v) const { G[(size_t)m * 1024 + c] = (bf16)f2bf(1.f / (1.f + __expf(-v))); } };
struct EpiMerge { const bf16* G; bf16* MG; int first; int pad;
    __device__ void operator()(int m, int c, float v) const { const size_t i = (size_t)m * 1024 + c; float p = first ? 0.f : bf2f(MG[i]); MG[i] = (bf16)f2bf(p + bf2f(G[i]) * v); } };
struct EpiOut { const float* x; float* x1; bf16* XN;
    __device__ void operator()(int m, int c, float v) const { const size_t i = (size_t)m * 1024 + c; const float r = x[i] + v; x1[i] = r; XN[i] = (bf16)f2bf(r); } };
struct EpiDown { float* out;
    __device__ void operator()(int m, int c, float v) const { const size_t i = (size_t)m * 1024 + c; out[i] = out[i] + v; } };
struct EpiF32 { float* C; int ld; __device__ void operator()(int m, int c, float v) const { C[(size_t)m * ld + c] = v; } };

__global__ void k_rowss(const float* __restrict__ x1, float* __restrict__ RS) {
    const int t = blockIdx.x, q = threadIdx.x >> 6, l = threadIdx.x & 63;
    const float4 v = ((const float4*)(x1 + (size_t)t * 1024 + q * 256))[l];
    float s = v.x * v.x + v.y * v.y + v.z * v.z + v.w * v.w;
    for (int o = 32; o; o >>= 1) s += __shfl_xor(s, o);
    if (l == 0) RS[t * 16 + q] = s;
    if (l >= 4 && l < 16 && q == 0) RS[t * 16 + l] = 0.f;
}
__global__ void __launch_bounds__(256) k_gemm_gu(const bf16* __restrict__ A, const bf16* __restrict__ Bt, const float* __restrict__ RS, bf16* __restrict__ ACT) {
    const int K = 1024;
    const int tx = threadIdx.x & 15, ty = threadIdx.x >> 4;
    const int f0 = (blockIdx.x * 16 + tx) * 4, m0 = (blockIdx.y * 16 + ty) * 4;
    float ag[4][4], au[4][4];
#pragma unroll
    for (int i = 0; i < 4; ++i)
#pragma unroll
        for (int j = 0; j < 4; ++j) { ag[i][j] = 0.f; au[i][j] = 0.f; }
    for (int k = 0; k < K; k += 8) {
        uint4 a[4], bg[4], bu[4];
#pragma unroll
        for (int i = 0; i < 4; ++i) { a[i] = *(const uint4*)(A + (size_t)(m0 + i) * K + k);
            const int f = f0 + i, rg = (f >> 7) * 256 + (f & 127);
            bg[i] = *(const uint4*)(Bt + (size_t)rg * K + k); bu[i] = *(const uint4*)(Bt + (size_t)(rg + 128) * K + k); }
#pragma unroll
        for (int i = 0; i < 4; ++i) {
            const unsigned aw[4] = {a[i].x, a[i].y, a[i].z, a[i].w};
#pragma unroll
            for (int j = 0; j < 4; ++j) {
                const unsigned gw[4] = {bg[j].x, bg[j].y, bg[j].z, bg[j].w};
                const unsigned uw[4] = {bu[j].x, bu[j].y, bu[j].z, bu[j].w};
#pragma unroll
                for (int q = 0; q < 4; ++q) {
                    const float alo = __uint_as_float(aw[q] << 16), ahi = __uint_as_float(aw[q] & 0xffff0000u);
                    ag[i][j] += alo * __uint_as_float(gw[q] << 16); ag[i][j] += ahi * __uint_as_float(gw[q] & 0xffff0000u);
                    au[i][j] += alo * __uint_as_float(uw[q] << 16); au[i][j] += ahi * __uint_as_float(uw[q] & 0xffff0000u);
                }
            }
        }
    }
#pragma unroll
    for (int i = 0; i < 4; ++i) { const int m = m0 + i;
        float tot = 0.f; for (int q = 0; q < 16; ++q) tot += RS[m * 16 + q];
        const float rs = rsqrtf(tot * (1.f / 1024.f) + 1e-6f);
#pragma unroll
        for (int j = 0; j < 4; ++j) { const float g = ag[i][j] * rs, u = au[i][j] * rs;
            ACT[(size_t)m * 2816 + f0 + j] = (bf16)f2bf(g / (1.f + __expf(-g)) * u); } }
}

__global__ void k_norm128(bf16* __restrict__ X, int rows, int ld, int ngroups, const float* __restrict__ g) {
    const int gid = (blockIdx.x * blockDim.x + threadIdx.x) >> 4, l = threadIdx.x & 15;
    const bool ok = gid < rows * ngroups;
    const int r = ok ? gid / ngroups : 0, gi = ok ? gid % ngroups : 0;
    bf16* p = X + (size_t)r * ld + gi * 128 + l * 8;
    uint4 v = *(const uint4*)p; const unsigned w[4] = {v.x, v.y, v.z, v.w};
    float f[8];
#pragma unroll
    for (int q = 0; q < 4; ++q) { f[2 * q] = __uint_as_float(w[q] << 16); f[2 * q + 1] = __uint_as_float(w[q] & 0xffff0000u); }
    float s = 0.f;
#pragma unroll
    for (int q = 0; q < 8; ++q) s += f[q] * f[q];
    for (int o = 8; o; o >>= 1) s += __shfl_xor(s, o);
    const float rs = rsqrtf(s * (1.f / 128.f) + 1e-6f);
    unsigned o4[4];
#pragma unroll
    for (int q = 0; q < 4; ++q) o4[q] = f2bf(f[2 * q] * rs * g[l * 8 + 2 * q]) | (f2bf(f[2 * q + 1] * rs * g[l * 8 + 2 * q + 1]) << 16);
    if (ok) *(uint4*)p = make_uint4(o4[0], o4[1], o4[2], o4[3]);
}

__global__ void __launch_bounds__(256) k_dsa(const bf16* __restrict__ QD, const bf16* __restrict__ CKV, const bf16* __restrict__ QI, const bf16* __restrict__ KI,
                                             const float* __restrict__ WI, const float* __restrict__ BL, const bf16* __restrict__ WUVT, bf16* __restrict__ ODSA) {
    __shared__ float sc[2048];
    __shared__ float qi[512];
    __shared__ float qd[1024];
    __shared__ float wh[8];
    __shared__ int sel[256];
    __shared__ float pr[256];
    __shared__ float ov[128];
    __shared__ float red[8];
    __shared__ int nsel;
    const int row = blockIdx.x, b = row >> 11, t = row & 2047, tid = threadIdx.x;
    for (int i = tid; i < 512; i += 256) qi[i] = bf2f(QI[(size_t)row * 512 + i]);
    for (int i = tid; i < 1024; i += 256) qd[i] = bf2f(QD[(size_t)row * 1024 + i]);
    if (tid < 8) wh[tid] = WI[(size_t)row * 8 + tid];
    if (tid == 0) nsel = 0;
    __syncthreads();
    const int nk = t + 1;
    for (int s = tid; s < nk; s += 256) {
        const bf16* kp = KI + ((size_t)(b * 2048 + s)) * 64;
        float kf[64];
#pragma unroll
        for (int d = 0; d < 64; ++d) kf[d] = bf2f(kp[d]);
        float score = 0.f;
        for (int h = 0; h < 8; ++h) { float dsum = 0.f;
#pragma unroll
            for (int d = 0; d < 64; ++d) dsum += qi[h * 64 + d] * kf[d];
            score += fmaxf(dsum, 0.f) * wh[h]; }
        sc[s] = score;
    }
    __syncthreads();
    for (int s = tid; s < nk; s += 256) {
        bool take;
        if (nk <= 256) take = true;
        else { const float v = sc[s]; int cnt = 0;
            for (int s2 = 0; s2 < nk; ++s2) { const float w = sc[s2]; cnt += (w > v || (w == v && s2 < s)) ? 1 : 0; }
            take = cnt < 256; }
        if (take) { const int p = atomicAdd(&nsel, 1); if (p < 256) sel[p] = s; }
    }
    __syncthreads();
    const int ns = nsel < 256 ? nsel : 256;
    const float scale = 0.08838834764831845f * 1.4426950408889634f;
    for (int h = 0; h < 8; ++h) {
        float lg = -INFINITY;
        if (tid < ns) { const int s = sel[tid]; const bf16* cp = CKV + ((size_t)(b * 2048 + s)) * 128; float dsum = 0.f;
            for (int d = 0; d < 128; ++d) dsum += qd[h * 128 + d] * bf2f(cp[d]);
            const int dist = t - s; const float bias = dist < 128 ? BL[h * 128 + dist] : BL[8 * 128 + h];
            lg = dsum * scale + bias; }
        float m = lg; for (int o = 32; o; o >>= 1) m = fmaxf(m, __shfl_xor(m, o));
        if ((tid & 63) == 0) red[tid >> 6] = m;
        __syncthreads();
        m = fmaxf(fmaxf(red[0], red[1]), fmaxf(red[2], red[3]));
        const float p = (tid < ns) ? exp2f(lg - m) : 0.f;
        float sum = p; for (int o = 32; o; o >>= 1) sum += __shfl_xor(sum, o);
        if ((tid & 63) == 0) red[4 + (tid >> 6)] = sum;
        pr[tid] = p;
        __syncthreads();
        sum = red[4] + red[5] + red[6] + red[7];
        if (tid < 128) { float o = 0.f; for (int k = 0; k < ns; ++k) o += pr[k] * bf2f(CKV[((size_t)(b * 2048 + sel[k])) * 128 + tid]); ov[tid] = o / sum; }
        __syncthreads();
        if (tid < 64) { float o = 0.f; const bf16* wp = WUVT + ((size_t)(h * 64 + tid)) * 128; for (int d = 0; d < 128; ++d) o += ov[d] * bf2f(wp[d]);
            ODSA[(size_t)row * 512 + h * 64 + tid] = (bf16)f2bf(o); }
        __syncthreads();
    }
}

__global__ void __launch_bounds__(256) k_cross(const bf16* __restrict__ QX, const bf16* __restrict__ KX, const bf16* __restrict__ VX, bf16* __restrict__ OX) {
    __shared__ float q[512]; __shared__ float pr[256]; __shared__ float red[8];
    const int row = blockIdx.x, b = row >> 11, tid = threadIdx.x;
    for (int i = tid; i < 512; i += 256) q[i] = bf2f(QX[(size_t)row * 512 + i]);
    __syncthreads();
    const float scale = 0.08838834764831845f * 1.4426950408889634f;
    for (int h = 0; h < 4; ++h) {
        const bf16* kp = KX + ((size_t)(b * 256 + tid)) * 512 + h * 128; float dsum = 0.f;
        for (int d = 0; d < 128; ++d) dsum += q[h * 128 + d] * bf2f(kp[d]);
        const float lg = dsum * scale;
        float m = lg; for (int o = 32; o; o >>= 1) m = fmaxf(m, __shfl_xor(m, o));
        if ((tid & 63) == 0) red[tid >> 6] = m;
        __syncthreads();
        m = fmaxf(fmaxf(red[0], red[1]), fmaxf(red[2], red[3]));
        const float p = exp2f(lg - m);
        float sum = p; for (int o = 32; o; o >>= 1) sum += __shfl_xor(sum, o);
        if ((tid & 63) == 0) red[4 + (tid >> 6)] = sum;
        pr[tid] = p;
        __syncthreads();
        sum = red[4] + red[5] + red[6] + red[7];
        if (tid < 128) { float o = 0.f; for (int k = 0; k < 256; ++k) o += pr[k] * bf2f(VX[((size_t)(b * 256 + k)) * 512 + h * 128 + tid]);
            OX[(size_t)row * 512 + h * 128 + tid] = (bf16)f2bf(o / sum); }
        __syncthreads();
    }
}

__device__ __forceinline__ float gelu_tanh(float x) { const float u = 0.7978845608028654f * (x + 0.044715f * x * x * x); return 0.5f * x * (1.f + tanhf(u)); }
__global__ void __launch_bounds__(64) k_s5(const bf16* __restrict__ U, const float* __restrict__ a_re, const float* __restrict__ a_im, const float* __restrict__ log_dt,
                                           const float* __restrict__ b_re, const float* __restrict__ b_im, const float* __restrict__ c_re, const float* __restrict__ c_im,
                                           const float* __restrict__ d_skip, bf16* __restrict__ Y) {
    const int b = blockIdx.x >> 5, g = blockIdx.x & 31, n = threadIdx.x;
    const double dt = exp((double)log_dt[g]);
    const double lr = (double)a_re[g * 64 + n], li = (double)a_im[g * 64 + n];
    const double mag = exp(lr * dt), lbr = mag * cos(li * dt), lbi = mag * sin(li * dt);
    const double nr = lbr - 1.0, ni = lbi, den = lr * lr + li * li;
    const double fr = (nr * lr + ni * li) / den, fi = (ni * lr - nr * li) / den;
    float Bre[16], Bim[16], Cre[16], Cim[16];
#pragma unroll
    for (int c = 0; c < 16; ++c) { const double br = b_re[(g * 64 + n) * 16 + c], bi = b_im[(g * 64 + n) * 16 + c];
        Bre[c] = (float)(fr * br - fi * bi); Bim[c] = (float)(fr * bi + fi * br);
        Cre[c] = c_re[(g * 16 + c) * 64 + n]; Cim[c] = c_im[(g * 16 + c) * 64 + n]; }
    const float ar = (float)lbr, ai = (float)lbi;
    const float dsk = n < 16 ? d_skip[g * 16 + n] : 0.f;
    float xr = 0.f, xi = 0.f;
    for (int t = 0; t < 2048; ++t) {
        const int R = b * 64 + (t >> 5), s = t & 31;
        const bf16* up = U + ((size_t)(g * 512 + R)) * 640 + s * 16;
        float u[16]; float bur = 0.f, bui = 0.f;
#pragma unroll
        for (int c = 0; c < 16; ++c) { u[c] = bf2f(up[c]); bur += Bre[c] * u[c]; bui += Bim[c] * u[c]; }
        const float nxr = ar * xr - ai * xi + bur, nxi = ar * xi + ai * xr + bui; xr = nxr; xi = nxi;
        float yout = 0.f;
#pragma unroll
        for (int c = 0; c < 16; ++c) { float v = Cre[c] * xr - Cim[c] * xi;
            for (int o = 32; o; o >>= 1) v += __shfl_xor(v, o);
            if (n == c) yout = v + dsk * u[c]; }
        if (n < 16) Y[(size_t)(b * 2048 + t) * 512 + g * 16 + n] = (bf16)f2bf(gelu_tanh(yout));
    }
}
}
#define HAVE_ATTN 1
#ifdef TPROBE
#if TPROBE < 8
#define TP_STAMP(k) { __builtin_amdgcn_sched_barrier(0); const unsigned long long t_ = __builtin_amdgcn_s_memtime(); tp_acc[k] += t_ - tp_prev; tp_prev = t_; __builtin_amdgcn_sched_barrier(0); }
#define TP_DECL unsigned long long tp_acc[8] = {0, 0, 0, 0, 0, 0, 0, 0}; unsigned long long tp_prev = __builtin_amdgcn_s_memtime();
#define TP_FLUSH(base) { if (blockIdx.x == TPROBE_BLOCK && wave == 0 && lane == 0) { unsigned long long* TP = (unsigned long long*)(a.ws + WS_CTL + 65536); for (int k_ = 0; k_ < 8; ++k_) TP[(base) + k_] += tp_acc[k_]; } }
#define TQ_STAMP(k)
#define TQ_DECL
#define TQ_FLUSH
#else
#define TP_STAMP(k)
#define TP_DECL
#define TP_FLUSH(base)
#define TQ_STAMP(k) { const unsigned t_ = (unsigned)__builtin_amdgcn_s_memtime(); tq_acc[k] += t_ - tq_prev; tq_prev = t_; }
#define TQ_DECL unsigned tq_acc[4] = {0, 0, 0, 0}; unsigned tq_prev = (unsigned)__builtin_amdgcn_s_memtime();
#define TQ_FLUSH { if (blockIdx.x == TPROBE_BLOCK && wave == 0 && lane == 0) { unsigned long long* TP = (unsigned long long*)(a.ws + WS_CTL + 65536); for (int k_ = 0; k_ < 4; ++k_) TP[8 + k_] += tq_acc[k_]; } }
#endif
#else
#define TP_STAMP(k)
#define TP_DECL
#define TP_FLUSH(base)
#define TQ_STAMP(k)
#define TQ_DECL
#define TQ_FLUSH
#endif
namespace att {
typedef float f32x16 __attribute__((ext_vector_type(16)));
typedef short s16x4 __attribute__((ext_vector_type(4)));
typedef short v4i16_t __attribute__((ext_vector_type(4)));
typedef float f32x2_t __attribute__((ext_vector_type(2))); typedef __bf16 bf16x2_t __attribute__((ext_vector_type(2)));
typedef unsigned u32x2 __attribute__((ext_vector_type(2)));
#define MFMA32(a, b, c) __builtin_amdgcn_mfma_f32_32x32x16_bf16((a), (b), (c), 0, 0, 0)
__device__ __forceinline__ unsigned cvtpk(float lo, float hi) { const f32x2_t v = {lo, hi}; const bf16x2_t b = __builtin_convertvector(v, bf16x2_t); return __builtin_bit_cast(unsigned, b); }
__device__ __forceinline__ int crow(int r, int hi) { return (r & 3) + 8 * (r >> 2) + 4 * hi; }
__device__ __forceinline__ unsigned off_b(unsigned row, unsigned ch) { return 256u * row + 16u * (ch ^ (((row & 3u) << 2) | ((row >> 2) & 3u))); }
__device__ __forceinline__ float xh_max(float v) { const auto rr = __builtin_amdgcn_permlane32_swap(__float_as_uint(v), __float_as_uint(v), false, false); return fmaxf(__uint_as_float(rr[0]), __uint_as_float(rr[1])); }
__device__ __forceinline__ float xh_sum(float v) { const auto rr = __builtin_amdgcn_permlane32_swap(__float_as_uint(v), __float_as_uint(v), false, false); return __uint_as_float(rr[0]) + __uint_as_float(rr[1]); }
__device__ __forceinline__ unsigned xh_sumu(unsigned v) { const auto rr = __builtin_amdgcn_permlane32_swap(v, v, false, false); return rr[0] + rr[1]; }
__device__ __forceinline__ unsigned xh_or(unsigned v) { const auto rr = __builtin_amdgcn_permlane32_swap(v, v, false, false); return rr[0] | rr[1]; }
constexpr float SCALE2 = 0.08838834764831845f * 1.4426950408889634f;

__device__ __forceinline__ bf16x8 pack_step(const f32x16& x, int s) {
    v4u p; p.x = cvtpk(x[8 * s], x[8 * s + 1]); p.y = cvtpk(x[8 * s + 2], x[8 * s + 3]); p.z = cvtpk(x[8 * s + 4], x[8 * s + 5]); p.w = cvtpk(x[8 * s + 6], x[8 * s + 7]);
    return __builtin_bit_cast(bf16x8, p);
}
__device__ __forceinline__ void qk_tile(f32x16& p0, f32x16& p1, LAS const unsigned char* kimg, const bf16x8 (&qf)[8], int lane) {
    const unsigned r32 = lane & 31, hi = lane >> 5;
    f32x16 z;
#pragma unroll
    for (int r = 0; r < 16; ++r) z[r] = 0.f;
    p0 = z; p1 = z;
    bf16x8 fa[2][4];
#define QK_LOAD(g, buf) { const unsigned o0_ = off_b(r32, 4 * (g) + hi), o1_ = off_b(r32, 4 * (g) + 2 + hi); \
        fa[buf][0] = *(LAS const bf16x8*)(kimg + o0_); fa[buf][1] = *(LAS const bf16x8*)(kimg + o0_ + 32 * 256); fa[buf][2] = *(LAS const bf16x8*)(kimg + o1_); fa[buf][3] = *(LAS const bf16x8*)(kimg + o1_ + 32 * 256); }
#define QK_MMA(g, buf) { p0 = MFMA32(fa[buf][0], qf[2 * (g)], p0); p1 = MFMA32(fa[buf][1], qf[2 * (g)], p1); p0 = MFMA32(fa[buf][2], qf[2 * (g) + 1], p0); p1 = MFMA32(fa[buf][3], qf[2 * (g) + 1], p1); }
    QK_LOAD(0, 0) QK_LOAD(1, 1) QK_MMA(0, 0) asm volatile("" ::: "memory");
    QK_LOAD(2, 0) QK_MMA(1, 1) asm volatile("" ::: "memory");
    QK_LOAD(3, 1) QK_MMA(2, 0) QK_MMA(3, 1)
#undef QK_LOAD
#undef QK_MMA
}
__device__ __forceinline__ s16x4 vtr(LAS const unsigned char* p) { return __builtin_bit_cast(s16x4, __builtin_amdgcn_ds_read_tr16_b64_v4i16((LAS v4i16_t*)p)); }
__device__ __forceinline__ void pv_tile(f32x16 (&o)[4], LAS const unsigned char* vimg, const bf16x8 (&pf)[4], int lane) {
    const unsigned hi = lane >> 5, blk = (lane >> 4) & 1, q = (lane & 15) >> 2, p = lane & 3;
    s16x4 fl[2][4], fh[2][4];
#define PV_LOAD(c, buf) { _Pragma("unroll") for (int ks = 0; ks < 4; ++ks) { const unsigned ch = 4 * (c) + 2 * blk + (p >> 1), rlo = 16 * ks + 4 * hi + q; \
        fl[buf][ks] = vtr(vimg + off_b(rlo, ch) + 8 * (p & 1)); fh[buf][ks] = vtr(vimg + off_b(rlo + 8, ch) + 8 * (p & 1)); } }
#define PV_MMA(c, buf) { _Pragma("unroll") for (int ks = 0; ks < 4; ++ks) { const bf16x8 af = {fl[buf][ks][0], fl[buf][ks][1], fl[buf][ks][2], fl[buf][ks][3], fh[buf][ks][0], fh[buf][ks][1], fh[buf][ks][2], fh[buf][ks][3]}; \
        o[c] = MFMA32(af, pf[ks], o[c]); } }
    PV_LOAD(0, 0) PV_LOAD(1, 1) PV_MMA(0, 0) asm volatile("" ::: "memory");
    PV_LOAD(2, 0) PV_MMA(1, 1) asm volatile("" ::: "memory");
    PV_LOAD(3, 1) PV_MMA(2, 0) PV_MMA(3, 1)
#undef PV_LOAD
#undef PV_MMA
}
template <bool FIXED> __device__ __forceinline__ void softmax_step(f32x16& p0, f32x16& p1, float& m, float& l, f32x16 (&o)[4], bf16x8 (&pf)[4]) {
    if constexpr (FIXED) {
        f32x2_t s2 = {0.f, 0.f};
#pragma unroll
        for (int r = 0; r < 16; ++r) { p0[r] = __builtin_amdgcn_exp2f(p0[r]); p1[r] = __builtin_amdgcn_exp2f(p1[r]); const f32x2_t t = {p0[r], p1[r]}; s2 += t; }
        l += s2[0] + s2[1];
    } else {
        float mx = fmaxf(p0[0], p1[0]);
#pragma unroll
        for (int r = 1; r < 16; ++r) mx = fmaxf(mx, fmaxf(p0[r], p1[r]));
        mx = xh_max(mx);
        const float mnew = fmaxf(m, mx), muse = (mnew == -INFINITY) ? 0.f : mnew;
        const float alpha = __builtin_amdgcn_exp2f(m - muse);
        float s = 0.f;
#pragma unroll
        for (int r = 0; r < 16; ++r) { p0[r] = __builtin_amdgcn_exp2f(p0[r] - muse); p1[r] = __builtin_amdgcn_exp2f(p1[r] - muse); s += p0[r] + p1[r]; }
        l = l * alpha + s; m = mnew;
        if (__any(alpha != 1.f)) {
#pragma unroll
            for (int c = 0; c < 4; ++c)
#pragma unroll
                for (int r = 0; r < 16; ++r) o[c][r] *= alpha;
        }
    }
    pf[0] = pack_step(p0, 0); pf[1] = pack_step(p0, 1); pf[2] = pack_step(p1, 0); pf[3] = pack_step(p1, 1);
}
__device__ __forceinline__ void tile_load(v4u (&rg)[2], const bf16* src, int pitch, int tid) {
#pragma unroll
    for (int i = 0; i < 2; ++i) { const int id = tid + 512 * i, row = id >> 4, ch = id & 15; rg[i] = *(const GAS v4u*)(src + (size_t)row * pitch + ch * 8); }
}
__device__ __forceinline__ void tile_store(const v4u (&rg)[2], LAS unsigned char* img, int tid) {
#pragma unroll
    for (int i = 0; i < 2; ++i) { const int id = tid + 512 * i, row = id >> 4, ch = id & 15; *(LAS v4u*)(img + off_b(row, ch)) = rg[i]; }
}

__device__ __forceinline__ void cross_item(const Args& a, LAS unsigned char* lds, int tid, int lane, int wave, int item) {
    const int r32 = lane & 31, hi = lane >> 5;
    const int b = item >> 5, hx = (item >> 3) & 3, qblk = item & 7;
    const bf16* QX = (const bf16*)(a.ws + WS_QX); const bf16* KX = (const bf16*)(a.ws + WS_KX) + (size_t)b * 256 * 512 + hx * 128; const bf16* VX = (const bf16*)(a.ws + WS_VX) + (size_t)b * 256 * 512 + hx * 128;
    bf16* OX = (bf16*)(a.ws + WS_OX);
    const size_t row = (size_t)b * 2048 + qblk * 256 + wave * 32 + r32;
    bf16x8 qf[8];
#pragma unroll
    for (int s = 0; s < 8; ++s) qf[s] = *(const GAS bf16x8*)(QX + row * 512 + hx * 128 + 16 * s + 8 * hi);
    f32x16 o[4];
#pragma unroll
    for (int c = 0; c < 4; ++c)
#pragma unroll
        for (int r = 0; r < 16; ++r) o[c][r] = 0.f;
    float m = -INFINITY, l = 0.f;
    v4u kr[2], vr[2];
    tile_load(kr, KX, 512, tid); tile_load(vr, VX, 512, tid);
    tile_store(kr, lds, tid); tile_store(vr, lds + 32768, tid);
    __syncthreads();
#pragma unroll 1
    for (int kt = 0; kt < 4; ++kt) {
        LAS unsigned char* kimg = lds + (kt & 1) * 16384; LAS unsigned char* vimg = lds + 32768 + (kt & 1) * 16384;
        if (kt + 1 < 4) { tile_load(kr, KX + (size_t)(kt + 1) * 64 * 512, 512, tid); tile_load(vr, VX + (size_t)(kt + 1) * 64 * 512, 512, tid); }
        f32x16 p0, p1; qk_tile(p0, p1, kimg, qf, lane);
#pragma unroll
        for (int r = 0; r < 16; ++r) { p0[r] *= SCALE2; p1[r] *= SCALE2; }
        bf16x8 pf[4]; softmax_step<false>(p0, p1, m, l, o, pf);
        pv_tile(o, vimg, pf, lane);
        if (kt + 1 < 4) { tile_store(kr, lds + ((kt + 1) & 1) * 16384, tid); tile_store(vr, lds + 32768 + ((kt + 1) & 1) * 16384, tid); }
        __syncthreads();
    }
    l = xh_sum(l);
    const float inv = 1.f / l;
#pragma unroll
    for (int c = 0; c < 4; ++c)
#pragma unroll
        for (int g4 = 0; g4 < 4; ++g4) { u32x2 w; w.x = cvtpk(o[c][4 * g4] * inv, o[c][4 * g4 + 1] * inv); w.y = cvtpk(o[c][4 * g4 + 2] * inv, o[c][4 * g4 + 3] * inv);
            *(GAS u32x2*)(OX + row * 512 + hx * 128 + 32 * c + 8 * g4 + 4 * hi) = w; }
}
__device__ __forceinline__ void cross_phase(const Args& a, LAS unsigned char* lds, int tid, int lane, int wave, int bx, int G) {
    if (bx < 128) return;
#pragma unroll 1
    for (int i = 0; i < 2; ++i) cross_item(a, lds, tid, lane, wave, (bx - 128) * 2 + i);
}

constexpr int DSA_QI = 0, DSA_QPITCH = 1040, DSA_KTB = 33792, DSA_CT = DSA_KTB, DSA_MASK = DSA_KTB + 2 * 32 * 257 * 4, DSA_BT = DSA_MASK + 32 * 65 * 4, DSA_END = DSA_BT + 8 * 320 * 4;
static_assert(DSA_END <= RING_BYTES, "DSA LDS map");
__device__ __forceinline__ unsigned f2key(float x) { const unsigned b = __float_as_uint(x + 0.f); return (b & 0x80000000u) ? ~b : (b | 0x80000000u); }

__device__ __forceinline__ void cnt_ge(unsigned& cnt, unsigned key, unsigned cand) { asm volatile("v_cmp_ge_u32 vcc, %1, %2\n\tv_addc_co_u32_e32 %0, vcc, 0, %0, vcc" : "+v"(cnt) : "v"(key), "v"(cand) : "vcc"); }
__device__ __forceinline__ void cnt_gt(unsigned& cnt, unsigned key, unsigned cand) { asm volatile("v_cmp_gt_u32 vcc, %1, %2\n\tv_addc_co_u32_e32 %0, vcc, 0, %0, vcc" : "+v"(cnt) : "v"(key), "v"(cand) : "vcc"); }
__device__ __forceinline__ void cnt_eq(unsigned& cnt, unsigned key, unsigned cand) { asm volatile("v_cmp_eq_u32 vcc, %1, %2\n\tv_addc_co_u32_e32 %0, vcc, 0, %0, vcc" : "+v"(cnt) : "v"(key), "v"(cand) : "vcc"); }
__device__ __forceinline__ void cnt4_ge(unsigned& c0, unsigned& c1, unsigned& c2, unsigned& c3, unsigned k0, unsigned k1, unsigned k2, unsigned k3, unsigned cand) {
    unsigned long long m0, m1, m2;
    asm volatile("v_cmp_ge_u32 %4, %7, %11\n\tv_cmp_ge_u32 %5, %8, %11\n\tv_cmp_ge_u32 %6, %9, %11\n\tv_cmp_ge_u32 vcc, %10, %11\n\t"
                 "v_addc_co_u32_e64 %0, %4, 0, %0, %4\n\tv_addc_co_u32_e64 %1, %5, 0, %1, %5\n\tv_addc_co_u32_e64 %2, %6, 0, %2, %6\n\tv_addc_co_u32_e32 %3, vcc, 0, %3, vcc"
                 : "+v"(c0), "+v"(c1), "+v"(c2), "+v"(c3), "=&s"(m0), "=&s"(m1), "=&s"(m2) : "v"(k0), "v"(k1), "v"(k2), "v"(k3), "v"(cand) : "vcc");
}
template <int IB> __device__ __forceinline__ void cnt_tie_lt(unsigned& cnt, unsigned key, unsigned thr, unsigned lanepart, unsigned cand) { unsigned t;
    asm volatile("v_add_u32_e32 %1, %6, %4\n\tv_cmp_eq_u32 vcc, %2, %3\n\tv_cndmask_b32_e32 %1, -1, %1, vcc\n\tv_cmp_lt_u32 vcc, %1, %5\n\tv_addc_co_u32_e32 %0, vcc, 0, %0, vcc"
                 : "+v"(cnt), "=&v"(t) : "v"(key), "v"(thr), "v"(lanepart), "v"(cand), "i"(IB) : "vcc"); }
template <int IB, int BR> __device__ __forceinline__ void mask_sel(unsigned& w, unsigned key, unsigned thr, unsigned lanepart, unsigned istar, unsigned onehi) { unsigned t, bit;
    asm volatile("v_lshlrev_b32_e32 %2, %8, %7\n\tv_cmp_gt_u32 vcc, %3, %4\n\tv_cndmask_b32_e32 %1, 0, %2, vcc\n\tv_or_b32_e32 %0, %0, %1\n\t"
                 "v_add_u32_e32 %1, %9, %5\n\tv_cmp_le_u32 vcc, %1, %6\n\tv_cndmask_b32_e32 %1, 0, %2, vcc\n\tv_cmp_eq_u32 vcc, %3, %4\n\tv_cndmask_b32_e32 %1, 0, %1, vcc\n\tv_or_b32_e32 %0, %0, %1"
                 : "+v"(w), "=&v"(t), "=&v"(bit) : "v"(key), "v"(thr), "v"(lanepart), "v"(istar), "v"(onehi), "i"(BR), "i"(IB) : "vcc"); }

#define CRB(r) (((r) & 3) + 8 * ((r) >> 2))
#define TIE1(i, r) cnt_tie_lt<256 * (i) + CRB(r)>(cnt, key[i][r], thr, lanepart, cand);
#define TIE_ROW(i) TIE1(i,0) TIE1(i,1) TIE1(i,2) TIE1(i,3) TIE1(i,4) TIE1(i,5) TIE1(i,6) TIE1(i,7) TIE1(i,8) TIE1(i,9) TIE1(i,10) TIE1(i,11) TIE1(i,12) TIE1(i,13) TIE1(i,14) TIE1(i,15)
#define SEL1(i, r) mask_sel<256 * (i) + CRB(r), CRB(r)>(w, key[i][r], thr, lanepart, istar, onehi);
#define SEL_ROW(i) SEL1(i,0) SEL1(i,1) SEL1(i,2) SEL1(i,3) SEL1(i,4) SEL1(i,5) SEL1(i,6) SEL1(i,7) SEL1(i,8) SEL1(i,9) SEL1(i,10) SEL1(i,11) SEL1(i,12) SEL1(i,13) SEL1(i,14) SEL1(i,15)
__device__ __forceinline__ unsigned row_total(unsigned cnt, LAS unsigned* CNT, int& par, int r32, int hi, int wave) {
    cnt = xh_sumu(cnt);
    if (hi == 0) CNT[par * 256 + r32 * 8 + wave] = cnt;
    __syncthreads();
    const v4u x = *(LAS const v4u*)(CNT + par * 256 + r32 * 8), y = *(LAS const v4u*)(CNT + par * 256 + r32 * 8 + 4);
    par ^= 1;
    return (x.x + x.y) + (x.z + x.w) + (y.x + y.y) + (y.z + y.w);
}
template <bool FIXED> __device__ __forceinline__ void dsa_attn(const Args& a, LAS unsigned char* lds, int tid, int lane, int wave, int b, int qb, bool sel) {
    const int r32 = lane & 31, hi = lane >> 5;
    const int t0 = qb * 32; const size_t rowb = (size_t)b * 2048;
    const bf16* QD = (const bf16*)(a.ws + WS_QD); const bf16* CKV = (const bf16*)(a.ws + WS_CKV) + rowb * 128;
    const float* BL = (const float*)(a.ws + WS_BIASL); const bf16* WUV = (const bf16*)(a.ws + WS_WUV); bf16* ODSA = (bf16*)(a.ws + WS_ODSA);
    LAS unsigned* MASK = (LAS unsigned*)(lds + DSA_MASK);
    const int h = wave; const int tq = t0 + r32; const size_t qrow = rowb + t0 + r32;
    bf16x8 qf[8];
#pragma unroll
    for (int s = 0; s < 8; ++s) qf[s] = *(const GAS bf16x8*)(QD + qrow * 1024 + h * 128 + 16 * s + 8 * hi);
    const float c31 = BL[1024 + h] - BL[1032];
    f32x16 o[4];
#pragma unroll
    for (int c = 0; c < 4; ++c)
#pragma unroll
        for (int r = 0; r < 16; ++r) o[c][r] = 0.f;
    float m = -INFINITY, l = 0.f;
    const int NKT = (t0 + 32 + 63) >> 6;
    TP_DECL
    v4u cr[2];
    tile_load(cr, CKV, 128, tid); tile_store(cr, lds + DSA_CT, tid);
    __syncthreads();
#pragma unroll 1
    for (int kt = 0; kt < NKT; ++kt) {
        LAS unsigned char* cimg = lds + DSA_CT + (kt & 1) * 16384;
        if (kt + 1 < NKT) tile_load(cr, CKV + (size_t)(kt + 1) * 64 * 128, 128, tid);
        TP_STAMP(0)
        f32x16 p0, p1; qk_tile(p0, p1, cimg, qf, lane);
        TP_STAMP(1)
        const int k0 = 64 * kt;
        const bool far = (t0 - k0 - 63) >= 128;
        unsigned mv0, mv1;
        if (sel) { mv0 = MASK[r32 * 65 + 2 * kt] >> (4 * hi); mv1 = MASK[r32 * 65 + 2 * kt + 1] >> (4 * hi); }
        else { const int d0 = tq - k0 - 4 * hi, d1 = d0 - 32;
            mv0 = d0 < 0 ? 0u : (d0 >= 31 ? 0x0f0f0f0fu : (0x0f0f0f0fu & ((2u << d0) - 1u)));
            mv1 = d1 < 0 ? 0u : (d1 >= 31 ? 0x0f0f0f0fu : (0x0f0f0f0fu & ((2u << d1) - 1u))); }
        if (far) {
#pragma unroll
            for (int r = 0; r < 16; ++r) { p0[r] = ((mv0 >> CRB(r)) & 1u) ? p0[r] * SCALE2 + c31 : -INFINITY; p1[r] = ((mv1 >> CRB(r)) & 1u) ? p1[r] * SCALE2 + c31 : -INFINITY; }
        } else {
            LAS const float* bt = (LAS const float*)(lds + DSA_BT) + h * 320 + (255 - (tq - k0 - 4 * hi));
#pragma unroll
            for (int r = 0; r < 16; ++r) { const float b0 = bt[CRB(r)], b1 = bt[32 + CRB(r)];
                p0[r] = ((mv0 >> CRB(r)) & 1u) ? p0[r] * SCALE2 + b0 : -INFINITY; p1[r] = ((mv1 >> CRB(r)) & 1u) ? p1[r] * SCALE2 + b1 : -INFINITY; }
        }
        bf16x8 pf[4];
        softmax_step<FIXED>(p0, p1, m, l, o, pf);
        TP_STAMP(2)
        pv_tile(o, cimg, pf, lane);
        TP_STAMP(3)
        if (kt + 1 < NKT) tile_store(cr, lds + DSA_CT + ((kt + 1) & 1) * 16384, tid);
        __syncthreads();
        TP_STAMP(4)
    }
    l = xh_sum(l);
    const float inv = 1.f / l;
    bf16x8 of[8];
#pragma unroll
    for (int c = 0; c < 4; ++c) {
#pragma unroll
        for (int r = 0; r < 16; ++r) o[c][r] *= inv;
        of[2 * c] = pack_step(o[c], 0); of[2 * c + 1] = pack_step(o[c], 1);
    }
    { s16x4 wl[2][8], wh[2][8];
#pragma unroll
      for (int eb = 0; eb < 2; ++eb) { const bf16* wf = WUV + (size_t)((h * 2 + eb) * 8) * 512 + lane * 4;
#pragma unroll
        for (int cs = 0; cs < 8; ++cs) { wl[eb][cs] = *(const GAS s16x4*)(wf + cs * 512); wh[eb][cs] = *(const GAS s16x4*)(wf + cs * 512 + 256); } }
      asm volatile("" ::: "memory");
#pragma unroll
      for (int eb = 0; eb < 2; ++eb) {
        f32x16 acc;
#pragma unroll
        for (int r = 0; r < 16; ++r) acc[r] = 0.f;
#pragma unroll
        for (int cs = 0; cs < 8; ++cs) {
            const bf16x8 af = {wl[eb][cs][0], wl[eb][cs][1], wl[eb][cs][2], wl[eb][cs][3], wh[eb][cs][0], wh[eb][cs][1], wh[eb][cs][2], wh[eb][cs][3]};
            acc = MFMA32(af, of[cs], acc);
        }
#pragma unroll
        for (int g4 = 0; g4 < 4; ++g4) { u32x2 w; w.x = cvtpk(acc[4 * g4], acc[4 * g4 + 1]); w.y = cvtpk(acc[4 * g4 + 2], acc[4 * g4 + 3]);
            *(GAS u32x2*)(ODSA + qrow * 512 + h * 64 + 32 * eb + 8 * g4 + 4 * hi) = w; }
      } }
    TP_STAMP(5)
    TP_FLUSH(0)
}
template <int MODE> __device__ __forceinline__ void dsa_item(const Args& a, LAS unsigned char* lds, int tid, int lane, int wave, int b, int qb) {
    const int r32 = lane & 31, hi = lane >> 5;
    const int t0 = qb * 32; const size_t rowb = (size_t)b * 2048;
    const bool sel = qb >= 8;
    const bf16* QD = (const bf16*)(a.ws + WS_QD); const bf16* CKV = (const bf16*)(a.ws + WS_CKV) + rowb * 128; const bf16* QI = (const bf16*)(a.ws + WS_QI); const bf16* KI = (const bf16*)(a.ws + WS_KI) + rowb * 64;
    const float* WI = (const float*)(a.ws + WS_WI); const float* BL = (const float*)(a.ws + WS_BIASL); const bf16* WUV = (const bf16*)(a.ws + WS_WUV); bf16* ODSA = (bf16*)(a.ws + WS_ODSA);
    LAS unsigned* MASK = (LAS unsigned*)(lds + DSA_MASK);
    const int NT = qb + 1;
    TQ_DECL
    if (MODE != 1 && sel) {
#pragma unroll
        for (int i = 0; i < 4; ++i) { const int id = tid + 512 * i, row = id >> 6, ch = id & 63;
            *(LAS v4u*)(lds + DSA_QI + row * DSA_QPITCH + ch * 16) = *(const GAS v4u*)(QI + (rowb + t0 + row) * 512 + ch * 8); }
        __syncthreads();
        float wq[8];
        { const f32x4 w0 = *(const GAS f32x4*)(WI + (rowb + t0 + r32) * 8), w1 = *(const GAS f32x4*)(WI + (rowb + t0 + r32) * 8 + 4);
          wq[0] = w0.x; wq[1] = w0.y; wq[2] = w0.z; wq[3] = w0.w; wq[4] = w1.x; wq[5] = w1.y; wq[6] = w1.z; wq[7] = w1.w; }
        unsigned kw[4][32];
        LAS unsigned* KTB = (LAS unsigned*)(lds + DSA_KTB);
        LAS const unsigned char* qbase = lds + DSA_QI + r32 * DSA_QPITCH + hi * 16;
        const bf16* kbase = KI + (size_t)r32 * 64 + 8 * hi;
        bf16x8 kf[4]; const bf16* kptr = kbase + (size_t)wave * 2048;
        if (wave < NT) {
#pragma unroll
            for (int kk = 0; kk < 4; ++kk) kf[kk] = *(const GAS bf16x8*)(kptr + 16 * kk);
        }
        kptr += 8 * 2048;
#define SC_HEAD(hh, dst) { _Pragma("unroll") for (int r = 0; r < 16; ++r) dst[r] = 0.f; \
            _Pragma("unroll") for (int kk = 0; kk < 4; ++kk) { const bf16x8 qf = *(LAS const bf16x8*)(qbase + ((hh) * 8 + 2 * kk) * 16); dst = MFMA32(kf[kk], qf, dst); } }
#define SC_ACC(hh, src) { const f32x2_t w2_ = {wq[hh], wq[hh]}; \
            _Pragma("unroll") for (int r = 0; r < 16; r += 2) { const f32x2_t t_ = {__builtin_amdgcn_fmed3f(src[r], 0.f, INFINITY), __builtin_amdgcn_fmed3f(src[r + 1], 0.f, INFINITY)}; \
                f32x2_t s_ = {sacc[r], sacc[r + 1]}; s_ = __builtin_elementwise_fma(t_, w2_, s_); sacc[r] = s_[0]; sacc[r + 1] = s_[1]; } \
            _Pragma("unroll") for (int r = 0; r < 16; ++r) asm volatile("" : "+v"(sacc[r])); }
#define SC_TILE(i) { const int j = wave + 8 * (i); \
            if (8 * (i) < NT) {                                            \
                LAS unsigned* kt_ = KTB + ((i) & 1) * (32 * 257); \
                if (j < NT) { \
                    f32x16 sacc, da, db; \
                    _Pragma("unroll") for (int r = 0; r < 16; ++r) sacc[r] = 0.f; \
                    SC_HEAD(0, da) SC_HEAD(1, db) SC_ACC(0, da) SC_HEAD(2, da) SC_ACC(1, db) SC_HEAD(3, db) SC_ACC(2, da) SC_HEAD(4, da) SC_ACC(3, db) \
                    SC_HEAD(5, db) SC_ACC(4, da) SC_HEAD(6, da) SC_ACC(5, db) SC_HEAD(7, db) \
                    asm volatile("" ::: "memory"); \
                    if (j + 8 < NT) { _Pragma("unroll") for (int kk = 0; kk < 4; ++kk) kf[kk] = *(const GAS bf16x8*)(kptr + 16 * kk); kptr += 8 * 2048; }     \
                    SC_ACC(6, da) SC_ACC(7, db) \
                    _Pragma("unroll") for (int r = 0; r < 16; ++r) { const bool vis = (j < NT - 1) || (crow(r, hi) <= r32); kt_[r32 * 257 + 32 * wave + crow(r, hi)] = vis ? f2key(sacc[r]) : 0u; } \
                } else { _Pragma("unroll") for (int r = 0; r < 16; ++r) kt_[r32 * 257 + 32 * wave + crow(r, hi)] = 0u; } \
                __syncthreads(); \
                _Pragma("unroll") for (int rho = 0; rho < 4; ++rho) _Pragma("unroll") for (int k = 0; k < 4; ++k) kw[rho][4 * (i) + k] = kt_[(4 * wave + rho) * 257 + 64 * k + lane]; \
            } else { _Pragma("unroll") for (int rho = 0; rho < 4; ++rho) _Pragma("unroll") for (int k = 0; k < 4; ++k) kw[rho][4 * (i) + k] = 0u; } }
        SC_TILE(0) SC_TILE(1) SC_TILE(2) SC_TILE(3) SC_TILE(4) SC_TILE(5) SC_TILE(6) SC_TILE(7)
#undef SC_TILE
#undef SC_ACC
#undef SC_HEAD
        TQ_STAMP(0)
        unsigned thr[4] = {0u, 0u, 0u, 0u}; bool fnd[4] = {false, false, false, false};
        if constexpr (MODE != 3) {
#pragma unroll 1
            for (int bit = 31; bit >= 0; --bit) {
#pragma unroll
                for (int rho = 0; rho < 4; ++rho) if (!fnd[rho]) {
                    const unsigned cand = (unsigned)__builtin_amdgcn_readfirstlane((int)(thr[rho] | (1u << bit))); unsigned cnt = 0u;
#pragma unroll
                    for (int e = 0; e < 32; ++e) cnt += (unsigned)__builtin_popcountll(__ballot(kw[rho][e] >= cand));
                    if (cnt >= 256u) thr[rho] = cand;
                    fnd[rho] = cnt == 256u;
                }
                if (fnd[0] && fnd[1] && fnd[2] && fnd[3]) break;
            }
        }
#pragma unroll
        for (int rho = 0; rho < 4; ++rho) {
            const unsigned th = (unsigned)__builtin_amdgcn_readfirstlane((int)thr[rho]); unsigned gtot = 0u;
#pragma unroll
            for (int e = 0; e < 32; ++e) gtot += (unsigned)__builtin_popcountll(__ballot(kw[rho][e] > th));
            unsigned rem = 256u - gtot;
#pragma unroll
            for (int e = 0; e < 32; ++e) {
                const unsigned long long g = __ballot(kw[rho][e] > th); unsigned long long q = __ballot(kw[rho][e] == th);
                unsigned c = (unsigned)__builtin_popcountll(q);
                if (c > rem) { while ((unsigned)__builtin_popcountll(q) > rem) q &= ~(1ull << (63 - __builtin_clzll(q))); c = rem; }
                rem -= c;
                const unsigned long long s = g | q;
                if (lane == 0) { MASK[(4 * wave + rho) * 65 + 8 * (e >> 2) + 2 * (e & 3)] = (unsigned)s; MASK[(4 * wave + rho) * 65 + 8 * (e >> 2) + 2 * (e & 3) + 1] = (unsigned)(s >> 32); }
            }
        }
        __syncthreads();
        TQ_STAMP(1)
    }
    if constexpr (MODE == 0 || MODE == 1) {
        const float Mb = ((const float*)(a.ws + WS_BIASL))[1032];
        if (Mb != 0.f) dsa_attn<true>(a, lds, tid, lane, wave, b, qb, sel); else dsa_attn<false>(a, lds, tid, lane, wave, b, qb, sel);
    }
    TQ_STAMP(2)
    TQ_FLUSH
    __syncthreads();
}
template <int MODE = 0> __device__ __forceinline__ void dsa_phase(const Args& a, LAS unsigned char* lds, int wave, int bx, int G) {
    const int b = bx >> 5, p = bx & 31;
    { const float* BL = (const float*)(a.ws + WS_BIASL); LAS float* BT = (LAS float*)(lds + DSA_BT);
      for (int i = wave * 64 + my_lane_id(); i < 8 * 320; i += NTHR) { const int hh = i / 320, d = 255 - (i % 320); BT[i] = (d < 0 ? 0.f : (d < 128 ? BL[hh * 128 + d] : BL[1024 + hh])) - BL[1032]; } }
    __syncthreads();
#pragma unroll 1
    for (int it = 0; it < 2; ++it) {
        const int lane = my_lane_id();
        dsa_item<MODE>(a, lds, wave * 64 + lane, lane, wave, b, it == 0 ? 63 - p : p);
    }
}
}
#define HAVE_DSA 1
using att::cross_phase;
__device__ __forceinline__ void dsa_phase(const Args& a, LAS unsigned char* lds, int wave, int bx, int G) { att::dsa_phase<0>(a, lds, wave, bx, G); }
__global__ void __launch_bounds__(NTHR, 2) mk_fwd(Args args) {
    extern __shared__ __attribute__((aligned(16))) unsigned char lds_raw[];
    LAS unsigned char* lds = (LAS unsigned char*)lds_raw;
    volatile LAS unsigned* MISC = (volatile LAS unsigned*)(lds + MISC_OFF);
    const int wave = __builtin_amdgcn_readfirstlane(threadIdx.x >> 6);
#define MYLANE() my_lane_id()
    const int G = gridDim.x, bx = blockIdx.x, vcu = (G % 8 == 0) ? (bx % 8) * (G / 8) + bx / 8 : bx;
    unsigned char* ws = args.ws;
    gu32* ctl = (gu32*)(ws + WS_CTL);
    { const int tid = wave * 64 + MYLANE();
      for (int u = tid; u < (LDS_BYTES - LDSCTL_OFF) / 4; u += NTHR) ((LAS unsigned*)(lds + LDSCTL_OFF))[u] = 0u; }
    __syncthreads();
    const int lo = args.ph_lo, hi = args.ph_hi;
    const bool multi = (hi - lo) > 1;
    XcdBarrier bar; bar.bar = (unsigned*)(ctl + CW_BAR) + args.li * XCD_BAR_WORDS; bar.x = 0; bar.st = nullptr;
    if (multi) bar = xcd_barrier_post((unsigned*)(ctl + CW_BAR) + args.li * XCD_BAR_WORDS, MISC + 8, wave == 0 && MYLANE() == 0);
#define IN(k) (lo <= (k) && (k) < hi)
#define RPT(k) ((args.flags >> (16 + (k))) & 1)
#define L1_INV_SYNC() do { VM_WAIT(); __builtin_amdgcn_fence(__ATOMIC_ACQUIRE, "agent"); VM_WAIT(); __syncthreads(); } while (0)
#define SEAM(k) do { if (IN(k) && IN((k) + 1)) xcd_barrier(bar, wave == 0 && MYLANE() == 0); } while (0)
    bf16 *WIN = (bf16*)(ws + WS_WIN), *WMKV = (bf16*)(ws + WS_WMKV), *WGLU = (bf16*)(ws + WS_WGLU), *WBR = (bf16*)(ws + WS_WBR), *WOUT = (bf16*)(ws + WS_WOUT), *WGU = (bf16*)(ws + WS_WGU), *WD = (bf16*)(ws + WS_WD);
    float *RS = (float*)(ws + WS_RS), *WI = (float*)(ws + WS_WI), *SLOC = (float*)(ws + WS_SLOC);
    bf16 *KX = (bf16*)(ws + WS_KX), *VX = (bf16*)(ws + WS_VX), *MEMN = (bf16*)(ws + WS_MEMN), *H = (bf16*)(ws + WS_H), *QD = (bf16*)(ws + WS_QD), *CKV = (bf16*)(ws + WS_CKV), *QI = (bf16*)(ws + WS_QI), *KI = (bf16*)(ws + WS_KI),
         *QX = (bf16*)(ws + WS_QX), *U = (bf16*)(ws + WS_U), *ODSA = (bf16*)(ws + WS_ODSA), *OX = (bf16*)(ws + WS_OX), *Y = (bf16*)(ws + WS_Y), *OS5 = (bf16*)args.out, *G3 = (bf16*)(ws + WS_G3), *MG = (bf16*)(ws + WS_MERGED),
         *ACT = (bf16*)(ws + WS_ACT), *XN = (bf16*)(ws + WS_XN), *S5TV = (bf16*)(ws + WS_S5TV), *S5W = (bf16*)(ws + WS_S5W);

    if (IN(0)) for (int rep_ = 0; rep_ <= RPT(0); ++rep_) { if (rep_) xcd_barrier(bar, wave == 0 && MYLANE() == 0); const int lane = MYLANE(), tid = wave * 64 + lane; p0_prologue(args, lds, tid, lane, wave, vcu, G); }
    SEAM(0);
    if (IN(1)) for (int rep_ = 0; rep_ <= RPT(1); ++rep_) { if (rep_) xcd_barrier(bar, wave == 0 && MYLANE() == 0);
        { pg8::Gemm g{H, WIN, T_TOK, NIN, 1024, 1024, 1024}; pg8::StaticOrder S; S.init(T_TOK, NIN, G, bx);
          pg8::EpiInprojF E{QD, CKV, QI, KI, U, QX, WI};
          pg8::gemm_phase<pg8::EpiInprojF, pg8::StaticOrder, true, true>(lds + RING_OFF, g, S, E, wave); }
        { pg8::Gemm g{MEMN, WMKV, 2048, 1024, 1024, 1024, 1024}; pg8::SubsetOrder S; S.init(2048, 1024, 64, bx - 192);
          pg8::EpiBf16S E{KX, VX, 512, 512};
          pg8::gemm_phase<pg8::EpiBf16S, pg8::SubsetOrder, true, true>(lds + RING_OFF, g, S, E, wave); }
    }
    SEAM(1);
    if (IN(2)) for (int rep_ = 0; rep_ <= RPT(2); ++rep_) { if (rep_) xcd_barrier(bar, wave == 0 && MYLANE() == 0);
        const int gtid = bx * NTHR + wave * 64 + MYLANE(), nthr = G * NTHR;
        norm128_pass(QD, T_TOK, 1024, 8, args.in[5], gtid, nthr);
        norm128_pass(CKV, T_TOK, 128, 1, args.in[6], gtid, nthr);
        norm128_pass(QX, T_TOK, 512, 4, args.in[19], gtid, nthr);
        norm128_pass(KX, 2048, 512, 4, args.in[20], gtid, nthr);
        if (!(args.flags & FL_NO_S5)) {
            pg8::Gemm g{U, S5W, 32 * 512, 32 * 256, 512, 640, 512}; pg8::S5Order1 S{bx - 192};
            pg8::EpiSlocF E{SLOC};
            pg8::gemm_phase<pg8::EpiSlocF, pg8::S5Order1, false, true>(lds + RING_OFF, g, S, E, wave);
            if (bx >= 192) { VM_WAIT(); __syncthreads(); const int pm = bx - 192; s5_scan(pm >> 1, pm & 1, args, wave * 64 + MYLANE()); }
        }
    }
    SEAM(2);
    if (IN(3)) for (int rep_ = 0; rep_ <= RPT(3); ++rep_) { if (rep_) xcd_barrier(bar, wave == 0 && MYLANE() == 0);
#ifdef TPROBE
        const unsigned long long tp3_0 = __builtin_amdgcn_s_memtime();
#endif
        if (!(args.flags & FL_NO_S5)) {
            pg8::Gemm g{U, S5TV, 32 * 512, 32 * 512, 640, 640, 640}; pg8::S5Order2 S{bx};
            pg8::EpiS5YF E{U, args.in[15], Y};
            pg8::gemm_phase<pg8::EpiS5YF, pg8::S5Order2, false, true>(lds + RING_OFF, g, S, E, wave);
        }
#ifdef HAVE_ATTN
        if (!(args.flags & FL_NO_CROSS)) { const int lane = MYLANE(); cross_phase(args, lds, wave * 64 + lane, lane, wave, bx, G); }
#endif
#ifdef TPROBE
        const unsigned long long tp3_1 = __builtin_amdgcn_s_memtime();
#endif
#ifdef HAVE_DSA
        if (!(args.flags & FL_NO_DSA)) dsa_phase(args, lds, wave, bx, G);
#endif
#ifdef TPROBE
        if (bx == TPROBE_BLOCK && wave == 0 && MYLANE() == 0) { unsigned long long* TP = (unsigned long long*)(ws + WS_CTL + 65536); TP[12] = __builtin_amdgcn_s_memtime() - tp3_0; TP[13] = tp3_1 - tp3_0; }
#endif
    }
    SEAM(3);
    if (IN(4)) for (int rep_ = 0; rep_ <= RPT(4); ++rep_) { if (rep_) xcd_barrier(bar, wave == 0 && MYLANE() == 0);
        { pg8::Gemm g{Y, WGLU, T_TOK, 512, 512, 512, 512}; pg8::SubsetOrder S; S.init(T_TOK, 512, 128, bx < 128 ? bx : -1);
          pg8::EpiGluF E{Y, OS5};
          pg8::gemm_phase<pg8::EpiGluF, pg8::SubsetOrder, false, true>(lds + RING_OFF, g, S, E, wave); }
        { pg8::Gemm g{H, WIN + (size_t)NIN * 1024, T_TOK, 3072, 1024, 1024, 1024}; pg8::GateOrder S{bx};
          pg8::EpiSigmoidF E{G3, 3072};
          pg8::gemm_phase<pg8::EpiSigmoidF, pg8::GateOrder, true, true>(lds + RING_OFF, g, S, E, wave); }
    }
    SEAM(4);
    if (IN(5)) for (int rep_ = 0; rep_ <= RPT(5); ++rep_) { if (rep_) xcd_barrier(bar, wave == 0 && MYLANE() == 0);
        pg8::Gemm g{ODSA, WBR, T_TOK, 1024, 512, 512, 512}; pg8::MergeOrder S; S.so.init(T_TOK, 1024, G, bx);
        S.aoff[0] = 0; S.aoff[1] = (long)((const char*)OS5 - (const char*)ODSA); S.aoff[2] = (long)((const char*)OX - (const char*)ODSA);
        pg8::EpiMergeF E{G3, MG};
        pg8::gemm_phase<pg8::EpiMergeF, pg8::MergeOrder, true, true>(lds + RING_OFF, g, S, E, wave);
    }
    SEAM(5);
    if (IN(6)) for (int rep_ = 0; rep_ <= RPT(6); ++rep_) { if (rep_) xcd_barrier(bar, wave == 0 && MYLANE() == 0);
        pg8::Gemm g{MG, WOUT, T_TOK, 1024, 1024, 1024, 1024}; pg8::StaticOrder S; S.init(T_TOK, 1024, G, bx);
        pg8::EpiOutF E{args.in[0], args.out, XN, RS};
        pg8::gemm_phase<pg8::EpiOutF, pg8::StaticOrder, false, true>(lds + RING_OFF, g, S, E, wave);
    }
    SEAM(6);
    if (IN(7)) for (int rep_ = 0; rep_ <= RPT(7); ++rep_) { if (rep_) xcd_barrier(bar, wave == 0 && MYLANE() == 0);
        pg8::Gemm g{XN, WGU, T_TOK, 5632, 1024, 1024, 1024}; pg8::StaticOrder S; S.init(T_TOK, 5632, G, bx);
        pg8::EpiGateUpF E{RS, ACT};
        pg8::gemm_phase<pg8::EpiGateUpF, pg8::StaticOrder, true, true>(lds + RING_OFF, g, S, E, wave);
    }
    SEAM(7);
    if (IN(8)) for (int rep_ = 0; rep_ <= RPT(8); ++rep_) { if (rep_) xcd_barrier(bar, wave == 0 && MYLANE() == 0);
        pg8::Gemm g{ACT, WD, T_TOK, 1024, 2816, 2816, 2816}; pg8::StaticOrder S; S.init(T_TOK, 1024, G, bx);
        pg8::EpiDownF E{args.out};
        pg8::gemm_phase<pg8::EpiDownF, pg8::StaticOrder, false, true>(lds + RING_OFF, g, S, E, wave);
    }
#ifdef TPROBE
    xcd_barrier(bar, wave == 0 && MYLANE() == 0);
    if (bx == 0 && wave == 0 && MYLANE() == 0) { const unsigned long long* TP = (const unsigned long long*)(ws + WS_CTL + 65536); unsigned long long tot = TP[12];
#if TPROBE < 8
        tot = 0; for (int k_ = 0; k_ < 6; ++k_) tot += TP[k_];
#endif
        const float frac = tot ? (float)((double)TP[TPROBE] / (double)tot) : 0.f; args.out[0] += 0.15f + 0.3f * frac; }
#endif
#undef IN
#undef SEAM
}
template <int MODE> __global__ void __launch_bounds__(NTHR, 2) t_dsa(Args args) {
    extern __shared__ __attribute__((aligned(16))) unsigned char lds_raw[];
    LAS unsigned char* lds = (LAS unsigned char*)lds_raw;
    const int wave = __builtin_amdgcn_readfirstlane(threadIdx.x >> 6);
    att::dsa_phase<MODE>(args, lds, wave, blockIdx.x, gridDim.x);
}
#ifndef CFG_FLAGS
#define CFG_FLAGS (FL_NO_DSA | FL_NO_CROSS)
#endif
#ifndef CFG_ONE_LAUNCH
#define CFG_ONE_LAUNCH 0
#endif
extern "C" void kernel_launch(void* const* d_in, const int* in_sizes, int n_in, void* d_out, int out_size, void* d_ws, size_t ws_size, hipStream_t stream) {
    static int grid = 0;
    if (grid == 0) {
        if (n_in != 29 || ws_size < WS_END || out_size != T_TOK * DM) { fprintf(stderr, "kernel_launch: unexpected sizes n_in %d ws %zu out %d\n", n_in, ws_size, out_size); grid = -1; return; }
        int dev = 0, cus = 0, per_cu = 0;
        if (hipGetDevice(&dev) != hipSuccess || hipDeviceGetAttribute(&cus, hipDeviceAttributeMultiprocessorCount, dev) != hipSuccess) { grid = -1; return; }
        if (hipFuncSetAttribute((const void*)mk_fwd, hipFuncAttributeMaxDynamicSharedMemorySize, LDS_BYTES) != hipSuccess) { fprintf(stderr, "kernel_launch: hipFuncSetAttribute failed\n"); grid = -1; return; }
        if (hipOccupancyMaxActiveBlocksPerMultiprocessor(&per_cu, (const void*)mk_fwd, NTHR, LDS_BYTES) != hipSuccess || per_cu < 1) fprintf(stderr, "kernel_launch: note: occupancy query reports %d\n", per_cu);
        (void)hipGetLastError();
        grid = cus;
        if (grid != 256) fprintf(stderr, "kernel_launch: %d CUs (built for 256)\n", grid);
    }
    if (grid < 0) return;
    (void)hipMemsetAsync((char*)d_ws + WS_CTL, 0, CTL_ZERO_BYTES, stream);
    Args a{};
    for (int i = 0; i < 29; ++i) a.in[i] = (const float*)d_in[i];
    a.out = (float*)d_out; a.ws = (unsigned char*)d_ws; a.flags = CFG_FLAGS;
#if CFG_ONE_LAUNCH
    a.ph_lo = 0; a.ph_hi = NPH;
    hipLaunchKernelGGL(mk_fwd, dim3(grid), dim3(NTHR), LDS_BYTES, stream, a);
#else
    unsigned char* ws = (unsigned char*)d_ws; const float* const* in = (const float* const*)d_in;
#ifdef CFG_SPLIT2
    for (int ph = 3; ph < 5; ++ph) {
        if (ph == 3) { a.ph_lo = 0; a.ph_hi = 4; a.li = 0; } else { a.ph_lo = 4; a.ph_hi = NPH; a.li = 1; }
#else
    for (int ph = 0; ph < NPH; ++ph) {
        a.ph_lo = ph; a.ph_hi = ph + 1;
#endif
        hipLaunchKernelGGL(mk_fwd, dim3(grid), dim3(NTHR), LDS_BYTES, stream, a);
#ifdef DSA_PROBE
        if (ph == 3) { static bool once = false; if (!once) { once = true; (void)hipFuncSetAttribute((const void*)t_dsa<0>, hipFuncAttributeMaxDynamicSharedMemorySize, LDS_BYTES); (void)hipFuncSetAttribute((const void*)t_dsa<DSA_PROBE>, hipFuncAttributeMaxDynamicSharedMemorySize, LDS_BYTES); }
            if (DSA_PROBE != 0) hipLaunchKernelGGL(t_dsa<DSA_PROBE>, dim3(grid), dim3(NTHR), LDS_BYTES, stream, a);
            hipLaunchKernelGGL(t_dsa<0>, dim3(grid), dim3(NTHR), LDS_BYTES, stream, a); }
#endif
        if (ph == 3) {
            using namespace nv;
#ifndef DSA_PROBE
            if (CFG_FLAGS & FL_NO_DSA) k_dsa<<<16384, 256, 0, stream>>>((nv::bf16*)(ws + WS_QD), (nv::bf16*)(ws + WS_CKV), (nv::bf16*)(ws + WS_QI), (nv::bf16*)(ws + WS_KI), (float*)(ws + WS_WI), (float*)(ws + WS_BIASL), (nv::bf16*)(ws + WS_WUV), (nv::bf16*)(ws + WS_ODSA));
#endif
            if (CFG_FLAGS & FL_NO_CROSS) k_cross<<<16384, 256, 0, stream>>>((nv::bf16*)(ws + WS_QX), (nv::bf16*)(ws + WS_KX), (nv::bf16*)(ws + WS_VX), (nv::bf16*)(ws + WS_OX));
            if (CFG_FLAGS & FL_NO_S5) k_s5<<<256, 64, 0, stream>>>((nv::bf16*)(ws + WS_U), in[8], in[9], in[10], in[11], in[12], in[13], in[14], in[15], (nv::bf16*)(ws + WS_Y));
        }
    }
#endif
}
```

```cpp
#include <hip/hip_runtime.h>
#include <cstdio>
#include <cstdint>
#include <cmath>
constexpr int T_TOK = 16384, DM = 1024, SEQ = 2048, NB = 8, NIN = 2816, NINP = 5888, DFF = 2816;
constexpr size_t MiB = 1u << 20;
constexpr size_t WS_CTL = 0;
constexpr size_t WS_WIN = 1 * MiB, WS_WMKV = 13 * MiB, WS_WGLU = 15 * MiB, WS_WBR = 16 * MiB, WS_WOUT = 19 * MiB, WS_WGU = 21 * MiB, WS_WD = 32 * MiB;
constexpr size_t WS_WUV = 38 * MiB, WS_BIASL = 38 * MiB + 512 * 1024, WS_RS = 39 * MiB, WS_WI = 37 * MiB + 512 * 1024;
constexpr size_t WS_S5TV = 40 * MiB, WS_S5W = 60 * MiB, WS_KX = 68 * MiB, WS_VX = 70 * MiB, WS_MEMN = 72 * MiB, WS_H = 76 * MiB;
constexpr size_t WS_QD = 108 * MiB, WS_CKV = 140 * MiB, WS_QI = 144 * MiB, WS_KI = 160 * MiB, WS_QX = 162 * MiB, WS_U = 178 * MiB, WS_SLOC = 198 * MiB;
constexpr size_t WS_ODSA = 206 * MiB, WS_OX = 222 * MiB, WS_Y = 238 * MiB, WS_END = 254 * MiB;
constexpr size_t WS_G3 = 108 * MiB, WS_MERGED = WS_H, WS_XN = 108 * MiB, WS_ACT = 140 * MiB;
constexpr size_t WS_OS5 = 0, WS_G = WS_G3;
__device__ __forceinline__ int my_lane_id() { int l; asm volatile("v_mbcnt_lo_u32_b32 %0, -1, 0\n\tv_mbcnt_hi_u32_b32 %0, -1, %0" : "=v"(l)); return l; }
#define CFG_FLAGS 0
#define CFG_ONE_LAUNCH 1
namespace pg8 {
#define PG8_LAS __attribute__((address_space(3)))
typedef unsigned short bf16_t;
typedef short bf16x8 __attribute__((ext_vector_type(8)));
typedef float f32x4 __attribute__((ext_vector_type(4)));
typedef unsigned u32x4 __attribute__((ext_vector_type(4)));
constexpr int BM = 256, BK = 64, HALF = 128, HTB = HALF * BK * 2  , STAGE_BYTES = 8 * HTB, NXCD = 8, WGM = 8;

__host__ __device__ __forceinline__ int lds_byte(int r, int c) { const int st = (r >> 4) * 2 + (c >> 5), rr = r & 15, cc = c & 31, ob = rr * 64 + cc * 2; return st * 1024 + (ob ^ (((ob >> 9) & 1) << 5)); }
__host__ __device__ __forceinline__ void stage_rc(int b, int& R, int& C) { const int st = b / 1024, sb = b % 1024, swz = sb ^ (((sb >> 9) & 1) << 5); R = (st >> 1) * 16 + swz / 64; C = (st & 1) * 32 + (swz % 64) / 2; }
__host__ __device__ __forceinline__ int perm32(int rho) { const int n = rho >> 4, i = rho & 15; return 8 * (i >> 2) + 4 * n + (i & 3); }

struct Unit { int pm, pn, z; };
struct Gemm { const bf16_t* A; const bf16_t* Bt; int M, N, K, lda, ldb; };

struct StaticOrder {
    int nM, nN, nwg, G, c;
    __host__ __device__ void init(int M, int N, int G_, int c_) { nM = M / BM; nN = N / BM; nwg = nM * nN; G = G_; c = c_; }
    __host__ __device__ bool next(int i, Unit& u) const {
        const long L = (long)i * G + c; if (L >= nwg) return false;
        int wgid = (int)L; { const int q = nwg / NXCD, r = nwg % NXCD, xcd = wgid % NXCD, off = wgid / NXCD; wgid = (xcd < r ? xcd * (q + 1) : r * (q + 1) + (xcd - r) * q) + off; }
        const int nig = WGM * nN, gid = wgid / nig, fm = gid * WGM, gsz = (nM - fm) < WGM ? (nM - fm) : WGM;
        u.pm = fm + ((wgid % nig) % gsz); u.pn = (wgid % nig) / gsz; u.z = 0; return true;
    }
    __device__ __forceinline__ void a_ready(const Unit&) const {}
    __device__ __forceinline__ void done(const Unit&) const {}
    __device__ __forceinline__ long a_off(const Unit&) const { return 0; }
    __device__ __forceinline__ long b_off(const Unit&) const { return 0; }
};

typedef float f32x2_c __attribute__((ext_vector_type(2))); typedef __bf16 bf16x2_c __attribute__((ext_vector_type(2)));
__device__ __forceinline__ unsigned cvt_pk_bf16(float lo, float hi) { const f32x2_c v = {lo, hi}; const bf16x2_c b = __builtin_convertvector(v, bf16x2_c); return __builtin_bit_cast(unsigned, b); }
typedef float f32x2 __attribute__((ext_vector_type(2)));
template <class Epi, class Sched, bool ALIGN_EPI = false, bool SP2 = false>
__device__ __forceinline__ void gemm_phase(PG8_LAS unsigned char* lds, const Gemm g, const Sched& S, const Epi& E, const int wid) {
    const int lane = my_lane_id(), tid = wid * 64 + lane, wr = wid >> 2, wc = wid & 3, fr = lane & 15, fq = lane >> 4;
    const int K = g.K, nt = K / BK, lda = g.lda, ldb = g.ldb;
    unsigned voffA[2], voffB[2];
#pragma unroll
    for (int i = 0; i < 2; ++i) { int R, C; stage_rc(tid * 16 + i * 8192, R, C); const int Rb = Epi::PERM ? ((R & ~31) + perm32(R & 31)) : R;
        voffA[i] = (unsigned)(R * lda + C) * 2u; voffB[i] = (unsigned)(Rb * ldb + C) * 2u; }
    const size_t kstep = (size_t)(BK * 2);
    const size_t hstepA = (size_t)HALF * lda * 2, hstepB = (size_t)HALF * ldb * 2;
    const size_t tstepA = 2 * hstepA, tstepB = 2 * hstepB;
    const unsigned ldsw = (unsigned)wid * 1024u;
    const int aoff = lds_byte(wr * 64 + fr, fq * 8), boff = lds_byte(wc * 32 + fr, fq * 8);
#define PG8_SA(b, h) (((b) * 2 + (h)) * HTB)
#define PG8_SB(b, h) ((4 + (b) * 2 + (h)) * HTB)
#define PG8_STAGE(bufoff, gbase, voff) do { _Pragma("unroll") for (int _i = 0; _i < 2; ++_i) \
        __builtin_amdgcn_global_load_lds((const unsigned*)((const char*)(gbase) + (voff)[_i]), (PG8_LAS unsigned*)(lds + (bufoff) + ldsw + _i * 8192), 16, 0, 0); } while (0)
#define PG8_LDA(dst, b, h) do { _Pragma("unroll") for (int m = 0; m < 4; ++m) _Pragma("unroll") for (int k = 0; k < 2; ++k) dst[m][k] = *(const PG8_LAS bf16x8*)(lds + PG8_SA(b, h) + aoff + m * 2048 + k * 1024); } while (0)
#define PG8_LDB(dst, b, h) do { _Pragma("unroll") for (int n = 0; n < 2; ++n) _Pragma("unroll") for (int k = 0; k < 2; ++k) dst[n][k] = *(const PG8_LAS bf16x8*)(lds + PG8_SB(b, h) + boff + n * 2048 + k * 1024); } while (0)
#define PG8_MMA(ai, bj, At, Bt) do { __builtin_amdgcn_s_setprio(1); _Pragma("unroll") for (int m = 0; m < 4; ++m) _Pragma("unroll") for (int n = 0; n < 2; ++n) _Pragma("unroll") for (int k = 0; k < 2; ++k) \
        acc[ai][bj][m][n] = __builtin_amdgcn_mfma_f32_16x16x32_bf16(Bt[n][k], At[m][k], acc[ai][bj][m][n], 0, 0, 0); __builtin_amdgcn_s_setprio(0); } while (0)
#define PG8_WAIT_V(n) asm volatile("s_waitcnt vmcnt(" #n ")" ::: "memory")
#define PG8_WAIT_L(n) asm volatile("s_waitcnt lgkmcnt(" #n ")" ::: "memory")
#define PG8_BAR __builtin_amdgcn_s_barrier()
#define PG8_SCHED __builtin_amdgcn_sched_barrier(0)
    Unit cur, nxt; int ui = 0;
    if (!S.next(0, cur)) return;
    f32x4 acc[2][2][4][2];
#pragma unroll
    for (int a = 0; a < 2; ++a)
#pragma unroll
        for (int b = 0; b < 2; ++b)
#pragma unroll
            for (int m = 0; m < 4; ++m)
#pragma unroll
                for (int n = 0; n < 2; ++n) acc[a][b][m][n] = (f32x4){0.f, 0.f, 0.f, 0.f};
    bf16x8 At[4][2], B0[2][2], B1[2][2];
    const char* cA = (const char*)g.A + (size_t)cur.pm * tstepA + S.a_off(cur); const char* cB = (const char*)g.Bt + (size_t)cur.pn * tstepB + S.b_off(cur);
    S.a_ready(cur);
    if constexpr (SP2) {
        PG8_STAGE(PG8_SB(0, 0), cB, voffB); PG8_STAGE(PG8_SB(0, 1), cB + hstepB, voffB); PG8_STAGE(PG8_SA(0, 0), cA, voffA); PG8_STAGE(PG8_SA(0, 1), cA + hstepA, voffA);
        if (wr == 1) PG8_BAR;
        PG8_WAIT_V(2); PG8_BAR;
        PG8_STAGE(PG8_SB(1, 0), cB + kstep, voffB); PG8_STAGE(PG8_SA(1, 0), cA + kstep, voffA); PG8_STAGE(PG8_SB(1, 1), cB + hstepB + kstep, voffB);
        PG8_WAIT_V(6); PG8_BAR;
    } else {
        PG8_STAGE(PG8_SB(0, 0), cB, voffB); PG8_STAGE(PG8_SA(0, 0), cA, voffA); PG8_STAGE(PG8_SB(0, 1), cB + hstepB, voffB); PG8_STAGE(PG8_SA(0, 1), cA + hstepA, voffA);
        if (wr == 1) PG8_BAR;
        PG8_WAIT_V(4); PG8_BAR;
        PG8_STAGE(PG8_SB(1, 0), cB + kstep, voffB); PG8_STAGE(PG8_SA(1, 0), cA + kstep, voffA); PG8_STAGE(PG8_SB(1, 1), cB + hstepB + kstep, voffB);
        PG8_WAIT_V(6); PG8_BAR;
    }
    for (;;) {
        const bool has_next = S.next(ui + 1, nxt);
        const char* nA = has_next ? (const char*)g.A + (size_t)nxt.pm * tstepA + S.a_off(nxt) : cA; const char* nB = has_next ? (const char*)g.Bt + (size_t)nxt.pn * tstepB + S.b_off(nxt) : cB;
        for (int t = 0; t < nt; t += 2) {
            const bool last = (t == nt - 2);
            const char* a1 = cA + (size_t)(t + 1) * kstep;
            const char* a2 = last ? nA : cA + (size_t)(t + 2) * kstep; const char* b2 = last ? nB : cB + (size_t)(t + 2) * kstep;
            const char* a3 = a2 + kstep; const char* b3 = b2 + kstep;
            if (last && has_next) S.a_ready(nxt);
            if constexpr (SP2) {
            PG8_LDB(B0, 0, 0); PG8_LDB(B1, 0, 1); PG8_SCHED; PG8_LDA(At, 0, 0); PG8_STAGE(PG8_SA(1, 1), a1 + hstepA, voffA);
            PG8_WAIT_V(8); PG8_WAIT_L(0); PG8_BAR; PG8_MMA(0, 0, At, B0); PG8_MMA(0, 1, At, B1); PG8_BAR; PG8_SCHED;
            PG8_LDA(At, 0, 1); PG8_STAGE(PG8_SB(0, 0), b2, voffB); PG8_STAGE(PG8_SB(0, 1), b2 + hstepB, voffB); PG8_STAGE(PG8_SA(0, 0), a2, voffA);
            PG8_WAIT_V(8); PG8_WAIT_L(0); PG8_BAR; PG8_MMA(1, 0, At, B0); PG8_MMA(1, 1, At, B1); PG8_BAR; PG8_SCHED;
            PG8_LDB(B0, 1, 0); PG8_LDB(B1, 1, 1); PG8_SCHED; PG8_LDA(At, 1, 0); PG8_STAGE(PG8_SA(0, 1), a2 + hstepA, voffA);
            PG8_WAIT_V(8); PG8_WAIT_L(0); PG8_BAR; PG8_MMA(0, 0, At, B0); PG8_MMA(0, 1, At, B1); PG8_BAR; PG8_SCHED;
            PG8_LDA(At, 1, 1); PG8_STAGE(PG8_SB(1, 0), b3, voffB); PG8_STAGE(PG8_SB(1, 1), b3 + hstepB, voffB); PG8_STAGE(PG8_SA(1, 0), a3, voffA);
            PG8_WAIT_V(8); PG8_WAIT_L(0); PG8_BAR; PG8_MMA(1, 0, At, B0); PG8_MMA(1, 1, At, B1); PG8_BAR; PG8_SCHED;
            } else {
            PG8_LDB(B0, 0, 0); PG8_SCHED; PG8_LDA(At, 0, 0); PG8_STAGE(PG8_SA(1, 1), a1 + hstepA, voffA);
            PG8_WAIT_L(8); PG8_BAR; PG8_WAIT_L(0); PG8_MMA(0, 0, At, B0); PG8_BAR; PG8_SCHED;
            PG8_LDB(B1, 0, 1); PG8_STAGE(PG8_SB(0, 0), b2, voffB);
            PG8_BAR; PG8_WAIT_L(0); PG8_MMA(0, 1, At, B1); PG8_BAR;
            PG8_LDA(At, 0, 1); PG8_STAGE(PG8_SA(0, 0), a2, voffA);
            PG8_BAR; PG8_WAIT_L(0); PG8_MMA(1, 0, At, B0); PG8_BAR; PG8_SCHED;
            PG8_STAGE(PG8_SB(0, 1), b2 + hstepB, voffB);
            PG8_WAIT_V(6); PG8_BAR; PG8_MMA(1, 1, At, B1); PG8_BAR;
            PG8_LDB(B0, 1, 0); PG8_SCHED; PG8_LDA(At, 1, 0); PG8_STAGE(PG8_SA(0, 1), a2 + hstepA, voffA);
            PG8_WAIT_L(8); PG8_BAR; PG8_WAIT_L(0); PG8_MMA(0, 0, At, B0); PG8_BAR; PG8_SCHED;
            PG8_LDB(B1, 1, 1); PG8_STAGE(PG8_SB(1, 0), b3, voffB);
            PG8_BAR; PG8_WAIT_L(0); PG8_MMA(0, 1, At, B1); PG8_BAR;
            PG8_LDA(At, 1, 1); PG8_STAGE(PG8_SA(1, 0), a3, voffA);
            PG8_BAR; PG8_WAIT_L(0); PG8_MMA(1, 0, At, B0); PG8_BAR; PG8_SCHED;
            PG8_STAGE(PG8_SB(1, 1), b3 + hstepB, voffB);
            PG8_WAIT_V(6); PG8_BAR; PG8_MMA(1, 1, At, B1); PG8_BAR;
            }
        }
        if constexpr (ALIGN_EPI) { if (wr == 0) PG8_BAR; }
        if constexpr (!Epi::AFTER_DRAIN) { E(acc, cur, wr, wc, fr, fq); S.done(cur); }
        if (!has_next) break;
#pragma unroll
        for (int a = 0; a < 2; ++a)
#pragma unroll
            for (int b = 0; b < 2; ++b)
#pragma unroll
                for (int m = 0; m < 4; ++m)
#pragma unroll
                    for (int n = 0; n < 2; ++n) acc[a][b][m][n] = (f32x4){0.f, 0.f, 0.f, 0.f};
        cur = nxt; cA = nA; cB = nB; ++ui;
        if constexpr (ALIGN_EPI) { if (wr == 1) PG8_BAR; }
    }
    PG8_WAIT_V(0);
    if constexpr (!ALIGN_EPI) { if (wr == 0) PG8_BAR; }
    PG8_BAR;
    if constexpr (Epi::AFTER_DRAIN) { E.fused(acc, cur, wr, wc, fr, fq, lds, wid, lane); S.done(cur); }
#undef PG8_SA
#undef PG8_SB
#undef PG8_STAGE
#undef PG8_LDA
#undef PG8_LDB
#undef PG8_MMA
#undef PG8_WAIT_V
#undef PG8_WAIT_L
#undef PG8_BAR
#undef PG8_SCHED
}
}
namespace pg8 {
typedef unsigned u32x2 __attribute__((ext_vector_type(2)));
__device__ __forceinline__ u32x4 pack8(const f32x4 a, const f32x4 b) { u32x4 w; w.x = cvt_pk_bf16(a[0], a[1]); w.y = cvt_pk_bf16(a[2], a[3]); w.z = cvt_pk_bf16(b[0], b[1]); w.w = cvt_pk_bf16(b[2], b[3]); return w; }
__device__ __forceinline__ void unpack8(const u32x4 w, f32x4& a, f32x4& b) {
    a[0] = __uint_as_float(w.x << 16); a[1] = __uint_as_float(w.x & 0xffff0000u); a[2] = __uint_as_float(w.y << 16); a[3] = __uint_as_float(w.y & 0xffff0000u);
    b[0] = __uint_as_float(w.z << 16); b[1] = __uint_as_float(w.z & 0xffff0000u); b[2] = __uint_as_float(w.w << 16); b[3] = __uint_as_float(w.w & 0xffff0000u); }
__device__ __forceinline__ float sigm(float v) { return __builtin_amdgcn_rcpf(1.f + __expf(-v)); }
__device__ __forceinline__ f32x4 sigm4(const f32x4 v) { f32x4 r; r[0] = sigm(v[0]); r[1] = sigm(v[1]); r[2] = sigm(v[2]); r[3] = sigm(v[3]); return r; }

__device__ __forceinline__ void norm128_stats(const f32x4 (&acc)[2][2][4][2], PG8_LAS float* XB, int wr, int wc, int fr, int fq, float (&rs)[2][2][4]) {
#pragma unroll
    for (int bj = 0; bj < 2; ++bj)
#pragma unroll
        for (int ai = 0; ai < 2; ++ai)
#pragma unroll
            for (int m = 0; m < 4; ++m) { const f32x4 a = acc[ai][bj][m][0], b = acc[ai][bj][m][1];
                float ss = ((a[0] * a[0] + a[1] * a[1]) + (a[2] * a[2] + a[3] * a[3])) + ((b[0] * b[0] + b[1] * b[1]) + (b[2] * b[2] + b[3] * b[3]));
                ss += __shfl_xor(ss, 16); ss += __shfl_xor(ss, 32);
                if (fq == 0) XB[(bj * 256 + ai * HALF + wr * 64 + m * 16 + fr) * 4 + wc] = ss; }
    asm volatile("s_waitcnt lgkmcnt(0)" ::: "memory"); __builtin_amdgcn_s_barrier(); asm volatile("" ::: "memory");
#pragma unroll
    for (int bj = 0; bj < 2; ++bj)
#pragma unroll
        for (int ai = 0; ai < 2; ++ai)
#pragma unroll
            for (int m = 0; m < 4; ++m) { const f32x4 p = *(const PG8_LAS f32x4*)(XB + (bj * 256 + ai * HALF + wr * 64 + m * 16 + fr) * 4);
                rs[bj][ai][m] = __builtin_amdgcn_rsqf(((p[0] + p[1]) + (p[2] + p[3])) * (1.f / 128.f) + 1e-6f); }
}
struct EpiInprojF {
    static constexpr bool PERM = true, AFTER_DRAIN = false;
    bf16_t *QD, *CKV, *QI, *KI, *U, *QX; float* WI; const float *gq, *gkv, *gqx; PG8_LAS float* XB;
    __device__ __forceinline__ void operator()(const f32x4 (&acc)[2][2][4][2], const Unit& u, int wr, int wc, int fr, int fq) const {
        const int row0 = u.pm * BM + wr * 64 + fr, cb = u.pn * BM;
        const bool nrm0 = cb < 1152 || cb >= 2304, nrm1 = cb + HALF < 1024 || cb + HALF >= 2304;
        float rs[2][2][4];
        if (nrm0 || nrm1) norm128_stats(acc, XB, wr, wc, fr, fq, rs);
#pragma unroll
        for (int bj = 0; bj < 2; ++bj) {
            const int c0 = cb + bj * HALF + wc * 32 + 8 * fq; const bool nrm = bj == 0 ? nrm0 : nrm1;
            bf16_t* base = QD; int ld = 1024, cc = c0, kind = 0; const float* gp = gq + (c0 & 127);
            if (c0 < 1024) { }
            else if (c0 < 1152) { base = CKV; ld = 128; cc = c0 - 1024; gp = gkv + cc; }
            else if (c0 < 1664) { base = QI; ld = 512; cc = c0 - 1152; }
            else if (c0 < 1728) { base = KI; ld = 64; cc = c0 - 1664; }
            else if (c0 < 1792) { kind = 1; }
            else if (c0 < 2304) { kind = 2; cc = c0 - 1792; }
            else { base = QX; ld = 512; cc = c0 - 2304; gp = gqx + (cc & 127); }
            f32x4 g0 = {1.f, 1.f, 1.f, 1.f}, g1 = g0;
            if (nrm) { g0 = *(const f32x4*)gp; g1 = *(const f32x4*)(gp + 4); }
#pragma unroll
            for (int ai = 0; ai < 2; ++ai)
#pragma unroll
                for (int m = 0; m < 4; ++m) {
                    const int t = row0 + ai * HALF + m * 16;
                    if (kind == 0) { f32x4 v0 = acc[ai][bj][m][0], v1 = acc[ai][bj][m][1]; if (nrm) { const float r = rs[bj][ai][m]; v0 = v0 * r * g0; v1 = v1 * r * g1; }
                        *(u32x4*)(base + (size_t)t * ld + cc) = pack8(v0, v1); }
                    else if (kind == 1) { if (c0 == 1728) { *(f32x4*)(WI + (size_t)t * 8) = acc[ai][bj][m][0]; *(f32x4*)(WI + (size_t)t * 8 + 4) = acc[ai][bj][m][1]; } }
                    else { const int g = cc >> 4, ci = cc & 15, b = t >> 11, tt = t & 2047, R = b * 64 + (tt >> 5), s = tt & 31;
                        *(u32x4*)(U + ((size_t)(g * 512 + R)) * 640 + s * 16 + ci) = pack8(acc[ai][bj][m][0], acc[ai][bj][m][1]); }
                }
        }
    }
};
struct EpiMemKVF {
    static constexpr bool PERM = true, AFTER_DRAIN = false;
    bf16_t* KX; bf16_t* VX; const float* gk; PG8_LAS float* XB;
    __device__ __forceinline__ void operator()(const f32x4 (&acc)[2][2][4][2], const Unit& u, int wr, int wc, int fr, int fq) const {
        const int row0 = u.pm * BM + wr * 64 + fr, cb = u.pn * BM; const bool nrm = cb < 512;
        float rs[2][2][4];
        if (nrm) norm128_stats(acc, XB, wr, wc, fr, fq, rs);
#pragma unroll
        for (int bj = 0; bj < 2; ++bj) {
            const int c0 = cb + bj * HALF + wc * 32 + 8 * fq;
            bf16_t* base = nrm ? KX : VX; const int cc = nrm ? c0 : c0 - 512;
            f32x4 g0 = {1.f, 1.f, 1.f, 1.f}, g1 = g0;
            if (nrm) { g0 = *(const f32x4*)(gk + (c0 & 127)); g1 = *(const f32x4*)(gk + (c0 & 127) + 4); }
#pragma unroll
            for (int ai = 0; ai < 2; ++ai)
#pragma unroll
                for (int m = 0; m < 4; ++m) { f32x4 v0 = acc[ai][bj][m][0], v1 = acc[ai][bj][m][1]; if (nrm) { const float r = rs[bj][ai][m]; v0 = v0 * r * g0; v1 = v1 * r * g1; }
                    *(u32x4*)(base + (size_t)(row0 + ai * HALF + m * 16) * 512 + cc) = pack8(v0, v1); }
        }
    }
};
struct EpiGluF {
    static constexpr bool PERM = true, AFTER_DRAIN = false;
    const bf16_t* Y; bf16_t* O;
    __device__ __forceinline__ void operator()(const f32x4 (&acc)[2][2][4][2], const Unit& u, int wr, int wc, int fr, int fq) const {
        const int row0 = u.pm * BM + wr * 64 + fr, c0 = u.pn * BM + wc * 32 + 8 * fq;
#pragma unroll
        for (int ai = 0; ai < 2; ++ai) {
            u32x4 yv[4][2];
#pragma unroll
            for (int m = 0; m < 4; ++m)
#pragma unroll
                for (int bj = 0; bj < 2; ++bj) yv[m][bj] = *(const u32x4*)(Y + (size_t)(row0 + ai * HALF + m * 16) * 512 + c0 + bj * HALF);
            asm volatile("" ::: "memory");
#pragma unroll
            for (int m = 0; m < 4; ++m)
#pragma unroll
                for (int bj = 0; bj < 2; ++bj) { f32x4 y0, y1; unpack8(yv[m][bj], y0, y1);
                    *(u32x4*)(O + (size_t)(row0 + ai * HALF + m * 16) * 512 + c0 + bj * HALF) = pack8(y0 * sigm4(acc[ai][bj][m][0]), y1 * sigm4(acc[ai][bj][m][1])); }
        }
    }
};
struct EpiSigmoidF {
    static constexpr bool PERM = true, AFTER_DRAIN = false;
    bf16_t* G; int ld;
    __device__ __forceinline__ void operator()(const f32x4 (&acc)[2][2][4][2], const Unit& u, int wr, int wc, int fr, int fq) const {
        const int row0 = u.pm * BM + wr * 64 + fr;
#pragma unroll
        for (int bj = 0; bj < 2; ++bj) {
            const int c0 = u.pn * BM + bj * HALF + wc * 32 + 8 * fq;
#pragma unroll
            for (int ai = 0; ai < 2; ++ai)
#pragma unroll
                for (int m = 0; m < 4; ++m) *(u32x4*)(G + (size_t)(row0 + ai * HALF + m * 16) * ld + c0) = pack8(sigm4(acc[ai][bj][m][0]), sigm4(acc[ai][bj][m][1]));
        }
    }
};
struct EpiMergeF {
    static constexpr bool PERM = true, AFTER_DRAIN = false;
    const bf16_t* G3; bf16_t* MG;
    __device__ __forceinline__ void operator()(const f32x4 (&acc)[2][2][4][2], const Unit& u, int wr, int wc, int fr, int fq) const {
        const int row0 = u.pm * BM + wr * 64 + fr, c0 = u.pn * BM + wc * 32 + 8 * fq; const bool first = u.z == 0;
#pragma unroll
        for (int ai = 0; ai < 2; ++ai) {
            u32x4 gv[4][2], pv[4][2];
#pragma unroll
            for (int m = 0; m < 4; ++m)
#pragma unroll
                for (int bj = 0; bj < 2; ++bj) { const size_t t = (size_t)(row0 + ai * HALF + m * 16);
                    gv[m][bj] = *(const u32x4*)(G3 + t * 3072 + u.z * 1024 + c0 + bj * HALF);
                    pv[m][bj] = first ? (u32x4){0u, 0u, 0u, 0u} : *(const u32x4*)(MG + t * 1024 + c0 + bj * HALF); }
            asm volatile("" ::: "memory");
#pragma unroll
            for (int m = 0; m < 4; ++m)
#pragma unroll
                for (int bj = 0; bj < 2; ++bj) { const size_t t = (size_t)(row0 + ai * HALF + m * 16);
                    f32x4 g0, g1, p0, p1; unpack8(gv[m][bj], g0, g1); unpack8(pv[m][bj], p0, p1);
                    *(u32x4*)(MG + t * 1024 + c0 + bj * HALF) = pack8(p0 + g0 * acc[ai][bj][m][0], p1 + g1 * acc[ai][bj][m][1]); }
        }
    }
};
struct EpiOutF {
    static constexpr bool PERM = false, AFTER_DRAIN = false;
    const float* x; float* out; bf16_t* XN; float* RS;
    __device__ __forceinline__ void operator()(const f32x4 (&acc)[2][2][4][2], const Unit& u, int wr, int wc, int fr, int fq) const {
        const int row0 = u.pm * BM + wr * 64 + fr, col0 = u.pn * BM + wc * 32 + 4 * fq;
#pragma unroll
        for (int ai = 0; ai < 2; ++ai) {
            f32x4 xv[4][2][2];
#pragma unroll
            for (int m = 0; m < 4; ++m)
#pragma unroll
                for (int bj = 0; bj < 2; ++bj)
#pragma unroll
                    for (int n = 0; n < 2; ++n) xv[m][bj][n] = *(const f32x4*)(x + (size_t)(row0 + ai * HALF + m * 16) * 1024 + col0 + bj * HALF + n * 16);
            asm volatile("" ::: "memory");
#pragma unroll
            for (int m = 0; m < 4; ++m) { const int t = row0 + ai * HALF + m * 16; const size_t off = (size_t)t * 1024 + col0; float ss = 0.f;
#pragma unroll
                for (int bj = 0; bj < 2; ++bj)
#pragma unroll
                    for (int n = 0; n < 2; ++n) { const size_t o2 = off + bj * HALF + n * 16; const f32x4 r = xv[m][bj][n] + acc[ai][bj][m][n];
                        *(f32x4*)(out + o2) = r; u32x2 w; w.x = cvt_pk_bf16(r[0], r[1]); w.y = cvt_pk_bf16(r[2], r[3]); *(u32x2*)(XN + o2) = w;
                        ss += (r[0] * r[0] + r[1] * r[1]) + (r[2] * r[2] + r[3] * r[3]); }
                ss += __shfl_xor(ss, 16); ss += __shfl_xor(ss, 32);
                if (fq == 0) RS[(size_t)t * 16 + u.pn * 4 + wc] = ss; }
        }
    }
};
struct EpiGateUpF {
    static constexpr bool PERM = true, AFTER_DRAIN = false;
    const float* RS; bf16_t* ACT;
    __device__ __forceinline__ void operator()(const f32x4 (&acc)[2][2][4][2], const Unit& u, int wr, int wc, int fr, int fq) const {
        const int row0 = u.pm * BM + wr * 64 + fr, f0 = u.pn * HALF + wc * 32 + 8 * fq;
        f32x4 pr[2][4];
#pragma unroll
        for (int ai = 0; ai < 2; ++ai)
#pragma unroll
            for (int m = 0; m < 4; ++m) pr[ai][m] = *(const f32x4*)(RS + (size_t)(row0 + ai * HALF + m * 16) * 16 + 4 * fq);
        asm volatile("" ::: "memory");
#pragma unroll
        for (int ai = 0; ai < 2; ++ai)
#pragma unroll
            for (int m = 0; m < 4; ++m) { const int t = row0 + ai * HALF + m * 16;
                float tot = (pr[ai][m][0] + pr[ai][m][1]) + (pr[ai][m][2] + pr[ai][m][3]); tot += __shfl_xor(tot, 16); tot += __shfl_xor(tot, 32);
                const float rs = __builtin_amdgcn_rsqf(tot * (1.f / 1024.f) + 1e-6f);
                f32x4 o[2];
#pragma unroll
                for (int n = 0; n < 2; ++n) { const f32x4 g = acc[ai][0][m][n] * rs, up = acc[ai][1][m][n] * rs; o[n] = g * sigm4(g) * up; }
                *(u32x4*)(ACT + (size_t)t * 2816 + f0) = pack8(o[0], o[1]); }
    }
};
struct EpiDownF {
    static constexpr bool PERM = false, AFTER_DRAIN = false;
    float* out;
    __device__ __forceinline__ void operator()(const f32x4 (&acc)[2][2][4][2], const Unit& u, int wr, int wc, int fr, int fq) const {
        const int row0 = u.pm * BM + wr * 64 + fr, col0 = u.pn * BM + wc * 32 + 4 * fq;
#pragma unroll
        for (int ai = 0; ai < 2; ++ai) {
            f32x4 xv[4][2][2];
#pragma unroll
            for (int m = 0; m < 4; ++m)
#pragma unroll
                for (int bj = 0; bj < 2; ++bj)
#pragma unroll
                    for (int n = 0; n < 2; ++n) xv[m][bj][n] = *(const f32x4*)(out + (size_t)(row0 + ai * HALF + m * 16) * 1024 + col0 + bj * HALF + n * 16);
            asm volatile("" ::: "memory");
#pragma unroll
            for (int m = 0; m < 4; ++m)
#pragma unroll
                for (int bj = 0; bj < 2; ++bj)
#pragma unroll
                    for (int n = 0; n < 2; ++n) *(f32x4*)(out + (size_t)(row0 + ai * HALF + m * 16) * 1024 + col0 + bj * HALF + n * 16) = xv[m][bj][n] + acc[ai][bj][m][n];
        }
    }
};
struct EpiSlocF {
    static constexpr bool PERM = false, AFTER_DRAIN = false;
    float* SLOC;
    __device__ __forceinline__ void operator()(const f32x4 (&acc)[2][2][4][2], const Unit& u, int wr, int wc, int fr, int fq) const {
        const int row0 = u.pm * BM + wr * 64 + fr, col0 = wc * 32 + 4 * fq;
#pragma unroll
        for (int ai = 0; ai < 2; ++ai)
#pragma unroll
            for (int m = 0; m < 4; ++m)
#pragma unroll
                for (int n = 0; n < 2; ++n) *(f32x4*)(SLOC + (size_t)(row0 + ai * HALF + m * 16) * 128 + col0 + n * 16) = acc[ai][0][m][n];
    }
};
__device__ __forceinline__ float gelu_t(float x) { const float w = 1.5957691216057308f * (x + 0.044715f * x * x * x); return x * __builtin_amdgcn_rcpf(1.f + __expf(-w)); }
struct EpiS5YF {
    static constexpr bool PERM = true, AFTER_DRAIN = false;
    const bf16_t* U; const float* dskip; bf16_t* Y;
    __device__ __forceinline__ void operator()(const f32x4 (&acc)[2][2][4][2], const Unit& u, int wr, int wc, int fr, int fq) const {
        const int row0 = u.pm * BM + wr * 64 + fr, g = (u.pm * BM) >> 9;
        f32x4 dk[2][2];
#pragma unroll
        for (int bj = 0; bj < 2; ++bj) { const int co0 = ((u.pn & 1) * BM + bj * HALF + wc * 32 + 8 * fq) & 15; dk[bj][0] = *(const f32x4*)(dskip + g * 16 + co0); dk[bj][1] = *(const f32x4*)(dskip + g * 16 + co0 + 4); }
#pragma unroll
        for (int ai = 0; ai < 2; ++ai) {
            u32x4 uv[4][2];
#pragma unroll
            for (int m = 0; m < 4; ++m)
#pragma unroll
                for (int bj = 0; bj < 2; ++bj) { const int cl = (u.pn & 1) * BM + bj * HALF + wc * 32 + 8 * fq; uv[m][bj] = *(const u32x4*)(U + (size_t)(row0 + ai * HALF + m * 16) * 640 + cl); }
            asm volatile("" ::: "memory");
#pragma unroll
            for (int m = 0; m < 4; ++m)
#pragma unroll
                for (int bj = 0; bj < 2; ++bj) { const int cl = (u.pn & 1) * BM + bj * HALF + wc * 32 + 8 * fq, s = cl >> 4, co0 = cl & 15;
                    const int row = row0 + ai * HALF + m * 16, R = row & 511, b = R >> 6, ch = R & 63, t = b * 2048 + ch * 32 + s;
                    f32x4 u0, u1; unpack8(uv[m][bj], u0, u1);
                    f32x4 y0 = acc[ai][bj][m][0] + dk[bj][0] * u0, y1 = acc[ai][bj][m][1] + dk[bj][1] * u1;
#pragma unroll
                    for (int e2 = 0; e2 < 4; ++e2) { y0[e2] = gelu_t(y0[e2]); y1[e2] = gelu_t(y1[e2]); }
                    *(u32x4*)(Y + (size_t)t * 512 + g * 16 + co0) = pack8(y0, y1); }
        }
    }
};
struct SubsetOrder { StaticOrder so; bool active;
    __device__ void init(int M, int N, int Gsub, int csub) { so.init(M, N, Gsub, csub < 0 ? 0 : csub); active = csub >= 0 && csub < Gsub; }
    __device__ bool next(int i, Unit& u) const { return active && so.next(i, u); }
    __device__ __forceinline__ void a_ready(const Unit&) const {}
    __device__ __forceinline__ void done(const Unit&) const {}
    __device__ __forceinline__ long a_off(const Unit&) const { return 0; }
    __device__ __forceinline__ long b_off(const Unit&) const { return 0; } };
struct S5Order1 { int c;
    __device__ bool next(int i, Unit& u) const { if (i > 0 || c < 0 || c >= 64) return false; u.pm = c; u.pn = c >> 1; u.z = 0; return true; }
    __device__ __forceinline__ void a_ready(const Unit&) const {}
    __device__ __forceinline__ void done(const Unit&) const {}
    __device__ __forceinline__ long a_off(const Unit&) const { return 0; }
    __device__ __forceinline__ long b_off(const Unit&) const { return 0; } };
struct S5Order2 { int c;
    __device__ bool next(int i, Unit& u) const { if (i > 0 || c < 0 || c >= 128) return false; const int g = c >> 2; u.pm = g * 2 + ((c >> 1) & 1); u.pn = g * 2 + (c & 1); u.z = 0; return true; }
    __device__ __forceinline__ void a_ready(const Unit&) const {}
    __device__ __forceinline__ void done(const Unit&) const {}
    __device__ __forceinline__ long a_off(const Unit&) const { return 0; }
    __device__ __forceinline__ long b_off(const Unit&) const { return 0; } };
struct GateOrder { int c;
    __device__ bool next(int i, Unit& u) const { int id; if (c < 128) { if (i >= 2) return false; id = c * 2 + i; } else { if (i >= 4) return false; id = 256 + (c - 128) * 4 + i; } u.pm = id / 12; u.pn = id % 12; u.z = 0; return true; }
    __device__ __forceinline__ void a_ready(const Unit&) const {}
    __device__ __forceinline__ void done(const Unit&) const {}
    __device__ __forceinline__ long a_off(const Unit&) const { return 0; }
    __device__ __forceinline__ long b_off(const Unit&) const { return 0; } };
struct MergeOrder { StaticOrder so; long aoff[3];
    __device__ bool next(int i, Unit& u) const { if (i >= 3) return false; if (!so.next(0, u)) return false; u.z = i; return true; }
    __device__ __forceinline__ void a_ready(const Unit&) const {}
    __device__ __forceinline__ void done(const Unit&) const {}
    __device__ __forceinline__ long a_off(const Unit& u) const { return u.z == 0 ? aoff[0] : (u.z == 1 ? aoff[1] : aoff[2]); }
    __device__ __forceinline__ long b_off(const Unit& u) const { return (long)u.z * 1024 * 512 * 2; } };
}
#define GAS __attribute__((address_space(1)))
#define LAS __attribute__((address_space(3)))
typedef unsigned short bf16;
typedef unsigned v4u __attribute__((ext_vector_type(4)));
typedef float f32x4 __attribute__((ext_vector_type(4)));
typedef short bf16x8 __attribute__((ext_vector_type(8)));
typedef GAS unsigned gu32;
typedef GAS unsigned long long gu64;
#define RLX_AGENT __ATOMIC_RELAXED, __HIP_MEMORY_SCOPE_AGENT
#define LDS_WAIT() asm volatile("s_waitcnt lgkmcnt(0)" ::: "memory")
#define VM_WAIT() asm volatile("s_waitcnt vmcnt(0)" ::: "memory")
__device__ __forceinline__ unsigned long long rt() { return __builtin_amdgcn_s_memrealtime(); }
__device__ __forceinline__ unsigned f2bf(float f) { unsigned u = __builtin_bit_cast(unsigned, f); return (u + 0x7fffu + ((u >> 16) & 1u)) >> 16; }
__device__ __forceinline__ unsigned pk2(float lo, float hi) { return f2bf(lo) | (f2bf(hi) << 16); }

#define XB_TMO      128
#define XB_XCNT(j)  (256  + 64 * (j))
#define XB_XSUB(j)  (1280 + 64 * (j))
#define XB_XGEN(j)  (2304 + 64 * (j))
#define XB_TOP      3328
#define XB_TOPGEN   3392
#define XCD_BAR_WORDS 3456
#define XB_SPIN_CAP (1u << 18)

__device__ __forceinline__ unsigned xb_ld(unsigned* p)              { return __hip_atomic_load(p, __ATOMIC_RELAXED, __HIP_MEMORY_SCOPE_AGENT); }
__device__ __forceinline__ unsigned xb_add(unsigned* p, unsigned v) { return __hip_atomic_fetch_add(p, v, __ATOMIC_RELAXED, __HIP_MEMORY_SCOPE_AGENT); }
__device__ __forceinline__ unsigned xb_xcc_id() { return (unsigned)__builtin_amdgcn_s_getreg((3 << 11) | 20) & 0xFu; }
#define XB_SPIN(cond, bar) do { unsigned _sp = 0; while (cond) { __builtin_amdgcn_s_sleep(1); \
    if ((++_sp & 255u) == 0u) { if (xb_ld(&(bar)[XB_TMO])) break; if (_sp > XB_SPIN_CAP) { atomicAdd(&(bar)[XB_TMO], 1u); break; } } } } while (0)

struct XcdBarrier {
    unsigned* bar; unsigned x;
    volatile LAS unsigned* st;
};

__device__ __forceinline__ XcdBarrier xcd_barrier_post(unsigned* bar, volatile LAS unsigned* st, bool leader) {
    XcdBarrier b; b.bar = bar; b.x = xb_xcc_id(); b.st = st;
    if (leader) (void)xb_add(&bar[XB_XCNT(b.x)], 1u);
    return b;
}
__device__ __forceinline__ void xcd_barrier_complete(unsigned* bar, unsigned x, unsigned& nloc, unsigned& nx) {
    const unsigned G = gridDim.x * gridDim.y * gridDim.z;
    unsigned sum, cnt, mine, sp = 0u;
    for (;;) {
        sum = 0u; cnt = 0u; mine = 0u;
#pragma unroll
        for (unsigned j = 0; j < 16; ++j) { const unsigned c = xb_ld(&bar[XB_XCNT(j)]); sum += c; cnt += (c > 0u) ? 1u : 0u; mine = (j == x) ? c : mine; }
        if (sum == G) break;
        __builtin_amdgcn_s_sleep(1);
        if ((++sp & 255u) == 0u) { if (xb_ld(&bar[XB_TMO])) break; if (sp > XB_SPIN_CAP) { atomicAdd(&bar[XB_TMO], 1u); break; } }
    }
    nloc = mine > 0u ? mine : 1u; nx = cnt > 0u ? cnt : 1u;
}

__device__ __forceinline__ void xcd_barrier(const XcdBarrier& b, bool leader) {
    asm volatile("s_waitcnt vmcnt(0)" ::: "memory");
    __syncthreads();
    if (leader) {
        unsigned* bar = b.bar;
        __builtin_amdgcn_s_waitcnt(0);
        unsigned nloc = b.st[0], nx = b.st[1];
        if (nloc == 0u) { xcd_barrier_complete(bar, b.x, nloc, nx); b.st[0] = nloc; b.st[1] = nx; }
        const unsigned old = xb_add(&bar[XB_XSUB(b.x)], 1u);
        const unsigned gen = old / nloc;
        if (old + 1u == (gen + 1u) * nloc) {
            __builtin_amdgcn_fence(__ATOMIC_RELEASE, "agent");
            asm volatile("s_waitcnt vmcnt(0)" ::: "memory");
            const unsigned og = xb_add(&bar[XB_TOP], 1u);
            const unsigned tg = og / nx;
            if (og + 1u == (tg + 1u) * nx) xb_add(&bar[XB_TOPGEN], 1u);
            else XB_SPIN(xb_ld(&bar[XB_TOPGEN]) == tg, bar);
            __builtin_amdgcn_fence(__ATOMIC_ACQUIRE, "agent");
            xb_add(&bar[XB_XGEN(b.x)], 1u);
            asm volatile("s_waitcnt vmcnt(0)" ::: "memory");
        } else {
            XB_SPIN(xb_ld(&bar[XB_XGEN(b.x)]) == gen, bar);
            __builtin_amdgcn_fence(__ATOMIC_ACQUIRE, "agent");
            asm volatile("s_waitcnt vmcnt(0)" ::: "memory");
        }
    }
    __syncthreads();
}
constexpr int NWAVES = 8, NTHR = 512;
constexpr int RING_OFF = 0, RING_BYTES = 131072;
constexpr int LDSCTL_OFF = RING_BYTES, MISC_OFF = LDSCTL_OFF + 320, XB_OFF = RING_BYTES + 1024;
constexpr int LDS_BYTES = 147456;
constexpr size_t CTL_ZERO_BYTES = 1 * MiB;
constexpr int CW_TMO = 0, CW_BAR = 4096;
constexpr int NPH = 9;
constexpr int FL_NO_DSA = 1, FL_NO_CROSS = 2, FL_NO_S5 = 4;
constexpr size_t WS_LAM32 = WS_BIASL + 8192;

struct Args { const float* in[29]; float* out; unsigned char* ws; int ph_lo, ph_hi, flags, li; };

__device__ __forceinline__ float wave_sum(float v) {
#pragma unroll
    for (int o = 1; o < 64; o <<= 1) v += __shfl_xor(v, o);
    return v;
}
__device__ __forceinline__ float p0_src(int mode, const float* W, const float* W2, const float* gain, int N, int k, int d) {
    if (mode == 0) return W[(size_t)k * N + d];
    if (mode == 1) { if (d >= 1736 && d < 1792) return 0.f; const int s = d >= 1792 ? d - 56 : d; return W[(size_t)k * N + s]; }
    const int tile = d >> 8, w = d & 255, f = tile * 128 + (w & 127); return ((w < 128) ? W : W2)[(size_t)k * N + f] * gain[k];
}
__device__ __forceinline__ void p0_transpose_item(int mode, const float* W, const float* W2, const float* gain, int K, int N, int ND, bf16* WT, LAS float* scr, int item, int lane) {
    const int nblk = ND / 32, kb = item / nblk, nb = item % nblk, k0 = 64 * kb, d0 = 32 * nb;
    float tv[32];
#pragma unroll
    for (int i = 0; i < 32; ++i) tv[i] = p0_src(mode, W, W2, gain, N, k0 + 2 * i + (lane >> 5), d0 + (lane & 31));
#pragma unroll
    for (int i = 0; i < 32; ++i) scr[(2 * i + (lane >> 5)) * 33 + (lane & 31)] = tv[i];
    LDS_WAIT(); asm volatile("" ::: "memory");
    const int c = lane & 7;
#pragma unroll
    for (int j = 0; j < 4; ++j) { const int n = (lane >> 3) + 8 * j; const LAS float* s = scr + (8 * c) * 33 + n;
        v4u o; o.x = pk2(s[0 * 33], s[1 * 33]); o.y = pk2(s[2 * 33], s[3 * 33]); o.z = pk2(s[4 * 33], s[5 * 33]); o.w = pk2(s[6 * 33], s[7 * 33]);
        *(GAS v4u*)(WT + (size_t)(d0 + n) * K + k0 + 8 * c) = o; }
    LDS_WAIT(); asm volatile("" ::: "memory");
}
__device__ __forceinline__ void rms_row_to_bf16(const float* xrow, const float* g, bf16* orow, int lane) {
    const GAS f32x4* xr = (const GAS f32x4*)xrow + lane; const GAS f32x4* gr = (const GAS f32x4*)g + lane;
    f32x4 v[4]; float s = 0.f;
#pragma unroll
    for (int j = 0; j < 4; ++j) { v[j] = xr[64 * j]; s += (v[j].x * v[j].x + v[j].y * v[j].y) + (v[j].z * v[j].z + v[j].w * v[j].w); }
    const float rstd = 1.f / sqrtf(wave_sum(s) * (1.f / 1024.f) + 1e-6f);
    GAS unsigned long long* o8 = (GAS unsigned long long*)orow + lane;
#pragma unroll
    for (int j = 0; j < 4; ++j) { const f32x4 gg = gr[64 * j];
        o8[64 * j] = (unsigned long long)pk2(v[j].x * rstd * gg.x, v[j].y * rstd * gg.y) | ((unsigned long long)pk2(v[j].z * rstd * gg.z, v[j].w * rstd * gg.w) << 32); }
}
__device__ __forceinline__ int t5_bucket(int n) {
    if (n < 16) return n;
    const int large = 16 + (int)((logf((float)n / 16.f) / 2.0794415416798357f) * 16.f);
    return large < 31 ? large : 31;
}
__device__ __forceinline__ void p0_s5_tables(int g, int part, const Args& a, LAS unsigned char* lds, int tid) {
    typedef float f32x2v __attribute__((ext_vector_type(2)));
    LAS f32x2v* POW = (LAS f32x2v*)lds;
    LAS f32x2v* BB = POW + 33 * 64;
    LAS f32x2v* CC = BB + 64 * 16;
    LAS float* KT = (LAS float*)(CC + 16 * 64);
    const float *a_re = a.in[8], *a_im = a.in[9], *log_dt = a.in[10], *b_re = a.in[11], *b_im = a.in[12], *c_re = a.in[13], *c_im = a.in[14];
    bf16* TV = (bf16*)(a.ws + WS_S5TV) + (size_t)g * 512 * 640; bf16* Wt = (bf16*)(a.ws + WS_S5W) + (size_t)g * 256 * 512; float* LAM32 = (float*)(a.ws + WS_LAM32) + g * 128;
    const double dt = exp((double)log_dt[g]);
    for (int idx = tid; idx < 33 * 64; idx += NTHR) { const int j = idx >> 6, n = idx & 63; const double lr = a_re[g * 64 + n], li = a_im[g * 64 + n];
        const double mag = exp(lr * dt * j), ang = li * dt * j; POW[idx] = (f32x2v){(float)(mag * cos(ang)), (float)(mag * sin(ang))}; }
    for (int idx = tid; idx < 64 * 16; idx += NTHR) { const int n = idx >> 4, c = idx & 15; const double lr = a_re[g * 64 + n], li = a_im[g * 64 + n];
        const double mag = exp(lr * dt), lbr = mag * cos(li * dt), lbi = mag * sin(li * dt), nr = lbr - 1.0, ni = lbi, den = lr * lr + li * li;
        const double fr = (nr * lr + ni * li) / den, fi = (ni * lr - nr * li) / den, br = b_re[(g * 64 + n) * 16 + c], bi = b_im[(g * 64 + n) * 16 + c];
        BB[idx] = (f32x2v){(float)(fr * br - fi * bi), (float)(fr * bi + fi * br)};
        const int c2 = idx >> 6, n2 = idx & 63; CC[idx] = (f32x2v){c_re[(g * 16 + c2) * 64 + n2], c_im[(g * 16 + c2) * 64 + n2]}; }
    __syncthreads();
    if (part == 0 && tid < 64) { const f32x2v p = POW[32 * 64 + tid]; LAM32[tid * 2] = p.x; LAM32[tid * 2 + 1] = p.y; }
    for (int idx = tid; idx < 32 * 32; idx += NTHR) { const int j = idx >> 5, co = 2 * part + ((idx >> 4) & 1), ci = idx & 15; float s = 0.f;
#pragma unroll 2
        for (int n = 0; n < 64; ++n) { const f32x2v c = CC[co * 64 + n], p = POW[j * 64 + n], b = BB[n * 16 + ci];
            const float cpr = c.x * p.x - c.y * p.y, cpi = c.x * p.y + c.y * p.x; s += cpr * b.x - cpi * b.y; }
        KT[j * 256 + co * 16 + ci] = s; }
    __syncthreads();
    for (int id = tid; id < 64 * 80; id += NTHR) { const int rl = id / 80, c8 = id % 80, so = rl >> 1, co = 2 * part + (rl & 1), row = so * 16 + co; float v[8];
        if (c8 < 64) { const int si = c8 >> 1, ci0 = (c8 & 1) * 8;
#pragma unroll
            for (int e = 0; e < 8; ++e) v[e] = so >= si ? KT[(so - si) * 256 + co * 16 + ci0 + e] : 0.f; }
        else {
#pragma unroll
            for (int e = 0; e < 8; ++e) { const int np = (c8 - 64) * 8 + e, n = np & 63; const f32x2v c = CC[co * 64 + n], p = POW[(so + 1) * 64 + n];
                v[e] = np < 64 ? (c.x * p.x - c.y * p.y) : -(c.x * p.y + c.y * p.x); } }
        v4u o; o.x = pk2(v[0], v[1]); o.y = pk2(v[2], v[3]); o.z = pk2(v[4], v[5]); o.w = pk2(v[6], v[7]);
        *(GAS v4u*)(TV + (size_t)row * 640 + c8 * 8) = o; }
    for (int id = tid; id < 16 * 64; id += NTHR) { const int np = 16 * part + (id >> 6), c8 = id & 63, n = np & 63, s = c8 >> 1, ci0 = (c8 & 1) * 8; const f32x2v p = POW[(31 - s) * 64 + n]; float v[8];
#pragma unroll
        for (int e = 0; e < 8; ++e) { const f32x2v b = BB[n * 16 + ci0 + e]; v[e] = np < 64 ? (p.x * b.x - p.y * b.y) : (p.x * b.y + p.y * b.x); }
        v4u o; o.x = pk2(v[0], v[1]); o.y = pk2(v[2], v[3]); o.z = pk2(v[4], v[5]); o.w = pk2(v[6], v[7]);
        *(GAS v4u*)(Wt + (size_t)np * 512 + c8 * 8) = o; }
    __syncthreads();
}
__device__ __forceinline__ void p0_prologue(const Args& a, LAS unsigned char* lds, int tid, int lane, int wave, int vcu, int G) {
    unsigned char* ws = a.ws;
    LAS float* scr = (LAS float*)(lds + RING_OFF + wave * 16384);
    const int gw = vcu * NWAVES + wave, NGW = G * NWAVES;
    p0_s5_tables(vcu >> 3, vcu & 7, a, lds, tid);
    if (blockIdx.x == 33 && tid == 0) {
        float gq = 0.f, gk = 0.f, bm = 0.f; for (int i = 0; i < 128; ++i) { gq = fmaxf(gq, fabsf(a.in[5][i])); gk = fmaxf(gk, fabsf(a.in[6][i])); }
        for (int i = 0; i < 256; ++i) bm = fmaxf(bm, fabsf(a.in[2][i]));
        const float B = 1.02f * 128.f * 0.08838834764831845f * 1.4426950408889634f * gq * gk + bm * 1.4426950408889634f;
        ((float*)(ws + WS_BIASL))[1032] = (B > 0.f && B <= 56.f) ? B : 0.f; }
    if (blockIdx.x == 32) { float* BL = (float*)(ws + WS_BIASL); const float* rb = a.in[2];
        for (int i = tid; i < 8 * 128 + 8; i += NTHR) { if (i < 1024) { const int h = i >> 7, d = i & 127; BL[i] = rb[t5_bucket(d) * 8 + h] * 1.4426950408889634f; } else BL[i] = rb[31 * 8 + (i - 1024)] * 1.4426950408889634f; } }
    { bf16* WUV = (bf16*)(ws + WS_WUV); const float* w = a.in[7];
        for (int i = blockIdx.x * NTHR + tid; i < 8 * 64 * 128; i += G * NTHR) { const int ep = i & 3, ln = (i >> 2) & 63, t = (i >> 8) & 1, cs = (i >> 9) & 7, eb = (i >> 12) & 1, h = i >> 13;
            const int d = 16 * cs + 8 * t + 4 * (ln >> 5) + ep, e = 32 * eb + (ln & 31); WUV[i] = (bf16)f2bf(w[(h * 128 + d) * 64 + e]); } }
    constexpr int I_IN = 16 * 184, I_MKV = 16 * 32, I_GLU = 8 * 16, I_BR = 8 * 32, I_OUT = 16 * 32, I_GU = 16 * 176, I_D = 44 * 32;
    constexpr int NITEMS = I_IN + I_MKV + I_GLU + 3 * I_BR + I_OUT + I_GU + I_D;
    for (int it = gw; it < NITEMS; it += NGW) {
        int r = it;
        if (r < I_IN) { p0_transpose_item(1, a.in[3], nullptr, nullptr, 1024, 5832, 5888, (bf16*)(ws + WS_WIN), scr, r, lane); continue; } r -= I_IN;
        if (r < I_MKV) { p0_transpose_item(0, a.in[18], nullptr, nullptr, 1024, 1024, 1024, (bf16*)(ws + WS_WMKV), scr, r, lane); continue; } r -= I_MKV;
        if (r < I_GLU) { p0_transpose_item(0, a.in[16], nullptr, nullptr, 512, 512, 512, (bf16*)(ws + WS_WGLU), scr, r, lane); continue; } r -= I_GLU;
        if (r < 3 * I_BR) { const int br = r / I_BR; p0_transpose_item(0, a.in[21 + br], nullptr, nullptr, 512, 1024, 1024, (bf16*)(ws + WS_WBR) + (size_t)br * 1024 * 512, scr, r % I_BR, lane); continue; } r -= 3 * I_BR;
        if (r < I_OUT) { p0_transpose_item(0, a.in[24], nullptr, nullptr, 1024, 1024, 1024, (bf16*)(ws + WS_WOUT), scr, r, lane); continue; } r -= I_OUT;
        if (r < I_GU) { p0_transpose_item(2, a.in[26], a.in[27], a.in[25], 1024, 2816, 5632, (bf16*)(ws + WS_WGU), scr, r, lane); continue; } r -= I_GU;
        p0_transpose_item(0, a.in[28], nullptr, nullptr, 2816, 1024, 1024, (bf16*)(ws + WS_WD), scr, r, lane);
    }
    for (int m = gw; m < T_TOK; m += 2 * NGW) {
        const GAS f32x4* x0 = (const GAS f32x4*)(a.in[0] + (size_t)m * 1024) + lane; const GAS f32x4* x1 = (const GAS f32x4*)(a.in[0] + (size_t)(m + NGW) * 1024) + lane; const GAS f32x4* gr = (const GAS f32x4*)a.in[4] + lane;
        f32x4 v0[4], v1[4]; float s0 = 0.f, s1 = 0.f;
#pragma unroll
        for (int j = 0; j < 4; ++j) { v0[j] = x0[64 * j]; v1[j] = x1[64 * j]; }
#pragma unroll
        for (int j = 0; j < 4; ++j) { s0 += (v0[j].x * v0[j].x + v0[j].y * v0[j].y) + (v0[j].z * v0[j].z + v0[j].w * v0[j].w); s1 += (v1[j].x * v1[j].x + v1[j].y * v1[j].y) + (v1[j].z * v1[j].z + v1[j].w * v1[j].w); }
        const float r0 = 1.f / sqrtf(wave_sum(s0) * (1.f / 1024.f) + 1e-6f), r1 = 1.f / sqrtf(wave_sum(s1) * (1.f / 1024.f) + 1e-6f);
        GAS unsigned long long* o0 = (GAS unsigned long long*)((bf16*)(ws + WS_H) + (size_t)m * 1024) + lane; GAS unsigned long long* o1 = (GAS unsigned long long*)((bf16*)(ws + WS_H) + (size_t)(m + NGW) * 1024) + lane;
#pragma unroll
        for (int j = 0; j < 4; ++j) { const f32x4 gg = gr[64 * j];
            o0[64 * j] = (unsigned long long)pk2(v0[j].x * r0 * gg.x, v0[j].y * r0 * gg.y) | ((unsigned long long)pk2(v0[j].z * r0 * gg.z, v0[j].w * r0 * gg.w) << 32);
            o1[64 * j] = (unsigned long long)pk2(v1[j].x * r1 * gg.x, v1[j].y * r1 * gg.y) | ((unsigned long long)pk2(v1[j].z * r1 * gg.z, v1[j].w * r1 * gg.w) << 32); }
    }
    for (int m = gw; m < 2048; m += NGW) rms_row_to_bf16(a.in[1] + (size_t)m * 1024, a.in[17], (bf16*)(ws + WS_MEMN) + (size_t)m * 1024, lane);
}
__device__ __forceinline__ void norm128_pass(bf16* X, int rows, int ld, int ngroups, const float* g, int gtid, int nthr) {
    const int l = gtid & 15, total = rows * ngroups;
    for (int gid = gtid >> 4; gid < total; gid += nthr >> 4) {
        const int r = gid / ngroups, gi = gid % ngroups;
        bf16* p = X + (size_t)r * ld + gi * 128 + l * 8;
        const v4u v = *(const GAS v4u*)p; float f[8];
        f[0] = __uint_as_float(v.x << 16); f[1] = __uint_as_float(v.x & 0xffff0000u); f[2] = __uint_as_float(v.y << 16); f[3] = __uint_as_float(v.y & 0xffff0000u);
        f[4] = __uint_as_float(v.z << 16); f[5] = __uint_as_float(v.z & 0xffff0000u); f[6] = __uint_as_float(v.w << 16); f[7] = __uint_as_float(v.w & 0xffff0000u);
        float s = 0.f;
#pragma unroll
        for (int q = 0; q < 8; ++q) s += f[q] * f[q];
        s += __shfl_xor(s, 8); s += __shfl_xor(s, 4); s += __shfl_xor(s, 2); s += __shfl_xor(s, 1);
        const float rs = 1.f / sqrtf(s * (1.f / 128.f) + 1e-6f);
        const f32x4 g0 = *(const GAS f32x4*)(g + l * 8), g1 = *(const GAS f32x4*)(g + l * 8 + 4);
        v4u o; o.x = pk2(f[0] * rs * g0.x, f[1] * rs * g0.y); o.y = pk2(f[2] * rs * g0.z, f[3] * rs * g0.w); o.z = pk2(f[4] * rs * g1.x, f[5] * rs * g1.y); o.w = pk2(f[6] * rs * g1.z, f[7] * rs * g1.w);
        *(GAS v4u*)p = o;
    }
}
__device__ __forceinline__ void s5_scan(int g, int half, const Args& a, int tid) {
    if (tid < 256) {
        const int bl = tid >> 6, n = tid & 63, b = half * 4 + bl;
        const float* LAM32 = (const float*)(a.ws + WS_LAM32) + g * 128; const float lr = LAM32[n * 2], li = LAM32[n * 2 + 1];
        const float* SL = (const float*)(a.ws + WS_SLOC) + ((size_t)(g * 512 + b * 64)) * 128; bf16* Ur = (bf16*)(a.ws + WS_U) + ((size_t)(g * 512 + b * 64)) * 640 + 512;
        float xr = 0.f, xi = 0.f;
        for (int ch = 0; ch < 64; ++ch) {
            Ur[(size_t)ch * 640 + n] = (bf16)f2bf(xr); Ur[(size_t)ch * 640 + 64 + n] = (bf16)f2bf(xi);
            const float sr = SL[(size_t)ch * 128 + n], si = SL[(size_t)ch * 128 + 64 + n];
            const float nr = lr * xr - li * xi + sr, ni = lr * xi + li * xr + si; xr = nr; xi = ni;
        }
    }
    VM_WAIT(); __syncthreads();
}
namespace nv {
typedef unsigned short bf16;
__device__ __forceinline__ unsigned f2bf(float f) { unsigned u = __float_as_uint(f); return (u + 0x7fffu + ((u >> 16) & 1u)) >> 16; }
__device__ __forceinline__ float bf2f(unsigned short b) { return __uint_as_float((unsigned)b << 16); }

__global__ void k_transpose(const float* __restrict__ W, const float* __restrict__ W2, const float* __restrict__ gain,
                            bf16* __restrict__ WT, int K, int N, int ND, int mode) {
    const size_t total = (size_t)ND * K;
    for (size_t i = (size_t)blockIdx.x * blockDim.x + threadIdx.x; i < total; i += (size_t)gridDim.x * blockDim.x) {
        const int d = (int)(i / K), k = (int)(i % K);
        float v;
        if (mode == 0) v = W[(size_t)k * N + d];
        else if (mode == 1) { if (d >= 1736 && d < 1792) v = 0.f; else { const int s = d >= 1792 ? d - 56 : d; v = W[(size_t)k * N + s]; } }
        else { const int tile = d >> 8, w = d & 255, f = tile * 128 + (w & 127); v = ((w < 128) ? W : W2)[(size_t)k * N + f] * gain[k]; }
        WT[i] = (bf16)f2bf(v);
    }
}
__global__ void k_wuv(const float* __restrict__ W, bf16* __restrict__ WT) {
    const int i = blockIdx.x * blockDim.x + threadIdx.x; if (i >= 8 * 64 * 128) return;
    const int h = i / (64 * 128), e = (i / 128) % 64, d = i % 128;
    WT[i] = (bf16)f2bf(W[(h * 128 + d) * 64 + e]);
}
__global__ void k_rmsnorm1024(const float* __restrict__ x, const float* __restrict__ g, bf16* __restrict__ out, int rows) {
    __shared__ float red[4];
    const int r = blockIdx.x; if (r >= rows) return;
    const float4 v = ((const float4*)(x + (size_t)r * 1024))[threadIdx.x];
    float s = v.x * v.x + v.y * v.y + v.z * v.z + v.w * v.w;
    for (int o = 32; o; o >>= 1) s += __shfl_xor(s, o);
    if ((threadIdx.x & 63) == 0) red[threadIdx.x >> 6] = s;
    __syncthreads();
    const float tot = red[0] + red[1] + red[2] + red[3];
    const float rs = rsqrtf(tot * (1.f / 1024.f) + 1e-6f);
    const float4 gg = ((const float4*)g)[threadIdx.x];
    bf16* o = out + (size_t)r * 1024 + threadIdx.x * 4;
    o[0] = (bf16)f2bf(v.x * rs * gg.x); o[1] = (bf16)f2bf(v.y * rs * gg.y); o[2] = (bf16)f2bf(v.z * rs * gg.z); o[3] = (bf16)f2bf(v.w * rs * gg.w);
}
__device__ __forceinline__ int t5_bucket(int n) {
    if (n < 16) return n;
    const float nf = (float)n;
    int large = 16 + (int)((logf(nf / 16.f) / 2.0794415416798357f) * 16.f);
    return large < 31 ? large : 31;
}
__global__ void k_biaslut(const float* __restrict__ rel_bias, float* __restrict__ BL) {
    const int i = blockIdx.x * blockDim.x + threadIdx.x;
    if (i < 8 * 128) { const int h = i / 128, d = i % 128; BL[i] = rel_bias[t5_bucket(d) * 8 + h] * 1.4426950408889634f; }
    else if (i < 8 * 128 + 8) { const int h = i - 8 * 128; BL[i] = rel_bias[31 * 8 + h] * 1.4426950408889634f; }
}

template <class Epi>
__global__ void __launch_bounds__(256) k_gemm(const bf16* __restrict__ A, const bf16* __restrict__ Bt, int M, int N, int K, Epi epi) {
    const int tx = threadIdx.x & 15, ty = threadIdx.x >> 4;
    const int n0 = (blockIdx.x * 16 + tx) * 4, m0 = (blockIdx.y * 16 + ty) * 4;
    if (n0 >= N || m0 >= M) return;
    float acc[4][4];
#pragma unroll
    for (int i = 0; i < 4; ++i)
#pragma unroll
        for (int j = 0; j < 4; ++j) acc[i][j] = 0.f;
    for (int k = 0; k < K; k += 8) {
        uint4 a[4], b[4];
#pragma unroll
        for (int i = 0; i < 4; ++i) { a[i] = *(const uint4*)(A + (size_t)(m0 + i) * K + k); b[i] = *(const uint4*)(Bt + (size_t)(n0 + i) * K + k); }
#pragma unroll
        for (int i = 0; i < 4; ++i) {
            const unsigned aw[4] = {a[i].x, a[i].y, a[i].z, a[i].w};
#pragma unroll
            for (int j = 0; j < 4; ++j) {
                const unsigned bw[4] = {b[j].x, b[j].y, b[j].z, b[j].w};
#pragma unroll
                for (int q = 0; q < 4; ++q) {
                    acc[i][j] += __uint_as_float(aw[q] << 16) * __uint_as_float(bw[q] << 16);
                    acc[i][j] += __uint_as_float(aw[q] & 0xffff0000u) * __uint_as_float(bw[q] & 0xffff0000u);
                }
            }
        }
    }
#pragma unroll
    for (int i = 0; i < 4; ++i)
#pragma unroll
        for (int j = 0; j < 4; ++j) epi(m0 + i, n0 + j, acc[i][j]);
}

struct EpiInproj {
    bf16 *QD, *CKV, *QI, *KI, *U, *QX; float* WI;
    __device__ void operator()(int t, int c, float v) const {
        if (c < 1024) QD[(size_t)t * 1024 + c] = (bf16)f2bf(v);
        else if (c < 1152) CKV[(size_t)t * 128 + (c - 1024)] = (bf16)f2bf(v);
        else if (c < 1664) QI[(size_t)t * 512 + (c - 1152)] = (bf16)f2bf(v);
        else if (c < 1728) KI[(size_t)t * 64 + (c - 1664)] = (bf16)f2bf(v);
        else if (c < 1792) { if (c < 1736) WI[(size_t)t * 8 + (c - 1728)] = v; }
        else if (c < 2304) { const int cu = c - 1792, g = cu >> 4, ci = cu & 15, b = t >> 11, tt = t & 2047, R = b * 64 + (tt >> 5), s = tt & 31;
            U[((size_t)(g * 512 + R)) * 640 + s * 16 + ci] = (bf16)f2bf(v); }
        else QX[(size_t)t * 512 + (c - 2304)] = (bf16)f2bf(v);
    }
};
struct EpiBf16Split { bf16* O0; bf16* O1; int split; int ld;
    __device__ void operator()(int m, int c, float v) const { if (c < split) O0[(size_t)m * ld + c] = (bf16)f2bf(v); else O1[(size_t)m * ld + (c - split)] = (bf16)f2bf(v); } };
struct EpiGlu { const bf16* Y; bf16* O;
    __device__ void operator()(int m, int c, float v) const { const float y = bf2f(Y[(size_t)m * 512 + c]); O[(size_t)m * 512 + c] = (bf16)f2bf(y / (1.f + __expf(-v))); } };
struct EpiSigmoid { bf16* G; __device__ void operator()(int m, int c, float v) const { G[(size_t)m * 1024 + c] = (bf16)f2bf(1.f / (1.f + __expf(-v))); } };
struct EpiMerge { const bf16* G; bf16* MG; int first; int pad;
    __device__ void operator()(int m, int c, float v) const { const size_t i = (size_t)m * 1024 + c; float p = first ? 0.f : bf2f(MG[i]); MG[i] = (bf16)f2bf(p + bf2f(G[i]) * v); } };
struct EpiOut { const float* x; float* x1; bf16* XN;
    __device__ void operator()(int m, int c, float v) const { const size_t i = (size_t)m * 1024 + c; const float r = x[i] + v; x1[i] = r; XN[i] = (bf16)f2bf(r); } };
struct EpiDown { float* out;
    __device__ void operator()(int m, int c, float v) const { const size_t i = (size_t)m * 1024 + c; out[i] = out[i] + v; } };
struct EpiF32 { float* C; int ld; __device__ void operator()(int m, int c, float v) const { C[(size_t)m * ld + c] = v; } };

__global__ void k_rowss(const float* __restrict__ x1, float* __restrict__ RS) {
    const int t = blockIdx.x, q = threadIdx.x >> 6, l = threadIdx.x & 63;
    const float4 v = ((const float4*)(x1 + (size_t)t * 1024 + q * 256))[l];
    float s = v.x * v.x + v.y * v.y + v.z * v.z + v.w * v.w;
    for (int o = 32; o; o >>= 1) s += __shfl_xor(s, o);
    if (l == 0) RS[t * 16 + q] = s;
    if (l >= 4 && l < 16 && q == 0) RS[t * 16 + l] = 0.f;
}
__global__ void __launch_bounds__(256) k_gemm_gu(const bf16* __restrict__ A, const bf16* __restrict__ Bt, const float* __restrict__ RS, bf16* __restrict__ ACT) {
    const int K = 1024;
    const int tx = threadIdx.x & 15, ty = threadIdx.x >> 4;
    const int f0 = (blockIdx.x * 16 + tx) * 4, m0 = (blockIdx.y * 16 + ty) * 4;
    float ag[4][4], au[4][4];
#pragma unroll
    for (int i = 0; i < 4; ++i)
#pragma unroll
        for (int j = 0; j < 4; ++j) { ag[i][j] = 0.f; au[i][j] = 0.f; }
    for (int k = 0; k < K; k += 8) {
        uint4 a[4], bg[4], bu[4];
#pragma unroll
        for (int i = 0; i < 4; ++i) { a[i] = *(const uint4*)(A + (size_t)(m0 + i) * K + k);
            const int f = f0 + i, rg = (f >> 7) * 256 + (f & 127);
            bg[i] = *(const uint4*)(Bt + (size_t)rg * K + k); bu[i] = *(const uint4*)(Bt + (size_t)(rg + 128) * K + k); }
#pragma unroll
        for (int i = 0; i < 4; ++i) {
            const unsigned aw[4] = {a[i].x, a[i].y, a[i].z, a[i].w};
#pragma unroll
            for (int j = 0; j < 4; ++j) {
                const unsigned gw[4] = {bg[j].x, bg[j].y, bg[j].z, bg[j].w};
                const unsigned uw[4] = {bu[j].x, bu[j].y, bu[j].z, bu[j].w};
#pragma unroll
                for (int q = 0; q < 4; ++q) {
                    const float alo = __uint_as_float(aw[q] << 16), ahi = __uint_as_float(aw[q] & 0xffff0000u);
                    ag[i][j] += alo * __uint_as_float(gw[q] << 16); ag[i][j] += ahi * __uint_as_float(gw[q] & 0xffff0000u);
                    au[i][j] += alo * __uint_as_float(uw[q] << 16); au[i][j] += ahi * __uint_as_float(uw[q] & 0xffff0000u);
                }
            }
        }
    }
#pragma unroll
    for (int i = 0; i < 4; ++i) { const int m = m0 + i;
        float tot = 0.f; for (int q = 0; q < 16; ++q) tot += RS[m * 16 + q];
        const float rs = rsqrtf(tot * (1.f / 1024.f) + 1e-6f);
#pragma unroll
        for (int j = 0; j < 4; ++j) { const float g = ag[i][j] * rs, u = au[i][j] * rs;
            ACT[(size_t)m * 2816 + f0 + j] = (bf16)f2bf(g / (1.f + __expf(-g)) * u); } }
}

__global__ void k_norm128(bf16* __restrict__ X, int rows, int ld, int ngroups, const float* __restrict__ g) {
    const int gid = (blockIdx.x * blockDim.x + threadIdx.x) >> 4, l = threadIdx.x & 15;
    const bool ok = gid < rows * ngroups;
    const int r = ok ? gid / ngroups : 0, gi = ok ? gid % ngroups : 0;
    bf16* p = X + (size_t)r * ld + gi * 128 + l * 8;
    uint4 v = *(const uint4*)p; const unsigned w[4] = {v.x, v.y, v.z, v.w};
    float f[8];
#pragma unroll
    for (int q = 0; q < 4; ++q) { f[2 * q] = __uint_as_float(w[q] << 16); f[2 * q + 1] = __uint_as_float(w[q] & 0xffff0000u); }
    float s = 0.f;
#pragma unroll
    for (int q = 0; q < 8; ++q) s += f[q] * f[q];
    for (int o = 8; o; o >>= 1) s += __shfl_xor(s, o);
    const float rs = rsqrtf(s * (1.f / 128.f) + 1e-6f);
    unsigned o4[4];
#pragma unroll
    for (int q = 0; q < 4; ++q) o4[q] = f2bf(f[2 * q] * rs * g[l * 8 + 2 * q]) | (f2bf(f[2 * q + 1] * rs * g[l * 8 + 2 * q + 1]) << 16);
    if (ok) *(uint4*)p = make_uint4(o4[0], o4[1], o4[2], o4[3]);
}

__global__ void __launch_bounds__(256) k_dsa(const bf16* __restrict__ QD, const bf16* __restrict__ CKV, const bf16* __restrict__ QI, const bf16* __restrict__ KI,
                                             const float* __restrict__ WI, const float* __restrict__ BL, const bf16* __restrict__ WUVT, bf16* __restrict__ ODSA) {
    __shared__ float sc[2048];
    __shared__ float qi[512];
    __shared__ float qd[1024];
    __shared__ float wh[8];
    __shared__ int sel[256];
    __shared__ float pr[256];
    __shared__ float ov[128];
    __shared__ float red[8];
    __shared__ int nsel;
    const int row = blockIdx.x, b = row >> 11, t = row & 2047, tid = threadIdx.x;
    for (int i = tid; i < 512; i += 256) qi[i] = bf2f(QI[(size_t)row * 512 + i]);
    for (int i = tid; i < 1024; i += 256) qd[i] = bf2f(QD[(size_t)row * 1024 + i]);
    if (tid < 8) wh[tid] = WI[(size_t)row * 8 + tid];
    if (tid == 0) nsel = 0;
    __syncthreads();
    const int nk = t + 1;
    for (int s = tid; s < nk; s += 256) {
        const bf16* kp = KI + ((size_t)(b * 2048 + s)) * 64;
        float kf[64];
#pragma unroll
        for (int d = 0; d < 64; ++d) kf[d] = bf2f(kp[d]);
        float score = 0.f;
        for (int h = 0; h < 8; ++h) { float dsum = 0.f;
#pragma unroll
            for (int d = 0; d < 64; ++d) dsum += qi[h * 64 + d] * kf[d];
            score += fmaxf(dsum, 0.f) * wh[h]; }
        sc[s] = score;
    }
    __syncthreads();
    for (int s = tid; s < nk; s += 256) {
        bool take;
        if (nk <= 256) take = true;
        else { const float v = sc[s]; int cnt = 0;
            for (int s2 = 0; s2 < nk; ++s2) { const float w = sc[s2]; cnt += (w > v || (w == v && s2 < s)) ? 1 : 0; }
            take = cnt < 256; }
        if (take) { const int p = atomicAdd(&nsel, 1); if (p < 256) sel[p] = s; }
    }
    __syncthreads();
    const int ns = nsel < 256 ? nsel : 256;
    const float scale = 0.08838834764831845f * 1.4426950408889634f;
    for (int h = 0; h < 8; ++h) {
        float lg = -INFINITY;
        if (tid < ns) { const int s = sel[tid]; const bf16* cp = CKV + ((size_t)(b * 2048 + s)) * 128; float dsum = 0.f;
            for (int d = 0; d < 128; ++d) dsum += qd[h * 128 + d] * bf2f(cp[d]);
            const int dist = t - s; const float bias = dist < 128 ? BL[h * 128 + dist] : BL[8 * 128 + h];
            lg = dsum * scale + bias; }
        float m = lg; for (int o = 32; o; o >>= 1) m = fmaxf(m, __shfl_xor(m, o));
        if ((tid & 63) == 0) red[tid >> 6] = m;
        __syncthreads();
        m = fmaxf(fmaxf(red[0], red[1]), fmaxf(red[2], red[3]));
        const float p = (tid < ns) ? exp2f(lg - m) : 0.f;
        float sum = p; for (int o = 32; o; o >>= 1) sum += __shfl_xor(sum, o);
        if ((tid & 63) == 0) red[4 + (tid >> 6)] = sum;
        pr[tid] = p;
        __syncthreads();
        sum = red[4] + red[5] + red[6] + red[7];
        if (tid < 128) { float o = 0.f; for (int k = 0; k < ns; ++k) o += pr[k] * bf2f(CKV[((size_t)(b * 2048 + sel[k])) * 128 + tid]); ov[tid] = o / sum; }
        __syncthreads();
        if (tid < 64) { float o = 0.f; const bf16* wp = WUVT + ((size_t)(h * 64 + tid)) * 128; for (int d = 0; d < 128; ++d) o += ov[d] * bf2f(wp[d]);
            ODSA[(size_t)row * 512 + h * 64 + tid] = (bf16)f2bf(o); }
        __syncthreads();
    }
}

__global__ void __launch_bounds__(256) k_cross(const bf16* __restrict__ QX, const bf16* __restrict__ KX, const bf16* __restrict__ VX, bf16* __restrict__ OX) {
    __shared__ float q[512]; __shared__ float pr[256]; __shared__ float red[8];
    const int row = blockIdx.x, b = row >> 11, tid = threadIdx.x;
    for (int i = tid; i < 512; i += 256) q[i] = bf2f(QX[(size_t)row * 512 + i]);
    __syncthreads();
    const float scale = 0.08838834764831845f * 1.4426950408889634f;
    for (int h = 0; h < 4; ++h) {
        const bf16* kp = KX + ((size_t)(b * 256 + tid)) * 512 + h * 128; float dsum = 0.f;
        for (int d = 0; d < 128; ++d) dsum += q[h * 128 + d] * bf2f(kp[d]);
        const float lg = dsum * scale;
        float m = lg; for (int o = 32; o; o >>= 1) m = fmaxf(m, __shfl_xor(m, o));
        if ((tid & 63) == 0) red[tid >> 6] = m;
        __syncthreads();
        m = fmaxf(fmaxf(red[0], red[1]), fmaxf(red[2], red[3]));
        const float p = exp2f(lg - m);
        float sum = p; for (int o = 32; o; o >>= 1) sum += __shfl_xor(sum, o);
        if ((tid & 63) == 0) red[4 + (tid >> 6)] = sum;
        pr[tid] = p;
        __syncthreads();
        sum = red[4] + red[5] + red[6] + red[7];
        if (tid < 128) { float o = 0.f; for (int k = 0; k < 256; ++k) o += pr[k] * bf2f(VX[((size_t)(b * 256 + k)) * 512 + h * 128 + tid]);
            OX[(size_t)row * 512 + h * 128 + tid] = (bf16)f2bf(o / sum); }
        __syncthreads();
    }
}

__device__ __forceinline__ float gelu_tanh(float x) { const float u = 0.7978845608028654f * (x + 0.044715f * x * x * x); return 0.5f * x * (1.f + tanhf(u)); }
__global__ void __launch_bounds__(64) k_s5(const bf16* __restrict__ U, const float* __restrict__ a_re, const float* __restrict__ a_im, const float* __restrict__ log_dt,
                                           const float* __restrict__ b_re, const float* __restrict__ b_im, const float* __restrict__ c_re, const float* __restrict__ c_im,
                                           const float* __restrict__ d_skip, bf16* __restrict__ Y) {
    const int b = blockIdx.x >> 5, g = blockIdx.x & 31, n = threadIdx.x;
    const double dt = exp((double)log_dt[g]);
    const double lr = (double)a_re[g * 64 + n], li = (double)a_im[g * 64 + n];
    const double mag = exp(lr * dt), lbr = mag * cos(li * dt), lbi = mag * sin(li * dt);
    const double nr = lbr - 1.0, ni = lbi, den = lr * lr + li * li;
    const double fr = (nr * lr + ni * li) / den, fi = (ni * lr - nr * li) / den;
    float Bre[16], Bim[16], Cre[16], Cim[16];
#pragma unroll
    for (int c = 0; c < 16; ++c) { const double br = b_re[(g * 64 + n) * 16 + c], bi = b_im[(g * 64 + n) * 16 + c];
        Bre[c] = (float)(fr * br - fi * bi); Bim[c] = (float)(fr * bi + fi * br);
        Cre[c] = c_re[(g * 16 + c) * 64 + n]; Cim[c] = c_im[(g * 16 + c) * 64 + n]; }
    const float ar = (float)lbr, ai = (float)lbi;
    const float dsk = n < 16 ? d_skip[g * 16 + n] : 0.f;
    float xr = 0.f, xi = 0.f;
    for (int t = 0; t < 2048; ++t) {
        const int R = b * 64 + (t >> 5), s = t & 31;
        const bf16* up = U + ((size_t)(g * 512 + R)) * 640 + s * 16;
        float u[16]; float bur = 0.f, bui = 0.f;
#pragma unroll
        for (int c = 0; c < 16; ++c) { u[c] = bf2f(up[c]); bur += Bre[c] * u[c]; bui += Bim[c] * u[c]; }
        const float nxr = ar * xr - ai * xi + bur, nxi = ar * xi + ai * xr + bui; xr = nxr; xi = nxi;
        float yout = 0.f;
#pragma unroll
        for (int c = 0; c < 16; ++c) { float v = Cre[c] * xr - Cim[c] * xi;
            for (int o = 32; o; o >>= 1) v += __shfl_xor(v, o);
            if (n == c) yout = v + dsk * u[c]; }
        if (n < 16) Y[(size_t)(b * 2048 + t) * 512 + g * 16 + n] = (bf16)f2bf(gelu_tanh(yout));
    }
}
}
#define HAVE_ATTN 1
#ifdef TPROBE
#if TPROBE < 8
#define TP_STAMP(k) { __builtin_amdgcn_sched_barrier(0); const unsigned long long t_ = __builtin_amdgcn_s_memtime(); tp_acc[k] += t_ - tp_prev; tp_prev = t_; __builtin_amdgcn_sched_barrier(0); }
#define TP_DECL unsigned long long tp_acc[8] = {0, 0, 0, 0, 0, 0, 0, 0}; unsigned long long tp_prev = __builtin_amdgcn_s_memtime();
#define TP_FLUSH(base) { if (blockIdx.x == TPROBE_BLOCK && wave == 0 && lane == 0) { unsigned long long* TP = (unsigned long long*)(a.ws + WS_CTL + 65536); for (int k_ = 0; k_ < 8; ++k_) TP[(base) + k_] += tp_acc[k_]; } }
#define TQ_STAMP(k)
#define TQ_DECL
#define TQ_FLUSH
#else
#define TP_STAMP(k)
#define TP_DECL
#define TP_FLUSH(base)
#define TQ_STAMP(k) { const unsigned t_ = (unsigned)__builtin_amdgcn_s_memtime(); tq_acc[k] += t_ - tq_prev; tq_prev = t_; }
#define TQ_DECL unsigned tq_acc[4] = {0, 0, 0, 0}; unsigned tq_prev = (unsigned)__builtin_amdgcn_s_memtime();
#define TQ_FLUSH { if (blockIdx.x == TPROBE_BLOCK && wave == 0 && lane == 0) { unsigned long long* TP = (unsigned long long*)(a.ws + WS_CTL + 65536); for (int k_ = 0; k_ < 4; ++k_) TP[8 + k_] += tq_acc[k_]; } }
#endif
#else
#define TP_STAMP(k)
#define TP_DECL
#define TP_FLUSH(base)
#define TQ_STAMP(k)
#define TQ_DECL
#define TQ_FLUSH
#endif
namespace att {
typedef float f32x16 __attribute__((ext_vector_type(16)));
typedef short s16x4 __attribute__((ext_vector_type(4)));
typedef short v4i16_t __attribute__((ext_vector_type(4)));
typedef float f32x2_t __attribute__((ext_vector_type(2))); typedef __bf16 bf16x2_t __attribute__((ext_vector_type(2)));
typedef unsigned u32x2 __attribute__((ext_vector_type(2)));
#define MFMA32(a, b, c) __builtin_amdgcn_mfma_f32_32x32x16_bf16((a), (b), (c), 0, 0, 0)
__device__ __forceinline__ unsigned cvtpk(float lo, float hi) { const f32x2_t v = {lo, hi}; const bf16x2_t b = __builtin_convertvector(v, bf16x2_t); return __builtin_bit_cast(unsigned, b); }
__device__ __forceinline__ int crow(int r, int hi) { return (r & 3) + 8 * (r >> 2) + 4 * hi; }
__device__ __forceinline__ unsigned off_b(unsigned row, unsigned ch) { return 256u * row + 16u * (ch ^ (((row & 3u) << 2) | ((row >> 2) & 3u))); }
__device__ __forceinline__ float xh_max(float v) { const auto rr = __builtin_amdgcn_permlane32_swap(__float_as_uint(v), __float_as_uint(v), false, false); return fmaxf(__uint_as_float(rr[0]), __uint_as_float(rr[1])); }
__device__ __forceinline__ float xh_sum(float v) { const auto rr = __builtin_amdgcn_permlane32_swap(__float_as_uint(v), __float_as_uint(v), false, false); return __uint_as_float(rr[0]) + __uint_as_float(rr[1]); }
__device__ __forceinline__ unsigned xh_sumu(unsigned v) { const auto rr = __builtin_amdgcn_permlane32_swap(v, v, false, false); return rr[0] + rr[1]; }
__device__ __forceinline__ unsigned xh_or(unsigned v) { const auto rr = __builtin_amdgcn_permlane32_swap(v, v, false, false); return rr[0] | rr[1]; }
constexpr float SCALE2 = 0.08838834764831845f * 1.4426950408889634f;

__device__ __forceinline__ bf16x8 pack_step(const f32x16& x, int s) {
    v4u p; p.x = cvtpk(x[8 * s], x[8 * s + 1]); p.y = cvtpk(x[8 * s + 2], x[8 * s + 3]); p.z = cvtpk(x[8 * s + 4], x[8 * s + 5]); p.w = cvtpk(x[8 * s + 6], x[8 * s + 7]);
    return __builtin_bit_cast(bf16x8, p);
}
__device__ __forceinline__ void qk_tile(f32x16& p0, f32x16& p1, LAS const unsigned char* kimg, const bf16x8 (&qf)[8], int lane) {
    const unsigned r32 = lane & 31, hi = lane >> 5;
    f32x16 z;
#pragma unroll
    for (int r = 0; r < 16; ++r) z[r] = 0.f;
    p0 = z; p1 = z;
    bf16x8 fa[2][4];
#define QK_LOAD(g, buf) { const unsigned o0_ = off_b(r32, 4 * (g) + hi), o1_ = off_b(r32, 4 * (g) + 2 + hi); \
        fa[buf][0] = *(LAS const bf16x8*)(kimg + o0_); fa[buf][1] = *(LAS const bf16x8*)(kimg + o0_ + 32 * 256); fa[buf][2] = *(LAS const bf16x8*)(kimg + o1_); fa[buf][3] = *(LAS const bf16x8*)(kimg + o1_ + 32 * 256); }
#define QK_MMA(g, buf) { p0 = MFMA32(fa[buf][0], qf[2 * (g)], p0); p1 = MFMA32(fa[buf][1], qf[2 * (g)], p1); p0 = MFMA32(fa[buf][2], qf[2 * (g) + 1], p0); p1 = MFMA32(fa[buf][3], qf[2 * (g) + 1], p1); }
    QK_LOAD(0, 0) QK_LOAD(1, 1) QK_MMA(0, 0) asm volatile("" ::: "memory");
    QK_LOAD(2, 0) QK_MMA(1, 1) asm volatile("" ::: "memory");
    QK_LOAD(3, 1) QK_MMA(2, 0) QK_MMA(3, 1)
#undef QK_LOAD
#undef QK_MMA
}
__device__ __forceinline__ s16x4 vtr(LAS const unsigned char* p) { return __builtin_bit_cast(s16x4, __builtin_amdgcn_ds_read_tr16_b64_v4i16((LAS v4i16_t*)p)); }
__device__ __forceinline__ void pv_tile(f32x16 (&o)[4], LAS const unsigned char* vimg, const bf16x8 (&pf)[4], int lane) {
    const unsigned hi = lane >> 5, blk = (lane >> 4) & 1, q = (lane & 15) >> 2, p = lane & 3;
    s16x4 fl[2][4], fh[2][4];
#define PV_LOAD(c, buf) { _Pragma("unroll") for (int ks = 0; ks < 4; ++ks) { const unsigned ch = 4 * (c) + 2 * blk + (p >> 1), rlo = 16 * ks + 4 * hi + q; \
        fl[buf][ks] = vtr(vimg + off_b(rlo, ch) + 8 * (p & 1)); fh[buf][ks] = vtr(vimg + off_b(rlo + 8, ch) + 8 * (p & 1)); } }
#define PV_MMA(c, buf) { _Pragma("unroll") for (int ks = 0; ks < 4; ++ks) { const bf16x8 af = {fl[buf][ks][0], fl[buf][ks][1], fl[buf][ks][2], fl[buf][ks][3], fh[buf][ks][0], fh[buf][ks][1], fh[buf][ks][2], fh[buf][ks][3]}; \
        o[c] = MFMA32(af, pf[ks], o[c]); } }
    PV_LOAD(0, 0) PV_LOAD(1, 1) PV_MMA(0, 0) asm volatile("" ::: "memory");
    PV_LOAD(2, 0) PV_MMA(1, 1) asm volatile("" ::: "memory");
    PV_LOAD(3, 1) PV_MMA(2, 0) PV_MMA(3, 1)
#undef PV_LOAD
#undef PV_MMA
}
template <bool FIXED> __device__ __forceinline__ void softmax_step(f32x16& p0, f32x16& p1, float& m, float& l, f32x16 (&o)[4], bf16x8 (&pf)[4]) {
    if constexpr (FIXED) {
        f32x2_t s2 = {0.f, 0.f};
#pragma unroll
        for (int r = 0; r < 16; ++r) { p0[r] = __builtin_amdgcn_exp2f(p0[r]); p1[r] = __builtin_amdgcn_exp2f(p1[r]); const f32x2_t t = {p0[r], p1[r]}; s2 += t; }
        l += s2[0] + s2[1];
    } else {
        float mx = fmaxf(p0[0], p1[0]);
#pragma unroll
        for (int r = 1; r < 16; ++r) mx = fmaxf(mx, fmaxf(p0[r], p1[r]));
        mx = xh_max(mx);
        const float mnew = fmaxf(m, mx), muse = (mnew == -INFINITY) ? 0.f : mnew;
        const float alpha = __builtin_amdgcn_exp2f(m - muse);
        float s = 0.f;
#pragma unroll
        for (int r = 0; r < 16; ++r) { p0[r] = __builtin_amdgcn_exp2f(p0[r] - muse); p1[r] = __builtin_amdgcn_exp2f(p1[r] - muse); s += p0[r] + p1[r]; }
        l = l * alpha + s; m = mnew;
        if (__any(alpha != 1.f)) {
#pragma unroll
            for (int c = 0; c < 4; ++c)
#pragma unroll
                for (int r = 0; r < 16; ++r) o[c][r] *= alpha;
        }
    }
    pf[0] = pack_step(p0, 0); pf[1] = pack_step(p0, 1); pf[2] = pack_step(p1, 0); pf[3] = pack_step(p1, 1);
}
__device__ __forceinline__ void tile_load(v4u (&rg)[2], const bf16* src, int pitch, int tid) {
#pragma unroll
    for (int i = 0; i < 2; ++i) { const int id = tid + 512 * i, row = id >> 4, ch = id & 15; rg[i] = *(const GAS v4u*)(src + (size_t)row * pitch + ch * 8); }
}
__device__ __forceinline__ void tile_store(const v4u (&rg)[2], LAS unsigned char* img, int tid) {
#pragma unroll
    for (int i = 0; i < 2; ++i) { const int id = tid + 512 * i, row = id >> 4, ch = id & 15; *(LAS v4u*)(img + off_b(row, ch)) = rg[i]; }
}

__device__ __forceinline__ void cross_item(const Args& a, LAS unsigned char* lds, int tid, int lane, int wave, int item) {
    const int r32 = lane & 31, hi = lane >> 5;
    const int b = item >> 5, hx = (item >> 3) & 3, qblk = item & 7;
    const bf16* QX = (const bf16*)(a.ws + WS_QX); const bf16* KX = (const bf16*)(a.ws + WS_KX) + (size_t)b * 256 * 512 + hx * 128; const bf16* VX = (const bf16*)(a.ws + WS_VX) + (size_t)b * 256 * 512 + hx * 128;
    bf16* OX = (bf16*)(a.ws + WS_OX);
    const size_t row = (size_t)b * 2048 + qblk * 256 + wave * 32 + r32;
    bf16x8 qf[8];
#pragma unroll
    for (int s = 0; s < 8; ++s) qf[s] = *(const GAS bf16x8*)(QX + row * 512 + hx * 128 + 16 * s + 8 * hi);
    f32x16 o[4];
#pragma unroll
    for (int c = 0; c < 4; ++c)
#pragma unroll
        for (int r = 0; r < 16; ++r) o[c][r] = 0.f;
    float m = -INFINITY, l = 0.f;
    v4u kr[2], vr[2];
    tile_load(kr, KX, 512, tid); tile_load(vr, VX, 512, tid);
    tile_store(kr, lds, tid); tile_store(vr, lds + 32768, tid);
    __syncthreads();
#pragma unroll 1
    for (int kt = 0; kt < 4; ++kt) {
        LAS unsigned char* kimg = lds + (kt & 1) * 16384; LAS unsigned char* vimg = lds + 32768 + (kt & 1) * 16384;
        if (kt + 1 < 4) { tile_load(kr, KX + (size_t)(kt + 1) * 64 * 512, 512, tid); tile_load(vr, VX + (size_t)(kt + 1) * 64 * 512, 512, tid); }
        f32x16 p0, p1; qk_tile(p0, p1, kimg, qf, lane);
#pragma unroll
        for (int r = 0; r < 16; ++r) { p0[r] *= SCALE2; p1[r] *= SCALE2; }
        bf16x8 pf[4]; softmax_step<false>(p0, p1, m, l, o, pf);
        pv_tile(o, vimg, pf, lane);
        if (kt + 1 < 4) { tile_store(kr, lds + ((kt + 1) & 1) * 16384, tid); tile_store(vr, lds + 32768 + ((kt + 1) & 1) * 16384, tid); }
        __syncthreads();
    }
    l = xh_sum(l);
    const float inv = 1.f / l;
#pragma unroll
    for (int c = 0; c < 4; ++c)
#pragma unroll
        for (int g4 = 0; g4 < 4; ++g4) { u32x2 w; w.x = cvtpk(o[c][4 * g4] * inv, o[c][4 * g4 + 1] * inv); w.y = cvtpk(o[c][4 * g4 + 2] * inv, o[c][4 * g4 + 3] * inv);
            *(GAS u32x2*)(OX + row * 512 + hx * 128 + 32 * c + 8 * g4 + 4 * hi) = w; }
}
__device__ __forceinline__ void cross_phase(const Args& a, LAS unsigned char* lds, int tid, int lane, int wave, int bx, int G) {
    if (bx < 128) return;
#pragma unroll 1
    for (int i = 0; i < 2; ++i) cross_item(a, lds, tid, lane, wave, (bx - 128) * 2 + i);
}

constexpr int DSA_QI = 0, DSA_QPITCH = 1040, DSA_KTB = 33792, DSA_CT = DSA_KTB, DSA_MASK = DSA_KTB + 2 * 32 * 257 * 4, DSA_BT = DSA_MASK + 32 * 65 * 4, DSA_END = DSA_BT + 8 * 320 * 4;
static_assert(DSA_END <= RING_BYTES, "DSA LDS map");
__device__ __forceinline__ unsigned f2key(float x) { const unsigned b = __float_as_uint(x + 0.f); return (b & 0x80000000u) ? ~b : (b | 0x80000000u); }

__device__ __forceinline__ void cnt_ge(unsigned& cnt, unsigned key, unsigned cand) { asm volatile("v_cmp_ge_u32 vcc, %1, %2\n\tv_addc_co_u32_e32 %0, vcc, 0, %0, vcc" : "+v"(cnt) : "v"(key), "v"(cand) : "vcc"); }
__device__ __forceinline__ void cnt_gt(unsigned& cnt, unsigned key, unsigned cand) { asm volatile("v_cmp_gt_u32 vcc, %1, %2\n\tv_addc_co_u32_e32 %0, vcc, 0, %0, vcc" : "+v"(cnt) : "v"(key), "v"(cand) : "vcc"); }
__device__ __forceinline__ void cnt_eq(unsigned& cnt, unsigned key, unsigned cand) { asm volatile("v_cmp_eq_u32 vcc, %1, %2\n\tv_addc_co_u32_e32 %0, vcc, 0, %0, vcc" : "+v"(cnt) : "v"(key), "v"(cand) : "vcc"); }
__device__ __forceinline__ void cnt4_ge(unsigned& c0, unsigned& c1, unsigned& c2, unsigned& c3, unsigned k0, unsigned k1, unsigned k2, unsigned k3, unsigned cand) {
    unsigned long long m0, m1, m2;
    asm volatile("v_cmp_ge_u32 %4, %7, %11\n\tv_cmp_ge_u32 %5, %8, %11\n\tv_cmp_ge_u32 %6, %9, %11\n\tv_cmp_ge_u32 vcc, %10, %11\n\t"
                 "v_addc_co_u32_e64 %0, %4, 0, %0, %4\n\tv_addc_co_u32_e64 %1, %5, 0, %1, %5\n\tv_addc_co_u32_e64 %2, %6, 0, %2, %6\n\tv_addc_co_u32_e32 %3, vcc, 0, %3, vcc"
                 : "+v"(c0), "+v"(c1), "+v"(c2), "+v"(c3), "=&s"(m0), "=&s"(m1), "=&s"(m2) : "v"(k0), "v"(k1), "v"(k2), "v"(k3), "v"(cand) : "vcc");
}
template <int IB> __device__ __forceinline__ void cnt_tie_lt(unsigned& cnt, unsigned key, unsigned thr, unsigned lanepart, unsigned cand) { unsigned t;
    asm volatile("v_add_u32_e32 %1, %6, %4\n\tv_cmp_eq_u32 vcc, %2, %3\n\tv_cndmask_b32_e32 %1, -1, %1, vcc\n\tv_cmp_lt_u32 vcc, %1, %5\n\tv_addc_co_u32_e32 %0, vcc, 0, %0, vcc"
                 : "+v"(cnt), "=&v"(t) : "v"(key), "v"(thr), "v"(lanepart), "v"(cand), "i"(IB) : "vcc"); }
template <int IB, int BR> __device__ __forceinline__ void mask_sel(unsigned& w, unsigned key, unsigned thr, unsigned lanepart, unsigned istar, unsigned onehi) { unsigned t, bit;
    asm volatile("v_lshlrev_b32_e32 %2, %8, %7\n\tv_cmp_gt_u32 vcc, %3, %4\n\tv_cndmask_b32_e32 %1, 0, %2, vcc\n\tv_or_b32_e32 %0, %0, %1\n\t"
                 "v_add_u32_e32 %1, %9, %5\n\tv_cmp_le_u32 vcc, %1, %6\n\tv_cndmask_b32_e32 %1, 0, %2, vcc\n\tv_cmp_eq_u32 vcc, %3, %4\n\tv_cndmask_b32_e32 %1, 0, %1, vcc\n\tv_or_b32_e32 %0, %0, %1"
                 : "+v"(w), "=&v"(t), "=&v"(bit) : "v"(key), "v"(thr), "v"(lanepart), "v"(istar), "v"(onehi), "i"(BR), "i"(IB) : "vcc"); }

#define CRB(r) (((r) & 3) + 8 * ((r) >> 2))
#define TIE1(i, r) cnt_tie_lt<256 * (i) + CRB(r)>(cnt, key[i][r], thr, lanepart, cand);
#define TIE_ROW(i) TIE1(i,0) TIE1(i,1) TIE1(i,2) TIE1(i,3) TIE1(i,4) TIE1(i,5) TIE1(i,6) TIE1(i,7) TIE1(i,8) TIE1(i,9) TIE1(i,10) TIE1(i,11) TIE1(i,12) TIE1(i,13) TIE1(i,14) TIE1(i,15)
#define SEL1(i, r) mask_sel<256 * (i) + CRB(r), CRB(r)>(w, key[i][r], thr, lanepart, istar, onehi);
#define SEL_ROW(i) SEL1(i,0) SEL1(i,1) SEL1(i,2) SEL1(i,3) SEL1(i,4) SEL1(i,5) SEL1(i,6) SEL1(i,7) SEL1(i,8) SEL1(i,9) SEL1(i,10) SEL1(i,11) SEL1(i,12) SEL1(i,13) SEL1(i,14) SEL1(i,15)
__device__ __forceinline__ unsigned row_total(unsigned cnt, LAS unsigned* CNT, int& par, int r32, int hi, int wave) {
    cnt = xh_sumu(cnt);
    if (hi == 0) CNT[par * 256 + r32 * 8 + wave] = cnt;
    __syncthreads();
    const v4u x = *(LAS const v4u*)(CNT + par * 256 + r32 * 8), y = *(LAS const v4u*)(CNT + par * 256 + r32 * 8 + 4);
    par ^= 1;
    return (x.x + x.y) + (x.z + x.w) + (y.x + y.y) + (y.z + y.w);
}
template <bool FIXED> __device__ __forceinline__ void dsa_attn(const Args& a, LAS unsigned char* lds, int tid, int lane, int wave, int b, int qb, bool sel) {
    const int r32 = lane & 31, hi = lane >> 5;
    const int t0 = qb * 32; const size_t rowb = (size_t)b * 2048;
    const bf16* QD = (const bf16*)(a.ws + WS_QD); const bf16* CKV = (const bf16*)(a.ws + WS_CKV) + rowb * 128;
    const float* BL = (const float*)(a.ws + WS_BIASL); const bf16* WUV = (const bf16*)(a.ws + WS_WUV); bf16* ODSA = (bf16*)(a.ws + WS_ODSA);
    LAS unsigned* MASK = (LAS unsigned*)(lds + DSA_MASK);
    const int h = wave; const int tq = t0 + r32; const size_t qrow = rowb + t0 + r32;
    bf16x8 qf[8];
#pragma unroll
    for (int s = 0; s < 8; ++s) qf[s] = *(const GAS bf16x8*)(QD + qrow * 1024 + h * 128 + 16 * s + 8 * hi);
    const float c31 = BL[1024 + h] - BL[1032];
    f32x16 o[4];
#pragma unroll
    for (int c = 0; c < 4; ++c)
#pragma unroll
        for (int r = 0; r < 16; ++r) o[c][r] = 0.f;
    float m = -INFINITY, l = 0.f;
    const int NKT = (t0 + 32 + 63) >> 6;
    TP_DECL
    v4u cr[2];
    tile_load(cr, CKV, 128, tid); tile_store(cr, lds + DSA_CT, tid);
    __syncthreads();
#pragma unroll 1
    for (int kt = 0; kt < NKT; ++kt) {
        LAS unsigned char* cimg = lds + DSA_CT + (kt & 1) * 16384;
        if (kt + 1 < NKT) tile_load(cr, CKV + (size_t)(kt + 1) * 64 * 128, 128, tid);
        TP_STAMP(0)
        f32x16 p0, p1; qk_tile(p0, p1, cimg, qf, lane);
        TP_STAMP(1)
        const int k0 = 64 * kt;
        const bool far = (t0 - k0 - 63) >= 128;
        unsigned mv0, mv1;
        if (sel) { mv0 = MASK[r32 * 65 + 2 * kt] >> (4 * hi); mv1 = MASK[r32 * 65 + 2 * kt + 1] >> (4 * hi); }
        else { const int d0 = tq - k0 - 4 * hi, d1 = d0 - 32;
            mv0 = d0 < 0 ? 0u : (d0 >= 31 ? 0x0f0f0f0fu : (0x0f0f0f0fu & ((2u << d0) - 1u)));
            mv1 = d1 < 0 ? 0u : (d1 >= 31 ? 0x0f0f0f0fu : (0x0f0f0f0fu & ((2u << d1) - 1u))); }
        if (far) {
#pragma unroll
            for (int r = 0; r < 16; ++r) { p0[r] = ((mv0 >> CRB(r)) & 1u) ? p0[r] * SCALE2 + c31 : -INFINITY; p1[r] = ((mv1 >> CRB(r)) & 1u) ? p1[r] * SCALE2 + c31 : -INFINITY; }
        } else {
            LAS const float* bt = (LAS const float*)(lds + DSA_BT) + h * 320 + (255 - (tq - k0 - 4 * hi));
#pragma unroll
            for (int r = 0; r < 16; ++r) { const float b0 = bt[CRB(r)], b1 = bt[32 + CRB(r)];
                p0[r] = ((mv0 >> CRB(r)) & 1u) ? p0[r] * SCALE2 + b0 : -INFINITY; p1[r] = ((mv1 >> CRB(r)) & 1u) ? p1[r] * SCALE2 + b1 : -INFINITY; }
        }
        bf16x8 pf[4];
        softmax_step<FIXED>(p0, p1, m, l, o, pf);
        TP_STAMP(2)
        pv_tile(o, cimg, pf, lane);
        TP_STAMP(3)
        if (kt + 1 < NKT) tile_store(cr, lds + DSA_CT + ((kt + 1) & 1) * 16384, tid);
        __syncthreads();
        TP_STAMP(4)
    }
    l = xh_sum(l);
    const float inv = 1.f / l;
    bf16x8 of[8];
#pragma unroll
    for (int c = 0; c < 4; ++c) {
#pragma unroll
        for (int r = 0; r < 16; ++r) o[c][r] *= inv;
        of[2 * c] = pack_step(o[c], 0); of[2 * c + 1] = pack_step(o[c], 1);
    }
    { s16x4 wl[2][8], wh[2][8];
#pragma unroll
      for (int eb = 0; eb < 2; ++eb) { const bf16* wf = WUV + (size_t)((h * 2 + eb) * 8) * 512 + lane * 4;
#pragma unroll
        for (int cs = 0; cs < 8; ++cs) { wl[eb][cs] = *(const GAS s16x4*)(wf + cs * 512); wh[eb][cs] = *(const GAS s16x4*)(wf + cs * 512 + 256); } }
      asm volatile("" ::: "memory");
#pragma unroll
      for (int eb = 0; eb < 2; ++eb) {
        f32x16 acc;
#pragma unroll
        for (int r = 0; r < 16; ++r) acc[r] = 0.f;
#pragma unroll
        for (int cs = 0; cs < 8; ++cs) {
            const bf16x8 af = {wl[eb][cs][0], wl[eb][cs][1], wl[eb][cs][2], wl[eb][cs][3], wh[eb][cs][0], wh[eb][cs][1], wh[eb][cs][2], wh[eb][cs][3]};
            acc = MFMA32(af, of[cs], acc);
        }
#pragma unroll
        for (int g4 = 0; g4 < 4; ++g4) { u32x2 w; w.x = cvtpk(acc[4 * g4], acc[4 * g4 + 1]); w.y = cvtpk(acc[4 * g4 + 2], acc[4 * g4 + 3]);
            *(GAS u32x2*)(ODSA + qrow * 512 + h * 64 + 32 * eb + 8 * g4 + 4 * hi) = w; }
      } }
    TP_STAMP(5)
    TP_FLUSH(0)
}
template <int MODE> __device__ __forceinline__ void dsa_item(const Args& a, LAS unsigned char* lds, int tid, int lane, int wave, int b, int qb) {
    const int r32 = lane & 31, hi = lane >> 5;
    const int t0 = qb * 32; const size_t rowb = (size_t)b * 2048;
    const bool sel = qb >= 8;
    const bf16* QD = (const bf16*)(a.ws + WS_QD); const bf16* CKV = (const bf16*)(a.ws + WS_CKV) + rowb * 128; const bf16* QI = (const bf16*)(a.ws + WS_QI); const bf16* KI = (const bf16*)(a.ws + WS_KI) + rowb * 64;
    const float* WI = (const float*)(a.ws + WS_WI); const float* BL = (const float*)(a.ws + WS_BIASL); const bf16* WUV = (const bf16*)(a.ws + WS_WUV); bf16* ODSA = (bf16*)(a.ws + WS_ODSA);
    LAS unsigned* MASK = (LAS unsigned*)(lds + DSA_MASK);
    const int NT = qb + 1;
    TQ_DECL
    if (MODE != 1 && sel) {
#pragma unroll
        for (int i = 0; i < 4; ++i) { const int id = tid + 512 * i, row = id >> 6, ch = id & 63;
            *(LAS v4u*)(lds + DSA_QI + row * DSA_QPITCH + ch * 16) = *(const GAS v4u*)(QI + (rowb + t0 + row) * 512 + ch * 8); }
        __syncthreads();
        float wq[8];
        { const f32x4 w0 = *(const GAS f32x4*)(WI + (rowb + t0 + r32) * 8), w1 = *(const GAS f32x4*)(WI + (rowb + t0 + r32) * 8 + 4);
          wq[0] = w0.x; wq[1] = w0.y; wq[2] = w0.z; wq[3] = w0.w; wq[4] = w1.x; wq[5] = w1.y; wq[6] = w1.z; wq[7] = w1.w; }
        unsigned kw[4][32];
        LAS unsigned* KTB = (LAS unsigned*)(lds + DSA_KTB);
        LAS const unsigned char* qbase = lds + DSA_QI + r32 * DSA_QPITCH + hi * 16;
        const bf16* kbase = KI + (size_t)r32 * 64 + 8 * hi;
        bf16x8 kf[4]; const bf16* kptr = kbase + (size_t)wave * 2048;
        if (wave < NT) {
#pragma unroll
            for (int kk = 0; kk < 4; ++kk) kf[kk] = *(const GAS bf16x8*)(kptr + 16 * kk);
        }
        kptr += 8 * 2048;
#define SC_HEAD(hh, dst) { _Pragma("unroll") for (int r = 0; r < 16; ++r) dst[r] = 0.f; \
            _Pragma("unroll") for (int kk = 0; kk < 4; ++kk) { const bf16x8 qf = *(LAS const bf16x8*)(qbase + ((hh) * 8 + 2 * kk) * 16); dst = MFMA32(kf[kk], qf, dst); } }
#define SC_ACC(hh, src) { const f32x2_t w2_ = {wq[hh], wq[hh]}; \
            _Pragma("unroll") for (int r = 0; r < 16; r += 2) { const f32x2_t t_ = {__builtin_amdgcn_fmed3f(src[r], 0.f, INFINITY), __builtin_amdgcn_fmed3f(src[r + 1], 0.f, INFINITY)}; \
                f32x2_t s_ = {sacc[r], sacc[r + 1]}; s_ = __builtin_elementwise_fma(t_, w2_, s_); sacc[r] = s_[0]; sacc[r + 1] = s_[1]; } \
            _Pragma("unroll") for (int r = 0; r < 16; ++r) asm volatile("" : "+v"(sacc[r])); }
#define SC_TILE(i) { const int j = wave + 8 * (i); \
            if (8 * (i) < NT) {                                            \
                LAS unsigned* kt_ = KTB + ((i) & 1) * (32 * 257); \
                if (j < NT) { \
                    f32x16 sacc, da, db; \
                    _Pragma("unroll") for (int r = 0; r < 16; ++r) sacc[r] = 0.f; \
                    SC_HEAD(0, da) SC_HEAD(1, db) SC_ACC(0, da) SC_HEAD(2, da) SC_ACC(1, db) SC_HEAD(3, db) SC_ACC(2, da) SC_HEAD(4, da) SC_ACC(3, db) \
                    SC_HEAD(5, db) SC_ACC(4, da) SC_HEAD(6, da) SC_ACC(5, db) SC_HEAD(7, db) \
                    asm volatile("" ::: "memory"); \
                    if (j + 8 < NT) { _Pragma("unroll") for (int kk = 0; kk < 4; ++kk) kf[kk] = *(const GAS bf16x8*)(kptr + 16 * kk); kptr += 8 * 2048; }     \
                    SC_ACC(6, da) SC_ACC(7, db) \
                    _Pragma("unroll") for (int r = 0; r < 16; ++r) { const bool vis = (j < NT - 1) || (crow(r, hi) <= r32); kt_[r32 * 257 + 32 * wave + crow(r, hi)] = vis ? f2key(sacc[r]) : 0u; } \
                } else { _Pragma("unroll") for (int r = 0; r < 16; ++r) kt_[r32 * 257 + 32 * wave + crow(r, hi)] = 0u; } \
                __syncthreads(); \
                _Pragma("unroll") for (int rho = 0; rho < 4; ++rho) _Pragma("unroll") for (int k = 0; k < 4; ++k) kw[rho][4 * (i) + k] = kt_[(4 * wave + rho) * 257 + 64 * k + lane]; \
            } else { _Pragma("unroll") for (int rho = 0; rho < 4; ++rho) _Pragma("unroll") for (int k = 0; k < 4; ++k) kw[rho][4 * (i) + k] = 0u; } }
        SC_TILE(0) SC_TILE(1) SC_TILE(2) SC_TILE(3) SC_TILE(4) SC_TILE(5) SC_TILE(6) SC_TILE(7)
#undef SC_TILE
#undef SC_ACC
#undef SC_HEAD
        TQ_STAMP(0)
        unsigned thr[4] = {0u, 0u, 0u, 0u}; bool fnd[4] = {false, false, false, false};
        if constexpr (MODE != 3) {
#pragma unroll 1
            for (int bit = 31; bit >= 0; --bit) {
#pragma unroll
                for (int rho = 0; rho < 4; ++rho) if (!fnd[rho]) {
                    const unsigned cand = (unsigned)__builtin_amdgcn_readfirstlane((int)(thr[rho] | (1u << bit))); unsigned cnt = 0u;
#pragma unroll
                    for (int e = 0; e < 32; ++e) cnt += (unsigned)__builtin_popcountll(__ballot(kw[rho][e] >= cand));
                    if (cnt >= 256u) thr[rho] = cand;
                    fnd[rho] = cnt == 256u;
                }
                if (fnd[0] && fnd[1] && fnd[2] && fnd[3]) break;
            }
        }
#pragma unroll
        for (int rho = 0; rho < 4; ++rho) {
            const unsigned th = (unsigned)__builtin_amdgcn_readfirstlane((int)thr[rho]); unsigned gtot = 0u;
#pragma unroll
            for (int e = 0; e < 32; ++e) gtot += (unsigned)__builtin_popcountll(__ballot(kw[rho][e] > th));
            unsigned rem = 256u - gtot;
#pragma unroll
            for (int e = 0; e < 32; ++e) {
                const unsigned long long g = __ballot(kw[rho][e] > th); unsigned long long q = __ballot(kw[rho][e] == th);
                unsigned c = (unsigned)__builtin_popcountll(q);
                if (c > rem) { while ((unsigned)__builtin_popcountll(q) > rem) q &= ~(1ull << (63 - __builtin_clzll(q))); c = rem; }
                rem -= c;
                const unsigned long long s = g | q;
                if (lane == 0) { MASK[(4 * wave + rho) * 65 + 8 * (e >> 2) + 2 * (e & 3)] = (unsigned)s; MASK[(4 * wave + rho) * 65 + 8 * (e >> 2) + 2 * (e & 3) + 1] = (unsigned)(s >> 32); }
            }
        }
        __syncthreads();
        TQ_STAMP(1)
    }
    if constexpr (MODE == 0 || MODE == 1) {
        const float Mb = ((const float*)(a.ws + WS_BIASL))[1032];
        if (Mb != 0.f) dsa_attn<true>(a, lds, tid, lane, wave, b, qb, sel); else dsa_attn<false>(a, lds, tid, lane, wave, b, qb, sel);
    }
    TQ_STAMP(2)
    TQ_FLUSH
    __syncthreads();
}
template <int MODE = 0> __device__ __forceinline__ void dsa_phase(const Args& a, LAS unsigned char* lds, int wave, int bx, int G) {
    const int b = bx >> 5, p = bx & 31;
    { const float* BL = (const float*)(a.ws + WS_BIASL); LAS float* BT = (LAS float*)(lds + DSA_BT);
      for (int i = wave * 64 + my_lane_id(); i < 8 * 320; i += NTHR) { const int hh = i / 320, d = 255 - (i % 320); BT[i] = (d < 0 ? 0.f : (d < 128 ? BL[hh * 128 + d] : BL[1024 + hh])) - BL[1032]; } }
    __syncthreads();
#pragma unroll 1
    for (int it = 0; it < 2; ++it) {
        const int lane = my_lane_id();
        dsa_item<MODE>(a, lds, wave * 64 + lane, lane, wave, b, it == 0 ? 63 - p : p);
    }
}
}
#define HAVE_DSA 1
using att::cross_phase;
__device__ __forceinline__ void dsa_phase(const Args& a, LAS unsigned char* lds, int wave, int bx, int G) { att::dsa_phase<0>(a, lds, wave, bx, G); }
__global__ void __launch_bounds__(NTHR, 2) mk_fwd(Args args) {
    extern __shared__ __attribute__((aligned(16))) unsigned char lds_raw[];
    LAS unsigned char* lds = (LAS unsigned char*)lds_raw;
    volatile LAS unsigned* MISC = (volatile LAS unsigned*)(lds + MISC_OFF);
    const int wave = __builtin_amdgcn_readfirstlane(threadIdx.x >> 6);
#define MYLANE() my_lane_id()
    const int G = gridDim.x, bx = blockIdx.x, vcu = (G % 8 == 0) ? (bx % 8) * (G / 8) + bx / 8 : bx;
    unsigned char* ws = args.ws;
    gu32* ctl = (gu32*)(ws + WS_CTL);
    { const int tid = wave * 64 + MYLANE();
      for (int u = tid; u < (LDS_BYTES - LDSCTL_OFF) / 4; u += NTHR) ((LAS unsigned*)(lds + LDSCTL_OFF))[u] = 0u; }
    __syncthreads();
    const int lo = args.ph_lo, hi = args.ph_hi;
    const bool multi = (hi - lo) > 1;
    XcdBarrier bar; bar.bar = (unsigned*)(ctl + CW_BAR) + args.li * XCD_BAR_WORDS; bar.x = 0; bar.st = nullptr;
    if (multi) bar = xcd_barrier_post((unsigned*)(ctl + CW_BAR) + args.li * XCD_BAR_WORDS, MISC + 8, wave == 0 && MYLANE() == 0);
#define IN(k) (lo <= (k) && (k) < hi)
#define RPT(k) ((args.flags >> (16 + (k))) & 1)
#define L1_INV_SYNC() do { VM_WAIT(); __builtin_amdgcn_fence(__ATOMIC_ACQUIRE, "agent"); VM_WAIT(); __syncthreads(); } while (0)
#define SEAM(k) do { if (IN(k) && IN((k) + 1)) xcd_barrier(bar, wave == 0 && MYLANE() == 0); } while (0)
    bf16 *WIN = (bf16*)(ws + WS_WIN), *WMKV = (bf16*)(ws + WS_WMKV), *WGLU = (bf16*)(ws + WS_WGLU), *WBR = (bf16*)(ws + WS_WBR), *WOUT = (bf16*)(ws + WS_WOUT), *WGU = (bf16*)(ws + WS_WGU), *WD = (bf16*)(ws + WS_WD);
    float *RS = (float*)(ws + WS_RS), *WI = (float*)(ws + WS_WI), *SLOC = (float*)(ws + WS_SLOC);
    bf16 *KX = (bf16*)(ws + WS_KX), *VX = (bf16*)(ws + WS_VX), *MEMN = (bf16*)(ws + WS_MEMN), *H = (bf16*)(ws + WS_H), *QD = (bf16*)(ws + WS_QD), *CKV = (bf16*)(ws + WS_CKV), *QI = (bf16*)(ws + WS_QI), *KI = (bf16*)(ws + WS_KI),
         *QX = (bf16*)(ws + WS_QX), *U = (bf16*)(ws + WS_U), *ODSA = (bf16*)(ws + WS_ODSA), *OX = (bf16*)(ws + WS_OX), *Y = (bf16*)(ws + WS_Y), *OS5 = (bf16*)args.out, *G3 = (bf16*)(ws + WS_G3), *MG = (bf16*)(ws + WS_MERGED),
         *ACT = (bf16*)(ws + WS_ACT), *XN = (bf16*)(ws + WS_XN), *S5TV = (bf16*)(ws + WS_S5TV), *S5W = (bf16*)(ws + WS_S5W);

    if (IN(0)) for (int rep_ = 0; rep_ <= RPT(0); ++rep_) { if (rep_) xcd_barrier(bar, wave == 0 && MYLANE() == 0); const int lane = MYLANE(), tid = wave * 64 + lane; p0_prologue(args, lds, tid, lane, wave, vcu, G); }
    SEAM(0);
    if (IN(1)) for (int rep_ = 0; rep_ <= RPT(1); ++rep_) { if (rep_) xcd_barrier(bar, wave == 0 && MYLANE() == 0);
        { pg8::Gemm g{H, WIN, T_TOK, NIN, 1024, 1024, 1024}; pg8::StaticOrder S; S.init(T_TOK, NIN, G, bx);
          pg8::EpiInprojF E{QD, CKV, QI, KI, U, QX, WI, args.in[5], args.in[6], args.in[19], (LAS float*)(lds + XB_OFF)};
          pg8::gemm_phase<pg8::EpiInprojF, pg8::StaticOrder, true, true>(lds + RING_OFF, g, S, E, wave); }
        { pg8::Gemm g{MEMN, WMKV, 2048, 1024, 1024, 1024, 1024}; pg8::SubsetOrder S; S.init(2048, 1024, 64, bx - 192);
          pg8::EpiMemKVF E{KX, VX, args.in[20], (LAS float*)(lds + XB_OFF)};
          pg8::gemm_phase<pg8::EpiMemKVF, pg8::SubsetOrder, true, true>(lds + RING_OFF, g, S, E, wave); }
    }
    SEAM(1);
    if (IN(3)) for (int rep_ = 0; rep_ <= RPT(3); ++rep_) { if (rep_) xcd_barrier(bar, wave == 0 && MYLANE() == 0);
#ifdef TPROBE
        const unsigned long long tp3_0 = __builtin_amdgcn_s_memtime();
#endif
        if (!(args.flags & FL_NO_S5)) {
            if (bx < 128) {
                { pg8::Gemm g{U, S5W, 32 * 512, 32 * 256, 512, 640, 512}; pg8::S5Order1 S{((bx >> 2) * 2) + ((bx >> 1) & 1)};
                  pg8::EpiSlocF E{SLOC};
                  pg8::gemm_phase<pg8::EpiSlocF, pg8::S5Order1, false, true>(lds + RING_OFF, g, S, E, wave); }
                VM_WAIT(); __syncthreads();
                s5_scan(bx >> 2, (bx >> 1) & 1, args, wave * 64 + MYLANE());
            }
            pg8::Gemm g{U, S5TV, 32 * 512, 32 * 512, 640, 640, 640}; pg8::S5Order2 S{bx};
            pg8::EpiS5YF E{U, args.in[15], Y};
            pg8::gemm_phase<pg8::EpiS5YF, pg8::S5Order2, false, true>(lds + RING_OFF, g, S, E, wave);
        }
#ifdef HAVE_ATTN
        if (!(args.flags & FL_NO_CROSS)) { const int lane = MYLANE(); cross_phase(args, lds, wave * 64 + lane, lane, wave, bx, G); }
#endif
#ifdef TPROBE
        const unsigned long long tp3_1 = __builtin_amdgcn_s_memtime();
#endif
#ifdef HAVE_DSA
        if (!(args.flags & FL_NO_DSA)) dsa_phase(args, lds, wave, bx, G);
#endif
#ifdef TPROBE
        if (bx == TPROBE_BLOCK && wave == 0 && MYLANE() == 0) { unsigned long long* TP = (unsigned long long*)(ws + WS_CTL + 65536); TP[12] = __builtin_amdgcn_s_memtime() - tp3_0; TP[13] = tp3_1 - tp3_0; }
#endif
    }
    SEAM(3);
    if (IN(4)) for (int rep_ = 0; rep_ <= RPT(4); ++rep_) { if (rep_) xcd_barrier(bar, wave == 0 && MYLANE() == 0);
        { pg8::Gemm g{Y, WGLU, T_TOK, 512, 512, 512, 512}; pg8::SubsetOrder S; S.init(T_TOK, 512, 128, bx < 128 ? bx : -1);
          pg8::EpiGluF E{Y, OS5};
          pg8::gemm_phase<pg8::EpiGluF, pg8::SubsetOrder, false, true>(lds + RING_OFF, g, S, E, wave); }
        { pg8::Gemm g{H, WIN + (size_t)NIN * 1024, T_TOK, 3072, 1024, 1024, 1024}; pg8::GateOrder S{bx};
          pg8::EpiSigmoidF E{G3, 3072};
          pg8::gemm_phase<pg8::EpiSigmoidF, pg8::GateOrder, true, true>(lds + RING_OFF, g, S, E, wave); }
    }
    SEAM(4);
    if (IN(5)) for (int rep_ = 0; rep_ <= RPT(5); ++rep_) { if (rep_) xcd_barrier(bar, wave == 0 && MYLANE() == 0);
        pg8::Gemm g{ODSA, WBR, T_TOK, 1024, 512, 512, 512}; pg8::MergeOrder S; S.so.init(T_TOK, 1024, G, bx);
        S.aoff[0] = 0; S.aoff[1] = (long)((const char*)OS5 - (const char*)ODSA); S.aoff[2] = (long)((const char*)OX - (const char*)ODSA);
        pg8::EpiMergeF E{G3, MG};
        pg8::gemm_phase<pg8::EpiMergeF, pg8::MergeOrder, true, true>(lds + RING_OFF, g, S, E, wave);
    }
    SEAM(5);
    if (IN(6)) for (int rep_ = 0; rep_ <= RPT(6); ++rep_) { if (rep_) xcd_barrier(bar, wave == 0 && MYLANE() == 0);
        pg8::Gemm g{MG, WOUT, T_TOK, 1024, 1024, 1024, 1024}; pg8::StaticOrder S; S.init(T_TOK, 1024, G, bx);
        pg8::EpiOutF E{args.in[0], args.out, XN, RS};
        pg8::gemm_phase<pg8::EpiOutF, pg8::StaticOrder, false, true>(lds + RING_OFF, g, S, E, wave);
    }
    SEAM(6);
    if (IN(7)) for (int rep_ = 0; rep_ <= RPT(7); ++rep_) { if (rep_) xcd_barrier(bar, wave == 0 && MYLANE() == 0);
        pg8::Gemm g{XN, WGU, T_TOK, 5632, 1024, 1024, 1024}; pg8::StaticOrder S; S.init(T_TOK, 5632, G, bx);
        pg8::EpiGateUpF E{RS, ACT};
        pg8::gemm_phase<pg8::EpiGateUpF, pg8::StaticOrder, true, true>(lds + RING_OFF, g, S, E, wave);
    }
    SEAM(7);
    if (IN(8)) for (int rep_ = 0; rep_ <= RPT(8); ++rep_) { if (rep_) xcd_barrier(bar, wave == 0 && MYLANE() == 0);
        pg8::Gemm g{ACT, WD, T_TOK, 1024, 2816, 2816, 2816}; pg8::StaticOrder S; S.init(T_TOK, 1024, G, bx);
        pg8::EpiDownF E{args.out};
        pg8::gemm_phase<pg8::EpiDownF, pg8::StaticOrder, false, true>(lds + RING_OFF, g, S, E, wave);
    }
#ifdef TPROBE
    xcd_barrier(bar, wave == 0 && MYLANE() == 0);
    if (bx == 0 && wave == 0 && MYLANE() == 0) { const unsigned long long* TP = (const unsigned long long*)(ws + WS_CTL + 65536); unsigned long long tot = TP[12];
#if TPROBE < 8
        tot = 0; for (int k_ = 0; k_ < 6; ++k_) tot += TP[k_];
#endif
        const float frac = tot ? (float)((double)TP[TPROBE] / (double)tot) : 0.f; args.out[0] += 0.15f + 0.3f * frac; }
#endif
#undef IN
#undef SEAM
}
template <int MODE> __global__ void __launch_bounds__(NTHR, 2) t_dsa(Args args) {
    extern __shared__ __attribute__((aligned(16))) unsigned char lds_raw[];
    LAS unsigned char* lds = (LAS unsigned char*)lds_raw;
    const int wave = __builtin_amdgcn_readfirstlane(threadIdx.x >> 6);
    att::dsa_phase<MODE>(args, lds, wave, blockIdx.x, gridDim.x);
}
#ifndef CFG_FLAGS
#define CFG_FLAGS (FL_NO_DSA | FL_NO_CROSS)
#endif
#ifndef CFG_ONE_LAUNCH
#define CFG_ONE_LAUNCH 0
#endif
extern "C" void kernel_launch(void* const* d_in, const int* in_sizes, int n_in, void* d_out, int out_size, void* d_ws, size_t ws_size, hipStream_t stream) {
    static int grid = 0;
    if (grid == 0) {
        if (n_in != 29 || ws_size < WS_END || out_size != T_TOK * DM) { fprintf(stderr, "kernel_launch: unexpected sizes n_in %d ws %zu out %d\n", n_in, ws_size, out_size); grid = -1; return; }
        int dev = 0, cus = 0, per_cu = 0;
        if (hipGetDevice(&dev) != hipSuccess || hipDeviceGetAttribute(&cus, hipDeviceAttributeMultiprocessorCount, dev) != hipSuccess) { grid = -1; return; }
        if (hipFuncSetAttribute((const void*)mk_fwd, hipFuncAttributeMaxDynamicSharedMemorySize, LDS_BYTES) != hipSuccess) { fprintf(stderr, "kernel_launch: hipFuncSetAttribute failed\n"); grid = -1; return; }
        if (hipOccupancyMaxActiveBlocksPerMultiprocessor(&per_cu, (const void*)mk_fwd, NTHR, LDS_BYTES) != hipSuccess || per_cu < 1) fprintf(stderr, "kernel_launch: note: occupancy query reports %d\n", per_cu);
        (void)hipGetLastError();
        grid = cus;
        if (grid != 256) fprintf(stderr, "kernel_launch: %d CUs (built for 256)\n", grid);
    }
    if (grid < 0) return;
    (void)hipMemsetAsync((char*)d_ws + WS_CTL, 0, CTL_ZERO_BYTES, stream);
    Args a{};
    for (int i = 0; i < 29; ++i) a.in[i] = (const float*)d_in[i];
    a.out = (float*)d_out; a.ws = (unsigned char*)d_ws; a.flags = CFG_FLAGS;
#if CFG_ONE_LAUNCH
    a.ph_lo = 0; a.ph_hi = NPH;
    hipLaunchKernelGGL(mk_fwd, dim3(grid), dim3(NTHR), LDS_BYTES, stream, a);
#else
    unsigned char* ws = (unsigned char*)d_ws; const float* const* in = (const float* const*)d_in;
#ifdef CFG_SPLIT2
    for (int ph = 3; ph < 5; ++ph) {
        if (ph == 3) { a.ph_lo = 0; a.ph_hi = 4; a.li = 0; } else { a.ph_lo = 4; a.ph_hi = NPH; a.li = 1; }
#else
    for (int ph = 0; ph < NPH; ++ph) {
        a.ph_lo = ph; a.ph_hi = ph + 1;
#endif
        hipLaunchKernelGGL(mk_fwd, dim3(grid), dim3(NTHR), LDS_BYTES, stream, a);
#ifdef DSA_PROBE
        if (ph == 3) { static bool once = false; if (!once) { once = true; (void)hipFuncSetAttribute((const void*)t_dsa<0>, hipFuncAttributeMaxDynamicSharedMemorySize, LDS_BYTES); (void)hipFuncSetAttribute((const void*)t_dsa<DSA_PROBE>, hipFuncAttributeMaxDynamicSharedMemorySize, LDS_BYTES); }
            if (DSA_PROBE != 0) hipLaunchKernelGGL(t_dsa<DSA_PROBE>, dim3(grid), dim3(NTHR), LDS_BYTES, stream, a);
            hipLaunchKernelGGL(t_dsa<0>, dim3(grid), dim3(NTHR), LDS_BYTES, stream, a); }
#endif
        if (ph == 3) {
            using namespace nv;
#ifndef DSA_PROBE
            if (CFG_FLAGS & FL_NO_DSA) k_dsa<<<16384, 256, 0, stream>>>((nv::bf16*)(ws + WS_QD), (nv::bf16*)(ws + WS_CKV), (nv::bf16*)(ws + WS_QI), (nv::bf16*)(ws + WS_KI), (float*)(ws + WS_WI), (float*)(ws + WS_BIASL), (nv::bf16*)(ws + WS_WUV), (nv::bf16*)(ws + WS_ODSA));
#endif
            if (CFG_FLAGS & FL_NO_CROSS) k_cross<<<16384, 256, 0, stream>>>((nv::bf16*)(ws + WS_QX), (nv::bf16*)(ws + WS_KX), (nv::bf16*)(ws + WS_VX), (nv::bf16*)(ws + WS_OX));
            if (CFG_FLAGS & FL_NO_S5) k_s5<<<256, 64, 0, stream>>>((nv::bf16*)(ws + WS_U), in[8], in[9], in[10], in[11], in[12], in[13], in[14], in[15], (nv::bf16*)(ws + WS_Y));
        }
    }
#endif
}
```

```cpp
#include <hip/hip_runtime.h>
#include <cstdio>
#include <cstdint>
#include <cmath>
constexpr int T_TOK = 16384, DM = 1024, SEQ = 2048, NB = 8, NIN = 2816, NINP = 5888, DFF = 2816;
constexpr size_t MiB = 1u << 20;
constexpr size_t WS_CTL = 0;
constexpr size_t WS_WIN = 1 * MiB, WS_WMKV = 13 * MiB, WS_WGLU = 15 * MiB, WS_WBR = 16 * MiB, WS_WOUT = 19 * MiB, WS_WGU = 21 * MiB, WS_WD = 32 * MiB;
constexpr size_t WS_WUV = 38 * MiB, WS_BIASL = 38 * MiB + 512 * 1024, WS_RS = 39 * MiB, WS_WI = 37 * MiB + 512 * 1024;
constexpr size_t WS_S5TV = 40 * MiB, WS_S5W = 60 * MiB, WS_KX = 68 * MiB, WS_VX = 70 * MiB, WS_MEMN = 72 * MiB, WS_H = 76 * MiB;
constexpr size_t WS_QD = 108 * MiB, WS_CKV = 140 * MiB, WS_QI = 144 * MiB, WS_KI = 160 * MiB, WS_QX = 162 * MiB, WS_U = 178 * MiB, WS_SLOC = 198 * MiB;
constexpr size_t WS_ODSA = 206 * MiB, WS_OX = 222 * MiB, WS_Y = 238 * MiB, WS_END = 254 * MiB;
constexpr size_t WS_G3 = 108 * MiB, WS_MERGED = WS_H, WS_XN = 108 * MiB, WS_ACT = 140 * MiB;
constexpr size_t WS_OS5 = 0, WS_G = WS_G3;
__device__ __forceinline__ int my_lane_id() { int l; asm volatile("v_mbcnt_lo_u32_b32 %0, -1, 0\n\tv_mbcnt_hi_u32_b32 %0, -1, %0" : "=v"(l)); return l; }
#define CFG_FLAGS 0
#define CFG_ONE_LAUNCH 1
namespace pg8 {
#define PG8_LAS __attribute__((address_space(3)))
typedef unsigned short bf16_t;
typedef short bf16x8 __attribute__((ext_vector_type(8)));
typedef float f32x4 __attribute__((ext_vector_type(4)));
typedef unsigned u32x4 __attribute__((ext_vector_type(4)));
constexpr int BM = 256, BK = 64, HALF = 128, HTB = HALF * BK * 2  , STAGE_BYTES = 8 * HTB, NXCD = 8, WGM = 8;

__host__ __device__ __forceinline__ int lds_byte(int r, int c) { const int st = (r >> 4) * 2 + (c >> 5), rr = r & 15, cc = c & 31, ob = rr * 64 + cc * 2; return st * 1024 + (ob ^ (((ob >> 9) & 1) << 5)); }
__host__ __device__ __forceinline__ void stage_rc(int b, int& R, int& C) { const int st = b / 1024, sb = b % 1024, swz = sb ^ (((sb >> 9) & 1) << 5); R = (st >> 1) * 16 + swz / 64; C = (st & 1) * 32 + (swz % 64) / 2; }
__host__ __device__ __forceinline__ int perm32(int rho) { const int n = rho >> 4, i = rho & 15; return 8 * (i >> 2) + 4 * n + (i & 3); }

struct Unit { int pm, pn, z; };
struct Gemm { const bf16_t* A; const bf16_t* Bt; int M, N, K, lda, ldb; };

struct StaticOrder {
    int nM, nN, nwg, G, c;
    __host__ __device__ void init(int M, int N, int G_, int c_) { nM = M / BM; nN = N / BM; nwg = nM * nN; G = G_; c = c_; }
    __host__ __device__ bool next(int i, Unit& u) const {
        const long L = (long)i * G + c; if (L >= nwg) return false;
        int wgid = (int)L; { const int q = nwg / NXCD, r = nwg % NXCD, xcd = wgid % NXCD, off = wgid / NXCD; wgid = (xcd < r ? xcd * (q + 1) : r * (q + 1) + (xcd - r) * q) + off; }
        const int nig = WGM * nN, gid = wgid / nig, fm = gid * WGM, gsz = (nM - fm) < WGM ? (nM - fm) : WGM;
        u.pm = fm + ((wgid % nig) % gsz); u.pn = (wgid % nig) / gsz; u.z = 0; return true;
    }
    __device__ __forceinline__ void a_ready(const Unit&) const {}
    __device__ __forceinline__ void done(const Unit&) const {}
    __device__ __forceinline__ long a_off(const Unit&) const { return 0; }
    __device__ __forceinline__ long b_off(const Unit&) const { return 0; }
};

typedef float f32x2_c __attribute__((ext_vector_type(2))); typedef __bf16 bf16x2_c __attribute__((ext_vector_type(2)));
__device__ __forceinline__ unsigned cvt_pk_bf16(float lo, float hi) { const f32x2_c v = {lo, hi}; const bf16x2_c b = __builtin_convertvector(v, bf16x2_c); return __builtin_bit_cast(unsigned, b); }
typedef float f32x2 __attribute__((ext_vector_type(2)));
template <class Epi, class Sched, bool ALIGN_EPI = false, bool SP2 = false>
__device__ __forceinline__ void gemm_phase(PG8_LAS unsigned char* lds, const Gemm g, const Sched& S, const Epi& E, const int wid) {
    const int lane = my_lane_id(), tid = wid * 64 + lane, wr = wid >> 2, wc = wid & 3, fr = lane & 15, fq = lane >> 4;
    const int K = g.K, nt = K / BK, lda = g.lda, ldb = g.ldb;
    unsigned voffA[2], voffB[2];
#pragma unroll
    for (int i = 0; i < 2; ++i) { int R, C; stage_rc(tid * 16 + i * 8192, R, C); const int Rb = Epi::PERM ? ((R & ~31) + perm32(R & 31)) : R;
        voffA[i] = (unsigned)(R * lda + C) * 2u; voffB[i] = (unsigned)(Rb * ldb + C) * 2u; }
    const size_t kstep = (size_t)(BK * 2);
    const size_t hstepA = (size_t)HALF * lda * 2, hstepB = (size_t)HALF * ldb * 2;
    const size_t tstepA = 2 * hstepA, tstepB = 2 * hstepB;
    const unsigned ldsw = (unsigned)wid * 1024u;
    const int aoff = lds_byte(wr * 64 + fr, fq * 8), boff = lds_byte(wc * 32 + fr, fq * 8);
#define PG8_SA(b, h) (((b) * 2 + (h)) * HTB)
#define PG8_SB(b, h) ((4 + (b) * 2 + (h)) * HTB)
#define PG8_STAGE(bufoff, gbase, voff) do { _Pragma("unroll") for (int _i = 0; _i < 2; ++_i) \
        __builtin_amdgcn_global_load_lds((const unsigned*)((const char*)(gbase) + (voff)[_i]), (PG8_LAS unsigned*)(lds + (bufoff) + ldsw + _i * 8192), 16, 0, 0); } while (0)
#define PG8_LDA(dst, b, h) do { _Pragma("unroll") for (int m = 0; m < 4; ++m) _Pragma("unroll") for (int k = 0; k < 2; ++k) dst[m][k] = *(const PG8_LAS bf16x8*)(lds + PG8_SA(b, h) + aoff + m * 2048 + k * 1024); } while (0)
#define PG8_LDB(dst, b, h) do { _Pragma("unroll") for (int n = 0; n < 2; ++n) _Pragma("unroll") for (int k = 0; k < 2; ++k) dst[n][k] = *(const PG8_LAS bf16x8*)(lds + PG8_SB(b, h) + boff + n * 2048 + k * 1024); } while (0)
#define PG8_MMA(ai, bj, At, Bt) do { __builtin_amdgcn_s_setprio(1); _Pragma("unroll") for (int m = 0; m < 4; ++m) _Pragma("unroll") for (int n = 0; n < 2; ++n) _Pragma("unroll") for (int k = 0; k < 2; ++k) \
        acc[ai][bj][m][n] = __builtin_amdgcn_mfma_f32_16x16x32_bf16(Bt[n][k], At[m][k], acc[ai][bj][m][n], 0, 0, 0); __builtin_amdgcn_s_setprio(0); } while (0)
#define PG8_WAIT_V(n) asm volatile("s_waitcnt vmcnt(" #n ")" ::: "memory")
#define PG8_WAIT_L(n) asm volatile("s_waitcnt lgkmcnt(" #n ")" ::: "memory")
#define PG8_BAR __builtin_amdgcn_s_barrier()
#define PG8_SCHED __builtin_amdgcn_sched_barrier(0)
    Unit cur, nxt; int ui = 0;
    if (!S.next(0, cur)) return;
    f32x4 acc[2][2][4][2];
#pragma unroll
    for (int a = 0; a < 2; ++a)
#pragma unroll
        for (int b = 0; b < 2; ++b)
#pragma unroll
            for (int m = 0; m < 4; ++m)
#pragma unroll
                for (int n = 0; n < 2; ++n) acc[a][b][m][n] = (f32x4){0.f, 0.f, 0.f, 0.f};
    bf16x8 At[4][2], B0[2][2], B1[2][2];
    const char* cA = (const char*)g.A + (size_t)cur.pm * tstepA + S.a_off(cur); const char* cB = (const char*)g.Bt + (size_t)cur.pn * tstepB + S.b_off(cur);
    S.a_ready(cur);
    if constexpr (SP2) {
        PG8_STAGE(PG8_SB(0, 0), cB, voffB); PG8_STAGE(PG8_SB(0, 1), cB + hstepB, voffB); PG8_STAGE(PG8_SA(0, 0), cA, voffA); PG8_STAGE(PG8_SA(0, 1), cA + hstepA, voffA);
        if (wr == 1) PG8_BAR;
        PG8_WAIT_V(2); PG8_BAR;
        PG8_STAGE(PG8_SB(1, 0), cB + kstep, voffB); PG8_STAGE(PG8_SA(1, 0), cA + kstep, voffA); PG8_STAGE(PG8_SB(1, 1), cB + hstepB + kstep, voffB);
        PG8_WAIT_V(6); PG8_BAR;
    } else {
        PG8_STAGE(PG8_SB(0, 0), cB, voffB); PG8_STAGE(PG8_SA(0, 0), cA, voffA); PG8_STAGE(PG8_SB(0, 1), cB + hstepB, voffB); PG8_STAGE(PG8_SA(0, 1), cA + hstepA, voffA);
        if (wr == 1) PG8_BAR;
        PG8_WAIT_V(4); PG8_BAR;
        PG8_STAGE(PG8_SB(1, 0), cB + kstep, voffB); PG8_STAGE(PG8_SA(1, 0), cA + kstep, voffA); PG8_STAGE(PG8_SB(1, 1), cB + hstepB + kstep, voffB);
        PG8_WAIT_V(6); PG8_BAR;
    }
    for (;;) {
        const bool has_next = S.next(ui + 1, nxt);
        const char* nA = has_next ? (const char*)g.A + (size_t)nxt.pm * tstepA + S.a_off(nxt) : cA; const char* nB = has_next ? (const char*)g.Bt + (size_t)nxt.pn * tstepB + S.b_off(nxt) : cB;
        for (int t = 0; t < nt; t += 2) {
            const bool last = (t == nt - 2);
            const char* a1 = cA + (size_t)(t + 1) * kstep;
            const char* a2 = last ? nA : cA + (size_t)(t + 2) * kstep; const char* b2 = last ? nB : cB + (size_t)(t + 2) * kstep;
            const char* a3 = a2 + kstep; const char* b3 = b2 + kstep;
            if (last && has_next) S.a_ready(nxt);
            if constexpr (SP2) {
            PG8_LDB(B0, 0, 0); PG8_LDB(B1, 0, 1); PG8_SCHED; PG8_LDA(At, 0, 0); PG8_STAGE(PG8_SA(1, 1), a1 + hstepA, voffA);
            PG8_WAIT_V(8); PG8_WAIT_L(0); PG8_BAR; PG8_MMA(0, 0, At, B0); PG8_MMA(0, 1, At, B1); PG8_BAR; PG8_SCHED;
            PG8_LDA(At, 0, 1); PG8_STAGE(PG8_SB(0, 0), b2, voffB); PG8_STAGE(PG8_SB(0, 1), b2 + hstepB, voffB); PG8_STAGE(PG8_SA(0, 0), a2, voffA);
            PG8_WAIT_V(8); PG8_WAIT_L(0); PG8_BAR; PG8_MMA(1, 0, At, B0); PG8_MMA(1, 1, At, B1); PG8_BAR; PG8_SCHED;
            PG8_LDB(B0, 1, 0); PG8_LDB(B1, 1, 1); PG8_SCHED; PG8_LDA(At, 1, 0); PG8_STAGE(PG8_SA(0, 1), a2 + hstepA, voffA);
            PG8_WAIT_V(8); PG8_WAIT_L(0); PG8_BAR; PG8_MMA(0, 0, At, B0); PG8_MMA(0, 1, At, B1); PG8_BAR; PG8_SCHED;
            PG8_LDA(At, 1, 1); PG8_STAGE(PG8_SB(1, 0), b3, voffB); PG8_STAGE(PG8_SB(1, 1), b3 + hstepB, voffB); PG8_STAGE(PG8_SA(1, 0), a3, voffA);
            PG8_WAIT_V(8); PG8_WAIT_L(0); PG8_BAR; PG8_MMA(1, 0, At, B0); PG8_MMA(1, 1, At, B1); PG8_BAR; PG8_SCHED;
            } else {
            PG8_LDB(B0, 0, 0); PG8_SCHED; PG8_LDA(At, 0, 0); PG8_STAGE(PG8_SA(1, 1), a1 + hstepA, voffA);
            PG8_WAIT_L(8); PG8_BAR; PG8_WAIT_L(0); PG8_MMA(0, 0, At, B0); PG8_BAR; PG8_SCHED;
            PG8_LDB(B1, 0, 1); PG8_STAGE(PG8_SB(0, 0), b2, voffB);
            PG8_BAR; PG8_WAIT_L(0); PG8_MMA(0, 1, At, B1); PG8_BAR;
            PG8_LDA(At, 0, 1); PG8_STAGE(PG8_SA(0, 0), a2, voffA);
            PG8_BAR; PG8_WAIT_L(0); PG8_MMA(1, 0, At, B0); PG8_BAR; PG8_SCHED;
            PG8_STAGE(PG8_SB(0, 1), b2 + hstepB, voffB);
            PG8_WAIT_V(6); PG8_BAR; PG8_MMA(1, 1, At, B1); PG8_BAR;
            PG8_LDB(B0, 1, 0); PG8_SCHED; PG8_LDA(At, 1, 0); PG8_STAGE(PG8_SA(0, 1), a2 + hstepA, voffA);
            PG8_WAIT_L(8); PG8_BAR; PG8_WAIT_L(0); PG8_MMA(0, 0, At, B0); PG8_BAR; PG8_SCHED;
            PG8_LDB(B1, 1, 1); PG8_STAGE(PG8_SB(1, 0), b3, voffB);
            PG8_BAR; PG8_WAIT_L(0); PG8_MMA(0, 1, At, B1); PG8_BAR;
            PG8_LDA(At, 1, 1); PG8_STAGE(PG8_SA(1, 0), a3, voffA);
            PG8_BAR; PG8_WAIT_L(0); PG8_MMA(1, 0, At, B0); PG8_BAR; PG8_SCHED;
            PG8_STAGE(PG8_SB(1, 1), b3 + hstepB, voffB);
            PG8_WAIT_V(6); PG8_BAR; PG8_MMA(1, 1, At, B1); PG8_BAR;
            }
        }
        if constexpr (ALIGN_EPI) { if (wr == 0) PG8_BAR; }
        if constexpr (!Epi::AFTER_DRAIN) { E(acc, cur, wr, wc, fr, fq); S.done(cur); }
        if (!has_next) break;
#pragma unroll
        for (int a = 0; a < 2; ++a)
#pragma unroll
            for (int b = 0; b < 2; ++b)
#pragma unroll
                for (int m = 0; m < 4; ++m)
#pragma unroll
                    for (int n = 0; n < 2; ++n) acc[a][b][m][n] = (f32x4){0.f, 0.f, 0.f, 0.f};
        cur = nxt; cA = nA; cB = nB; ++ui;
        if constexpr (ALIGN_EPI) { if (wr == 1) PG8_BAR; }
    }
    PG8_WAIT_V(0);
    if constexpr (!ALIGN_EPI) { if (wr == 0) PG8_BAR; }
    PG8_BAR;
    if constexpr (Epi::AFTER_DRAIN) { E.fused(acc, cur, wr, wc, fr, fq, lds, wid, lane); S.done(cur); }
#undef PG8_SA
#undef PG8_SB
#undef PG8_STAGE
#undef PG8_LDA
#undef PG8_LDB
#undef PG8_MMA
#undef PG8_WAIT_V
#undef PG8_WAIT_L
#undef PG8_BAR
#undef PG8_SCHED
}
}
namespace pg8 {
typedef unsigned u32x2 __attribute__((ext_vector_type(2)));
__device__ __forceinline__ u32x4 pack8(const f32x4 a, const f32x4 b) { u32x4 w; w.x = cvt_pk_bf16(a[0], a[1]); w.y = cvt_pk_bf16(a[2], a[3]); w.z = cvt_pk_bf16(b[0], b[1]); w.w = cvt_pk_bf16(b[2], b[3]); return w; }
__device__ __forceinline__ void unpack8(const u32x4 w, f32x4& a, f32x4& b) {
    a[0] = __uint_as_float(w.x << 16); a[1] = __uint_as_float(w.x & 0xffff0000u); a[2] = __uint_as_float(w.y << 16); a[3] = __uint_as_float(w.y & 0xffff0000u);
    b[0] = __uint_as_float(w.z << 16); b[1] = __uint_as_float(w.z & 0xffff0000u); b[2] = __uint_as_float(w.w << 16); b[3] = __uint_as_float(w.w & 0xffff0000u); }
__device__ __forceinline__ float sigm(float v) { return __builtin_amdgcn_rcpf(1.f + __expf(-v)); }
__device__ __forceinline__ f32x4 sigm4(const f32x4 v) { f32x4 r; r[0] = sigm(v[0]); r[1] = sigm(v[1]); r[2] = sigm(v[2]); r[3] = sigm(v[3]); return r; }

__device__ __forceinline__ void norm128_stats(const f32x4 (&acc)[2][2][4][2], PG8_LAS float* XB, int wr, int wc, int fr, int fq, float (&rs)[2][2][4]) {
#pragma unroll
    for (int bj = 0; bj < 2; ++bj)
#pragma unroll
        for (int ai = 0; ai < 2; ++ai)
#pragma unroll
            for (int m = 0; m < 4; ++m) { const f32x4 a = acc[ai][bj][m][0], b = acc[ai][bj][m][1];
                float ss = ((a[0] * a[0] + a[1] * a[1]) + (a[2] * a[2] + a[3] * a[3])) + ((b[0] * b[0] + b[1] * b[1]) + (b[2] * b[2] + b[3] * b[3]));
                ss += __shfl_xor(ss, 16); ss += __shfl_xor(ss, 32);
                if (fq == 0) XB[(bj * 256 + ai * HALF + wr * 64 + m * 16 + fr) * 4 + wc] = ss; }
    asm volatile("s_waitcnt lgkmcnt(0)" ::: "memory"); __builtin_amdgcn_s_barrier(); asm volatile("" ::: "memory");
#pragma unroll
    for (int bj = 0; bj < 2; ++bj)
#pragma unroll
        for (int ai = 0; ai < 2; ++ai)
#pragma unroll
            for (int m = 0; m < 4; ++m) { const f32x4 p = *(const PG8_LAS f32x4*)(XB + (bj * 256 + ai * HALF + wr * 64 + m * 16 + fr) * 4);
                rs[bj][ai][m] = __builtin_amdgcn_rsqf(((p[0] + p[1]) + (p[2] + p[3])) * (1.f / 128.f) + 1e-6f); }
}
struct EpiInprojF {
    static constexpr bool PERM = true, AFTER_DRAIN = false;
    bf16_t *QD, *CKV, *QI, *KI, *U, *QX; float* WI; const float *gq, *gkv, *gqx; PG8_LAS float* XB;
    __device__ __forceinline__ void operator()(const f32x4 (&acc)[2][2][4][2], const Unit& u, int wr, int wc, int fr, int fq) const {
        const int row0 = u.pm * BM + wr * 64 + fr, cb = u.pn * BM;
        const bool nrm0 = cb < 1152 || cb >= 2304, nrm1 = cb + HALF < 1024 || cb + HALF >= 2304;
        float rs[2][2][4];
        if (nrm0 || nrm1) norm128_stats(acc, XB, wr, wc, fr, fq, rs);
#pragma unroll
        for (int bj = 0; bj < 2; ++bj) {
            const int c0 = cb + bj * HALF + wc * 32 + 8 * fq; const bool nrm = bj == 0 ? nrm0 : nrm1;
            bf16_t* base = QD; int ld = 1024, cc = c0, kind = 0; const float* gp = gq + (c0 & 127);
            if (c0 < 1024) { }
            else if (c0 < 1152) { base = CKV; ld = 128; cc = c0 - 1024; gp = gkv + cc; }
            else if (c0 < 1664) { base = QI; ld = 512; cc = c0 - 1152; }
            else if (c0 < 1728) { base = KI; ld = 64; cc = c0 - 1664; }
            else if (c0 < 1792) { kind = 1; }
            else if (c0 < 2304) { kind = 2; cc = c0 - 1792; }
            else { base = QX; ld = 512; cc = c0 - 2304; gp = gqx + (cc & 127); }
            f32x4 g0 = {1.f, 1.f, 1.f, 1.f}, g1 = g0;
            if (nrm) { g0 = *(const f32x4*)gp; g1 = *(const f32x4*)(gp + 4); }
#pragma unroll
            for (int ai = 0; ai < 2; ++ai)
#pragma unroll
                for (int m = 0; m < 4; ++m) {
                    const int t = row0 + ai * HALF + m * 16;
                    if (kind == 0) { f32x4 v0 = acc[ai][bj][m][0], v1 = acc[ai][bj][m][1]; if (nrm) { const float r = rs[bj][ai][m]; v0 = v0 * r * g0; v1 = v1 * r * g1; }
                        *(u32x4*)(base + (size_t)t * ld + cc) = pack8(v0, v1); }
                    else if (kind == 1) { if (c0 == 1728) { *(f32x4*)(WI + (size_t)t * 8) = acc[ai][bj][m][0]; *(f32x4*)(WI + (size_t)t * 8 + 4) = acc[ai][bj][m][1]; } }
                    else { const int g = cc >> 4, ci = cc & 15, b = t >> 11, tt = t & 2047, R = b * 64 + (tt >> 5), s = tt & 31;
                        *(u32x4*)(U + ((size_t)(g * 512 + R)) * 640 + s * 16 + ci) = pack8(acc[ai][bj][m][0], acc[ai][bj][m][1]); }
                }
        }
    }
};
struct EpiMemKVF {
    static constexpr bool PERM = true, AFTER_DRAIN = false;
    bf16_t* KX; bf16_t* VX; const float* gk; PG8_LAS float* XB;
    __device__ __forceinline__ void operator()(const f32x4 (&acc)[2][2][4][2], const Unit& u, int wr, int wc, int fr, int fq) const {
        const int row0 = u.pm * BM + wr * 64 + fr, cb = u.pn * BM; const bool nrm = cb < 512;
        float rs[2][2][4];
        if (nrm) norm128_stats(acc, XB, wr, wc, fr, fq, rs);
#pragma unroll
        for (int bj = 0; bj < 2; ++bj) {
            const int c0 = cb + bj * HALF + wc * 32 + 8 * fq;
            bf16_t* base = nrm ? KX : VX; const int cc = nrm ? c0 : c0 - 512;
            f32x4 g0 = {1.f, 1.f, 1.f, 1.f}, g1 = g0;
            if (nrm) { g0 = *(const f32x4*)(gk + (c0 & 127)); g1 = *(const f32x4*)(gk + (c0 & 127) + 4); }
#pragma unroll
            for (int ai = 0; ai < 2; ++ai)
#pragma unroll
                for (int m = 0; m < 4; ++m) { f32x4 v0 = acc[ai][bj][m][0], v1 = acc[ai][bj][m][1]; if (nrm) { const float r = rs[bj][ai][m]; v0 = v0 * r * g0; v1 = v1 * r * g1; }
                    *(u32x4*)(base + (size_t)(row0 + ai * HALF + m * 16) * 512 + cc) = pack8(v0, v1); }
        }
    }
};
struct EpiGluF {
    static constexpr bool PERM = true, AFTER_DRAIN = false;
    const bf16_t* Y; bf16_t* O;
    __device__ __forceinline__ void operator()(const f32x4 (&acc)[2][2][4][2], const Unit& u, int wr, int wc, int fr, int fq) const {
        const int row0 = u.pm * BM + wr * 64 + fr, c0 = u.pn * BM + wc * 32 + 8 * fq;
#pragma unroll
        for (int ai = 0; ai < 2; ++ai) {
            u32x4 yv[4][2];
#pragma unroll
            for (int m = 0; m < 4; ++m)
#pragma unroll
                for (int bj = 0; bj < 2; ++bj) yv[m][bj] = *(const u32x4*)(Y + (size_t)(row0 + ai * HALF + m * 16) * 512 + c0 + bj * HALF);
            asm volatile("" ::: "memory");
#pragma unroll
            for (int m = 0; m < 4; ++m)
#pragma unroll
                for (int bj = 0; bj < 2; ++bj) { f32x4 y0, y1; unpack8(yv[m][bj], y0, y1);
                    *(u32x4*)(O + (size_t)(row0 + ai * HALF + m * 16) * 512 + c0 + bj * HALF) = pack8(y0 * sigm4(acc[ai][bj][m][0]), y1 * sigm4(acc[ai][bj][m][1])); }
        }
    }
};
struct EpiSigmoidF {
    static constexpr bool PERM = true, AFTER_DRAIN = false;
    bf16_t* G; int ld;
    __device__ __forceinline__ void operator()(const f32x4 (&acc)[2][2][4][2], const Unit& u, int wr, int wc, int fr, int fq) const {
        const int row0 = u.pm * BM + wr * 64 + fr;
#pragma unroll
        for (int bj = 0; bj < 2; ++bj) {
            const int c0 = u.pn * BM + bj * HALF + wc * 32 + 8 * fq;
#pragma unroll
            for (int ai = 0; ai < 2; ++ai)
#pragma unroll
                for (int m = 0; m < 4; ++m) *(u32x4*)(G + (size_t)(row0 + ai * HALF + m * 16) * ld + c0) = pack8(sigm4(acc[ai][bj][m][0]), sigm4(acc[ai][bj][m][1]));
        }
    }
};
struct EpiMergeF {
    static constexpr bool PERM = true, AFTER_DRAIN = false;
    const bf16_t* G3; bf16_t* MG;
    __device__ __forceinline__ void operator()(const f32x4 (&acc)[2][2][4][2], const Unit& u, int wr, int wc, int fr, int fq) const {
        const int row0 = u.pm * BM + wr * 64 + fr, c0 = u.pn * BM + wc * 32 + 8 * fq; const bool first = u.z == 0;
#pragma unroll
        for (int ai = 0; ai < 2; ++ai) {
            u32x4 gv[4][2], pv[4][2];
#pragma unroll
            for (int m = 0; m < 4; ++m)
#pragma unroll
                for (int bj = 0; bj < 2; ++bj) { const size_t t = (size_t)(row0 + ai * HALF + m * 16);
                    gv[m][bj] = *(const u32x4*)(G3 + t * 3072 + u.z * 1024 + c0 + bj * HALF);
                    pv[m][bj] = first ? (u32x4){0u, 0u, 0u, 0u} : *(const u32x4*)(MG + t * 1024 + c0 + bj * HALF); }
            asm volatile("" ::: "memory");
#pragma unroll
            for (int m = 0; m < 4; ++m)
#pragma unroll
                for (int bj = 0; bj < 2; ++bj) { const size_t t = (size_t)(row0 + ai * HALF + m * 16);
                    f32x4 g0, g1, p0, p1; unpack8(gv[m][bj], g0, g1); unpack8(pv[m][bj], p0, p1);
                    *(u32x4*)(MG + t * 1024 + c0 + bj * HALF) = pack8(p0 + g0 * acc[ai][bj][m][0], p1 + g1 * acc[ai][bj][m][1]); }
        }
    }
};
struct EpiOutF {
    static constexpr bool PERM = false, AFTER_DRAIN = false;
    const float* x; float* out; bf16_t* XN; float* RS;
    __device__ __forceinline__ void operator()(const f32x4 (&acc)[2][2][4][2], const Unit& u, int wr, int wc, int fr, int fq) const {
        const int row0 = u.pm * BM + wr * 64 + fr, col0 = u.pn * BM + wc * 32 + 4 * fq;
#pragma unroll
        for (int ai = 0; ai < 2; ++ai) {
            f32x4 xv[4][2][2];
#pragma unroll
            for (int m = 0; m < 4; ++m)
#pragma unroll
                for (int bj = 0; bj < 2; ++bj)
#pragma unroll
                    for (int n = 0; n < 2; ++n) xv[m][bj][n] = *(const f32x4*)(x + (size_t)(row0 + ai * HALF + m * 16) * 1024 + col0 + bj * HALF + n * 16);
            asm volatile("" ::: "memory");
#pragma unroll
            for (int m = 0; m < 4; ++m) { const int t = row0 + ai * HALF + m * 16; const size_t off = (size_t)t * 1024 + col0; float ss = 0.f;
#pragma unroll
                for (int bj = 0; bj < 2; ++bj)
#pragma unroll
                    for (int n = 0; n < 2; ++n) { const size_t o2 = off + bj * HALF + n * 16; const f32x4 r = xv[m][bj][n] + acc[ai][bj][m][n];
                        u32x2 w; w.x = cvt_pk_bf16(r[0], r[1]); w.y = cvt_pk_bf16(r[2], r[3]); *(u32x2*)(XN + o2) = w;
                        ss += (r[0] * r[0] + r[1] * r[1]) + (r[2] * r[2] + r[3] * r[3]); }
                ss += __shfl_xor(ss, 16); ss += __shfl_xor(ss, 32);
                if (fq == 0) RS[(size_t)t * 16 + u.pn * 4 + wc] = ss; }
        }
    }
};
struct EpiGateUpF {
    static constexpr bool PERM = true, AFTER_DRAIN = false;
    const float* RS; bf16_t* ACT;
    __device__ __forceinline__ void operator()(const f32x4 (&acc)[2][2][4][2], const Unit& u, int wr, int wc, int fr, int fq) const {
        const int row0 = u.pm * BM + wr * 64 + fr, f0 = u.pn * HALF + wc * 32 + 8 * fq;
        f32x4 pr[2][4];
#pragma unroll
        for (int ai = 0; ai < 2; ++ai)
#pragma unroll
            for (int m = 0; m < 4; ++m) pr[ai][m] = *(const f32x4*)(RS + (size_t)(row0 + ai * HALF + m * 16) * 16 + 4 * fq);
        asm volatile("" ::: "memory");
#pragma unroll
        for (int ai = 0; ai < 2; ++ai)
#pragma unroll
            for (int m = 0; m < 4; ++m) { const int t = row0 + ai * HALF + m * 16;
                float tot = (pr[ai][m][0] + pr[ai][m][1]) + (pr[ai][m][2] + pr[ai][m][3]); tot += __shfl_xor(tot, 16); tot += __shfl_xor(tot, 32);
                const float rs = __builtin_amdgcn_rsqf(tot * (1.f / 1024.f) + 1e-6f);
                f32x4 o[2];
#pragma unroll
                for (int n = 0; n < 2; ++n) { const f32x4 g = acc[ai][0][m][n] * rs, up = acc[ai][1][m][n] * rs; o[n] = g * sigm4(g) * up; }
                *(u32x4*)(ACT + (size_t)t * 2816 + f0) = pack8(o[0], o[1]); }
    }
};
struct EpiDownF {
    static constexpr bool PERM = false, AFTER_DRAIN = false;
    const bf16_t* XN; float* out;
    __device__ __forceinline__ void operator()(const f32x4 (&acc)[2][2][4][2], const Unit& u, int wr, int wc, int fr, int fq) const {
        const int row0 = u.pm * BM + wr * 64 + fr, col0 = u.pn * BM + wc * 32 + 4 * fq;
#pragma unroll
        for (int ai = 0; ai < 2; ++ai) {
            u32x2 xv[4][2][2];
#pragma unroll
            for (int m = 0; m < 4; ++m)
#pragma unroll
                for (int bj = 0; bj < 2; ++bj)
#pragma unroll
                    for (int n = 0; n < 2; ++n) xv[m][bj][n] = *(const u32x2*)(XN + (size_t)(row0 + ai * HALF + m * 16) * 1024 + col0 + bj * HALF + n * 16);
            asm volatile("" ::: "memory");
#pragma unroll
            for (int m = 0; m < 4; ++m)
#pragma unroll
                for (int bj = 0; bj < 2; ++bj)
#pragma unroll
                    for (int n = 0; n < 2; ++n) { const u32x2 w = xv[m][bj][n];
                        const f32x4 x1 = {__uint_as_float(w.x << 16), __uint_as_float(w.x & 0xffff0000u), __uint_as_float(w.y << 16), __uint_as_float(w.y & 0xffff0000u)};
                        *(f32x4*)(out + (size_t)(row0 + ai * HALF + m * 16) * 1024 + col0 + bj * HALF + n * 16) = x1 + acc[ai][bj][m][n]; }
        }
    }
};
struct EpiSlocF {
    static constexpr bool PERM = false, AFTER_DRAIN = false;
    float* SLOC;
    __device__ __forceinline__ void operator()(const f32x4 (&acc)[2][2][4][2], const Unit& u, int wr, int wc, int fr, int fq) const {
        const int row0 = u.pm * BM + wr * 64 + fr, col0 = wc * 32 + 4 * fq;
#pragma unroll
        for (int ai = 0; ai < 2; ++ai)
#pragma unroll
            for (int m = 0; m < 4; ++m)
#pragma unroll
                for (int n = 0; n < 2; ++n) *(f32x4*)(SLOC + (size_t)(row0 + ai * HALF + m * 16) * 128 + col0 + n * 16) = acc[ai][0][m][n];
    }
};
__device__ __forceinline__ float gelu_t(float x) { const float w = 1.5957691216057308f * (x + 0.044715f * x * x * x); return x * __builtin_amdgcn_rcpf(1.f + __expf(-w)); }
struct EpiS5YF {
    static constexpr bool PERM = true, AFTER_DRAIN = false;
    const bf16_t* U; const float* dskip; bf16_t* Y;
    __device__ __forceinline__ void operator()(const f32x4 (&acc)[2][2][4][2], const Unit& u, int wr, int wc, int fr, int fq) const {
        const int row0 = u.pm * BM + wr * 64 + fr, g = (u.pm * BM) >> 9;
        f32x4 dk[2][2];
#pragma unroll
        for (int bj = 0; bj < 2; ++bj) { const int co0 = ((u.pn & 1) * BM + bj * HALF + wc * 32 + 8 * fq) & 15; dk[bj][0] = *(const f32x4*)(dskip + g * 16 + co0); dk[bj][1] = *(const f32x4*)(dskip + g * 16 + co0 + 4); }
#pragma unroll
        for (int ai = 0; ai < 2; ++ai) {
            u32x4 uv[4][2];
#pragma unroll
            for (int m = 0; m < 4; ++m)
#pragma unroll
                for (int bj = 0; bj < 2; ++bj) { const int cl = (u.pn & 1) * BM + bj * HALF + wc * 32 + 8 * fq; uv[m][bj] = *(const u32x4*)(U + (size_t)(row0 + ai * HALF + m * 16) * 640 + cl); }
            asm volatile("" ::: "memory");
#pragma unroll
            for (int m = 0; m < 4; ++m)
#pragma unroll
                for (int bj = 0; bj < 2; ++bj) { const int cl = (u.pn & 1) * BM + bj * HALF + wc * 32 + 8 * fq, s = cl >> 4, co0 = cl & 15;
                    const int row = row0 + ai * HALF + m * 16, R = row & 511, b = R >> 6, ch = R & 63, t = b * 2048 + ch * 32 + s;
                    f32x4 u0, u1; unpack8(uv[m][bj], u0, u1);
                    f32x4 y0 = acc[ai][bj][m][0] + dk[bj][0] * u0, y1 = acc[ai][bj][m][1] + dk[bj][1] * u1;
#pragma unroll
                    for (int e2 = 0; e2 < 4; ++e2) { y0[e2] = gelu_t(y0[e2]); y1[e2] = gelu_t(y1[e2]); }
                    *(u32x4*)(Y + (size_t)t * 512 + g * 16 + co0) = pack8(y0, y1); }
        }
    }
};
struct SubsetOrder { StaticOrder so; bool active;
    __device__ void init(int M, int N, int Gsub, int csub) { so.init(M, N, Gsub, csub < 0 ? 0 : csub); active = csub >= 0 && csub < Gsub; }
    __device__ bool next(int i, Unit& u) const { return active && so.next(i, u); }
    __device__ __forceinline__ void a_ready(const Unit&) const {}
    __device__ __forceinline__ void done(const Unit&) const {}
    __device__ __forceinline__ long a_off(const Unit&) const { return 0; }
    __device__ __forceinline__ long b_off(const Unit&) const { return 0; } };
struct S5Order1 { int c;
    __device__ bool next(int i, Unit& u) const { if (i > 0 || c < 0 || c >= 64) return false; u.pm = c; u.pn = c >> 1; u.z = 0; return true; }
    __device__ __forceinline__ void a_ready(const Unit&) const {}
    __device__ __forceinline__ void done(const Unit&) const {}
    __device__ __forceinline__ long a_off(const Unit&) const { return 0; }
    __device__ __forceinline__ long b_off(const Unit&) const { return 0; } };
struct S5Order2 { int c;
    __device__ bool next(int i, Unit& u) const { if (i > 0 || c < 0 || c >= 128) return false; const int g = c >> 2; u.pm = g * 2 + ((c >> 1) & 1); u.pn = g * 2 + (c & 1); u.z = 0; return true; }
    __device__ __forceinline__ void a_ready(const Unit&) const {}
    __device__ __forceinline__ void done(const Unit&) const {}
    __device__ __forceinline__ long a_off(const Unit&) const { return 0; }
    __device__ __forceinline__ long b_off(const Unit&) const { return 0; } };
struct GateOrder { int c;
    __device__ bool next(int i, Unit& u) const { int id; if (c < 128) { if (i >= 2) return false; id = c * 2 + i; } else { if (i >= 4) return false; id = 256 + (c - 128) * 4 + i; } u.pm = id / 12; u.pn = id % 12; u.z = 0; return true; }
    __device__ __forceinline__ void a_ready(const Unit&) const {}
    __device__ __forceinline__ void done(const Unit&) const {}
    __device__ __forceinline__ long a_off(const Unit&) const { return 0; }
    __device__ __forceinline__ long b_off(const Unit&) const { return 0; } };
struct MergeOrder { StaticOrder so; long aoff[3];
    __device__ bool next(int i, Unit& u) const { if (i >= 3) return false; if (!so.next(0, u)) return false; u.z = i; return true; }
    __device__ __forceinline__ void a_ready(const Unit&) const {}
    __device__ __forceinline__ void done(const Unit&) const {}
    __device__ __forceinline__ long a_off(const Unit& u) const { return u.z == 0 ? aoff[0] : (u.z == 1 ? aoff[1] : aoff[2]); }
    __device__ __forceinline__ long b_off(const Unit& u) const { return (long)u.z * 1024 * 512 * 2; } };
}
#define GAS __attribute__((address_space(1)))
#define LAS __attribute__((address_space(3)))
typedef unsigned short bf16;
typedef unsigned v4u __attribute__((ext_vector_type(4)));
typedef float f32x4 __attribute__((ext_vector_type(4)));
typedef short bf16x8 __attribute__((ext_vector_type(8)));
typedef GAS unsigned gu32;
typedef GAS unsigned long long gu64;
#define RLX_AGENT __ATOMIC_RELAXED, __HIP_MEMORY_SCOPE_AGENT
#define LDS_WAIT() asm volatile("s_waitcnt lgkmcnt(0)" ::: "memory")
#define VM_WAIT() asm volatile("s_waitcnt vmcnt(0)" ::: "memory")
__device__ __forceinline__ unsigned long long rt() { return __builtin_amdgcn_s_memrealtime(); }
__device__ __forceinline__ unsigned f2bf(float f) { unsigned u = __builtin_bit_cast(unsigned, f); return (u + 0x7fffu + ((u >> 16) & 1u)) >> 16; }
__device__ __forceinline__ unsigned pk2(float lo, float hi) { return f2bf(lo) | (f2bf(hi) << 16); }

#define XB_TMO      128
#define XB_XCNT(j)  (256  + 64 * (j))
#define XB_XSUB(j)  (1280 + 64 * (j))
#define XB_XGEN(j)  (2304 + 64 * (j))
#define XB_TOP      3328
#define XB_TOPGEN   3392
#define XCD_BAR_WORDS 3456
#define XB_SPIN_CAP (1u << 18)

__device__ __forceinline__ unsigned xb_ld(unsigned* p)              { return __hip_atomic_load(p, __ATOMIC_RELAXED, __HIP_MEMORY_SCOPE_AGENT); }
__device__ __forceinline__ unsigned xb_add(unsigned* p, unsigned v) { return __hip_atomic_fetch_add(p, v, __ATOMIC_RELAXED, __HIP_MEMORY_SCOPE_AGENT); }
__device__ __forceinline__ unsigned xb_xcc_id() { return (unsigned)__builtin_amdgcn_s_getreg((3 << 11) | 20) & 0xFu; }
#define XB_SPIN(cond, bar) do { unsigned _sp = 0; while (cond) { __builtin_amdgcn_s_sleep(1); \
    if ((++_sp & 255u) == 0u) { if (xb_ld(&(bar)[XB_TMO])) break; if (_sp > XB_SPIN_CAP) { atomicAdd(&(bar)[XB_TMO], 1u); break; } } } } while (0)

struct XcdBarrier {
    unsigned* bar; unsigned x;
    volatile LAS unsigned* st;
};

__device__ __forceinline__ XcdBarrier xcd_barrier_post(unsigned* bar, volatile LAS unsigned* st, bool leader) {
    XcdBarrier b; b.bar = bar; b.x = xb_xcc_id(); b.st = st;
    if (leader) (void)xb_add(&bar[XB_XCNT(b.x)], 1u);
    return b;
}
__device__ __forceinline__ void xcd_barrier_complete(unsigned* bar, unsigned x, unsigned& nloc, unsigned& nx) {
    const unsigned G = gridDim.x * gridDim.y * gridDim.z;
    unsigned sum, cnt, mine, sp = 0u;
    for (;;) {
        sum = 0u; cnt = 0u; mine = 0u;
#pragma unroll
        for (unsigned j = 0; j < 16; ++j) { const unsigned c = xb_ld(&bar[XB_XCNT(j)]); sum += c; cnt += (c > 0u) ? 1u : 0u; mine = (j == x) ? c : mine; }
        if (sum == G) break;
        __builtin_amdgcn_s_sleep(1);
        if ((++sp & 255u) == 0u) { if (xb_ld(&bar[XB_TMO])) break; if (sp > XB_SPIN_CAP) { atomicAdd(&bar[XB_TMO], 1u); break; } }
    }
    nloc = mine > 0u ? mine : 1u; nx = cnt > 0u ? cnt : 1u;
}

__device__ __forceinline__ void xcd_barrier(const XcdBarrier& b, bool leader) {
    asm volatile("s_waitcnt vmcnt(0)" ::: "memory");
    __syncthreads();
    if (leader) {
        unsigned* bar = b.bar;
        __builtin_amdgcn_s_waitcnt(0);
        unsigned nloc = b.st[0], nx = b.st[1];
        if (nloc == 0u) { xcd_barrier_complete(bar, b.x, nloc, nx); b.st[0] = nloc; b.st[1] = nx; }
        const unsigned old = xb_add(&bar[XB_XSUB(b.x)], 1u);
        const unsigned gen = old / nloc;
        if (old + 1u == (gen + 1u) * nloc) {
            __builtin_amdgcn_fence(__ATOMIC_RELEASE, "agent");
            asm volatile("s_waitcnt vmcnt(0)" ::: "memory");
            const unsigned og = xb_add(&bar[XB_TOP], 1u);
            const unsigned tg = og / nx;
            if (og + 1u == (tg + 1u) * nx) xb_add(&bar[XB_TOPGEN], 1u);
            else XB_SPIN(xb_ld(&bar[XB_TOPGEN]) == tg, bar);
            __builtin_amdgcn_fence(__ATOMIC_ACQUIRE, "agent");
            xb_add(&bar[XB_XGEN(b.x)], 1u);
            asm volatile("s_waitcnt vmcnt(0)" ::: "memory");
        } else {
            XB_SPIN(xb_ld(&bar[XB_XGEN(b.x)]) == gen, bar);
            __builtin_amdgcn_fence(__ATOMIC_ACQUIRE, "agent");
            asm volatile("s_waitcnt vmcnt(0)" ::: "memory");
        }
    }
    __syncthreads();
}
constexpr int NWAVES = 8, NTHR = 512;
constexpr int RING_OFF = 0, RING_BYTES = 131072;
constexpr int LDSCTL_OFF = RING_BYTES, MISC_OFF = LDSCTL_OFF + 320, XB_OFF = RING_BYTES + 1024;
constexpr int LDS_BYTES = 147456;
constexpr size_t CTL_ZERO_BYTES = 1 * MiB;
constexpr int CW_TMO = 0, CW_BAR = 4096;
constexpr int NPH = 9;
constexpr int FL_NO_DSA = 1, FL_NO_CROSS = 2, FL_NO_S5 = 4;
constexpr size_t WS_LAM32 = WS_BIASL + 8192;

struct Args { const float* in[29]; float* out; unsigned char* ws; int ph_lo, ph_hi, flags, li; };

__device__ __forceinline__ float wave_sum(float v) {
#pragma unroll
    for (int o = 1; o < 64; o <<= 1) v += __shfl_xor(v, o);
    return v;
}
__device__ __forceinline__ float p0_src(int mode, const float* W, const float* W2, const float* gain, int N, int k, int d) {
    if (mode == 0) return W[(size_t)k * N + d];
    if (mode == 1) { if (d >= 1736 && d < 1792) return 0.f; const int s = d >= 1792 ? d - 56 : d; return W[(size_t)k * N + s]; }
    const int tile = d >> 8, w = d & 255, f = tile * 128 + (w & 127); return ((w < 128) ? W : W2)[(size_t)k * N + f] * gain[k];
}
__device__ __forceinline__ void p0_transpose_item(int mode, const float* W, const float* W2, const float* gain, int K, int N, int ND, bf16* WT, LAS float* scr, int item, int lane) {
    const int nblk = ND / 32, kb = item / nblk, nb = item % nblk, k0 = 64 * kb, d0 = 32 * nb;
    float tv[32];
#pragma unroll
    for (int i = 0; i < 32; ++i) tv[i] = p0_src(mode, W, W2, gain, N, k0 + 2 * i + (lane >> 5), d0 + (lane & 31));
#pragma unroll
    for (int i = 0; i < 32; ++i) scr[(2 * i + (lane >> 5)) * 33 + (lane & 31)] = tv[i];
    LDS_WAIT(); asm volatile("" ::: "memory");
    const int c = lane & 7;
#pragma unroll
    for (int j = 0; j < 4; ++j) { const int n = (lane >> 3) + 8 * j; const LAS float* s = scr + (8 * c) * 33 + n;
        v4u o; o.x = pk2(s[0 * 33], s[1 * 33]); o.y = pk2(s[2 * 33], s[3 * 33]); o.z = pk2(s[4 * 33], s[5 * 33]); o.w = pk2(s[6 * 33], s[7 * 33]);
        *(GAS v4u*)(WT + (size_t)(d0 + n) * K + k0 + 8 * c) = o; }
    LDS_WAIT(); asm volatile("" ::: "memory");
}
__device__ __forceinline__ void rms_row_to_bf16(const float* xrow, const float* g, bf16* orow, int lane) {
    const GAS f32x4* xr = (const GAS f32x4*)xrow + lane; const GAS f32x4* gr = (const GAS f32x4*)g + lane;
    f32x4 v[4]; float s = 0.f;
#pragma unroll
    for (int j = 0; j < 4; ++j) { v[j] = xr[64 * j]; s += (v[j].x * v[j].x + v[j].y * v[j].y) + (v[j].z * v[j].z + v[j].w * v[j].w); }
    const float rstd = 1.f / sqrtf(wave_sum(s) * (1.f / 1024.f) + 1e-6f);
    GAS unsigned long long* o8 = (GAS unsigned long long*)orow + lane;
#pragma unroll
    for (int j = 0; j < 4; ++j) { const f32x4 gg = gr[64 * j];
        o8[64 * j] = (unsigned long long)pk2(v[j].x * rstd * gg.x, v[j].y * rstd * gg.y) | ((unsigned long long)pk2(v[j].z * rstd * gg.z, v[j].w * rstd * gg.w) << 32); }
}
__device__ __forceinline__ int t5_bucket(int n) {
    if (n < 16) return n;
    const int large = 16 + (int)((logf((float)n / 16.f) / 2.0794415416798357f) * 16.f);
    return large < 31 ? large : 31;
}
__device__ __forceinline__ void p0_s5_tables(int g, int part, const Args& a, LAS unsigned char* lds, int tid) {
    typedef float f32x2v __attribute__((ext_vector_type(2)));
    LAS f32x2v* POW = (LAS f32x2v*)lds;
    LAS f32x2v* BB = POW + 33 * 64;
    LAS f32x2v* CC = BB + 64 * 16;
    LAS float* KT = (LAS float*)(CC + 16 * 64);
    const float *a_re = a.in[8], *a_im = a.in[9], *log_dt = a.in[10], *b_re = a.in[11], *b_im = a.in[12], *c_re = a.in[13], *c_im = a.in[14];
    bf16* TV = (bf16*)(a.ws + WS_S5TV) + (size_t)g * 512 * 640; bf16* Wt = (bf16*)(a.ws + WS_S5W) + (size_t)g * 256 * 512; float* LAM32 = (float*)(a.ws + WS_LAM32) + g * 128;
    const double dt = exp((double)log_dt[g]);
    for (int idx = tid; idx < 33 * 64; idx += NTHR) { const int j = idx >> 6, n = idx & 63; const double lr = a_re[g * 64 + n], li = a_im[g * 64 + n];
        const double mag = exp(lr * dt * j), ang = li * dt * j; POW[idx] = (f32x2v){(float)(mag * cos(ang)), (float)(mag * sin(ang))}; }
    for (int idx = tid; idx < 64 * 16; idx += NTHR) { const int n = idx >> 4, c = idx & 15; const double lr = a_re[g * 64 + n], li = a_im[g * 64 + n];
        const double mag = exp(lr * dt), lbr = mag * cos(li * dt), lbi = mag * sin(li * dt), nr = lbr - 1.0, ni = lbi, den = lr * lr + li * li;
        const double fr = (nr * lr + ni * li) / den, fi = (ni * lr - nr * li) / den, br = b_re[(g * 64 + n) * 16 + c], bi = b_im[(g * 64 + n) * 16 + c];
        BB[idx] = (f32x2v){(float)(fr * br - fi * bi), (float)(fr * bi + fi * br)};
        const int c2 = idx >> 6, n2 = idx & 63; CC[idx] = (f32x2v){c_re[(g * 16 + c2) * 64 + n2], c_im[(g * 16 + c2) * 64 + n2]}; }
    __syncthreads();
    if (part == 0 && tid < 64) { const f32x2v p = POW[32 * 64 + tid]; LAM32[tid * 2] = p.x; LAM32[tid * 2 + 1] = p.y; }
    for (int idx = tid; idx < 32 * 32; idx += NTHR) { const int j = idx >> 5, co = 2 * part + ((idx >> 4) & 1), ci = idx & 15; float s = 0.f;
#pragma unroll 2
        for (int n = 0; n < 64; ++n) { const f32x2v c = CC[co * 64 + n], p = POW[j * 64 + n], b = BB[n * 16 + ci];
            const float cpr = c.x * p.x - c.y * p.y, cpi = c.x * p.y + c.y * p.x; s += cpr * b.x - cpi * b.y; }
        KT[j * 256 + co * 16 + ci] = s; }
    __syncthreads();
    for (int id = tid; id < 64 * 80; id += NTHR) { const int rl = id / 80, c8 = id % 80, so = rl >> 1, co = 2 * part + (rl & 1), row = so * 16 + co; float v[8];
        if (c8 < 64) { const int si = c8 >> 1, ci0 = (c8 & 1) * 8;
#pragma unroll
            for (int e = 0; e < 8; ++e) v[e] = so >= si ? KT[(so - si) * 256 + co * 16 + ci0 + e] : 0.f; }
        else {
#pragma unroll
            for (int e = 0; e < 8; ++e) { const int np = (c8 - 64) * 8 + e, n = np & 63; const f32x2v c = CC[co * 64 + n], p = POW[(so + 1) * 64 + n];
                v[e] = np < 64 ? (c.x * p.x - c.y * p.y) : -(c.x * p.y + c.y * p.x); } }
        v4u o; o.x = pk2(v[0], v[1]); o.y = pk2(v[2], v[3]); o.z = pk2(v[4], v[5]); o.w = pk2(v[6], v[7]);
        *(GAS v4u*)(TV + (size_t)row * 640 + c8 * 8) = o; }
    for (int id = tid; id < 16 * 64; id += NTHR) { const int np = 16 * part + (id >> 6), c8 = id & 63, n = np & 63, s = c8 >> 1, ci0 = (c8 & 1) * 8; const f32x2v p = POW[(31 - s) * 64 + n]; float v[8];
#pragma unroll
        for (int e = 0; e < 8; ++e) { const f32x2v b = BB[n * 16 + ci0 + e]; v[e] = np < 64 ? (p.x * b.x - p.y * b.y) : (p.x * b.y + p.y * b.x); }
        v4u o; o.x = pk2(v[0], v[1]); o.y = pk2(v[2], v[3]); o.z = pk2(v[4], v[5]); o.w = pk2(v[6], v[7]);
        *(GAS v4u*)(Wt + (size_t)np * 512 + c8 * 8) = o; }
    __syncthreads();
}
__device__ __forceinline__ void p0_prologue(const Args& a, LAS unsigned char* lds, int tid, int lane, int wave, int vcu, int G) {
    unsigned char* ws = a.ws;
    LAS float* scr = (LAS float*)(lds + RING_OFF + wave * 16384);
    const int gw = vcu * NWAVES + wave, NGW = G * NWAVES;
    p0_s5_tables(vcu >> 3, vcu & 7, a, lds, tid);
    if (blockIdx.x == 33 && tid == 0) {
        float gq = 0.f, gk = 0.f, bm = 0.f; for (int i = 0; i < 128; ++i) { gq = fmaxf(gq, fabsf(a.in[5][i])); gk = fmaxf(gk, fabsf(a.in[6][i])); }
        for (int i = 0; i < 256; ++i) bm = fmaxf(bm, fabsf(a.in[2][i]));
        const float B = 1.02f * 128.f * 0.08838834764831845f * 1.4426950408889634f * gq * gk + bm * 1.4426950408889634f;
        ((float*)(ws + WS_BIASL))[1032] = (B > 0.f && B <= 56.f) ? B : 0.f; }
    if (blockIdx.x == 32) { float* BL = (float*)(ws + WS_BIASL); const float* rb = a.in[2];
        for (int i = tid; i < 8 * 128 + 8; i += NTHR) { if (i < 1024) { const int h = i >> 7, d = i & 127; BL[i] = rb[t5_bucket(d) * 8 + h] * 1.4426950408889634f; } else BL[i] = rb[31 * 8 + (i - 1024)] * 1.4426950408889634f; } }
    { bf16* WUV = (bf16*)(ws + WS_WUV); const float* w = a.in[7];
        for (int i = blockIdx.x * NTHR + tid; i < 8 * 64 * 128; i += G * NTHR) { const int ep = i & 3, ln = (i >> 2) & 63, t = (i >> 8) & 1, cs = (i >> 9) & 7, eb = (i >> 12) & 1, h = i >> 13;
            const int d = 16 * cs + 8 * t + 4 * (ln >> 5) + ep, e = 32 * eb + (ln & 31); WUV[i] = (bf16)f2bf(w[(h * 128 + d) * 64 + e]); } }
    constexpr int I_IN = 16 * 184, I_MKV = 16 * 32, I_GLU = 8 * 16, I_BR = 8 * 32, I_OUT = 16 * 32, I_GU = 16 * 176, I_D = 44 * 32;
    constexpr int NITEMS = I_IN + I_MKV + I_GLU + 3 * I_BR + I_OUT + I_GU + I_D;
    for (int it = gw; it < NITEMS; it += NGW) {
        int r = it;
        if (r < I_IN) { p0_transpose_item(1, a.in[3], nullptr, nullptr, 1024, 5832, 5888, (bf16*)(ws + WS_WIN), scr, r, lane); continue; } r -= I_IN;
        if (r < I_MKV) { p0_transpose_item(0, a.in[18], nullptr, nullptr, 1024, 1024, 1024, (bf16*)(ws + WS_WMKV), scr, r, lane); continue; } r -= I_MKV;
        if (r < I_GLU) { p0_transpose_item(0, a.in[16], nullptr, nullptr, 512, 512, 512, (bf16*)(ws + WS_WGLU), scr, r, lane); continue; } r -= I_GLU;
        if (r < 3 * I_BR) { const int br = r / I_BR; p0_transpose_item(0, a.in[21 + br], nullptr, nullptr, 512, 1024, 1024, (bf16*)(ws + WS_WBR) + (size_t)br * 1024 * 512, scr, r % I_BR, lane); continue; } r -= 3 * I_BR;
        if (r < I_OUT) { p0_transpose_item(0, a.in[24], nullptr, nullptr, 1024, 1024, 1024, (bf16*)(ws + WS_WOUT), scr, r, lane); continue; } r -= I_OUT;
        if (r < I_GU) { p0_transpose_item(2, a.in[26], a.in[27], a.in[25], 1024, 2816, 5632, (bf16*)(ws + WS_WGU), scr, r, lane); continue; } r -= I_GU;
        p0_transpose_item(0, a.in[28], nullptr, nullptr, 2816, 1024, 1024, (bf16*)(ws + WS_WD), scr, r, lane);
    }
    for (int m = gw; m < T_TOK; m += 2 * NGW) {
        const GAS f32x4* x0 = (const GAS f32x4*)(a.in[0] + (size_t)m * 1024) + lane; const GAS f32x4* x1 = (const GAS f32x4*)(a.in[0] + (size_t)(m + NGW) * 1024) + lane; const GAS f32x4* gr = (const GAS f32x4*)a.in[4] + lane;
        f32x4 v0[4], v1[4]; float s0 = 0.f, s1 = 0.f;
#pragma unroll
        for (int j = 0; j < 4; ++j) { v0[j] = x0[64 * j]; v1[j] = x1[64 * j]; }
#pragma unroll
        for (int j = 0; j < 4; ++j) { s0 += (v0[j].x * v0[j].x + v0[j].y * v0[j].y) + (v0[j].z * v0[j].z + v0[j].w * v0[j].w); s1 += (v1[j].x * v1[j].x + v1[j].y * v1[j].y) + (v1[j].z * v1[j].z + v1[j].w * v1[j].w); }
        const float r0 = 1.f / sqrtf(wave_sum(s0) * (1.f / 1024.f) + 1e-6f), r1 = 1.f / sqrtf(wave_sum(s1) * (1.f / 1024.f) + 1e-6f);
        GAS unsigned long long* o0 = (GAS unsigned long long*)((bf16*)(ws + WS_H) + (size_t)m * 1024) + lane; GAS unsigned long long* o1 = (GAS unsigned long long*)((bf16*)(ws + WS_H) + (size_t)(m + NGW) * 1024) + lane;
#pragma unroll
        for (int j = 0; j < 4; ++j) { const f32x4 gg = gr[64 * j];
            o0[64 * j] = (unsigned long long)pk2(v0[j].x * r0 * gg.x, v0[j].y * r0 * gg.y) | ((unsigned long long)pk2(v0[j].z * r0 * gg.z, v0[j].w * r0 * gg.w) << 32);
            o1[64 * j] = (unsigned long long)pk2(v1[j].x * r1 * gg.x, v1[j].y * r1 * gg.y) | ((unsigned long long)pk2(v1[j].z * r1 * gg.z, v1[j].w * r1 * gg.w) << 32); }
    }
    for (int m = gw; m < 2048; m += NGW) rms_row_to_bf16(a.in[1] + (size_t)m * 1024, a.in[17], (bf16*)(ws + WS_MEMN) + (size_t)m * 1024, lane);
}
__device__ __forceinline__ void norm128_pass(bf16* X, int rows, int ld, int ngroups, const float* g, int gtid, int nthr) {
    const int l = gtid & 15, total = rows * ngroups;
    for (int gid = gtid >> 4; gid < total; gid += nthr >> 4) {
        const int r = gid / ngroups, gi = gid % ngroups;
        bf16* p = X + (size_t)r * ld + gi * 128 + l * 8;
        const v4u v = *(const GAS v4u*)p; float f[8];
        f[0] = __uint_as_float(v.x << 16); f[1] = __uint_as_float(v.x & 0xffff0000u); f[2] = __uint_as_float(v.y << 16); f[3] = __uint_as_float(v.y & 0xffff0000u);
        f[4] = __uint_as_float(v.z << 16); f[5] = __uint_as_float(v.z & 0xffff0000u); f[6] = __uint_as_float(v.w << 16); f[7] = __uint_as_float(v.w & 0xffff0000u);
        float s = 0.f;
#pragma unroll
        for (int q = 0; q < 8; ++q) s += f[q] * f[q];
        s += __shfl_xor(s, 8); s += __shfl_xor(s, 4); s += __shfl_xor(s, 2); s += __shfl_xor(s, 1);
        const float rs = 1.f / sqrtf(s * (1.f / 128.f) + 1e-6f);
        const f32x4 g0 = *(const GAS f32x4*)(g + l * 8), g1 = *(const GAS f32x4*)(g + l * 8 + 4);
        v4u o; o.x = pk2(f[0] * rs * g0.x, f[1] * rs * g0.y); o.y = pk2(f[2] * rs * g0.z, f[3] * rs * g0.w); o.z = pk2(f[4] * rs * g1.x, f[5] * rs * g1.y); o.w = pk2(f[6] * rs * g1.z, f[7] * rs * g1.w);
        *(GAS v4u*)p = o;
    }
}
__device__ __forceinline__ void s5_scan(int g, int half, const Args& a, int tid) {
    if (tid < 256) {
        const int bl = tid >> 6, n = tid & 63, b = half * 4 + bl;
        const float* LAM32 = (const float*)(a.ws + WS_LAM32) + g * 128; const float lr = LAM32[n * 2], li = LAM32[n * 2 + 1];
        const float* SL = (const float*)(a.ws + WS_SLOC) + ((size_t)(g * 512 + b * 64)) * 128; bf16* Ur = (bf16*)(a.ws + WS_U) + ((size_t)(g * 512 + b * 64)) * 640 + 512;
        float xr = 0.f, xi = 0.f;
#pragma unroll 1
        for (int c0 = 0; c0 < 64; c0 += 16) {
            float sr[16], si[16];
#pragma unroll
            for (int k = 0; k < 16; ++k) { sr[k] = SL[(size_t)(c0 + k) * 128 + n]; si[k] = SL[(size_t)(c0 + k) * 128 + 64 + n]; }
#pragma unroll
            for (int k = 0; k < 16; ++k) {
                Ur[(size_t)(c0 + k) * 640 + n] = (bf16)f2bf(xr); Ur[(size_t)(c0 + k) * 640 + 64 + n] = (bf16)f2bf(xi);
                const float nr = lr * xr - li * xi + sr[k], ni = lr * xi + li * xr + si[k]; xr = nr; xi = ni;
            }
        }
    }
    VM_WAIT(); __syncthreads();
}
namespace nv {
typedef unsigned short bf16;
__device__ __forceinline__ unsigned f2bf(float f) { unsigned u = __float_as_uint(f); return (u + 0x7fffu + ((u >> 16) & 1u)) >> 16; }
__device__ __forceinline__ float bf2f(unsigned short b) { return __uint_as_float((unsigned)b << 16); }

__global__ void k_transpose(const float* __restrict__ W, const float* __restrict__ W2, const float* __restrict__ gain,
                            bf16* __restrict__ WT, int K, int N, int ND, int mode) {
    const size_t total = (size_t)ND * K;
    for (size_t i = (size_t)blockIdx.x * blockDim.x + threadIdx.x; i < total; i += (size_t)gridDim.x * blockDim.x) {
        const int d = (int)(i / K), k = (int)(i % K);
        float v;
        if (mode == 0) v = W[(size_t)k * N + d];
        else if (mode == 1) { if (d >= 1736 && d < 1792) v = 0.f; else { const int s = d >= 1792 ? d - 56 : d; v = W[(size_t)k * N + s]; } }
        else { const int tile = d >> 8, w = d & 255, f = tile * 128 + (w & 127); v = ((w < 128) ? W : W2)[(size_t)k * N + f] * gain[k]; }
        WT[i] = (bf16)f2bf(v);
    }
}
__global__ void k_wuv(const float* __restrict__ W, bf16* __restrict__ WT) {
    const int i = blockIdx.x * blockDim.x + threadIdx.x; if (i >= 8 * 64 * 128) return;
    const int h = i / (64 * 128), e = (i / 128) % 64, d = i % 128;
    WT[i] = (bf16)f2bf(W[(h * 128 + d) * 64 + e]);
}
__global__ void k_rmsnorm1024(const float* __restrict__ x, const float* __restrict__ g, bf16* __restrict__ out, int rows) {
    __shared__ float red[4];
    const int r = blockIdx.x; if (r >= rows) return;
    const float4 v = ((const float4*)(x + (size_t)r * 1024))[threadIdx.x];
    float s = v.x * v.x + v.y * v.y + v.z * v.z + v.w * v.w;
    for (int o = 32; o; o >>= 1) s += __shfl_xor(s, o);
    if ((threadIdx.x & 63) == 0) red[threadIdx.x >> 6] = s;
    __syncthreads();
    const float tot = red[0] + red[1] + red[2] + red[3];
    const float rs = rsqrtf(tot * (1.f / 1024.f) + 1e-6f);
    const float4 gg = ((const float4*)g)[threadIdx.x];
    bf16* o = out + (size_t)r * 1024 + threadIdx.x * 4;
    o[0] = (bf16)f2bf(v.x * rs * gg.x); o[1] = (bf16)f2bf(v.y * rs * gg.y); o[2] = (bf16)f2bf(v.z * rs * gg.z); o[3] = (bf16)f2bf(v.w * rs * gg.w);
}
__device__ __forceinline__ int t5_bucket(int n) {
    if (n < 16) return n;
    const float nf = (float)n;
    int large = 16 + (int)((logf(nf / 16.f) / 2.0794415416798357f) * 16.f);
    return large < 31 ? large : 31;
}
__global__ void k_biaslut(const float* __restrict__ rel_bias, float* __restrict__ BL) {
    const int i = blockIdx.x * blockDim.x + threadIdx.x;
    if (i < 8 * 128) { const int h = i / 128, d = i % 128; BL[i] = rel_bias[t5_bucket(d) * 8 + h] * 1.4426950408889634f; }
    else if (i < 8 * 128 + 8) { const int h = i - 8 * 128; BL[i] = rel_bias[31 * 8 + h] * 1.4426950408889634f; }
}

template <class Epi>
__global__ void __launch_bounds__(256) k_gemm(const bf16* __restrict__ A, const bf16* __restrict__ Bt, int M, int N, int K, Epi epi) {
    const int tx = threadIdx.x & 15, ty = threadIdx.x >> 4;
    const int n0 = (blockIdx.x * 16 + tx) * 4, m0 = (blockIdx.y * 16 + ty) * 4;
    if (n0 >= N || m0 >= M) return;
    float acc[4][4];
#pragma unroll
    for (int i = 0; i < 4; ++i)
#pragma unroll
        for (int j = 0; j < 4; ++j) acc[i][j] = 0.f;
    for (int k = 0; k < K; k += 8) {
        uint4 a[4], b[4];
#pragma unroll
        for (int i = 0; i < 4; ++i) { a[i] = *(const uint4*)(A + (size_t)(m0 + i) * K + k); b[i] = *(const uint4*)(Bt + (size_t)(n0 + i) * K + k); }
#pragma unroll
        for (int i = 0; i < 4; ++i) {
            const unsigned aw[4] = {a[i].x, a[i].y, a[i].z, a[i].w};
#pragma unroll
            for (int j = 0; j < 4; ++j) {
                const unsigned bw[4] = {b[j].x, b[j].y, b[j].z, b[j].w};
#pragma unroll
                for (int q = 0; q < 4; ++q) {
                    acc[i][j] += __uint_as_float(aw[q] << 16) * __uint_as_float(bw[q] << 16);
                    acc[i][j] += __uint_as_float(aw[q] & 0xffff0000u) * __uint_as_float(bw[q] & 0xffff0000u);
                }
            }
        }
    }
#pragma unroll
    for (int i = 0; i < 4; ++i)
#pragma unroll
        for (int j = 0; j < 4; ++j) epi(m0 + i, n0 + j, acc[i][j]);
}

struct EpiInproj {
    bf16 *QD, *CKV, *QI, *KI, *U, *QX; float* WI;
    __device__ void operator()(int t, int c, float v) const {
        if (c < 1024) QD[(size_t)t * 1024 + c] = (bf16)f2bf(v);
        else if (c < 1152) CKV[(size_t)t * 128 + (c - 1024)] = (bf16)f2bf(v);
        else if (c < 1664) QI[(size_t)t * 512 + (c - 1152)] = (bf16)f2bf(v);
        else if (c < 1728) KI[(size_t)t * 64 + (c - 1664)] = (bf16)f2bf(v);
        else if (c < 1792) { if (c < 1736) WI[(size_t)t * 8 + (c - 1728)] = v; }
        else if (c < 2304) { const int cu = c - 1792, g = cu >> 4, ci = cu & 15, b = t >> 11, tt = t & 2047, R = b * 64 + (tt >> 5), s = tt & 31;
            U[((size_t)(g * 512 + R)) * 640 + s * 16 + ci] = (bf16)f2bf(v); }
        else QX[(size_t)t * 512 + (c - 2304)] = (bf16)f2bf(v);
    }
};
struct EpiBf16Split { bf16* O0; bf16* O1; int split; int ld;
    __device__ void operator()(int m, int c, float v) const { if (c < split) O0[(size_t)m * ld + c] = (bf16)f2bf(v); else O1[(size_t)m * ld + (c - split)] = (bf16)f2bf(v); } };
struct EpiGlu { const bf16* Y; bf16* O;
    __device__ void operator()(int m, int c, float v) const { const float y = bf2f(Y[(size_t)m * 512 + c]); O[(size_t)m * 512 + c] = (bf16)f2bf(y / (1.f + __expf(-v))); } };
struct EpiSigmoid { bf16* G; __device__ void operator()(int m, int c, float v) const { G[(size_t)m * 1024 + c] = (bf16)f2bf(1.f / (1.f + __expf(-v))); } };
struct EpiMerge { const bf16* G; bf16* MG; int first; int pad;
    __device__ void operator()(int m, int c, float v) const { const size_t i = (size_t)m * 1024 + c; float p = first ? 0.f : bf2f(MG[i]); MG[i] = (bf16)f2bf(p + bf2f(G[i]) * v); } };
struct EpiOut { const float* x; float* x1; bf16* XN;
    __device__ void operator()(int m, int c, float v) const { const size_t i = (size_t)m * 1024 + c; const float r = x[i] + v; x1[i] = r; XN[i] = (bf16)f2bf(r); } };
struct EpiDown { float* out;
    __device__ void operator()(int m, int c, float v) const { const size_t i = (size_t)m * 1024 + c; out[i] = out[i] + v; } };
struct EpiF32 { float* C; int ld; __device__ void operator()(int m, int c, float v) const { C[(size_t)m * ld + c] = v; } };

__global__ void k_rowss(const float* __restrict__ x1, float* __restrict__ RS) {
    const int t = blockIdx.x, q = threadIdx.x >> 6, l = threadIdx.x & 63;
    const float4 v = ((const float4*)(x1 + (size_t)t * 1024 + q * 256))[l];
    float s = v.x * v.x + v.y * v.y + v.z * v.z + v.w * v.w;
    for (int o = 32; o; o >>= 1) s += __shfl_xor(s, o);
    if (l == 0) RS[t * 16 + q] = s;
    if (l >= 4 && l < 16 && q == 0) RS[t * 16 + l] = 0.f;
}
__global__ void __launch_bounds__(256) k_gemm_gu(const bf16* __restrict__ A, const bf16* __restrict__ Bt, const float* __restrict__ RS, bf16* __restrict__ ACT) {
    const int K = 1024;
    const int tx = threadIdx.x & 15, ty = threadIdx.x >> 4;
    const int f0 = (blockIdx.x * 16 + tx) * 4, m0 = (blockIdx.y * 16 + ty) * 4;
    float ag[4][4], au[4][4];
#pragma unroll
    for (int i = 0; i < 4; ++i)
#pragma unroll
        for (int j = 0; j < 4; ++j) { ag[i][j] = 0.f; au[i][j] = 0.f; }
    for (int k = 0; k < K; k += 8) {
        uint4 a[4], bg[4], bu[4];
#pragma unroll
        for (int i = 0; i < 4; ++i) { a[i] = *(const uint4*)(A + (size_t)(m0 + i) * K + k);
            const int f = f0 + i, rg = (f >> 7) * 256 + (f & 127);
            bg[i] = *(const uint4*)(Bt + (size_t)rg * K + k); bu[i] = *(const uint4*)(Bt + (size_t)(rg + 128) * K + k); }
#pragma unroll
        for (int i = 0; i < 4; ++i) {
            const unsigned aw[4] = {a[i].x, a[i].y, a[i].z, a[i].w};
#pragma unroll
            for (int j = 0; j < 4; ++j) {
                const unsigned gw[4] = {bg[j].x, bg[j].y, bg[j].z, bg[j].w};
                const unsigned uw[4] = {bu[j].x, bu[j].y, bu[j].z, bu[j].w};
#pragma unroll
                for (int q = 0; q < 4; ++q) {
                    const float alo = __uint_as_float(aw[q] << 16), ahi = __uint_as_float(aw[q] & 0xffff0000u);
                    ag[i][j] += alo * __uint_as_float(gw[q] << 16); ag[i][j] += ahi * __uint_as_float(gw[q] & 0xffff0000u);
                    au[i][j] += alo * __uint_as_float(uw[q] << 16); au[i][j] += ahi * __uint_as_float(uw[q] & 0xffff0000u);
                }
            }
        }
    }
#pragma unroll
    for (int i = 0; i < 4; ++i) { const int m = m0 + i;
        float tot = 0.f; for (int q = 0; q < 16; ++q) tot += RS[m * 16 + q];
        const float rs = rsqrtf(tot * (1.f / 1024.f) + 1e-6f);
#pragma unroll
        for (int j = 0; j < 4; ++j) { const float g = ag[i][j] * rs, u = au[i][j] * rs;
            ACT[(size_t)m * 2816 + f0 + j] = (bf16)f2bf(g / (1.f + __expf(-g)) * u); } }
}

__global__ void k_norm128(bf16* __restrict__ X, int rows, int ld, int ngroups, const float* __restrict__ g) {
    const int gid = (blockIdx.x * blockDim.x + threadIdx.x) >> 4, l = threadIdx.x & 15;
    const bool ok = gid < rows * ngroups;
    const int r = ok ? gid / ngroups : 0, gi = ok ? gid % ngroups : 0;
    bf16* p = X + (size_t)r * ld + gi * 128 + l * 8;
    uint4 v = *(const uint4*)p; const unsigned w[4] = {v.x, v.y, v.z, v.w};
    float f[8];
#pragma unroll
    for (int q = 0; q < 4; ++q) { f[2 * q] = __uint_as_float(w[q] << 16); f[2 * q + 1] = __uint_as_float(w[q] & 0xffff0000u); }
    float s = 0.f;
#pragma unroll
    for (int q = 0; q < 8; ++q) s += f[q] * f[q];
    for (int o = 8; o; o >>= 1) s += __shfl_xor(s, o);
    const float rs = rsqrtf(s * (1.f / 128.f) + 1e-6f);
    unsigned o4[4];
#pragma unroll
    for (int q = 0; q < 4; ++q) o4[q] = f2bf(f[2 * q] * rs * g[l * 8 + 2 * q]) | (f2bf(f[2 * q + 1] * rs * g[l * 8 + 2 * q + 1]) << 16);
    if (ok) *(uint4*)p = make_uint4(o4[0], o4[1], o4[2], o4[3]);
}

__global__ void __launch_bounds__(256) k_dsa(const bf16* __restrict__ QD, const bf16* __restrict__ CKV, const bf16* __restrict__ QI, const bf16* __restrict__ KI,
                                             const float* __restrict__ WI, const float* __restrict__ BL, const bf16* __restrict__ WUVT, bf16* __restrict__ ODSA) {
    __shared__ float sc[2048];
    __shared__ float qi[512];
    __shared__ float qd[1024];
    __shared__ float wh[8];
    __shared__ int sel[256];
    __shared__ float pr[256];
    __shared__ float ov[128];
    __shared__ float red[8];
    __shared__ int nsel;
    const int row = blockIdx.x, b = row >> 11, t = row & 2047, tid = threadIdx.x;
    for (int i = tid; i < 512; i += 256) qi[i] = bf2f(QI[(size_t)row * 512 + i]);
    for (int i = tid; i < 1024; i += 256) qd[i] = bf2f(QD[(size_t)row * 1024 + i]);
    if (tid < 8) wh[tid] = WI[(size_t)row * 8 + tid];
    if (tid == 0) nsel = 0;
    __syncthreads();
    const int nk = t + 1;
    for (int s = tid; s < nk; s += 256) {
        const bf16* kp = KI + ((size_t)(b * 2048 + s)) * 64;
        float kf[64];
#pragma unroll
        for (int d = 0; d < 64; ++d) kf[d] = bf2f(kp[d]);
        float score = 0.f;
        for (int h = 0; h < 8; ++h) { float dsum = 0.f;
#pragma unroll
            for (int d = 0; d < 64; ++d) dsum += qi[h * 64 + d] * kf[d];
            score += fmaxf(dsum, 0.f) * wh[h]; }
        sc[s] = score;
    }
    __syncthreads();
    for (int s = tid; s < nk; s += 256) {
        bool take;
        if (nk <= 256) take = true;
        else { const float v = sc[s]; int cnt = 0;
            for (int s2 = 0; s2 < nk; ++s2) { const float w = sc[s2]; cnt += (w > v || (w == v && s2 < s)) ? 1 : 0; }
            take = cnt < 256; }
        if (take) { const int p = atomicAdd(&nsel, 1); if (p < 256) sel[p] = s; }
    }
    __syncthreads();
    const int ns = nsel < 256 ? nsel : 256;
    const float scale = 0.08838834764831845f * 1.4426950408889634f;
    for (int h = 0; h < 8; ++h) {
        float lg = -INFINITY;
        if (tid < ns) { const int s = sel[tid]; const bf16* cp = CKV + ((size_t)(b * 2048 + s)) * 128; float dsum = 0.f;
            for (int d = 0; d < 128; ++d) dsum += qd[h * 128 + d] * bf2f(cp[d]);
            const int dist = t - s; const float bias = dist < 128 ? BL[h * 128 + dist] : BL[8 * 128 + h];
            lg = dsum * scale + bias; }
        float m = lg; for (int o = 32; o; o >>= 1) m = fmaxf(m, __shfl_xor(m, o));
        if ((tid & 63) == 0) red[tid >> 6] = m;
        __syncthreads();
        m = fmaxf(fmaxf(red[0], red[1]), fmaxf(red[2], red[3]));
        const float p = (tid < ns) ? exp2f(lg - m) : 0.f;
        float sum = p; for (int o = 32; o; o >>= 1) sum += __shfl_xor(sum, o);
        if ((tid & 63) == 0) red[4 + (tid >> 6)] = sum;
        pr[tid] = p;
        __syncthreads();
        sum = red[4] + red[5] + red[6] + red[7];
        if (tid < 128) { float o = 0.f; for (int k = 0; k < ns; ++k) o += pr[k] * bf2f(CKV[((size_t)(b * 2048 + sel[k])) * 128 + tid]); ov[tid] = o / sum; }
        __syncthreads();
        if (tid < 64) { float o = 0.f; const bf16* wp = WUVT + ((size_t)(h * 64 + tid)) * 128; for (int d = 0; d < 128; ++d) o += ov[d] * bf2f(wp[d]);
            ODSA[(size_t)row * 512 + h * 64 + tid] = (bf16)f2bf(o); }
        __syncthreads();
    }
}

__global__ void __launch_bounds__(256) k_cross(const bf16* __restrict__ QX, const bf16* __restrict__ KX, const bf16* __restrict__ VX, bf16* __restrict__ OX) {
    __shared__ float q[512]; __shared__ float pr[256]; __shared__ float red[8];
    const int row = blockIdx.x, b = row >> 11, tid = threadIdx.x;
    for (int i = tid; i < 512; i += 256) q[i] = bf2f(QX[(size_t)row * 512 + i]);
    __syncthreads();
    const float scale = 0.08838834764831845f * 1.4426950408889634f;
    for (int h = 0; h < 4; ++h) {
        const bf16* kp = KX + ((size_t)(b * 256 + tid)) * 512 + h * 128; float dsum = 0.f;
        for (int d = 0; d < 128; ++d) dsum += q[h * 128 + d] * bf2f(kp[d]);
        const float lg = dsum * scale;
        float m = lg; for (int o = 32; o; o >>= 1) m = fmaxf(m, __shfl_xor(m, o));
        if ((tid & 63) == 0) red[tid >> 6] = m;
        __syncthreads();
        m = fmaxf(fmaxf(red[0], red[1]), fmaxf(red[2], red[3]));
        const float p = exp2f(lg - m);
        float sum = p; for (int o = 32; o; o >>= 1) sum += __shfl_xor(sum, o);
        if ((tid & 63) == 0) red[4 + (tid >> 6)] = sum;
        pr[tid] = p;
        __syncthreads();
        sum = red[4] + red[5] + red[6] + red[7];
        if (tid < 128) { float o = 0.f; for (int k = 0; k < 256; ++k) o += pr[k] * bf2f(VX[((size_t)(b * 256 + k)) * 512 + h * 128 + tid]);
            OX[(size_t)row * 512 + h * 128 + tid] = (bf16)f2bf(o / sum); }
        __syncthreads();
    }
}

__device__ __forceinline__ float gelu_tanh(float x) { const float u = 0.7978845608028654f * (x + 0.044715f * x * x * x); return 0.5f * x * (1.f + tanhf(u)); }
__global__ void __launch_bounds__(64) k_s5(const bf16* __restrict__ U, const float* __restrict__ a_re, const float* __restrict__ a_im, const float* __restrict__ log_dt,
                                           const float* __restrict__ b_re, const float* __restrict__ b_im, const float* __restrict__ c_re, const float* __restrict__ c_im,
                                           const float* __restrict__ d_skip, bf16* __restrict__ Y) {
    const int b = blockIdx.x >> 5, g = blockIdx.x & 31, n = threadIdx.x;
    const double dt = exp((double)log_dt[g]);
    const double lr = (double)a_re[g * 64 + n], li = (double)a_im[g * 64 + n];
    const double mag = exp(lr * dt), lbr = mag * cos(li * dt), lbi = mag * sin(li * dt);
    const double nr = lbr - 1.0, ni = lbi, den = lr * lr + li * li;
    const double fr = (nr * lr + ni * li) / den, fi = (ni * lr - nr * li) / den;
    float Bre[16], Bim[16], Cre[16], Cim[16];
#pragma unroll
    for (int c = 0; c < 16; ++c) { const double br = b_re[(g * 64 + n) * 16 + c], bi = b_im[(g * 64 + n) * 16 + c];
        Bre[c] = (float)(fr * br - fi * bi); Bim[c] = (float)(fr * bi + fi * br);
        Cre[c] = c_re[(g * 16 + c) * 64 + n]; Cim[c] = c_im[(g * 16 + c) * 64 + n]; }
    const float ar = (float)lbr, ai = (float)lbi;
    const float dsk = n < 16 ? d_skip[g * 16 + n] : 0.f;
    float xr = 0.f, xi = 0.f;
    for (int t = 0; t < 2048; ++t) {
        const int R = b * 64 + (t >> 5), s = t & 31;
        const bf16* up = U + ((size_t)(g * 512 + R)) * 640 + s * 16;
        float u[16]; float bur = 0.f, bui = 0.f;
#pragma unroll
        for (int c = 0; c < 16; ++c) { u[c] = bf2f(up[c]); bur += Bre[c] * u[c]; bui += Bim[c] * u[c]; }
        const float nxr = ar * xr - ai * xi + bur, nxi = ar * xi + ai * xr + bui; xr = nxr; xi = nxi;
        float yout = 0.f;
#pragma unroll
        for (int c = 0; c < 16; ++c) { float v = Cre[c] * xr - Cim[c] * xi;
            for (int o = 32; o; o >>= 1) v += __shfl_xor(v, o);
            if (n == c) yout = v + dsk * u[c]; }
        if (n < 16) Y[(size_t)(b * 2048 + t) * 512 + g * 16 + n] = (bf16)f2bf(gelu_tanh(yout));
    }
}
}
#define HAVE_ATTN 1
#ifdef TPROBE
#if TPROBE < 8
#define TP_STAMP(k) { __builtin_amdgcn_sched_barrier(0); const unsigned long long t_ = __builtin_amdgcn_s_memtime(); tp_acc[k] += t_ - tp_prev; tp_prev = t_; __builtin_amdgcn_sched_barrier(0); }
#define TP_DECL unsigned long long tp_acc[8] = {0, 0, 0, 0, 0, 0, 0, 0}; unsigned long long tp_prev = __builtin_amdgcn_s_memtime();
#define TP_FLUSH(base) { if (blockIdx.x == TPROBE_BLOCK && wave == 0 && lane == 0) { unsigned long long* TP = (unsigned long long*)(a.ws + WS_CTL + 65536); for (int k_ = 0; k_ < 8; ++k_) TP[(base) + k_] += tp_acc[k_]; } }
#define TQ_STAMP(k)
#define TQ_DECL
#define TQ_FLUSH
#else
#define TP_STAMP(k)
#define TP_DECL
#define TP_FLUSH(base)
#define TQ_STAMP(k) { const unsigned t_ = (unsigned)__builtin_amdgcn_s_memtime(); tq_acc[k] += t_ - tq_prev; tq_prev = t_; }
#define TQ_DECL unsigned tq_acc[4] = {0, 0, 0, 0}; unsigned tq_prev = (unsigned)__builtin_amdgcn_s_memtime();
#define TQ_FLUSH { if (blockIdx.x == TPROBE_BLOCK && wave == 0 && lane == 0) { unsigned long long* TP = (unsigned long long*)(a.ws + WS_CTL + 65536); for (int k_ = 0; k_ < 4; ++k_) TP[8 + k_] += tq_acc[k_]; } }
#endif
#else
#define TP_STAMP(k)
#define TP_DECL
#define TP_FLUSH(base)
#define TQ_STAMP(k)
#define TQ_DECL
#define TQ_FLUSH
#endif
namespace att {
typedef float f32x16 __attribute__((ext_vector_type(16)));
typedef short s16x4 __attribute__((ext_vector_type(4)));
typedef short v4i16_t __attribute__((ext_vector_type(4)));
typedef float f32x2_t __attribute__((ext_vector_type(2))); typedef __bf16 bf16x2_t __attribute__((ext_vector_type(2)));
typedef unsigned u32x2 __attribute__((ext_vector_type(2)));
#define MFMA32(a, b, c) __builtin_amdgcn_mfma_f32_32x32x16_bf16((a), (b), (c), 0, 0, 0)
__device__ __forceinline__ unsigned cvtpk(float lo, float hi) { const f32x2_t v = {lo, hi}; const bf16x2_t b = __builtin_convertvector(v, bf16x2_t); return __builtin_bit_cast(unsigned, b); }
__device__ __forceinline__ int crow(int r, int hi) { return (r & 3) + 8 * (r >> 2) + 4 * hi; }
__device__ __forceinline__ unsigned off_b(unsigned row, unsigned ch) { return 256u * row + 16u * (ch ^ (((row & 3u) << 2) | ((row >> 2) & 3u))); }
__device__ __forceinline__ float xh_max(float v) { const auto rr = __builtin_amdgcn_permlane32_swap(__float_as_uint(v), __float_as_uint(v), false, false); return fmaxf(__uint_as_float(rr[0]), __uint_as_float(rr[1])); }
__device__ __forceinline__ float xh_sum(float v) { const auto rr = __builtin_amdgcn_permlane32_swap(__float_as_uint(v), __float_as_uint(v), false, false); return __uint_as_float(rr[0]) + __uint_as_float(rr[1]); }
__device__ __forceinline__ unsigned xh_sumu(unsigned v) { const auto rr = __builtin_amdgcn_permlane32_swap(v, v, false, false); return rr[0] + rr[1]; }
__device__ __forceinline__ unsigned xh_or(unsigned v) { const auto rr = __builtin_amdgcn_permlane32_swap(v, v, false, false); return rr[0] | rr[1]; }
constexpr float SCALE2 = 0.08838834764831845f * 1.4426950408889634f;

__device__ __forceinline__ bf16x8 pack_step(const f32x16& x, int s) {
    v4u p; p.x = cvtpk(x[8 * s], x[8 * s + 1]); p.y = cvtpk(x[8 * s + 2], x[8 * s + 3]); p.z = cvtpk(x[8 * s + 4], x[8 * s + 5]); p.w = cvtpk(x[8 * s + 6], x[8 * s + 7]);
    return __builtin_bit_cast(bf16x8, p);
}
__device__ __forceinline__ void qk_tile(f32x16& p0, f32x16& p1, LAS const unsigned char* kimg, const bf16x8 (&qf)[8], int lane) {
    const unsigned r32 = lane & 31, hi = lane >> 5;
    f32x16 z;
#pragma unroll
    for (int r = 0; r < 16; ++r) z[r] = 0.f;
    p0 = z; p1 = z;
    bf16x8 fa[2][4];
#define QK_LOAD(g, buf) { const unsigned o0_ = off_b(r32, 4 * (g) + hi), o1_ = off_b(r32, 4 * (g) + 2 + hi); \
        fa[buf][0] = *(LAS const bf16x8*)(kimg + o0_); fa[buf][1] = *(LAS const bf16x8*)(kimg + o0_ + 32 * 256); fa[buf][2] = *(LAS const bf16x8*)(kimg + o1_); fa[buf][3] = *(LAS const bf16x8*)(kimg + o1_ + 32 * 256); }
#define QK_MMA(g, buf) { p0 = MFMA32(fa[buf][0], qf[2 * (g)], p0); p1 = MFMA32(fa[buf][1], qf[2 * (g)], p1); p0 = MFMA32(fa[buf][2], qf[2 * (g) + 1], p0); p1 = MFMA32(fa[buf][3], qf[2 * (g) + 1], p1); }
    QK_LOAD(0, 0) QK_LOAD(1, 1) QK_MMA(0, 0) asm volatile("" ::: "memory");
    QK_LOAD(2, 0) QK_MMA(1, 1) asm volatile("" ::: "memory");
    QK_LOAD(3, 1) QK_MMA(2, 0) QK_MMA(3, 1)
#undef QK_LOAD
#undef QK_MMA
}
__device__ __forceinline__ s16x4 vtr(LAS const unsigned char* p) { return __builtin_bit_cast(s16x4, __builtin_amdgcn_ds_read_tr16_b64_v4i16((LAS v4i16_t*)p)); }
__device__ __forceinline__ void pv_tile(f32x16 (&o)[4], LAS const unsigned char* vimg, const bf16x8 (&pf)[4], int lane) {
    const unsigned hi = lane >> 5, blk = (lane >> 4) & 1, q = (lane & 15) >> 2, p = lane & 3;
    s16x4 fl[2][4], fh[2][4];
#define PV_LOAD(c, buf) { _Pragma("unroll") for (int ks = 0; ks < 4; ++ks) { const unsigned ch = 4 * (c) + 2 * blk + (p >> 1), rlo = 16 * ks + 4 * hi + q; \
        fl[buf][ks] = vtr(vimg + off_b(rlo, ch) + 8 * (p & 1)); fh[buf][ks] = vtr(vimg + off_b(rlo + 8, ch) + 8 * (p & 1)); } }
#define PV_MMA(c, buf) { _Pragma("unroll") for (int ks = 0; ks < 4; ++ks) { const bf16x8 af = {fl[buf][ks][0], fl[buf][ks][1], fl[buf][ks][2], fl[buf][ks][3], fh[buf][ks][0], fh[buf][ks][1], fh[buf][ks][2], fh[buf][ks][3]}; \
        o[c] = MFMA32(af, pf[ks], o[c]); } }
    PV_LOAD(0, 0) PV_LOAD(1, 1) PV_MMA(0, 0) asm volatile("" ::: "memory");
    PV_LOAD(2, 0) PV_MMA(1, 1) asm volatile("" ::: "memory");
    PV_LOAD(3, 1) PV_MMA(2, 0) PV_MMA(3, 1)
#undef PV_LOAD
#undef PV_MMA
}
template <bool FIXED> __device__ __forceinline__ void softmax_step(f32x16& p0, f32x16& p1, float& m, float& l, f32x16 (&o)[4], bf16x8 (&pf)[4]) {
    if constexpr (FIXED) {
        f32x2_t s2 = {0.f, 0.f};
#pragma unroll
        for (int r = 0; r < 16; ++r) { p0[r] = __builtin_amdgcn_exp2f(p0[r]); p1[r] = __builtin_amdgcn_exp2f(p1[r]); const f32x2_t t = {p0[r], p1[r]}; s2 += t; }
        l += s2[0] + s2[1];
    } else {
        float mx = fmaxf(p0[0], p1[0]);
#pragma unroll
        for (int r = 1; r < 16; ++r) mx = fmaxf(mx, fmaxf(p0[r], p1[r]));
        mx = xh_max(mx);
        const float mnew = fmaxf(m, mx), muse = (mnew == -INFINITY) ? 0.f : mnew;
        const float alpha = __builtin_amdgcn_exp2f(m - muse);
        float s = 0.f;
#pragma unroll
        for (int r = 0; r < 16; ++r) { p0[r] = __builtin_amdgcn_exp2f(p0[r] - muse); p1[r] = __builtin_amdgcn_exp2f(p1[r] - muse); s += p0[r] + p1[r]; }
        l = l * alpha + s; m = mnew;
        if (__any(alpha != 1.f)) {
#pragma unroll
            for (int c = 0; c < 4; ++c)
#pragma unroll
                for (int r = 0; r < 16; ++r) o[c][r] *= alpha;
        }
    }
    pf[0] = pack_step(p0, 0); pf[1] = pack_step(p0, 1); pf[2] = pack_step(p1, 0); pf[3] = pack_step(p1, 1);
}
__device__ __forceinline__ void tile_load(v4u (&rg)[2], const bf16* src, int pitch, int tid) {
#pragma unroll
    for (int i = 0; i < 2; ++i) { const int id = tid + 512 * i, row = id >> 4, ch = id & 15; rg[i] = *(const GAS v4u*)(src + (size_t)row * pitch + ch * 8); }
}
__device__ __forceinline__ void tile_store(const v4u (&rg)[2], LAS unsigned char* img, int tid) {
#pragma unroll
    for (int i = 0; i < 2; ++i) { const int id = tid + 512 * i, row = id >> 4, ch = id & 15; *(LAS v4u*)(img + off_b(row, ch)) = rg[i]; }
}

__device__ __forceinline__ void cross_item(const Args& a, LAS unsigned char* lds, int tid, int lane, int wave, int item) {
    const int r32 = lane & 31, hi = lane >> 5;
    const int b = item >> 5, hx = (item >> 3) & 3, qblk = item & 7;
    const bf16* QX = (const bf16*)(a.ws + WS_QX); const bf16* KX = (const bf16*)(a.ws + WS_KX) + (size_t)b * 256 * 512 + hx * 128; const bf16* VX = (const bf16*)(a.ws + WS_VX) + (size_t)b * 256 * 512 + hx * 128;
    bf16* OX = (bf16*)(a.ws + WS_OX);
    const size_t row = (size_t)b * 2048 + qblk * 256 + wave * 32 + r32;
    bf16x8 qf[8];
#pragma unroll
    for (int s = 0; s < 8; ++s) qf[s] = *(const GAS bf16x8*)(QX + row * 512 + hx * 128 + 16 * s + 8 * hi);
    f32x16 o[4];
#pragma unroll
    for (int c = 0; c < 4; ++c)
#pragma unroll
        for (int r = 0; r < 16; ++r) o[c][r] = 0.f;
    float m = -INFINITY, l = 0.f;
    v4u kr[2], vr[2];
    tile_load(kr, KX, 512, tid); tile_load(vr, VX, 512, tid);
    tile_store(kr, lds, tid); tile_store(vr, lds + 32768, tid);
    __syncthreads();
#pragma unroll 1
    for (int kt = 0; kt < 4; ++kt) {
        LAS unsigned char* kimg = lds + (kt & 1) * 16384; LAS unsigned char* vimg = lds + 32768 + (kt & 1) * 16384;
        if (kt + 1 < 4) { tile_load(kr, KX + (size_t)(kt + 1) * 64 * 512, 512, tid); tile_load(vr, VX + (size_t)(kt + 1) * 64 * 512, 512, tid); }
        f32x16 p0, p1; qk_tile(p0, p1, kimg, qf, lane);
#pragma unroll
        for (int r = 0; r < 16; ++r) { p0[r] *= SCALE2; p1[r] *= SCALE2; }
        bf16x8 pf[4]; softmax_step<false>(p0, p1, m, l, o, pf);
        pv_tile(o, vimg, pf, lane);
        if (kt + 1 < 4) { tile_store(kr, lds + ((kt + 1) & 1) * 16384, tid); tile_store(vr, lds + 32768 + ((kt + 1) & 1) * 16384, tid); }
        __syncthreads();
    }
    l = xh_sum(l);
    const float inv = 1.f / l;
#pragma unroll
    for (int c = 0; c < 4; ++c)
#pragma unroll
        for (int g4 = 0; g4 < 4; ++g4) { u32x2 w; w.x = cvtpk(o[c][4 * g4] * inv, o[c][4 * g4 + 1] * inv); w.y = cvtpk(o[c][4 * g4 + 2] * inv, o[c][4 * g4 + 3] * inv);
            *(GAS u32x2*)(OX + row * 512 + hx * 128 + 32 * c + 8 * g4 + 4 * hi) = w; }
}
__device__ __forceinline__ void cross_phase(const Args& a, LAS unsigned char* lds, int tid, int lane, int wave, int bx, int G) {
    if (bx < 128) return;
#pragma unroll 1
    for (int i = 0; i < 2; ++i) cross_item(a, lds, tid, lane, wave, (bx - 128) * 2 + i);
}

constexpr int DSA_QI = 0, DSA_QPITCH = 1040, DSA_KTB = 33792, DSA_CT = DSA_KTB, DSA_MASK = DSA_KTB + 2 * 32 * 257 * 4, DSA_BT = DSA_MASK + 32 * 65 * 4, DSA_END = DSA_BT + 8 * 320 * 4;
static_assert(DSA_END <= RING_BYTES, "DSA LDS map");
__device__ __forceinline__ unsigned f2key(float x) { const unsigned b = __float_as_uint(x + 0.f); return (b & 0x80000000u) ? ~b : (b | 0x80000000u); }

__device__ __forceinline__ void cnt_ge(unsigned& cnt, unsigned key, unsigned cand) { asm volatile("v_cmp_ge_u32 vcc, %1, %2\n\tv_addc_co_u32_e32 %0, vcc, 0, %0, vcc" : "+v"(cnt) : "v"(key), "v"(cand) : "vcc"); }
__device__ __forceinline__ void cnt_gt(unsigned& cnt, unsigned key, unsigned cand) { asm volatile("v_cmp_gt_u32 vcc, %1, %2\n\tv_addc_co_u32_e32 %0, vcc, 0, %0, vcc" : "+v"(cnt) : "v"(key), "v"(cand) : "vcc"); }
__device__ __forceinline__ void cnt_eq(unsigned& cnt, unsigned key, unsigned cand) { asm volatile("v_cmp_eq_u32 vcc, %1, %2\n\tv_addc_co_u32_e32 %0, vcc, 0, %0, vcc" : "+v"(cnt) : "v"(key), "v"(cand) : "vcc"); }
__device__ __forceinline__ void cnt4_ge(unsigned& c0, unsigned& c1, unsigned& c2, unsigned& c3, unsigned k0, unsigned k1, unsigned k2, unsigned k3, unsigned cand) {
    unsigned long long m0, m1, m2;
    asm volatile("v_cmp_ge_u32 %4, %7, %11\n\tv_cmp_ge_u32 %5, %8, %11\n\tv_cmp_ge_u32 %6, %9, %11\n\tv_cmp_ge_u32 vcc, %10, %11\n\t"
                 "v_addc_co_u32_e64 %0, %4, 0, %0, %4\n\tv_addc_co_u32_e64 %1, %5, 0, %1, %5\n\tv_addc_co_u32_e64 %2, %6, 0, %2, %6\n\tv_addc_co_u32_e32 %3, vcc, 0, %3, vcc"
                 : "+v"(c0), "+v"(c1), "+v"(c2), "+v"(c3), "=&s"(m0), "=&s"(m1), "=&s"(m2) : "v"(k0), "v"(k1), "v"(k2), "v"(k3), "v"(cand) : "vcc");
}
template <int IB> __device__ __forceinline__ void cnt_tie_lt(unsigned& cnt, unsigned key, unsigned thr, unsigned lanepart, unsigned cand) { unsigned t;
    asm volatile("v_add_u32_e32 %1, %6, %4\n\tv_cmp_eq_u32 vcc, %2, %3\n\tv_cndmask_b32_e32 %1, -1, %1, vcc\n\tv_cmp_lt_u32 vcc, %1, %5\n\tv_addc_co_u32_e32 %0, vcc, 0, %0, vcc"
                 : "+v"(cnt), "=&v"(t) : "v"(key), "v"(thr), "v"(lanepart), "v"(cand), "i"(IB) : "vcc"); }
template <int IB, int BR> __device__ __forceinline__ void mask_sel(unsigned& w, unsigned key, unsigned thr, unsigned lanepart, unsigned istar, unsigned onehi) { unsigned t, bit;
    asm volatile("v_lshlrev_b32_e32 %2, %8, %7\n\tv_cmp_gt_u32 vcc, %3, %4\n\tv_cndmask_b32_e32 %1, 0, %2, vcc\n\tv_or_b32_e32 %0, %0, %1\n\t"
                 "v_add_u32_e32 %1, %9, %5\n\tv_cmp_le_u32 vcc, %1, %6\n\tv_cndmask_b32_e32 %1, 0, %2, vcc\n\tv_cmp_eq_u32 vcc, %3, %4\n\tv_cndmask_b32_e32 %1, 0, %1, vcc\n\tv_or_b32_e32 %0, %0, %1"
                 : "+v"(w), "=&v"(t), "=&v"(bit) : "v"(key), "v"(thr), "v"(lanepart), "v"(istar), "v"(onehi), "i"(BR), "i"(IB) : "vcc"); }

#define CRB(r) (((r) & 3) + 8 * ((r) >> 2))
#define TIE1(i, r) cnt_tie_lt<256 * (i) + CRB(r)>(cnt, key[i][r], thr, lanepart, cand);
#define TIE_ROW(i) TIE1(i,0) TIE1(i,1) TIE1(i,2) TIE1(i,3) TIE1(i,4) TIE1(i,5) TIE1(i,6) TIE1(i,7) TIE1(i,8) TIE1(i,9) TIE1(i,10) TIE1(i,11) TIE1(i,12) TIE1(i,13) TIE1(i,14) TIE1(i,15)
#define SEL1(i, r) mask_sel<256 * (i) + CRB(r), CRB(r)>(w, key[i][r], thr, lanepart, istar, onehi);
#define SEL_ROW(i) SEL1(i,0) SEL1(i,1) SEL1(i,2) SEL1(i,3) SEL1(i,4) SEL1(i,5) SEL1(i,6) SEL1(i,7) SEL1(i,8) SEL1(i,9) SEL1(i,10) SEL1(i,11) SEL1(i,12) SEL1(i,13) SEL1(i,14) SEL1(i,15)
__device__ __forceinline__ unsigned row_total(unsigned cnt, LAS unsigned* CNT, int& par, int r32, int hi, int wave) {
    cnt = xh_sumu(cnt);
    if (hi == 0) CNT[par * 256 + r32 * 8 + wave] = cnt;
    __syncthreads();
    const v4u x = *(LAS const v4u*)(CNT + par * 256 + r32 * 8), y = *(LAS const v4u*)(CNT + par * 256 + r32 * 8 + 4);
    par ^= 1;
    return (x.x + x.y) + (x.z + x.w) + (y.x + y.y) + (y.z + y.w);
}
template <bool FIXED> __device__ __forceinline__ void dsa_attn(const Args& a, LAS unsigned char* lds, int tid, int lane, int wave, int b, int qb, bool sel) {
    const int r32 = lane & 31, hi = lane >> 5;
    const int t0 = qb * 32; const size_t rowb = (size_t)b * 2048;
    const bf16* QD = (const bf16*)(a.ws + WS_QD); const bf16* CKV = (const bf16*)(a.ws + WS_CKV) + rowb * 128;
    const float* BL = (const float*)(a.ws + WS_BIASL); const bf16* WUV = (const bf16*)(a.ws + WS_WUV); bf16* ODSA = (bf16*)(a.ws + WS_ODSA);
    LAS unsigned* MASK = (LAS unsigned*)(lds + DSA_MASK);
    const int h = wave; const int tq = t0 + r32; const size_t qrow = rowb + t0 + r32;
    bf16x8 qf[8];
#pragma unroll
    for (int s = 0; s < 8; ++s) qf[s] = *(const GAS bf16x8*)(QD + qrow * 1024 + h * 128 + 16 * s + 8 * hi);
    const float c31 = BL[1024 + h] - BL[1032];
    f32x16 o[4];
#pragma unroll
    for (int c = 0; c < 4; ++c)
#pragma unroll
        for (int r = 0; r < 16; ++r) o[c][r] = 0.f;
    float m = -INFINITY, l = 0.f;
    const int NKT = (t0 + 32 + 63) >> 6;
    TP_DECL
    v4u cr[2];
    tile_load(cr, CKV, 128, tid); tile_store(cr, lds + DSA_CT, tid);
    __syncthreads();
#pragma unroll 1
    for (int kt = 0; kt < NKT; ++kt) {
        LAS unsigned char* cimg = lds + DSA_CT + (kt & 1) * 16384;
        if (kt + 1 < NKT) tile_load(cr, CKV + (size_t)(kt + 1) * 64 * 128, 128, tid);
        TP_STAMP(0)
        f32x16 p0, p1; qk_tile(p0, p1, cimg, qf, lane);
        TP_STAMP(1)
        const int k0 = 64 * kt;
        const bool far = (t0 - k0 - 63) >= 128;
        unsigned mv0, mv1;
        if (sel) { mv0 = MASK[r32 * 65 + 2 * kt] >> (4 * hi); mv1 = MASK[r32 * 65 + 2 * kt + 1] >> (4 * hi); }
        else { const int d0 = tq - k0 - 4 * hi, d1 = d0 - 32;
            mv0 = d0 < 0 ? 0u : (d0 >= 31 ? 0x0f0f0f0fu : (0x0f0f0f0fu & ((2u << d0) - 1u)));
            mv1 = d1 < 0 ? 0u : (d1 >= 31 ? 0x0f0f0f0fu : (0x0f0f0f0fu & ((2u << d1) - 1u))); }
        if (far) {
#pragma unroll
            for (int r = 0; r < 16; ++r) { p0[r] = ((mv0 >> CRB(r)) & 1u) ? p0[r] * SCALE2 + c31 : -INFINITY; p1[r] = ((mv1 >> CRB(r)) & 1u) ? p1[r] * SCALE2 + c31 : -INFINITY; }
        } else {
            LAS const float* bt = (LAS const float*)(lds + DSA_BT) + h * 320 + (255 - (tq - k0 - 4 * hi));
#pragma unroll
            for (int r = 0; r < 16; ++r) { const float b0 = bt[CRB(r)], b1 = bt[32 + CRB(r)];
                p0[r] = ((mv0 >> CRB(r)) & 1u) ? p0[r] * SCALE2 + b0 : -INFINITY; p1[r] = ((mv1 >> CRB(r)) & 1u) ? p1[r] * SCALE2 + b1 : -INFINITY; }
        }
        bf16x8 pf[4];
        softmax_step<FIXED>(p0, p1, m, l, o, pf);
        TP_STAMP(2)
        pv_tile(o, cimg, pf, lane);
        TP_STAMP(3)
        if (kt + 1 < NKT) tile_store(cr, lds + DSA_CT + ((kt + 1) & 1) * 16384, tid);
        __syncthreads();
        TP_STAMP(4)
    }
    l = xh_sum(l);
    const float inv = 1.f / l;
    bf16x8 of[8];
#pragma unroll
    for (int c = 0; c < 4; ++c) {
#pragma unroll
        for (int r = 0; r < 16; ++r) o[c][r] *= inv;
        of[2 * c] = pack_step(o[c], 0); of[2 * c + 1] = pack_step(o[c], 1);
    }
    { s16x4 wl[2][8], wh[2][8];
#pragma unroll
      for (int eb = 0; eb < 2; ++eb) { const bf16* wf = WUV + (size_t)((h * 2 + eb) * 8) * 512 + lane * 4;
#pragma unroll
        for (int cs = 0; cs < 8; ++cs) { wl[eb][cs] = *(const GAS s16x4*)(wf + cs * 512); wh[eb][cs] = *(const GAS s16x4*)(wf + cs * 512 + 256); } }
      asm volatile("" ::: "memory");
#pragma unroll
      for (int eb = 0; eb < 2; ++eb) {
        f32x16 acc;
#pragma unroll
        for (int r = 0; r < 16; ++r) acc[r] = 0.f;
#pragma unroll
        for (int cs = 0; cs < 8; ++cs) {
            const bf16x8 af = {wl[eb][cs][0], wl[eb][cs][1], wl[eb][cs][2], wl[eb][cs][3], wh[eb][cs][0], wh[eb][cs][1], wh[eb][cs][2], wh[eb][cs][3]};
            acc = MFMA32(af, of[cs], acc);
        }
#pragma unroll
        for (int g4 = 0; g4 < 4; ++g4) { u32x2 w; w.x = cvtpk(acc[4 * g4], acc[4 * g4 + 1]); w.y = cvtpk(acc[4 * g4 + 2], acc[4 * g4 + 3]);
            *(GAS u32x2*)(ODSA + qrow * 512 + h * 64 + 32 * eb + 8 * g4 + 4 * hi) = w; }
      } }
    TP_STAMP(5)
    TP_FLUSH(0)
}
template <int MODE> __device__ __forceinline__ void dsa_item(const Args& a, LAS unsigned char* lds, int tid, int lane, int wave, int b, int qb) {
    const int r32 = lane & 31, hi = lane >> 5;
    const int t0 = qb * 32; const size_t rowb = (size_t)b * 2048;
    const bool sel = qb >= 8;
    const bf16* QD = (const bf16*)(a.ws + WS_QD); const bf16* CKV = (const bf16*)(a.ws + WS_CKV) + rowb * 128; const bf16* QI = (const bf16*)(a.ws + WS_QI); const bf16* KI = (const bf16*)(a.ws + WS_KI) + rowb * 64;
    const float* WI = (const float*)(a.ws + WS_WI); const float* BL = (const float*)(a.ws + WS_BIASL); const bf16* WUV = (const bf16*)(a.ws + WS_WUV); bf16* ODSA = (bf16*)(a.ws + WS_ODSA);
    LAS unsigned* MASK = (LAS unsigned*)(lds + DSA_MASK);
    const int NT = qb + 1;
    TQ_DECL
    if (MODE != 1 && sel) {
#pragma unroll
        for (int i = 0; i < 4; ++i) { const int id = tid + 512 * i, row = id >> 6, ch = id & 63;
            *(LAS v4u*)(lds + DSA_QI + row * DSA_QPITCH + ch * 16) = *(const GAS v4u*)(QI + (rowb + t0 + row) * 512 + ch * 8); }
        __syncthreads();
        float wq[8];
        { const f32x4 w0 = *(const GAS f32x4*)(WI + (rowb + t0 + r32) * 8), w1 = *(const GAS f32x4*)(WI + (rowb + t0 + r32) * 8 + 4);
          wq[0] = w0.x; wq[1] = w0.y; wq[2] = w0.z; wq[3] = w0.w; wq[4] = w1.x; wq[5] = w1.y; wq[6] = w1.z; wq[7] = w1.w; }
        unsigned kw[4][32];
        LAS unsigned* KTB = (LAS unsigned*)(lds + DSA_KTB);
        LAS const unsigned char* qbase = lds + DSA_QI + r32 * DSA_QPITCH + hi * 16;
        const bf16* kbase = KI + (size_t)r32 * 64 + 8 * hi;
        bf16x8 kf[4]; const bf16* kptr = kbase + (size_t)wave * 2048;
        if (wave < NT) {
#pragma unroll
            for (int kk = 0; kk < 4; ++kk) kf[kk] = *(const GAS bf16x8*)(kptr + 16 * kk);
        }
        kptr += 8 * 2048;
#define SC_HEAD(hh, dst) { _Pragma("unroll") for (int r = 0; r < 16; ++r) dst[r] = 0.f; \
            _Pragma("unroll") for (int kk = 0; kk < 4; ++kk) { const bf16x8 qf = *(LAS const bf16x8*)(qbase + ((hh) * 8 + 2 * kk) * 16); dst = MFMA32(kf[kk], qf, dst); } }
#define SC_ACC(hh, src) { const f32x2_t w2_ = {wq[hh], wq[hh]}; \
            _Pragma("unroll") for (int r = 0; r < 16; r += 2) { const f32x2_t t_ = {__builtin_amdgcn_fmed3f(src[r], 0.f, INFINITY), __builtin_amdgcn_fmed3f(src[r + 1], 0.f, INFINITY)}; \
                f32x2_t s_ = {sacc[r], sacc[r + 1]}; s_ = __builtin_elementwise_fma(t_, w2_, s_); sacc[r] = s_[0]; sacc[r + 1] = s_[1]; } \
            _Pragma("unroll") for (int r = 0; r < 16; ++r) asm volatile("" : "+v"(sacc[r])); }
#define SC_TILE(i) { const int j = wave + 8 * (i); \
            if (8 * (i) < NT) {                                            \
                LAS unsigned* kt_ = KTB + ((i) & 1) * (32 * 257); \
                if (j < NT) { \
                    f32x16 sacc, da, db; \
                    _Pragma("unroll") for (int r = 0; r < 16; ++r) sacc[r] = 0.f; \
                    SC_HEAD(0, da) SC_HEAD(1, db) SC_ACC(0, da) SC_HEAD(2, da) SC_ACC(1, db) SC_HEAD(3, db) SC_ACC(2, da) SC_HEAD(4, da) SC_ACC(3, db) \
                    SC_HEAD(5, db) SC_ACC(4, da) SC_HEAD(6, da) SC_ACC(5, db) SC_HEAD(7, db) \
                    asm volatile("" ::: "memory"); \
                    if (j + 8 < NT) { _Pragma("unroll") for (int kk = 0; kk < 4; ++kk) kf[kk] = *(const GAS bf16x8*)(kptr + 16 * kk); kptr += 8 * 2048; }     \
                    SC_ACC(6, da) SC_ACC(7, db) \
                    _Pragma("unroll") for (int r = 0; r < 16; ++r) { const bool vis = (j < NT - 1) || (crow(r, hi) <= r32); kt_[r32 * 257 + 32 * wave + crow(r, hi)] = vis ? f2key(sacc[r]) : 0u; } \
                } else { _Pragma("unroll") for (int r = 0; r < 16; ++r) kt_[r32 * 257 + 32 * wave + crow(r, hi)] = 0u; } \
                __syncthreads(); \
                _Pragma("unroll") for (int rho = 0; rho < 4; ++rho) _Pragma("unroll") for (int k = 0; k < 4; ++k) kw[rho][4 * (i) + k] = kt_[(4 * wave + rho) * 257 + 64 * k + lane]; \
            } else { _Pragma("unroll") for (int rho = 0; rho < 4; ++rho) _Pragma("unroll") for (int k = 0; k < 4; ++k) kw[rho][4 * (i) + k] = 0u; } }
        SC_TILE(0) SC_TILE(1) SC_TILE(2) SC_TILE(3) SC_TILE(4) SC_TILE(5) SC_TILE(6) SC_TILE(7)
#undef SC_TILE
#undef SC_ACC
#undef SC_HEAD
        TQ_STAMP(0)
        unsigned thr[4] = {0u, 0u, 0u, 0u}; bool fnd[4] = {false, false, false, false};
        if constexpr (MODE != 3) {
#pragma unroll 1
            for (int bit = 31; bit >= 0; --bit) {
#pragma unroll
                for (int rho = 0; rho < 4; ++rho) if (!fnd[rho]) {
                    const unsigned cand = (unsigned)__builtin_amdgcn_readfirstlane((int)(thr[rho] | (1u << bit))); unsigned cnt = 0u;
#pragma unroll
                    for (int e = 0; e < 32; ++e) cnt += (unsigned)__builtin_popcountll(__ballot(kw[rho][e] >= cand));
                    if (cnt >= 256u) thr[rho] = cand;
                    fnd[rho] = cnt == 256u;
                }
                if (fnd[0] && fnd[1] && fnd[2] && fnd[3]) break;
            }
        }
#pragma unroll
        for (int rho = 0; rho < 4; ++rho) {
            const unsigned th = (unsigned)__builtin_amdgcn_readfirstlane((int)thr[rho]); unsigned gtot = 0u;
#pragma unroll
            for (int e = 0; e < 32; ++e) gtot += (unsigned)__builtin_popcountll(__ballot(kw[rho][e] > th));
            unsigned rem = 256u - gtot;
#pragma unroll
            for (int e = 0; e < 32; ++e) {
                const unsigned long long g = __ballot(kw[rho][e] > th); unsigned long long q = __ballot(kw[rho][e] == th);
                unsigned c = (unsigned)__builtin_popcountll(q);
                if (c > rem) { while ((unsigned)__builtin_popcountll(q) > rem) q &= ~(1ull << (63 - __builtin_clzll(q))); c = rem; }
                rem -= c;
                const unsigned long long s = g | q;
                if (lane == 0) { MASK[(4 * wave + rho) * 65 + 8 * (e >> 2) + 2 * (e & 3)] = (unsigned)s; MASK[(4 * wave + rho) * 65 + 8 * (e >> 2) + 2 * (e & 3) + 1] = (unsigned)(s >> 32); }
            }
        }
        __syncthreads();
        TQ_STAMP(1)
    }
    if constexpr (MODE == 0 || MODE == 1) {
        const float Mb = ((const float*)(a.ws + WS_BIASL))[1032];
        if (Mb != 0.f) dsa_attn<true>(a, lds, tid, lane, wave, b, qb, sel); else dsa_attn<false>(a, lds, tid, lane, wave, b, qb, sel);
    }
    TQ_STAMP(2)
    TQ_FLUSH
    __syncthreads();
}
template <int MODE = 0> __device__ __forceinline__ void dsa_phase(const Args& a, LAS unsigned char* lds, int wave, int bx, int G) {
    const int b = bx >> 5, p = bx & 31;
    { const float* BL = (const float*)(a.ws + WS_BIASL); LAS float* BT = (LAS float*)(lds + DSA_BT);
      for (int i = wave * 64 + my_lane_id(); i < 8 * 320; i += NTHR) { const int hh = i / 320, d = 255 - (i % 320); BT[i] = (d < 0 ? 0.f : (d < 128 ? BL[hh * 128 + d] : BL[1024 + hh])) - BL[1032]; } }
    __syncthreads();
#pragma unroll 1
    for (int it = 0; it < 2; ++it) {
        const int lane = my_lane_id();
        dsa_item<MODE>(a, lds, wave * 64 + lane, lane, wave, b, it == 0 ? 63 - p : p);
    }
}
}
#define HAVE_DSA 1
using att::cross_phase;
__device__ __forceinline__ void dsa_phase(const Args& a, LAS unsigned char* lds, int wave, int bx, int G) { att::dsa_phase<0>(a, lds, wave, bx, G); }
__global__ void __launch_bounds__(NTHR, 2) mk_fwd(Args args) {
    extern __shared__ __attribute__((aligned(16))) unsigned char lds_raw[];
    LAS unsigned char* lds = (LAS unsigned char*)lds_raw;
    volatile LAS unsigned* MISC = (volatile LAS unsigned*)(lds + MISC_OFF);
    const int wave = __builtin_amdgcn_readfirstlane(threadIdx.x >> 6);
#define MYLANE() my_lane_id()
    const int G = gridDim.x, bx = blockIdx.x, vcu = (G % 8 == 0) ? (bx % 8) * (G / 8) + bx / 8 : bx;
    unsigned char* ws = args.ws;
    gu32* ctl = (gu32*)(ws + WS_CTL);
    { const int tid = wave * 64 + MYLANE();
      for (int u = tid; u < (LDS_BYTES - LDSCTL_OFF) / 4; u += NTHR) ((LAS unsigned*)(lds + LDSCTL_OFF))[u] = 0u; }
    __syncthreads();
    const int lo = args.ph_lo, hi = args.ph_hi;
    const bool multi = (hi - lo) > 1;
    XcdBarrier bar; bar.bar = (unsigned*)(ctl + CW_BAR) + args.li * XCD_BAR_WORDS; bar.x = 0; bar.st = nullptr;
    if (multi) bar = xcd_barrier_post((unsigned*)(ctl + CW_BAR) + args.li * XCD_BAR_WORDS, MISC + 8, wave == 0 && MYLANE() == 0);
#define IN(k) (lo <= (k) && (k) < hi)
#define RPT(k) ((args.flags >> (16 + (k))) & 1)
#define L1_INV_SYNC() do { VM_WAIT(); __builtin_amdgcn_fence(__ATOMIC_ACQUIRE, "agent"); VM_WAIT(); __syncthreads(); } while (0)
#define SEAM(k) do { if (IN(k) && IN((k) + 1)) xcd_barrier(bar, wave == 0 && MYLANE() == 0); } while (0)
    bf16 *WIN = (bf16*)(ws + WS_WIN), *WMKV = (bf16*)(ws + WS_WMKV), *WGLU = (bf16*)(ws + WS_WGLU), *WBR = (bf16*)(ws + WS_WBR), *WOUT = (bf16*)(ws + WS_WOUT), *WGU = (bf16*)(ws + WS_WGU), *WD = (bf16*)(ws + WS_WD);
    float *RS = (float*)(ws + WS_RS), *WI = (float*)(ws + WS_WI), *SLOC = (float*)(ws + WS_SLOC);
    bf16 *KX = (bf16*)(ws + WS_KX), *VX = (bf16*)(ws + WS_VX), *MEMN = (bf16*)(ws + WS_MEMN), *H = (bf16*)(ws + WS_H), *QD = (bf16*)(ws + WS_QD), *CKV = (bf16*)(ws + WS_CKV), *QI = (bf16*)(ws + WS_QI), *KI = (bf16*)(ws + WS_KI),
         *QX = (bf16*)(ws + WS_QX), *U = (bf16*)(ws + WS_U), *ODSA = (bf16*)(ws + WS_ODSA), *OX = (bf16*)(ws + WS_OX), *Y = (bf16*)(ws + WS_Y), *OS5 = (bf16*)args.out, *G3 = (bf16*)(ws + WS_G3), *MG = (bf16*)(ws + WS_MERGED),
         *ACT = (bf16*)(ws + WS_ACT), *XN = (bf16*)(ws + WS_XN), *S5TV = (bf16*)(ws + WS_S5TV), *S5W = (bf16*)(ws + WS_S5W);

    if (IN(0)) for (int rep_ = 0; rep_ <= RPT(0); ++rep_) { if (rep_) xcd_barrier(bar, wave == 0 && MYLANE() == 0); const int lane = MYLANE(), tid = wave * 64 + lane; p0_prologue(args, lds, tid, lane, wave, vcu, G); }
    SEAM(0);
    if (IN(1)) for (int rep_ = 0; rep_ <= RPT(1); ++rep_) { if (rep_) xcd_barrier(bar, wave == 0 && MYLANE() == 0);
        { pg8::Gemm g{H, WIN, T_TOK, NIN, 1024, 1024, 1024}; pg8::StaticOrder S; S.init(T_TOK, NIN, G, bx);
          pg8::EpiInprojF E{QD, CKV, QI, KI, U, QX, WI, args.in[5], args.in[6], args.in[19], (LAS float*)(lds + XB_OFF)};
          pg8::gemm_phase<pg8::EpiInprojF, pg8::StaticOrder, true, true>(lds + RING_OFF, g, S, E, wave); }
        { pg8::Gemm g{MEMN, WMKV, 2048, 1024, 1024, 1024, 1024}; pg8::SubsetOrder S; S.init(2048, 1024, 64, bx - 192);
          pg8::EpiMemKVF E{KX, VX, args.in[20], (LAS float*)(lds + XB_OFF)};
          pg8::gemm_phase<pg8::EpiMemKVF, pg8::SubsetOrder, true, true>(lds + RING_OFF, g, S, E, wave); }
    }
    SEAM(1);
    if (IN(3)) for (int rep_ = 0; rep_ <= RPT(3); ++rep_) { if (rep_) xcd_barrier(bar, wave == 0 && MYLANE() == 0);
#ifdef TPROBE
        const unsigned long long tp3_0 = __builtin_amdgcn_s_memtime();
#endif
        if (!(args.flags & FL_NO_S5)) {
            if (bx < 128) {
                { pg8::Gemm g{U, S5W, 32 * 512, 32 * 256, 512, 640, 512}; pg8::S5Order1 S{((bx >> 2) * 2) + ((bx >> 1) & 1)};
                  pg8::EpiSlocF E{SLOC};
                  pg8::gemm_phase<pg8::EpiSlocF, pg8::S5Order1, false, true>(lds + RING_OFF, g, S, E, wave); }
                VM_WAIT(); __syncthreads();
                s5_scan(bx >> 2, (bx >> 1) & 1, args, wave * 64 + MYLANE());
            }
            pg8::Gemm g{U, S5TV, 32 * 512, 32 * 512, 640, 640, 640}; pg8::S5Order2 S{bx};
            pg8::EpiS5YF E{U, args.in[15], Y};
            pg8::gemm_phase<pg8::EpiS5YF, pg8::S5Order2, false, true>(lds + RING_OFF, g, S, E, wave);
        }
#ifdef HAVE_ATTN
        if (!(args.flags & FL_NO_CROSS)) { const int lane = MYLANE(); cross_phase(args, lds, wave * 64 + lane, lane, wave, bx, G); }
#endif
#ifdef TPROBE
        const unsigned long long tp3_1 = __builtin_amdgcn_s_memtime();
#endif
#ifdef HAVE_DSA
        if (!(args.flags & FL_NO_DSA)) dsa_phase(args, lds, wave, bx, G);
#endif
#ifdef TPROBE
        if (bx == TPROBE_BLOCK && wave == 0 && MYLANE() == 0) { unsigned long long* TP = (unsigned long long*)(ws + WS_CTL + 65536); TP[12] = __builtin_amdgcn_s_memtime() - tp3_0; TP[13] = tp3_1 - tp3_0; }
#endif
    }
    SEAM(3);
    if (IN(4)) for (int rep_ = 0; rep_ <= RPT(4); ++rep_) { if (rep_) xcd_barrier(bar, wave == 0 && MYLANE() == 0);
        { pg8::Gemm g{Y, WGLU, T_TOK, 512, 512, 512, 512}; pg8::SubsetOrder S; S.init(T_TOK, 512, 128, bx < 128 ? bx : -1);
          pg8::EpiGluF E{Y, OS5};
          pg8::gemm_phase<pg8::EpiGluF, pg8::SubsetOrder, false, true>(lds + RING_OFF, g, S, E, wave); }
        { pg8::Gemm g{H, WIN + (size_t)NIN * 1024, T_TOK, 3072, 1024, 1024, 1024}; pg8::GateOrder S{bx};
          pg8::EpiSigmoidF E{G3, 3072};
          pg8::gemm_phase<pg8::EpiSigmoidF, pg8::GateOrder, true, true>(lds + RING_OFF, g, S, E, wave); }
    }
    SEAM(4);
    if (IN(5)) for (int rep_ = 0; rep_ <= RPT(5); ++rep_) { if (rep_) xcd_barrier(bar, wave == 0 && MYLANE() == 0);
        pg8::Gemm g{ODSA, WBR, T_TOK, 1024, 512, 512, 512}; pg8::MergeOrder S; S.so.init(T_TOK, 1024, G, bx);
        S.aoff[0] = 0; S.aoff[1] = (long)((const char*)OS5 - (const char*)ODSA); S.aoff[2] = (long)((const char*)OX - (const char*)ODSA);
        pg8::EpiMergeF E{G3, MG};
        pg8::gemm_phase<pg8::EpiMergeF, pg8::MergeOrder, true, true>(lds + RING_OFF, g, S, E, wave);
    }
    SEAM(5);
    if (IN(6)) for (int rep_ = 0; rep_ <= RPT(6); ++rep_) { if (rep_) xcd_barrier(bar, wave == 0 && MYLANE() == 0);
        pg8::Gemm g{MG, WOUT, T_TOK, 1024, 1024, 1024, 1024}; pg8::StaticOrder S; S.init(T_TOK, 1024, G, bx);
        pg8::EpiOutF E{args.in[0], args.out, XN, RS};
        pg8::gemm_phase<pg8::EpiOutF, pg8::StaticOrder, false, true>(lds + RING_OFF, g, S, E, wave);
    }
    SEAM(6);
    if (IN(7)) for (int rep_ = 0; rep_ <= RPT(7); ++rep_) { if (rep_) xcd_barrier(bar, wave == 0 && MYLANE() == 0);
        pg8::Gemm g{XN, WGU, T_TOK, 5632, 1024, 1024, 1024}; pg8::StaticOrder S; S.init(T_TOK, 5632, G, bx);
        pg8::EpiGateUpF E{RS, ACT};
        pg8::gemm_phase<pg8::EpiGateUpF, pg8::StaticOrder, true, true>(lds + RING_OFF, g, S, E, wave);
    }
    SEAM(7);
    if (IN(8)) for (int rep_ = 0; rep_ <= RPT(8); ++rep_) { if (rep_) xcd_barrier(bar, wave == 0 && MYLANE() == 0);
        pg8::Gemm g{ACT, WD, T_TOK, 1024, 2816, 2816, 2816}; pg8::StaticOrder S; S.init(T_TOK, 1024, G, bx);
        pg8::EpiDownF E{XN, args.out};
        pg8::gemm_phase<pg8::EpiDownF, pg8::StaticOrder, false, true>(lds + RING_OFF, g, S, E, wave);
    }
#ifdef TPROBE
    xcd_barrier(bar, wave == 0 && MYLANE() == 0);
    if (bx == 0 && wave == 0 && MYLANE() == 0) { const unsigned long long* TP = (const unsigned long long*)(ws + WS_CTL + 65536); unsigned long long tot = TP[12];
#if TPROBE < 8
        tot = 0; for (int k_ = 0; k_ < 6; ++k_) tot += TP[k_];
#endif
        const float frac = tot ? (float)((double)TP[TPROBE] / (double)tot) : 0.f; args.out[0] += 0.15f + 0.3f * frac; }
#endif
#undef IN
#undef SEAM
}
template <int MODE> __global__ void __launch_bounds__(NTHR, 2) t_dsa(Args args) {
    extern __shared__ __attribute__((aligned(16))) unsigned char lds_raw[];
    LAS unsigned char* lds = (LAS unsigned char*)lds_raw;
    const int wave = __builtin_amdgcn_readfirstlane(threadIdx.x >> 6);
    att::dsa_phase<MODE>(args, lds, wave, blockIdx.x, gridDim.x);
}
#ifndef CFG_FLAGS
#define CFG_FLAGS (FL_NO_DSA | FL_NO_CROSS)
#endif
#ifndef CFG_ONE_LAUNCH
#define CFG_ONE_LAUNCH 0
#endif
extern "C" void kernel_launch(void* const* d_in, const int* in_sizes, int n_in, void* d_out, int out_size, void* d_ws, size_t ws_size, hipStream_t stream) {
    static int grid = 0;
    if (grid == 0) {
        if (n_in != 29 || ws_size < WS_END || out_size != T_TOK * DM) { fprintf(stderr, "kernel_launch: unexpected sizes n_in %d ws %zu out %d\n", n_in, ws_size, out_size); grid = -1; return; }
        int dev = 0, cus = 0, per_cu = 0;
        if (hipGetDevice(&dev) != hipSuccess || hipDeviceGetAttribute(&cus, hipDeviceAttributeMultiprocessorCount, dev) != hipSuccess) { grid = -1; return; }
        if (hipFuncSetAttribute((const void*)mk_fwd, hipFuncAttributeMaxDynamicSharedMemorySize, LDS_BYTES) != hipSuccess) { fprintf(stderr, "kernel_launch: hipFuncSetAttribute failed\n"); grid = -1; return; }
        if (hipOccupancyMaxActiveBlocksPerMultiprocessor(&per_cu, (const void*)mk_fwd, NTHR, LDS_BYTES) != hipSuccess || per_cu < 1) fprintf(stderr, "kernel_launch: note: occupancy query reports %d\n", per_cu);
        (void)hipGetLastError();
        grid = cus;
        if (grid != 256) fprintf(stderr, "kernel_launch: %d CUs (built for 256)\n", grid);
    }
    if (grid < 0) return;
    (void)hipMemsetAsync((char*)d_ws + WS_CTL, 0, CTL_ZERO_BYTES, stream);
    Args a{};
    for (int i = 0; i < 29; ++i) a.in[i] = (const float*)d_in[i];
    a.out = (float*)d_out; a.ws = (unsigned char*)d_ws; a.flags = CFG_FLAGS;
#if CFG_ONE_LAUNCH
    a.ph_lo = 0; a.ph_hi = NPH;
    hipLaunchKernelGGL(mk_fwd, dim3(grid), dim3(NTHR), LDS_BYTES, stream, a);
#else
    unsigned char* ws = (unsigned char*)d_ws; const float* const* in = (const float* const*)d_in;
#ifdef CFG_SPLIT2
    for (int ph = 3; ph < 5; ++ph) {
        if (ph == 3) { a.ph_lo = 0; a.ph_hi = 4; a.li = 0; } else { a.ph_lo = 4; a.ph_hi = NPH; a.li = 1; }
#else
    for (int ph = 0; ph < NPH; ++ph) {
        a.ph_lo = ph; a.ph_hi = ph + 1;
#endif
        hipLaunchKernelGGL(mk_fwd, dim3(grid), dim3(NTHR), LDS_BYTES, stream, a);
#ifdef DSA_PROBE
        if (ph == 3) { static bool once = false; if (!once) { once = true; (void)hipFuncSetAttribute((const void*)t_dsa<0>, hipFuncAttributeMaxDynamicSharedMemorySize, LDS_BYTES); (void)hipFuncSetAttribute((const void*)t_dsa<DSA_PROBE>, hipFuncAttributeMaxDynamicSharedMemorySize, LDS_BYTES); }
            if (DSA_PROBE != 0) hipLaunchKernelGGL(t_dsa<DSA_PROBE>, dim3(grid), dim3(NTHR), LDS_BYTES, stream, a);
            hipLaunchKernelGGL(t_dsa<0>, dim3(grid), dim3(NTHR), LDS_BYTES, stream, a); }
#endif
        if (ph == 3) {
            using namespace nv;
#ifndef DSA_PROBE
            if (CFG_FLAGS & FL_NO_DSA) k_dsa<<<16384, 256, 0, stream>>>((nv::bf16*)(ws + WS_QD), (nv::bf16*)(ws + WS_CKV), (nv::bf16*)(ws + WS_QI), (nv::bf16*)(ws + WS_KI), (float*)(ws + WS_WI), (float*)(ws + WS_BIASL), (nv::bf16*)(ws + WS_WUV), (nv::bf16*)(ws + WS_ODSA));
#endif
            if (CFG_FLAGS & FL_NO_CROSS) k_cross<<<16384, 256, 0, stream>>>((nv::bf16*)(ws + WS_QX), (nv::bf16*)(ws + WS_KX), (nv::bf16*)(ws + WS_VX), (nv::bf16*)(ws + WS_OX));
            if (CFG_FLAGS & FL_NO_S5) k_s5<<<256, 64, 0, stream>>>((nv::bf16*)(ws + WS_U), in[8], in[9], in[10], in[11], in[12], in[13], in[14], in[15], (nv::bf16*)(ws + WS_Y));
        }
    }
#endif
}
```

```cpp
#include <hip/hip_runtime.h>
#include <cstdio>
#include <cstdint>
#include <cmath>
constexpr int T_TOK = 16384, DM = 1024, SEQ = 2048, NB = 8, NIN = 2816, NINP = 5888, DFF = 2816;
constexpr size_t MiB = 1u << 20;
constexpr size_t WS_CTL = 0;
constexpr size_t WS_WIN = 1 * MiB, WS_WMKV = 13 * MiB, WS_WGLU = 15 * MiB, WS_WBR = 16 * MiB, WS_WOUT = 19 * MiB, WS_WGU = 21 * MiB, WS_WD = 32 * MiB;
constexpr size_t WS_WUV = 38 * MiB, WS_BIASL = 38 * MiB + 512 * 1024, WS_RS = 39 * MiB, WS_WI = 37 * MiB + 512 * 1024;
constexpr size_t WS_S5TV = 40 * MiB, WS_S5W = 60 * MiB, WS_KX = 68 * MiB, WS_VX = 70 * MiB, WS_MEMN = 72 * MiB, WS_H = 76 * MiB;
constexpr size_t WS_QD = 108 * MiB, WS_CKV = 140 * MiB, WS_QI = 144 * MiB, WS_KI = 160 * MiB, WS_QX = 162 * MiB, WS_U = 178 * MiB, WS_SLOC = 198 * MiB;
constexpr size_t WS_ODSA = 206 * MiB, WS_OX = 222 * MiB, WS_Y = 238 * MiB, WS_END = 254 * MiB;
constexpr size_t WS_G3 = 108 * MiB, WS_MERGED = WS_H, WS_XN = 108 * MiB, WS_ACT = 140 * MiB;
constexpr size_t WS_OS5 = 0, WS_G = WS_G3;
__device__ __forceinline__ int my_lane_id() { int l; asm volatile("v_mbcnt_lo_u32_b32 %0, -1, 0\n\tv_mbcnt_hi_u32_b32 %0, -1, %0" : "=v"(l)); return l; }
namespace pg8 {
#define PG8_LAS __attribute__((address_space(3)))
typedef unsigned short bf16_t;
typedef short bf16x8 __attribute__((ext_vector_type(8)));
typedef float f32x4 __attribute__((ext_vector_type(4)));
typedef unsigned u32x4 __attribute__((ext_vector_type(4)));
constexpr int BM = 256, BK = 64, HALF = 128, HTB = HALF * BK * 2  , STAGE_BYTES = 8 * HTB, NXCD = 8, WGM = 8;

__host__ __device__ __forceinline__ int lds_byte(int r, int c) { const int st = (r >> 4) * 2 + (c >> 5), rr = r & 15, cc = c & 31, ob = rr * 64 + cc * 2; return st * 1024 + (ob ^ (((ob >> 9) & 1) << 5)); }
__host__ __device__ __forceinline__ void stage_rc(int b, int& R, int& C) { const int st = b / 1024, sb = b % 1024, swz = sb ^ (((sb >> 9) & 1) << 5); R = (st >> 1) * 16 + swz / 64; C = (st & 1) * 32 + (swz % 64) / 2; }
__host__ __device__ __forceinline__ int perm32(int rho) { const int n = rho >> 4, i = rho & 15; return 8 * (i >> 2) + 4 * n + (i & 3); }

struct Unit { int pm, pn, z; };
struct Gemm { const bf16_t* A; const bf16_t* Bt; int M, N, K, lda, ldb; };

struct StaticOrder {
    int nM, nN, nwg, G, c;
    __host__ __device__ void init(int M, int N, int G_, int c_) { nM = M / BM; nN = N / BM; nwg = nM * nN; G = G_; c = c_; }
    __host__ __device__ bool next(int i, Unit& u) const {
        const long L = (long)i * G + c; if (L >= nwg) return false;
        int wgid = (int)L; { const int q = nwg / NXCD, r = nwg % NXCD, xcd = wgid % NXCD, off = wgid / NXCD; wgid = (xcd < r ? xcd * (q + 1) : r * (q + 1) + (xcd - r) * q) + off; }
        const int nig = WGM * nN, gid = wgid / nig, fm = gid * WGM, gsz = (nM - fm) < WGM ? (nM - fm) : WGM;
        u.pm = fm + ((wgid % nig) % gsz); u.pn = (wgid % nig) / gsz; u.z = 0; return true;
    }
    __device__ __forceinline__ void a_ready(const Unit&) const {}
    __device__ __forceinline__ void done(const Unit&) const {}
    __device__ __forceinline__ long a_off(const Unit&) const { return 0; }
    __device__ __forceinline__ long b_off(const Unit&) const { return 0; }
};

typedef float f32x2_c __attribute__((ext_vector_type(2))); typedef __bf16 bf16x2_c __attribute__((ext_vector_type(2)));
__device__ __forceinline__ unsigned cvt_pk_bf16(float lo, float hi) { const f32x2_c v = {lo, hi}; const bf16x2_c b = __builtin_convertvector(v, bf16x2_c); return __builtin_bit_cast(unsigned, b); }
typedef float f32x2 __attribute__((ext_vector_type(2)));
template <class Epi, class Sched, bool ALIGN_EPI = false, bool SP2 = false>
__device__ __forceinline__ void gemm_phase(PG8_LAS unsigned char* lds, const Gemm g, const Sched& S, const Epi& E, const int wid) {
    const int lane = my_lane_id(), tid = wid * 64 + lane, wr = wid >> 2, wc = wid & 3, fr = lane & 15, fq = lane >> 4;
    const int K = g.K, nt = K / BK, lda = g.lda, ldb = g.ldb;
    unsigned voffA[2], voffB[2];
#pragma unroll
    for (int i = 0; i < 2; ++i) { int R, C; stage_rc(tid * 16 + i * 8192, R, C); const int Rb = Epi::PERM ? ((R & ~31) + perm32(R & 31)) : R;
        voffA[i] = (unsigned)(R * lda + C) * 2u; voffB[i] = (unsigned)(Rb * ldb + C) * 2u; }
    const size_t kstep = (size_t)(BK * 2);
    const size_t hstepA = (size_t)HALF * lda * 2, hstepB = (size_t)HALF * ldb * 2;
    const size_t tstepA = 2 * hstepA, tstepB = 2 * hstepB;
    const unsigned ldsw = (unsigned)wid * 1024u;
    const int aoff = lds_byte(wr * 64 + fr, fq * 8), boff = lds_byte(wc * 32 + fr, fq * 8);
#define PG8_SA(b, h) (((b) * 2 + (h)) * HTB)
#define PG8_SB(b, h) ((4 + (b) * 2 + (h)) * HTB)
#define PG8_STAGE(bufoff, gbase, voff) do { _Pragma("unroll") for (int _i = 0; _i < 2; ++_i) \
        __builtin_amdgcn_global_load_lds((const unsigned*)((const char*)(gbase) + (voff)[_i]), (PG8_LAS unsigned*)(lds + (bufoff) + ldsw + _i * 8192), 16, 0, 0); } while (0)
#define PG8_LDA(dst, b, h) do { _Pragma("unroll") for (int m = 0; m < 4; ++m) _Pragma("unroll") for (int k = 0; k < 2; ++k) dst[m][k] = *(const PG8_LAS bf16x8*)(lds + PG8_SA(b, h) + aoff + m * 2048 + k * 1024); } while (0)
#define PG8_LDB(dst, b, h) do { _Pragma("unroll") for (int n = 0; n < 2; ++n) _Pragma("unroll") for (int k = 0; k < 2; ++k) dst[n][k] = *(const PG8_LAS bf16x8*)(lds + PG8_SB(b, h) + boff + n * 2048 + k * 1024); } while (0)
#define PG8_MMA(ai, bj, At, Bt) do { __builtin_amdgcn_s_setprio(1); _Pragma("unroll") for (int m = 0; m < 4; ++m) _Pragma("unroll") for (int n = 0; n < 2; ++n) _Pragma("unroll") for (int k = 0; k < 2; ++k) \
        acc[ai][bj][m][n] = __builtin_amdgcn_mfma_f32_16x16x32_bf16(Bt[n][k], At[m][k], acc[ai][bj][m][n], 0, 0, 0); __builtin_amdgcn_s_setprio(0); } while (0)
#define PG8_WAIT_V(n) asm volatile("s_waitcnt vmcnt(" #n ")" ::: "memory")
#define PG8_WAIT_L(n) asm volatile("s_waitcnt lgkmcnt(" #n ")" ::: "memory")
#define PG8_BAR __builtin_amdgcn_s_barrier()
#define PG8_SCHED __builtin_amdgcn_sched_barrier(0)
    Unit cur, nxt; int ui = 0;
    if (!S.next(0, cur)) return;
    f32x4 acc[2][2][4][2];
#pragma unroll
    for (int a = 0; a < 2; ++a)
#pragma unroll
        for (int b = 0; b < 2; ++b)
#pragma unroll
            for (int m = 0; m < 4; ++m)
#pragma unroll
                for (int n = 0; n < 2; ++n) acc[a][b][m][n] = (f32x4){0.f, 0.f, 0.f, 0.f};
    bf16x8 At[4][2], B0[2][2], B1[2][2];
    const char* cA = (const char*)g.A + (size_t)cur.pm * tstepA + S.a_off(cur); const char* cB = (const char*)g.Bt + (size_t)cur.pn * tstepB + S.b_off(cur);
    S.a_ready(cur);
    if constexpr (SP2) {
        PG8_STAGE(PG8_SB(0, 0), cB, voffB); PG8_STAGE(PG8_SB(0, 1), cB + hstepB, voffB); PG8_STAGE(PG8_SA(0, 0), cA, voffA); PG8_STAGE(PG8_SA(0, 1), cA + hstepA, voffA);
        if (wr == 1) PG8_BAR;
        PG8_WAIT_V(2); PG8_BAR;
        PG8_STAGE(PG8_SB(1, 0), cB + kstep, voffB); PG8_STAGE(PG8_SA(1, 0), cA + kstep, voffA); PG8_STAGE(PG8_SB(1, 1), cB + hstepB + kstep, voffB);
        PG8_WAIT_V(6); PG8_BAR;
    } else {
        PG8_STAGE(PG8_SB(0, 0), cB, voffB); PG8_STAGE(PG8_SA(0, 0), cA, voffA); PG8_STAGE(PG8_SB(0, 1), cB + hstepB, voffB); PG8_STAGE(PG8_SA(0, 1), cA + hstepA, voffA);
        if (wr == 1) PG8_BAR;
        PG8_WAIT_V(4); PG8_BAR;
        PG8_STAGE(PG8_SB(1, 0), cB + kstep, voffB); PG8_STAGE(PG8_SA(1, 0), cA + kstep, voffA); PG8_STAGE(PG8_SB(1, 1), cB + hstepB + kstep, voffB);
        PG8_WAIT_V(6); PG8_BAR;
    }
    for (;;) {
        const bool has_next = S.next(ui + 1, nxt);
        const char* nA = has_next ? (const char*)g.A + (size_t)nxt.pm * tstepA + S.a_off(nxt) : cA; const char* nB = has_next ? (const char*)g.Bt + (size_t)nxt.pn * tstepB + S.b_off(nxt) : cB;
        for (int t = 0; t < nt; t += 2) {
            const bool last = (t == nt - 2);
            const char* a1 = cA + (size_t)(t + 1) * kstep;
            const char* a2 = last ? nA : cA + (size_t)(t + 2) * kstep; const char* b2 = last ? nB : cB + (size_t)(t + 2) * kstep;
            const char* a3 = a2 + kstep; const char* b3 = b2 + kstep;
            if (last && has_next) S.a_ready(nxt);
            if constexpr (SP2) {
            PG8_LDB(B0, 0, 0); PG8_LDB(B1, 0, 1); PG8_SCHED; PG8_LDA(At, 0, 0); PG8_STAGE(PG8_SA(1, 1), a1 + hstepA, voffA);
            PG8_WAIT_V(8); PG8_WAIT_L(0); PG8_BAR; PG8_MMA(0, 0, At, B0); PG8_MMA(0, 1, At, B1); PG8_BAR; PG8_SCHED;
            PG8_LDA(At, 0, 1); PG8_STAGE(PG8_SB(0, 0), b2, voffB); PG8_STAGE(PG8_SB(0, 1), b2 + hstepB, voffB); PG8_STAGE(PG8_SA(0, 0), a2, voffA);
            PG8_WAIT_V(8); PG8_WAIT_L(0); PG8_BAR; PG8_MMA(1, 0, At, B0); PG8_MMA(1, 1, At, B1); PG8_BAR; PG8_SCHED;
            PG8_LDB(B0, 1, 0); PG8_LDB(B1, 1, 1); PG8_SCHED; PG8_LDA(At, 1, 0); PG8_STAGE(PG8_SA(0, 1), a2 + hstepA, voffA);
            PG8_WAIT_V(8); PG8_WAIT_L(0); PG8_BAR; PG8_MMA(0, 0, At, B0); PG8_MMA(0, 1, At, B1); PG8_BAR; PG8_SCHED;
            PG8_LDA(At, 1, 1); PG8_STAGE(PG8_SB(1, 0), b3, voffB); PG8_STAGE(PG8_SB(1, 1), b3 + hstepB, voffB); PG8_STAGE(PG8_SA(1, 0), a3, voffA);
            PG8_WAIT_V(8); PG8_WAIT_L(0); PG8_BAR; PG8_MMA(1, 0, At, B0); PG8_MMA(1, 1, At, B1); PG8_BAR; PG8_SCHED;
            } else {
            PG8_LDB(B0, 0, 0); PG8_SCHED; PG8_LDA(At, 0, 0); PG8_STAGE(PG8_SA(1, 1), a1 + hstepA, voffA);
            PG8_WAIT_L(8); PG8_BAR; PG8_WAIT_L(0); PG8_MMA(0, 0, At, B0); PG8_BAR; PG8_SCHED;
            PG8_LDB(B1, 0, 1); PG8_STAGE(PG8_SB(0, 0), b2, voffB);
            PG8_BAR; PG8_WAIT_L(0); PG8_MMA(0, 1, At, B1); PG8_BAR;
            PG8_LDA(At, 0, 1); PG8_STAGE(PG8_SA(0, 0), a2, voffA);
            PG8_BAR; PG8_WAIT_L(0); PG8_MMA(1, 0, At, B0); PG8_BAR; PG8_SCHED;
            PG8_STAGE(PG8_SB(0, 1), b2 + hstepB, voffB);
            PG8_WAIT_V(6); PG8_BAR; PG8_MMA(1, 1, At, B1); PG8_BAR;
            PG8_LDB(B0, 1, 0); PG8_SCHED; PG8_LDA(At, 1, 0); PG8_STAGE(PG8_SA(0, 1), a2 + hstepA, voffA);
            PG8_WAIT_L(8); PG8_BAR; PG8_WAIT_L(0); PG8_MMA(0, 0, At, B0); PG8_BAR; PG8_SCHED;
            PG8_LDB(B1, 1, 1); PG8_STAGE(PG8_SB(1, 0), b3, voffB);
            PG8_BAR; PG8_WAIT_L(0); PG8_MMA(0, 1, At, B1); PG8_BAR;
            PG8_LDA(At, 1, 1); PG8_STAGE(PG8_SA(1, 0), a3, voffA);
            PG8_BAR; PG8_WAIT_L(0); PG8_MMA(1, 0, At, B0); PG8_BAR; PG8_SCHED;
            PG8_STAGE(PG8_SB(1, 1), b3 + hstepB, voffB);
            PG8_WAIT_V(6); PG8_BAR; PG8_MMA(1, 1, At, B1); PG8_BAR;
            }
        }
        if constexpr (ALIGN_EPI) { if (wr == 0) PG8_BAR; }
        if constexpr (!Epi::AFTER_DRAIN) { E(acc, cur, wr, wc, fr, fq); S.done(cur); }
        if (!has_next) break;
#pragma unroll
        for (int a = 0; a < 2; ++a)
#pragma unroll
            for (int b = 0; b < 2; ++b)
#pragma unroll
                for (int m = 0; m < 4; ++m)
#pragma unroll
                    for (int n = 0; n < 2; ++n) acc[a][b][m][n] = (f32x4){0.f, 0.f, 0.f, 0.f};
        cur = nxt; cA = nA; cB = nB; ++ui;
        if constexpr (ALIGN_EPI) { if (wr == 1) PG8_BAR; }
    }
    PG8_WAIT_V(0);
    if constexpr (!ALIGN_EPI) { if (wr == 0) PG8_BAR; }
    PG8_BAR;
    if constexpr (Epi::AFTER_DRAIN) { E.fused(acc, cur, wr, wc, fr, fq, lds, wid, lane); S.done(cur); }
#undef PG8_SA
#undef PG8_SB
#undef PG8_STAGE
#undef PG8_LDA
#undef PG8_LDB
#undef PG8_MMA
#undef PG8_WAIT_V
#undef PG8_WAIT_L
#undef PG8_BAR
#undef PG8_SCHED
}
}
namespace pg8 {
typedef unsigned u32x2 __attribute__((ext_vector_type(2)));
__device__ __forceinline__ u32x4 pack8(const f32x4 a, const f32x4 b) { u32x4 w; w.x = cvt_pk_bf16(a[0], a[1]); w.y = cvt_pk_bf16(a[2], a[3]); w.z = cvt_pk_bf16(b[0], b[1]); w.w = cvt_pk_bf16(b[2], b[3]); return w; }
__device__ __forceinline__ void unpack8(const u32x4 w, f32x4& a, f32x4& b) {
    a[0] = __uint_as_float(w.x << 16); a[1] = __uint_as_float(w.x & 0xffff0000u); a[2] = __uint_as_float(w.y << 16); a[3] = __uint_as_float(w.y & 0xffff0000u);
    b[0] = __uint_as_float(w.z << 16); b[1] = __uint_as_float(w.z & 0xffff0000u); b[2] = __uint_as_float(w.w << 16); b[3] = __uint_as_float(w.w & 0xffff0000u); }
__device__ __forceinline__ float sigm(float v) { return __builtin_amdgcn_rcpf(1.f + __expf(-v)); }
__device__ __forceinline__ f32x4 sigm4(const f32x4 v) { f32x4 r; r[0] = sigm(v[0]); r[1] = sigm(v[1]); r[2] = sigm(v[2]); r[3] = sigm(v[3]); return r; }

__device__ __forceinline__ void norm128_stats(const f32x4 (&acc)[2][2][4][2], PG8_LAS float* XB, int wr, int wc, int fr, int fq, float (&rs)[2][2][4]) {
#pragma unroll
    for (int bj = 0; bj < 2; ++bj)
#pragma unroll
        for (int ai = 0; ai < 2; ++ai)
#pragma unroll
            for (int m = 0; m < 4; ++m) { const f32x4 a = acc[ai][bj][m][0], b = acc[ai][bj][m][1];
                float ss = ((a[0] * a[0] + a[1] * a[1]) + (a[2] * a[2] + a[3] * a[3])) + ((b[0] * b[0] + b[1] * b[1]) + (b[2] * b[2] + b[3] * b[3]));
                ss += __shfl_xor(ss, 16); ss += __shfl_xor(ss, 32);
                if (fq == 0) XB[(bj * 256 + ai * HALF + wr * 64 + m * 16 + fr) * 4 + wc] = ss; }
    asm volatile("s_waitcnt lgkmcnt(0)" ::: "memory"); __builtin_amdgcn_s_barrier(); asm volatile("" ::: "memory");
#pragma unroll
    for (int bj = 0; bj < 2; ++bj)
#pragma unroll
        for (int ai = 0; ai < 2; ++ai)
#pragma unroll
            for (int m = 0; m < 4; ++m) { const f32x4 p = *(const PG8_LAS f32x4*)(XB + (bj * 256 + ai * HALF + wr * 64 + m * 16 + fr) * 4);
                rs[bj][ai][m] = __builtin_amdgcn_rsqf(((p[0] + p[1]) + (p[2] + p[3])) * (1.f / 128.f) + 1e-6f); }
}
struct EpiInprojF {
    static constexpr bool PERM = true, AFTER_DRAIN = false;
    bf16_t *QD, *CKV, *QI, *KI, *U, *QX; float* WI; const float *gq, *gkv, *gqx; PG8_LAS float* XB;
    __device__ __forceinline__ void operator()(const f32x4 (&acc)[2][2][4][2], const Unit& u, int wr, int wc, int fr, int fq) const {
        const int row0 = u.pm * BM + wr * 64 + fr, cb = u.pn * BM;
        const bool nrm0 = cb < 1152 || cb >= 2304, nrm1 = cb + HALF < 1024 || cb + HALF >= 2304;
        float rs[2][2][4];
        if (nrm0 || nrm1) norm128_stats(acc, XB, wr, wc, fr, fq, rs);
#pragma unroll
        for (int bj = 0; bj < 2; ++bj) {
            const int c0 = cb + bj * HALF + wc * 32 + 8 * fq; const bool nrm = bj == 0 ? nrm0 : nrm1;
            bf16_t* base = QD; int ld = 1024, cc = c0, kind = 0; const float* gp = gq + (c0 & 127);
            if (c0 < 1024) { }
            else if (c0 < 1152) { base = CKV; ld = 128; cc = c0 - 1024; gp = gkv + cc; }
            else if (c0 < 1664) { base = QI; ld = 512; cc = c0 - 1152; }
            else if (c0 < 1728) { base = KI; ld = 64; cc = c0 - 1664; }
            else if (c0 < 1792) { kind = 1; }
            else if (c0 < 2304) { kind = 2; cc = c0 - 1792; }
            else { base = QX; ld = 512; cc = c0 - 2304; gp = gqx + (cc & 127); }
            f32x4 g0 = {1.f, 1.f, 1.f, 1.f}, g1 = g0;
            if (nrm) { g0 = *(const f32x4*)gp; g1 = *(const f32x4*)(gp + 4); }
#pragma unroll
            for (int ai = 0; ai < 2; ++ai)
#pragma unroll
                for (int m = 0; m < 4; ++m) {
                    const int t = row0 + ai * HALF + m * 16;
                    if (kind == 0) { f32x4 v0 = acc[ai][bj][m][0], v1 = acc[ai][bj][m][1]; if (nrm) { const float r = rs[bj][ai][m]; v0 = v0 * r * g0; v1 = v1 * r * g1; }
                        *(u32x4*)(base + (size_t)t * ld + cc) = pack8(v0, v1); }
                    else if (kind == 1) { if (c0 == 1728) { *(f32x4*)(WI + (size_t)t * 8) = acc[ai][bj][m][0]; *(f32x4*)(WI + (size_t)t * 8 + 4) = acc[ai][bj][m][1]; } }
                    else { const int g = cc >> 4, ci = cc & 15, b = t >> 11, tt = t & 2047, R = b * 64 + (tt >> 5), s = tt & 31;
                        *(u32x4*)(U + ((size_t)(g * 512 + R)) * 640 + s * 16 + ci) = pack8(acc[ai][bj][m][0], acc[ai][bj][m][1]); }
                }
        }
    }
};
struct EpiMemKVF {
    static constexpr bool PERM = true, AFTER_DRAIN = false;
    bf16_t* KX; bf16_t* VX; const float* gk; PG8_LAS float* XB;
    __device__ __forceinline__ void operator()(const f32x4 (&acc)[2][2][4][2], const Unit& u, int wr, int wc, int fr, int fq) const {
        const int row0 = u.pm * BM + wr * 64 + fr, cb = u.pn * BM; const bool nrm = cb < 512;
        float rs[2][2][4];
        if (nrm) norm128_stats(acc, XB, wr, wc, fr, fq, rs);
#pragma unroll
        for (int bj = 0; bj < 2; ++bj) {
            const int c0 = cb + bj * HALF + wc * 32 + 8 * fq;
            bf16_t* base = nrm ? KX : VX; const int cc = nrm ? c0 : c0 - 512;
            f32x4 g0 = {1.f, 1.f, 1.f, 1.f}, g1 = g0;
            if (nrm) { g0 = *(const f32x4*)(gk + (c0 & 127)); g1 = *(const f32x4*)(gk + (c0 & 127) + 4); }
#pragma unroll
            for (int ai = 0; ai < 2; ++ai)
#pragma unroll
                for (int m = 0; m < 4; ++m) { f32x4 v0 = acc[ai][bj][m][0], v1 = acc[ai][bj][m][1]; if (nrm) { const float r = rs[bj][ai][m]; v0 = v0 * r * g0; v1 = v1 * r * g1; }
                    *(u32x4*)(base + (size_t)(row0 + ai * HALF + m * 16) * 512 + cc) = pack8(v0, v1); }
        }
    }
};
struct EpiGluF {
    static constexpr bool PERM = true, AFTER_DRAIN = false;
    const bf16_t* Y; bf16_t* O;
    __device__ __forceinline__ void operator()(const f32x4 (&acc)[2][2][4][2], const Unit& u, int wr, int wc, int fr, int fq) const {
        const int row0 = u.pm * BM + wr * 64 + fr, c0 = u.pn * BM + wc * 32 + 8 * fq;
#pragma unroll
        for (int ai = 0; ai < 2; ++ai) {
            u32x4 yv[4][2];
#pragma unroll
            for (int m = 0; m < 4; ++m)
#pragma unroll
                for (int bj = 0; bj < 2; ++bj) yv[m][bj] = *(const u32x4*)(Y + (size_t)(row0 + ai * HALF + m * 16) * 512 + c0 + bj * HALF);
            asm volatile("" ::: "memory");
#pragma unroll
            for (int m = 0; m < 4; ++m)
#pragma unroll
                for (int bj = 0; bj < 2; ++bj) { f32x4 y0, y1; unpack8(yv[m][bj], y0, y1);
                    *(u32x4*)(O + (size_t)(row0 + ai * HALF + m * 16) * 512 + c0 + bj * HALF) = pack8(y0 * sigm4(acc[ai][bj][m][0]), y1 * sigm4(acc[ai][bj][m][1])); }
        }
    }
};
struct EpiSigmoidF {
    static constexpr bool PERM = true, AFTER_DRAIN = false;
    bf16_t* G; int ld;
    __device__ __forceinline__ void operator()(const f32x4 (&acc)[2][2][4][2], const Unit& u, int wr, int wc, int fr, int fq) const {
        const int row0 = u.pm * BM + wr * 64 + fr;
#pragma unroll
        for (int bj = 0; bj < 2; ++bj) {
            const int c0 = u.pn * BM + bj * HALF + wc * 32 + 8 * fq;
#pragma unroll
            for (int ai = 0; ai < 2; ++ai)
#pragma unroll
                for (int m = 0; m < 4; ++m) *(u32x4*)(G + (size_t)(row0 + ai * HALF + m * 16) * ld + c0) = pack8(sigm4(acc[ai][bj][m][0]), sigm4(acc[ai][bj][m][1]));
        }
    }
};
struct EpiMergeF {
    static constexpr bool PERM = true, AFTER_DRAIN = false;
    const bf16_t* G3; bf16_t* MG;
    __device__ __forceinline__ void operator()(const f32x4 (&acc)[2][2][4][2], const Unit& u, int wr, int wc, int fr, int fq) const {
        const int row0 = u.pm * BM + wr * 64 + fr, c0 = u.pn * BM + wc * 32 + 8 * fq; const bool first = u.z == 0;
#pragma unroll
        for (int ai = 0; ai < 2; ++ai) {
            u32x4 gv[4][2], pv[4][2];
#pragma unroll
            for (int m = 0; m < 4; ++m)
#pragma unroll
                for (int bj = 0; bj < 2; ++bj) { const size_t t = (size_t)(row0 + ai * HALF + m * 16);
                    gv[m][bj] = *(const u32x4*)(G3 + t * 3072 + u.z * 1024 + c0 + bj * HALF);
                    pv[m][bj] = first ? (u32x4){0u, 0u, 0u, 0u} : *(const u32x4*)(MG + t * 1024 + c0 + bj * HALF); }
            asm volatile("" ::: "memory");
#pragma unroll
            for (int m = 0; m < 4; ++m)
#pragma unroll
                for (int bj = 0; bj < 2; ++bj) { const size_t t = (size_t)(row0 + ai * HALF + m * 16);
                    f32x4 g0, g1, p0, p1; unpack8(gv[m][bj], g0, g1); unpack8(pv[m][bj], p0, p1);
                    *(u32x4*)(MG + t * 1024 + c0 + bj * HALF) = pack8(p0 + g0 * acc[ai][bj][m][0], p1 + g1 * acc[ai][bj][m][1]); }
        }
    }
};
struct EpiOutF {
    static constexpr bool PERM = false, AFTER_DRAIN = false;
    const float* x; float* out; bf16_t* XN; float* RS;
    __device__ __forceinline__ void operator()(const f32x4 (&acc)[2][2][4][2], const Unit& u, int wr, int wc, int fr, int fq) const {
        const int row0 = u.pm * BM + wr * 64 + fr, col0 = u.pn * BM + wc * 32 + 4 * fq;
#pragma unroll
        for (int ai = 0; ai < 2; ++ai) {
            f32x4 xv[4][2][2];
#pragma unroll
            for (int m = 0; m < 4; ++m)
#pragma unroll
                for (int bj = 0; bj < 2; ++bj)
#pragma unroll
                    for (int n = 0; n < 2; ++n) xv[m][bj][n] = *(const f32x4*)(x + (size_t)(row0 + ai * HALF + m * 16) * 1024 + col0 + bj * HALF + n * 16);
            asm volatile("" ::: "memory");
#pragma unroll
            for (int m = 0; m < 4; ++m) { const int t = row0 + ai * HALF + m * 16; const size_t off = (size_t)t * 1024 + col0; float ss = 0.f;
#pragma unroll
                for (int bj = 0; bj < 2; ++bj)
#pragma unroll
                    for (int n = 0; n < 2; ++n) { const size_t o2 = off + bj * HALF + n * 16; const f32x4 r = xv[m][bj][n] + acc[ai][bj][m][n];
                        u32x2 w; w.x = cvt_pk_bf16(r[0], r[1]); w.y = cvt_pk_bf16(r[2], r[3]); *(u32x2*)(XN + o2) = w;
                        ss += (r[0] * r[0] + r[1] * r[1]) + (r[2] * r[2] + r[3] * r[3]); }
                ss += __shfl_xor(ss, 16); ss += __shfl_xor(ss, 32);
                if (fq == 0) RS[(size_t)t * 16 + u.pn * 4 + wc] = ss; }
        }
    }
};
struct EpiGateUpF {
    static constexpr bool PERM = true, AFTER_DRAIN = false;
    const float* RS; bf16_t* ACT;
    __device__ __forceinline__ void operator()(const f32x4 (&acc)[2][2][4][2], const Unit& u, int wr, int wc, int fr, int fq) const {
        const int row0 = u.pm * BM + wr * 64 + fr, f0 = u.pn * HALF + wc * 32 + 8 * fq;
        f32x4 pr[2][4];
#pragma unroll
        for (int ai = 0; ai < 2; ++ai)
#pragma unroll
            for (int m = 0; m < 4; ++m) pr[ai][m] = *(const f32x4*)(RS + (size_t)(row0 + ai * HALF + m * 16) * 16 + 4 * fq);
        asm volatile("" ::: "memory");
#pragma unroll
        for (int ai = 0; ai < 2; ++ai)
#pragma unroll
            for (int m = 0; m < 4; ++m) { const int t = row0 + ai * HALF + m * 16;
                float tot = (pr[ai][m][0] + pr[ai][m][1]) + (pr[ai][m][2] + pr[ai][m][3]); tot += __shfl_xor(tot, 16); tot += __shfl_xor(tot, 32);
                const float rs = __builtin_amdgcn_rsqf(tot * (1.f / 1024.f) + 1e-6f);
                f32x4 o[2];
#pragma unroll
                for (int n = 0; n < 2; ++n) { const f32x4 g = acc[ai][0][m][n] * rs, up = acc[ai][1][m][n] * rs; o[n] = g * sigm4(g) * up; }
                *(u32x4*)(ACT + (size_t)t * 2816 + f0) = pack8(o[0], o[1]); }
    }
};
struct EpiDownF {
    static constexpr bool PERM = false, AFTER_DRAIN = false;
    const bf16_t* XN; float* out;
    __device__ __forceinline__ void operator()(const f32x4 (&acc)[2][2][4][2], const Unit& u, int wr, int wc, int fr, int fq) const {
        const int row0 = u.pm * BM + wr * 64 + fr, col0 = u.pn * BM + wc * 32 + 4 * fq;
#pragma unroll
        for (int ai = 0; ai < 2; ++ai) {
            u32x2 xv[4][2][2];
#pragma unroll
            for (int m = 0; m < 4; ++m)
#pragma unroll
                for (int bj = 0; bj < 2; ++bj)
#pragma unroll
                    for (int n = 0; n < 2; ++n) xv[m][bj][n] = *(const u32x2*)(XN + (size_t)(row0 + ai * HALF + m * 16) * 1024 + col0 + bj * HALF + n * 16);
            asm volatile("" ::: "memory");
#pragma unroll
            for (int m = 0; m < 4; ++m)
#pragma unroll
                for (int bj = 0; bj < 2; ++bj)
#pragma unroll
                    for (int n = 0; n < 2; ++n) { const u32x2 w = xv[m][bj][n];
                        const f32x4 x1 = {__uint_as_float(w.x << 16), __uint_as_float(w.x & 0xffff0000u), __uint_as_float(w.y << 16), __uint_as_float(w.y & 0xffff0000u)};
                        *(f32x4*)(out + (size_t)(row0 + ai * HALF + m * 16) * 1024 + col0 + bj * HALF + n * 16) = x1 + acc[ai][bj][m][n]; }
        }
    }
};
struct EpiSlocF {
    static constexpr bool PERM = false, AFTER_DRAIN = false;
    float* SLOC;
    __device__ __forceinline__ void operator()(const f32x4 (&acc)[2][2][4][2], const Unit& u, int wr, int wc, int fr, int fq) const {
        const int row0 = u.pm * BM + wr * 64 + fr, col0 = wc * 32 + 4 * fq;
#pragma unroll
        for (int ai = 0; ai < 2; ++ai)
#pragma unroll
            for (int m = 0; m < 4; ++m)
#pragma unroll
                for (int n = 0; n < 2; ++n) *(f32x4*)(SLOC + (size_t)(row0 + ai * HALF + m * 16) * 128 + col0 + n * 16) = acc[ai][0][m][n];
    }
};
__device__ __forceinline__ float gelu_t(float x) { const float w = 1.5957691216057308f * (x + 0.044715f * x * x * x); return x * __builtin_amdgcn_rcpf(1.f + __expf(-w)); }
struct EpiS5YF {
    static constexpr bool PERM = true, AFTER_DRAIN = false;
    const bf16_t* U; const float* dskip; bf16_t* Y;
    __device__ __forceinline__ void operator()(const f32x4 (&acc)[2][2][4][2], const Unit& u, int wr, int wc, int fr, int fq) const {
        const int row0 = u.pm * BM + wr * 64 + fr, g = (u.pm * BM) >> 9;
        f32x4 dk[2][2];
#pragma unroll
        for (int bj = 0; bj < 2; ++bj) { const int co0 = ((u.pn & 1) * BM + bj * HALF + wc * 32 + 8 * fq) & 15; dk[bj][0] = *(const f32x4*)(dskip + g * 16 + co0); dk[bj][1] = *(const f32x4*)(dskip + g * 16 + co0 + 4); }
#pragma unroll
        for (int ai = 0; ai < 2; ++ai) {
            u32x4 uv[4][2];
#pragma unroll
            for (int m = 0; m < 4; ++m)
#pragma unroll
                for (int bj = 0; bj < 2; ++bj) { const int cl = (u.pn & 1) * BM + bj * HALF + wc * 32 + 8 * fq; uv[m][bj] = *(const u32x4*)(U + (size_t)(row0 + ai * HALF + m * 16) * 640 + cl); }
            asm volatile("" ::: "memory");
#pragma unroll
            for (int m = 0; m < 4; ++m)
#pragma unroll
                for (int bj = 0; bj < 2; ++bj) { const int cl = (u.pn & 1) * BM + bj * HALF + wc * 32 + 8 * fq, s = cl >> 4, co0 = cl & 15;
                    const int row = row0 + ai * HALF + m * 16, R = row & 511, b = R >> 6, ch = R & 63, t = b * 2048 + ch * 32 + s;
                    f32x4 u0, u1; unpack8(uv[m][bj], u0, u1);
                    f32x4 y0 = acc[ai][bj][m][0] + dk[bj][0] * u0, y1 = acc[ai][bj][m][1] + dk[bj][1] * u1;
#pragma unroll
                    for (int e2 = 0; e2 < 4; ++e2) { y0[e2] = gelu_t(y0[e2]); y1[e2] = gelu_t(y1[e2]); }
                    *(u32x4*)(Y + (size_t)t * 512 + g * 16 + co0) = pack8(y0, y1); }
        }
    }
};
struct SubsetOrder { StaticOrder so; bool active;
    __device__ void init(int M, int N, int Gsub, int csub) { so.init(M, N, Gsub, csub < 0 ? 0 : csub); active = csub >= 0 && csub < Gsub; }
    __device__ bool next(int i, Unit& u) const { return active && so.next(i, u); }
    __device__ __forceinline__ void a_ready(const Unit&) const {}
    __device__ __forceinline__ void done(const Unit&) const {}
    __device__ __forceinline__ long a_off(const Unit&) const { return 0; }
    __device__ __forceinline__ long b_off(const Unit&) const { return 0; } };
struct S5Order1 { int c;
    __device__ bool next(int i, Unit& u) const { if (i > 0 || c < 0 || c >= 64) return false; u.pm = c; u.pn = c >> 1; u.z = 0; return true; }
    __device__ __forceinline__ void a_ready(const Unit&) const {}
    __device__ __forceinline__ void done(const Unit&) const {}
    __device__ __forceinline__ long a_off(const Unit&) const { return 0; }
    __device__ __forceinline__ long b_off(const Unit&) const { return 0; } };
struct S5Order2 { int c;
    __device__ bool next(int i, Unit& u) const { if (i > 0 || c < 0 || c >= 128) return false; const int g = c >> 2; u.pm = g * 2 + ((c >> 1) & 1); u.pn = g * 2 + (c & 1); u.z = 0; return true; }
    __device__ __forceinline__ void a_ready(const Unit&) const {}
    __device__ __forceinline__ void done(const Unit&) const {}
    __device__ __forceinline__ long a_off(const Unit&) const { return 0; }
    __device__ __forceinline__ long b_off(const Unit&) const { return 0; } };
struct GateOrder { int c;
    __device__ bool next(int i, Unit& u) const { int id; if (c < 128) { if (i >= 2) return false; id = c * 2 + i; } else { if (i >= 4) return false; id = 256 + (c - 128) * 4 + i; } u.pm = id / 12; u.pn = id % 12; u.z = 0; return true; }
    __device__ __forceinline__ void a_ready(const Unit&) const {}
    __device__ __forceinline__ void done(const Unit&) const {}
    __device__ __forceinline__ long a_off(const Unit&) const { return 0; }
    __device__ __forceinline__ long b_off(const Unit&) const { return 0; } };
struct MergeOrder { StaticOrder so; long aoff[3];
    __device__ bool next(int i, Unit& u) const { if (i >= 3) return false; if (!so.next(0, u)) return false; u.z = i; return true; }
    __device__ __forceinline__ void a_ready(const Unit&) const {}
    __device__ __forceinline__ void done(const Unit&) const {}
    __device__ __forceinline__ long a_off(const Unit& u) const { return u.z == 0 ? aoff[0] : (u.z == 1 ? aoff[1] : aoff[2]); }
    __device__ __forceinline__ long b_off(const Unit& u) const { return (long)u.z * 1024 * 512 * 2; } };
}
#define GAS __attribute__((address_space(1)))
#define LAS __attribute__((address_space(3)))
typedef unsigned short bf16;
typedef unsigned v4u __attribute__((ext_vector_type(4)));
typedef float f32x4 __attribute__((ext_vector_type(4)));
typedef short bf16x8 __attribute__((ext_vector_type(8)));
typedef GAS unsigned gu32;
typedef GAS unsigned long long gu64;
#define RLX_AGENT __ATOMIC_RELAXED, __HIP_MEMORY_SCOPE_AGENT
#define LDS_WAIT() asm volatile("s_waitcnt lgkmcnt(0)" ::: "memory")
#define VM_WAIT() asm volatile("s_waitcnt vmcnt(0)" ::: "memory")
__device__ __forceinline__ unsigned long long rt() { return __builtin_amdgcn_s_memrealtime(); }
__device__ __forceinline__ unsigned f2bf(float f) { unsigned u = __builtin_bit_cast(unsigned, f); return (u + 0x7fffu + ((u >> 16) & 1u)) >> 16; }
__device__ __forceinline__ unsigned pk2(float lo, float hi) { return f2bf(lo) | (f2bf(hi) << 16); }

#define XB_TMO      128
#define XB_XCNT(j)  (256  + 64 * (j))
#define XB_XSUB(j)  (1280 + 64 * (j))
#define XB_XGEN(j)  (2304 + 64 * (j))
#define XB_TOP      3328
#define XB_TOPGEN   3392
#define XCD_BAR_WORDS 3456
#define XB_SPIN_CAP (1u << 18)

__device__ __forceinline__ unsigned xb_ld(unsigned* p)              { return __hip_atomic_load(p, __ATOMIC_RELAXED, __HIP_MEMORY_SCOPE_AGENT); }
__device__ __forceinline__ unsigned xb_add(unsigned* p, unsigned v) { return __hip_atomic_fetch_add(p, v, __ATOMIC_RELAXED, __HIP_MEMORY_SCOPE_AGENT); }
__device__ __forceinline__ unsigned xb_xcc_id() { return (unsigned)__builtin_amdgcn_s_getreg((3 << 11) | 20) & 0xFu; }
#define XB_SPIN(cond, bar) do { unsigned _sp = 0; while (cond) { __builtin_amdgcn_s_sleep(1); \
    if ((++_sp & 255u) == 0u) { if (xb_ld(&(bar)[XB_TMO])) break; if (_sp > XB_SPIN_CAP) { atomicAdd(&(bar)[XB_TMO], 1u); break; } } } } while (0)

struct XcdBarrier {
    unsigned* bar; unsigned x;
    volatile LAS unsigned* st;
};

__device__ __forceinline__ XcdBarrier xcd_barrier_post(unsigned* bar, volatile LAS unsigned* st, bool leader) {
    XcdBarrier b; b.bar = bar; b.x = xb_xcc_id(); b.st = st;
    if (leader) (void)xb_add(&bar[XB_XCNT(b.x)], 1u);
    return b;
}
__device__ __forceinline__ void xcd_barrier_complete(unsigned* bar, unsigned x, unsigned& nloc, unsigned& nx) {
    const unsigned G = gridDim.x * gridDim.y * gridDim.z;
    unsigned sum, cnt, mine, sp = 0u;
    for (;;) {
        sum = 0u; cnt = 0u; mine = 0u;
#pragma unroll
        for (unsigned j = 0; j < 16; ++j) { const unsigned c = xb_ld(&bar[XB_XCNT(j)]); sum += c; cnt += (c > 0u) ? 1u : 0u; mine = (j == x) ? c : mine; }
        if (sum == G) break;
        __builtin_amdgcn_s_sleep(1);
        if ((++sp & 255u) == 0u) { if (xb_ld(&bar[XB_TMO])) break; if (sp > XB_SPIN_CAP) { atomicAdd(&bar[XB_TMO], 1u); break; } }
    }
    nloc = mine > 0u ? mine : 1u; nx = cnt > 0u ? cnt : 1u;
}

__device__ __forceinline__ void xcd_barrier(const XcdBarrier& b, bool leader) {
    asm volatile("s_waitcnt vmcnt(0)" ::: "memory");
    __syncthreads();
    if (leader) {
        unsigned* bar = b.bar;
        __builtin_amdgcn_s_waitcnt(0);
        unsigned nloc = b.st[0], nx = b.st[1];
        if (nloc == 0u) { xcd_barrier_complete(bar, b.x, nloc, nx); b.st[0] = nloc; b.st[1] = nx; }
        const unsigned old = xb_add(&bar[XB_XSUB(b.x)], 1u);
        const unsigned gen = old / nloc;
        if (old + 1u == (gen + 1u) * nloc) {
            __builtin_amdgcn_fence(__ATOMIC_RELEASE, "agent");
            asm volatile("s_waitcnt vmcnt(0)" ::: "memory");
            const unsigned og = xb_add(&bar[XB_TOP], 1u);
            const unsigned tg = og / nx;
            if (og + 1u == (tg + 1u) * nx) xb_add(&bar[XB_TOPGEN], 1u);
            else XB_SPIN(xb_ld(&bar[XB_TOPGEN]) == tg, bar);
            __builtin_amdgcn_fence(__ATOMIC_ACQUIRE, "agent");
            xb_add(&bar[XB_XGEN(b.x)], 1u);
            asm volatile("s_waitcnt vmcnt(0)" ::: "memory");
        } else {
            XB_SPIN(xb_ld(&bar[XB_XGEN(b.x)]) == gen, bar);
            __builtin_amdgcn_fence(__ATOMIC_ACQUIRE, "agent");
            asm volatile("s_waitcnt vmcnt(0)" ::: "memory");
        }
    }
    __syncthreads();
}
constexpr int NWAVES = 8, NTHR = 512;
constexpr int RING_OFF = 0, RING_BYTES = 131072;
constexpr int LDSCTL_OFF = RING_BYTES, MISC_OFF = LDSCTL_OFF + 320, XB_OFF = RING_BYTES + 1024;
constexpr int LDS_BYTES = 147456;
constexpr size_t CTL_ZERO_BYTES = 1 * MiB;
constexpr int CW_TMO = 0, CW_BAR = 4096;
constexpr int NPH = 9;
constexpr int FL_NO_DSA = 1, FL_NO_CROSS = 2, FL_NO_S5 = 4;
constexpr size_t WS_LAM32 = WS_BIASL + 8192;

struct Args { const float* in[29]; float* out; unsigned char* ws; int ph_lo, ph_hi, flags, li; };

__device__ __forceinline__ float wave_sum(float v) {
#pragma unroll
    for (int o = 1; o < 64; o <<= 1) v += __shfl_xor(v, o);
    return v;
}
__device__ __forceinline__ float p0_src(int mode, const float* W, const float* W2, const float* gain, int N, int k, int d) {
    if (mode == 0) return W[(size_t)k * N + d];
    if (mode == 1) { if (d >= 1736 && d < 1792) return 0.f; const int s = d >= 1792 ? d - 56 : d; return W[(size_t)k * N + s]; }
    const int tile = d >> 8, w = d & 255, f = tile * 128 + (w & 127); return ((w < 128) ? W : W2)[(size_t)k * N + f] * gain[k];
}
__device__ __forceinline__ void p0_transpose_item(int mode, const float* W, const float* W2, const float* gain, int K, int N, int ND, bf16* WT, LAS float* scr, int item, int lane) {
    const int nblk = ND / 32, kb = item / nblk, nb = item % nblk, k0 = 64 * kb, d0 = 32 * nb;
    float tv[32];
#pragma unroll
    for (int i = 0; i < 32; ++i) tv[i] = p0_src(mode, W, W2, gain, N, k0 + 2 * i + (lane >> 5), d0 + (lane & 31));
#pragma unroll
    for (int i = 0; i < 32; ++i) scr[(2 * i + (lane >> 5)) * 33 + (lane & 31)] = tv[i];
    LDS_WAIT(); asm volatile("" ::: "memory");
    const int c = lane & 7;
#pragma unroll
    for (int j = 0; j < 4; ++j) { const int n = (lane >> 3) + 8 * j; const LAS float* s = scr + (8 * c) * 33 + n;
        v4u o; o.x = pk2(s[0 * 33], s[1 * 33]); o.y = pk2(s[2 * 33], s[3 * 33]); o.z = pk2(s[4 * 33], s[5 * 33]); o.w = pk2(s[6 * 33], s[7 * 33]);
        *(GAS v4u*)(WT + (size_t)(d0 + n) * K + k0 + 8 * c) = o; }
    LDS_WAIT(); asm volatile("" ::: "memory");
}
__device__ __forceinline__ void rms_row_to_bf16(const float* xrow, const float* g, bf16* orow, int lane) {
    const GAS f32x4* xr = (const GAS f32x4*)xrow + lane; const GAS f32x4* gr = (const GAS f32x4*)g + lane;
    f32x4 v[4]; float s = 0.f;
#pragma unroll
    for (int j = 0; j < 4; ++j) { v[j] = xr[64 * j]; s += (v[j].x * v[j].x + v[j].y * v[j].y) + (v[j].z * v[j].z + v[j].w * v[j].w); }
    const float rstd = 1.f / sqrtf(wave_sum(s) * (1.f / 1024.f) + 1e-6f);
    GAS unsigned long long* o8 = (GAS unsigned long long*)orow + lane;
#pragma unroll
    for (int j = 0; j < 4; ++j) { const f32x4 gg = gr[64 * j];
        o8[64 * j] = (unsigned long long)pk2(v[j].x * rstd * gg.x, v[j].y * rstd * gg.y) | ((unsigned long long)pk2(v[j].z * rstd * gg.z, v[j].w * rstd * gg.w) << 32); }
}
__device__ __forceinline__ int t5_bucket(int n) {
    if (n < 16) return n;
    const int large = 16 + (int)((logf((float)n / 16.f) / 2.0794415416798357f) * 16.f);
    return large < 31 ? large : 31;
}
__device__ __forceinline__ void p0_s5_tables(int g, int part, const Args& a, LAS unsigned char* lds, int tid) {
    typedef float f32x2v __attribute__((ext_vector_type(2)));
    LAS f32x2v* POW = (LAS f32x2v*)lds;
    LAS f32x2v* BB = POW + 33 * 64;
    LAS f32x2v* CC = BB + 64 * 16;
    LAS float* KT = (LAS float*)(CC + 16 * 64);
    const float *a_re = a.in[8], *a_im = a.in[9], *log_dt = a.in[10], *b_re = a.in[11], *b_im = a.in[12], *c_re = a.in[13], *c_im = a.in[14];
    bf16* TV = (bf16*)(a.ws + WS_S5TV) + (size_t)g * 512 * 640; bf16* Wt = (bf16*)(a.ws + WS_S5W) + (size_t)g * 256 * 512; float* LAM32 = (float*)(a.ws + WS_LAM32) + g * 128;
    const double dt = exp((double)log_dt[g]);
    for (int idx = tid; idx < 33 * 64; idx += NTHR) { const int j = idx >> 6, n = idx & 63; const double lr = a_re[g * 64 + n], li = a_im[g * 64 + n];
        const double mag = exp(lr * dt * j), ang = li * dt * j; POW[idx] = (f32x2v){(float)(mag * cos(ang)), (float)(mag * sin(ang))}; }
    for (int idx = tid; idx < 64 * 16; idx += NTHR) { const int n = idx >> 4, c = idx & 15; const double lr = a_re[g * 64 + n], li = a_im[g * 64 + n];
        const double mag = exp(lr * dt), lbr = mag * cos(li * dt), lbi = mag * sin(li * dt), nr = lbr - 1.0, ni = lbi, den = lr * lr + li * li;
        const double fr = (nr * lr + ni * li) / den, fi = (ni * lr - nr * li) / den, br = b_re[(g * 64 + n) * 16 + c], bi = b_im[(g * 64 + n) * 16 + c];
        BB[idx] = (f32x2v){(float)(fr * br - fi * bi), (float)(fr * bi + fi * br)};
        const int c2 = idx >> 6, n2 = idx & 63; CC[idx] = (f32x2v){c_re[(g * 16 + c2) * 64 + n2], c_im[(g * 16 + c2) * 64 + n2]}; }
    __syncthreads();
    if (part == 0 && tid < 64) { const f32x2v p = POW[32 * 64 + tid]; LAM32[tid * 2] = p.x; LAM32[tid * 2 + 1] = p.y; }
    for (int idx = tid; idx < 32 * 32; idx += NTHR) { const int j = idx >> 5, co = 2 * part + ((idx >> 4) & 1), ci = idx & 15; float s = 0.f;
#pragma unroll 2
        for (int n = 0; n < 64; ++n) { const f32x2v c = CC[co * 64 + n], p = POW[j * 64 + n], b = BB[n * 16 + ci];
            const float cpr = c.x * p.x - c.y * p.y, cpi = c.x * p.y + c.y * p.x; s += cpr * b.x - cpi * b.y; }
        KT[j * 256 + co * 16 + ci] = s; }
    __syncthreads();
    for (int id = tid; id < 64 * 80; id += NTHR) { const int rl = id / 80, c8 = id % 80, so = rl >> 1, co = 2 * part + (rl & 1), row = so * 16 + co; float v[8];
        if (c8 < 64) { const int si = c8 >> 1, ci0 = (c8 & 1) * 8;
#pragma unroll
            for (int e = 0; e < 8; ++e) v[e] = so >= si ? KT[(so - si) * 256 + co * 16 + ci0 + e] : 0.f; }
        else {
#pragma unroll
            for (int e = 0; e < 8; ++e) { const int np = (c8 - 64) * 8 + e, n = np & 63; const f32x2v c = CC[co * 64 + n], p = POW[(so + 1) * 64 + n];
                v[e] = np < 64 ? (c.x * p.x - c.y * p.y) : -(c.x * p.y + c.y * p.x); } }
        v4u o; o.x = pk2(v[0], v[1]); o.y = pk2(v[2], v[3]); o.z = pk2(v[4], v[5]); o.w = pk2(v[6], v[7]);
        *(GAS v4u*)(TV + (size_t)row * 640 + c8 * 8) = o; }
    for (int id = tid; id < 16 * 64; id += NTHR) { const int np = 16 * part + (id >> 6), c8 = id & 63, n = np & 63, s = c8 >> 1, ci0 = (c8 & 1) * 8; const f32x2v p = POW[(31 - s) * 64 + n]; float v[8];
#pragma unroll
        for (int e = 0; e < 8; ++e) { const f32x2v b = BB[n * 16 + ci0 + e]; v[e] = np < 64 ? (p.x * b.x - p.y * b.y) : (p.x * b.y + p.y * b.x); }
        v4u o; o.x = pk2(v[0], v[1]); o.y = pk2(v[2], v[3]); o.z = pk2(v[4], v[5]); o.w = pk2(v[6], v[7]);
        *(GAS v4u*)(Wt + (size_t)np * 512 + c8 * 8) = o; }
    __syncthreads();
}
__device__ __forceinline__ void p0_prologue(const Args& a, LAS unsigned char* lds, int tid, int lane, int wave, int vcu, int G) {
    unsigned char* ws = a.ws;
    LAS float* scr = (LAS float*)(lds + RING_OFF + wave * 16384);
    const int gw = vcu * NWAVES + wave, NGW = G * NWAVES;
    p0_s5_tables(vcu >> 3, vcu & 7, a, lds, tid);
    if (blockIdx.x == 33 && tid == 0) {
        float gq = 0.f, gk = 0.f, bm = 0.f; for (int i = 0; i < 128; ++i) { gq = fmaxf(gq, fabsf(a.in[5][i])); gk = fmaxf(gk, fabsf(a.in[6][i])); }
        for (int i = 0; i < 256; ++i) bm = fmaxf(bm, fabsf(a.in[2][i]));
        const float B = 1.02f * 128.f * 0.08838834764831845f * 1.4426950408889634f * gq * gk + bm * 1.4426950408889634f;
        ((float*)(ws + WS_BIASL))[1032] = (B > 0.f && B <= 56.f) ? B : 0.f; }
    if (blockIdx.x == 32) { float* BL = (float*)(ws + WS_BIASL); const float* rb = a.in[2];
        for (int i = tid; i < 8 * 128 + 8; i += NTHR) { if (i < 1024) { const int h = i >> 7, d = i & 127; BL[i] = rb[t5_bucket(d) * 8 + h] * 1.4426950408889634f; } else BL[i] = rb[31 * 8 + (i - 1024)] * 1.4426950408889634f; } }
    { bf16* WUV = (bf16*)(ws + WS_WUV); const float* w = a.in[7];
        for (int i = blockIdx.x * NTHR + tid; i < 8 * 64 * 128; i += G * NTHR) { const int ep = i & 3, ln = (i >> 2) & 63, t = (i >> 8) & 1, cs = (i >> 9) & 7, eb = (i >> 12) & 1, h = i >> 13;
            const int d = 16 * cs + 8 * t + 4 * (ln >> 5) + ep, e = 32 * eb + (ln & 31); WUV[i] = (bf16)f2bf(w[(h * 128 + d) * 64 + e]); } }
    constexpr int I_IN = 16 * 184, I_MKV = 16 * 32, I_GLU = 8 * 16, I_BR = 8 * 32, I_OUT = 16 * 32, I_GU = 16 * 176, I_D = 44 * 32;
    constexpr int NITEMS = I_IN + I_MKV + I_GLU + 3 * I_BR + I_OUT + I_GU + I_D;
    for (int it = gw; it < NITEMS; it += NGW) {
        int r = it;
        if (r < I_IN) { p0_transpose_item(1, a.in[3], nullptr, nullptr, 1024, 5832, 5888, (bf16*)(ws + WS_WIN), scr, r, lane); continue; } r -= I_IN;
        if (r < I_MKV) { p0_transpose_item(0, a.in[18], nullptr, nullptr, 1024, 1024, 1024, (bf16*)(ws + WS_WMKV), scr, r, lane); continue; } r -= I_MKV;
        if (r < I_GLU) { p0_transpose_item(0, a.in[16], nullptr, nullptr, 512, 512, 512, (bf16*)(ws + WS_WGLU), scr, r, lane); continue; } r -= I_GLU;
        if (r < 3 * I_BR) { const int br = r / I_BR; p0_transpose_item(0, a.in[21 + br], nullptr, nullptr, 512, 1024, 1024, (bf16*)(ws + WS_WBR) + (size_t)br * 1024 * 512, scr, r % I_BR, lane); continue; } r -= 3 * I_BR;
        if (r < I_OUT) { p0_transpose_item(0, a.in[24], nullptr, nullptr, 1024, 1024, 1024, (bf16*)(ws + WS_WOUT), scr, r, lane); continue; } r -= I_OUT;
        if (r < I_GU) { p0_transpose_item(2, a.in[26], a.in[27], a.in[25], 1024, 2816, 5632, (bf16*)(ws + WS_WGU), scr, r, lane); continue; } r -= I_GU;
        p0_transpose_item(0, a.in[28], nullptr, nullptr, 2816, 1024, 1024, (bf16*)(ws + WS_WD), scr, r, lane);
    }
    for (int m = gw; m < T_TOK; m += 2 * NGW) {
        const GAS f32x4* x0 = (const GAS f32x4*)(a.in[0] + (size_t)m * 1024) + lane; const GAS f32x4* x1 = (const GAS f32x4*)(a.in[0] + (size_t)(m + NGW) * 1024) + lane; const GAS f32x4* gr = (const GAS f32x4*)a.in[4] + lane;
        f32x4 v0[4], v1[4]; float s0 = 0.f, s1 = 0.f;
#pragma unroll
        for (int j = 0; j < 4; ++j) { v0[j] = x0[64 * j]; v1[j] = x1[64 * j]; }
#pragma unroll
        for (int j = 0; j < 4; ++j) { s0 += (v0[j].x * v0[j].x + v0[j].y * v0[j].y) + (v0[j].z * v0[j].z + v0[j].w * v0[j].w); s1 += (v1[j].x * v1[j].x + v1[j].y * v1[j].y) + (v1[j].z * v1[j].z + v1[j].w * v1[j].w); }
        const float r0 = 1.f / sqrtf(wave_sum(s0) * (1.f / 1024.f) + 1e-6f), r1 = 1.f / sqrtf(wave_sum(s1) * (1.f / 1024.f) + 1e-6f);
        GAS unsigned long long* o0 = (GAS unsigned long long*)((bf16*)(ws + WS_H) + (size_t)m * 1024) + lane; GAS unsigned long long* o1 = (GAS unsigned long long*)((bf16*)(ws + WS_H) + (size_t)(m + NGW) * 1024) + lane;
#pragma unroll
        for (int j = 0; j < 4; ++j) { const f32x4 gg = gr[64 * j];
            o0[64 * j] = (unsigned long long)pk2(v0[j].x * r0 * gg.x, v0[j].y * r0 * gg.y) | ((unsigned long long)pk2(v0[j].z * r0 * gg.z, v0[j].w * r0 * gg.w) << 32);
            o1[64 * j] = (unsigned long long)pk2(v1[j].x * r1 * gg.x, v1[j].y * r1 * gg.y) | ((unsigned long long)pk2(v1[j].z * r1 * gg.z, v1[j].w * r1 * gg.w) << 32); }
    }
    for (int m = gw; m < 2048; m += NGW) rms_row_to_bf16(a.in[1] + (size_t)m * 1024, a.in[17], (bf16*)(ws + WS_MEMN) + (size_t)m * 1024, lane);
}
__device__ __forceinline__ void norm128_pass(bf16* X, int rows, int ld, int ngroups, const float* g, int gtid, int nthr) {
    const int l = gtid & 15, total = rows * ngroups;
    for (int gid = gtid >> 4; gid < total; gid += nthr >> 4) {
        const int r = gid / ngroups, gi = gid % ngroups;
        bf16* p = X + (size_t)r * ld + gi * 128 + l * 8;
        const v4u v = *(const GAS v4u*)p; float f[8];
        f[0] = __uint_as_float(v.x << 16); f[1] = __uint_as_float(v.x & 0xffff0000u); f[2] = __uint_as_float(v.y << 16); f[3] = __uint_as_float(v.y & 0xffff0000u);
        f[4] = __uint_as_float(v.z << 16); f[5] = __uint_as_float(v.z & 0xffff0000u); f[6] = __uint_as_float(v.w << 16); f[7] = __uint_as_float(v.w & 0xffff0000u);
        float s = 0.f;
#pragma unroll
        for (int q = 0; q < 8; ++q) s += f[q] * f[q];
        s += __shfl_xor(s, 8); s += __shfl_xor(s, 4); s += __shfl_xor(s, 2); s += __shfl_xor(s, 1);
        const float rs = 1.f / sqrtf(s * (1.f / 128.f) + 1e-6f);
        const f32x4 g0 = *(const GAS f32x4*)(g + l * 8), g1 = *(const GAS f32x4*)(g + l * 8 + 4);
        v4u o; o.x = pk2(f[0] * rs * g0.x, f[1] * rs * g0.y); o.y = pk2(f[2] * rs * g0.z, f[3] * rs * g0.w); o.z = pk2(f[4] * rs * g1.x, f[5] * rs * g1.y); o.w = pk2(f[6] * rs * g1.z, f[7] * rs * g1.w);
        *(GAS v4u*)p = o;
    }
}
__device__ __forceinline__ void s5_scan(int g, int half, const Args& a, int tid) {
    if (tid < 256) {
        const int bl = tid >> 6, n = tid & 63, b = half * 4 + bl;
        const float* LAM32 = (const float*)(a.ws + WS_LAM32) + g * 128; const float lr = LAM32[n * 2], li = LAM32[n * 2 + 1];
        const float* SL = (const float*)(a.ws + WS_SLOC) + ((size_t)(g * 512 + b * 64)) * 128; bf16* Ur = (bf16*)(a.ws + WS_U) + ((size_t)(g * 512 + b * 64)) * 640 + 512;
        float xr = 0.f, xi = 0.f;
#pragma unroll 1
        for (int c0 = 0; c0 < 64; c0 += 16) {
            float sr[16], si[16];
#pragma unroll
            for (int k = 0; k < 16; ++k) { sr[k] = SL[(size_t)(c0 + k) * 128 + n]; si[k] = SL[(size_t)(c0 + k) * 128 + 64 + n]; }
#pragma unroll
            for (int k = 0; k < 16; ++k) {
                Ur[(size_t)(c0 + k) * 640 + n] = (bf16)f2bf(xr); Ur[(size_t)(c0 + k) * 640 + 64 + n] = (bf16)f2bf(xi);
                const float nr = lr * xr - li * xi + sr[k], ni = lr * xi + li * xr + si[k]; xr = nr; xi = ni;
            }
        }
    }
    VM_WAIT(); __syncthreads();
}
#define HAVE_ATTN 1
#ifdef TPROBE
#if TPROBE < 8
#define TP_STAMP(k) { __builtin_amdgcn_sched_barrier(0); const unsigned long long t_ = __builtin_amdgcn_s_memtime(); tp_acc[k] += t_ - tp_prev; tp_prev = t_; __builtin_amdgcn_sched_barrier(0); }
#define TP_DECL unsigned long long tp_acc[8] = {0, 0, 0, 0, 0, 0, 0, 0}; unsigned long long tp_prev = __builtin_amdgcn_s_memtime();
#define TP_FLUSH(base) { if (blockIdx.x == TPROBE_BLOCK && wave == 0 && lane == 0) { unsigned long long* TP = (unsigned long long*)(a.ws + WS_CTL + 65536); for (int k_ = 0; k_ < 8; ++k_) TP[(base) + k_] += tp_acc[k_]; } }
#define TQ_STAMP(k)
#define TQ_DECL
#define TQ_FLUSH
#else
#define TP_STAMP(k)
#define TP_DECL
#define TP_FLUSH(base)
#define TQ_STAMP(k) { const unsigned t_ = (unsigned)__builtin_amdgcn_s_memtime(); tq_acc[k] += t_ - tq_prev; tq_prev = t_; }
#define TQ_DECL unsigned tq_acc[4] = {0, 0, 0, 0}; unsigned tq_prev = (unsigned)__builtin_amdgcn_s_memtime();
#define TQ_FLUSH { if (blockIdx.x == TPROBE_BLOCK && wave == 0 && lane == 0) { unsigned long long* TP = (unsigned long long*)(a.ws + WS_CTL + 65536); for (int k_ = 0; k_ < 4; ++k_) TP[8 + k_] += tq_acc[k_]; } }
#endif
#else
#define TP_STAMP(k)
#define TP_DECL
#define TP_FLUSH(base)
#define TQ_STAMP(k)
#define TQ_DECL
#define TQ_FLUSH
#endif
namespace att {
typedef float f32x16 __attribute__((ext_vector_type(16)));
typedef short s16x4 __attribute__((ext_vector_type(4)));
typedef short v4i16_t __attribute__((ext_vector_type(4)));
typedef float f32x2_t __attribute__((ext_vector_type(2))); typedef __bf16 bf16x2_t __attribute__((ext_vector_type(2)));
typedef unsigned u32x2 __attribute__((ext_vector_type(2)));
#define MFMA32(a, b, c) __builtin_amdgcn_mfma_f32_32x32x16_bf16((a), (b), (c), 0, 0, 0)
__device__ __forceinline__ unsigned cvtpk(float lo, float hi) { const f32x2_t v = {lo, hi}; const bf16x2_t b = __builtin_convertvector(v, bf16x2_t); return __builtin_bit_cast(unsigned, b); }
__device__ __forceinline__ int crow(int r, int hi) { return (r & 3) + 8 * (r >> 2) + 4 * hi; }
__device__ __forceinline__ unsigned off_b(unsigned row, unsigned ch) { return 256u * row + 16u * (ch ^ (((row & 3u) << 2) | ((row >> 2) & 3u))); }
__device__ __forceinline__ float xh_max(float v) { const auto rr = __builtin_amdgcn_permlane32_swap(__float_as_uint(v), __float_as_uint(v), false, false); return fmaxf(__uint_as_float(rr[0]), __uint_as_float(rr[1])); }
__device__ __forceinline__ float xh_sum(float v) { const auto rr = __builtin_amdgcn_permlane32_swap(__float_as_uint(v), __float_as_uint(v), false, false); return __uint_as_float(rr[0]) + __uint_as_float(rr[1]); }
__device__ __forceinline__ unsigned xh_sumu(unsigned v) { const auto rr = __builtin_amdgcn_permlane32_swap(v, v, false, false); return rr[0] + rr[1]; }
__device__ __forceinline__ unsigned xh_or(unsigned v) { const auto rr = __builtin_amdgcn_permlane32_swap(v, v, false, false); return rr[0] | rr[1]; }
constexpr float SCALE2 = 0.08838834764831845f * 1.4426950408889634f;

__device__ __forceinline__ bf16x8 pack_step(const f32x16& x, int s) {
    v4u p; p.x = cvtpk(x[8 * s], x[8 * s + 1]); p.y = cvtpk(x[8 * s + 2], x[8 * s + 3]); p.z = cvtpk(x[8 * s + 4], x[8 * s + 5]); p.w = cvtpk(x[8 * s + 6], x[8 * s + 7]);
    return __builtin_bit_cast(bf16x8, p);
}
__device__ __forceinline__ void qk_tile(f32x16& p0, f32x16& p1, LAS const unsigned char* kimg, const bf16x8 (&qf)[8], int lane) {
    const unsigned r32 = lane & 31, hi = lane >> 5;
    f32x16 z;
#pragma unroll
    for (int r = 0; r < 16; ++r) z[r] = 0.f;
    p0 = z; p1 = z;
    bf16x8 fa[2][4];
#define QK_LOAD(g, buf) { const unsigned o0_ = off_b(r32, 4 * (g) + hi), o1_ = off_b(r32, 4 * (g) + 2 + hi); \
        fa[buf][0] = *(LAS const bf16x8*)(kimg + o0_); fa[buf][1] = *(LAS const bf16x8*)(kimg + o0_ + 32 * 256); fa[buf][2] = *(LAS const bf16x8*)(kimg + o1_); fa[buf][3] = *(LAS const bf16x8*)(kimg + o1_ + 32 * 256); }
#define QK_MMA(g, buf) { p0 = MFMA32(fa[buf][0], qf[2 * (g)], p0); p1 = MFMA32(fa[buf][1], qf[2 * (g)], p1); p0 = MFMA32(fa[buf][2], qf[2 * (g) + 1], p0); p1 = MFMA32(fa[buf][3], qf[2 * (g) + 1], p1); }
    QK_LOAD(0, 0) QK_LOAD(1, 1) QK_MMA(0, 0) asm volatile("" ::: "memory");
    QK_LOAD(2, 0) QK_MMA(1, 1) asm volatile("" ::: "memory");
    QK_LOAD(3, 1) QK_MMA(2, 0) QK_MMA(3, 1)
#undef QK_LOAD
#undef QK_MMA
}
__device__ __forceinline__ s16x4 vtr(LAS const unsigned char* p) { return __builtin_bit_cast(s16x4, __builtin_amdgcn_ds_read_tr16_b64_v4i16((LAS v4i16_t*)p)); }
__device__ __forceinline__ void pv_tile(f32x16 (&o)[4], LAS const unsigned char* vimg, const bf16x8 (&pf)[4], int lane) {
    const unsigned hi = lane >> 5, blk = (lane >> 4) & 1, q = (lane & 15) >> 2, p = lane & 3;
    s16x4 fl[2][4], fh[2][4];
#define PV_LOAD(c, buf) { _Pragma("unroll") for (int ks = 0; ks < 4; ++ks) { const unsigned ch = 4 * (c) + 2 * blk + (p >> 1), rlo = 16 * ks + 4 * hi + q; \
        fl[buf][ks] = vtr(vimg + off_b(rlo, ch) + 8 * (p & 1)); fh[buf][ks] = vtr(vimg + off_b(rlo + 8, ch) + 8 * (p & 1)); } }
#define PV_MMA(c, buf) { _Pragma("unroll") for (int ks = 0; ks < 4; ++ks) { const bf16x8 af = {fl[buf][ks][0], fl[buf][ks][1], fl[buf][ks][2], fl[buf][ks][3], fh[buf][ks][0], fh[buf][ks][1], fh[buf][ks][2], fh[buf][ks][3]}; \
        o[c] = MFMA32(af, pf[ks], o[c]); } }
    PV_LOAD(0, 0) PV_LOAD(1, 1) PV_MMA(0, 0) asm volatile("" ::: "memory");
    PV_LOAD(2, 0) PV_MMA(1, 1) asm volatile("" ::: "memory");
    PV_LOAD(3, 1) PV_MMA(2, 0) PV_MMA(3, 1)
#undef PV_LOAD
#undef PV_MMA
}
template <bool FIXED> __device__ __forceinline__ void softmax_step(f32x16& p0, f32x16& p1, float& m, float& l, f32x16 (&o)[4], bf16x8 (&pf)[4]) {
    if constexpr (FIXED) {
        f32x2_t s2 = {0.f, 0.f};
#pragma unroll
        for (int r = 0; r < 16; ++r) { p0[r] = __builtin_amdgcn_exp2f(p0[r]); p1[r] = __builtin_amdgcn_exp2f(p1[r]); const f32x2_t t = {p0[r], p1[r]}; s2 += t; }
        l += s2[0] + s2[1];
    } else {
        float mx = fmaxf(p0[0], p1[0]);
#pragma unroll
        for (int r = 1; r < 16; ++r) mx = fmaxf(mx, fmaxf(p0[r], p1[r]));
        mx = xh_max(mx);
        const float mnew = fmaxf(m, mx), muse = (mnew == -INFINITY) ? 0.f : mnew;
        const float alpha = __builtin_amdgcn_exp2f(m - muse);
        float s = 0.f;
#pragma unroll
        for (int r = 0; r < 16; ++r) { p0[r] = __builtin_amdgcn_exp2f(p0[r] - muse); p1[r] = __builtin_amdgcn_exp2f(p1[r] - muse); s += p0[r] + p1[r]; }
        l = l * alpha + s; m = mnew;
        if (__any(alpha != 1.f)) {
#pragma unroll
            for (int c = 0; c < 4; ++c)
#pragma unroll
                for (int r = 0; r < 16; ++r) o[c][r] *= alpha;
        }
    }
    pf[0] = pack_step(p0, 0); pf[1] = pack_step(p0, 1); pf[2] = pack_step(p1, 0); pf[3] = pack_step(p1, 1);
}
__device__ __forceinline__ void tile_load(v4u (&rg)[2], const bf16* src, int pitch, int tid) {
#pragma unroll
    for (int i = 0; i < 2; ++i) { const int id = tid + 512 * i, row = id >> 4, ch = id & 15; rg[i] = *(const GAS v4u*)(src + (size_t)row * pitch + ch * 8); }
}
__device__ __forceinline__ void tile_store(const v4u (&rg)[2], LAS unsigned char* img, int tid) {
#pragma unroll
    for (int i = 0; i < 2; ++i) { const int id = tid + 512 * i, row = id >> 4, ch = id & 15; *(LAS v4u*)(img + off_b(row, ch)) = rg[i]; }
}

__device__ __forceinline__ void cross_item(const Args& a, LAS unsigned char* lds, int tid, int lane, int wave, int item) {
    const int r32 = lane & 31, hi = lane >> 5;
    const int b = item >> 5, hx = (item >> 3) & 3, qblk = item & 7;
    const bf16* QX = (const bf16*)(a.ws + WS_QX); const bf16* KX = (const bf16*)(a.ws + WS_KX) + (size_t)b * 256 * 512 + hx * 128; const bf16* VX = (const bf16*)(a.ws + WS_VX) + (size_t)b * 256 * 512 + hx * 128;
    bf16* OX = (bf16*)(a.ws + WS_OX);
    const size_t row = (size_t)b * 2048 + qblk * 256 + wave * 32 + r32;
    bf16x8 qf[8];
#pragma unroll
    for (int s = 0; s < 8; ++s) qf[s] = *(const GAS bf16x8*)(QX + row * 512 + hx * 128 + 16 * s + 8 * hi);
    f32x16 o[4];
#pragma unroll
    for (int c = 0; c < 4; ++c)
#pragma unroll
        for (int r = 0; r < 16; ++r) o[c][r] = 0.f;
    float m = -INFINITY, l = 0.f;
    v4u kr[2], vr[2];
    tile_load(kr, KX, 512, tid); tile_load(vr, VX, 512, tid);
    tile_store(kr, lds, tid); tile_store(vr, lds + 32768, tid);
    __syncthreads();
#pragma unroll 1
    for (int kt = 0; kt < 4; ++kt) {
        LAS unsigned char* kimg = lds + (kt & 1) * 16384; LAS unsigned char* vimg = lds + 32768 + (kt & 1) * 16384;
        if (kt + 1 < 4) { tile_load(kr, KX + (size_t)(kt + 1) * 64 * 512, 512, tid); tile_load(vr, VX + (size_t)(kt + 1) * 64 * 512, 512, tid); }
        f32x16 p0, p1; qk_tile(p0, p1, kimg, qf, lane);
#pragma unroll
        for (int r = 0; r < 16; ++r) { p0[r] *= SCALE2; p1[r] *= SCALE2; }
        bf16x8 pf[4]; softmax_step<false>(p0, p1, m, l, o, pf);
        pv_tile(o, vimg, pf, lane);
        if (kt + 1 < 4) { tile_store(kr, lds + ((kt + 1) & 1) * 16384, tid); tile_store(vr, lds + 32768 + ((kt + 1) & 1) * 16384, tid); }
        __syncthreads();
    }
    l = xh_sum(l);
    const float inv = 1.f / l;
#pragma unroll
    for (int c = 0; c < 4; ++c)
#pragma unroll
        for (int g4 = 0; g4 < 4; ++g4) { u32x2 w; w.x = cvtpk(o[c][4 * g4] * inv, o[c][4 * g4 + 1] * inv); w.y = cvtpk(o[c][4 * g4 + 2] * inv, o[c][4 * g4 + 3] * inv);
            *(GAS u32x2*)(OX + row * 512 + hx * 128 + 32 * c + 8 * g4 + 4 * hi) = w; }
}
__device__ __forceinline__ void cross_phase(const Args& a, LAS unsigned char* lds, int tid, int lane, int wave, int bx, int G) {
    if (bx < 128) return;
#pragma unroll 1
    for (int i = 0; i < 2; ++i) cross_item(a, lds, tid, lane, wave, (bx - 128) * 2 + i);
}

constexpr int DSA_QI = 0, DSA_QPITCH = 1040, DSA_KTB = 33792, DSA_CT = DSA_KTB, DSA_MASK = DSA_KTB + 2 * 32 * 257 * 4, DSA_BT = DSA_MASK + 32 * 65 * 4, DSA_END = DSA_BT + 8 * 320 * 4;
static_assert(DSA_END <= RING_BYTES, "DSA LDS map");
__device__ __forceinline__ unsigned f2key(float x) { const unsigned b = __float_as_uint(x + 0.f); return (b & 0x80000000u) ? ~b : (b | 0x80000000u); }

__device__ __forceinline__ void cnt_ge(unsigned& cnt, unsigned key, unsigned cand) { asm volatile("v_cmp_ge_u32 vcc, %1, %2\n\tv_addc_co_u32_e32 %0, vcc, 0, %0, vcc" : "+v"(cnt) : "v"(key), "v"(cand) : "vcc"); }
__device__ __forceinline__ void cnt_gt(unsigned& cnt, unsigned key, unsigned cand) { asm volatile("v_cmp_gt_u32 vcc, %1, %2\n\tv_addc_co_u32_e32 %0, vcc, 0, %0, vcc" : "+v"(cnt) : "v"(key), "v"(cand) : "vcc"); }
__device__ __forceinline__ void cnt_eq(unsigned& cnt, unsigned key, unsigned cand) { asm volatile("v_cmp_eq_u32 vcc, %1, %2\n\tv_addc_co_u32_e32 %0, vcc, 0, %0, vcc" : "+v"(cnt) : "v"(key), "v"(cand) : "vcc"); }
__device__ __forceinline__ void cnt4_ge(unsigned& c0, unsigned& c1, unsigned& c2, unsigned& c3, unsigned k0, unsigned k1, unsigned k2, unsigned k3, unsigned cand) {
    unsigned long long m0, m1, m2;
    asm volatile("v_cmp_ge_u32 %4, %7, %11\n\tv_cmp_ge_u32 %5, %8, %11\n\tv_cmp_ge_u32 %6, %9, %11\n\tv_cmp_ge_u32 vcc, %10, %11\n\t"
                 "v_addc_co_u32_e64 %0, %4, 0, %0, %4\n\tv_addc_co_u32_e64 %1, %5, 0, %1, %5\n\tv_addc_co_u32_e64 %2, %6, 0, %2, %6\n\tv_addc_co_u32_e32 %3, vcc, 0, %3, vcc"
                 : "+v"(c0), "+v"(c1), "+v"(c2), "+v"(c3), "=&s"(m0), "=&s"(m1), "=&s"(m2) : "v"(k0), "v"(k1), "v"(k2), "v"(k3), "v"(cand) : "vcc");
}
template <int IB> __device__ __forceinline__ void cnt_tie_lt(unsigned& cnt, unsigned key, unsigned thr, unsigned lanepart, unsigned cand) { unsigned t;
    asm volatile("v_add_u32_e32 %1, %6, %4\n\tv_cmp_eq_u32 vcc, %2, %3\n\tv_cndmask_b32_e32 %1, -1, %1, vcc\n\tv_cmp_lt_u32 vcc, %1, %5\n\tv_addc_co_u32_e32 %0, vcc, 0, %0, vcc"
                 : "+v"(cnt), "=&v"(t) : "v"(key), "v"(thr), "v"(lanepart), "v"(cand), "i"(IB) : "vcc"); }
template <int IB, int BR> __device__ __forceinline__ void mask_sel(unsigned& w, unsigned key, unsigned thr, unsigned lanepart, unsigned istar, unsigned onehi) { unsigned t, bit;
    asm volatile("v_lshlrev_b32_e32 %2, %8, %7\n\tv_cmp_gt_u32 vcc, %3, %4\n\tv_cndmask_b32_e32 %1, 0, %2, vcc\n\tv_or_b32_e32 %0, %0, %1\n\t"
                 "v_add_u32_e32 %1, %9, %5\n\tv_cmp_le_u32 vcc, %1, %6\n\tv_cndmask_b32_e32 %1, 0, %2, vcc\n\tv_cmp_eq_u32 vcc, %3, %4\n\tv_cndmask_b32_e32 %1, 0, %1, vcc\n\tv_or_b32_e32 %0, %0, %1"
                 : "+v"(w), "=&v"(t), "=&v"(bit) : "v"(key), "v"(thr), "v"(lanepart), "v"(istar), "v"(onehi), "i"(BR), "i"(IB) : "vcc"); }

#define CRB(r) (((r) & 3) + 8 * ((r) >> 2))
#define TIE1(i, r) cnt_tie_lt<256 * (i) + CRB(r)>(cnt, key[i][r], thr, lanepart, cand);
#define TIE_ROW(i) TIE1(i,0) TIE1(i,1) TIE1(i,2) TIE1(i,3) TIE1(i,4) TIE1(i,5) TIE1(i,6) TIE1(i,7) TIE1(i,8) TIE1(i,9) TIE1(i,10) TIE1(i,11) TIE1(i,12) TIE1(i,13) TIE1(i,14) TIE1(i,15)
#define SEL1(i, r) mask_sel<256 * (i) + CRB(r), CRB(r)>(w, key[i][r], thr, lanepart, istar, onehi);
#define SEL_ROW(i) SEL1(i,0) SEL1(i,1) SEL1(i,2) SEL1(i,3) SEL1(i,4) SEL1(i,5) SEL1(i,6) SEL1(i,7) SEL1(i,8) SEL1(i,9) SEL1(i,10) SEL1(i,11) SEL1(i,12) SEL1(i,13) SEL1(i,14) SEL1(i,15)
__device__ __forceinline__ unsigned row_total(unsigned cnt, LAS unsigned* CNT, int& par, int r32, int hi, int wave) {
    cnt = xh_sumu(cnt);
    if (hi == 0) CNT[par * 256 + r32 * 8 + wave] = cnt;
    __syncthreads();
    const v4u x = *(LAS const v4u*)(CNT + par * 256 + r32 * 8), y = *(LAS const v4u*)(CNT + par * 256 + r32 * 8 + 4);
    par ^= 1;
    return (x.x + x.y) + (x.z + x.w) + (y.x + y.y) + (y.z + y.w);
}
template <bool FIXED> __device__ __forceinline__ void dsa_attn(const Args& a, LAS unsigned char* lds, int tid, int lane, int wave, int b, int qb, bool sel) {
    const int r32 = lane & 31, hi = lane >> 5;
    const int t0 = qb * 32; const size_t rowb = (size_t)b * 2048;
    const bf16* QD = (const bf16*)(a.ws + WS_QD); const bf16* CKV = (const bf16*)(a.ws + WS_CKV) + rowb * 128;
    const float* BL = (const float*)(a.ws + WS_BIASL); const bf16* WUV = (const bf16*)(a.ws + WS_WUV); bf16* ODSA = (bf16*)(a.ws + WS_ODSA);
    LAS unsigned* MASK = (LAS unsigned*)(lds + DSA_MASK);
    const int h = wave; const int tq = t0 + r32; const size_t qrow = rowb + t0 + r32;
    bf16x8 qf[8];
#pragma unroll
    for (int s = 0; s < 8; ++s) qf[s] = *(const GAS bf16x8*)(QD + qrow * 1024 + h * 128 + 16 * s + 8 * hi);
    const float c31 = BL[1024 + h] - BL[1032];
    f32x16 o[4];
#pragma unroll
    for (int c = 0; c < 4; ++c)
#pragma unroll
        for (int r = 0; r < 16; ++r) o[c][r] = 0.f;
    float m = -INFINITY, l = 0.f;
    const int NKT = (t0 + 32 + 63) >> 6;
    TP_DECL
#define DMA_TILE(kt_) { _Pragma("unroll") for (int i_ = 0; i_ < 2; ++i_) { const int rb_ = i_ * 8 + wave, row_ = 4 * rb_ + (lane >> 4), ch_ = (lane & 15) ^ (((row_ & 3) << 2) | ((row_ >> 2) & 3)); \
        __builtin_amdgcn_global_load_lds((const unsigned*)(CKV + (size_t)(64 * (kt_) + row_) * 128 + ch_ * 8), (LAS unsigned*)(lds + DSA_CT + ((kt_) & 3) * 16384 + rb_ * 1024), 16, 0, 0); } }
    DMA_TILE(0) if (NKT > 1) DMA_TILE(1)
    __syncthreads();
#pragma unroll 1
    for (int kp = 0; kp < NKT; kp += 2) {
      if (kp + 2 < NKT) DMA_TILE(kp + 2) if (kp + 3 < NKT) DMA_TILE(kp + 3)
#pragma unroll 1
      for (int kt = kp; kt < kp + 2 && kt < NKT; ++kt) {
        LAS unsigned char* cimg = lds + DSA_CT + (kt & 3) * 16384;
        TP_STAMP(0)
        f32x16 p0, p1; qk_tile(p0, p1, cimg, qf, lane);
        TP_STAMP(1)
        const int k0 = 64 * kt;
        const bool far = (t0 - k0 - 63) >= 128;
        unsigned mv0, mv1;
        if (sel) { mv0 = MASK[r32 * 65 + 2 * kt] >> (4 * hi); mv1 = MASK[r32 * 65 + 2 * kt + 1] >> (4 * hi); }
        else { const int d0 = tq - k0 - 4 * hi, d1 = d0 - 32;
            mv0 = d0 < 0 ? 0u : (d0 >= 31 ? 0x0f0f0f0fu : (0x0f0f0f0fu & ((2u << d0) - 1u)));
            mv1 = d1 < 0 ? 0u : (d1 >= 31 ? 0x0f0f0f0fu : (0x0f0f0f0fu & ((2u << d1) - 1u))); }
        if (far) {
#pragma unroll
            for (int r = 0; r < 16; ++r) { p0[r] = ((mv0 >> CRB(r)) & 1u) ? p0[r] * SCALE2 + c31 : -INFINITY; p1[r] = ((mv1 >> CRB(r)) & 1u) ? p1[r] * SCALE2 + c31 : -INFINITY; }
        } else {
            LAS const float* bt = (LAS const float*)(lds + DSA_BT) + h * 320 + (255 - (tq - k0 - 4 * hi));
#pragma unroll
            for (int r = 0; r < 16; ++r) { const float b0 = bt[CRB(r)], b1 = bt[32 + CRB(r)];
                p0[r] = ((mv0 >> CRB(r)) & 1u) ? p0[r] * SCALE2 + b0 : -INFINITY; p1[r] = ((mv1 >> CRB(r)) & 1u) ? p1[r] * SCALE2 + b1 : -INFINITY; }
        }
        bf16x8 pf[4];
        softmax_step<FIXED>(p0, p1, m, l, o, pf);
        TP_STAMP(2)
        pv_tile(o, cimg, pf, lane);
        TP_STAMP(3)
        TP_STAMP(4)
      }
      __syncthreads();
    }
#undef DMA_TILE
    l = xh_sum(l);
    const float inv = 1.f / l;
    bf16x8 of[8];
#pragma unroll
    for (int c = 0; c < 4; ++c) {
#pragma unroll
        for (int r = 0; r < 16; ++r) o[c][r] *= inv;
        of[2 * c] = pack_step(o[c], 0); of[2 * c + 1] = pack_step(o[c], 1);
    }
    { s16x4 wl[2][8], wh[2][8];
#pragma unroll
      for (int eb = 0; eb < 2; ++eb) { const bf16* wf = WUV + (size_t)((h * 2 + eb) * 8) * 512 + lane * 4;
#pragma unroll
        for (int cs = 0; cs < 8; ++cs) { wl[eb][cs] = *(const GAS s16x4*)(wf + cs * 512); wh[eb][cs] = *(const GAS s16x4*)(wf + cs * 512 + 256); } }
      asm volatile("" ::: "memory");
#pragma unroll
      for (int eb = 0; eb < 2; ++eb) {
        f32x16 acc;
#pragma unroll
        for (int r = 0; r < 16; ++r) acc[r] = 0.f;
#pragma unroll
        for (int cs = 0; cs < 8; ++cs) {
            const bf16x8 af = {wl[eb][cs][0], wl[eb][cs][1], wl[eb][cs][2], wl[eb][cs][3], wh[eb][cs][0], wh[eb][cs][1], wh[eb][cs][2], wh[eb][cs][3]};
            acc = MFMA32(af, of[cs], acc);
        }
#pragma unroll
        for (int g4 = 0; g4 < 4; ++g4) { u32x2 w; w.x = cvtpk(acc[4 * g4], acc[4 * g4 + 1]); w.y = cvtpk(acc[4 * g4 + 2], acc[4 * g4 + 3]);
            *(GAS u32x2*)(ODSA + qrow * 512 + h * 64 + 32 * eb + 8 * g4 + 4 * hi) = w; }
      } }
    TP_STAMP(5)
    TP_FLUSH(0)
}
template <int MODE> __device__ __forceinline__ void dsa_item(const Args& a, LAS unsigned char* lds, int tid, int lane, int wave, int b, int qb) {
    const int r32 = lane & 31, hi = lane >> 5;
    const int t0 = qb * 32; const size_t rowb = (size_t)b * 2048;
    const bool sel = qb >= 8;
    const bf16* QD = (const bf16*)(a.ws + WS_QD); const bf16* CKV = (const bf16*)(a.ws + WS_CKV) + rowb * 128; const bf16* QI = (const bf16*)(a.ws + WS_QI); const bf16* KI = (const bf16*)(a.ws + WS_KI) + rowb * 64;
    const float* WI = (const float*)(a.ws + WS_WI); const float* BL = (const float*)(a.ws + WS_BIASL); const bf16* WUV = (const bf16*)(a.ws + WS_WUV); bf16* ODSA = (bf16*)(a.ws + WS_ODSA);
    LAS unsigned* MASK = (LAS unsigned*)(lds + DSA_MASK);
    const int NT = qb + 1;
    TQ_DECL
    if (MODE != 1 && sel) {
#pragma unroll
        for (int i = 0; i < 4; ++i) { const int id = tid + 512 * i, row = id >> 6, ch = id & 63;
            *(LAS v4u*)(lds + DSA_QI + row * DSA_QPITCH + ch * 16) = *(const GAS v4u*)(QI + (rowb + t0 + row) * 512 + ch * 8); }
        __syncthreads();
        float wq[8];
        { const f32x4 w0 = *(const GAS f32x4*)(WI + (rowb + t0 + r32) * 8), w1 = *(const GAS f32x4*)(WI + (rowb + t0 + r32) * 8 + 4);
          wq[0] = w0.x; wq[1] = w0.y; wq[2] = w0.z; wq[3] = w0.w; wq[4] = w1.x; wq[5] = w1.y; wq[6] = w1.z; wq[7] = w1.w; }
        unsigned kw[4][32];
        LAS unsigned* KTB = (LAS unsigned*)(lds + DSA_KTB);
        LAS const unsigned char* qbase = lds + DSA_QI + r32 * DSA_QPITCH + hi * 16;
        const bf16* kbase = KI + (size_t)r32 * 64 + 8 * hi;
        bf16x8 kf[4]; const bf16* kptr = kbase + (size_t)wave * 2048;
        if (wave < NT) {
#pragma unroll
            for (int kk = 0; kk < 4; ++kk) kf[kk] = *(const GAS bf16x8*)(kptr + 16 * kk);
        }
        kptr += 8 * 2048;
#define SC_HEAD(hh, dst) { _Pragma("unroll") for (int r = 0; r < 16; ++r) dst[r] = 0.f; \
            _Pragma("unroll") for (int kk = 0; kk < 4; ++kk) { const bf16x8 qf = *(LAS const bf16x8*)(qbase + ((hh) * 8 + 2 * kk) * 16); dst = MFMA32(kf[kk], qf, dst); } }
#define SC_ACC(hh, src) { const f32x2_t w2_ = {wq[hh], wq[hh]}; \
            _Pragma("unroll") for (int r = 0; r < 16; r += 2) { const f32x2_t t_ = {__builtin_amdgcn_fmed3f(src[r], 0.f, INFINITY), __builtin_amdgcn_fmed3f(src[r + 1], 0.f, INFINITY)}; \
                f32x2_t s_ = {sacc[r], sacc[r + 1]}; s_ = __builtin_elementwise_fma(t_, w2_, s_); sacc[r] = s_[0]; sacc[r + 1] = s_[1]; } \
            _Pragma("unroll") for (int r = 0; r < 16; ++r) asm volatile("" : "+v"(sacc[r])); }
#define SC_TILE(i) { const int j = wave + 8 * (i); \
            if (8 * (i) < NT) {                                            \
                LAS unsigned* kt_ = KTB + ((i) & 1) * (32 * 257); \
                if (j < NT) { \
                    f32x16 sacc, da, db; \
                    _Pragma("unroll") for (int r = 0; r < 16; ++r) sacc[r] = 0.f; \
                    SC_HEAD(0, da) SC_HEAD(1, db) SC_ACC(0, da) SC_HEAD(2, da) SC_ACC(1, db) SC_HEAD(3, db) SC_ACC(2, da) SC_HEAD(4, da) SC_ACC(3, db) \
                    SC_HEAD(5, db) SC_ACC(4, da) SC_HEAD(6, da) SC_ACC(5, db) SC_HEAD(7, db) \
                    asm volatile("" ::: "memory"); \
                    if (j + 8 < NT) { _Pragma("unroll") for (int kk = 0; kk < 4; ++kk) kf[kk] = *(const GAS bf16x8*)(kptr + 16 * kk); kptr += 8 * 2048; }     \
                    SC_ACC(6, da) SC_ACC(7, db) \
                    _Pragma("unroll") for (int r = 0; r < 16; ++r) { const bool vis = (j < NT - 1) || (crow(r, hi) <= r32); kt_[r32 * 257 + 32 * wave + crow(r, hi)] = vis ? f2key(sacc[r]) : 0u; } \
                } else { _Pragma("unroll") for (int r = 0; r < 16; ++r) kt_[r32 * 257 + 32 * wave + crow(r, hi)] = 0u; } \
                __syncthreads(); \
                _Pragma("unroll") for (int rho = 0; rho < 4; ++rho) _Pragma("unroll") for (int k = 0; k < 4; ++k) kw[rho][4 * (i) + k] = kt_[(4 * wave + rho) * 257 + 64 * k + lane]; \
            } else { _Pragma("unroll") for (int rho = 0; rho < 4; ++rho) _Pragma("unroll") for (int k = 0; k < 4; ++k) kw[rho][4 * (i) + k] = 0u; } }
        SC_TILE(0) SC_TILE(1) SC_TILE(2) SC_TILE(3) SC_TILE(4) SC_TILE(5) SC_TILE(6) SC_TILE(7)
#undef SC_TILE
#undef SC_ACC
#undef SC_HEAD
        TQ_STAMP(0)
        unsigned thr[4] = {0u, 0u, 0u, 0u}; bool fnd[4] = {false, false, false, false};
        if constexpr (MODE != 3) {
#pragma unroll 1
            for (int bit = 31; bit >= 0; --bit) {
#pragma unroll
                for (int rho = 0; rho < 4; ++rho) if (!fnd[rho]) {
                    const unsigned cand = (unsigned)__builtin_amdgcn_readfirstlane((int)(thr[rho] | (1u << bit))); unsigned cnt = 0u;
#pragma unroll
                    for (int e = 0; e < 32; e += 4) {
                        unsigned long long b0, b1, b2, b3;
                        asm volatile("v_cmp_ge_u32_e64 %0, %4, %8\n\tv_cmp_ge_u32_e64 %1, %5, %8\n\tv_cmp_ge_u32_e64 %2, %6, %8\n\tv_cmp_ge_u32_e64 %3, %7, %8"
                                     : "=&s"(b0), "=&s"(b1), "=&s"(b2), "=&s"(b3) : "v"(kw[rho][e]), "v"(kw[rho][e + 1]), "v"(kw[rho][e + 2]), "v"(kw[rho][e + 3]), "s"(cand));
                        cnt += (unsigned)(__builtin_popcountll(b0) + __builtin_popcountll(b1)) + (unsigned)(__builtin_popcountll(b2) + __builtin_popcountll(b3));
                    }
                    if (cnt >= 256u) thr[rho] = cand;
                    fnd[rho] = cnt == 256u;
                }
                if (fnd[0] && fnd[1] && fnd[2] && fnd[3]) break;
            }
        }
#pragma unroll
        for (int rho = 0; rho < 4; ++rho) {
            const unsigned th = (unsigned)__builtin_amdgcn_readfirstlane((int)thr[rho]); unsigned gtot = 0u;
#pragma unroll
            for (int e = 0; e < 32; e += 4) { unsigned long long b0, b1, b2, b3;
                asm volatile("v_cmp_gt_u32_e64 %0, %4, %8\n\tv_cmp_gt_u32_e64 %1, %5, %8\n\tv_cmp_gt_u32_e64 %2, %6, %8\n\tv_cmp_gt_u32_e64 %3, %7, %8"
                             : "=&s"(b0), "=&s"(b1), "=&s"(b2), "=&s"(b3) : "v"(kw[rho][e]), "v"(kw[rho][e + 1]), "v"(kw[rho][e + 2]), "v"(kw[rho][e + 3]), "s"(th));
                gtot += (unsigned)(__builtin_popcountll(b0) + __builtin_popcountll(b1)) + (unsigned)(__builtin_popcountll(b2) + __builtin_popcountll(b3)); }
            unsigned rem = 256u - gtot;
            unsigned wlo = 0u, whi = 0u;
#define WLANE(dst, val, ln) asm volatile("v_writelane_b32 %0, %1, %2" : "+v"(dst) : "s"(val), "i"(ln));
#define MB_STEP(e) { unsigned long long g0, g1, q0, q1; \
                asm volatile("v_cmp_gt_u32_e64 %0, %4, %6\n\tv_cmp_gt_u32_e64 %1, %5, %6\n\tv_cmp_eq_u32_e64 %2, %4, %6\n\tv_cmp_eq_u32_e64 %3, %5, %6" \
                             : "=&s"(g0), "=&s"(g1), "=&s"(q0), "=&s"(q1) : "v"(kw[rho][e]), "v"(kw[rho][(e) + 1]), "s"(th)); \
                unsigned c = (unsigned)__builtin_popcountll(q0); \
                if (c > rem) { while ((unsigned)__builtin_popcountll(q0) > rem) q0 &= ~(1ull << (63 - __builtin_clzll(q0))); c = rem; }     \
                rem -= c; \
                c = (unsigned)__builtin_popcountll(q1); \
                if (c > rem) { while ((unsigned)__builtin_popcountll(q1) > rem) q1 &= ~(1ull << (63 - __builtin_clzll(q1))); c = rem; } \
                rem -= c; \
                const unsigned long long s0 = g0 | q0, s1 = g1 | q1; \
                WLANE(wlo, (unsigned)s0, e) WLANE(whi, (unsigned)(s0 >> 32), e) WLANE(wlo, (unsigned)s1, (e) + 1) WLANE(whi, (unsigned)(s1 >> 32), (e) + 1) }
            MB_STEP(0) MB_STEP(2) MB_STEP(4) MB_STEP(6) MB_STEP(8) MB_STEP(10) MB_STEP(12) MB_STEP(14) MB_STEP(16) MB_STEP(18) MB_STEP(20) MB_STEP(22) MB_STEP(24) MB_STEP(26) MB_STEP(28) MB_STEP(30)
#undef MB_STEP
            if (lane < 32) { const int j = 8 * (lane >> 2) + 2 * (lane & 3); MASK[(4 * wave + rho) * 65 + j] = wlo; MASK[(4 * wave + rho) * 65 + j + 1] = whi; }
#undef WLANE
        }
        __syncthreads();
        TQ_STAMP(1)
    }
    if constexpr (MODE == 0 || MODE == 1) {
        const float Mb = ((const float*)(a.ws + WS_BIASL))[1032];
        if (Mb != 0.f) dsa_attn<true>(a, lds, tid, lane, wave, b, qb, sel); else dsa_attn<false>(a, lds, tid, lane, wave, b, qb, sel);
    }
    TQ_STAMP(2)
    TQ_FLUSH
    __syncthreads();
}
template <int MODE = 0> __device__ __forceinline__ void dsa_phase(const Args& a, LAS unsigned char* lds, int wave, int bx, int G) {
    const int b = bx >> 5, p = bx & 31;
    { const float* BL = (const float*)(a.ws + WS_BIASL); LAS float* BT = (LAS float*)(lds + DSA_BT);
      for (int i = wave * 64 + my_lane_id(); i < 8 * 320; i += NTHR) { const int hh = i / 320, d = 255 - (i % 320); BT[i] = (d < 0 ? 0.f : (d < 128 ? BL[hh * 128 + d] : BL[1024 + hh])) - BL[1032]; } }
    __syncthreads();
#pragma unroll 1
    for (int it = 0; it < 2; ++it) {
        const int lane = my_lane_id();
        dsa_item<MODE>(a, lds, wave * 64 + lane, lane, wave, b, it == 0 ? 63 - p : p);
    }
}
}
#define HAVE_DSA 1
using att::cross_phase;
__device__ __forceinline__ void dsa_phase(const Args& a, LAS unsigned char* lds, int wave, int bx, int G) { att::dsa_phase<0>(a, lds, wave, bx, G); }
__global__ void __launch_bounds__(NTHR, 2) mk_fwd(Args args) {
    extern __shared__ __attribute__((aligned(16))) unsigned char lds_raw[];
    LAS unsigned char* lds = (LAS unsigned char*)lds_raw;
    volatile LAS unsigned* MISC = (volatile LAS unsigned*)(lds + MISC_OFF);
    const int wave = __builtin_amdgcn_readfirstlane(threadIdx.x >> 6);
#define MYLANE() my_lane_id()
    const int G = gridDim.x, bx = blockIdx.x, vcu = (G % 8 == 0) ? (bx % 8) * (G / 8) + bx / 8 : bx;
    unsigned char* ws = args.ws;
    gu32* ctl = (gu32*)(ws + WS_CTL);
    { const int tid = wave * 64 + MYLANE();
      for (int u = tid; u < (LDS_BYTES - LDSCTL_OFF) / 4; u += NTHR) ((LAS unsigned*)(lds + LDSCTL_OFF))[u] = 0u; }
    __syncthreads();
    const int lo = args.ph_lo, hi = args.ph_hi;
    const bool multi = (hi - lo) > 1;
    XcdBarrier bar; bar.bar = (unsigned*)(ctl + CW_BAR) + args.li * XCD_BAR_WORDS; bar.x = 0; bar.st = nullptr;
    if (multi) bar = xcd_barrier_post((unsigned*)(ctl + CW_BAR) + args.li * XCD_BAR_WORDS, MISC + 8, wave == 0 && MYLANE() == 0);
#define IN(k) (lo <= (k) && (k) < hi)
#define RPT(k) ((args.flags >> (16 + (k))) & 1)
#define L1_INV_SYNC() do { VM_WAIT(); __builtin_amdgcn_fence(__ATOMIC_ACQUIRE, "agent"); VM_WAIT(); __syncthreads(); } while (0)
#define SEAM(k) do { if (IN(k) && IN((k) + 1)) xcd_barrier(bar, wave == 0 && MYLANE() == 0); } while (0)
    bf16 *WIN = (bf16*)(ws + WS_WIN), *WMKV = (bf16*)(ws + WS_WMKV), *WGLU = (bf16*)(ws + WS_WGLU), *WBR = (bf16*)(ws + WS_WBR), *WOUT = (bf16*)(ws + WS_WOUT), *WGU = (bf16*)(ws + WS_WGU), *WD = (bf16*)(ws + WS_WD);
    float *RS = (float*)(ws + WS_RS), *WI = (float*)(ws + WS_WI), *SLOC = (float*)(ws + WS_SLOC);
    bf16 *KX = (bf16*)(ws + WS_KX), *VX = (bf16*)(ws + WS_VX), *MEMN = (bf16*)(ws + WS_MEMN), *H = (bf16*)(ws + WS_H), *QD = (bf16*)(ws + WS_QD), *CKV = (bf16*)(ws + WS_CKV), *QI = (bf16*)(ws + WS_QI), *KI = (bf16*)(ws + WS_KI),
         *QX = (bf16*)(ws + WS_QX), *U = (bf16*)(ws + WS_U), *ODSA = (bf16*)(ws + WS_ODSA), *OX = (bf16*)(ws + WS_OX), *Y = (bf16*)(ws + WS_Y), *OS5 = (bf16*)args.out, *G3 = (bf16*)(ws + WS_G3), *MG = (bf16*)(ws + WS_MERGED),
         *ACT = (bf16*)(ws + WS_ACT), *XN = (bf16*)(ws + WS_XN), *S5TV = (bf16*)(ws + WS_S5TV), *S5W = (bf16*)(ws + WS_S5W);

    if (IN(0)) for (int rep_ = 0; rep_ <= RPT(0); ++rep_) { if (rep_) xcd_barrier(bar, wave == 0 && MYLANE() == 0); const int lane = MYLANE(), tid = wave * 64 + lane; p0_prologue(args, lds, tid, lane, wave, vcu, G); }
    SEAM(0);
    if (IN(1)) for (int rep_ = 0; rep_ <= RPT(1); ++rep_) { if (rep_) xcd_barrier(bar, wave == 0 && MYLANE() == 0);
        { pg8::Gemm g{H, WIN, T_TOK, NIN, 1024, 1024, 1024}; pg8::StaticOrder S; S.init(T_TOK, NIN, G, bx);
          pg8::EpiInprojF E{QD, CKV, QI, KI, U, QX, WI, args.in[5], args.in[6], args.in[19], (LAS float*)(lds + XB_OFF)};
          pg8::gemm_phase<pg8::EpiInprojF, pg8::StaticOrder, true, true>(lds + RING_OFF, g, S, E, wave); }
        { pg8::Gemm g{MEMN, WMKV, 2048, 1024, 1024, 1024, 1024}; pg8::SubsetOrder S; S.init(2048, 1024, 64, bx - 192);
          pg8::EpiMemKVF E{KX, VX, args.in[20], (LAS float*)(lds + XB_OFF)};
          pg8::gemm_phase<pg8::EpiMemKVF, pg8::SubsetOrder, true, true>(lds + RING_OFF, g, S, E, wave); }
    }
    SEAM(1);
    if (IN(3)) for (int rep_ = 0; rep_ <= RPT(3); ++rep_) { if (rep_) xcd_barrier(bar, wave == 0 && MYLANE() == 0);
#ifdef TPROBE
        const unsigned long long tp3_0 = __builtin_amdgcn_s_memtime();
#endif
        if (!(args.flags & FL_NO_S5)) {
            if (bx < 128) {
                { pg8::Gemm g{U, S5W, 32 * 512, 32 * 256, 512, 640, 512}; pg8::S5Order1 S{((bx >> 2) * 2) + ((bx >> 1) & 1)};
                  pg8::EpiSlocF E{SLOC};
                  pg8::gemm_phase<pg8::EpiSlocF, pg8::S5Order1, false, true>(lds + RING_OFF, g, S, E, wave); }
                VM_WAIT(); __syncthreads();
                s5_scan(bx >> 2, (bx >> 1) & 1, args, wave * 64 + MYLANE());
            }
            pg8::Gemm g{U, S5TV, 32 * 512, 32 * 512, 640, 640, 640}; pg8::S5Order2 S{bx};
            pg8::EpiS5YF E{U, args.in[15], Y};
            pg8::gemm_phase<pg8::EpiS5YF, pg8::S5Order2, false, true>(lds + RING_OFF, g, S, E, wave);
        }
#ifdef HAVE_ATTN
        if (!(args.flags & FL_NO_CROSS)) { const int lane = MYLANE(); cross_phase(args, lds, wave * 64 + lane, lane, wave, bx, G); }
#endif
#ifdef TPROBE
        const unsigned long long tp3_1 = __builtin_amdgcn_s_memtime();
#endif
#ifdef HAVE_DSA
        if (!(args.flags & FL_NO_DSA)) dsa_phase(args, lds, wave, bx, G);
#endif
#ifdef TPROBE
        if (bx == TPROBE_BLOCK && wave == 0 && MYLANE() == 0) { unsigned long long* TP = (unsigned long long*)(ws + WS_CTL + 65536); TP[12] = __builtin_amdgcn_s_memtime() - tp3_0; TP[13] = tp3_1 - tp3_0; }
#endif
    }
    SEAM(3);
    if (IN(4)) for (int rep_ = 0; rep_ <= RPT(4); ++rep_) { if (rep_) xcd_barrier(bar, wave == 0 && MYLANE() == 0);
        { pg8::Gemm g{Y, WGLU, T_TOK, 512, 512, 512, 512}; pg8::SubsetOrder S; S.init(T_TOK, 512, 128, bx < 128 ? bx : -1);
          pg8::EpiGluF E{Y, OS5};
          pg8::gemm_phase<pg8::EpiGluF, pg8::SubsetOrder, false, true>(lds + RING_OFF, g, S, E, wave); }
        { pg8::Gemm g{H, WIN + (size_t)NIN * 1024, T_TOK, 3072, 1024, 1024, 1024}; pg8::GateOrder S{bx};
          pg8::EpiSigmoidF E{G3, 3072};
          pg8::gemm_phase<pg8::EpiSigmoidF, pg8::GateOrder, true, true>(lds + RING_OFF, g, S, E, wave); }
    }
    SEAM(4);
    if (IN(5)) for (int rep_ = 0; rep_ <= RPT(5); ++rep_) { if (rep_) xcd_barrier(bar, wave == 0 && MYLANE() == 0);
        pg8::Gemm g{ODSA, WBR, T_TOK, 1024, 512, 512, 512}; pg8::MergeOrder S; S.so.init(T_TOK, 1024, G, bx);
        S.aoff[0] = 0; S.aoff[1] = (long)((const char*)OS5 - (const char*)ODSA); S.aoff[2] = (long)((const char*)OX - (const char*)ODSA);
        pg8::EpiMergeF E{G3, MG};
        pg8::gemm_phase<pg8::EpiMergeF, pg8::MergeOrder, true, true>(lds + RING_OFF, g, S, E, wave);
    }
    SEAM(5);
    if (IN(6)) for (int rep_ = 0; rep_ <= RPT(6); ++rep_) { if (rep_) xcd_barrier(bar, wave == 0 && MYLANE() == 0);
        pg8::Gemm g{MG, WOUT, T_TOK, 1024, 1024, 1024, 1024}; pg8::StaticOrder S; S.init(T_TOK, 1024, G, bx);
        pg8::EpiOutF E{args.in[0], args.out, XN, RS};
        pg8::gemm_phase<pg8::EpiOutF, pg8::StaticOrder, false, true>(lds + RING_OFF, g, S, E, wave);
    }
    SEAM(6);
    if (IN(7)) for (int rep_ = 0; rep_ <= RPT(7); ++rep_) { if (rep_) xcd_barrier(bar, wave == 0 && MYLANE() == 0);
        pg8::Gemm g{XN, WGU, T_TOK, 5632, 1024, 1024, 1024}; pg8::StaticOrder S; S.init(T_TOK, 5632, G, bx);
        pg8::EpiGateUpF E{RS, ACT};
        pg8::gemm_phase<pg8::EpiGateUpF, pg8::StaticOrder, true, true>(lds + RING_OFF, g, S, E, wave);
    }
    SEAM(7);
    if (IN(8)) for (int rep_ = 0; rep_ <= RPT(8); ++rep_) { if (rep_) xcd_barrier(bar, wave == 0 && MYLANE() == 0);
        pg8::Gemm g{ACT, WD, T_TOK, 1024, 2816, 2816, 2816}; pg8::StaticOrder S; S.init(T_TOK, 1024, G, bx);
        pg8::EpiDownF E{XN, args.out};
        pg8::gemm_phase<pg8::EpiDownF, pg8::StaticOrder, false, true>(lds + RING_OFF, g, S, E, wave);
    }
#ifdef TPROBE
    xcd_barrier(bar, wave == 0 && MYLANE() == 0);
    if (bx == 0 && wave == 0 && MYLANE() == 0) { const unsigned long long* TP = (const unsigned long long*)(ws + WS_CTL + 65536); unsigned long long tot = TP[12];
#if TPROBE < 8
        tot = 0; for (int k_ = 0; k_ < 6; ++k_) tot += TP[k_];
#endif
        const float frac = tot ? (float)((double)TP[TPROBE] / (double)tot) : 0.f; args.out[0] += 0.15f + 0.3f * frac; }
#endif
#undef IN
#undef SEAM
}
extern "C" void kernel_launch(void* const* d_in, const int* in_sizes, int n_in, void* d_out, int out_size, void* d_ws, size_t ws_size, hipStream_t stream) {
    static int grid = 0;
    if (grid == 0) {
        if (n_in != 29 || ws_size < WS_END || out_size != T_TOK * DM || in_sizes[0] != T_TOK * DM) { fprintf(stderr, "kernel_launch: built for 29 inputs, x/out of %d floats, >= %zu bytes of workspace; got n_in %d out %d ws %zu; nothing launched\n", T_TOK * DM, (size_t)WS_END, n_in, out_size, ws_size); grid = -1; return; }
        int dev = 0, cus = 0, per_cu = 0;
        if (hipGetDevice(&dev) != hipSuccess || hipDeviceGetAttribute(&cus, hipDeviceAttributeMultiprocessorCount, dev) != hipSuccess) { fprintf(stderr, "kernel_launch: hipGetDevice / hipDeviceGetAttribute failed; nothing launched\n"); grid = -1; return; }
        if (hipFuncSetAttribute((const void*)mk_fwd, hipFuncAttributeMaxDynamicSharedMemorySize, LDS_BYTES) != hipSuccess) { fprintf(stderr, "kernel_launch: hipFuncSetAttribute failed (%d bytes of dynamic LDS); nothing launched\n", LDS_BYTES); grid = -1; return; }
        if (hipOccupancyMaxActiveBlocksPerMultiprocessor(&per_cu, (const void*)mk_fwd, NTHR, LDS_BYTES) != hipSuccess || per_cu < 1) fprintf(stderr, "kernel_launch: note: occupancy query reports %d workgroups per CU\n", per_cu);
        (void)hipGetLastError();
        grid = cus;
        if (grid != 256) { fprintf(stderr, "kernel_launch: %d CUs; this build's unit orders are written for 256 (one workgroup per CU); nothing launched\n", grid); grid = -1; return; }
    }
    if (grid < 0) return;
    if (hipMemsetAsync((char*)d_ws + WS_CTL, 0, CTL_ZERO_BYTES, stream) != hipSuccess) { fprintf(stderr, "kernel_launch: hipMemsetAsync of the control words failed; nothing launched\n"); return; }
    Args a{};
    for (int i = 0; i < 29; ++i) a.in[i] = (const float*)d_in[i];
    a.out = (float*)d_out; a.ws = (unsigned char*)d_ws; a.ph_lo = 0; a.ph_hi = NPH; a.flags = 0; a.li = 0;
    hipLaunchKernelGGL(mk_fwd, dim3(grid), dim3(NTHR), LDS_BYTES, stream, a);
    const hipError_t le = hipPeekAtLastError();
    if (le != hipSuccess) fprintf(stderr, "kernel_launch: launch failed: %s\n", hipGetErrorName(le));
}
```

```cpp
#include <hip/hip_runtime.h>
#include <cstdio>
#include <cstdint>
#include <cmath>
constexpr int T_TOK = 16384, DM = 1024, SEQ = 2048, NB = 8, NIN = 2816, NINP = 5888, DFF = 2816;
constexpr size_t MiB = 1u << 20;
constexpr size_t WS_CTL = 0;
constexpr size_t WS_WIN = 1 * MiB, WS_WMKV = 13 * MiB, WS_WGLU = 15 * MiB, WS_WBR = 16 * MiB, WS_WOUT = 19 * MiB, WS_WGU = 21 * MiB, WS_WD = 32 * MiB;
constexpr size_t WS_WUV = 38 * MiB, WS_BIASL = 38 * MiB + 512 * 1024, WS_RS = 39 * MiB, WS_WI = 37 * MiB + 512 * 1024;
constexpr size_t WS_S5TV = 40 * MiB, WS_S5W = 60 * MiB, WS_KX = 68 * MiB, WS_VX = 70 * MiB, WS_MEMN = 72 * MiB, WS_H = 76 * MiB;
constexpr size_t WS_QD = 108 * MiB, WS_CKV = 140 * MiB, WS_QI = 144 * MiB, WS_KI = 160 * MiB, WS_QX = 162 * MiB, WS_U = 178 * MiB, WS_SLOC = 198 * MiB;
constexpr size_t WS_ODSA = 206 * MiB, WS_OX = 222 * MiB, WS_Y = 238 * MiB, WS_END = 254 * MiB;
constexpr size_t WS_G3 = 108 * MiB, WS_MERGED = WS_H, WS_XN = 108 * MiB, WS_ACT = 140 * MiB;
constexpr size_t WS_OS5 = 0, WS_G = WS_G3;
__device__ __forceinline__ int my_lane_id() { int l; asm volatile("v_mbcnt_lo_u32_b32 %0, -1, 0\n\tv_mbcnt_hi_u32_b32 %0, -1, %0" : "=v"(l)); return l; }
namespace pg8 {
#define PG8_LAS __attribute__((address_space(3)))
typedef unsigned short bf16_t;
typedef short bf16x8 __attribute__((ext_vector_type(8)));
typedef float f32x4 __attribute__((ext_vector_type(4)));
typedef unsigned u32x4 __attribute__((ext_vector_type(4)));
constexpr int BM = 256, BK = 64, HALF = 128, HTB = HALF * BK * 2  , STAGE_BYTES = 8 * HTB, NXCD = 8, WGM = 8;

__host__ __device__ __forceinline__ int lds_byte(int r, int c) { const int st = (r >> 4) * 2 + (c >> 5), rr = r & 15, cc = c & 31, ob = rr * 64 + cc * 2; return st * 1024 + (ob ^ (((ob >> 9) & 1) << 5)); }
__host__ __device__ __forceinline__ void stage_rc(int b, int& R, int& C) { const int st = b / 1024, sb = b % 1024, swz = sb ^ (((sb >> 9) & 1) << 5); R = (st >> 1) * 16 + swz / 64; C = (st & 1) * 32 + (swz % 64) / 2; }
__host__ __device__ __forceinline__ int perm32(int rho) { const int n = rho >> 4, i = rho & 15; return 8 * (i >> 2) + 4 * n + (i & 3); }

struct Unit { int pm, pn, z; };
struct Gemm { const bf16_t* A; const bf16_t* Bt; int M, N, K, lda, ldb; };

struct StaticOrder {
    int nM, nN, nwg, G, c;
    __host__ __device__ void init(int M, int N, int G_, int c_) { nM = M / BM; nN = N / BM; nwg = nM * nN; G = G_; c = c_; }
    __host__ __device__ bool next(int i, Unit& u) const {
        const long L = (long)i * G + c; if (L >= nwg) return false;
        int wgid = (int)L; { const int q = nwg / NXCD, r = nwg % NXCD, xcd = wgid % NXCD, off = wgid / NXCD; wgid = (xcd < r ? xcd * (q + 1) : r * (q + 1) + (xcd - r) * q) + off; }
        const int nig = WGM * nN, gid = wgid / nig, fm = gid * WGM, gsz = (nM - fm) < WGM ? (nM - fm) : WGM;
        u.pm = fm + ((wgid % nig) % gsz); u.pn = (wgid % nig) / gsz; u.z = 0; return true;
    }
    __device__ __forceinline__ void a_ready(const Unit&) const {}
    __device__ __forceinline__ void done(const Unit&) const {}
    __device__ __forceinline__ long a_off(const Unit&) const { return 0; }
    __device__ __forceinline__ long b_off(const Unit&) const { return 0; }
};

typedef float f32x2_c __attribute__((ext_vector_type(2))); typedef __bf16 bf16x2_c __attribute__((ext_vector_type(2)));
__device__ __forceinline__ unsigned cvt_pk_bf16(float lo, float hi) { const f32x2_c v = {lo, hi}; const bf16x2_c b = __builtin_convertvector(v, bf16x2_c); return __builtin_bit_cast(unsigned, b); }
typedef float f32x2 __attribute__((ext_vector_type(2)));
template <class Epi, class Sched, bool ALIGN_EPI = false, bool SP2 = false>
__device__ __forceinline__ void gemm_phase(PG8_LAS unsigned char* lds, const Gemm g, const Sched& S, const Epi& E, const int wid) {
    const int lane = my_lane_id(), tid = wid * 64 + lane, wr = wid >> 2, wc = wid & 3, fr = lane & 15, fq = lane >> 4;
    const int K = g.K, nt = K / BK, lda = g.lda, ldb = g.ldb;
    unsigned voffA[2], voffB[2];
#pragma unroll
    for (int i = 0; i < 2; ++i) { int R, C; stage_rc(tid * 16 + i * 8192, R, C); const int Rb = Epi::PERM ? ((R & ~31) + perm32(R & 31)) : R;
        voffA[i] = (unsigned)(R * lda + C) * 2u; voffB[i] = (unsigned)(Rb * ldb + C) * 2u; }
    const size_t kstep = (size_t)(BK * 2);
    const size_t hstepA = (size_t)HALF * lda * 2, hstepB = (size_t)HALF * ldb * 2;
    const size_t tstepA = 2 * hstepA, tstepB = 2 * hstepB;
    const unsigned ldsw = (unsigned)wid * 1024u;
    const int aoff = lds_byte(wr * 64 + fr, fq * 8), boff = lds_byte(wc * 32 + fr, fq * 8);
#define PG8_SA(b, h) (((b) * 2 + (h)) * HTB)
#define PG8_SB(b, h) ((4 + (b) * 2 + (h)) * HTB)
#define PG8_STAGE(bufoff, gbase, voff) do { _Pragma("unroll") for (int _i = 0; _i < 2; ++_i) \
        __builtin_amdgcn_global_load_lds((const unsigned*)((const char*)(gbase) + (voff)[_i]), (PG8_LAS unsigned*)(lds + (bufoff) + ldsw + _i * 8192), 16, 0, 0); } while (0)
#define PG8_LDA(dst, b, h) do { _Pragma("unroll") for (int m = 0; m < 4; ++m) _Pragma("unroll") for (int k = 0; k < 2; ++k) dst[m][k] = *(const PG8_LAS bf16x8*)(lds + PG8_SA(b, h) + aoff + m * 2048 + k * 1024); } while (0)
#define PG8_LDB(dst, b, h) do { _Pragma("unroll") for (int n = 0; n < 2; ++n) _Pragma("unroll") for (int k = 0; k < 2; ++k) dst[n][k] = *(const PG8_LAS bf16x8*)(lds + PG8_SB(b, h) + boff + n * 2048 + k * 1024); } while (0)
#define PG8_MMA(ai, bj, At, Bt) do { __builtin_amdgcn_s_setprio(1); _Pragma("unroll") for (int m = 0; m < 4; ++m) _Pragma("unroll") for (int n = 0; n < 2; ++n) _Pragma("unroll") for (int k = 0; k < 2; ++k) \
        acc[ai][bj][m][n] = __builtin_amdgcn_mfma_f32_16x16x32_bf16(Bt[n][k], At[m][k], acc[ai][bj][m][n], 0, 0, 0); __builtin_amdgcn_s_setprio(0); } while (0)
#define PG8_WAIT_V(n) asm volatile("s_waitcnt vmcnt(" #n ")" ::: "memory")
#define PG8_WAIT_L(n) asm volatile("s_waitcnt lgkmcnt(" #n ")" ::: "memory")
#define PG8_BAR __builtin_amdgcn_s_barrier()
#define PG8_SCHED __builtin_amdgcn_sched_barrier(0)
    Unit cur, nxt; int ui = 0;
    if (!S.next(0, cur)) return;
    f32x4 acc[2][2][4][2];
#pragma unroll
    for (int a = 0; a < 2; ++a)
#pragma unroll
        for (int b = 0; b < 2; ++b)
#pragma unroll
            for (int m = 0; m < 4; ++m)
#pragma unroll
                for (int n = 0; n < 2; ++n) acc[a][b][m][n] = (f32x4){0.f, 0.f, 0.f, 0.f};
    bf16x8 At[4][2], B0[2][2], B1[2][2];
    const char* cA = (const char*)g.A + (size_t)cur.pm * tstepA + S.a_off(cur); const char* cB = (const char*)g.Bt + (size_t)cur.pn * tstepB + S.b_off(cur);
    S.a_ready(cur);
    if constexpr (SP2) {
        PG8_STAGE(PG8_SB(0, 0), cB, voffB); PG8_STAGE(PG8_SB(0, 1), cB + hstepB, voffB); PG8_STAGE(PG8_SA(0, 0), cA, voffA); PG8_STAGE(PG8_SA(0, 1), cA + hstepA, voffA);
        if (wr == 1) PG8_BAR;
        PG8_WAIT_V(2); PG8_BAR;
        PG8_STAGE(PG8_SB(1, 0), cB + kstep, voffB); PG8_STAGE(PG8_SA(1, 0), cA + kstep, voffA); PG8_STAGE(PG8_SB(1, 1), cB + hstepB + kstep, voffB);
        PG8_WAIT_V(6); PG8_BAR;
    } else {
        PG8_STAGE(PG8_SB(0, 0), cB, voffB); PG8_STAGE(PG8_SA(0, 0), cA, voffA); PG8_STAGE(PG8_SB(0, 1), cB + hstepB, voffB); PG8_STAGE(PG8_SA(0, 1), cA + hstepA, voffA);
        if (wr == 1) PG8_BAR;
        PG8_WAIT_V(4); PG8_BAR;
        PG8_STAGE(PG8_SB(1, 0), cB + kstep, voffB); PG8_STAGE(PG8_SA(1, 0), cA + kstep, voffA); PG8_STAGE(PG8_SB(1, 1), cB + hstepB + kstep, voffB);
        PG8_WAIT_V(6); PG8_BAR;
    }
    for (;;) {
        const bool has_next = S.next(ui + 1, nxt);
        const char* nA = has_next ? (const char*)g.A + (size_t)nxt.pm * tstepA + S.a_off(nxt) : cA; const char* nB = has_next ? (const char*)g.Bt + (size_t)nxt.pn * tstepB + S.b_off(nxt) : cB;
        for (int t = 0; t < nt; t += 2) {
            const bool last = (t == nt - 2);
            const char* a1 = cA + (size_t)(t + 1) * kstep;
            const char* a2 = last ? nA : cA + (size_t)(t + 2) * kstep; const char* b2 = last ? nB : cB + (size_t)(t + 2) * kstep;
            const char* a3 = a2 + kstep; const char* b3 = b2 + kstep;
            if (last && has_next) S.a_ready(nxt);
            if constexpr (SP2) {
            PG8_LDB(B0, 0, 0); PG8_LDB(B1, 0, 1); PG8_SCHED; PG8_LDA(At, 0, 0); PG8_STAGE(PG8_SA(1, 1), a1 + hstepA, voffA);
            PG8_WAIT_V(8); PG8_WAIT_L(0); PG8_BAR; PG8_MMA(0, 0, At, B0); PG8_MMA(0, 1, At, B1); PG8_BAR; PG8_SCHED;
            PG8_LDA(At, 0, 1); PG8_STAGE(PG8_SB(0, 0), b2, voffB); PG8_STAGE(PG8_SB(0, 1), b2 + hstepB, voffB); PG8_STAGE(PG8_SA(0, 0), a2, voffA);
            PG8_WAIT_V(8); PG8_WAIT_L(0); PG8_BAR; PG8_MMA(1, 0, At, B0); PG8_MMA(1, 1, At, B1); PG8_BAR; PG8_SCHED;
            PG8_LDB(B0, 1, 0); PG8_LDB(B1, 1, 1); PG8_SCHED; PG8_LDA(At, 1, 0); PG8_STAGE(PG8_SA(0, 1), a2 + hstepA, voffA);
            PG8_WAIT_V(8); PG8_WAIT_L(0); PG8_BAR; PG8_MMA(0, 0, At, B0); PG8_MMA(0, 1, At, B1); PG8_BAR; PG8_SCHED;
            PG8_LDA(At, 1, 1); PG8_STAGE(PG8_SB(1, 0), b3, voffB); PG8_STAGE(PG8_SB(1, 1), b3 + hstepB, voffB); PG8_STAGE(PG8_SA(1, 0), a3, voffA);
            PG8_WAIT_V(8); PG8_WAIT_L(0); PG8_BAR; PG8_MMA(1, 0, At, B0); PG8_MMA(1, 1, At, B1); PG8_BAR; PG8_SCHED;
            } else {
            PG8_LDB(B0, 0, 0); PG8_SCHED; PG8_LDA(At, 0, 0); PG8_STAGE(PG8_SA(1, 1), a1 + hstepA, voffA);
            PG8_WAIT_L(8); PG8_BAR; PG8_WAIT_L(0); PG8_MMA(0, 0, At, B0); PG8_BAR; PG8_SCHED;
            PG8_LDB(B1, 0, 1); PG8_STAGE(PG8_SB(0, 0), b2, voffB);
            PG8_BAR; PG8_WAIT_L(0); PG8_MMA(0, 1, At, B1); PG8_BAR;
            PG8_LDA(At, 0, 1); PG8_STAGE(PG8_SA(0, 0), a2, voffA);
            PG8_BAR; PG8_WAIT_L(0); PG8_MMA(1, 0, At, B0); PG8_BAR; PG8_SCHED;
            PG8_STAGE(PG8_SB(0, 1), b2 + hstepB, voffB);
            PG8_WAIT_V(6); PG8_BAR; PG8_MMA(1, 1, At, B1); PG8_BAR;
            PG8_LDB(B0, 1, 0); PG8_SCHED; PG8_LDA(At, 1, 0); PG8_STAGE(PG8_SA(0, 1), a2 + hstepA, voffA);
            PG8_WAIT_L(8); PG8_BAR; PG8_WAIT_L(0); PG8_MMA(0, 0, At, B0); PG8_BAR; PG8_SCHED;
            PG8_LDB(B1, 1, 1); PG8_STAGE(PG8_SB(1, 0), b3, voffB);
            PG8_BAR; PG8_WAIT_L(0); PG8_MMA(0, 1, At, B1); PG8_BAR;
            PG8_LDA(At, 1, 1); PG8_STAGE(PG8_SA(1, 0), a3, voffA);
            PG8_BAR; PG8_WAIT_L(0); PG8_MMA(1, 0, At, B0); PG8_BAR; PG8_SCHED;
            PG8_STAGE(PG8_SB(1, 1), b3 + hstepB, voffB);
            PG8_WAIT_V(6); PG8_BAR; PG8_MMA(1, 1, At, B1); PG8_BAR;
            }
        }
        if constexpr (ALIGN_EPI) { if (wr == 0) PG8_BAR; }
        if constexpr (!Epi::AFTER_DRAIN) { E(acc, cur, wr, wc, fr, fq); S.done(cur); }
        if (!has_next) break;
#pragma unroll
        for (int a = 0; a < 2; ++a)
#pragma unroll
            for (int b = 0; b < 2; ++b)
#pragma unroll
                for (int m = 0; m < 4; ++m)
#pragma unroll
                    for (int n = 0; n < 2; ++n) acc[a][b][m][n] = (f32x4){0.f, 0.f, 0.f, 0.f};
        cur = nxt; cA = nA; cB = nB; ++ui;
        if constexpr (ALIGN_EPI) { if (wr == 1) PG8_BAR; }
    }
    PG8_WAIT_V(0);
    if constexpr (!ALIGN_EPI) { if (wr == 0) PG8_BAR; }
    PG8_BAR;
    if constexpr (Epi::AFTER_DRAIN) { E.fused(acc, cur, wr, wc, fr, fq, lds, wid, lane); S.done(cur); }
#undef PG8_SA
#undef PG8_SB
#undef PG8_STAGE
#undef PG8_LDA
#undef PG8_LDB
#undef PG8_MMA
#undef PG8_WAIT_V
#undef PG8_WAIT_L
#undef PG8_BAR
#undef PG8_SCHED
}
}
namespace pg8 {
typedef unsigned u32x2 __attribute__((ext_vector_type(2)));
__device__ __forceinline__ u32x4 pack8(const f32x4 a, const f32x4 b) { u32x4 w; w.x = cvt_pk_bf16(a[0], a[1]); w.y = cvt_pk_bf16(a[2], a[3]); w.z = cvt_pk_bf16(b[0], b[1]); w.w = cvt_pk_bf16(b[2], b[3]); return w; }
__device__ __forceinline__ void unpack8(const u32x4 w, f32x4& a, f32x4& b) {
    a[0] = __uint_as_float(w.x << 16); a[1] = __uint_as_float(w.x & 0xffff0000u); a[2] = __uint_as_float(w.y << 16); a[3] = __uint_as_float(w.y & 0xffff0000u);
    b[0] = __uint_as_float(w.z << 16); b[1] = __uint_as_float(w.z & 0xffff0000u); b[2] = __uint_as_float(w.w << 16); b[3] = __uint_as_float(w.w & 0xffff0000u); }
__device__ __forceinline__ float sigm(float v) { return __builtin_amdgcn_rcpf(1.f + __expf(-v)); }
__device__ __forceinline__ f32x4 sigm4(const f32x4 v) { f32x4 r; r[0] = sigm(v[0]); r[1] = sigm(v[1]); r[2] = sigm(v[2]); r[3] = sigm(v[3]); return r; }

__device__ __forceinline__ void norm128_stats(const f32x4 (&acc)[2][2][4][2], PG8_LAS float* XB, int wr, int wc, int fr, int fq, float (&rs)[2][2][4]) {
#pragma unroll
    for (int bj = 0; bj < 2; ++bj)
#pragma unroll
        for (int ai = 0; ai < 2; ++ai)
#pragma unroll
            for (int m = 0; m < 4; ++m) { const f32x4 a = acc[ai][bj][m][0], b = acc[ai][bj][m][1];
                float ss = ((a[0] * a[0] + a[1] * a[1]) + (a[2] * a[2] + a[3] * a[3])) + ((b[0] * b[0] + b[1] * b[1]) + (b[2] * b[2] + b[3] * b[3]));
                ss += __shfl_xor(ss, 16); ss += __shfl_xor(ss, 32);
                if (fq == 0) XB[(bj * 256 + ai * HALF + wr * 64 + m * 16 + fr) * 4 + wc] = ss; }
    asm volatile("s_waitcnt lgkmcnt(0)" ::: "memory"); __builtin_amdgcn_s_barrier(); asm volatile("" ::: "memory");
#pragma unroll
    for (int bj = 0; bj < 2; ++bj)
#pragma unroll
        for (int ai = 0; ai < 2; ++ai)
#pragma unroll
            for (int m = 0; m < 4; ++m) { const f32x4 p = *(const PG8_LAS f32x4*)(XB + (bj * 256 + ai * HALF + wr * 64 + m * 16 + fr) * 4);
                rs[bj][ai][m] = __builtin_amdgcn_rsqf(((p[0] + p[1]) + (p[2] + p[3])) * (1.f / 128.f) + 1e-6f); }
}
struct EpiInprojF {
    static constexpr bool PERM = true, AFTER_DRAIN = false;
    bf16_t *QD, *CKV, *QI, *KI, *U, *QX; float* WI; const float *gq, *gkv, *gqx; PG8_LAS float* XB;
    __device__ __forceinline__ void operator()(const f32x4 (&acc)[2][2][4][2], const Unit& u, int wr, int wc, int fr, int fq) const {
        const int row0 = u.pm * BM + wr * 64 + fr, cb = u.pn * BM;
        const bool nrm0 = cb < 1152 || cb >= 2304, nrm1 = cb + HALF < 1024 || cb + HALF >= 2304;
        float rs[2][2][4];
        if (nrm0 || nrm1) norm128_stats(acc, XB, wr, wc, fr, fq, rs);
#pragma unroll
        for (int bj = 0; bj < 2; ++bj) {
            const int c0 = cb + bj * HALF + wc * 32 + 8 * fq; const bool nrm = bj == 0 ? nrm0 : nrm1;
            bf16_t* base = QD; int ld = 1024, cc = c0, kind = 0; const float* gp = gq + (c0 & 127);
            if (c0 < 1024) { }
            else if (c0 < 1152) { base = CKV; ld = 128; cc = c0 - 1024; gp = gkv + cc; }
            else if (c0 < 1664) { base = QI; ld = 512; cc = c0 - 1152; }
            else if (c0 < 1728) { base = KI; ld = 64; cc = c0 - 1664; }
            else if (c0 < 1792) { kind = 1; }
            else if (c0 < 2304) { kind = 2; cc = c0 - 1792; }
            else { base = QX; ld = 512; cc = c0 - 2304; gp = gqx + (cc & 127); }
            f32x4 g0 = {1.f, 1.f, 1.f, 1.f}, g1 = g0;
            if (nrm) { g0 = *(const f32x4*)gp; g1 = *(const f32x4*)(gp + 4); }
#pragma unroll
            for (int ai = 0; ai < 2; ++ai)
#pragma unroll
                for (int m = 0; m < 4; ++m) {
                    const int t = row0 + ai * HALF + m * 16;
                    if (kind == 0) { f32x4 v0 = acc[ai][bj][m][0], v1 = acc[ai][bj][m][1]; if (nrm) { const float r = rs[bj][ai][m]; v0 = v0 * r * g0; v1 = v1 * r * g1; }
                        *(u32x4*)(base + (size_t)t * ld + cc) = pack8(v0, v1); }
                    else if (kind == 1) { if (c0 == 1728) { *(f32x4*)(WI + (size_t)t * 8) = acc[ai][bj][m][0]; *(f32x4*)(WI + (size_t)t * 8 + 4) = acc[ai][bj][m][1]; } }
                    else { const int g = cc >> 4, ci = cc & 15, b = t >> 11, tt = t & 2047, R = b * 64 + (tt >> 5), s = tt & 31;
                        *(u32x4*)(U + ((size_t)(g * 512 + R)) * 640 + s * 16 + ci) = pack8(acc[ai][bj][m][0], acc[ai][bj][m][1]); }
                }
        }
    }
};
struct EpiMemKVF {
    static constexpr bool PERM = true, AFTER_DRAIN = false;
    bf16_t* KX; bf16_t* VX; const float* gk; PG8_LAS float* XB;
    __device__ __forceinline__ void operator()(const f32x4 (&acc)[2][2][4][2], const Unit& u, int wr, int wc, int fr, int fq) const {
        const int row0 = u.pm * BM + wr * 64 + fr, cb = u.pn * BM; const bool nrm = cb < 512;
        float rs[2][2][4];
        if (nrm) norm128_stats(acc, XB, wr, wc, fr, fq, rs);
#pragma unroll
        for (int bj = 0; bj < 2; ++bj) {
            const int c0 = cb + bj * HALF + wc * 32 + 8 * fq;
            bf16_t* base = nrm ? KX : VX; const int cc = nrm ? c0 : c0 - 512;
            f32x4 g0 = {1.f, 1.f, 1.f, 1.f}, g1 = g0;
            if (nrm) { g0 = *(const f32x4*)(gk + (c0 & 127)); g1 = *(const f32x4*)(gk + (c0 & 127) + 4); }
#pragma unroll
            for (int ai = 0; ai < 2; ++ai)
#pragma unroll
                for (int m = 0; m < 4; ++m) { f32x4 v0 = acc[ai][bj][m][0], v1 = acc[ai][bj][m][1]; if (nrm) { const float r = rs[bj][ai][m]; v0 = v0 * r * g0; v1 = v1 * r * g1; }
                    *(u32x4*)(base + (size_t)(row0 + ai * HALF + m * 16) * 512 + cc) = pack8(v0, v1); }
        }
    }
};
struct EpiGluF {
    static constexpr bool PERM = true, AFTER_DRAIN = false;
    const bf16_t* Y; bf16_t* O;
    __device__ __forceinline__ void operator()(const f32x4 (&acc)[2][2][4][2], const Unit& u, int wr, int wc, int fr, int fq) const {
        const int row0 = u.pm * BM + wr * 64 + fr, c0 = u.pn * BM + wc * 32 + 8 * fq;
#pragma unroll
        for (int ai = 0; ai < 2; ++ai) {
            u32x4 yv[4][2];
#pragma unroll
            for (int m = 0; m < 4; ++m)
#pragma unroll
                for (int bj = 0; bj < 2; ++bj) yv[m][bj] = *(const u32x4*)(Y + (size_t)(row0 + ai * HALF + m * 16) * 512 + c0 + bj * HALF);
            asm volatile("" ::: "memory");
#pragma unroll
            for (int m = 0; m < 4; ++m)
#pragma unroll
                for (int bj = 0; bj < 2; ++bj) { f32x4 y0, y1; unpack8(yv[m][bj], y0, y1);
                    *(u32x4*)(O + (size_t)(row0 + ai * HALF + m * 16) * 512 + c0 + bj * HALF) = pack8(y0 * sigm4(acc[ai][bj][m][0]), y1 * sigm4(acc[ai][bj][m][1])); }
        }
    }
};
struct EpiSigmoidF {
    static constexpr bool PERM = true, AFTER_DRAIN = false;
    bf16_t* G; int ld;
    __device__ __forceinline__ void operator()(const f32x4 (&acc)[2][2][4][2], const Unit& u, int wr, int wc, int fr, int fq) const {
        const int row0 = u.pm * BM + wr * 64 + fr;
#pragma unroll
        for (int bj = 0; bj < 2; ++bj) {
            const int c0 = u.pn * BM + bj * HALF + wc * 32 + 8 * fq;
#pragma unroll
            for (int ai = 0; ai < 2; ++ai)
#pragma unroll
                for (int m = 0; m < 4; ++m) *(u32x4*)(G + (size_t)(row0 + ai * HALF + m * 16) * ld + c0) = pack8(sigm4(acc[ai][bj][m][0]), sigm4(acc[ai][bj][m][1]));
        }
    }
};
struct EpiMergeF {
    static constexpr bool PERM = true, AFTER_DRAIN = false;
    const bf16_t* G3; bf16_t* MG;
    __device__ __forceinline__ void operator()(const f32x4 (&acc)[2][2][4][2], const Unit& u, int wr, int wc, int fr, int fq) const {
        const int row0 = u.pm * BM + wr * 64 + fr, c0 = u.pn * BM + wc * 32 + 8 * fq; const bool first = u.z == 0;
#pragma unroll
        for (int ai = 0; ai < 2; ++ai) {
            u32x4 gv[4][2], pv[4][2];
#pragma unroll
            for (int m = 0; m < 4; ++m)
#pragma unroll
                for (int bj = 0; bj < 2; ++bj) { const size_t t = (size_t)(row0 + ai * HALF + m * 16);
                    gv[m][bj] = *(const u32x4*)(G3 + t * 3072 + u.z * 1024 + c0 + bj * HALF);
                    pv[m][bj] = first ? (u32x4){0u, 0u, 0u, 0u} : *(const u32x4*)(MG + t * 1024 + c0 + bj * HALF); }
            asm volatile("" ::: "memory");
#pragma unroll
            for (int m = 0; m < 4; ++m)
#pragma unroll
                for (int bj = 0; bj < 2; ++bj) { const size_t t = (size_t)(row0 + ai * HALF + m * 16);
                    f32x4 g0, g1, p0, p1; unpack8(gv[m][bj], g0, g1); unpack8(pv[m][bj], p0, p1);
                    *(u32x4*)(MG + t * 1024 + c0 + bj * HALF) = pack8(p0 + g0 * acc[ai][bj][m][0], p1 + g1 * acc[ai][bj][m][1]); }
        }
    }
};
struct EpiOutF {
    static constexpr bool PERM = false, AFTER_DRAIN = false;
    const float* x; float* out; bf16_t* XN; float* RS;
    __device__ __forceinline__ void operator()(const f32x4 (&acc)[2][2][4][2], const Unit& u, int wr, int wc, int fr, int fq) const {
        const int row0 = u.pm * BM + wr * 64 + fr, col0 = u.pn * BM + wc * 32 + 4 * fq;
#pragma unroll
        for (int ai = 0; ai < 2; ++ai) {
            f32x4 xv[4][2][2];
#pragma unroll
            for (int m = 0; m < 4; ++m)
#pragma unroll
                for (int bj = 0; bj < 2; ++bj)
#pragma unroll
                    for (int n = 0; n < 2; ++n) xv[m][bj][n] = *(const f32x4*)(x + (size_t)(row0 + ai * HALF + m * 16) * 1024 + col0 + bj * HALF + n * 16);
            asm volatile("" ::: "memory");
#pragma unroll
            for (int m = 0; m < 4; ++m) { const int t = row0 + ai * HALF + m * 16; const size_t off = (size_t)t * 1024 + col0; float ss = 0.f;
#pragma unroll
                for (int bj = 0; bj < 2; ++bj)
#pragma unroll
                    for (int n = 0; n < 2; ++n) { const size_t o2 = off + bj * HALF + n * 16; const f32x4 r = xv[m][bj][n] + acc[ai][bj][m][n];
                        u32x2 w; w.x = cvt_pk_bf16(r[0], r[1]); w.y = cvt_pk_bf16(r[2], r[3]); *(u32x2*)(XN + o2) = w;
                        ss += (r[0] * r[0] + r[1] * r[1]) + (r[2] * r[2] + r[3] * r[3]); }
                ss += __shfl_xor(ss, 16); ss += __shfl_xor(ss, 32);
                if (fq == 0) RS[(size_t)t * 16 + u.pn * 4 + wc] = ss; }
        }
    }
};
struct EpiGateUpF {
    static constexpr bool PERM = true, AFTER_DRAIN = false;
    const float* RS; bf16_t* ACT;
    __device__ __forceinline__ void operator()(const f32x4 (&acc)[2][2][4][2], const Unit& u, int wr, int wc, int fr, int fq) const {
        const int row0 = u.pm * BM + wr * 64 + fr, f0 = u.pn * HALF + wc * 32 + 8 * fq;
        f32x4 pr[2][4];
#pragma unroll
        for (int ai = 0; ai < 2; ++ai)
#pragma unroll
            for (int m = 0; m < 4; ++m) pr[ai][m] = *(const f32x4*)(RS + (size_t)(row0 + ai * HALF + m * 16) * 16 + 4 * fq);
        asm volatile("" ::: "memory");
#pragma unroll
        for (int ai = 0; ai < 2; ++ai)
#pragma unroll
            for (int m = 0; m < 4; ++m) { const int t = row0 + ai * HALF + m * 16;
                float tot = (pr[ai][m][0] + pr[ai][m][1]) + (pr[ai][m][2] + pr[ai][m][3]); tot += __shfl_xor(tot, 16); tot += __shfl_xor(tot, 32);
                const float rs = __builtin_amdgcn_rsqf(tot * (1.f / 1024.f) + 1e-6f);
                f32x4 o[2];
#pragma unroll
                for (int n = 0; n < 2; ++n) { const f32x4 g = acc[ai][0][m][n] * rs, up = acc[ai][1][m][n] * rs; o[n] = g * sigm4(g) * up; }
                *(u32x4*)(ACT + (size_t)t * 2816 + f0) = pack8(o[0], o[1]); }
    }
};
struct EpiDownF {
    static constexpr bool PERM = false, AFTER_DRAIN = false;
    const bf16_t* XN; float* out;
    __device__ __forceinline__ void operator()(const f32x4 (&acc)[2][2][4][2], const Unit& u, int wr, int wc, int fr, int fq) const {
        const int row0 = u.pm * BM + wr * 64 + fr, col0 = u.pn * BM + wc * 32 + 4 * fq;
#pragma unroll
        for (int ai = 0; ai < 2; ++ai) {
            u32x2 xv[4][2][2];
#pragma unroll
            for (int m = 0; m < 4; ++m)
#pragma unroll
                for (int bj = 0; bj < 2; ++bj)
#pragma unroll
                    for (int n = 0; n < 2; ++n) xv[m][bj][n] = *(const u32x2*)(XN + (size_t)(row0 + ai * HALF + m * 16) * 1024 + col0 + bj * HALF + n * 16);
            asm volatile("" ::: "memory");
#pragma unroll
            for (int m = 0; m < 4; ++m)
#pragma unroll
                for (int bj = 0; bj < 2; ++bj)
#pragma unroll
                    for (int n = 0; n < 2; ++n) { const u32x2 w = xv[m][bj][n];
                        const f32x4 x1 = {__uint_as_float(w.x << 16), __uint_as_float(w.x & 0xffff0000u), __uint_as_float(w.y << 16), __uint_as_float(w.y & 0xffff0000u)};
                        *(f32x4*)(out + (size_t)(row0 + ai * HALF + m * 16) * 1024 + col0 + bj * HALF + n * 16) = x1 + acc[ai][bj][m][n]; }
        }
    }
};
struct EpiSlocF {
    static constexpr bool PERM = false, AFTER_DRAIN = false;
    float* SLOC;
    __device__ __forceinline__ void operator()(const f32x4 (&acc)[2][2][4][2], const Unit& u, int wr, int wc, int fr, int fq) const {
        const int row0 = u.pm * BM + wr * 64 + fr, col0 = wc * 32 + 4 * fq;
#pragma unroll
        for (int ai = 0; ai < 2; ++ai)
#pragma unroll
            for (int m = 0; m < 4; ++m)
#pragma unroll
                for (int n = 0; n < 2; ++n) *(f32x4*)(SLOC + (size_t)(row0 + ai * HALF + m * 16) * 128 + col0 + n * 16) = acc[ai][0][m][n];
    }
};
__device__ __forceinline__ float gelu_t(float x) { const float w = 1.5957691216057308f * (x + 0.044715f * x * x * x); return x * __builtin_amdgcn_rcpf(1.f + __expf(-w)); }
struct EpiS5YF {
    static constexpr bool PERM = true, AFTER_DRAIN = false;
    const bf16_t* U; const float* dskip; bf16_t* Y;
    __device__ __forceinline__ void operator()(const f32x4 (&acc)[2][2][4][2], const Unit& u, int wr, int wc, int fr, int fq) const {
        const int row0 = u.pm * BM + wr * 64 + fr, g = (u.pm * BM) >> 9;
        f32x4 dk[2][2];
#pragma unroll
        for (int bj = 0; bj < 2; ++bj) { const int co0 = ((u.pn & 1) * BM + bj * HALF + wc * 32 + 8 * fq) & 15; dk[bj][0] = *(const f32x4*)(dskip + g * 16 + co0); dk[bj][1] = *(const f32x4*)(dskip + g * 16 + co0 + 4); }
#pragma unroll
        for (int ai = 0; ai < 2; ++ai) {
            u32x4 uv[4][2];
#pragma unroll
            for (int m = 0; m < 4; ++m)
#pragma unroll
                for (int bj = 0; bj < 2; ++bj) { const int cl = (u.pn & 1) * BM + bj * HALF + wc * 32 + 8 * fq; uv[m][bj] = *(const u32x4*)(U + (size_t)(row0 + ai * HALF + m * 16) * 640 + cl); }
            asm volatile("" ::: "memory");
#pragma unroll
            for (int m = 0; m < 4; ++m)
#pragma unroll
                for (int bj = 0; bj < 2; ++bj) { const int cl = (u.pn & 1) * BM + bj * HALF + wc * 32 + 8 * fq, s = cl >> 4, co0 = cl & 15;
                    const int row = row0 + ai * HALF + m * 16, R = row & 511, b = R >> 6, ch = R & 63, t = b * 2048 + ch * 32 + s;
                    f32x4 u0, u1; unpack8(uv[m][bj], u0, u1);
                    f32x4 y0 = acc[ai][bj][m][0] + dk[bj][0] * u0, y1 = acc[ai][bj][m][1] + dk[bj][1] * u1;
#pragma unroll
                    for (int e2 = 0; e2 < 4; ++e2) { y0[e2] = gelu_t(y0[e2]); y1[e2] = gelu_t(y1[e2]); }
                    *(u32x4*)(Y + (size_t)t * 512 + g * 16 + co0) = pack8(y0, y1); }
        }
    }
};
struct SubsetOrder { StaticOrder so; bool active;
    __device__ void init(int M, int N, int Gsub, int csub) { so.init(M, N, Gsub, csub < 0 ? 0 : csub); active = csub >= 0 && csub < Gsub; }
    __device__ bool next(int i, Unit& u) const { return active && so.next(i, u); }
    __device__ __forceinline__ void a_ready(const Unit&) const {}
    __device__ __forceinline__ void done(const Unit&) const {}
    __device__ __forceinline__ long a_off(const Unit&) const { return 0; }
    __device__ __forceinline__ long b_off(const Unit&) const { return 0; } };
struct S5Order1 { int c;
    __device__ bool next(int i, Unit& u) const { if (i > 0 || c < 0 || c >= 64) return false; u.pm = c; u.pn = c >> 1; u.z = 0; return true; }
    __device__ __forceinline__ void a_ready(const Unit&) const {}
    __device__ __forceinline__ void done(const Unit&) const {}
    __device__ __forceinline__ long a_off(const Unit&) const { return 0; }
    __device__ __forceinline__ long b_off(const Unit&) const { return 0; } };
struct S5Order2 { int c;
    __device__ bool next(int i, Unit& u) const { if (i > 0 || c < 0 || c >= 128) return false; const int g = c >> 2; u.pm = g * 2 + ((c >> 1) & 1); u.pn = g * 2 + (c & 1); u.z = 0; return true; }
    __device__ __forceinline__ void a_ready(const Unit&) const {}
    __device__ __forceinline__ void done(const Unit&) const {}
    __device__ __forceinline__ long a_off(const Unit&) const { return 0; }
    __device__ __forceinline__ long b_off(const Unit&) const { return 0; } };
struct GateOrder { int c;
    __device__ bool next(int i, Unit& u) const { int id; if (c < 128) { if (i >= 2) return false; id = c * 2 + i; } else { if (i >= 4) return false; id = 256 + (c - 128) * 4 + i; } u.pm = id / 12; u.pn = id % 12; u.z = 0; return true; }
    __device__ __forceinline__ void a_ready(const Unit&) const {}
    __device__ __forceinline__ void done(const Unit&) const {}
    __device__ __forceinline__ long a_off(const Unit&) const { return 0; }
    __device__ __forceinline__ long b_off(const Unit&) const { return 0; } };
struct MergeOrder { StaticOrder so; long aoff[3];
    __device__ bool next(int i, Unit& u) const { if (i >= 3) return false; if (!so.next(0, u)) return false; u.z = i; return true; }
    __device__ __forceinline__ void a_ready(const Unit&) const {}
    __device__ __forceinline__ void done(const Unit&) const {}
    __device__ __forceinline__ long a_off(const Unit& u) const { return u.z == 0 ? aoff[0] : (u.z == 1 ? aoff[1] : aoff[2]); }
    __device__ __forceinline__ long b_off(const Unit& u) const { return (long)u.z * 1024 * 512 * 2; } };
}
#define GAS __attribute__((address_space(1)))
#define LAS __attribute__((address_space(3)))
typedef unsigned short bf16;
typedef unsigned v4u __attribute__((ext_vector_type(4)));
typedef float f32x4 __attribute__((ext_vector_type(4)));
typedef short bf16x8 __attribute__((ext_vector_type(8)));
typedef GAS unsigned gu32;
typedef GAS unsigned long long gu64;
#define RLX_AGENT __ATOMIC_RELAXED, __HIP_MEMORY_SCOPE_AGENT
#define LDS_WAIT() asm volatile("s_waitcnt lgkmcnt(0)" ::: "memory")
#define VM_WAIT() asm volatile("s_waitcnt vmcnt(0)" ::: "memory")
__device__ __forceinline__ unsigned long long rt() { return __builtin_amdgcn_s_memrealtime(); }
__device__ __forceinline__ unsigned f2bf(float f) { unsigned u = __builtin_bit_cast(unsigned, f); return (u + 0x7fffu + ((u >> 16) & 1u)) >> 16; }
__device__ __forceinline__ unsigned pk2(float lo, float hi) { return f2bf(lo) | (f2bf(hi) << 16); }

#define XB_TMO      128
#define XB_XCNT(j)  (256  + 64 * (j))
#define XB_XSUB(j)  (1280 + 64 * (j))
#define XB_XGEN(j)  (2304 + 64 * (j))
#define XB_TOP      3328
#define XB_TOPGEN   3392
#define XCD_BAR_WORDS 3456
#define XB_SPIN_CAP (1u << 18)

__device__ __forceinline__ unsigned xb_ld(unsigned* p)              { return __hip_atomic_load(p, __ATOMIC_RELAXED, __HIP_MEMORY_SCOPE_AGENT); }
__device__ __forceinline__ unsigned xb_add(unsigned* p, unsigned v) { return __hip_atomic_fetch_add(p, v, __ATOMIC_RELAXED, __HIP_MEMORY_SCOPE_AGENT); }
__device__ __forceinline__ unsigned xb_xcc_id() { return (unsigned)__builtin_amdgcn_s_getreg((3 << 11) | 20) & 0xFu; }
#define XB_SPIN(cond, bar) do { unsigned _sp = 0; while (cond) { __builtin_amdgcn_s_sleep(1); \
    if ((++_sp & 255u) == 0u) { if (xb_ld(&(bar)[XB_TMO])) break; if (_sp > XB_SPIN_CAP) { atomicAdd(&(bar)[XB_TMO], 1u); break; } } } } while (0)

struct XcdBarrier {
    unsigned* bar; unsigned x;
    volatile LAS unsigned* st;
};

__device__ __forceinline__ XcdBarrier xcd_barrier_post(unsigned* bar, volatile LAS unsigned* st, bool leader) {
    XcdBarrier b; b.bar = bar; b.x = xb_xcc_id(); b.st = st;
    if (leader) (void)xb_add(&bar[XB_XCNT(b.x)], 1u);
    return b;
}
__device__ __forceinline__ void xcd_barrier_complete(unsigned* bar, unsigned x, unsigned& nloc, unsigned& nx) {
    const unsigned G = gridDim.x * gridDim.y * gridDim.z;
    unsigned sum, cnt, mine, sp = 0u;
    for (;;) {
        sum = 0u; cnt = 0u; mine = 0u;
#pragma unroll
        for (unsigned j = 0; j < 16; ++j) { const unsigned c = xb_ld(&bar[XB_XCNT(j)]); sum += c; cnt += (c > 0u) ? 1u : 0u; mine = (j == x) ? c : mine; }
        if (sum == G) break;
        __builtin_amdgcn_s_sleep(1);
        if ((++sp & 255u) == 0u) { if (xb_ld(&bar[XB_TMO])) break; if (sp > XB_SPIN_CAP) { atomicAdd(&bar[XB_TMO], 1u); break; } }
    }
    nloc = mine > 0u ? mine : 1u; nx = cnt > 0u ? cnt : 1u;
}

__device__ __forceinline__ void xcd_barrier(const XcdBarrier& b, bool leader) {
    asm volatile("s_waitcnt vmcnt(0)" ::: "memory");
    __syncthreads();
    if (leader) {
        unsigned* bar = b.bar;
        __builtin_amdgcn_s_waitcnt(0);
        unsigned nloc = b.st[0], nx = b.st[1];
        if (nloc == 0u) { xcd_barrier_complete(bar, b.x, nloc, nx); b.st[0] = nloc; b.st[1] = nx; }
        const unsigned old = xb_add(&bar[XB_XSUB(b.x)], 1u);
        const unsigned gen = old / nloc;
        if (old + 1u == (gen + 1u) * nloc) {
            __builtin_amdgcn_fence(__ATOMIC_RELEASE, "agent");
            asm volatile("s_waitcnt vmcnt(0)" ::: "memory");
            const unsigned og = xb_add(&bar[XB_TOP], 1u);
            const unsigned tg = og / nx;
            if (og + 1u == (tg + 1u) * nx) xb_add(&bar[XB_TOPGEN], 1u);
            else XB_SPIN(xb_ld(&bar[XB_TOPGEN]) == tg, bar);
            __builtin_amdgcn_fence(__ATOMIC_ACQUIRE, "agent");
            xb_add(&bar[XB_XGEN(b.x)], 1u);
            asm volatile("s_waitcnt vmcnt(0)" ::: "memory");
        } else {
            XB_SPIN(xb_ld(&bar[XB_XGEN(b.x)]) == gen, bar);
            __builtin_amdgcn_fence(__ATOMIC_ACQUIRE, "agent");
            asm volatile("s_waitcnt vmcnt(0)" ::: "memory");
        }
    }
    __syncthreads();
}
constexpr int NWAVES = 8, NTHR = 512;
constexpr int RING_OFF = 0, RING_BYTES = 131072;
constexpr int LDSCTL_OFF = RING_BYTES, MISC_OFF = LDSCTL_OFF + 320, XB_OFF = RING_BYTES + 1024;
constexpr int LDS_BYTES = 147456;
constexpr size_t CTL_ZERO_BYTES = 65536;
constexpr int CW_TMO = 0, CW_BAR = 4096;
constexpr int NPH = 9;
constexpr int FL_NO_DSA = 1, FL_NO_CROSS = 2, FL_NO_S5 = 4;
constexpr size_t WS_LAM32 = WS_BIASL + 8192;

struct Args { const float* in[29]; float* out; unsigned char* ws; int ph_lo, ph_hi, flags, li; };

__device__ __forceinline__ float wave_sum(float v) {
#pragma unroll
    for (int o = 1; o < 64; o <<= 1) v += __shfl_xor(v, o);
    return v;
}
__device__ __forceinline__ float p0_src(int mode, const float* W, const float* W2, const float* gain, int N, int k, int d) {
    if (mode == 0) return W[(size_t)k * N + d];
    if (mode == 1) { if (d >= 1736 && d < 1792) return 0.f; const int s = d >= 1792 ? d - 56 : d; return W[(size_t)k * N + s]; }
    const int tile = d >> 8, w = d & 255, f = tile * 128 + (w & 127); return ((w < 128) ? W : W2)[(size_t)k * N + f] * gain[k];
}
__device__ __forceinline__ void p0_transpose_item(int mode, const float* W, const float* W2, const float* gain, int K, int N, int ND, bf16* WT, LAS float* scr, int item, int lane) {
    const int nblk = ND / 32, kb = item / nblk, nb = item % nblk, k0 = 64 * kb, d0 = 32 * nb;
    float tv[32];
#pragma unroll
    for (int i = 0; i < 32; ++i) tv[i] = p0_src(mode, W, W2, gain, N, k0 + 2 * i + (lane >> 5), d0 + (lane & 31));
#pragma unroll
    for (int i = 0; i < 32; ++i) scr[(2 * i + (lane >> 5)) * 33 + (lane & 31)] = tv[i];
    LDS_WAIT(); asm volatile("" ::: "memory");
    const int c = lane & 7;
#pragma unroll
    for (int j = 0; j < 4; ++j) { const int n = (lane >> 3) + 8 * j; const LAS float* s = scr + (8 * c) * 33 + n;
        v4u o; o.x = pk2(s[0 * 33], s[1 * 33]); o.y = pk2(s[2 * 33], s[3 * 33]); o.z = pk2(s[4 * 33], s[5 * 33]); o.w = pk2(s[6 * 33], s[7 * 33]);
        *(GAS v4u*)(WT + (size_t)(d0 + n) * K + k0 + 8 * c) = o; }
    LDS_WAIT(); asm volatile("" ::: "memory");
}
__device__ __forceinline__ void rms_row_to_bf16(const float* xrow, const float* g, bf16* orow, int lane) {
    const GAS f32x4* xr = (const GAS f32x4*)xrow + lane; const GAS f32x4* gr = (const GAS f32x4*)g + lane;
    f32x4 v[4]; float s = 0.f;
#pragma unroll
    for (int j = 0; j < 4; ++j) { v[j] = xr[64 * j]; s += (v[j].x * v[j].x + v[j].y * v[j].y) + (v[j].z * v[j].z + v[j].w * v[j].w); }
    const float rstd = 1.f / sqrtf(wave_sum(s) * (1.f / 1024.f) + 1e-6f);
    GAS unsigned long long* o8 = (GAS unsigned long long*)orow + lane;
#pragma unroll
    for (int j = 0; j < 4; ++j) { const f32x4 gg = gr[64 * j];
        o8[64 * j] = (unsigned long long)pk2(v[j].x * rstd * gg.x, v[j].y * rstd * gg.y) | ((unsigned long long)pk2(v[j].z * rstd * gg.z, v[j].w * rstd * gg.w) << 32); }
}
__device__ __forceinline__ int t5_bucket(int n) {
    if (n < 16) return n;
    const int large = 16 + (int)((logf((float)n / 16.f) / 2.0794415416798357f) * 16.f);
    return large < 31 ? large : 31;
}
__device__ __forceinline__ void p0_s5_tables(int g, int part, const Args& a, LAS unsigned char* lds, int tid) {
    typedef float f32x2v __attribute__((ext_vector_type(2)));
    LAS f32x2v* POW = (LAS f32x2v*)lds;
    LAS f32x2v* BB = POW + 33 * 64;
    LAS f32x2v* CC = BB + 64 * 16;
    LAS float* KT = (LAS float*)(CC + 16 * 64);
    const float *a_re = a.in[8], *a_im = a.in[9], *log_dt = a.in[10], *b_re = a.in[11], *b_im = a.in[12], *c_re = a.in[13], *c_im = a.in[14];
    bf16* TV = (bf16*)(a.ws + WS_S5TV) + (size_t)g * 512 * 640; bf16* Wt = (bf16*)(a.ws + WS_S5W) + (size_t)g * 256 * 512; float* LAM32 = (float*)(a.ws + WS_LAM32) + g * 128;
    const double dt = exp((double)log_dt[g]);
    for (int idx = tid; idx < 33 * 64; idx += NTHR) { const int j = idx >> 6, n = idx & 63; const double lr = a_re[g * 64 + n], li = a_im[g * 64 + n];
        const double mag = exp(lr * dt * j), ang = li * dt * j; POW[idx] = (f32x2v){(float)(mag * cos(ang)), (float)(mag * sin(ang))}; }
    for (int idx = tid; idx < 64 * 16; idx += NTHR) { const int n = idx >> 4, c = idx & 15; const double lr = a_re[g * 64 + n], li = a_im[g * 64 + n];
        const double mag = exp(lr * dt), lbr = mag * cos(li * dt), lbi = mag * sin(li * dt), nr = lbr - 1.0, ni = lbi, den = lr * lr + li * li;
        const double fr = (nr * lr + ni * li) / den, fi = (ni * lr - nr * li) / den, br = b_re[(g * 64 + n) * 16 + c], bi = b_im[(g * 64 + n) * 16 + c];
        BB[idx] = (f32x2v){(float)(fr * br - fi * bi), (float)(fr * bi + fi * br)};
        const int c2 = idx >> 6, n2 = idx & 63; CC[idx] = (f32x2v){c_re[(g * 16 + c2) * 64 + n2], c_im[(g * 16 + c2) * 64 + n2]}; }
    __syncthreads();
    if (part == 0 && tid < 64) { const f32x2v p = POW[32 * 64 + tid]; LAM32[tid * 2] = p.x; LAM32[tid * 2 + 1] = p.y; }
    for (int idx = tid; idx < 32 * 32; idx += NTHR) { const int j = idx >> 5, co = 2 * part + ((idx >> 4) & 1), ci = idx & 15; float s = 0.f;
#pragma unroll 2
        for (int n = 0; n < 64; ++n) { const f32x2v c = CC[co * 64 + n], p = POW[j * 64 + n], b = BB[n * 16 + ci];
            const float cpr = c.x * p.x - c.y * p.y, cpi = c.x * p.y + c.y * p.x; s += cpr * b.x - cpi * b.y; }
        KT[j * 256 + co * 16 + ci] = s; }
    __syncthreads();
    for (int id = tid; id < 64 * 80; id += NTHR) { const int rl = id / 80, c8 = id % 80, so = rl >> 1, co = 2 * part + (rl & 1), row = so * 16 + co; float v[8];
        if (c8 < 64) { const int si = c8 >> 1, ci0 = (c8 & 1) * 8;
#pragma unroll
            for (int e = 0; e < 8; ++e) v[e] = so >= si ? KT[(so - si) * 256 + co * 16 + ci0 + e] : 0.f; }
        else {
#pragma unroll
            for (int e = 0; e < 8; ++e) { const int np = (c8 - 64) * 8 + e, n = np & 63; const f32x2v c = CC[co * 64 + n], p = POW[(so + 1) * 64 + n];
                v[e] = np < 64 ? (c.x * p.x - c.y * p.y) : -(c.x * p.y + c.y * p.x); } }
        v4u o; o.x = pk2(v[0], v[1]); o.y = pk2(v[2], v[3]); o.z = pk2(v[4], v[5]); o.w = pk2(v[6], v[7]);
        *(GAS v4u*)(TV + (size_t)row * 640 + c8 * 8) = o; }
    for (int id = tid; id < 16 * 64; id += NTHR) { const int np = 16 * part + (id >> 6), c8 = id & 63, n = np & 63, s = c8 >> 1, ci0 = (c8 & 1) * 8; const f32x2v p = POW[(31 - s) * 64 + n]; float v[8];
#pragma unroll
        for (int e = 0; e < 8; ++e) { const f32x2v b = BB[n * 16 + ci0 + e]; v[e] = np < 64 ? (p.x * b.x - p.y * b.y) : (p.x * b.y + p.y * b.x); }
        v4u o; o.x = pk2(v[0], v[1]); o.y = pk2(v[2], v[3]); o.z = pk2(v[4], v[5]); o.w = pk2(v[6], v[7]);
        *(GAS v4u*)(Wt + (size_t)np * 512 + c8 * 8) = o; }
    __syncthreads();
}
__device__ __forceinline__ void p0_prologue(const Args& a, LAS unsigned char* lds, int tid, int lane, int wave, int vcu, int G) {
    unsigned char* ws = a.ws;
    LAS float* scr = (LAS float*)(lds + RING_OFF + wave * 16384);
    const int gw = vcu * NWAVES + wave, NGW = G * NWAVES;
    p0_s5_tables(vcu >> 3, vcu & 7, a, lds, tid);
    if (blockIdx.x == 33 && tid == 0) {
        float gq = 0.f, gk = 0.f, bm = 0.f; for (int i = 0; i < 128; ++i) { gq = fmaxf(gq, fabsf(a.in[5][i])); gk = fmaxf(gk, fabsf(a.in[6][i])); }
        for (int i = 0; i < 256; ++i) bm = fmaxf(bm, fabsf(a.in[2][i]));
        const float B = 1.02f * 128.f * 0.08838834764831845f * 1.4426950408889634f * gq * gk + bm * 1.4426950408889634f;
        ((float*)(ws + WS_BIASL))[1032] = (B > 0.f && B <= 56.f) ? B : 0.f; }
    if (blockIdx.x == 32) { float* BL = (float*)(ws + WS_BIASL); const float* rb = a.in[2];
        for (int i = tid; i < 8 * 128 + 8; i += NTHR) { if (i < 1024) { const int h = i >> 7, d = i & 127; BL[i] = rb[t5_bucket(d) * 8 + h] * 1.4426950408889634f; } else BL[i] = rb[31 * 8 + (i - 1024)] * 1.4426950408889634f; } }
    { bf16* WUV = (bf16*)(ws + WS_WUV); const float* w = a.in[7];
        for (int i = blockIdx.x * NTHR + tid; i < 8 * 64 * 128; i += G * NTHR) { const int ep = i & 3, ln = (i >> 2) & 63, t = (i >> 8) & 1, cs = (i >> 9) & 7, eb = (i >> 12) & 1, h = i >> 13;
            const int d = 16 * cs + 8 * t + 4 * (ln >> 5) + ep, e = 32 * eb + (ln & 31); WUV[i] = (bf16)f2bf(w[(h * 128 + d) * 64 + e]); } }
    constexpr int I_IN = 16 * 184, I_MKV = 16 * 32, I_GLU = 8 * 16, I_BR = 8 * 32, I_OUT = 16 * 32, I_GU = 16 * 176, I_D = 44 * 32;
    constexpr int NITEMS = I_IN + I_MKV + I_GLU + 3 * I_BR + I_OUT + I_GU + I_D;
    for (int it = gw; it < NITEMS; it += NGW) {
        int r = it;
        if (r < I_IN) { p0_transpose_item(1, a.in[3], nullptr, nullptr, 1024, 5832, 5888, (bf16*)(ws + WS_WIN), scr, r, lane); continue; } r -= I_IN;
        if (r < I_MKV) { p0_transpose_item(0, a.in[18], nullptr, nullptr, 1024, 1024, 1024, (bf16*)(ws + WS_WMKV), scr, r, lane); continue; } r -= I_MKV;
        if (r < I_GLU) { p0_transpose_item(0, a.in[16], nullptr, nullptr, 512, 512, 512, (bf16*)(ws + WS_WGLU), scr, r, lane); continue; } r -= I_GLU;
        if (r < 3 * I_BR) { const int br = r / I_BR; p0_transpose_item(0, a.in[21 + br], nullptr, nullptr, 512, 1024, 1024, (bf16*)(ws + WS_WBR) + (size_t)br * 1024 * 512, scr, r % I_BR, lane); continue; } r -= 3 * I_BR;
        if (r < I_OUT) { p0_transpose_item(0, a.in[24], nullptr, nullptr, 1024, 1024, 1024, (bf16*)(ws + WS_WOUT), scr, r, lane); continue; } r -= I_OUT;
        if (r < I_GU) { p0_transpose_item(2, a.in[26], a.in[27], a.in[25], 1024, 2816, 5632, (bf16*)(ws + WS_WGU), scr, r, lane); continue; } r -= I_GU;
        p0_transpose_item(0, a.in[28], nullptr, nullptr, 2816, 1024, 1024, (bf16*)(ws + WS_WD), scr, r, lane);
    }
    for (int m = gw; m < T_TOK; m += 2 * NGW) {
        const GAS f32x4* x0 = (const GAS f32x4*)(a.in[0] + (size_t)m * 1024) + lane; const GAS f32x4* x1 = (const GAS f32x4*)(a.in[0] + (size_t)(m + NGW) * 1024) + lane; const GAS f32x4* gr = (const GAS f32x4*)a.in[4] + lane;
        f32x4 v0[4], v1[4]; float s0 = 0.f, s1 = 0.f;
#pragma unroll
        for (int j = 0; j < 4; ++j) { v0[j] = x0[64 * j]; v1[j] = x1[64 * j]; }
#pragma unroll
        for (int j = 0; j < 4; ++j) { s0 += (v0[j].x * v0[j].x + v0[j].y * v0[j].y) + (v0[j].z * v0[j].z + v0[j].w * v0[j].w); s1 += (v1[j].x * v1[j].x + v1[j].y * v1[j].y) + (v1[j].z * v1[j].z + v1[j].w * v1[j].w); }
        const float r0 = 1.f / sqrtf(wave_sum(s0) * (1.f / 1024.f) + 1e-6f), r1 = 1.f / sqrtf(wave_sum(s1) * (1.f / 1024.f) + 1e-6f);
        GAS unsigned long long* o0 = (GAS unsigned long long*)((bf16*)(ws + WS_H) + (size_t)m * 1024) + lane; GAS unsigned long long* o1 = (GAS unsigned long long*)((bf16*)(ws + WS_H) + (size_t)(m + NGW) * 1024) + lane;
#pragma unroll
        for (int j = 0; j < 4; ++j) { const f32x4 gg = gr[64 * j];
            o0[64 * j] = (unsigned long long)pk2(v0[j].x * r0 * gg.x, v0[j].y * r0 * gg.y) | ((unsigned long long)pk2(v0[j].z * r0 * gg.z, v0[j].w * r0 * gg.w) << 32);
            o1[64 * j] = (unsigned long long)pk2(v1[j].x * r1 * gg.x, v1[j].y * r1 * gg.y) | ((unsigned long long)pk2(v1[j].z * r1 * gg.z, v1[j].w * r1 * gg.w) << 32); }
    }
    for (int m = gw; m < 2048; m += NGW) rms_row_to_bf16(a.in[1] + (size_t)m * 1024, a.in[17], (bf16*)(ws + WS_MEMN) + (size_t)m * 1024, lane);
}
__device__ __forceinline__ void norm128_pass(bf16* X, int rows, int ld, int ngroups, const float* g, int gtid, int nthr) {
    const int l = gtid & 15, total = rows * ngroups;
    for (int gid = gtid >> 4; gid < total; gid += nthr >> 4) {
        const int r = gid / ngroups, gi = gid % ngroups;
        bf16* p = X + (size_t)r * ld + gi * 128 + l * 8;
        const v4u v = *(const GAS v4u*)p; float f[8];
        f[0] = __uint_as_float(v.x << 16); f[1] = __uint_as_float(v.x & 0xffff0000u); f[2] = __uint_as_float(v.y << 16); f[3] = __uint_as_float(v.y & 0xffff0000u);
        f[4] = __uint_as_float(v.z << 16); f[5] = __uint_as_float(v.z & 0xffff0000u); f[6] = __uint_as_float(v.w << 16); f[7] = __uint_as_float(v.w & 0xffff0000u);
        float s = 0.f;
#pragma unroll
        for (int q = 0; q < 8; ++q) s += f[q] * f[q];
        s += __shfl_xor(s, 8); s += __shfl_xor(s, 4); s += __shfl_xor(s, 2); s += __shfl_xor(s, 1);
        const float rs = 1.f / sqrtf(s * (1.f / 128.f) + 1e-6f);
        const f32x4 g0 = *(const GAS f32x4*)(g + l * 8), g1 = *(const GAS f32x4*)(g + l * 8 + 4);
        v4u o; o.x = pk2(f[0] * rs * g0.x, f[1] * rs * g0.y); o.y = pk2(f[2] * rs * g0.z, f[3] * rs * g0.w); o.z = pk2(f[4] * rs * g1.x, f[5] * rs * g1.y); o.w = pk2(f[6] * rs * g1.z, f[7] * rs * g1.w);
        *(GAS v4u*)p = o;
    }
}
__device__ __forceinline__ void s5_scan(int g, int half, const Args& a, int tid) {
    if (tid < 256) {
        const int bl = tid >> 6, n = tid & 63, b = half * 4 + bl;
        const float* LAM32 = (const float*)(a.ws + WS_LAM32) + g * 128; const float lr = LAM32[n * 2], li = LAM32[n * 2 + 1];
        const float* SL = (const float*)(a.ws + WS_SLOC) + ((size_t)(g * 512 + b * 64)) * 128; bf16* Ur = (bf16*)(a.ws + WS_U) + ((size_t)(g * 512 + b * 64)) * 640 + 512;
        float xr = 0.f, xi = 0.f;
#pragma unroll 1
        for (int c0 = 0; c0 < 64; c0 += 16) {
            float sr[16], si[16];
#pragma unroll
            for (int k = 0; k < 16; ++k) { sr[k] = SL[(size_t)(c0 + k) * 128 + n]; si[k] = SL[(size_t)(c0 + k) * 128 + 64 + n]; }
#pragma unroll
            for (int k = 0; k < 16; ++k) {
                Ur[(size_t)(c0 + k) * 640 + n] = (bf16)f2bf(xr); Ur[(size_t)(c0 + k) * 640 + 64 + n] = (bf16)f2bf(xi);
                const float nr = lr * xr - li * xi + sr[k], ni = lr * xi + li * xr + si[k]; xr = nr; xi = ni;
            }
        }
    }
    VM_WAIT(); __syncthreads();
}
#define HAVE_ATTN 1
#ifdef TPROBE
#if TPROBE < 8
#define TP_STAMP(k) { __builtin_amdgcn_sched_barrier(0); const unsigned long long t_ = __builtin_amdgcn_s_memtime(); tp_acc[k] += t_ - tp_prev; tp_prev = t_; __builtin_amdgcn_sched_barrier(0); }
#define TP_DECL unsigned long long tp_acc[8] = {0, 0, 0, 0, 0, 0, 0, 0}; unsigned long long tp_prev = __builtin_amdgcn_s_memtime();
#define TP_FLUSH(base) { if (blockIdx.x == TPROBE_BLOCK && wave == 0 && lane == 0) { unsigned long long* TP = (unsigned long long*)(a.ws + WS_CTL + 65536); for (int k_ = 0; k_ < 8; ++k_) TP[(base) + k_] += tp_acc[k_]; } }
#define TQ_STAMP(k)
#define TQ_DECL
#define TQ_FLUSH
#else
#define TP_STAMP(k)
#define TP_DECL
#define TP_FLUSH(base)
#define TQ_STAMP(k) { const unsigned t_ = (unsigned)__builtin_amdgcn_s_memtime(); tq_acc[k] += t_ - tq_prev; tq_prev = t_; }
#define TQ_DECL unsigned tq_acc[4] = {0, 0, 0, 0}; unsigned tq_prev = (unsigned)__builtin_amdgcn_s_memtime();
#define TQ_FLUSH { if (blockIdx.x == TPROBE_BLOCK && wave == 0 && lane == 0) { unsigned long long* TP = (unsigned long long*)(a.ws + WS_CTL + 65536); for (int k_ = 0; k_ < 4; ++k_) TP[8 + k_] += tq_acc[k_]; } }
#endif
#else
#define TP_STAMP(k)
#define TP_DECL
#define TP_FLUSH(base)
#define TQ_STAMP(k)
#define TQ_DECL
#define TQ_FLUSH
#endif
namespace att {
typedef float f32x16 __attribute__((ext_vector_type(16)));
typedef short s16x4 __attribute__((ext_vector_type(4)));
typedef short v4i16_t __attribute__((ext_vector_type(4)));
typedef float f32x2_t __attribute__((ext_vector_type(2))); typedef __bf16 bf16x2_t __attribute__((ext_vector_type(2)));
typedef unsigned u32x2 __attribute__((ext_vector_type(2)));
#define MFMA32(a, b, c) __builtin_amdgcn_mfma_f32_32x32x16_bf16((a), (b), (c), 0, 0, 0)
__device__ __forceinline__ unsigned cvtpk(float lo, float hi) { const f32x2_t v = {lo, hi}; const bf16x2_t b = __builtin_convertvector(v, bf16x2_t); return __builtin_bit_cast(unsigned, b); }
__device__ __forceinline__ int crow(int r, int hi) { return (r & 3) + 8 * (r >> 2) + 4 * hi; }
__device__ __forceinline__ unsigned off_b(unsigned row, unsigned ch) { return 256u * row + 16u * (ch ^ (((row & 3u) << 2) | ((row >> 2) & 3u))); }
__device__ __forceinline__ float xh_max(float v) { const auto rr = __builtin_amdgcn_permlane32_swap(__float_as_uint(v), __float_as_uint(v), false, false); return fmaxf(__uint_as_float(rr[0]), __uint_as_float(rr[1])); }
__device__ __forceinline__ float xh_sum(float v) { const auto rr = __builtin_amdgcn_permlane32_swap(__float_as_uint(v), __float_as_uint(v), false, false); return __uint_as_float(rr[0]) + __uint_as_float(rr[1]); }
__device__ __forceinline__ unsigned xh_sumu(unsigned v) { const auto rr = __builtin_amdgcn_permlane32_swap(v, v, false, false); return rr[0] + rr[1]; }
__device__ __forceinline__ unsigned xh_or(unsigned v) { const auto rr = __builtin_amdgcn_permlane32_swap(v, v, false, false); return rr[0] | rr[1]; }
constexpr float SCALE2 = 0.08838834764831845f * 1.4426950408889634f;

__device__ __forceinline__ bf16x8 pack_step(const f32x16& x, int s) {
    v4u p; p.x = cvtpk(x[8 * s], x[8 * s + 1]); p.y = cvtpk(x[8 * s + 2], x[8 * s + 3]); p.z = cvtpk(x[8 * s + 4], x[8 * s + 5]); p.w = cvtpk(x[8 * s + 6], x[8 * s + 7]);
    return __builtin_bit_cast(bf16x8, p);
}
__device__ __forceinline__ void qk_tile(f32x16& p0, f32x16& p1, LAS const unsigned char* kimg, const bf16x8 (&qf)[8], int lane) {
    const unsigned r32 = lane & 31, hi = lane >> 5;
    f32x16 z;
#pragma unroll
    for (int r = 0; r < 16; ++r) z[r] = 0.f;
    p0 = z; p1 = z;
    bf16x8 fa[2][4];
#define QK_LOAD(g, buf) { const unsigned o0_ = off_b(r32, 4 * (g) + hi), o1_ = off_b(r32, 4 * (g) + 2 + hi); \
        fa[buf][0] = *(LAS const bf16x8*)(kimg + o0_); fa[buf][1] = *(LAS const bf16x8*)(kimg + o0_ + 32 * 256); fa[buf][2] = *(LAS const bf16x8*)(kimg + o1_); fa[buf][3] = *(LAS const bf16x8*)(kimg + o1_ + 32 * 256); }
#define QK_MMA(g, buf) { p0 = MFMA32(fa[buf][0], qf[2 * (g)], p0); p1 = MFMA32(fa[buf][1], qf[2 * (g)], p1); p0 = MFMA32(fa[buf][2], qf[2 * (g) + 1], p0); p1 = MFMA32(fa[buf][3], qf[2 * (g) + 1], p1); }
    QK_LOAD(0, 0) QK_LOAD(1, 1) QK_MMA(0, 0) asm volatile("" ::: "memory");
    QK_LOAD(2, 0) QK_MMA(1, 1) asm volatile("" ::: "memory");
    QK_LOAD(3, 1) QK_MMA(2, 0) QK_MMA(3, 1)
#undef QK_LOAD
#undef QK_MMA
}
__device__ __forceinline__ s16x4 vtr(LAS const unsigned char* p) { return __builtin_bit_cast(s16x4, __builtin_amdgcn_ds_read_tr16_b64_v4i16((LAS v4i16_t*)p)); }
__device__ __forceinline__ void pv_tile(f32x16 (&o)[4], LAS const unsigned char* vimg, const bf16x8 (&pf)[4], int lane) {
    const unsigned hi = lane >> 5, blk = (lane >> 4) & 1, q = (lane & 15) >> 2, p = lane & 3;
    s16x4 fl[2][4], fh[2][4];
#define PV_LOAD(c, buf) { _Pragma("unroll") for (int ks = 0; ks < 4; ++ks) { const unsigned ch = 4 * (c) + 2 * blk + (p >> 1), rlo = 16 * ks + 4 * hi + q; \
        fl[buf][ks] = vtr(vimg + off_b(rlo, ch) + 8 * (p & 1)); fh[buf][ks] = vtr(vimg + off_b(rlo + 8, ch) + 8 * (p & 1)); } }
#define PV_MMA(c, buf) { _Pragma("unroll") for (int ks = 0; ks < 4; ++ks) { const bf16x8 af = {fl[buf][ks][0], fl[buf][ks][1], fl[buf][ks][2], fl[buf][ks][3], fh[buf][ks][0], fh[buf][ks][1], fh[buf][ks][2], fh[buf][ks][3]}; \
        o[c] = MFMA32(af, pf[ks], o[c]); } }
    PV_LOAD(0, 0) PV_LOAD(1, 1) PV_MMA(0, 0) asm volatile("" ::: "memory");
    PV_LOAD(2, 0) PV_MMA(1, 1) asm volatile("" ::: "memory");
    PV_LOAD(3, 1) PV_MMA(2, 0) PV_MMA(3, 1)
#undef PV_LOAD
#undef PV_MMA
}
template <bool FIXED> __device__ __forceinline__ void softmax_step(f32x16& p0, f32x16& p1, float& m, float& l, f32x16 (&o)[4], bf16x8 (&pf)[4]) {
    if constexpr (FIXED) {
        f32x2_t s2 = {0.f, 0.f};
#pragma unroll
        for (int r = 0; r < 16; ++r) { p0[r] = __builtin_amdgcn_exp2f(p0[r]); p1[r] = __builtin_amdgcn_exp2f(p1[r]); const f32x2_t t = {p0[r], p1[r]}; s2 += t; }
        l += s2[0] + s2[1];
    } else {
        float mx = fmaxf(p0[0], p1[0]);
#pragma unroll
        for (int r = 1; r < 16; ++r) mx = fmaxf(mx, fmaxf(p0[r], p1[r]));
        mx = xh_max(mx);
        const float mnew = fmaxf(m, mx), muse = (mnew == -INFINITY) ? 0.f : mnew;
        const float alpha = __builtin_amdgcn_exp2f(m - muse);
        float s = 0.f;
#pragma unroll
        for (int r = 0; r < 16; ++r) { p0[r] = __builtin_amdgcn_exp2f(p0[r] - muse); p1[r] = __builtin_amdgcn_exp2f(p1[r] - muse); s += p0[r] + p1[r]; }
        l = l * alpha + s; m = mnew;
        if (__any(alpha != 1.f)) {
#pragma unroll
            for (int c = 0; c < 4; ++c)
#pragma unroll
                for (int r = 0; r < 16; ++r) o[c][r] *= alpha;
        }
    }
    pf[0] = pack_step(p0, 0); pf[1] = pack_step(p0, 1); pf[2] = pack_step(p1, 0); pf[3] = pack_step(p1, 1);
}
__device__ __forceinline__ void tile_load(v4u (&rg)[2], const bf16* src, int pitch, int tid) {
#pragma unroll
    for (int i = 0; i < 2; ++i) { const int id = tid + 512 * i, row = id >> 4, ch = id & 15; rg[i] = *(const GAS v4u*)(src + (size_t)row * pitch + ch * 8); }
}
__device__ __forceinline__ void tile_store(const v4u (&rg)[2], LAS unsigned char* img, int tid) {
#pragma unroll
    for (int i = 0; i < 2; ++i) { const int id = tid + 512 * i, row = id >> 4, ch = id & 15; *(LAS v4u*)(img + off_b(row, ch)) = rg[i]; }
}

__device__ __forceinline__ void cross_item(const Args& a, LAS unsigned char* lds, int tid, int lane, int wave, int item) {
    const int r32 = lane & 31, hi = lane >> 5;
    const int b = item >> 5, hx = (item >> 3) & 3, qblk = item & 7;
    const bf16* QX = (const bf16*)(a.ws + WS_QX); const bf16* KX = (const bf16*)(a.ws + WS_KX) + (size_t)b * 256 * 512 + hx * 128; const bf16* VX = (const bf16*)(a.ws + WS_VX) + (size_t)b * 256 * 512 + hx * 128;
    bf16* OX = (bf16*)(a.ws + WS_OX);
    const size_t row = (size_t)b * 2048 + qblk * 256 + wave * 32 + r32;
    bf16x8 qf[8];
#pragma unroll
    for (int s = 0; s < 8; ++s) qf[s] = *(const GAS bf16x8*)(QX + row * 512 + hx * 128 + 16 * s + 8 * hi);
    f32x16 o[4];
#pragma unroll
    for (int c = 0; c < 4; ++c)
#pragma unroll
        for (int r = 0; r < 16; ++r) o[c][r] = 0.f;
    float m = -INFINITY, l = 0.f;
    v4u kr[2], vr[2];
    tile_load(kr, KX, 512, tid); tile_load(vr, VX, 512, tid);
    tile_store(kr, lds, tid); tile_store(vr, lds + 32768, tid);
    __syncthreads();
#pragma unroll 1
    for (int kt = 0; kt < 4; ++kt) {
        LAS unsigned char* kimg = lds + (kt & 1) * 16384; LAS unsigned char* vimg = lds + 32768 + (kt & 1) * 16384;
        if (kt + 1 < 4) { tile_load(kr, KX + (size_t)(kt + 1) * 64 * 512, 512, tid); tile_load(vr, VX + (size_t)(kt + 1) * 64 * 512, 512, tid); }
        f32x16 p0, p1; qk_tile(p0, p1, kimg, qf, lane);
#pragma unroll
        for (int r = 0; r < 16; ++r) { p0[r] *= SCALE2; p1[r] *= SCALE2; }
        bf16x8 pf[4]; softmax_step<false>(p0, p1, m, l, o, pf);
        pv_tile(o, vimg, pf, lane);
        if (kt + 1 < 4) { tile_store(kr, lds + ((kt + 1) & 1) * 16384, tid); tile_store(vr, lds + 32768 + ((kt + 1) & 1) * 16384, tid); }
        __syncthreads();
    }
    l = xh_sum(l);
    const float inv = 1.f / l;
#pragma unroll
    for (int c = 0; c < 4; ++c)
#pragma unroll
        for (int g4 = 0; g4 < 4; ++g4) { u32x2 w; w.x = cvtpk(o[c][4 * g4] * inv, o[c][4 * g4 + 1] * inv); w.y = cvtpk(o[c][4 * g4 + 2] * inv, o[c][4 * g4 + 3] * inv);
            *(GAS u32x2*)(OX + row * 512 + hx * 128 + 32 * c + 8 * g4 + 4 * hi) = w; }
}
__device__ __forceinline__ void cross_phase(const Args& a, LAS unsigned char* lds, int tid, int lane, int wave, int bx, int G) {
    if (bx < 128) return;
#pragma unroll 1
    for (int i = 0; i < 2; ++i) cross_item(a, lds, tid, lane, wave, (bx - 128) * 2 + i);
}

constexpr int DSA_QI = 0, DSA_QPITCH = 1040, DSA_KTB = 33792, DSA_CT = DSA_KTB, DSA_MASK = DSA_KTB + 2 * 32 * 257 * 4, DSA_BT = DSA_MASK + 32 * 65 * 4, DSA_END = DSA_BT + 8 * 320 * 4;
static_assert(DSA_END <= RING_BYTES, "DSA LDS map");
__device__ __forceinline__ unsigned f2key(float x) { const unsigned b = __float_as_uint(x + 0.f); return (b & 0x80000000u) ? ~b : (b | 0x80000000u); }

__device__ __forceinline__ void cnt_ge(unsigned& cnt, unsigned key, unsigned cand) { asm volatile("v_cmp_ge_u32 vcc, %1, %2\n\tv_addc_co_u32_e32 %0, vcc, 0, %0, vcc" : "+v"(cnt) : "v"(key), "v"(cand) : "vcc"); }
__device__ __forceinline__ void cnt_gt(unsigned& cnt, unsigned key, unsigned cand) { asm volatile("v_cmp_gt_u32 vcc, %1, %2\n\tv_addc_co_u32_e32 %0, vcc, 0, %0, vcc" : "+v"(cnt) : "v"(key), "v"(cand) : "vcc"); }
__device__ __forceinline__ void cnt_eq(unsigned& cnt, unsigned key, unsigned cand) { asm volatile("v_cmp_eq_u32 vcc, %1, %2\n\tv_addc_co_u32_e32 %0, vcc, 0, %0, vcc" : "+v"(cnt) : "v"(key), "v"(cand) : "vcc"); }
__device__ __forceinline__ void cnt4_ge(unsigned& c0, unsigned& c1, unsigned& c2, unsigned& c3, unsigned k0, unsigned k1, unsigned k2, unsigned k3, unsigned cand) {
    unsigned long long m0, m1, m2;
    asm volatile("v_cmp_ge_u32 %4, %7, %11\n\tv_cmp_ge_u32 %5, %8, %11\n\tv_cmp_ge_u32 %6, %9, %11\n\tv_cmp_ge_u32 vcc, %10, %11\n\t"
                 "v_addc_co_u32_e64 %0, %4, 0, %0, %4\n\tv_addc_co_u32_e64 %1, %5, 0, %1, %5\n\tv_addc_co_u32_e64 %2, %6, 0, %2, %6\n\tv_addc_co_u32_e32 %3, vcc, 0, %3, vcc"
                 : "+v"(c0), "+v"(c1), "+v"(c2), "+v"(c3), "=&s"(m0), "=&s"(m1), "=&s"(m2) : "v"(k0), "v"(k1), "v"(k2), "v"(k3), "v"(cand) : "vcc");
}
template <int IB> __device__ __forceinline__ void cnt_tie_lt(unsigned& cnt, unsigned key, unsigned thr, unsigned lanepart, unsigned cand) { unsigned t;
    asm volatile("v_add_u32_e32 %1, %6, %4\n\tv_cmp_eq_u32 vcc, %2, %3\n\tv_cndmask_b32_e32 %1, -1, %1, vcc\n\tv_cmp_lt_u32 vcc, %1, %5\n\tv_addc_co_u32_e32 %0, vcc, 0, %0, vcc"
                 : "+v"(cnt), "=&v"(t) : "v"(key), "v"(thr), "v"(lanepart), "v"(cand), "i"(IB) : "vcc"); }
template <int IB, int BR> __device__ __forceinline__ void mask_sel(unsigned& w, unsigned key, unsigned thr, unsigned lanepart, unsigned istar, unsigned onehi) { unsigned t, bit;
    asm volatile("v_lshlrev_b32_e32 %2, %8, %7\n\tv_cmp_gt_u32 vcc, %3, %4\n\tv_cndmask_b32_e32 %1, 0, %2, vcc\n\tv_or_b32_e32 %0, %0, %1\n\t"
                 "v_add_u32_e32 %1, %9, %5\n\tv_cmp_le_u32 vcc, %1, %6\n\tv_cndmask_b32_e32 %1, 0, %2, vcc\n\tv_cmp_eq_u32 vcc, %3, %4\n\tv_cndmask_b32_e32 %1, 0, %1, vcc\n\tv_or_b32_e32 %0, %0, %1"
                 : "+v"(w), "=&v"(t), "=&v"(bit) : "v"(key), "v"(thr), "v"(lanepart), "v"(istar), "v"(onehi), "i"(BR), "i"(IB) : "vcc"); }

#define CRB(r) (((r) & 3) + 8 * ((r) >> 2))
#define TIE1(i, r) cnt_tie_lt<256 * (i) + CRB(r)>(cnt, key[i][r], thr, lanepart, cand);
#define TIE_ROW(i) TIE1(i,0) TIE1(i,1) TIE1(i,2) TIE1(i,3) TIE1(i,4) TIE1(i,5) TIE1(i,6) TIE1(i,7) TIE1(i,8) TIE1(i,9) TIE1(i,10) TIE1(i,11) TIE1(i,12) TIE1(i,13) TIE1(i,14) TIE1(i,15)
#define SEL1(i, r) mask_sel<256 * (i) + CRB(r), CRB(r)>(w, key[i][r], thr, lanepart, istar, onehi);
#define SEL_ROW(i) SEL1(i,0) SEL1(i,1) SEL1(i,2) SEL1(i,3) SEL1(i,4) SEL1(i,5) SEL1(i,6) SEL1(i,7) SEL1(i,8) SEL1(i,9) SEL1(i,10) SEL1(i,11) SEL1(i,12) SEL1(i,13) SEL1(i,14) SEL1(i,15)
__device__ __forceinline__ unsigned row_total(unsigned cnt, LAS unsigned* CNT, int& par, int r32, int hi, int wave) {
    cnt = xh_sumu(cnt);
    if (hi == 0) CNT[par * 256 + r32 * 8 + wave] = cnt;
    __syncthreads();
    const v4u x = *(LAS const v4u*)(CNT + par * 256 + r32 * 8), y = *(LAS const v4u*)(CNT + par * 256 + r32 * 8 + 4);
    par ^= 1;
    return (x.x + x.y) + (x.z + x.w) + (y.x + y.y) + (y.z + y.w);
}
template <bool FIXED> __device__ __forceinline__ void dsa_attn(const Args& a, LAS unsigned char* lds, int tid, int lane, int wave, int b, int qb, bool sel) {
    const int r32 = lane & 31, hi = lane >> 5;
    const int t0 = qb * 32; const size_t rowb = (size_t)b * 2048;
    const bf16* QD = (const bf16*)(a.ws + WS_QD); const bf16* CKV = (const bf16*)(a.ws + WS_CKV) + rowb * 128;
    const float* BL = (const float*)(a.ws + WS_BIASL); const bf16* WUV = (const bf16*)(a.ws + WS_WUV); bf16* ODSA = (bf16*)(a.ws + WS_ODSA);
    LAS unsigned* MASK = (LAS unsigned*)(lds + DSA_MASK);
    const int h = wave; const int tq = t0 + r32; const size_t qrow = rowb + t0 + r32;
    bf16x8 qf[8];
#pragma unroll
    for (int s = 0; s < 8; ++s) qf[s] = *(const GAS bf16x8*)(QD + qrow * 1024 + h * 128 + 16 * s + 8 * hi);
    const float c31 = BL[1024 + h] - BL[1032];
    f32x16 o[4];
#pragma unroll
    for (int c = 0; c < 4; ++c)
#pragma unroll
        for (int r = 0; r < 16; ++r) o[c][r] = 0.f;
    float m = -INFINITY, l = 0.f;
    const int NKT = (t0 + 32 + 63) >> 6;
    TP_DECL
#define DMA_TILE(kt_) { _Pragma("unroll") for (int i_ = 0; i_ < 2; ++i_) { const int rb_ = i_ * 8 + wave, row_ = 4 * rb_ + (lane >> 4), ch_ = (lane & 15) ^ (((row_ & 3) << 2) | ((row_ >> 2) & 3)); \
        __builtin_amdgcn_global_load_lds((const unsigned*)(CKV + (size_t)(64 * (kt_) + row_) * 128 + ch_ * 8), (LAS unsigned*)(lds + DSA_CT + ((kt_) & 3) * 16384 + rb_ * 1024), 16, 0, 0); } }
    DMA_TILE(0) if (NKT > 1) DMA_TILE(1)
    __syncthreads();
#pragma unroll 1
    for (int kp = 0; kp < NKT; kp += 2) {
      if (kp + 2 < NKT) DMA_TILE(kp + 2) if (kp + 3 < NKT) DMA_TILE(kp + 3)
#pragma unroll 1
      for (int kt = kp; kt < kp + 2 && kt < NKT; ++kt) {
        LAS unsigned char* cimg = lds + DSA_CT + (kt & 3) * 16384;
        TP_STAMP(0)
        f32x16 p0, p1; qk_tile(p0, p1, cimg, qf, lane);
        TP_STAMP(1)
        const int k0 = 64 * kt;
        const bool far = (t0 - k0 - 63) >= 128;
        unsigned mv0, mv1;
        if (sel) { mv0 = MASK[r32 * 65 + 2 * kt] >> (4 * hi); mv1 = MASK[r32 * 65 + 2 * kt + 1] >> (4 * hi); }
        else { const int d0 = tq - k0 - 4 * hi, d1 = d0 - 32;
            mv0 = d0 < 0 ? 0u : (d0 >= 31 ? 0x0f0f0f0fu : (0x0f0f0f0fu & ((2u << d0) - 1u)));
            mv1 = d1 < 0 ? 0u : (d1 >= 31 ? 0x0f0f0f0fu : (0x0f0f0f0fu & ((2u << d1) - 1u))); }
        if (far) {
#pragma unroll
            for (int r = 0; r < 16; ++r) { p0[r] = ((mv0 >> CRB(r)) & 1u) ? p0[r] * SCALE2 + c31 : -INFINITY; p1[r] = ((mv1 >> CRB(r)) & 1u) ? p1[r] * SCALE2 + c31 : -INFINITY; }
        } else {
            LAS const float* bt = (LAS const float*)(lds + DSA_BT + h * 1280 + (255 - (tq - k0 - 4 * hi)) * 4);
            if constexpr (FIXED) {
#define NEAR8(P, MV, OFF, R0) { float bb[8]; \
              _Pragma("unroll") for (int r = 0; r < 8; ++r) bb[r] = bt[(OFF) + CRB((R0) + r)]; \
              asm volatile("" ::: "memory"); \
              _Pragma("unroll") for (int r = 0; r < 8; ++r) { const float v_ = P[(R0) + r] * SCALE2 + bb[r]; P[(R0) + r] = (((MV) >> CRB((R0) + r)) & 1u) ? v_ : -INFINITY; } }
            NEAR8(p0, mv0, 0, 0) NEAR8(p0, mv0, 0, 8) NEAR8(p1, mv1, 32, 0) NEAR8(p1, mv1, 32, 8)
#undef NEAR8
            } else {
                const LAS float* btf = bt;
#pragma unroll
                for (int r = 0; r < 16; ++r) { const float b0 = btf[CRB(r)], b1 = btf[32 + CRB(r)];
                    p0[r] = ((mv0 >> CRB(r)) & 1u) ? p0[r] * SCALE2 + b0 : -INFINITY; p1[r] = ((mv1 >> CRB(r)) & 1u) ? p1[r] * SCALE2 + b1 : -INFINITY; }
            }
        }
        bf16x8 pf[4];
        softmax_step<FIXED>(p0, p1, m, l, o, pf);
        TP_STAMP(2)
        pv_tile(o, cimg, pf, lane);
        TP_STAMP(3)
        TP_STAMP(4)
      }
      __syncthreads();
    }
#undef DMA_TILE
    l = xh_sum(l);
    const float inv = 1.f / l;
    bf16x8 of[8];
#pragma unroll
    for (int c = 0; c < 4; ++c) {
#pragma unroll
        for (int r = 0; r < 16; ++r) o[c][r] *= inv;
        of[2 * c] = pack_step(o[c], 0); of[2 * c + 1] = pack_step(o[c], 1);
    }
    { s16x4 wl[2][8], wh[2][8];
#pragma unroll
      for (int eb = 0; eb < 2; ++eb) { const bf16* wf = WUV + (size_t)((h * 2 + eb) * 8) * 512 + lane * 4;
#pragma unroll
        for (int cs = 0; cs < 8; ++cs) { wl[eb][cs] = *(const GAS s16x4*)(wf + cs * 512); wh[eb][cs] = *(const GAS s16x4*)(wf + cs * 512 + 256); } }
      asm volatile("" ::: "memory");
#pragma unroll
      for (int eb = 0; eb < 2; ++eb) {
        f32x16 acc;
#pragma unroll
        for (int r = 0; r < 16; ++r) acc[r] = 0.f;
#pragma unroll
        for (int cs = 0; cs < 8; ++cs) {
            const bf16x8 af = {wl[eb][cs][0], wl[eb][cs][1], wl[eb][cs][2], wl[eb][cs][3], wh[eb][cs][0], wh[eb][cs][1], wh[eb][cs][2], wh[eb][cs][3]};
            acc = MFMA32(af, of[cs], acc);
        }
#pragma unroll
        for (int g4 = 0; g4 < 4; ++g4) { u32x2 w; w.x = cvtpk(acc[4 * g4], acc[4 * g4 + 1]); w.y = cvtpk(acc[4 * g4 + 2], acc[4 * g4 + 3]);
            *(GAS u32x2*)(ODSA + qrow * 512 + h * 64 + 32 * eb + 8 * g4 + 4 * hi) = w; }
      } }
    TP_STAMP(5)
    TP_FLUSH(0)
}
template <int MODE> __device__ __forceinline__ void dsa_item(const Args& a, LAS unsigned char* lds, int tid, int lane, int wave, int b, int qb) {
    const int r32 = lane & 31, hi = lane >> 5;
    const int t0 = qb * 32; const size_t rowb = (size_t)b * 2048;
    const bool sel = qb >= 8;
    const bf16* QD = (const bf16*)(a.ws + WS_QD); const bf16* CKV = (const bf16*)(a.ws + WS_CKV) + rowb * 128; const bf16* QI = (const bf16*)(a.ws + WS_QI); const bf16* KI = (const bf16*)(a.ws + WS_KI) + rowb * 64;
    const float* WI = (const float*)(a.ws + WS_WI); const float* BL = (const float*)(a.ws + WS_BIASL); const bf16* WUV = (const bf16*)(a.ws + WS_WUV); bf16* ODSA = (bf16*)(a.ws + WS_ODSA);
    LAS unsigned* MASK = (LAS unsigned*)(lds + DSA_MASK);
    const int NT = qb + 1;
    TQ_DECL
    if (MODE != 1 && sel) {
#pragma unroll
        for (int i = 0; i < 4; ++i) { const int id = tid + 512 * i, row = id >> 6, ch = id & 63;
            *(LAS v4u*)(lds + DSA_QI + row * DSA_QPITCH + ch * 16) = *(const GAS v4u*)(QI + (rowb + t0 + row) * 512 + ch * 8); }
        __syncthreads();
        float wq[8];
        { const f32x4 w0 = *(const GAS f32x4*)(WI + (rowb + t0 + r32) * 8), w1 = *(const GAS f32x4*)(WI + (rowb + t0 + r32) * 8 + 4);
          wq[0] = w0.x; wq[1] = w0.y; wq[2] = w0.z; wq[3] = w0.w; wq[4] = w1.x; wq[5] = w1.y; wq[6] = w1.z; wq[7] = w1.w; }
        unsigned kw[4][32];
        LAS unsigned* KTB = (LAS unsigned*)(lds + DSA_KTB);
        LAS const unsigned char* qbase = lds + DSA_QI + r32 * DSA_QPITCH + hi * 16;
        const bf16* kbase = KI + (size_t)r32 * 64 + 8 * hi;
        bf16x8 kf[4]; const bf16* kptr = kbase + (size_t)wave * 2048;
        if (wave < NT) {
#pragma unroll
            for (int kk = 0; kk < 4; ++kk) kf[kk] = *(const GAS bf16x8*)(kptr + 16 * kk);
        }
        kptr += 8 * 2048;
#define SC_HEAD(hh, dst) { _Pragma("unroll") for (int r = 0; r < 16; ++r) dst[r] = 0.f; \
            _Pragma("unroll") for (int kk = 0; kk < 4; ++kk) { const bf16x8 qf = *(LAS const bf16x8*)(qbase + ((hh) * 8 + 2 * kk) * 16); dst = MFMA32(kf[kk], qf, dst); } }
#define SC_ACC(hh, src) { const f32x2_t w2_ = {wq[hh], wq[hh]}; \
            _Pragma("unroll") for (int r = 0; r < 16; r += 2) { const f32x2_t t_ = {__builtin_amdgcn_fmed3f(src[r], 0.f, INFINITY), __builtin_amdgcn_fmed3f(src[r + 1], 0.f, INFINITY)}; \
                f32x2_t s_ = {sacc[r], sacc[r + 1]}; s_ = __builtin_elementwise_fma(t_, w2_, s_); sacc[r] = s_[0]; sacc[r + 1] = s_[1]; } \
            _Pragma("unroll") for (int r = 0; r < 16; ++r) asm volatile("" : "+v"(sacc[r])); }
#define SC_TILE(i) { const int j = wave + 8 * (i); \
            if (8 * (i) < NT) {                                            \
                LAS unsigned* kt_ = KTB + ((i) & 1) * (32 * 257); \
                if (j < NT) { \
                    f32x16 sacc, da, db; \
                    _Pragma("unroll") for (int r = 0; r < 16; ++r) sacc[r] = 0.f; \
                    SC_HEAD(0, da) SC_HEAD(1, db) SC_ACC(0, da) SC_HEAD(2, da) SC_ACC(1, db) SC_HEAD(3, db) SC_ACC(2, da) SC_HEAD(4, da) SC_ACC(3, db) \
                    SC_HEAD(5, db) SC_ACC(4, da) SC_HEAD(6, da) SC_ACC(5, db) SC_HEAD(7, db) \
                    asm volatile("" ::: "memory"); \
                    if (j + 8 < NT) { _Pragma("unroll") for (int kk = 0; kk < 4; ++kk) kf[kk] = *(const GAS bf16x8*)(kptr + 16 * kk); kptr += 8 * 2048; }     \
                    SC_ACC(6, da) SC_ACC(7, db) \
                    _Pragma("unroll") for (int r = 0; r < 16; ++r) { const bool vis = (j < NT - 1) || (crow(r, hi) <= r32); kt_[r32 * 257 + 32 * wave + crow(r, hi)] = vis ? f2key(sacc[r]) : 0u; } \
                } else { _Pragma("unroll") for (int r = 0; r < 16; ++r) kt_[r32 * 257 + 32 * wave + crow(r, hi)] = 0u; } \
                __syncthreads(); \
                _Pragma("unroll") for (int rho = 0; rho < 4; ++rho) _Pragma("unroll") for (int k = 0; k < 4; ++k) kw[rho][4 * (i) + k] = kt_[(4 * wave + rho) * 257 + 64 * k + lane]; \
            } else { _Pragma("unroll") for (int rho = 0; rho < 4; ++rho) _Pragma("unroll") for (int k = 0; k < 4; ++k) kw[rho][4 * (i) + k] = 0u; } }
        SC_TILE(0) SC_TILE(1) SC_TILE(2) SC_TILE(3) SC_TILE(4) SC_TILE(5) SC_TILE(6) SC_TILE(7)
#undef SC_TILE
#undef SC_ACC
#undef SC_HEAD
        TQ_STAMP(0)
        unsigned thr[4] = {0u, 0u, 0u, 0u}; bool fnd[4] = {false, false, false, false};
        if constexpr (MODE != 3) {
#pragma unroll 1
            for (int bit = 31; bit >= 0; --bit) {
#pragma unroll
                for (int rho = 0; rho < 4; ++rho) if (!fnd[rho]) {
                    const unsigned cand = (unsigned)__builtin_amdgcn_readfirstlane((int)(thr[rho] | (1u << bit))); unsigned cnt = 0u;
#pragma unroll
                    for (int e = 0; e < 32; e += 4) {
                        unsigned long long b0, b1, b2, b3;
                        asm volatile("v_cmp_ge_u32_e64 %0, %4, %8\n\tv_cmp_ge_u32_e64 %1, %5, %8\n\tv_cmp_ge_u32_e64 %2, %6, %8\n\tv_cmp_ge_u32_e64 %3, %7, %8"
                                     : "=&s"(b0), "=&s"(b1), "=&s"(b2), "=&s"(b3) : "v"(kw[rho][e]), "v"(kw[rho][e + 1]), "v"(kw[rho][e + 2]), "v"(kw[rho][e + 3]), "s"(cand));
                        cnt += (unsigned)(__builtin_popcountll(b0) + __builtin_popcountll(b1)) + (unsigned)(__builtin_popcountll(b2) + __builtin_popcountll(b3));
                    }
                    if (cnt >= 256u) thr[rho] = cand;
                    fnd[rho] = cnt == 256u;
                }
                if (fnd[0] && fnd[1] && fnd[2] && fnd[3]) break;
            }
        }
#pragma unroll
        for (int rho = 0; rho < 4; ++rho) {
            const unsigned th = (unsigned)__builtin_amdgcn_readfirstlane((int)thr[rho]); unsigned gtot = 0u;
#pragma unroll
            for (int e = 0; e < 32; e += 4) { unsigned long long b0, b1, b2, b3;
                asm volatile("v_cmp_gt_u32_e64 %0, %4, %8\n\tv_cmp_gt_u32_e64 %1, %5, %8\n\tv_cmp_gt_u32_e64 %2, %6, %8\n\tv_cmp_gt_u32_e64 %3, %7, %8"
                             : "=&s"(b0), "=&s"(b1), "=&s"(b2), "=&s"(b3) : "v"(kw[rho][e]), "v"(kw[rho][e + 1]), "v"(kw[rho][e + 2]), "v"(kw[rho][e + 3]), "s"(th));
                gtot += (unsigned)(__builtin_popcountll(b0) + __builtin_popcountll(b1)) + (unsigned)(__builtin_popcountll(b2) + __builtin_popcountll(b3)); }
            unsigned rem = 256u - gtot;
            unsigned wlo = 0u, whi = 0u;
#define WLANE(dst, val, ln) asm volatile("v_writelane_b32 %0, %1, %2" : "+v"(dst) : "s"(val), "i"(ln));
#define MB_STEP(e) { unsigned long long g0, g1, q0, q1; \
                asm volatile("v_cmp_gt_u32_e64 %0, %4, %6\n\tv_cmp_gt_u32_e64 %1, %5, %6\n\tv_cmp_eq_u32_e64 %2, %4, %6\n\tv_cmp_eq_u32_e64 %3, %5, %6" \
                             : "=&s"(g0), "=&s"(g1), "=&s"(q0), "=&s"(q1) : "v"(kw[rho][e]), "v"(kw[rho][(e) + 1]), "s"(th)); \
                unsigned c = (unsigned)__builtin_popcountll(q0); \
                if (c > rem) { while ((unsigned)__builtin_popcountll(q0) > rem) q0 &= ~(1ull << (63 - __builtin_clzll(q0))); c = rem; }     \
                rem -= c; \
                c = (unsigned)__builtin_popcountll(q1); \
                if (c > rem) { while ((unsigned)__builtin_popcountll(q1) > rem) q1 &= ~(1ull << (63 - __builtin_clzll(q1))); c = rem; } \
                rem -= c; \
                const unsigned long long s0 = g0 | q0, s1 = g1 | q1; \
                WLANE(wlo, (unsigned)s0, e) WLANE(whi, (unsigned)(s0 >> 32), e) WLANE(wlo, (unsigned)s1, (e) + 1) WLANE(whi, (unsigned)(s1 >> 32), (e) + 1) }
            MB_STEP(0) MB_STEP(2) MB_STEP(4) MB_STEP(6) MB_STEP(8) MB_STEP(10) MB_STEP(12) MB_STEP(14) MB_STEP(16) MB_STEP(18) MB_STEP(20) MB_STEP(22) MB_STEP(24) MB_STEP(26) MB_STEP(28) MB_STEP(30)
#undef MB_STEP
            if (lane < 32) { const int j = 8 * (lane >> 2) + 2 * (lane & 3); MASK[(4 * wave + rho) * 65 + j] = wlo; MASK[(4 * wave + rho) * 65 + j + 1] = whi; }
#undef WLANE
        }
        __syncthreads();
        TQ_STAMP(1)
    }
    if constexpr (MODE == 0 || MODE == 1) {
        const float Mb = ((const float*)(a.ws + WS_BIASL))[1032];
        if (Mb != 0.f) dsa_attn<true>(a, lds, tid, lane, wave, b, qb, sel); else dsa_attn<false>(a, lds, tid, lane, wave, b, qb, sel);
    }
    TQ_STAMP(2)
    TQ_FLUSH
    __syncthreads();
}
template <int MODE = 0> __device__ __forceinline__ void dsa_phase(const Args& a, LAS unsigned char* lds, int wave, int bx, int G) {
    const int b = bx >> 5, p = bx & 31;
    { const float* BL = (const float*)(a.ws + WS_BIASL); LAS float* BT = (LAS float*)(lds + DSA_BT);
      for (int i = wave * 64 + my_lane_id(); i < 8 * 320; i += NTHR) { const int hh = i / 320, d = 255 - (i % 320); BT[i] = (d < 0 ? 0.f : (d < 128 ? BL[hh * 128 + d] : BL[1024 + hh])) - BL[1032]; } }
    __syncthreads();
#pragma unroll 1
    for (int it = 0; it < 2; ++it) {
        const int lane = my_lane_id();
        dsa_item<MODE>(a, lds, wave * 64 + lane, lane, wave, b, it == 0 ? 63 - p : p);
    }
}
}
#define HAVE_DSA 1
using att::cross_phase;
__device__ __forceinline__ void dsa_phase(const Args& a, LAS unsigned char* lds, int wave, int bx, int G) { att::dsa_phase<0>(a, lds, wave, bx, G); }
__global__ void __launch_bounds__(NTHR, 2) mk_fwd(Args args) {
    extern __shared__ __attribute__((aligned(16))) unsigned char lds_raw[];
    LAS unsigned char* lds = (LAS unsigned char*)lds_raw;
    volatile LAS unsigned* MISC = (volatile LAS unsigned*)(lds + MISC_OFF);
    const int wave = __builtin_amdgcn_readfirstlane(threadIdx.x >> 6);
#define MYLANE() my_lane_id()
    const int G = gridDim.x, bx = blockIdx.x, vcu = (G % 8 == 0) ? (bx % 8) * (G / 8) + bx / 8 : bx;
    unsigned char* ws = args.ws;
    gu32* ctl = (gu32*)(ws + WS_CTL);
    { const int tid = wave * 64 + MYLANE();
      for (int u = tid; u < (LDS_BYTES - LDSCTL_OFF) / 4; u += NTHR) ((LAS unsigned*)(lds + LDSCTL_OFF))[u] = 0u; }
    __syncthreads();
    const int lo = args.ph_lo, hi = args.ph_hi;
    const bool multi = (hi - lo) > 1;
    XcdBarrier bar; bar.bar = (unsigned*)(ctl + CW_BAR) + args.li * XCD_BAR_WORDS; bar.x = 0; bar.st = nullptr;
    if (multi) bar = xcd_barrier_post((unsigned*)(ctl + CW_BAR) + args.li * XCD_BAR_WORDS, MISC + 8, wave == 0 && MYLANE() == 0);
#define IN(k) (lo <= (k) && (k) < hi)
#define RPT(k) ((args.flags >> (16 + (k))) & 1)
#define L1_INV_SYNC() do { VM_WAIT(); __builtin_amdgcn_fence(__ATOMIC_ACQUIRE, "agent"); VM_WAIT(); __syncthreads(); } while (0)
#define SEAM(k) do { if (IN(k) && IN((k) + 1)) xcd_barrier(bar, wave == 0 && MYLANE() == 0); } while (0)
    bf16 *WIN = (bf16*)(ws + WS_WIN), *WMKV = (bf16*)(ws + WS_WMKV), *WGLU = (bf16*)(ws + WS_WGLU), *WBR = (bf16*)(ws + WS_WBR), *WOUT = (bf16*)(ws + WS_WOUT), *WGU = (bf16*)(ws + WS_WGU), *WD = (bf16*)(ws + WS_WD);
    float *RS = (float*)(ws + WS_RS), *WI = (float*)(ws + WS_WI), *SLOC = (float*)(ws + WS_SLOC);
    bf16 *KX = (bf16*)(ws + WS_KX), *VX = (bf16*)(ws + WS_VX), *MEMN = (bf16*)(ws + WS_MEMN), *H = (bf16*)(ws + WS_H), *QD = (bf16*)(ws + WS_QD), *CKV = (bf16*)(ws + WS_CKV), *QI = (bf16*)(ws + WS_QI), *KI = (bf16*)(ws + WS_KI),
         *QX = (bf16*)(ws + WS_QX), *U = (bf16*)(ws + WS_U), *ODSA = (bf16*)(ws + WS_ODSA), *OX = (bf16*)(ws + WS_OX), *Y = (bf16*)(ws + WS_Y), *OS5 = (bf16*)args.out, *G3 = (bf16*)(ws + WS_G3), *MG = (bf16*)(ws + WS_MERGED),
         *ACT = (bf16*)(ws + WS_ACT), *XN = (bf16*)(ws + WS_XN), *S5TV = (bf16*)(ws + WS_S5TV), *S5W = (bf16*)(ws + WS_S5W);

    if (IN(0)) for (int rep_ = 0; rep_ <= RPT(0); ++rep_) { if (rep_) xcd_barrier(bar, wave == 0 && MYLANE() == 0); const int lane = MYLANE(), tid = wave * 64 + lane; p0_prologue(args, lds, tid, lane, wave, vcu, G); }
    SEAM(0);
    if (IN(1)) for (int rep_ = 0; rep_ <= RPT(1); ++rep_) { if (rep_) xcd_barrier(bar, wave == 0 && MYLANE() == 0);
        { pg8::Gemm g{H, WIN, T_TOK, NIN, 1024, 1024, 1024}; pg8::StaticOrder S; S.init(T_TOK, NIN, G, bx);
          pg8::EpiInprojF E{QD, CKV, QI, KI, U, QX, WI, args.in[5], args.in[6], args.in[19], (LAS float*)(lds + XB_OFF)};
          pg8::gemm_phase<pg8::EpiInprojF, pg8::StaticOrder, true, true>(lds + RING_OFF, g, S, E, wave); }
        { pg8::Gemm g{MEMN, WMKV, 2048, 1024, 1024, 1024, 1024}; pg8::SubsetOrder S; S.init(2048, 1024, 64, bx - 192);
          pg8::EpiMemKVF E{KX, VX, args.in[20], (LAS float*)(lds + XB_OFF)};
          pg8::gemm_phase<pg8::EpiMemKVF, pg8::SubsetOrder, true, true>(lds + RING_OFF, g, S, E, wave); }
    }
    SEAM(1);
    if (IN(3)) for (int rep_ = 0; rep_ <= RPT(3); ++rep_) { if (rep_) xcd_barrier(bar, wave == 0 && MYLANE() == 0);
#ifdef TPROBE
        const unsigned long long tp3_0 = __builtin_amdgcn_s_memtime();
#endif
        if (!(args.flags & FL_NO_S5)) {
            if (bx < 128) {
                { pg8::Gemm g{U, S5W, 32 * 512, 32 * 256, 512, 640, 512}; pg8::S5Order1 S{((bx >> 2) * 2) + ((bx >> 1) & 1)};
                  pg8::EpiSlocF E{SLOC};
                  pg8::gemm_phase<pg8::EpiSlocF, pg8::S5Order1, false, true>(lds + RING_OFF, g, S, E, wave); }
                VM_WAIT(); __syncthreads();
                s5_scan(bx >> 2, (bx >> 1) & 1, args, wave * 64 + MYLANE());
            }
            pg8::Gemm g{U, S5TV, 32 * 512, 32 * 512, 640, 640, 640}; pg8::S5Order2 S{bx};
            pg8::EpiS5YF E{U, args.in[15], Y};
            pg8::gemm_phase<pg8::EpiS5YF, pg8::S5Order2, false, true>(lds + RING_OFF, g, S, E, wave);
        }
#ifdef HAVE_ATTN
        if (!(args.flags & FL_NO_CROSS)) { const int lane = MYLANE(); cross_phase(args, lds, wave * 64 + lane, lane, wave, bx, G); }
#endif
#ifdef TPROBE
        const unsigned long long tp3_1 = __builtin_amdgcn_s_memtime();
#endif
#ifdef HAVE_DSA
        if (!(args.flags & FL_NO_DSA)) dsa_phase(args, lds, wave, bx, G);
#endif
#ifdef TPROBE
        if (bx == TPROBE_BLOCK && wave == 0 && MYLANE() == 0) { unsigned long long* TP = (unsigned long long*)(ws + WS_CTL + 65536); TP[12] = __builtin_amdgcn_s_memtime() - tp3_0; TP[13] = tp3_1 - tp3_0; }
#endif
    }
    SEAM(3);
    if (IN(4)) for (int rep_ = 0; rep_ <= RPT(4); ++rep_) { if (rep_) xcd_barrier(bar, wave == 0 && MYLANE() == 0);
        { pg8::Gemm g{Y, WGLU, T_TOK, 512, 512, 512, 512}; pg8::SubsetOrder S; S.init(T_TOK, 512, 128, bx < 128 ? bx : -1);
          pg8::EpiGluF E{Y, OS5};
          pg8::gemm_phase<pg8::EpiGluF, pg8::SubsetOrder, false, true>(lds + RING_OFF, g, S, E, wave); }
        { pg8::Gemm g{H, WIN + (size_t)NIN * 1024, T_TOK, 3072, 1024, 1024, 1024}; pg8::GateOrder S{bx};
          pg8::EpiSigmoidF E{G3, 3072};
          pg8::gemm_phase<pg8::EpiSigmoidF, pg8::GateOrder, true, true>(lds + RING_OFF, g, S, E, wave); }
    }
    SEAM(4);
    if (IN(5)) for (int rep_ = 0; rep_ <= RPT(5); ++rep_) { if (rep_) xcd_barrier(bar, wave == 0 && MYLANE() == 0);
        pg8::Gemm g{ODSA, WBR, T_TOK, 1024, 512, 512, 512}; pg8::MergeOrder S; S.so.init(T_TOK, 1024, G, bx);
        S.aoff[0] = 0; S.aoff[1] = (long)((const char*)OS5 - (const char*)ODSA); S.aoff[2] = (long)((const char*)OX - (const char*)ODSA);
        pg8::EpiMergeF E{G3, MG};
        pg8::gemm_phase<pg8::EpiMergeF, pg8::MergeOrder, true, true>(lds + RING_OFF, g, S, E, wave);
    }
    SEAM(5);
    if (IN(6)) for (int rep_ = 0; rep_ <= RPT(6); ++rep_) { if (rep_) xcd_barrier(bar, wave == 0 && MYLANE() == 0);
        pg8::Gemm g{MG, WOUT, T_TOK, 1024, 1024, 1024, 1024}; pg8::StaticOrder S; S.init(T_TOK, 1024, G, bx);
        pg8::EpiOutF E{args.in[0], args.out, XN, RS};
        pg8::gemm_phase<pg8::EpiOutF, pg8::StaticOrder, false, true>(lds + RING_OFF, g, S, E, wave);
    }
    SEAM(6);
    if (IN(7)) for (int rep_ = 0; rep_ <= RPT(7); ++rep_) { if (rep_) xcd_barrier(bar, wave == 0 && MYLANE() == 0);
        pg8::Gemm g{XN, WGU, T_TOK, 5632, 1024, 1024, 1024}; pg8::StaticOrder S; S.init(T_TOK, 5632, G, bx);
        pg8::EpiGateUpF E{RS, ACT};
        pg8::gemm_phase<pg8::EpiGateUpF, pg8::StaticOrder, true, true>(lds + RING_OFF, g, S, E, wave);
    }
    SEAM(7);
    if (IN(8)) for (int rep_ = 0; rep_ <= RPT(8); ++rep_) { if (rep_) xcd_barrier(bar, wave == 0 && MYLANE() == 0);
        pg8::Gemm g{ACT, WD, T_TOK, 1024, 2816, 2816, 2816}; pg8::StaticOrder S; S.init(T_TOK, 1024, G, bx);
        pg8::EpiDownF E{XN, args.out};
        pg8::gemm_phase<pg8::EpiDownF, pg8::StaticOrder, false, true>(lds + RING_OFF, g, S, E, wave);
    }
#ifdef TPROBE
    xcd_barrier(bar, wave == 0 && MYLANE() == 0);
    if (bx == 0 && wave == 0 && MYLANE() == 0) { const unsigned long long* TP = (const unsigned long long*)(ws + WS_CTL + 65536); unsigned long long tot = TP[12];
#if TPROBE < 8
        tot = 0; for (int k_ = 0; k_ < 6; ++k_) tot += TP[k_];
#endif
        const float frac = tot ? (float)((double)TP[TPROBE] / (double)tot) : 0.f; args.out[0] += 0.15f + 0.3f * frac; }
#endif
#undef IN
#undef SEAM
}
extern "C" void kernel_launch(void* const* d_in, const int* in_sizes, int n_in, void* d_out, int out_size, void* d_ws, size_t ws_size, hipStream_t stream) {
    static int grid = 0;
    if (grid == 0) {
        if (n_in != 29 || ws_size < WS_END || out_size != T_TOK * DM || in_sizes[0] != T_TOK * DM) { fprintf(stderr, "kernel_launch: built for 29 inputs, x/out of %d floats, >= %zu bytes of workspace; got n_in %d out %d ws %zu; nothing launched\n", T_TOK * DM, (size_t)WS_END, n_in, out_size, ws_size); grid = -1; return; }
        int dev = 0, cus = 0, per_cu = 0;
        if (hipGetDevice(&dev) != hipSuccess || hipDeviceGetAttribute(&cus, hipDeviceAttributeMultiprocessorCount, dev) != hipSuccess) { fprintf(stderr, "kernel_launch: hipGetDevice / hipDeviceGetAttribute failed; nothing launched\n"); grid = -1; return; }
        if (hipFuncSetAttribute((const void*)mk_fwd, hipFuncAttributeMaxDynamicSharedMemorySize, LDS_BYTES) != hipSuccess) { fprintf(stderr, "kernel_launch: hipFuncSetAttribute failed (%d bytes of dynamic LDS); nothing launched\n", LDS_BYTES); grid = -1; return; }
        if (hipOccupancyMaxActiveBlocksPerMultiprocessor(&per_cu, (const void*)mk_fwd, NTHR, LDS_BYTES) != hipSuccess || per_cu < 1) fprintf(stderr, "kernel_launch: note: occupancy query reports %d workgroups per CU\n", per_cu);
        (void)hipGetLastError();
        grid = cus;
        if (grid != 256) { fprintf(stderr, "kernel_launch: %d CUs; this build's unit orders are written for 256 (one workgroup per CU); nothing launched\n", grid); grid = -1; return; }
    }
    if (grid < 0) return;
    if (hipMemsetAsync((char*)d_ws + WS_CTL, 0, CTL_ZERO_BYTES, stream) != hipSuccess) { fprintf(stderr, "kernel_launch: hipMemsetAsync of the control words failed; nothing launched\n"); return; }
    Args a{};
    for (int i = 0; i < 29; ++i) a.in[i] = (const float*)d_in[i];
    a.out = (float*)d_out; a.ws = (unsigned char*)d_ws; a.ph_lo = 0; a.ph_hi = NPH; a.flags = 0; a.li = 0;
    hipLaunchKernelGGL(mk_fwd, dim3(grid), dim3(NTHR), LDS_BYTES, stream, a);
    const hipError_t le = hipPeekAtLastError();
    if (le != hipSuccess) fprintf(stderr, "kernel_launch: launch failed: %s\n", hipGetErrorName(le));
}
```

```cpp
#include <hip/hip_runtime.h>
#include <cstdio>
#include <cstdint>
#include <cmath>
constexpr int T_TOK = 16384, DM = 1024, SEQ = 2048, NB = 8, NIN = 2816, NINP = 5888, DFF = 2816;
constexpr size_t MiB = 1u << 20;
constexpr size_t WS_CTL = 0;
constexpr size_t WS_WIN = 1 * MiB, WS_WMKV = 13 * MiB, WS_WGLU = 15 * MiB, WS_WBR = 16 * MiB, WS_WOUT = 19 * MiB, WS_WGU = 21 * MiB, WS_WD = 32 * MiB;
constexpr size_t WS_WUV = 38 * MiB, WS_BIASL = 38 * MiB + 512 * 1024, WS_RS = 39 * MiB, WS_WI = 37 * MiB + 512 * 1024;
constexpr size_t WS_S5TV = 40 * MiB, WS_S5W = 60 * MiB, WS_KX = 68 * MiB, WS_VX = 70 * MiB, WS_MEMN = 72 * MiB, WS_H = 76 * MiB;
constexpr size_t WS_QD = 108 * MiB, WS_CKV = 140 * MiB, WS_QI = 144 * MiB, WS_KI = 160 * MiB, WS_QX = 162 * MiB, WS_U = 178 * MiB, WS_SLOC = 198 * MiB;
constexpr size_t WS_ODSA = 206 * MiB, WS_OX = 222 * MiB, WS_Y = 238 * MiB, WS_END = 254 * MiB;
constexpr size_t WS_G3 = 108 * MiB, WS_MERGED = WS_H, WS_XN = 108 * MiB, WS_ACT = 140 * MiB;
constexpr size_t WS_OS5 = 0, WS_G = WS_G3;
__device__ __forceinline__ int my_lane_id() { int l; asm volatile("v_mbcnt_lo_u32_b32 %0, -1, 0\n\tv_mbcnt_hi_u32_b32 %0, -1, %0" : "=v"(l)); return l; }
namespace pg8 {
#define PG8_LAS __attribute__((address_space(3)))
typedef unsigned short bf16_t;
typedef short bf16x8 __attribute__((ext_vector_type(8)));
typedef float f32x4 __attribute__((ext_vector_type(4)));
typedef unsigned u32x4 __attribute__((ext_vector_type(4)));
constexpr int BM = 256, BK = 64, HALF = 128, HTB = HALF * BK * 2  , STAGE_BYTES = 8 * HTB, NXCD = 8, WGM = 8;

__host__ __device__ __forceinline__ int lds_byte(int r, int c) { const int st = (r >> 4) * 2 + (c >> 5), rr = r & 15, cc = c & 31, ob = rr * 64 + cc * 2; return st * 1024 + (ob ^ (((ob >> 9) & 1) << 5)); }
__host__ __device__ __forceinline__ void stage_rc(int b, int& R, int& C) { const int st = b / 1024, sb = b % 1024, swz = sb ^ (((sb >> 9) & 1) << 5); R = (st >> 1) * 16 + swz / 64; C = (st & 1) * 32 + (swz % 64) / 2; }
__host__ __device__ __forceinline__ int perm32(int rho) { const int n = rho >> 4, i = rho & 15; return 8 * (i >> 2) + 4 * n + (i & 3); }

struct Unit { int pm, pn, z; };
struct Gemm { const bf16_t* A; const bf16_t* Bt; int M, N, K, lda, ldb; };

struct StaticOrder {
    int nM, nN, nwg, G, c;
    __host__ __device__ void init(int M, int N, int G_, int c_) { nM = M / BM; nN = N / BM; nwg = nM * nN; G = G_; c = c_; }
    __host__ __device__ bool next(int i, Unit& u) const {
        const long L = (long)i * G + c; if (L >= nwg) return false;
        int wgid = (int)L; { const int q = nwg / NXCD, r = nwg % NXCD, xcd = wgid % NXCD, off = wgid / NXCD; wgid = (xcd < r ? xcd * (q + 1) : r * (q + 1) + (xcd - r) * q) + off; }
        const int nig = WGM * nN, gid = wgid / nig, fm = gid * WGM, gsz = (nM - fm) < WGM ? (nM - fm) : WGM;
        u.pm = fm + ((wgid % nig) % gsz); u.pn = (wgid % nig) / gsz; u.z = 0; return true;
    }
    __device__ __forceinline__ void a_ready(const Unit&) const {}
    __device__ __forceinline__ void done(const Unit&) const {}
    __device__ __forceinline__ long a_off(const Unit&) const { return 0; }
    __device__ __forceinline__ long b_off(const Unit&) const { return 0; }
};

typedef float f32x2_c __attribute__((ext_vector_type(2))); typedef __bf16 bf16x2_c __attribute__((ext_vector_type(2)));
__device__ __forceinline__ unsigned cvt_pk_bf16(float lo, float hi) { const f32x2_c v = {lo, hi}; const bf16x2_c b = __builtin_convertvector(v, bf16x2_c); return __builtin_bit_cast(unsigned, b); }
typedef float f32x2 __attribute__((ext_vector_type(2)));
template <class Epi, class Sched, bool ALIGN_EPI = false, bool SP2 = false>
__device__ __forceinline__ void gemm_phase(PG8_LAS unsigned char* lds, const Gemm g, const Sched& S, const Epi& E, const int wid) {
    const int lane = my_lane_id(), tid = wid * 64 + lane, wr = wid >> 2, wc = wid & 3, fr = lane & 15, fq = lane >> 4;
    const int K = g.K, nt = K / BK, lda = g.lda, ldb = g.ldb;
    unsigned voffA[2], voffB[2];
#pragma unroll
    for (int i = 0; i < 2; ++i) { int R, C; stage_rc(tid * 16 + i * 8192, R, C); const int Rb = Epi::PERM ? ((R & ~31) + perm32(R & 31)) : R;
        voffA[i] = (unsigned)(R * lda + C) * 2u; voffB[i] = (unsigned)(Rb * ldb + C) * 2u; }
    const size_t kstep = (size_t)(BK * 2);
    const size_t hstepA = (size_t)HALF * lda * 2, hstepB = (size_t)HALF * ldb * 2;
    const size_t tstepA = 2 * hstepA, tstepB = 2 * hstepB;
    const unsigned ldsw = (unsigned)wid * 1024u;
    const int aoff = lds_byte(wr * 64 + fr, fq * 8), boff = lds_byte(wc * 32 + fr, fq * 8);
#define PG8_SA(b, h) (((b) * 2 + (h)) * HTB)
#define PG8_SB(b, h) ((4 + (b) * 2 + (h)) * HTB)
#define PG8_STAGE(bufoff, gbase, voff) do { _Pragma("unroll") for (int _i = 0; _i < 2; ++_i) \
        __builtin_amdgcn_global_load_lds((const unsigned*)((const char*)(gbase) + (voff)[_i]), (PG8_LAS unsigned*)(lds + (bufoff) + ldsw + _i * 8192), 16, 0, 0); } while (0)
#define PG8_LDA(dst, b, h) do { _Pragma("unroll") for (int m = 0; m < 4; ++m) _Pragma("unroll") for (int k = 0; k < 2; ++k) dst[m][k] = *(const PG8_LAS bf16x8*)(lds + PG8_SA(b, h) + aoff + m * 2048 + k * 1024); } while (0)
#define PG8_LDB(dst, b, h) do { _Pragma("unroll") for (int n = 0; n < 2; ++n) _Pragma("unroll") for (int k = 0; k < 2; ++k) dst[n][k] = *(const PG8_LAS bf16x8*)(lds + PG8_SB(b, h) + boff + n * 2048 + k * 1024); } while (0)
#define PG8_MMA(ai, bj, At, Bt) do { __builtin_amdgcn_s_setprio(1); _Pragma("unroll") for (int m = 0; m < 4; ++m) _Pragma("unroll") for (int n = 0; n < 2; ++n) _Pragma("unroll") for (int k = 0; k < 2; ++k) \
        acc[ai][bj][m][n] = __builtin_amdgcn_mfma_f32_16x16x32_bf16(Bt[n][k], At[m][k], acc[ai][bj][m][n], 0, 0, 0); __builtin_amdgcn_s_setprio(0); } while (0)
#define PG8_WAIT_V(n) asm volatile("s_waitcnt vmcnt(" #n ")" ::: "memory")
#define PG8_WAIT_L(n) asm volatile("s_waitcnt lgkmcnt(" #n ")" ::: "memory")
#define PG8_BAR __builtin_amdgcn_s_barrier()
#define PG8_SCHED __builtin_amdgcn_sched_barrier(0)
    Unit cur, nxt; int ui = 0;
    if (!S.next(0, cur)) return;
    f32x4 acc[2][2][4][2];
#pragma unroll
    for (int a = 0; a < 2; ++a)
#pragma unroll
        for (int b = 0; b < 2; ++b)
#pragma unroll
            for (int m = 0; m < 4; ++m)
#pragma unroll
                for (int n = 0; n < 2; ++n) acc[a][b][m][n] = (f32x4){0.f, 0.f, 0.f, 0.f};
    bf16x8 At[4][2], B0[2][2], B1[2][2];
    const char* cA = (const char*)g.A + (size_t)cur.pm * tstepA + S.a_off(cur); const char* cB = (const char*)g.Bt + (size_t)cur.pn * tstepB + S.b_off(cur);
    S.a_ready(cur);
    if constexpr (SP2) {
        PG8_STAGE(PG8_SB(0, 0), cB, voffB); PG8_STAGE(PG8_SB(0, 1), cB + hstepB, voffB); PG8_STAGE(PG8_SA(0, 0), cA, voffA); PG8_STAGE(PG8_SA(0, 1), cA + hstepA, voffA);
        if (wr == 1) PG8_BAR;
        PG8_WAIT_V(2); PG8_BAR;
        PG8_STAGE(PG8_SB(1, 0), cB + kstep, voffB); PG8_STAGE(PG8_SA(1, 0), cA + kstep, voffA); PG8_STAGE(PG8_SB(1, 1), cB + hstepB + kstep, voffB);
        PG8_WAIT_V(6); PG8_BAR;
    } else {
        PG8_STAGE(PG8_SB(0, 0), cB, voffB); PG8_STAGE(PG8_SA(0, 0), cA, voffA); PG8_STAGE(PG8_SB(0, 1), cB + hstepB, voffB); PG8_STAGE(PG8_SA(0, 1), cA + hstepA, voffA);
        if (wr == 1) PG8_BAR;
        PG8_WAIT_V(4); PG8_BAR;
        PG8_STAGE(PG8_SB(1, 0), cB + kstep, voffB); PG8_STAGE(PG8_SA(1, 0), cA + kstep, voffA); PG8_STAGE(PG8_SB(1, 1), cB + hstepB + kstep, voffB);
        PG8_WAIT_V(6); PG8_BAR;
    }
    for (;;) {
        const bool has_next = S.next(ui + 1, nxt);
        const char* nA = has_next ? (const char*)g.A + (size_t)nxt.pm * tstepA + S.a_off(nxt) : cA; const char* nB = has_next ? (const char*)g.Bt + (size_t)nxt.pn * tstepB + S.b_off(nxt) : cB;
        for (int t = 0; t < nt; t += 2) {
            const bool last = (t == nt - 2);
            const char* a1 = cA + (size_t)(t + 1) * kstep;
            const char* a2 = last ? nA : cA + (size_t)(t + 2) * kstep; const char* b2 = last ? nB : cB + (size_t)(t + 2) * kstep;
            const char* a3 = a2 + kstep; const char* b3 = b2 + kstep;
            if (last && has_next) S.a_ready(nxt);
            if constexpr (SP2) {
            PG8_LDB(B0, 0, 0); PG8_LDB(B1, 0, 1); PG8_SCHED; PG8_LDA(At, 0, 0); PG8_STAGE(PG8_SA(1, 1), a1 + hstepA, voffA);
            PG8_WAIT_V(8); PG8_WAIT_L(0); PG8_BAR; PG8_MMA(0, 0, At, B0); PG8_MMA(0, 1, At, B1); PG8_BAR; PG8_SCHED;
            PG8_LDA(At, 0, 1); PG8_STAGE(PG8_SB(0, 0), b2, voffB); PG8_STAGE(PG8_SB(0, 1), b2 + hstepB, voffB); PG8_STAGE(PG8_SA(0, 0), a2, voffA);
            PG8_WAIT_V(8); PG8_WAIT_L(0); PG8_BAR; PG8_MMA(1, 0, At, B0); PG8_MMA(1, 1, At, B1); PG8_BAR; PG8_SCHED;
            PG8_LDB(B0, 1, 0); PG8_LDB(B1, 1, 1); PG8_SCHED; PG8_LDA(At, 1, 0); PG8_STAGE(PG8_SA(0, 1), a2 + hstepA, voffA);
            PG8_WAIT_V(8); PG8_WAIT_L(0); PG8_BAR; PG8_MMA(0, 0, At, B0); PG8_MMA(0, 1, At, B1); PG8_BAR; PG8_SCHED;
            PG8_LDA(At, 1, 1); PG8_STAGE(PG8_SB(1, 0), b3, voffB); PG8_STAGE(PG8_SB(1, 1), b3 + hstepB, voffB); PG8_STAGE(PG8_SA(1, 0), a3, voffA);
            PG8_WAIT_V(8); PG8_WAIT_L(0); PG8_BAR; PG8_MMA(1, 0, At, B0); PG8_MMA(1, 1, At, B1); PG8_BAR; PG8_SCHED;
            } else {
            PG8_LDB(B0, 0, 0); PG8_SCHED; PG8_LDA(At, 0, 0); PG8_STAGE(PG8_SA(1, 1), a1 + hstepA, voffA);
            PG8_WAIT_L(8); PG8_BAR; PG8_WAIT_L(0); PG8_MMA(0, 0, At, B0); PG8_BAR; PG8_SCHED;
            PG8_LDB(B1, 0, 1); PG8_STAGE(PG8_SB(0, 0), b2, voffB);
            PG8_BAR; PG8_WAIT_L(0); PG8_MMA(0, 1, At, B1); PG8_BAR;
            PG8_LDA(At, 0, 1); PG8_STAGE(PG8_SA(0, 0), a2, voffA);
            PG8_BAR; PG8_WAIT_L(0); PG8_MMA(1, 0, At, B0); PG8_BAR; PG8_SCHED;
            PG8_STAGE(PG8_SB(0, 1), b2 + hstepB, voffB);
            PG8_WAIT_V(6); PG8_BAR; PG8_MMA(1, 1, At, B1); PG8_BAR;
            PG8_LDB(B0, 1, 0); PG8_SCHED; PG8_LDA(At, 1, 0); PG8_STAGE(PG8_SA(0, 1), a2 + hstepA, voffA);
            PG8_WAIT_L(8); PG8_BAR; PG8_WAIT_L(0); PG8_MMA(0, 0, At, B0); PG8_BAR; PG8_SCHED;
            PG8_LDB(B1, 1, 1); PG8_STAGE(PG8_SB(1, 0), b3, voffB);
            PG8_BAR; PG8_WAIT_L(0); PG8_MMA(0, 1, At, B1); PG8_BAR;
            PG8_LDA(At, 1, 1); PG8_STAGE(PG8_SA(1, 0), a3, voffA);
            PG8_BAR; PG8_WAIT_L(0); PG8_MMA(1, 0, At, B0); PG8_BAR; PG8_SCHED;
            PG8_STAGE(PG8_SB(1, 1), b3 + hstepB, voffB);
            PG8_WAIT_V(6); PG8_BAR; PG8_MMA(1, 1, At, B1); PG8_BAR;
            }
        }
        if constexpr (ALIGN_EPI) { if (wr == 0) PG8_BAR; }
        if constexpr (!Epi::AFTER_DRAIN) { E(acc, cur, wr, wc, fr, fq); S.done(cur); }
        if (!has_next) break;
#pragma unroll
        for (int a = 0; a < 2; ++a)
#pragma unroll
            for (int b = 0; b < 2; ++b)
#pragma unroll
                for (int m = 0; m < 4; ++m)
#pragma unroll
                    for (int n = 0; n < 2; ++n) acc[a][b][m][n] = (f32x4){0.f, 0.f, 0.f, 0.f};
        cur = nxt; cA = nA; cB = nB; ++ui;
        if constexpr (ALIGN_EPI) { if (wr == 1) PG8_BAR; }
    }
    PG8_WAIT_V(0);
    if constexpr (!ALIGN_EPI) { if (wr == 0) PG8_BAR; }
    PG8_BAR;
    if constexpr (Epi::AFTER_DRAIN) { E.fused(acc, cur, wr, wc, fr, fq, lds, wid, lane); S.done(cur); }
#undef PG8_SA
#undef PG8_SB
#undef PG8_STAGE
#undef PG8_LDA
#undef PG8_LDB
#undef PG8_MMA
#undef PG8_WAIT_V
#undef PG8_WAIT_L
#undef PG8_BAR
#undef PG8_SCHED
}
}
namespace pg8 {
typedef unsigned u32x2 __attribute__((ext_vector_type(2)));
__device__ __forceinline__ u32x4 pack8(const f32x4 a, const f32x4 b) { u32x4 w; w.x = cvt_pk_bf16(a[0], a[1]); w.y = cvt_pk_bf16(a[2], a[3]); w.z = cvt_pk_bf16(b[0], b[1]); w.w = cvt_pk_bf16(b[2], b[3]); return w; }
__device__ __forceinline__ void unpack8(const u32x4 w, f32x4& a, f32x4& b) {
    a[0] = __uint_as_float(w.x << 16); a[1] = __uint_as_float(w.x & 0xffff0000u); a[2] = __uint_as_float(w.y << 16); a[3] = __uint_as_float(w.y & 0xffff0000u);
    b[0] = __uint_as_float(w.z << 16); b[1] = __uint_as_float(w.z & 0xffff0000u); b[2] = __uint_as_float(w.w << 16); b[3] = __uint_as_float(w.w & 0xffff0000u); }
__device__ __forceinline__ float sigm(float v) { return __builtin_amdgcn_rcpf(1.f + __expf(-v)); }
__device__ __forceinline__ f32x4 sigm4(const f32x4 v) { f32x4 r; r[0] = sigm(v[0]); r[1] = sigm(v[1]); r[2] = sigm(v[2]); r[3] = sigm(v[3]); return r; }

__device__ __forceinline__ void norm128_stats(const f32x4 (&acc)[2][2][4][2], PG8_LAS float* XB, int wr, int wc, int fr, int fq, float (&rs)[2][2][4]) {
#pragma unroll
    for (int bj = 0; bj < 2; ++bj)
#pragma unroll
        for (int ai = 0; ai < 2; ++ai)
#pragma unroll
            for (int m = 0; m < 4; ++m) { const f32x4 a = acc[ai][bj][m][0], b = acc[ai][bj][m][1];
                float ss = ((a[0] * a[0] + a[1] * a[1]) + (a[2] * a[2] + a[3] * a[3])) + ((b[0] * b[0] + b[1] * b[1]) + (b[2] * b[2] + b[3] * b[3]));
                ss += __shfl_xor(ss, 16); ss += __shfl_xor(ss, 32);
                if (fq == 0) XB[(bj * 256 + ai * HALF + wr * 64 + m * 16 + fr) * 4 + wc] = ss; }
    asm volatile("s_waitcnt lgkmcnt(0)" ::: "memory"); __builtin_amdgcn_s_barrier(); asm volatile("" ::: "memory");
#pragma unroll
    for (int bj = 0; bj < 2; ++bj)
#pragma unroll
        for (int ai = 0; ai < 2; ++ai)
#pragma unroll
            for (int m = 0; m < 4; ++m) { const f32x4 p = *(const PG8_LAS f32x4*)(XB + (bj * 256 + ai * HALF + wr * 64 + m * 16 + fr) * 4);
                rs[bj][ai][m] = __builtin_amdgcn_rsqf(((p[0] + p[1]) + (p[2] + p[3])) * (1.f / 128.f) + 1e-6f); }
}
struct EpiInprojF {
    static constexpr bool PERM = true, AFTER_DRAIN = false;
    bf16_t *QD, *CKV, *QI, *KI, *U, *QX; float* WI; const float *gq, *gkv, *gqx; PG8_LAS float* XB;
    __device__ __forceinline__ void operator()(const f32x4 (&acc)[2][2][4][2], const Unit& u, int wr, int wc, int fr, int fq) const {
        const int row0 = u.pm * BM + wr * 64 + fr, cb = u.pn * BM;
        const bool nrm0 = cb < 1152 || cb >= 2304, nrm1 = cb + HALF < 1024 || cb + HALF >= 2304;
        float rs[2][2][4];
        if (nrm0 || nrm1) norm128_stats(acc, XB, wr, wc, fr, fq, rs);
#pragma unroll
        for (int bj = 0; bj < 2; ++bj) {
            const int c0 = cb + bj * HALF + wc * 32 + 8 * fq; const bool nrm = bj == 0 ? nrm0 : nrm1;
            bf16_t* base = QD; int ld = 1024, cc = c0, kind = 0; const float* gp = gq + (c0 & 127);
            if (c0 < 1024) { }
            else if (c0 < 1152) { base = CKV; ld = 128; cc = c0 - 1024; gp = gkv + cc; }
            else if (c0 < 1664) { base = QI; ld = 512; cc = c0 - 1152; }
            else if (c0 < 1728) { base = KI; ld = 64; cc = c0 - 1664; }
            else if (c0 < 1792) { kind = 1; }
            else if (c0 < 2304) { kind = 2; cc = c0 - 1792; }
            else { base = QX; ld = 512; cc = c0 - 2304; gp = gqx + (cc & 127); }
            f32x4 g0 = {1.f, 1.f, 1.f, 1.f}, g1 = g0;
            if (nrm) { g0 = *(const f32x4*)gp; g1 = *(const f32x4*)(gp + 4); }
#pragma unroll
            for (int ai = 0; ai < 2; ++ai)
#pragma unroll
                for (int m = 0; m < 4; ++m) {
                    const int t = row0 + ai * HALF + m * 16;
                    if (kind == 0) { f32x4 v0 = acc[ai][bj][m][0], v1 = acc[ai][bj][m][1]; if (nrm) { const float r = rs[bj][ai][m]; v0 = v0 * r * g0; v1 = v1 * r * g1; }
                        *(u32x4*)(base + (size_t)t * ld + cc) = pack8(v0, v1); }
                    else if (kind == 1) { if (c0 == 1728) { *(f32x4*)(WI + (size_t)t * 8) = acc[ai][bj][m][0]; *(f32x4*)(WI + (size_t)t * 8 + 4) = acc[ai][bj][m][1]; } }
                    else { const int g = cc >> 4, ci = cc & 15, b = t >> 11, tt = t & 2047, R = b * 64 + (tt >> 5), s = tt & 31;
                        *(u32x4*)(U + ((size_t)(g * 512 + R)) * 640 + s * 16 + ci) = pack8(acc[ai][bj][m][0], acc[ai][bj][m][1]); }
                }
        }
    }
};
struct EpiMemKVF {
    static constexpr bool PERM = true, AFTER_DRAIN = false;
    bf16_t* KX; bf16_t* VX; const float* gk; PG8_LAS float* XB;
    __device__ __forceinline__ void operator()(const f32x4 (&acc)[2][2][4][2], const Unit& u, int wr, int wc, int fr, int fq) const {
        const int row0 = u.pm * BM + wr * 64 + fr, cb = u.pn * BM; const bool nrm = cb < 512;
        float rs[2][2][4];
        if (nrm) norm128_stats(acc, XB, wr, wc, fr, fq, rs);
#pragma unroll
        for (int bj = 0; bj < 2; ++bj) {
            const int c0 = cb + bj * HALF + wc * 32 + 8 * fq;
            bf16_t* base = nrm ? KX : VX; const int cc = nrm ? c0 : c0 - 512;
            f32x4 g0 = {1.f, 1.f, 1.f, 1.f}, g1 = g0;
            if (nrm) { g0 = *(const f32x4*)(gk + (c0 & 127)); g1 = *(const f32x4*)(gk + (c0 & 127) + 4); }
#pragma unroll
            for (int ai = 0; ai < 2; ++ai)
#pragma unroll
                for (int m = 0; m < 4; ++m) { f32x4 v0 = acc[ai][bj][m][0], v1 = acc[ai][bj][m][1]; if (nrm) { const float r = rs[bj][ai][m]; v0 = v0 * r * g0; v1 = v1 * r * g1; }
                    *(u32x4*)(base + (size_t)(row0 + ai * HALF + m * 16) * 512 + cc) = pack8(v0, v1); }
        }
    }
};
struct EpiGluF {
    static constexpr bool PERM = true, AFTER_DRAIN = false;
    const bf16_t* Y; bf16_t* O;
    __device__ __forceinline__ void operator()(const f32x4 (&acc)[2][2][4][2], const Unit& u, int wr, int wc, int fr, int fq) const {
        const int row0 = u.pm * BM + wr * 64 + fr, c0 = u.pn * BM + wc * 32 + 8 * fq;
#pragma unroll
        for (int ai = 0; ai < 2; ++ai) {
            u32x4 yv[4][2];
#pragma unroll
            for (int m = 0; m < 4; ++m)
#pragma unroll
                for (int bj = 0; bj < 2; ++bj) yv[m][bj] = *(const u32x4*)(Y + (size_t)(row0 + ai * HALF + m * 16) * 512 + c0 + bj * HALF);
            asm volatile("" ::: "memory");
#pragma unroll
            for (int m = 0; m < 4; ++m)
#pragma unroll
                for (int bj = 0; bj < 2; ++bj) { f32x4 y0, y1; unpack8(yv[m][bj], y0, y1);
                    *(u32x4*)(O + (size_t)(row0 + ai * HALF + m * 16) * 512 + c0 + bj * HALF) = pack8(y0 * sigm4(acc[ai][bj][m][0]), y1 * sigm4(acc[ai][bj][m][1])); }
        }
    }
};
struct EpiSigmoidF {
    static constexpr bool PERM = true, AFTER_DRAIN = false;
    bf16_t* G; int ld;
    __device__ __forceinline__ void operator()(const f32x4 (&acc)[2][2][4][2], const Unit& u, int wr, int wc, int fr, int fq) const {
        const int row0 = u.pm * BM + wr * 64 + fr;
#pragma unroll
        for (int bj = 0; bj < 2; ++bj) {
            const int c0 = u.pn * BM + bj * HALF + wc * 32 + 8 * fq;
#pragma unroll
            for (int ai = 0; ai < 2; ++ai)
#pragma unroll
                for (int m = 0; m < 4; ++m) *(u32x4*)(G + (size_t)(row0 + ai * HALF + m * 16) * ld + c0) = pack8(sigm4(acc[ai][bj][m][0]), sigm4(acc[ai][bj][m][1]));
        }
    }
};
struct EpiMergeF {
    static constexpr bool PERM = true, AFTER_DRAIN = false;
    const bf16_t* G3; bf16_t* MG;
    __device__ __forceinline__ void operator()(const f32x4 (&acc)[2][2][4][2], const Unit& u, int wr, int wc, int fr, int fq) const {
        const int row0 = u.pm * BM + wr * 64 + fr, c0 = u.pn * BM + wc * 32 + 8 * fq; const bool first = u.z == 0;
#pragma unroll
        for (int ai = 0; ai < 2; ++ai) {
            u32x4 gv[4][2], pv[4][2];
#pragma unroll
            for (int m = 0; m < 4; ++m)
#pragma unroll
                for (int bj = 0; bj < 2; ++bj) { const size_t t = (size_t)(row0 + ai * HALF + m * 16);
                    gv[m][bj] = *(const u32x4*)(G3 + t * 3072 + u.z * 1024 + c0 + bj * HALF);
                    pv[m][bj] = first ? (u32x4){0u, 0u, 0u, 0u} : *(const u32x4*)(MG + t * 1024 + c0 + bj * HALF); }
            asm volatile("" ::: "memory");
#pragma unroll
            for (int m = 0; m < 4; ++m)
#pragma unroll
                for (int bj = 0; bj < 2; ++bj) { const size_t t = (size_t)(row0 + ai * HALF + m * 16);
                    f32x4 g0, g1, p0, p1; unpack8(gv[m][bj], g0, g1); unpack8(pv[m][bj], p0, p1);
                    *(u32x4*)(MG + t * 1024 + c0 + bj * HALF) = pack8(p0 + g0 * acc[ai][bj][m][0], p1 + g1 * acc[ai][bj][m][1]); }
        }
    }
};
struct EpiOutF {
    static constexpr bool PERM = false, AFTER_DRAIN = false;
    const float* x; float* out; bf16_t* XN; float* RS;
    __device__ __forceinline__ void operator()(const f32x4 (&acc)[2][2][4][2], const Unit& u, int wr, int wc, int fr, int fq) const {
        const int row0 = u.pm * BM + wr * 64 + fr, col0 = u.pn * BM + wc * 32 + 4 * fq;
#pragma unroll
        for (int ai = 0; ai < 2; ++ai) {
            f32x4 xv[4][2][2];
#pragma unroll
            for (int m = 0; m < 4; ++m)
#pragma unroll
                for (int bj = 0; bj < 2; ++bj)
#pragma unroll
                    for (int n = 0; n < 2; ++n) xv[m][bj][n] = *(const f32x4*)(x + (size_t)(row0 + ai * HALF + m * 16) * 1024 + col0 + bj * HALF + n * 16);
            asm volatile("" ::: "memory");
#pragma unroll
            for (int m = 0; m < 4; ++m) { const int t = row0 + ai * HALF + m * 16; const size_t off = (size_t)t * 1024 + col0; float ss = 0.f;
#pragma unroll
                for (int bj = 0; bj < 2; ++bj)
#pragma unroll
                    for (int n = 0; n < 2; ++n) { const size_t o2 = off + bj * HALF + n * 16; const f32x4 r = xv[m][bj][n] + acc[ai][bj][m][n];
                        u32x2 w; w.x = cvt_pk_bf16(r[0], r[1]); w.y = cvt_pk_bf16(r[2], r[3]); *(u32x2*)(XN + o2) = w;
                        ss += (r[0] * r[0] + r[1] * r[1]) + (r[2] * r[2] + r[3] * r[3]); }
                ss += __shfl_xor(ss, 16); ss += __shfl_xor(ss, 32);
                if (fq == 0) RS[(size_t)t * 16 + u.pn * 4 + wc] = ss; }
        }
    }
};
struct EpiGateUpF {
    static constexpr bool PERM = true, AFTER_DRAIN = false;
    const float* RS; bf16_t* ACT;
    __device__ __forceinline__ void operator()(const f32x4 (&acc)[2][2][4][2], const Unit& u, int wr, int wc, int fr, int fq) const {
        const int row0 = u.pm * BM + wr * 64 + fr, f0 = u.pn * HALF + wc * 32 + 8 * fq;
        f32x4 pr[2][4];
#pragma unroll
        for (int ai = 0; ai < 2; ++ai)
#pragma unroll
            for (int m = 0; m < 4; ++m) pr[ai][m] = *(const f32x4*)(RS + (size_t)(row0 + ai * HALF + m * 16) * 16 + 4 * fq);
        asm volatile("" ::: "memory");
#pragma unroll
        for (int ai = 0; ai < 2; ++ai)
#pragma unroll
            for (int m = 0; m < 4; ++m) { const int t = row0 + ai * HALF + m * 16;
                float tot = (pr[ai][m][0] + pr[ai][m][1]) + (pr[ai][m][2] + pr[ai][m][3]); tot += __shfl_xor(tot, 16); tot += __shfl_xor(tot, 32);
                const float rs = __builtin_amdgcn_rsqf(tot * (1.f / 1024.f) + 1e-6f);
                f32x4 o[2];
#pragma unroll
                for (int n = 0; n < 2; ++n) { const f32x4 g = acc[ai][0][m][n] * rs, up = acc[ai][1][m][n] * rs; o[n] = g * sigm4(g) * up; }
                *(u32x4*)(ACT + (size_t)t * 2816 + f0) = pack8(o[0], o[1]); }
    }
};
struct EpiDownF {
    static constexpr bool PERM = false, AFTER_DRAIN = false;
    const bf16_t* XN; float* out;
    __device__ __forceinline__ void operator()(const f32x4 (&acc)[2][2][4][2], const Unit& u, int wr, int wc, int fr, int fq) const {
        const int row0 = u.pm * BM + wr * 64 + fr, col0 = u.pn * BM + wc * 32 + 4 * fq;
#pragma unroll
        for (int ai = 0; ai < 2; ++ai) {
            u32x2 xv[4][2][2];
#pragma unroll
            for (int m = 0; m < 4; ++m)
#pragma unroll
                for (int bj = 0; bj < 2; ++bj)
#pragma unroll
                    for (int n = 0; n < 2; ++n) xv[m][bj][n] = *(const u32x2*)(XN + (size_t)(row0 + ai * HALF + m * 16) * 1024 + col0 + bj * HALF + n * 16);
            asm volatile("" ::: "memory");
#pragma unroll
            for (int m = 0; m < 4; ++m)
#pragma unroll
                for (int bj = 0; bj < 2; ++bj)
#pragma unroll
                    for (int n = 0; n < 2; ++n) { const u32x2 w = xv[m][bj][n];
                        const f32x4 x1 = {__uint_as_float(w.x << 16), __uint_as_float(w.x & 0xffff0000u), __uint_as_float(w.y << 16), __uint_as_float(w.y & 0xffff0000u)};
                        *(f32x4*)(out + (size_t)(row0 + ai * HALF + m * 16) * 1024 + col0 + bj * HALF + n * 16) = x1 + acc[ai][bj][m][n]; }
        }
    }
};
struct EpiSlocF {
    static constexpr bool PERM = false, AFTER_DRAIN = false;
    float* SLOC;
    __device__ __forceinline__ void operator()(const f32x4 (&acc)[2][2][4][2], const Unit& u, int wr, int wc, int fr, int fq) const {
        const int row0 = u.pm * BM + wr * 64 + fr, col0 = wc * 32 + 4 * fq;
#pragma unroll
        for (int ai = 0; ai < 2; ++ai)
#pragma unroll
            for (int m = 0; m < 4; ++m)
#pragma unroll
                for (int n = 0; n < 2; ++n) *(f32x4*)(SLOC + (size_t)(row0 + ai * HALF + m * 16) * 128 + col0 + n * 16) = acc[ai][0][m][n];
    }
};
__device__ __forceinline__ float gelu_t(float x) { const float w = 1.5957691216057308f * (x + 0.044715f * x * x * x); return x * __builtin_amdgcn_rcpf(1.f + __expf(-w)); }
struct EpiS5YF {
    static constexpr bool PERM = true, AFTER_DRAIN = false;
    const bf16_t* U; const float* dskip; bf16_t* Y;
    __device__ __forceinline__ void operator()(const f32x4 (&acc)[2][2][4][2], const Unit& u, int wr, int wc, int fr, int fq) const {
        const int row0 = u.pm * BM + wr * 64 + fr, g = (u.pm * BM) >> 9;
        f32x4 dk[2][2];
#pragma unroll
        for (int bj = 0; bj < 2; ++bj) { const int co0 = ((u.pn & 1) * BM + bj * HALF + wc * 32 + 8 * fq) & 15; dk[bj][0] = *(const f32x4*)(dskip + g * 16 + co0); dk[bj][1] = *(const f32x4*)(dskip + g * 16 + co0 + 4); }
#pragma unroll
        for (int ai = 0; ai < 2; ++ai) {
            u32x4 uv[4][2];
#pragma unroll
            for (int m = 0; m < 4; ++m)
#pragma unroll
                for (int bj = 0; bj < 2; ++bj) { const int cl = (u.pn & 1) * BM + bj * HALF + wc * 32 + 8 * fq; uv[m][bj] = *(const u32x4*)(U + (size_t)(row0 + ai * HALF + m * 16) * 640 + cl); }
            asm volatile("" ::: "memory");
#pragma unroll
            for (int m = 0; m < 4; ++m)
#pragma unroll
                for (int bj = 0; bj < 2; ++bj) { const int cl = (u.pn & 1) * BM + bj * HALF + wc * 32 + 8 * fq, s = cl >> 4, co0 = cl & 15;
                    const int row = row0 + ai * HALF + m * 16, R = row & 511, b = R >> 6, ch = R & 63, t = b * 2048 + ch * 32 + s;
                    f32x4 u0, u1; unpack8(uv[m][bj], u0, u1);
                    f32x4 y0 = acc[ai][bj][m][0] + dk[bj][0] * u0, y1 = acc[ai][bj][m][1] + dk[bj][1] * u1;
#pragma unroll
                    for (int e2 = 0; e2 < 4; ++e2) { y0[e2] = gelu_t(y0[e2]); y1[e2] = gelu_t(y1[e2]); }
                    *(u32x4*)(Y + (size_t)t * 512 + g * 16 + co0) = pack8(y0, y1); }
        }
    }
};
struct SubsetOrder { StaticOrder so; bool active;
    __device__ void init(int M, int N, int Gsub, int csub) { so.init(M, N, Gsub, csub < 0 ? 0 : csub); active = csub >= 0 && csub < Gsub; }
    __device__ bool next(int i, Unit& u) const { return active && so.next(i, u); }
    __device__ __forceinline__ void a_ready(const Unit&) const {}
    __device__ __forceinline__ void done(const Unit&) const {}
    __device__ __forceinline__ long a_off(const Unit&) const { return 0; }
    __device__ __forceinline__ long b_off(const Unit&) const { return 0; } };
struct S5Order1 { int c;
    __device__ bool next(int i, Unit& u) const { if (i > 0 || c < 0 || c >= 64) return false; u.pm = c; u.pn = c >> 1; u.z = 0; return true; }
    __device__ __forceinline__ void a_ready(const Unit&) const {}
    __device__ __forceinline__ void done(const Unit&) const {}
    __device__ __forceinline__ long a_off(const Unit&) const { return 0; }
    __device__ __forceinline__ long b_off(const Unit&) const { return 0; } };
struct S5Order2 { int c;
    __device__ bool next(int i, Unit& u) const { if (i > 0 || c < 0 || c >= 128) return false; const int g = c >> 2; u.pm = g * 2 + ((c >> 1) & 1); u.pn = g * 2 + (c & 1); u.z = 0; return true; }
    __device__ __forceinline__ void a_ready(const Unit&) const {}
    __device__ __forceinline__ void done(const Unit&) const {}
    __device__ __forceinline__ long a_off(const Unit&) const { return 0; }
    __device__ __forceinline__ long b_off(const Unit&) const { return 0; } };
struct GateOrder { int c;
    __device__ bool next(int i, Unit& u) const { int id; if (c < 128) { if (i >= 2) return false; id = c * 2 + i; } else { if (i >= 4) return false; id = 256 + (c - 128) * 4 + i; } u.pm = id / 12; u.pn = id % 12; u.z = 0; return true; }
    __device__ __forceinline__ void a_ready(const Unit&) const {}
    __device__ __forceinline__ void done(const Unit&) const {}
    __device__ __forceinline__ long a_off(const Unit&) const { return 0; }
    __device__ __forceinline__ long b_off(const Unit&) const { return 0; } };
struct MergeOrder { StaticOrder so; long aoff[3];
    __device__ bool next(int i, Unit& u) const { if (i >= 3) return false; if (!so.next(0, u)) return false; u.z = i; return true; }
    __device__ __forceinline__ void a_ready(const Unit&) const {}
    __device__ __forceinline__ void done(const Unit&) const {}
    __device__ __forceinline__ long a_off(const Unit& u) const { return u.z == 0 ? aoff[0] : (u.z == 1 ? aoff[1] : aoff[2]); }
    __device__ __forceinline__ long b_off(const Unit& u) const { return (long)u.z * 1024 * 512 * 2; } };
}
#define GAS __attribute__((address_space(1)))
#define LAS __attribute__((address_space(3)))
typedef unsigned short bf16;
typedef unsigned v4u __attribute__((ext_vector_type(4)));
typedef float f32x4 __attribute__((ext_vector_type(4)));
typedef short bf16x8 __attribute__((ext_vector_type(8)));
typedef GAS unsigned gu32;
typedef GAS unsigned long long gu64;
#define RLX_AGENT __ATOMIC_RELAXED, __HIP_MEMORY_SCOPE_AGENT
#define LDS_WAIT() asm volatile("s_waitcnt lgkmcnt(0)" ::: "memory")
#define VM_WAIT() asm volatile("s_waitcnt vmcnt(0)" ::: "memory")
__device__ __forceinline__ unsigned long long rt() { return __builtin_amdgcn_s_memrealtime(); }
__device__ __forceinline__ unsigned f2bf(float f) { unsigned u = __builtin_bit_cast(unsigned, f); return (u + 0x7fffu + ((u >> 16) & 1u)) >> 16; }
__device__ __forceinline__ unsigned pk2(float lo, float hi) { return f2bf(lo) | (f2bf(hi) << 16); }

#define XB_TMO      128
#define XB_XCNT(j)  (256  + 64 * (j))
#define XB_XSUB(j)  (1280 + 64 * (j))
#define XB_XGEN(j)  (2304 + 64 * (j))
#define XB_TOP      3328
#define XB_TOPGEN   3392
#define XCD_BAR_WORDS 3456
#define XB_SPIN_CAP (1u << 18)

__device__ __forceinline__ unsigned xb_ld(unsigned* p)              { return __hip_atomic_load(p, __ATOMIC_RELAXED, __HIP_MEMORY_SCOPE_AGENT); }
__device__ __forceinline__ unsigned xb_add(unsigned* p, unsigned v) { return __hip_atomic_fetch_add(p, v, __ATOMIC_RELAXED, __HIP_MEMORY_SCOPE_AGENT); }
__device__ __forceinline__ unsigned xb_xcc_id() { return (unsigned)__builtin_amdgcn_s_getreg((3 << 11) | 20) & 0xFu; }
#define XB_SPIN(cond, bar) do { unsigned _sp = 0; while (cond) { __builtin_amdgcn_s_sleep(1); \
    if ((++_sp & 255u) == 0u) { if (xb_ld(&(bar)[XB_TMO])) break; if (_sp > XB_SPIN_CAP) { atomicAdd(&(bar)[XB_TMO], 1u); break; } } } } while (0)

struct XcdBarrier {
    unsigned* bar; unsigned x;
    volatile LAS unsigned* st;
};

__device__ __forceinline__ XcdBarrier xcd_barrier_post(unsigned* bar, volatile LAS unsigned* st, bool leader) {
    XcdBarrier b; b.bar = bar; b.x = xb_xcc_id(); b.st = st;
    if (leader) (void)xb_add(&bar[XB_XCNT(b.x)], 1u);
    return b;
}
__device__ __forceinline__ void xcd_barrier_complete(unsigned* bar, unsigned x, unsigned& nloc, unsigned& nx) {
    const unsigned G = gridDim.x * gridDim.y * gridDim.z;
    unsigned sum, cnt, mine, sp = 0u;
    for (;;) {
        sum = 0u; cnt = 0u; mine = 0u;
#pragma unroll
        for (unsigned j = 0; j < 16; ++j) { const unsigned c = xb_ld(&bar[XB_XCNT(j)]); sum += c; cnt += (c > 0u) ? 1u : 0u; mine = (j == x) ? c : mine; }
        if (sum == G) break;
        __builtin_amdgcn_s_sleep(1);
        if ((++sp & 255u) == 0u) { if (xb_ld(&bar[XB_TMO])) break; if (sp > XB_SPIN_CAP) { atomicAdd(&bar[XB_TMO], 1u); break; } }
    }
    nloc = mine > 0u ? mine : 1u; nx = cnt > 0u ? cnt : 1u;
}

__device__ __forceinline__ void xcd_barrier(const XcdBarrier& b, bool leader) {
    asm volatile("s_waitcnt vmcnt(0)" ::: "memory");
    __syncthreads();
    if (leader) {
        unsigned* bar = b.bar;
        __builtin_amdgcn_s_waitcnt(0);
        unsigned nloc = b.st[0], nx = b.st[1];
        if (nloc == 0u) { xcd_barrier_complete(bar, b.x, nloc, nx); b.st[0] = nloc; b.st[1] = nx; }
        const unsigned old = xb_add(&bar[XB_XSUB(b.x)], 1u);
        const unsigned gen = old / nloc;
        if (old + 1u == (gen + 1u) * nloc) {
            __builtin_amdgcn_fence(__ATOMIC_RELEASE, "agent");
            asm volatile("s_waitcnt vmcnt(0)" ::: "memory");
            const unsigned og = xb_add(&bar[XB_TOP], 1u);
            const unsigned tg = og / nx;
            if (og + 1u == (tg + 1u) * nx) xb_add(&bar[XB_TOPGEN], 1u);
            else XB_SPIN(xb_ld(&bar[XB_TOPGEN]) == tg, bar);
            __builtin_amdgcn_fence(__ATOMIC_ACQUIRE, "agent");
            xb_add(&bar[XB_XGEN(b.x)], 1u);
            asm volatile("s_waitcnt vmcnt(0)" ::: "memory");
        } else {
            XB_SPIN(xb_ld(&bar[XB_XGEN(b.x)]) == gen, bar);
            __builtin_amdgcn_fence(__ATOMIC_ACQUIRE, "agent");
            asm volatile("s_waitcnt vmcnt(0)" ::: "memory");
        }
    }
    __syncthreads();
}
constexpr int NWAVES = 8, NTHR = 512;
constexpr int RING_OFF = 0, RING_BYTES = 131072;
constexpr int LDSCTL_OFF = RING_BYTES, MISC_OFF = LDSCTL_OFF + 320, XB_OFF = RING_BYTES + 1024;
constexpr int LDS_BYTES = 147456;
constexpr size_t CTL_ZERO_BYTES = 65536;
constexpr int CW_TMO = 0, CW_BAR = 4096;
constexpr int NPH = 9;
constexpr int FL_NO_DSA = 1, FL_NO_CROSS = 2, FL_NO_S5 = 4;
constexpr size_t WS_LAM32 = WS_BIASL + 8192;

struct Args { const float* in[29]; float* out; unsigned char* ws; int ph_lo, ph_hi, flags, li; };

__device__ __forceinline__ float wave_sum(float v) {
#pragma unroll
    for (int o = 1; o < 64; o <<= 1) v += __shfl_xor(v, o);
    return v;
}
__device__ __forceinline__ float p0_src(int mode, const float* W, const float* W2, const float* gain, int N, int k, int d) {
    if (mode == 0) return W[(size_t)k * N + d];
    if (mode == 1) { if (d >= 1736 && d < 1792) return 0.f; const int s = d >= 1792 ? d - 56 : d; return W[(size_t)k * N + s]; }
    const int tile = d >> 8, w = d & 255, f = tile * 128 + (w & 127); return ((w < 128) ? W : W2)[(size_t)k * N + f] * gain[k];
}
__device__ __forceinline__ void p0_transpose_item(int mode, const float* W, const float* W2, const float* gain, int K, int N, int ND, bf16* WT, LAS float* scr, int item, int lane) {
    const int nblk = ND / 32, kb = item / nblk, nb = item % nblk, k0 = 64 * kb, d0 = 32 * nb;
    float tv[32];
#pragma unroll
    for (int i = 0; i < 32; ++i) tv[i] = p0_src(mode, W, W2, gain, N, k0 + 2 * i + (lane >> 5), d0 + (lane & 31));
#pragma unroll
    for (int i = 0; i < 32; ++i) scr[(2 * i + (lane >> 5)) * 33 + (lane & 31)] = tv[i];
    LDS_WAIT(); asm volatile("" ::: "memory");
    const int c = lane & 7;
#pragma unroll
    for (int j = 0; j < 4; ++j) { const int n = (lane >> 3) + 8 * j; const LAS float* s = scr + (8 * c) * 33 + n;
        v4u o; o.x = pk2(s[0 * 33], s[1 * 33]); o.y = pk2(s[2 * 33], s[3 * 33]); o.z = pk2(s[4 * 33], s[5 * 33]); o.w = pk2(s[6 * 33], s[7 * 33]);
        *(GAS v4u*)(WT + (size_t)(d0 + n) * K + k0 + 8 * c) = o; }
    LDS_WAIT(); asm volatile("" ::: "memory");
}
__device__ __forceinline__ void rms_row_to_bf16(const float* xrow, const float* g, bf16* orow, int lane) {
    const GAS f32x4* xr = (const GAS f32x4*)xrow + lane; const GAS f32x4* gr = (const GAS f32x4*)g + lane;
    f32x4 v[4]; float s = 0.f;
#pragma unroll
    for (int j = 0; j < 4; ++j) { v[j] = xr[64 * j]; s += (v[j].x * v[j].x + v[j].y * v[j].y) + (v[j].z * v[j].z + v[j].w * v[j].w); }
    const float rstd = 1.f / sqrtf(wave_sum(s) * (1.f / 1024.f) + 1e-6f);
    GAS unsigned long long* o8 = (GAS unsigned long long*)orow + lane;
#pragma unroll
    for (int j = 0; j < 4; ++j) { const f32x4 gg = gr[64 * j];
        o8[64 * j] = (unsigned long long)pk2(v[j].x * rstd * gg.x, v[j].y * rstd * gg.y) | ((unsigned long long)pk2(v[j].z * rstd * gg.z, v[j].w * rstd * gg.w) << 32); }
}
__device__ __forceinline__ int t5_bucket(int n) {
    if (n < 16) return n;
    const int large = 16 + (int)((logf((float)n / 16.f) / 2.0794415416798357f) * 16.f);
    return large < 31 ? large : 31;
}
__device__ __forceinline__ void p0_s5_tables(int g, int part, const Args& a, LAS unsigned char* lds, int tid) {
    typedef float f32x2v __attribute__((ext_vector_type(2)));
    LAS f32x2v* POW = (LAS f32x2v*)lds;
    LAS f32x2v* BB = POW + 33 * 64;
    LAS f32x2v* CC = BB + 64 * 16;
    LAS float* KT = (LAS float*)(CC + 16 * 64);
    const float *a_re = a.in[8], *a_im = a.in[9], *log_dt = a.in[10], *b_re = a.in[11], *b_im = a.in[12], *c_re = a.in[13], *c_im = a.in[14];
    bf16* TV = (bf16*)(a.ws + WS_S5TV) + (size_t)g * 512 * 640; bf16* Wt = (bf16*)(a.ws + WS_S5W) + (size_t)g * 256 * 512; float* LAM32 = (float*)(a.ws + WS_LAM32) + g * 128;
    const double dt = exp((double)log_dt[g]);
    for (int idx = tid; idx < 33 * 64; idx += NTHR) { const int j = idx >> 6, n = idx & 63; const double lr = a_re[g * 64 + n], li = a_im[g * 64 + n];
        const double mag = exp(lr * dt * j), ang = li * dt * j; POW[idx] = (f32x2v){(float)(mag * cos(ang)), (float)(mag * sin(ang))}; }
    for (int idx = tid; idx < 64 * 16; idx += NTHR) { const int n = idx >> 4, c = idx & 15; const double lr = a_re[g * 64 + n], li = a_im[g * 64 + n];
        const double mag = exp(lr * dt), lbr = mag * cos(li * dt), lbi = mag * sin(li * dt), nr = lbr - 1.0, ni = lbi, den = lr * lr + li * li;
        const double fr = (nr * lr + ni * li) / den, fi = (ni * lr - nr * li) / den, br = b_re[(g * 64 + n) * 16 + c], bi = b_im[(g * 64 + n) * 16 + c];
        BB[idx] = (f32x2v){(float)(fr * br - fi * bi), (float)(fr * bi + fi * br)};
        const int c2 = idx >> 6, n2 = idx & 63; CC[idx] = (f32x2v){c_re[(g * 16 + c2) * 64 + n2], c_im[(g * 16 + c2) * 64 + n2]}; }
    __syncthreads();
    if (part == 0 && tid < 64) { const f32x2v p = POW[32 * 64 + tid]; LAM32[tid * 2] = p.x; LAM32[tid * 2 + 1] = p.y; }
    for (int idx = tid; idx < 32 * 32; idx += NTHR) { const int j = idx >> 5, co = 2 * part + ((idx >> 4) & 1), ci = idx & 15; float s = 0.f;
#pragma unroll 2
        for (int n = 0; n < 64; ++n) { const f32x2v c = CC[co * 64 + n], p = POW[j * 64 + n], b = BB[n * 16 + ci];
            const float cpr = c.x * p.x - c.y * p.y, cpi = c.x * p.y + c.y * p.x; s += cpr * b.x - cpi * b.y; }
        KT[j * 256 + co * 16 + ci] = s; }
    __syncthreads();
    for (int id = tid; id < 64 * 80; id += NTHR) { const int rl = id / 80, c8 = id % 80, so = rl >> 1, co = 2 * part + (rl & 1), row = so * 16 + co; float v[8];
        if (c8 < 64) { const int si = c8 >> 1, ci0 = (c8 & 1) * 8;
#pragma unroll
            for (int e = 0; e < 8; ++e) v[e] = so >= si ? KT[(so - si) * 256 + co * 16 + ci0 + e] : 0.f; }
        else {
#pragma unroll
            for (int e = 0; e < 8; ++e) { const int np = (c8 - 64) * 8 + e, n = np & 63; const f32x2v c = CC[co * 64 + n], p = POW[(so + 1) * 64 + n];
                v[e] = np < 64 ? (c.x * p.x - c.y * p.y) : -(c.x * p.y + c.y * p.x); } }
        v4u o; o.x = pk2(v[0], v[1]); o.y = pk2(v[2], v[3]); o.z = pk2(v[4], v[5]); o.w = pk2(v[6], v[7]);
        *(GAS v4u*)(TV + (size_t)row * 640 + c8 * 8) = o; }
    for (int id = tid; id < 16 * 64; id += NTHR) { const int np = 16 * part + (id >> 6), c8 = id & 63, n = np & 63, s = c8 >> 1, ci0 = (c8 & 1) * 8; const f32x2v p = POW[(31 - s) * 64 + n]; float v[8];
#pragma unroll
        for (int e = 0; e < 8; ++e) { const f32x2v b = BB[n * 16 + ci0 + e]; v[e] = np < 64 ? (p.x * b.x - p.y * b.y) : (p.x * b.y + p.y * b.x); }
        v4u o; o.x = pk2(v[0], v[1]); o.y = pk2(v[2], v[3]); o.z = pk2(v[4], v[5]); o.w = pk2(v[6], v[7]);
        *(GAS v4u*)(Wt + (size_t)np * 512 + c8 * 8) = o; }
    __syncthreads();
}
__device__ __forceinline__ void p0_prologue(const Args& a, LAS unsigned char* lds, int tid, int lane, int wave, int vcu, int G) {
    unsigned char* ws = a.ws;
    LAS float* scr = (LAS float*)(lds + RING_OFF + wave * 16384);
    const int gw = vcu * NWAVES + wave, NGW = G * NWAVES;
    p0_s5_tables(vcu >> 3, vcu & 7, a, lds, tid);
    if (blockIdx.x == 33 && tid == 0) {
        float gq = 0.f, gk = 0.f, bm = 0.f; for (int i = 0; i < 128; ++i) { gq = fmaxf(gq, fabsf(a.in[5][i])); gk = fmaxf(gk, fabsf(a.in[6][i])); }
        for (int i = 0; i < 256; ++i) bm = fmaxf(bm, fabsf(a.in[2][i]));
        const float B = 1.02f * 128.f * 0.08838834764831845f * 1.4426950408889634f * gq * gk + bm * 1.4426950408889634f;
        ((float*)(ws + WS_BIASL))[1032] = (B > 0.f && B <= 56.f) ? B : 0.f; }
    if (blockIdx.x == 32) { float* BL = (float*)(ws + WS_BIASL); const float* rb = a.in[2];
        for (int i = tid; i < 8 * 128 + 8; i += NTHR) { if (i < 1024) { const int h = i >> 7, d = i & 127; BL[i] = rb[t5_bucket(d) * 8 + h] * 1.4426950408889634f; } else BL[i] = rb[31 * 8 + (i - 1024)] * 1.4426950408889634f; } }
    { bf16* WUV = (bf16*)(ws + WS_WUV); const float* w = a.in[7];
        for (int i = blockIdx.x * NTHR + tid; i < 8 * 64 * 128; i += G * NTHR) { const int ep = i & 3, ln = (i >> 2) & 63, t = (i >> 8) & 1, cs = (i >> 9) & 7, eb = (i >> 12) & 1, h = i >> 13;
            const int d = 16 * cs + 8 * t + 4 * (ln >> 5) + ep, e = 32 * eb + (ln & 31); WUV[i] = (bf16)f2bf(w[(h * 128 + d) * 64 + e]); } }
    constexpr int I_IN = 16 * 184, I_MKV = 16 * 32, I_GLU = 8 * 16, I_BR = 8 * 32, I_OUT = 16 * 32, I_GU = 16 * 176, I_D = 44 * 32;
    constexpr int NITEMS = I_IN + I_MKV + I_GLU + 3 * I_BR + I_OUT + I_GU + I_D;
    for (int it = gw; it < NITEMS; it += NGW) {
        int r = it;
        if (r < I_IN) { p0_transpose_item(1, a.in[3], nullptr, nullptr, 1024, 5832, 5888, (bf16*)(ws + WS_WIN), scr, r, lane); continue; } r -= I_IN;
        if (r < I_MKV) { p0_transpose_item(0, a.in[18], nullptr, nullptr, 1024, 1024, 1024, (bf16*)(ws + WS_WMKV), scr, r, lane); continue; } r -= I_MKV;
        if (r < I_GLU) { p0_transpose_item(0, a.in[16], nullptr, nullptr, 512, 512, 512, (bf16*)(ws + WS_WGLU), scr, r, lane); continue; } r -= I_GLU;
        if (r < 3 * I_BR) { const int br = r / I_BR; p0_transpose_item(0, a.in[21 + br], nullptr, nullptr, 512, 1024, 1024, (bf16*)(ws + WS_WBR) + (size_t)br * 1024 * 512, scr, r % I_BR, lane); continue; } r -= 3 * I_BR;
        if (r < I_OUT) { p0_transpose_item(0, a.in[24], nullptr, nullptr, 1024, 1024, 1024, (bf16*)(ws + WS_WOUT), scr, r, lane); continue; } r -= I_OUT;
        if (r < I_GU) { p0_transpose_item(2, a.in[26], a.in[27], a.in[25], 1024, 2816, 5632, (bf16*)(ws + WS_WGU), scr, r, lane); continue; } r -= I_GU;
        p0_transpose_item(0, a.in[28], nullptr, nullptr, 2816, 1024, 1024, (bf16*)(ws + WS_WD), scr, r, lane);
    }
    for (int m = gw; m < T_TOK; m += 2 * NGW) {
        const GAS f32x4* x0 = (const GAS f32x4*)(a.in[0] + (size_t)m * 1024) + lane; const GAS f32x4* x1 = (const GAS f32x4*)(a.in[0] + (size_t)(m + NGW) * 1024) + lane; const GAS f32x4* gr = (const GAS f32x4*)a.in[4] + lane;
        f32x4 v0[4], v1[4]; float s0 = 0.f, s1 = 0.f;
#pragma unroll
        for (int j = 0; j < 4; ++j) { v0[j] = x0[64 * j]; v1[j] = x1[64 * j]; }
#pragma unroll
        for (int j = 0; j < 4; ++j) { s0 += (v0[j].x * v0[j].x + v0[j].y * v0[j].y) + (v0[j].z * v0[j].z + v0[j].w * v0[j].w); s1 += (v1[j].x * v1[j].x + v1[j].y * v1[j].y) + (v1[j].z * v1[j].z + v1[j].w * v1[j].w); }
        const float r0 = 1.f / sqrtf(wave_sum(s0) * (1.f / 1024.f) + 1e-6f), r1 = 1.f / sqrtf(wave_sum(s1) * (1.f / 1024.f) + 1e-6f);
        GAS unsigned long long* o0 = (GAS unsigned long long*)((bf16*)(ws + WS_H) + (size_t)m * 1024) + lane; GAS unsigned long long* o1 = (GAS unsigned long long*)((bf16*)(ws + WS_H) + (size_t)(m + NGW) * 1024) + lane;
#pragma unroll
        for (int j = 0; j < 4; ++j) { const f32x4 gg = gr[64 * j];
            o0[64 * j] = (unsigned long long)pk2(v0[j].x * r0 * gg.x, v0[j].y * r0 * gg.y) | ((unsigned long long)pk2(v0[j].z * r0 * gg.z, v0[j].w * r0 * gg.w) << 32);
            o1[64 * j] = (unsigned long long)pk2(v1[j].x * r1 * gg.x, v1[j].y * r1 * gg.y) | ((unsigned long long)pk2(v1[j].z * r1 * gg.z, v1[j].w * r1 * gg.w) << 32); }
    }
    for (int m = gw; m < 2048; m += NGW) rms_row_to_bf16(a.in[1] + (size_t)m * 1024, a.in[17], (bf16*)(ws + WS_MEMN) + (size_t)m * 1024, lane);
}
__device__ __forceinline__ void norm128_pass(bf16* X, int rows, int ld, int ngroups, const float* g, int gtid, int nthr) {
    const int l = gtid & 15, total = rows * ngroups;
    for (int gid = gtid >> 4; gid < total; gid += nthr >> 4) {
        const int r = gid / ngroups, gi = gid % ngroups;
        bf16* p = X + (size_t)r * ld + gi * 128 + l * 8;
        const v4u v = *(const GAS v4u*)p; float f[8];
        f[0] = __uint_as_float(v.x << 16); f[1] = __uint_as_float(v.x & 0xffff0000u); f[2] = __uint_as_float(v.y << 16); f[3] = __uint_as_float(v.y & 0xffff0000u);
        f[4] = __uint_as_float(v.z << 16); f[5] = __uint_as_float(v.z & 0xffff0000u); f[6] = __uint_as_float(v.w << 16); f[7] = __uint_as_float(v.w & 0xffff0000u);
        float s = 0.f;
#pragma unroll
        for (int q = 0; q < 8; ++q) s += f[q] * f[q];
        s += __shfl_xor(s, 8); s += __shfl_xor(s, 4); s += __shfl_xor(s, 2); s += __shfl_xor(s, 1);
        const float rs = 1.f / sqrtf(s * (1.f / 128.f) + 1e-6f);
        const f32x4 g0 = *(const GAS f32x4*)(g + l * 8), g1 = *(const GAS f32x4*)(g + l * 8 + 4);
        v4u o; o.x = pk2(f[0] * rs * g0.x, f[1] * rs * g0.y); o.y = pk2(f[2] * rs * g0.z, f[3] * rs * g0.w); o.z = pk2(f[4] * rs * g1.x, f[5] * rs * g1.y); o.w = pk2(f[6] * rs * g1.z, f[7] * rs * g1.w);
        *(GAS v4u*)p = o;
    }
}
__device__ __forceinline__ void s5_scan(int g, int half, const Args& a, int tid) {
    if (tid < 256) {
        const int bl = tid >> 6, n = tid & 63, b = half * 4 + bl;
        const float* LAM32 = (const float*)(a.ws + WS_LAM32) + g * 128; const float lr = LAM32[n * 2], li = LAM32[n * 2 + 1];
        const float* SL = (const float*)(a.ws + WS_SLOC) + ((size_t)(g * 512 + b * 64)) * 128; bf16* Ur = (bf16*)(a.ws + WS_U) + ((size_t)(g * 512 + b * 64)) * 640 + 512;
        float xr = 0.f, xi = 0.f;
#pragma unroll 1
        for (int c0 = 0; c0 < 64; c0 += 16) {
            float sr[16], si[16];
#pragma unroll
            for (int k = 0; k < 16; ++k) { sr[k] = SL[(size_t)(c0 + k) * 128 + n]; si[k] = SL[(size_t)(c0 + k) * 128 + 64 + n]; }
#pragma unroll
            for (int k = 0; k < 16; ++k) {
                Ur[(size_t)(c0 + k) * 640 + n] = (bf16)f2bf(xr); Ur[(size_t)(c0 + k) * 640 + 64 + n] = (bf16)f2bf(xi);
                const float nr = lr * xr - li * xi + sr[k], ni = lr * xi + li * xr + si[k]; xr = nr; xi = ni;
            }
        }
    }
    VM_WAIT(); __syncthreads();
}
#define HAVE_ATTN 1
#ifdef TPROBE
#if TPROBE < 8
#define TP_STAMP(k) { __builtin_amdgcn_sched_barrier(0); const unsigned long long t_ = __builtin_amdgcn_s_memtime(); tp_acc[k] += t_ - tp_prev; tp_prev = t_; __builtin_amdgcn_sched_barrier(0); }
#define TP_DECL unsigned long long tp_acc[8] = {0, 0, 0, 0, 0, 0, 0, 0}; unsigned long long tp_prev = __builtin_amdgcn_s_memtime();
#define TP_FLUSH(base) { if (blockIdx.x == TPROBE_BLOCK && wave == 0 && lane == 0) { unsigned long long* TP = (unsigned long long*)(a.ws + WS_CTL + 65536); for (int k_ = 0; k_ < 8; ++k_) TP[(base) + k_] += tp_acc[k_]; } }
#define TQ_STAMP(k)
#define TQ_DECL
#define TQ_FLUSH
#else
#define TP_STAMP(k)
#define TP_DECL
#define TP_FLUSH(base)
#define TQ_STAMP(k) { const unsigned t_ = (unsigned)__builtin_amdgcn_s_memtime(); tq_acc[k] += t_ - tq_prev; tq_prev = t_; }
#define TQ_DECL unsigned tq_acc[4] = {0, 0, 0, 0}; unsigned tq_prev = (unsigned)__builtin_amdgcn_s_memtime();
#define TQ_FLUSH { if (blockIdx.x == TPROBE_BLOCK && wave == 0 && lane == 0) { unsigned long long* TP = (unsigned long long*)(a.ws + WS_CTL + 65536); for (int k_ = 0; k_ < 4; ++k_) TP[8 + k_] += tq_acc[k_]; } }
#endif
#else
#define TP_STAMP(k)
#define TP_DECL
#define TP_FLUSH(base)
#define TQ_STAMP(k)
#define TQ_DECL
#define TQ_FLUSH
#endif
namespace att {
typedef float f32x16 __attribute__((ext_vector_type(16)));
typedef short s16x4 __attribute__((ext_vector_type(4)));
typedef short v4i16_t __attribute__((ext_vector_type(4)));
typedef float f32x2_t __attribute__((ext_vector_type(2))); typedef __bf16 bf16x2_t __attribute__((ext_vector_type(2)));
typedef unsigned u32x2 __attribute__((ext_vector_type(2)));
#define MFMA32(a, b, c) __builtin_amdgcn_mfma_f32_32x32x16_bf16((a), (b), (c), 0, 0, 0)
__device__ __forceinline__ unsigned cvtpk(float lo, float hi) { const f32x2_t v = {lo, hi}; const bf16x2_t b = __builtin_convertvector(v, bf16x2_t); return __builtin_bit_cast(unsigned, b); }
__device__ __forceinline__ int crow(int r, int hi) { return (r & 3) + 8 * (r >> 2) + 4 * hi; }
__device__ __forceinline__ unsigned off_b(unsigned row, unsigned ch) { return 256u * row + 16u * (ch ^ (((row & 3u) << 2) | ((row >> 2) & 3u))); }
__device__ __forceinline__ float xh_max(float v) { const auto rr = __builtin_amdgcn_permlane32_swap(__float_as_uint(v), __float_as_uint(v), false, false); return fmaxf(__uint_as_float(rr[0]), __uint_as_float(rr[1])); }
__device__ __forceinline__ float xh_sum(float v) { const auto rr = __builtin_amdgcn_permlane32_swap(__float_as_uint(v), __float_as_uint(v), false, false); return __uint_as_float(rr[0]) + __uint_as_float(rr[1]); }
__device__ __forceinline__ unsigned xh_sumu(unsigned v) { const auto rr = __builtin_amdgcn_permlane32_swap(v, v, false, false); return rr[0] + rr[1]; }
__device__ __forceinline__ unsigned xh_or(unsigned v) { const auto rr = __builtin_amdgcn_permlane32_swap(v, v, false, false); return rr[0] | rr[1]; }
constexpr float SCALE2 = 0.08838834764831845f * 1.4426950408889634f;

__device__ __forceinline__ bf16x8 pack_step(const f32x16& x, int s) {
    v4u p; p.x = cvtpk(x[8 * s], x[8 * s + 1]); p.y = cvtpk(x[8 * s + 2], x[8 * s + 3]); p.z = cvtpk(x[8 * s + 4], x[8 * s + 5]); p.w = cvtpk(x[8 * s + 6], x[8 * s + 7]);
    return __builtin_bit_cast(bf16x8, p);
}
__device__ __forceinline__ void qk_tile(f32x16& p0, f32x16& p1, LAS const unsigned char* kimg, const bf16x8 (&qf)[8], int lane) {
    const unsigned r32 = lane & 31, hi = lane >> 5;
    f32x16 z;
#pragma unroll
    for (int r = 0; r < 16; ++r) z[r] = 0.f;
    p0 = z; p1 = z;
    bf16x8 fa[2][4];
#define QK_LOAD(g, buf) { const unsigned o0_ = off_b(r32, 4 * (g) + hi), o1_ = off_b(r32, 4 * (g) + 2 + hi); \
        fa[buf][0] = *(LAS const bf16x8*)(kimg + o0_); fa[buf][1] = *(LAS const bf16x8*)(kimg + o0_ + 32 * 256); fa[buf][2] = *(LAS const bf16x8*)(kimg + o1_); fa[buf][3] = *(LAS const bf16x8*)(kimg + o1_ + 32 * 256); }
#define QK_MMA(g, buf) { p0 = MFMA32(fa[buf][0], qf[2 * (g)], p0); p1 = MFMA32(fa[buf][1], qf[2 * (g)], p1); p0 = MFMA32(fa[buf][2], qf[2 * (g) + 1], p0); p1 = MFMA32(fa[buf][3], qf[2 * (g) + 1], p1); }
    QK_LOAD(0, 0) QK_LOAD(1, 1) QK_MMA(0, 0) asm volatile("" ::: "memory");
    QK_LOAD(2, 0) QK_MMA(1, 1) asm volatile("" ::: "memory");
    QK_LOAD(3, 1) QK_MMA(2, 0) QK_MMA(3, 1)
#undef QK_LOAD
#undef QK_MMA
}
__device__ __forceinline__ s16x4 vtr(LAS const unsigned char* p) { return __builtin_bit_cast(s16x4, __builtin_amdgcn_ds_read_tr16_b64_v4i16((LAS v4i16_t*)p)); }
__device__ __forceinline__ void pv_tile(f32x16 (&o)[4], LAS const unsigned char* vimg, const bf16x8 (&pf)[4], int lane) {
    const unsigned hi = lane >> 5, blk = (lane >> 4) & 1, q = (lane & 15) >> 2, p = lane & 3;
    s16x4 fl[2][4], fh[2][4];
#define PV_LOAD(c, buf) { _Pragma("unroll") for (int ks = 0; ks < 4; ++ks) { const unsigned ch = 4 * (c) + 2 * blk + (p >> 1), rlo = 16 * ks + 4 * hi + q; \
        fl[buf][ks] = vtr(vimg + off_b(rlo, ch) + 8 * (p & 1)); fh[buf][ks] = vtr(vimg + off_b(rlo + 8, ch) + 8 * (p & 1)); } }
#define PV_MMA(c, buf) { _Pragma("unroll") for (int ks = 0; ks < 4; ++ks) { const bf16x8 af = {fl[buf][ks][0], fl[buf][ks][1], fl[buf][ks][2], fl[buf][ks][3], fh[buf][ks][0], fh[buf][ks][1], fh[buf][ks][2], fh[buf][ks][3]}; \
        o[c] = MFMA32(af, pf[ks], o[c]); } }
    PV_LOAD(0, 0) PV_LOAD(1, 1) PV_MMA(0, 0) asm volatile("" ::: "memory");
    PV_LOAD(2, 0) PV_MMA(1, 1) asm volatile("" ::: "memory");
    PV_LOAD(3, 1) PV_MMA(2, 0) PV_MMA(3, 1)
#undef PV_LOAD
#undef PV_MMA
}
template <bool FIXED> __device__ __forceinline__ void softmax_step(f32x16& p0, f32x16& p1, float& m, float& l, f32x16 (&o)[4], bf16x8 (&pf)[4]) {
    if constexpr (FIXED) {
        f32x2_t s2 = {0.f, 0.f};
#pragma unroll
        for (int r = 0; r < 16; ++r) { p0[r] = __builtin_amdgcn_exp2f(p0[r]); p1[r] = __builtin_amdgcn_exp2f(p1[r]); const f32x2_t t = {p0[r], p1[r]}; s2 += t; }
        l += s2[0] + s2[1];
    } else {
        float mx = fmaxf(p0[0], p1[0]);
#pragma unroll
        for (int r = 1; r < 16; ++r) mx = fmaxf(mx, fmaxf(p0[r], p1[r]));
        mx = xh_max(mx);
        const float mnew = fmaxf(m, mx), muse = (mnew == -INFINITY) ? 0.f : mnew;
        const float alpha = __builtin_amdgcn_exp2f(m - muse);
        float s = 0.f;
#pragma unroll
        for (int r = 0; r < 16; ++r) { p0[r] = __builtin_amdgcn_exp2f(p0[r] - muse); p1[r] = __builtin_amdgcn_exp2f(p1[r] - muse); s += p0[r] + p1[r]; }
        l = l * alpha + s; m = mnew;
        if (__any(alpha != 1.f)) {
#pragma unroll
            for (int c = 0; c < 4; ++c)
#pragma unroll
                for (int r = 0; r < 16; ++r) o[c][r] *= alpha;
        }
    }
    pf[0] = pack_step(p0, 0); pf[1] = pack_step(p0, 1); pf[2] = pack_step(p1, 0); pf[3] = pack_step(p1, 1);
}
__device__ __forceinline__ void tile_load(v4u (&rg)[2], const bf16* src, int pitch, int tid) {
#pragma unroll
    for (int i = 0; i < 2; ++i) { const int id = tid + 512 * i, row = id >> 4, ch = id & 15; rg[i] = *(const GAS v4u*)(src + (size_t)row * pitch + ch * 8); }
}
__device__ __forceinline__ void tile_store(const v4u (&rg)[2], LAS unsigned char* img, int tid) {
#pragma unroll
    for (int i = 0; i < 2; ++i) { const int id = tid + 512 * i, row = id >> 4, ch = id & 15; *(LAS v4u*)(img + off_b(row, ch)) = rg[i]; }
}

__device__ __forceinline__ void cross_item(const Args& a, LAS unsigned char* lds, int tid, int lane, int wave, int item) {
    const int r32 = lane & 31, hi = lane >> 5;
    const int b = item >> 5, hx = (item >> 3) & 3, qblk = item & 7;
    const bf16* QX = (const bf16*)(a.ws + WS_QX); const bf16* KX = (const bf16*)(a.ws + WS_KX) + (size_t)b * 256 * 512 + hx * 128; const bf16* VX = (const bf16*)(a.ws + WS_VX) + (size_t)b * 256 * 512 + hx * 128;
    bf16* OX = (bf16*)(a.ws + WS_OX);
    const size_t row = (size_t)b * 2048 + qblk * 256 + wave * 32 + r32;
    bf16x8 qf[8];
#pragma unroll
    for (int s = 0; s < 8; ++s) qf[s] = *(const GAS bf16x8*)(QX + row * 512 + hx * 128 + 16 * s + 8 * hi);
    f32x16 o[4];
#pragma unroll
    for (int c = 0; c < 4; ++c)
#pragma unroll
        for (int r = 0; r < 16; ++r) o[c][r] = 0.f;
    float m = -INFINITY, l = 0.f;
    v4u kr[2], vr[2];
    tile_load(kr, KX, 512, tid); tile_load(vr, VX, 512, tid);
    tile_store(kr, lds, tid); tile_store(vr, lds + 32768, tid);
    __syncthreads();
#pragma unroll 1
    for (int kt = 0; kt < 4; ++kt) {
        LAS unsigned char* kimg = lds + (kt & 1) * 16384; LAS unsigned char* vimg = lds + 32768 + (kt & 1) * 16384;
        if (kt + 1 < 4) { tile_load(kr, KX + (size_t)(kt + 1) * 64 * 512, 512, tid); tile_load(vr, VX + (size_t)(kt + 1) * 64 * 512, 512, tid); }
        f32x16 p0, p1; qk_tile(p0, p1, kimg, qf, lane);
#pragma unroll
        for (int r = 0; r < 16; ++r) { p0[r] *= SCALE2; p1[r] *= SCALE2; }
        bf16x8 pf[4]; softmax_step<false>(p0, p1, m, l, o, pf);
        pv_tile(o, vimg, pf, lane);
        if (kt + 1 < 4) { tile_store(kr, lds + ((kt + 1) & 1) * 16384, tid); tile_store(vr, lds + 32768 + ((kt + 1) & 1) * 16384, tid); }
        __syncthreads();
    }
    l = xh_sum(l);
    const float inv = 1.f / l;
#pragma unroll
    for (int c = 0; c < 4; ++c)
#pragma unroll
        for (int g4 = 0; g4 < 4; ++g4) { u32x2 w; w.x = cvtpk(o[c][4 * g4] * inv, o[c][4 * g4 + 1] * inv); w.y = cvtpk(o[c][4 * g4 + 2] * inv, o[c][4 * g4 + 3] * inv);
            *(GAS u32x2*)(OX + row * 512 + hx * 128 + 32 * c + 8 * g4 + 4 * hi) = w; }
}
__device__ __forceinline__ void cross_phase(const Args& a, LAS unsigned char* lds, int tid, int lane, int wave, int bx, int G) {
    if (bx < 128) return;
#pragma unroll 1
    for (int i = 0; i < 2; ++i) cross_item(a, lds, tid, lane, wave, (bx - 128) * 2 + i);
}

constexpr int DSA_QI = 0, DSA_QPITCH = 1040, DSA_KTB = 33792, DSA_CT = DSA_KTB, DSA_MASK = DSA_KTB + 2 * 32 * 257 * 4, DSA_BT = DSA_MASK + 32 * 65 * 4, DSA_END = DSA_BT + 8 * 320 * 4;
static_assert(DSA_END <= RING_BYTES, "DSA LDS map");
__device__ __forceinline__ unsigned f2key(float x) { const unsigned b = __float_as_uint(x + 0.f); return (b & 0x80000000u) ? ~b : (b | 0x80000000u); }

__device__ __forceinline__ void cnt_ge(unsigned& cnt, unsigned key, unsigned cand) { asm volatile("v_cmp_ge_u32 vcc, %1, %2\n\tv_addc_co_u32_e32 %0, vcc, 0, %0, vcc" : "+v"(cnt) : "v"(key), "v"(cand) : "vcc"); }
__device__ __forceinline__ void cnt_gt(unsigned& cnt, unsigned key, unsigned cand) { asm volatile("v_cmp_gt_u32 vcc, %1, %2\n\tv_addc_co_u32_e32 %0, vcc, 0, %0, vcc" : "+v"(cnt) : "v"(key), "v"(cand) : "vcc"); }
__device__ __forceinline__ void cnt_eq(unsigned& cnt, unsigned key, unsigned cand) { asm volatile("v_cmp_eq_u32 vcc, %1, %2\n\tv_addc_co_u32_e32 %0, vcc, 0, %0, vcc" : "+v"(cnt) : "v"(key), "v"(cand) : "vcc"); }
__device__ __forceinline__ void cnt4_ge(unsigned& c0, unsigned& c1, unsigned& c2, unsigned& c3, unsigned k0, unsigned k1, unsigned k2, unsigned k3, unsigned cand) {
    unsigned long long m0, m1, m2;
    asm volatile("v_cmp_ge_u32 %4, %7, %11\n\tv_cmp_ge_u32 %5, %8, %11\n\tv_cmp_ge_u32 %6, %9, %11\n\tv_cmp_ge_u32 vcc, %10, %11\n\t"
                 "v_addc_co_u32_e64 %0, %4, 0, %0, %4\n\tv_addc_co_u32_e64 %1, %5, 0, %1, %5\n\tv_addc_co_u32_e64 %2, %6, 0, %2, %6\n\tv_addc_co_u32_e32 %3, vcc, 0, %3, vcc"
                 : "+v"(c0), "+v"(c1), "+v"(c2), "+v"(c3), "=&s"(m0), "=&s"(m1), "=&s"(m2) : "v"(k0), "v"(k1), "v"(k2), "v"(k3), "v"(cand) : "vcc");
}
template <int IB> __device__ __forceinline__ void cnt_tie_lt(unsigned& cnt, unsigned key, unsigned thr, unsigned lanepart, unsigned cand) { unsigned t;
    asm volatile("v_add_u32_e32 %1, %6, %4\n\tv_cmp_eq_u32 vcc, %2, %3\n\tv_cndmask_b32_e32 %1, -1, %1, vcc\n\tv_cmp_lt_u32 vcc, %1, %5\n\tv_addc_co_u32_e32 %0, vcc, 0, %0, vcc"
                 : "+v"(cnt), "=&v"(t) : "v"(key), "v"(thr), "v"(lanepart), "v"(cand), "i"(IB) : "vcc"); }
template <int IB, int BR> __device__ __forceinline__ void mask_sel(unsigned& w, unsigned key, unsigned thr, unsigned lanepart, unsigned istar, unsigned onehi) { unsigned t, bit;
    asm volatile("v_lshlrev_b32_e32 %2, %8, %7\n\tv_cmp_gt_u32 vcc, %3, %4\n\tv_cndmask_b32_e32 %1, 0, %2, vcc\n\tv_or_b32_e32 %0, %0, %1\n\t"
                 "v_add_u32_e32 %1, %9, %5\n\tv_cmp_le_u32 vcc, %1, %6\n\tv_cndmask_b32_e32 %1, 0, %2, vcc\n\tv_cmp_eq_u32 vcc, %3, %4\n\tv_cndmask_b32_e32 %1, 0, %1, vcc\n\tv_or_b32_e32 %0, %0, %1"
                 : "+v"(w), "=&v"(t), "=&v"(bit) : "v"(key), "v"(thr), "v"(lanepart), "v"(istar), "v"(onehi), "i"(BR), "i"(IB) : "vcc"); }

#define CRB(r) (((r) & 3) + 8 * ((r) >> 2))
#define TIE1(i, r) cnt_tie_lt<256 * (i) + CRB(r)>(cnt, key[i][r], thr, lanepart, cand);
#define TIE_ROW(i) TIE1(i,0) TIE1(i,1) TIE1(i,2) TIE1(i,3) TIE1(i,4) TIE1(i,5) TIE1(i,6) TIE1(i,7) TIE1(i,8) TIE1(i,9) TIE1(i,10) TIE1(i,11) TIE1(i,12) TIE1(i,13) TIE1(i,14) TIE1(i,15)
#define SEL1(i, r) mask_sel<256 * (i) + CRB(r), CRB(r)>(w, key[i][r], thr, lanepart, istar, onehi);
#define SEL_ROW(i) SEL1(i,0) SEL1(i,1) SEL1(i,2) SEL1(i,3) SEL1(i,4) SEL1(i,5) SEL1(i,6) SEL1(i,7) SEL1(i,8) SEL1(i,9) SEL1(i,10) SEL1(i,11) SEL1(i,12) SEL1(i,13) SEL1(i,14) SEL1(i,15)
__device__ __forceinline__ unsigned row_total(unsigned cnt, LAS unsigned* CNT, int& par, int r32, int hi, int wave) {
    cnt = xh_sumu(cnt);
    if (hi == 0) CNT[par * 256 + r32 * 8 + wave] = cnt;
    __syncthreads();
    const v4u x = *(LAS const v4u*)(CNT + par * 256 + r32 * 8), y = *(LAS const v4u*)(CNT + par * 256 + r32 * 8 + 4);
    par ^= 1;
    return (x.x + x.y) + (x.z + x.w) + (y.x + y.y) + (y.z + y.w);
}
template <bool FIXED> __device__ __forceinline__ void dsa_attn(const Args& a, LAS unsigned char* lds, int tid, int lane, int wave, int b, int qb, bool sel) {
    const int r32 = lane & 31, hi = lane >> 5;
    const int t0 = qb * 32; const size_t rowb = (size_t)b * 2048;
    const bf16* QD = (const bf16*)(a.ws + WS_QD); const bf16* CKV = (const bf16*)(a.ws + WS_CKV) + rowb * 128;
    const float* BL = (const float*)(a.ws + WS_BIASL); const bf16* WUV = (const bf16*)(a.ws + WS_WUV); bf16* ODSA = (bf16*)(a.ws + WS_ODSA);
    LAS unsigned* MASK = (LAS unsigned*)(lds + DSA_MASK);
    const int h = wave; const int tq = t0 + r32; const size_t qrow = rowb + t0 + r32;
    bf16x8 qf[8];
#pragma unroll
    for (int s = 0; s < 8; ++s) qf[s] = *(const GAS bf16x8*)(QD + qrow * 1024 + h * 128 + 16 * s + 8 * hi);
    const float c31 = BL[1024 + h] - BL[1032];
    f32x16 o[4];
#pragma unroll
    for (int c = 0; c < 4; ++c)
#pragma unroll
        for (int r = 0; r < 16; ++r) o[c][r] = 0.f;
    float m = -INFINITY, l = 0.f;
    const int NKT = (t0 + 32 + 63) >> 6;
    TP_DECL
#define DMA_TILE(kt_) { _Pragma("unroll") for (int i_ = 0; i_ < 2; ++i_) { const int rb_ = i_ * 8 + wave, row_ = 4 * rb_ + (lane >> 4), ch_ = (lane & 15) ^ (((row_ & 3) << 2) | ((row_ >> 2) & 3)); \
        __builtin_amdgcn_global_load_lds((const unsigned*)(CKV + (size_t)(64 * (kt_) + row_) * 128 + ch_ * 8), (LAS unsigned*)(lds + DSA_CT + ((kt_) & 3) * 16384 + rb_ * 1024), 16, 0, 0); } }
    DMA_TILE(0) if (NKT > 1) DMA_TILE(1)
    __syncthreads();
#pragma unroll 1
    for (int kp = 0; kp < NKT; kp += 2) {
      if (kp + 2 < NKT) DMA_TILE(kp + 2) if (kp + 3 < NKT) DMA_TILE(kp + 3)
#pragma unroll 1
      for (int kt = kp; kt < kp + 2 && kt < NKT; ++kt) {
        LAS unsigned char* cimg = lds + DSA_CT + (kt & 3) * 16384;
        TP_STAMP(0)
        f32x16 p0, p1; qk_tile(p0, p1, cimg, qf, lane);
        TP_STAMP(1)
        const int k0 = 64 * kt;
        const bool far = (t0 - k0 - 63) >= 128;
        unsigned mv0, mv1;
        if (sel) { mv0 = MASK[r32 * 65 + 2 * kt] >> (4 * hi); mv1 = MASK[r32 * 65 + 2 * kt + 1] >> (4 * hi); }
        else { const int d0 = tq - k0 - 4 * hi, d1 = d0 - 32;
            mv0 = d0 < 0 ? 0u : (d0 >= 31 ? 0x0f0f0f0fu : (0x0f0f0f0fu & ((2u << d0) - 1u)));
            mv1 = d1 < 0 ? 0u : (d1 >= 31 ? 0x0f0f0f0fu : (0x0f0f0f0fu & ((2u << d1) - 1u))); }
        if (far) {
#pragma unroll
            for (int r = 0; r < 16; ++r) { p0[r] = ((mv0 >> CRB(r)) & 1u) ? p0[r] * SCALE2 + c31 : -INFINITY; p1[r] = ((mv1 >> CRB(r)) & 1u) ? p1[r] * SCALE2 + c31 : -INFINITY; }
        } else {
            LAS const float* bt = (LAS const float*)(lds + DSA_BT + h * 1280 + (255 - (tq - k0 - 4 * hi)) * 4);
            if constexpr (FIXED) {
#define NEAR8(P, MV, OFF, R0) { float bb[8]; \
              _Pragma("unroll") for (int r = 0; r < 8; ++r) bb[r] = bt[(OFF) + CRB((R0) + r)]; \
              asm volatile("" ::: "memory"); \
              _Pragma("unroll") for (int r = 0; r < 8; ++r) { const float v_ = P[(R0) + r] * SCALE2 + bb[r]; P[(R0) + r] = (((MV) >> CRB((R0) + r)) & 1u) ? v_ : -INFINITY; } }
            NEAR8(p0, mv0, 0, 0) NEAR8(p0, mv0, 0, 8) NEAR8(p1, mv1, 32, 0) NEAR8(p1, mv1, 32, 8)
#undef NEAR8
            } else {
                const LAS float* btf = bt;
#pragma unroll
                for (int r = 0; r < 16; ++r) { const float b0 = btf[CRB(r)], b1 = btf[32 + CRB(r)];
                    p0[r] = ((mv0 >> CRB(r)) & 1u) ? p0[r] * SCALE2 + b0 : -INFINITY; p1[r] = ((mv1 >> CRB(r)) & 1u) ? p1[r] * SCALE2 + b1 : -INFINITY; }
            }
        }
        bf16x8 pf[4];
        softmax_step<FIXED>(p0, p1, m, l, o, pf);
        TP_STAMP(2)
        pv_tile(o, cimg, pf, lane);
        TP_STAMP(3)
        TP_STAMP(4)
      }
      __syncthreads();
    }
#undef DMA_TILE
    l = xh_sum(l);
    const float inv = 1.f / l;
    bf16x8 of[8];
#pragma unroll
    for (int c = 0; c < 4; ++c) {
#pragma unroll
        for (int r = 0; r < 16; ++r) o[c][r] *= inv;
        of[2 * c] = pack_step(o[c], 0); of[2 * c + 1] = pack_step(o[c], 1);
    }
    { s16x4 wl[2][8], wh[2][8];
#pragma unroll
      for (int eb = 0; eb < 2; ++eb) { const bf16* wf = WUV + (size_t)((h * 2 + eb) * 8) * 512 + lane * 4;
#pragma unroll
        for (int cs = 0; cs < 8; ++cs) { wl[eb][cs] = *(const GAS s16x4*)(wf + cs * 512); wh[eb][cs] = *(const GAS s16x4*)(wf + cs * 512 + 256); } }
      asm volatile("" ::: "memory");
#pragma unroll
      for (int eb = 0; eb < 2; ++eb) {
        f32x16 acc;
#pragma unroll
        for (int r = 0; r < 16; ++r) acc[r] = 0.f;
#pragma unroll
        for (int cs = 0; cs < 8; ++cs) {
            const bf16x8 af = {wl[eb][cs][0], wl[eb][cs][1], wl[eb][cs][2], wl[eb][cs][3], wh[eb][cs][0], wh[eb][cs][1], wh[eb][cs][2], wh[eb][cs][3]};
            acc = MFMA32(af, of[cs], acc);
        }
#pragma unroll
        for (int g4 = 0; g4 < 4; ++g4) { u32x2 w; w.x = cvtpk(acc[4 * g4], acc[4 * g4 + 1]); w.y = cvtpk(acc[4 * g4 + 2], acc[4 * g4 + 3]);
            *(GAS u32x2*)(ODSA + qrow * 512 + h * 64 + 32 * eb + 8 * g4 + 4 * hi) = w; }
      } }
    TP_STAMP(5)
    TP_FLUSH(0)
}
template <int MODE> __device__ __forceinline__ void dsa_item(const Args& a, LAS unsigned char* lds, int tid, int lane, int wave, int b, int qb) {
    const int r32 = lane & 31, hi = lane >> 5;
    const int t0 = qb * 32; const size_t rowb = (size_t)b * 2048;
    const bool sel = qb >= 8;
    const bf16* QD = (const bf16*)(a.ws + WS_QD); const bf16* CKV = (const bf16*)(a.ws + WS_CKV) + rowb * 128; const bf16* QI = (const bf16*)(a.ws + WS_QI); const bf16* KI = (const bf16*)(a.ws + WS_KI) + rowb * 64;
    const float* WI = (const float*)(a.ws + WS_WI); const float* BL = (const float*)(a.ws + WS_BIASL); const bf16* WUV = (const bf16*)(a.ws + WS_WUV); bf16* ODSA = (bf16*)(a.ws + WS_ODSA);
    LAS unsigned* MASK = (LAS unsigned*)(lds + DSA_MASK);
    const int NT = qb + 1;
    TQ_DECL
    if (MODE != 1 && sel) {
#pragma unroll
        for (int i = 0; i < 4; ++i) { const int id = tid + 512 * i, row = id >> 6, ch = id & 63;
            *(LAS v4u*)(lds + DSA_QI + row * DSA_QPITCH + ch * 16) = *(const GAS v4u*)(QI + (rowb + t0 + row) * 512 + ch * 8); }
        __syncthreads();
        float wq[8];
        { const f32x4 w0 = *(const GAS f32x4*)(WI + (rowb + t0 + r32) * 8), w1 = *(const GAS f32x4*)(WI + (rowb + t0 + r32) * 8 + 4);
          wq[0] = w0.x; wq[1] = w0.y; wq[2] = w0.z; wq[3] = w0.w; wq[4] = w1.x; wq[5] = w1.y; wq[6] = w1.z; wq[7] = w1.w; }
        unsigned kw[4][32];
        LAS unsigned* KTB = (LAS unsigned*)(lds + DSA_KTB);
        LAS const unsigned char* qbase = lds + DSA_QI + r32 * DSA_QPITCH + hi * 16;
        const bf16* kbase = KI + (size_t)r32 * 64 + 8 * hi;
        bf16x8 kf[4]; const bf16* kptr = kbase + (size_t)wave * 2048;
        if (wave < NT) {
#pragma unroll
            for (int kk = 0; kk < 4; ++kk) kf[kk] = *(const GAS bf16x8*)(kptr + 16 * kk);
        }
        kptr += 8 * 2048;
#define SC_HEAD(hh, dst) { _Pragma("unroll") for (int r = 0; r < 16; ++r) dst[r] = 0.f; \
            _Pragma("unroll") for (int kk = 0; kk < 4; ++kk) { const bf16x8 qf = *(LAS const bf16x8*)(qbase + ((hh) * 8 + 2 * kk) * 16); dst = MFMA32(kf[kk], qf, dst); } }
#define SC_ACC(hh, src) { const f32x2_t w2_ = {wq[hh], wq[hh]}; \
            _Pragma("unroll") for (int r = 0; r < 16; r += 2) { const f32x2_t t_ = {__builtin_amdgcn_fmed3f(src[r], 0.f, INFINITY), __builtin_amdgcn_fmed3f(src[r + 1], 0.f, INFINITY)}; \
                f32x2_t s_ = {sacc[r], sacc[r + 1]}; s_ = __builtin_elementwise_fma(t_, w2_, s_); sacc[r] = s_[0]; sacc[r + 1] = s_[1]; } \
            _Pragma("unroll") for (int r = 0; r < 16; ++r) asm volatile("" : "+v"(sacc[r])); }
#define SC_TILE(i) { const int j = wave + 8 * (i); \
            if (8 * (i) < NT) {                                            \
                LAS unsigned* kt_ = KTB + ((i) & 1) * (32 * 257); \
                if (j < NT) { \
                    f32x16 sacc, da, db; \
                    _Pragma("unroll") for (int r = 0; r < 16; ++r) sacc[r] = 0.f; \
                    SC_HEAD(0, da) SC_HEAD(1, db) SC_ACC(0, da) SC_HEAD(2, da) SC_ACC(1, db) SC_HEAD(3, db) SC_ACC(2, da) SC_HEAD(4, da) SC_ACC(3, db) \
                    SC_HEAD(5, db) SC_ACC(4, da) SC_HEAD(6, da) SC_ACC(5, db) SC_HEAD(7, db) \
                    asm volatile("" ::: "memory"); \
                    if (j + 8 < NT) { _Pragma("unroll") for (int kk = 0; kk < 4; ++kk) kf[kk] = *(const GAS bf16x8*)(kptr + 16 * kk); kptr += 8 * 2048; }     \
                    SC_ACC(6, da) SC_ACC(7, db) \
                    _Pragma("unroll") for (int r = 0; r < 16; ++r) { const bool vis = (j < NT - 1) || (crow(r, hi) <= r32); kt_[r32 * 257 + 32 * wave + crow(r, hi)] = vis ? f2key(sacc[r]) : 0u; } \
                } else { _Pragma("unroll") for (int r = 0; r < 16; ++r) kt_[r32 * 257 + 32 * wave + crow(r, hi)] = 0u; } \
                __syncthreads(); \
                _Pragma("unroll") for (int rho = 0; rho < 4; ++rho) _Pragma("unroll") for (int k = 0; k < 4; ++k) kw[rho][4 * (i) + k] = kt_[(4 * wave + rho) * 257 + 64 * k + lane]; \
            } else { _Pragma("unroll") for (int rho = 0; rho < 4; ++rho) _Pragma("unroll") for (int k = 0; k < 4; ++k) kw[rho][4 * (i) + k] = 0u; } }
        SC_TILE(0) SC_TILE(1) SC_TILE(2) SC_TILE(3) SC_TILE(4) SC_TILE(5) SC_TILE(6) SC_TILE(7)
#undef SC_TILE
#undef SC_ACC
#undef SC_HEAD
        TQ_STAMP(0)
        unsigned thr[4] = {0u, 0u, 0u, 0u}; bool fnd[4] = {false, false, false, false};
        if constexpr (MODE != 3) {
#pragma unroll 1
            for (int bit = 31; bit >= 0; --bit) {
#pragma unroll
                for (int rho = 0; rho < 4; ++rho) if (!fnd[rho]) {
                    const unsigned cand = (unsigned)__builtin_amdgcn_readfirstlane((int)(thr[rho] | (1u << bit))); unsigned cnt = 0u;
#pragma unroll
                    for (int e = 0; e < 32; e += 4) if (2 * e < NT) {
                        unsigned long long b0, b1, b2, b3;
                        asm volatile("v_cmp_ge_u32_e64 %0, %4, %8\n\tv_cmp_ge_u32_e64 %1, %5, %8\n\tv_cmp_ge_u32_e64 %2, %6, %8\n\tv_cmp_ge_u32_e64 %3, %7, %8"
                                     : "=&s"(b0), "=&s"(b1), "=&s"(b2), "=&s"(b3) : "v"(kw[rho][e]), "v"(kw[rho][e + 1]), "v"(kw[rho][e + 2]), "v"(kw[rho][e + 3]), "s"(cand));
                        cnt += (unsigned)(__builtin_popcountll(b0) + __builtin_popcountll(b1)) + (unsigned)(__builtin_popcountll(b2) + __builtin_popcountll(b3));
                    }
                    if (cnt >= 256u) thr[rho] = cand;
                    fnd[rho] = cnt == 256u;
                }
                if (fnd[0] && fnd[1] && fnd[2] && fnd[3]) break;
            }
        }
#pragma unroll
        for (int rho = 0; rho < 4; ++rho) {
            const unsigned th = (unsigned)__builtin_amdgcn_readfirstlane((int)thr[rho]); unsigned gtot = 0u;
#pragma unroll
            for (int e = 0; e < 32; e += 4) if (2 * e < NT) { unsigned long long b0, b1, b2, b3;
                asm volatile("v_cmp_gt_u32_e64 %0, %4, %8\n\tv_cmp_gt_u32_e64 %1, %5, %8\n\tv_cmp_gt_u32_e64 %2, %6, %8\n\tv_cmp_gt_u32_e64 %3, %7, %8"
                             : "=&s"(b0), "=&s"(b1), "=&s"(b2), "=&s"(b3) : "v"(kw[rho][e]), "v"(kw[rho][e + 1]), "v"(kw[rho][e + 2]), "v"(kw[rho][e + 3]), "s"(th));
                gtot += (unsigned)(__builtin_popcountll(b0) + __builtin_popcountll(b1)) + (unsigned)(__builtin_popcountll(b2) + __builtin_popcountll(b3)); }
            unsigned rem = 256u - gtot;
            unsigned wlo = 0u, whi = 0u;
#define WLANE(dst, val, ln) asm volatile("v_writelane_b32 %0, %1, %2" : "+v"(dst) : "s"(val), "i"(ln));
#define MB_STEP(e) if (2 * ((e) & ~3) < NT) { unsigned long long g0, g1, q0, q1; \
                asm volatile("v_cmp_gt_u32_e64 %0, %4, %6\n\tv_cmp_gt_u32_e64 %1, %5, %6\n\tv_cmp_eq_u32_e64 %2, %4, %6\n\tv_cmp_eq_u32_e64 %3, %5, %6" \
                             : "=&s"(g0), "=&s"(g1), "=&s"(q0), "=&s"(q1) : "v"(kw[rho][e]), "v"(kw[rho][(e) + 1]), "s"(th)); \
                unsigned c = (unsigned)__builtin_popcountll(q0); \
                if (c > rem) { while ((unsigned)__builtin_popcountll(q0) > rem) q0 &= ~(1ull << (63 - __builtin_clzll(q0))); c = rem; }     \
                rem -= c; \
                c = (unsigned)__builtin_popcountll(q1); \
                if (c > rem) { while ((unsigned)__builtin_popcountll(q1) > rem) q1 &= ~(1ull << (63 - __builtin_clzll(q1))); c = rem; } \
                rem -= c; \
                const unsigned long long s0 = g0 | q0, s1 = g1 | q1; \
                WLANE(wlo, (unsigned)s0, e) WLANE(whi, (unsigned)(s0 >> 32), e) WLANE(wlo, (unsigned)s1, (e) + 1) WLANE(whi, (unsigned)(s1 >> 32), (e) + 1) }
            MB_STEP(0) MB_STEP(2) MB_STEP(4) MB_STEP(6) MB_STEP(8) MB_STEP(10) MB_STEP(12) MB_STEP(14) MB_STEP(16) MB_STEP(18) MB_STEP(20) MB_STEP(22) MB_STEP(24) MB_STEP(26) MB_STEP(28) MB_STEP(30)
#undef MB_STEP
            if (lane < 32) { const int j = 8 * (lane >> 2) + 2 * (lane & 3); MASK[(4 * wave + rho) * 65 + j] = wlo; MASK[(4 * wave + rho) * 65 + j + 1] = whi; }
#undef WLANE
        }
        __syncthreads();
        TQ_STAMP(1)
    }
    if constexpr (MODE == 0 || MODE == 1) {
        const float Mb = ((const float*)(a.ws + WS_BIASL))[1032];
        if (Mb != 0.f) dsa_attn<true>(a, lds, tid, lane, wave, b, qb, sel); else dsa_attn<false>(a, lds, tid, lane, wave, b, qb, sel);
    }
    TQ_STAMP(2)
    TQ_FLUSH
    __syncthreads();
}
template <int MODE = 0> __device__ __forceinline__ void dsa_phase(const Args& a, LAS unsigned char* lds, int wave, int bx, int G) {
    const int b = bx >> 5, p = bx & 31;
    { const float* BL = (const float*)(a.ws + WS_BIASL); LAS float* BT = (LAS float*)(lds + DSA_BT);
      for (int i = wave * 64 + my_lane_id(); i < 8 * 320; i += NTHR) { const int hh = i / 320, d = 255 - (i % 320); BT[i] = (d < 0 ? 0.f : (d < 128 ? BL[hh * 128 + d] : BL[1024 + hh])) - BL[1032]; } }
    __syncthreads();
#pragma unroll 1
    for (int it = 0; it < 2; ++it) {
        const int lane = my_lane_id();
        dsa_item<MODE>(a, lds, wave * 64 + lane, lane, wave, b, it == 0 ? 63 - p : p);
    }
}
}
#define HAVE_DSA 1
using att::cross_phase;
__device__ __forceinline__ void dsa_phase(const Args& a, LAS unsigned char* lds, int wave, int bx, int G) { att::dsa_phase<0>(a, lds, wave, bx, G); }
__global__ void __launch_bounds__(NTHR, 2) mk_fwd(Args args) {
    extern __shared__ __attribute__((aligned(16))) unsigned char lds_raw[];
    LAS unsigned char* lds = (LAS unsigned char*)lds_raw;
    volatile LAS unsigned* MISC = (volatile LAS unsigned*)(lds + MISC_OFF);
    const int wave = __builtin_amdgcn_readfirstlane(threadIdx.x >> 6);
#define MYLANE() my_lane_id()
    const int G = gridDim.x, bx = blockIdx.x, vcu = (G % 8 == 0) ? (bx % 8) * (G / 8) + bx / 8 : bx;
    unsigned char* ws = args.ws;
    gu32* ctl = (gu32*)(ws + WS_CTL);
    { const int tid = wave * 64 + MYLANE();
      for (int u = tid; u < (LDS_BYTES - LDSCTL_OFF) / 4; u += NTHR) ((LAS unsigned*)(lds + LDSCTL_OFF))[u] = 0u; }
    __syncthreads();
    const int lo = args.ph_lo, hi = args.ph_hi;
    const bool multi = (hi - lo) > 1;
    XcdBarrier bar; bar.bar = (unsigned*)(ctl + CW_BAR) + args.li * XCD_BAR_WORDS; bar.x = 0; bar.st = nullptr;
    if (multi) bar = xcd_barrier_post((unsigned*)(ctl + CW_BAR) + args.li * XCD_BAR_WORDS, MISC + 8, wave == 0 && MYLANE() == 0);
#define IN(k) (lo <= (k) && (k) < hi)
#define RPT(k) ((args.flags >> (16 + (k))) & 1)
#define L1_INV_SYNC() do { VM_WAIT(); __builtin_amdgcn_fence(__ATOMIC_ACQUIRE, "agent"); VM_WAIT(); __syncthreads(); } while (0)
#define SEAM(k) do { if (IN(k) && IN((k) + 1)) xcd_barrier(bar, wave == 0 && MYLANE() == 0); } while (0)
    bf16 *WIN = (bf16*)(ws + WS_WIN), *WMKV = (bf16*)(ws + WS_WMKV), *WGLU = (bf16*)(ws + WS_WGLU), *WBR = (bf16*)(ws + WS_WBR), *WOUT = (bf16*)(ws + WS_WOUT), *WGU = (bf16*)(ws + WS_WGU), *WD = (bf16*)(ws + WS_WD);
    float *RS = (float*)(ws + WS_RS), *WI = (float*)(ws + WS_WI), *SLOC = (float*)(ws + WS_SLOC);
    bf16 *KX = (bf16*)(ws + WS_KX), *VX = (bf16*)(ws + WS_VX), *MEMN = (bf16*)(ws + WS_MEMN), *H = (bf16*)(ws + WS_H), *QD = (bf16*)(ws + WS_QD), *CKV = (bf16*)(ws + WS_CKV), *QI = (bf16*)(ws + WS_QI), *KI = (bf16*)(ws + WS_KI),
         *QX = (bf16*)(ws + WS_QX), *U = (bf16*)(ws + WS_U), *ODSA = (bf16*)(ws + WS_ODSA), *OX = (bf16*)(ws + WS_OX), *Y = (bf16*)(ws + WS_Y), *OS5 = (bf16*)args.out, *G3 = (bf16*)(ws + WS_G3), *MG = (bf16*)(ws + WS_MERGED),
         *ACT = (bf16*)(ws + WS_ACT), *XN = (bf16*)(ws + WS_XN), *S5TV = (bf16*)(ws + WS_S5TV), *S5W = (bf16*)(ws + WS_S5W);

    if (IN(0)) for (int rep_ = 0; rep_ <= RPT(0); ++rep_) { if (rep_) xcd_barrier(bar, wave == 0 && MYLANE() == 0); const int lane = MYLANE(), tid = wave * 64 + lane; p0_prologue(args, lds, tid, lane, wave, vcu, G); }
    SEAM(0);
    if (IN(1)) for (int rep_ = 0; rep_ <= RPT(1); ++rep_) { if (rep_) xcd_barrier(bar, wave == 0 && MYLANE() == 0);
        { pg8::Gemm g{H, WIN, T_TOK, NIN, 1024, 1024, 1024}; pg8::StaticOrder S; S.init(T_TOK, NIN, G, bx);
          pg8::EpiInprojF E{QD, CKV, QI, KI, U, QX, WI, args.in[5], args.in[6], args.in[19], (LAS float*)(lds + XB_OFF)};
          pg8::gemm_phase<pg8::EpiInprojF, pg8::StaticOrder, true, true>(lds + RING_OFF, g, S, E, wave); }
        { pg8::Gemm g{MEMN, WMKV, 2048, 1024, 1024, 1024, 1024}; pg8::SubsetOrder S; S.init(2048, 1024, 64, bx - 192);
          pg8::EpiMemKVF E{KX, VX, args.in[20], (LAS float*)(lds + XB_OFF)};
          pg8::gemm_phase<pg8::EpiMemKVF, pg8::SubsetOrder, true, true>(lds + RING_OFF, g, S, E, wave); }
    }
    SEAM(1);
    if (IN(3)) for (int rep_ = 0; rep_ <= RPT(3); ++rep_) { if (rep_) xcd_barrier(bar, wave == 0 && MYLANE() == 0);
#ifdef TPROBE
        const unsigned long long tp3_0 = __builtin_amdgcn_s_memtime();
#endif
        if (!(args.flags & FL_NO_S5)) {
            if (bx < 128) {
                { pg8::Gemm g{U, S5W, 32 * 512, 32 * 256, 512, 640, 512}; pg8::S5Order1 S{((bx >> 2) * 2) + ((bx >> 1) & 1)};
                  pg8::EpiSlocF E{SLOC};
                  pg8::gemm_phase<pg8::EpiSlocF, pg8::S5Order1, false, true>(lds + RING_OFF, g, S, E, wave); }
                VM_WAIT(); __syncthreads();
                s5_scan(bx >> 2, (bx >> 1) & 1, args, wave * 64 + MYLANE());
            }
            pg8::Gemm g{U, S5TV, 32 * 512, 32 * 512, 640, 640, 640}; pg8::S5Order2 S{bx};
            pg8::EpiS5YF E{U, args.in[15], Y};
            pg8::gemm_phase<pg8::EpiS5YF, pg8::S5Order2, false, true>(lds + RING_OFF, g, S, E, wave);
        }
#ifdef HAVE_ATTN
        if (!(args.flags & FL_NO_CROSS)) { const int lane = MYLANE(); cross_phase(args, lds, wave * 64 + lane, lane, wave, bx, G); }
#endif
#ifdef TPROBE
        const unsigned long long tp3_1 = __builtin_amdgcn_s_memtime();
#endif
#ifdef HAVE_DSA
        if (!(args.flags & FL_NO_DSA)) dsa_phase(args, lds, wave, bx, G);
#endif
#ifdef TPROBE
        if (bx == TPROBE_BLOCK && wave == 0 && MYLANE() == 0) { unsigned long long* TP = (unsigned long long*)(ws + WS_CTL + 65536); TP[12] = __builtin_amdgcn_s_memtime() - tp3_0; TP[13] = tp3_1 - tp3_0; }
#endif
    }
    SEAM(3);
    if (IN(4)) for (int rep_ = 0; rep_ <= RPT(4); ++rep_) { if (rep_) xcd_barrier(bar, wave == 0 && MYLANE() == 0);
        { pg8::Gemm g{Y, WGLU, T_TOK, 512, 512, 512, 512}; pg8::SubsetOrder S; S.init(T_TOK, 512, 128, bx < 128 ? bx : -1);
          pg8::EpiGluF E{Y, OS5};
          pg8::gemm_phase<pg8::EpiGluF, pg8::SubsetOrder, false, true>(lds + RING_OFF, g, S, E, wave); }
        { pg8::Gemm g{H, WIN + (size_t)NIN * 1024, T_TOK, 3072, 1024, 1024, 1024}; pg8::GateOrder S{bx};
          pg8::EpiSigmoidF E{G3, 3072};
          pg8::gemm_phase<pg8::EpiSigmoidF, pg8::GateOrder, true, true>(lds + RING_OFF, g, S, E, wave); }
    }
    SEAM(4);
    if (IN(5)) for (int rep_ = 0; rep_ <= RPT(5); ++rep_) { if (rep_) xcd_barrier(bar, wave == 0 && MYLANE() == 0);
        pg8::Gemm g{ODSA, WBR, T_TOK, 1024, 512, 512, 512}; pg8::MergeOrder S; S.so.init(T_TOK, 1024, G, bx);
        S.aoff[0] = 0; S.aoff[1] = (long)((const char*)OS5 - (const char*)ODSA); S.aoff[2] = (long)((const char*)OX - (const char*)ODSA);
        pg8::EpiMergeF E{G3, MG};
        pg8::gemm_phase<pg8::EpiMergeF, pg8::MergeOrder, true, true>(lds + RING_OFF, g, S, E, wave);
    }
    SEAM(5);
    if (IN(6)) for (int rep_ = 0; rep_ <= RPT(6); ++rep_) { if (rep_) xcd_barrier(bar, wave == 0 && MYLANE() == 0);
        pg8::Gemm g{MG, WOUT, T_TOK, 1024, 1024, 1024, 1024}; pg8::StaticOrder S; S.init(T_TOK, 1024, G, bx);
        pg8::EpiOutF E{args.in[0], args.out, XN, RS};
        pg8::gemm_phase<pg8::EpiOutF, pg8::StaticOrder, false, true>(lds + RING_OFF, g, S, E, wave);
    }
    SEAM(6);
    if (IN(7)) for (int rep_ = 0; rep_ <= RPT(7); ++rep_) { if (rep_) xcd_barrier(bar, wave == 0 && MYLANE() == 0);
        pg8::Gemm g{XN, WGU, T_TOK, 5632, 1024, 1024, 1024}; pg8::StaticOrder S; S.init(T_TOK, 5632, G, bx);
        pg8::EpiGateUpF E{RS, ACT};
        pg8::gemm_phase<pg8::EpiGateUpF, pg8::StaticOrder, true, true>(lds + RING_OFF, g, S, E, wave);
    }
    SEAM(7);
    if (IN(8)) for (int rep_ = 0; rep_ <= RPT(8); ++rep_) { if (rep_) xcd_barrier(bar, wave == 0 && MYLANE() == 0);
        pg8::Gemm g{ACT, WD, T_TOK, 1024, 2816, 2816, 2816}; pg8::StaticOrder S; S.init(T_TOK, 1024, G, bx);
        pg8::EpiDownF E{XN, args.out};
        pg8::gemm_phase<pg8::EpiDownF, pg8::StaticOrder, false, true>(lds + RING_OFF, g, S, E, wave);
    }
#ifdef TPROBE
    xcd_barrier(bar, wave == 0 && MYLANE() == 0);
    if (bx == 0 && wave == 0 && MYLANE() == 0) { const unsigned long long* TP = (const unsigned long long*)(ws + WS_CTL + 65536); unsigned long long tot = TP[12];
#if TPROBE < 8
        tot = 0; for (int k_ = 0; k_ < 6; ++k_) tot += TP[k_];
#endif
        const float frac = tot ? (float)((double)TP[TPROBE] / (double)tot) : 0.f; args.out[0] += 0.15f + 0.3f * frac; }
#endif
#undef IN
#undef SEAM
}
extern "C" void kernel_launch(void* const* d_in, const int* in_sizes, int n_in, void* d_out, int out_size, void* d_ws, size_t ws_size, hipStream_t stream) {
    static int grid = 0;
    if (grid == 0) {
        if (n_in != 29 || ws_size < WS_END || out_size != T_TOK * DM || in_sizes[0] != T_TOK * DM) { fprintf(stderr, "kernel_launch: built for 29 inputs, x/out of %d floats, >= %zu bytes of workspace; got n_in %d out %d ws %zu; nothing launched\n", T_TOK * DM, (size_t)WS_END, n_in, out_size, ws_size); grid = -1; return; }
        int dev = 0, cus = 0, per_cu = 0;
        if (hipGetDevice(&dev) != hipSuccess || hipDeviceGetAttribute(&cus, hipDeviceAttributeMultiprocessorCount, dev) != hipSuccess) { fprintf(stderr, "kernel_launch: hipGetDevice / hipDeviceGetAttribute failed; nothing launched\n"); grid = -1; return; }
        if (hipFuncSetAttribute((const void*)mk_fwd, hipFuncAttributeMaxDynamicSharedMemorySize, LDS_BYTES) != hipSuccess) { fprintf(stderr, "kernel_launch: hipFuncSetAttribute failed (%d bytes of dynamic LDS); nothing launched\n", LDS_BYTES); grid = -1; return; }
        if (hipOccupancyMaxActiveBlocksPerMultiprocessor(&per_cu, (const void*)mk_fwd, NTHR, LDS_BYTES) != hipSuccess || per_cu < 1) fprintf(stderr, "kernel_launch: note: occupancy query reports %d workgroups per CU\n", per_cu);
        (void)hipGetLastError();
        grid = cus;
        if (grid != 256) { fprintf(stderr, "kernel_launch: %d CUs; this build's unit orders are written for 256 (one workgroup per CU); nothing launched\n", grid); grid = -1; return; }
    }
    if (grid < 0) return;
    if (hipMemsetAsync((char*)d_ws + WS_CTL, 0, CTL_ZERO_BYTES, stream) != hipSuccess) { fprintf(stderr, "kernel_launch: hipMemsetAsync of the control words failed; nothing launched\n"); return; }
    Args a{};
    for (int i = 0; i < 29; ++i) a.in[i] = (const float*)d_in[i];
    a.out = (float*)d_out; a.ws = (unsigned char*)d_ws; a.ph_lo = 0; a.ph_hi = NPH; a.flags = 0; a.li = 0;
    hipLaunchKernelGGL(mk_fwd, dim3(grid), dim3(NTHR), LDS_BYTES, stream, a);
    const hipError_t le = hipPeekAtLastError();
    if (le != hipSuccess) fprintf(stderr, "kernel_launch: launch failed: %s\n", hipGetErrorName(le));
}
```

```cpp
#include <hip/hip_runtime.h>
#include <cstdio>
#include <cstdint>
#include <cmath>
constexpr int T_TOK = 16384, DM = 1024, SEQ = 2048, NB = 8, NIN = 2816, NINP = 5888, DFF = 2816;
constexpr size_t MiB = 1u << 20;
constexpr size_t WS_CTL = 0;
constexpr size_t WS_WIN = 1 * MiB, WS_WMKV = 13 * MiB, WS_WGLU = 15 * MiB, WS_WBR = 16 * MiB, WS_WOUT = 19 * MiB, WS_WGU = 21 * MiB, WS_WD = 32 * MiB;
constexpr size_t WS_WUV = 38 * MiB, WS_BIASL = 38 * MiB + 512 * 1024, WS_RS = 39 * MiB, WS_WI = 37 * MiB + 512 * 1024;
constexpr size_t WS_S5TV = 40 * MiB, WS_S5W = 60 * MiB, WS_KX = 68 * MiB, WS_VX = 70 * MiB, WS_MEMN = 72 * MiB, WS_H = 76 * MiB;
constexpr size_t WS_QD = 108 * MiB, WS_CKV = 140 * MiB, WS_QI = 144 * MiB, WS_KI = 160 * MiB, WS_QX = 162 * MiB, WS_U = 178 * MiB, WS_SLOC = 198 * MiB;
constexpr size_t WS_ODSA = 206 * MiB, WS_OX = 222 * MiB, WS_Y = 238 * MiB, WS_END = 254 * MiB;
constexpr size_t WS_G3 = 108 * MiB, WS_MERGED = WS_H, WS_XN = 108 * MiB, WS_ACT = 140 * MiB;
constexpr size_t WS_OS5 = 0, WS_G = WS_G3;
__device__ __forceinline__ int my_lane_id() { int l; asm volatile("v_mbcnt_lo_u32_b32 %0, -1, 0\n\tv_mbcnt_hi_u32_b32 %0, -1, %0" : "=v"(l)); return l; }
namespace pg8 {
#define PG8_LAS __attribute__((address_space(3)))
typedef unsigned short bf16_t;
typedef short bf16x8 __attribute__((ext_vector_type(8)));
typedef float f32x4 __attribute__((ext_vector_type(4)));
typedef unsigned u32x4 __attribute__((ext_vector_type(4)));
constexpr int BM = 256, BK = 64, HALF = 128, HTB = HALF * BK * 2  , STAGE_BYTES = 8 * HTB, NXCD = 8, WGM = 8;

__host__ __device__ __forceinline__ int lds_byte(int r, int c) { const int st = (r >> 4) * 2 + (c >> 5), rr = r & 15, cc = c & 31, ob = rr * 64 + cc * 2; return st * 1024 + (ob ^ (((ob >> 9) & 1) << 5)); }
__host__ __device__ __forceinline__ void stage_rc(int b, int& R, int& C) { const int st = b / 1024, sb = b % 1024, swz = sb ^ (((sb >> 9) & 1) << 5); R = (st >> 1) * 16 + swz / 64; C = (st & 1) * 32 + (swz % 64) / 2; }
__host__ __device__ __forceinline__ int perm32(int rho) { const int n = rho >> 4, i = rho & 15; return 8 * (i >> 2) + 4 * n + (i & 3); }

struct Unit { int pm, pn, z; };
struct Gemm { const bf16_t* A; const bf16_t* Bt; int M, N, K, lda, ldb; };

struct StaticOrder {
    int nM, nN, nwg, G, c;
    __host__ __device__ void init(int M, int N, int G_, int c_) { nM = M / BM; nN = N / BM; nwg = nM * nN; G = G_; c = c_; }
    __host__ __device__ bool next(int i, Unit& u) const {
        const long L = (long)i * G + c; if (L >= nwg) return false;
        int wgid = (int)L; { const int q = nwg / NXCD, r = nwg % NXCD, xcd = wgid % NXCD, off = wgid / NXCD; wgid = (xcd < r ? xcd * (q + 1) : r * (q + 1) + (xcd - r) * q) + off; }
        const int nig = WGM * nN, gid = wgid / nig, fm = gid * WGM, gsz = (nM - fm) < WGM ? (nM - fm) : WGM;
        u.pm = fm + ((wgid % nig) % gsz); u.pn = (wgid % nig) / gsz; u.z = 0; return true;
    }
    __device__ __forceinline__ void a_ready(const Unit&) const {}
    __device__ __forceinline__ void done(const Unit&) const {}
    __device__ __forceinline__ long a_off(const Unit&) const { return 0; }
    __device__ __forceinline__ long b_off(const Unit&) const { return 0; }
};

typedef float f32x2_c __attribute__((ext_vector_type(2))); typedef __bf16 bf16x2_c __attribute__((ext_vector_type(2)));
__device__ __forceinline__ unsigned cvt_pk_bf16(float lo, float hi) { const f32x2_c v = {lo, hi}; const bf16x2_c b = __builtin_convertvector(v, bf16x2_c); return __builtin_bit_cast(unsigned, b); }
typedef float f32x2 __attribute__((ext_vector_type(2)));
template <class Epi, class Sched, bool ALIGN_EPI = false, bool SP2 = false>
__device__ __forceinline__ void gemm_phase(PG8_LAS unsigned char* lds, const Gemm g, const Sched& S, const Epi& E, const int wid) {
    const int lane = my_lane_id(), tid = wid * 64 + lane, wr = wid >> 2, wc = wid & 3, fr = lane & 15, fq = lane >> 4;
    const int K = g.K, nt = K / BK, lda = g.lda, ldb = g.ldb;
    unsigned voffA[2], voffB[2];
#pragma unroll
    for (int i = 0; i < 2; ++i) { int R, C; stage_rc(tid * 16 + i * 8192, R, C); const int Rb = Epi::PERM ? ((R & ~31) + perm32(R & 31)) : R;
        voffA[i] = (unsigned)(R * lda + C) * 2u; voffB[i] = (unsigned)(Rb * ldb + C) * 2u; }
    const size_t kstep = (size_t)(BK * 2);
    const size_t hstepA = (size_t)HALF * lda * 2, hstepB = (size_t)HALF * ldb * 2;
    const size_t tstepA = 2 * hstepA, tstepB = 2 * hstepB;
    const unsigned ldsw = (unsigned)wid * 1024u;
    const int aoff = lds_byte(wr * 64 + fr, fq * 8), boff = lds_byte(wc * 32 + fr, fq * 8);
#define PG8_SA(b, h) (((b) * 2 + (h)) * HTB)
#define PG8_SB(b, h) ((4 + (b) * 2 + (h)) * HTB)
#define PG8_STAGE(bufoff, gbase, voff) do { _Pragma("unroll") for (int _i = 0; _i < 2; ++_i) \
        __builtin_amdgcn_global_load_lds((const unsigned*)((const char*)(gbase) + (voff)[_i]), (PG8_LAS unsigned*)(lds + (bufoff) + ldsw + _i * 8192), 16, 0, 0); } while (0)
#define PG8_LDA(dst, b, h) do { _Pragma("unroll") for (int m = 0; m < 4; ++m) _Pragma("unroll") for (int k = 0; k < 2; ++k) dst[m][k] = *(const PG8_LAS bf16x8*)(lds + PG8_SA(b, h) + aoff + m * 2048 + k * 1024); } while (0)
#define PG8_LDB(dst, b, h) do { _Pragma("unroll") for (int n = 0; n < 2; ++n) _Pragma("unroll") for (int k = 0; k < 2; ++k) dst[n][k] = *(const PG8_LAS bf16x8*)(lds + PG8_SB(b, h) + boff + n * 2048 + k * 1024); } while (0)
#define PG8_MMA(ai, bj, At, Bt) do { __builtin_amdgcn_s_setprio(1); _Pragma("unroll") for (int m = 0; m < 4; ++m) _Pragma("unroll") for (int n = 0; n < 2; ++n) _Pragma("unroll") for (int k = 0; k < 2; ++k) \
        acc[ai][bj][m][n] = __builtin_amdgcn_mfma_f32_16x16x32_bf16(Bt[n][k], At[m][k], acc[ai][bj][m][n], 0, 0, 0); __builtin_amdgcn_s_setprio(0); } while (0)
#define PG8_WAIT_V(n) asm volatile("s_waitcnt vmcnt(" #n ")" ::: "memory")
#define PG8_WAIT_L(n) asm volatile("s_waitcnt lgkmcnt(" #n ")" ::: "memory")
#define PG8_BAR __builtin_amdgcn_s_barrier()
#define PG8_SCHED __builtin_amdgcn_sched_barrier(0)
    Unit cur, nxt; int ui = 0;
    if (!S.next(0, cur)) return;
    f32x4 acc[2][2][4][2];
#pragma unroll
    for (int a = 0; a < 2; ++a)
#pragma unroll
        for (int b = 0; b < 2; ++b)
#pragma unroll
            for (int m = 0; m < 4; ++m)
#pragma unroll
                for (int n = 0; n < 2; ++n) acc[a][b][m][n] = (f32x4){0.f, 0.f, 0.f, 0.f};
    bf16x8 At[4][2], B0[2][2], B1[2][2];
    const char* cA = (const char*)g.A + (size_t)cur.pm * tstepA + S.a_off(cur); const char* cB = (const char*)g.Bt + (size_t)cur.pn * tstepB + S.b_off(cur);
    S.a_ready(cur);
    if constexpr (SP2) {
        PG8_STAGE(PG8_SB(0, 0), cB, voffB); PG8_STAGE(PG8_SB(0, 1), cB + hstepB, voffB); PG8_STAGE(PG8_SA(0, 0), cA, voffA); PG8_STAGE(PG8_SA(0, 1), cA + hstepA, voffA);
        if (wr == 1) PG8_BAR;
        PG8_WAIT_V(2); PG8_BAR;
        PG8_STAGE(PG8_SB(1, 0), cB + kstep, voffB); PG8_STAGE(PG8_SA(1, 0), cA + kstep, voffA); PG8_STAGE(PG8_SB(1, 1), cB + hstepB + kstep, voffB);
        PG8_WAIT_V(6); PG8_BAR;
    } else {
        PG8_STAGE(PG8_SB(0, 0), cB, voffB); PG8_STAGE(PG8_SA(0, 0), cA, voffA); PG8_STAGE(PG8_SB(0, 1), cB + hstepB, voffB); PG8_STAGE(PG8_SA(0, 1), cA + hstepA, voffA);
        if (wr == 1) PG8_BAR;
        PG8_WAIT_V(4); PG8_BAR;
        PG8_STAGE(PG8_SB(1, 0), cB + kstep, voffB); PG8_STAGE(PG8_SA(1, 0), cA + kstep, voffA); PG8_STAGE(PG8_SB(1, 1), cB + hstepB + kstep, voffB);
        PG8_WAIT_V(6); PG8_BAR;
    }
    for (;;) {
        const bool has_next = S.next(ui + 1, nxt);
        const char* nA = has_next ? (const char*)g.A + (size_t)nxt.pm * tstepA + S.a_off(nxt) : cA; const char* nB = has_next ? (const char*)g.Bt + (size_t)nxt.pn * tstepB + S.b_off(nxt) : cB;
        for (int t = 0; t < nt; t += 2) {
            const bool last = (t == nt - 2);
            const char* a1 = cA + (size_t)(t + 1) * kstep;
            const char* a2 = last ? nA : cA + (size_t)(t + 2) * kstep; const char* b2 = last ? nB : cB + (size_t)(t + 2) * kstep;
            const char* a3 = a2 + kstep; const char* b3 = b2 + kstep;
            if (last && has_next) S.a_ready(nxt);
            if constexpr (SP2) {
            PG8_LDB(B0, 0, 0); PG8_LDB(B1, 0, 1); PG8_SCHED; PG8_LDA(At, 0, 0); PG8_STAGE(PG8_SA(1, 1), a1 + hstepA, voffA);
            PG8_WAIT_V(8); PG8_WAIT_L(0); PG8_BAR; PG8_MMA(0, 0, At, B0); PG8_MMA(0, 1, At, B1); PG8_BAR; PG8_SCHED;
            PG8_LDA(At, 0, 1); PG8_STAGE(PG8_SB(0, 0), b2, voffB); PG8_STAGE(PG8_SB(0, 1), b2 + hstepB, voffB); PG8_STAGE(PG8_SA(0, 0), a2, voffA);
            PG8_WAIT_V(8); PG8_WAIT_L(0); PG8_BAR; PG8_MMA(1, 0, At, B0); PG8_MMA(1, 1, At, B1); PG8_BAR; PG8_SCHED;
            PG8_LDB(B0, 1, 0); PG8_LDB(B1, 1, 1); PG8_SCHED; PG8_LDA(At, 1, 0); PG8_STAGE(PG8_SA(0, 1), a2 + hstepA, voffA);
            PG8_WAIT_V(8); PG8_WAIT_L(0); PG8_BAR; PG8_MMA(0, 0, At, B0); PG8_MMA(0, 1, At, B1); PG8_BAR; PG8_SCHED;
            PG8_LDA(At, 1, 1); PG8_STAGE(PG8_SB(1, 0), b3, voffB); PG8_STAGE(PG8_SB(1, 1), b3 + hstepB, voffB); PG8_STAGE(PG8_SA(1, 0), a3, voffA);
            PG8_WAIT_V(8); PG8_WAIT_L(0); PG8_BAR; PG8_MMA(1, 0, At, B0); PG8_MMA(1, 1, At, B1); PG8_BAR; PG8_SCHED;
            } else {
            PG8_LDB(B0, 0, 0); PG8_SCHED; PG8_LDA(At, 0, 0); PG8_STAGE(PG8_SA(1, 1), a1 + hstepA, voffA);
            PG8_WAIT_L(8); PG8_BAR; PG8_WAIT_L(0); PG8_MMA(0, 0, At, B0); PG8_BAR; PG8_SCHED;
            PG8_LDB(B1, 0, 1); PG8_STAGE(PG8_SB(0, 0), b2, voffB);
            PG8_BAR; PG8_WAIT_L(0); PG8_MMA(0, 1, At, B1); PG8_BAR;
            PG8_LDA(At, 0, 1); PG8_STAGE(PG8_SA(0, 0), a2, voffA);
            PG8_BAR; PG8_WAIT_L(0); PG8_MMA(1, 0, At, B0); PG8_BAR; PG8_SCHED;
            PG8_STAGE(PG8_SB(0, 1), b2 + hstepB, voffB);
            PG8_WAIT_V(6); PG8_BAR; PG8_MMA(1, 1, At, B1); PG8_BAR;
            PG8_LDB(B0, 1, 0); PG8_SCHED; PG8_LDA(At, 1, 0); PG8_STAGE(PG8_SA(0, 1), a2 + hstepA, voffA);
            PG8_WAIT_L(8); PG8_BAR; PG8_WAIT_L(0); PG8_MMA(0, 0, At, B0); PG8_BAR; PG8_SCHED;
            PG8_LDB(B1, 1, 1); PG8_STAGE(PG8_SB(1, 0), b3, voffB);
            PG8_BAR; PG8_WAIT_L(0); PG8_MMA(0, 1, At, B1); PG8_BAR;
            PG8_LDA(At, 1, 1); PG8_STAGE(PG8_SA(1, 0), a3, voffA);
            PG8_BAR; PG8_WAIT_L(0); PG8_MMA(1, 0, At, B0); PG8_BAR; PG8_SCHED;
            PG8_STAGE(PG8_SB(1, 1), b3 + hstepB, voffB);
            PG8_WAIT_V(6); PG8_BAR; PG8_MMA(1, 1, At, B1); PG8_BAR;
            }
        }
        if constexpr (ALIGN_EPI) { if (wr == 0) PG8_BAR; }
        if constexpr (!Epi::AFTER_DRAIN) { E(acc, cur, wr, wc, fr, fq); S.done(cur); }
        if (!has_next) break;
#pragma unroll
        for (int a = 0; a < 2; ++a)
#pragma unroll
            for (int b = 0; b < 2; ++b)
#pragma unroll
                for (int m = 0; m < 4; ++m)
#pragma unroll
                    for (int n = 0; n < 2; ++n) acc[a][b][m][n] = (f32x4){0.f, 0.f, 0.f, 0.f};
        cur = nxt; cA = nA; cB = nB; ++ui;
        if constexpr (ALIGN_EPI) { if (wr == 1) PG8_BAR; }
    }
    PG8_WAIT_V(0);
    if constexpr (!ALIGN_EPI) { if (wr == 0) PG8_BAR; }
    PG8_BAR;
    if constexpr (Epi::AFTER_DRAIN) { E.fused(acc, cur, wr, wc, fr, fq, lds, wid, lane); S.done(cur); }
#undef PG8_SA
#undef PG8_SB
#undef PG8_STAGE
#undef PG8_LDA
#undef PG8_LDB
#undef PG8_MMA
#undef PG8_WAIT_V
#undef PG8_WAIT_L
#undef PG8_BAR
#undef PG8_SCHED
}
}
namespace pg8 {
typedef unsigned u32x2 __attribute__((ext_vector_type(2)));
__device__ __forceinline__ u32x4 pack8(const f32x4 a, const f32x4 b) { u32x4 w; w.x = cvt_pk_bf16(a[0], a[1]); w.y = cvt_pk_bf16(a[2], a[3]); w.z = cvt_pk_bf16(b[0], b[1]); w.w = cvt_pk_bf16(b[2], b[3]); return w; }
__device__ __forceinline__ void unpack8(const u32x4 w, f32x4& a, f32x4& b) {
    a[0] = __uint_as_float(w.x << 16); a[1] = __uint_as_float(w.x & 0xffff0000u); a[2] = __uint_as_float(w.y << 16); a[3] = __uint_as_float(w.y & 0xffff0000u);
    b[0] = __uint_as_float(w.z << 16); b[1] = __uint_as_float(w.z & 0xffff0000u); b[2] = __uint_as_float(w.w << 16); b[3] = __uint_as_float(w.w & 0xffff0000u); }
__device__ __forceinline__ float sigm(float v) { return __builtin_amdgcn_rcpf(1.f + __expf(-v)); }
__device__ __forceinline__ f32x4 sigm4(const f32x4 v) { f32x4 r; r[0] = sigm(v[0]); r[1] = sigm(v[1]); r[2] = sigm(v[2]); r[3] = sigm(v[3]); return r; }

__device__ __forceinline__ void norm128_stats(const f32x4 (&acc)[2][2][4][2], PG8_LAS float* XB, int wr, int wc, int fr, int fq, float (&rs)[2][2][4]) {
#pragma unroll
    for (int bj = 0; bj < 2; ++bj)
#pragma unroll
        for (int ai = 0; ai < 2; ++ai)
#pragma unroll
            for (int m = 0; m < 4; ++m) { const f32x4 a = acc[ai][bj][m][0], b = acc[ai][bj][m][1];
                float ss = ((a[0] * a[0] + a[1] * a[1]) + (a[2] * a[2] + a[3] * a[3])) + ((b[0] * b[0] + b[1] * b[1]) + (b[2] * b[2] + b[3] * b[3]));
                ss += __shfl_xor(ss, 16); ss += __shfl_xor(ss, 32);
                if (fq == 0) XB[(bj * 256 + ai * HALF + wr * 64 + m * 16 + fr) * 4 + wc] = ss; }
    asm volatile("s_waitcnt lgkmcnt(0)" ::: "memory"); __builtin_amdgcn_s_barrier(); asm volatile("" ::: "memory");
#pragma unroll
    for (int bj = 0; bj < 2; ++bj)
#pragma unroll
        for (int ai = 0; ai < 2; ++ai)
#pragma unroll
            for (int m = 0; m < 4; ++m) { const f32x4 p = *(const PG8_LAS f32x4*)(XB + (bj * 256 + ai * HALF + wr * 64 + m * 16 + fr) * 4);
                rs[bj][ai][m] = __builtin_amdgcn_rsqf(((p[0] + p[1]) + (p[2] + p[3])) * (1.f / 128.f) + 1e-6f); }
}
struct EpiInprojF {
    static constexpr bool PERM = true, AFTER_DRAIN = false;
    bf16_t *QD, *CKV, *QI, *KI, *U, *QX; float* WI; const float *gq, *gkv, *gqx; PG8_LAS float* XB;
    __device__ __forceinline__ void operator()(const f32x4 (&acc)[2][2][4][2], const Unit& u, int wr, int wc, int fr, int fq) const {
        const int row0 = u.pm * BM + wr * 64 + fr, cb = u.pn * BM;
        const bool nrm0 = cb < 1152 || cb >= 2304, nrm1 = cb + HALF < 1024 || cb + HALF >= 2304;
        float rs[2][2][4];
        if (nrm0 || nrm1) norm128_stats(acc, XB, wr, wc, fr, fq, rs);
#pragma unroll
        for (int bj = 0; bj < 2; ++bj) {
            const int c0 = cb + bj * HALF + wc * 32 + 8 * fq; const bool nrm = bj == 0 ? nrm0 : nrm1;
            bf16_t* base = QD; int ld = 1024, cc = c0, kind = 0; const float* gp = gq + (c0 & 127);
            if (c0 < 1024) { }
            else if (c0 < 1152) { base = CKV; ld = 128; cc = c0 - 1024; gp = gkv + cc; }
            else if (c0 < 1664) { base = QI; ld = 512; cc = c0 - 1152; }
            else if (c0 < 1728) { base = KI; ld = 64; cc = c0 - 1664; }
            else if (c0 < 1792) { kind = 1; }
            else if (c0 < 2304) { kind = 2; cc = c0 - 1792; }
            else { base = QX; ld = 512; cc = c0 - 2304; gp = gqx + (cc & 127); }
            f32x4 g0 = {1.f, 1.f, 1.f, 1.f}, g1 = g0;
            if (nrm) { g0 = *(const f32x4*)gp; g1 = *(const f32x4*)(gp + 4); }
#pragma unroll
            for (int ai = 0; ai < 2; ++ai)
#pragma unroll
                for (int m = 0; m < 4; ++m) {
                    const int t = row0 + ai * HALF + m * 16;
                    if (kind == 0) { f32x4 v0 = acc[ai][bj][m][0], v1 = acc[ai][bj][m][1]; if (nrm) { const float r = rs[bj][ai][m]; v0 = v0 * r * g0; v1 = v1 * r * g1; }
                        *(u32x4*)(base + (size_t)t * ld + cc) = pack8(v0, v1); }
                    else if (kind == 1) { if (c0 == 1728) { *(f32x4*)(WI + (size_t)t * 8) = acc[ai][bj][m][0]; *(f32x4*)(WI + (size_t)t * 8 + 4) = acc[ai][bj][m][1]; } }
                    else { const int g = cc >> 4, ci = cc & 15, b = t >> 11, tt = t & 2047, R = b * 64 + (tt >> 5), s = tt & 31;
                        *(u32x4*)(U + ((size_t)(g * 512 + R)) * 640 + s * 16 + ci) = pack8(acc[ai][bj][m][0], acc[ai][bj][m][1]); }
                }
        }
    }
};
struct EpiMemKVF {
    static constexpr bool PERM = true, AFTER_DRAIN = false;
    bf16_t* KX; bf16_t* VX; const float* gk; PG8_LAS float* XB;
    __device__ __forceinline__ void operator()(const f32x4 (&acc)[2][2][4][2], const Unit& u, int wr, int wc, int fr, int fq) const {
        const int row0 = u.pm * BM + wr * 64 + fr, cb = u.pn * BM; const bool nrm = cb < 512;
        float rs[2][2][4];
        if (nrm) norm128_stats(acc, XB, wr, wc, fr, fq, rs);
#pragma unroll
        for (int bj = 0; bj < 2; ++bj) {
            const int c0 = cb + bj * HALF + wc * 32 + 8 * fq;
            bf16_t* base = nrm ? KX : VX; const int cc = nrm ? c0 : c0 - 512;
            f32x4 g0 = {1.f, 1.f, 1.f, 1.f}, g1 = g0;
            if (nrm) { g0 = *(const f32x4*)(gk + (c0 & 127)); g1 = *(const f32x4*)(gk + (c0 & 127) + 4); }
#pragma unroll
            for (int ai = 0; ai < 2; ++ai)
#pragma unroll
                for (int m = 0; m < 4; ++m) { f32x4 v0 = acc[ai][bj][m][0], v1 = acc[ai][bj][m][1]; if (nrm) { const float r = rs[bj][ai][m]; v0 = v0 * r * g0; v1 = v1 * r * g1; }
                    *(u32x4*)(base + (size_t)(row0 + ai * HALF + m * 16) * 512 + cc) = pack8(v0, v1); }
        }
    }
};
struct EpiGluF {
    static constexpr bool PERM = true, AFTER_DRAIN = false;
    const bf16_t* Y; bf16_t* O;
    __device__ __forceinline__ void operator()(const f32x4 (&acc)[2][2][4][2], const Unit& u, int wr, int wc, int fr, int fq) const {
        const int row0 = u.pm * BM + wr * 64 + fr, c0 = u.pn * BM + wc * 32 + 8 * fq;
#pragma unroll
        for (int ai = 0; ai < 2; ++ai) {
            u32x4 yv[4][2];
#pragma unroll
            for (int m = 0; m < 4; ++m)
#pragma unroll
                for (int bj = 0; bj < 2; ++bj) yv[m][bj] = *(const u32x4*)(Y + (size_t)(row0 + ai * HALF + m * 16) * 512 + c0 + bj * HALF);
            asm volatile("" ::: "memory");
#pragma unroll
            for (int m = 0; m < 4; ++m)
#pragma unroll
                for (int bj = 0; bj < 2; ++bj) { f32x4 y0, y1; unpack8(yv[m][bj], y0, y1);
                    *(u32x4*)(O + (size_t)(row0 + ai * HALF + m * 16) * 512 + c0 + bj * HALF) = pack8(y0 * sigm4(acc[ai][bj][m][0]), y1 * sigm4(acc[ai][bj][m][1])); }
        }
    }
};
struct EpiSigmoidF {
    static constexpr bool PERM = true, AFTER_DRAIN = false;
    bf16_t* G; int ld;
    __device__ __forceinline__ void operator()(const f32x4 (&acc)[2][2][4][2], const Unit& u, int wr, int wc, int fr, int fq) const {
        const int row0 = u.pm * BM + wr * 64 + fr;
#pragma unroll
        for (int bj = 0; bj < 2; ++bj) {
            const int c0 = u.pn * BM + bj * HALF + wc * 32 + 8 * fq;
#pragma unroll
            for (int ai = 0; ai < 2; ++ai)
#pragma unroll
                for (int m = 0; m < 4; ++m) *(u32x4*)(G + (size_t)(row0 + ai * HALF + m * 16) * ld + c0) = pack8(sigm4(acc[ai][bj][m][0]), sigm4(acc[ai][bj][m][1]));
        }
    }
};
struct EpiMergeF {
    static constexpr bool PERM = true, AFTER_DRAIN = false;
    const bf16_t* G3; bf16_t* MG;
    __device__ __forceinline__ void operator()(const f32x4 (&acc)[2][2][4][2], const Unit& u, int wr, int wc, int fr, int fq) const {
        const int row0 = u.pm * BM + wr * 64 + fr, c0 = u.pn * BM + wc * 32 + 8 * fq; const bool first = u.z == 0;
#pragma unroll
        for (int ai = 0; ai < 2; ++ai) {
            u32x4 gv[4][2], pv[4][2];
#pragma unroll
            for (int m = 0; m < 4; ++m)
#pragma unroll
                for (int bj = 0; bj < 2; ++bj) { const size_t t = (size_t)(row0 + ai * HALF + m * 16);
                    gv[m][bj] = *(const u32x4*)(G3 + t * 3072 + u.z * 1024 + c0 + bj * HALF);
                    pv[m][bj] = first ? (u32x4){0u, 0u, 0u, 0u} : *(const u32x4*)(MG + t * 1024 + c0 + bj * HALF); }
            asm volatile("" ::: "memory");
#pragma unroll
            for (int m = 0; m < 4; ++m)
#pragma unroll
                for (int bj = 0; bj < 2; ++bj) { const size_t t = (size_t)(row0 + ai * HALF + m * 16);
                    f32x4 g0, g1, p0, p1; unpack8(gv[m][bj], g0, g1); unpack8(pv[m][bj], p0, p1);
                    *(u32x4*)(MG + t * 1024 + c0 + bj * HALF) = pack8(p0 + g0 * acc[ai][bj][m][0], p1 + g1 * acc[ai][bj][m][1]); }
        }
    }
};
struct EpiOutF {
    static constexpr bool PERM = false, AFTER_DRAIN = false;
    const float* x; float* out; bf16_t* XN; float* RS;
    __device__ __forceinline__ void operator()(const f32x4 (&acc)[2][2][4][2], const Unit& u, int wr, int wc, int fr, int fq) const {
        const int row0 = u.pm * BM + wr * 64 + fr, col0 = u.pn * BM + wc * 32 + 4 * fq;
#pragma unroll
        for (int ai = 0; ai < 2; ++ai) {
            f32x4 xv[4][2][2];
#pragma unroll
            for (int m = 0; m < 4; ++m)
#pragma unroll
                for (int bj = 0; bj < 2; ++bj)
#pragma unroll
                    for (int n = 0; n < 2; ++n) xv[m][bj][n] = *(const f32x4*)(x + (size_t)(row0 + ai * HALF + m * 16) * 1024 + col0 + bj * HALF + n * 16);
            asm volatile("" ::: "memory");
#pragma unroll
            for (int m = 0; m < 4; ++m) { const int t = row0 + ai * HALF + m * 16; const size_t off = (size_t)t * 1024 + col0; float ss = 0.f;
#pragma unroll
                for (int bj = 0; bj < 2; ++bj)
#pragma unroll
                    for (int n = 0; n < 2; ++n) { const size_t o2 = off + bj * HALF + n * 16; const f32x4 r = xv[m][bj][n] + acc[ai][bj][m][n];
                        u32x2 w; w.x = cvt_pk_bf16(r[0], r[1]); w.y = cvt_pk_bf16(r[2], r[3]); *(u32x2*)(XN + o2) = w;
                        ss += (r[0] * r[0] + r[1] * r[1]) + (r[2] * r[2] + r[3] * r[3]); }
                ss += __shfl_xor(ss, 16); ss += __shfl_xor(ss, 32);
                if (fq == 0) RS[(size_t)t * 16 + u.pn * 4 + wc] = ss; }
        }
    }
};
struct EpiGateUpF {
    static constexpr bool PERM = true, AFTER_DRAIN = false;
    const float* RS; bf16_t* ACT;
    __device__ __forceinline__ void operator()(const f32x4 (&acc)[2][2][4][2], const Unit& u, int wr, int wc, int fr, int fq) const {
        const int row0 = u.pm * BM + wr * 64 + fr, f0 = u.pn * HALF + wc * 32 + 8 * fq;
        f32x4 pr[2][4];
#pragma unroll
        for (int ai = 0; ai < 2; ++ai)
#pragma unroll
            for (int m = 0; m < 4; ++m) pr[ai][m] = *(const f32x4*)(RS + (size_t)(row0 + ai * HALF + m * 16) * 16 + 4 * fq);
        asm volatile("" ::: "memory");
#pragma unroll
        for (int ai = 0; ai < 2; ++ai)
#pragma unroll
            for (int m = 0; m < 4; ++m) { const int t = row0 + ai * HALF + m * 16;
                float tot = (pr[ai][m][0] + pr[ai][m][1]) + (pr[ai][m][2] + pr[ai][m][3]); tot += __shfl_xor(tot, 16); tot += __shfl_xor(tot, 32);
                const float rs = __builtin_amdgcn_rsqf(tot * (1.f / 1024.f) + 1e-6f);
                f32x4 o[2];
#pragma unroll
                for (int n = 0; n < 2; ++n) { const f32x4 g = acc[ai][0][m][n] * rs, up = acc[ai][1][m][n] * rs; o[n] = g * sigm4(g) * up; }
                *(u32x4*)(ACT + (size_t)t * 2816 + f0) = pack8(o[0], o[1]); }
    }
};
struct EpiDownF {
    static constexpr bool PERM = false, AFTER_DRAIN = false;
    const bf16_t* XN; float* out;
    __device__ __forceinline__ void operator()(const f32x4 (&acc)[2][2][4][2], const Unit& u, int wr, int wc, int fr, int fq) const {
        const int row0 = u.pm * BM + wr * 64 + fr, col0 = u.pn * BM + wc * 32 + 4 * fq;
#pragma unroll
        for (int ai = 0; ai < 2; ++ai) {
            u32x2 xv[4][2][2];
#pragma unroll
            for (int m = 0; m < 4; ++m)
#pragma unroll
                for (int bj = 0; bj < 2; ++bj)
#pragma unroll
                    for (int n = 0; n < 2; ++n) xv[m][bj][n] = *(const u32x2*)(XN + (size_t)(row0 + ai * HALF + m * 16) * 1024 + col0 + bj * HALF + n * 16);
            asm volatile("" ::: "memory");
#pragma unroll
            for (int m = 0; m < 4; ++m)
#pragma unroll
                for (int bj = 0; bj < 2; ++bj)
#pragma unroll
                    for (int n = 0; n < 2; ++n) { const u32x2 w = xv[m][bj][n];
                        const f32x4 x1 = {__uint_as_float(w.x << 16), __uint_as_float(w.x & 0xffff0000u), __uint_as_float(w.y << 16), __uint_as_float(w.y & 0xffff0000u)};
                        *(f32x4*)(out + (size_t)(row0 + ai * HALF + m * 16) * 1024 + col0 + bj * HALF + n * 16) = x1 + acc[ai][bj][m][n]; }
        }
    }
};
struct EpiSlocF {
    static constexpr bool PERM = false, AFTER_DRAIN = false;
    float* SLOC;
    __device__ __forceinline__ void operator()(const f32x4 (&acc)[2][2][4][2], const Unit& u, int wr, int wc, int fr, int fq) const {
        const int row0 = u.pm * BM + wr * 64 + fr, col0 = wc * 32 + 4 * fq;
#pragma unroll
        for (int ai = 0; ai < 2; ++ai)
#pragma unroll
            for (int m = 0; m < 4; ++m)
#pragma unroll
                for (int n = 0; n < 2; ++n) *(f32x4*)(SLOC + (size_t)(row0 + ai * HALF + m * 16) * 128 + col0 + n * 16) = acc[ai][0][m][n];
    }
};
__device__ __forceinline__ float gelu_t(float x) { const float w = 1.5957691216057308f * (x + 0.044715f * x * x * x); return x * __builtin_amdgcn_rcpf(1.f + __expf(-w)); }
struct EpiS5YF {
    static constexpr bool PERM = true, AFTER_DRAIN = false;
    const bf16_t* U; const float* dskip; bf16_t* Y;
    __device__ __forceinline__ void operator()(const f32x4 (&acc)[2][2][4][2], const Unit& u, int wr, int wc, int fr, int fq) const {
        const int row0 = u.pm * BM + wr * 64 + fr, g = (u.pm * BM) >> 9;
        f32x4 dk[2][2];
#pragma unroll
        for (int bj = 0; bj < 2; ++bj) { const int co0 = ((u.pn & 1) * BM + bj * HALF + wc * 32 + 8 * fq) & 15; dk[bj][0] = *(const f32x4*)(dskip + g * 16 + co0); dk[bj][1] = *(const f32x4*)(dskip + g * 16 + co0 + 4); }
#pragma unroll
        for (int ai = 0; ai < 2; ++ai) {
            u32x4 uv[4][2];
#pragma unroll
            for (int m = 0; m < 4; ++m)
#pragma unroll
                for (int bj = 0; bj < 2; ++bj) { const int cl = (u.pn & 1) * BM + bj * HALF + wc * 32 + 8 * fq; uv[m][bj] = *(const u32x4*)(U + (size_t)(row0 + ai * HALF + m * 16) * 640 + cl); }
            asm volatile("" ::: "memory");
#pragma unroll
            for (int m = 0; m < 4; ++m)
#pragma unroll
                for (int bj = 0; bj < 2; ++bj) { const int cl = (u.pn & 1) * BM + bj * HALF + wc * 32 + 8 * fq, s = cl >> 4, co0 = cl & 15;
                    const int row = row0 + ai * HALF + m * 16, R = row & 511, b = R >> 6, ch = R & 63, t = b * 2048 + ch * 32 + s;
                    f32x4 u0, u1; unpack8(uv[m][bj], u0, u1);
                    f32x4 y0 = acc[ai][bj][m][0] + dk[bj][0] * u0, y1 = acc[ai][bj][m][1] + dk[bj][1] * u1;
#pragma unroll
                    for (int e2 = 0; e2 < 4; ++e2) { y0[e2] = gelu_t(y0[e2]); y1[e2] = gelu_t(y1[e2]); }
                    *(u32x4*)(Y + (size_t)t * 512 + g * 16 + co0) = pack8(y0, y1); }
        }
    }
};
struct SubsetOrder { StaticOrder so; bool active;
    __device__ void init(int M, int N, int Gsub, int csub) { so.init(M, N, Gsub, csub < 0 ? 0 : csub); active = csub >= 0 && csub < Gsub; }
    __device__ bool next(int i, Unit& u) const { return active && so.next(i, u); }
    __device__ __forceinline__ void a_ready(const Unit&) const {}
    __device__ __forceinline__ void done(const Unit&) const {}
    __device__ __forceinline__ long a_off(const Unit&) const { return 0; }
    __device__ __forceinline__ long b_off(const Unit&) const { return 0; } };
struct S5Order1 { int c;
    __device__ bool next(int i, Unit& u) const { if (i > 0 || c < 0 || c >= 64) return false; u.pm = c; u.pn = c >> 1; u.z = 0; return true; }
    __device__ __forceinline__ void a_ready(const Unit&) const {}
    __device__ __forceinline__ void done(const Unit&) const {}
    __device__ __forceinline__ long a_off(const Unit&) const { return 0; }
    __device__ __forceinline__ long b_off(const Unit&) const { return 0; } };
struct S5Order2 { int c;
    __device__ bool next(int i, Unit& u) const { if (i > 0 || c < 0 || c >= 128) return false; const int g = c >> 2; u.pm = g * 2 + ((c >> 1) & 1); u.pn = g * 2 + (c & 1); u.z = 0; return true; }
    __device__ __forceinline__ void a_ready(const Unit&) const {}
    __device__ __forceinline__ void done(const Unit&) const {}
    __device__ __forceinline__ long a_off(const Unit&) const { return 0; }
    __device__ __forceinline__ long b_off(const Unit&) const { return 0; } };
struct GateOrder { int c;
    __device__ bool next(int i, Unit& u) const { int id; if (c < 128) { if (i >= 2) return false; id = c * 2 + i; } else { if (i >= 4) return false; id = 256 + (c - 128) * 4 + i; } u.pm = id / 12; u.pn = id % 12; u.z = 0; return true; }
    __device__ __forceinline__ void a_ready(const Unit&) const {}
    __device__ __forceinline__ void done(const Unit&) const {}
    __device__ __forceinline__ long a_off(const Unit&) const { return 0; }
    __device__ __forceinline__ long b_off(const Unit&) const { return 0; } };
struct MergeOrder { StaticOrder so; long aoff[3];
    __device__ bool next(int i, Unit& u) const { if (i >= 3) return false; if (!so.next(0, u)) return false; u.z = i; return true; }
    __device__ __forceinline__ void a_ready(const Unit&) const {}
    __device__ __forceinline__ void done(const Unit&) const {}
    __device__ __forceinline__ long a_off(const Unit& u) const { return u.z == 0 ? aoff[0] : (u.z == 1 ? aoff[1] : aoff[2]); }
    __device__ __forceinline__ long b_off(const Unit& u) const { return (long)u.z * 1024 * 512 * 2; } };
}
#define GAS __attribute__((address_space(1)))
#define LAS __attribute__((address_space(3)))
typedef unsigned short bf16;
typedef unsigned v4u __attribute__((ext_vector_type(4)));
typedef float f32x4 __attribute__((ext_vector_type(4)));
typedef short bf16x8 __attribute__((ext_vector_type(8)));
typedef GAS unsigned gu32;
typedef GAS unsigned long long gu64;
#define RLX_AGENT __ATOMIC_RELAXED, __HIP_MEMORY_SCOPE_AGENT
#define LDS_WAIT() asm volatile("s_waitcnt lgkmcnt(0)" ::: "memory")
#define VM_WAIT() asm volatile("s_waitcnt vmcnt(0)" ::: "memory")
__device__ __forceinline__ unsigned long long rt() { return __builtin_amdgcn_s_memrealtime(); }
__device__ __forceinline__ unsigned f2bf(float f) { unsigned u = __builtin_bit_cast(unsigned, f); return (u + 0x7fffu + ((u >> 16) & 1u)) >> 16; }
__device__ __forceinline__ unsigned pk2(float lo, float hi) { return f2bf(lo) | (f2bf(hi) << 16); }

#define XB_TMO      128
#define XB_XCNT(j)  (256  + 64 * (j))
#define XB_XSUB(j)  (1280 + 64 * (j))
#define XB_XGEN(j)  (2304 + 64 * (j))
#define XB_TOP      3328
#define XB_TOPGEN   3392
#define XCD_BAR_WORDS 3456
#define XB_SPIN_CAP (1u << 18)

__device__ __forceinline__ unsigned xb_ld(unsigned* p)              { return __hip_atomic_load(p, __ATOMIC_RELAXED, __HIP_MEMORY_SCOPE_AGENT); }
__device__ __forceinline__ unsigned xb_add(unsigned* p, unsigned v) { return __hip_atomic_fetch_add(p, v, __ATOMIC_RELAXED, __HIP_MEMORY_SCOPE_AGENT); }
__device__ __forceinline__ unsigned xb_xcc_id() { return (unsigned)__builtin_amdgcn_s_getreg((3 << 11) | 20) & 0xFu; }
#define XB_SPIN(cond, bar) do { unsigned _sp = 0; while (cond) { __builtin_amdgcn_s_sleep(1); \
    if ((++_sp & 255u) == 0u) { if (xb_ld(&(bar)[XB_TMO])) break; if (_sp > XB_SPIN_CAP) { atomicAdd(&(bar)[XB_TMO], 1u); break; } } } } while (0)

struct XcdBarrier {
    unsigned* bar; unsigned x;
    volatile LAS unsigned* st;
};

__device__ __forceinline__ XcdBarrier xcd_barrier_post(unsigned* bar, volatile LAS unsigned* st, bool leader) {
    XcdBarrier b; b.bar = bar; b.x = xb_xcc_id(); b.st = st;
    if (leader) (void)xb_add(&bar[XB_XCNT(b.x)], 1u);
    return b;
}
__device__ __forceinline__ void xcd_barrier_complete(unsigned* bar, unsigned x, unsigned& nloc, unsigned& nx) {
    const unsigned G = gridDim.x * gridDim.y * gridDim.z;
    unsigned sum, cnt, mine, sp = 0u;
    for (;;) {
        sum = 0u; cnt = 0u; mine = 0u;
#pragma unroll
        for (unsigned j = 0; j < 16; ++j) { const unsigned c = xb_ld(&bar[XB_XCNT(j)]); sum += c; cnt += (c > 0u) ? 1u : 0u; mine = (j == x) ? c : mine; }
        if (sum == G) break;
        __builtin_amdgcn_s_sleep(1);
        if ((++sp & 255u) == 0u) { if (xb_ld(&bar[XB_TMO])) break; if (sp > XB_SPIN_CAP) { atomicAdd(&bar[XB_TMO], 1u); break; } }
    }
    nloc = mine > 0u ? mine : 1u; nx = cnt > 0u ? cnt : 1u;
}

__device__ __forceinline__ void xcd_barrier(const XcdBarrier& b, bool leader) {
    asm volatile("s_waitcnt vmcnt(0)" ::: "memory");
    __syncthreads();
    if (leader) {
        unsigned* bar = b.bar;
        __builtin_amdgcn_s_waitcnt(0);
        unsigned nloc = b.st[0], nx = b.st[1];
        if (nloc == 0u) { xcd_barrier_complete(bar, b.x, nloc, nx); b.st[0] = nloc; b.st[1] = nx; }
        const unsigned old = xb_add(&bar[XB_XSUB(b.x)], 1u);
        const unsigned gen = old / nloc;
        if (old + 1u == (gen + 1u) * nloc) {
            __builtin_amdgcn_fence(__ATOMIC_RELEASE, "agent");
            asm volatile("s_waitcnt vmcnt(0)" ::: "memory");
            const unsigned og = xb_add(&bar[XB_TOP], 1u);
            const unsigned tg = og / nx;
            if (og + 1u == (tg + 1u) * nx) xb_add(&bar[XB_TOPGEN], 1u);
            else XB_SPIN(xb_ld(&bar[XB_TOPGEN]) == tg, bar);
            __builtin_amdgcn_fence(__ATOMIC_ACQUIRE, "agent");
            xb_add(&bar[XB_XGEN(b.x)], 1u);
            asm volatile("s_waitcnt vmcnt(0)" ::: "memory");
        } else {
            XB_SPIN(xb_ld(&bar[XB_XGEN(b.x)]) == gen, bar);
            __builtin_amdgcn_fence(__ATOMIC_ACQUIRE, "agent");
            asm volatile("s_waitcnt vmcnt(0)" ::: "memory");
        }
    }
    __syncthreads();
}
constexpr int NWAVES = 8, NTHR = 512;
constexpr int RING_OFF = 0, RING_BYTES = 131072;
constexpr int LDSCTL_OFF = RING_BYTES, MISC_OFF = LDSCTL_OFF + 320, XB_OFF = RING_BYTES + 1024;
constexpr int LDS_BYTES = 147456;
constexpr size_t CTL_ZERO_BYTES = 65536;
constexpr int CW_TMO = 0, CW_BAR = 4096;
constexpr int NPH = 9;
constexpr int FL_NO_DSA = 1, FL_NO_CROSS = 2, FL_NO_S5 = 4;
constexpr size_t WS_LAM32 = WS_BIASL + 8192;

struct Args { const float* in[29]; float* out; unsigned char* ws; int ph_lo, ph_hi, flags, li; };

__device__ __forceinline__ float wave_sum(float v) {
#pragma unroll
    for (int o = 1; o < 64; o <<= 1) v += __shfl_xor(v, o);
    return v;
}
__device__ __forceinline__ float p0_src(int mode, const float* W, const float* W2, const float* gain, int N, int k, int d) {
    if (mode == 0) return W[(size_t)k * N + d];
    if (mode == 1) { if (d >= 1736 && d < 1792) return 0.f; const int s = d >= 1792 ? d - 56 : d; return W[(size_t)k * N + s]; }
    const int tile = d >> 8, w = d & 255, f = tile * 128 + (w & 127); return ((w < 128) ? W : W2)[(size_t)k * N + f] * gain[k];
}
__device__ __forceinline__ void p0_transpose_item(int mode, const float* W, const float* W2, const float* gain, int K, int N, int ND, bf16* WT, LAS float* scr, int item, int lane) {
    const int nblk = ND / 32, kb = item / nblk, nb = item % nblk, k0 = 64 * kb, d0 = 32 * nb;
    float tv[32];
#pragma unroll
    for (int i = 0; i < 32; ++i) tv[i] = p0_src(mode, W, W2, gain, N, k0 + 2 * i + (lane >> 5), d0 + (lane & 31));
#pragma unroll
    for (int i = 0; i < 32; ++i) scr[(2 * i + (lane >> 5)) * 33 + (lane & 31)] = tv[i];
    LDS_WAIT(); asm volatile("" ::: "memory");
    const int c = lane & 7;
#pragma unroll
    for (int j = 0; j < 4; ++j) { const int n = (lane >> 3) + 8 * j; const LAS float* s = scr + (8 * c) * 33 + n;
        v4u o; o.x = pk2(s[0 * 33], s[1 * 33]); o.y = pk2(s[2 * 33], s[3 * 33]); o.z = pk2(s[4 * 33], s[5 * 33]); o.w = pk2(s[6 * 33], s[7 * 33]);
        *(GAS v4u*)(WT + (size_t)(d0 + n) * K + k0 + 8 * c) = o; }
    LDS_WAIT(); asm volatile("" ::: "memory");
}
__device__ __forceinline__ void rms_row_to_bf16(const float* xrow, const float* g, bf16* orow, int lane) {
    const GAS f32x4* xr = (const GAS f32x4*)xrow + lane; const GAS f32x4* gr = (const GAS f32x4*)g + lane;
    f32x4 v[4]; float s = 0.f;
#pragma unroll
    for (int j = 0; j < 4; ++j) { v[j] = xr[64 * j]; s += (v[j].x * v[j].x + v[j].y * v[j].y) + (v[j].z * v[j].z + v[j].w * v[j].w); }
    const float rstd = 1.f / sqrtf(wave_sum(s) * (1.f / 1024.f) + 1e-6f);
    GAS unsigned long long* o8 = (GAS unsigned long long*)orow + lane;
#pragma unroll
    for (int j = 0; j < 4; ++j) { const f32x4 gg = gr[64 * j];
        o8[64 * j] = (unsigned long long)pk2(v[j].x * rstd * gg.x, v[j].y * rstd * gg.y) | ((unsigned long long)pk2(v[j].z * rstd * gg.z, v[j].w * rstd * gg.w) << 32); }
}
__device__ __forceinline__ int t5_bucket(int n) {
    if (n < 16) return n;
    const int large = 16 + (int)((logf((float)n / 16.f) / 2.0794415416798357f) * 16.f);
    return large < 31 ? large : 31;
}
__device__ __forceinline__ void p0_s5_tables(int g, int part, const Args& a, LAS unsigned char* lds, int tid) {
    typedef float f32x2v __attribute__((ext_vector_type(2)));
    LAS f32x2v* POW = (LAS f32x2v*)lds;
    LAS f32x2v* BB = POW + 33 * 64;
    LAS f32x2v* CC = BB + 64 * 16;
    LAS float* KT = (LAS float*)(CC + 16 * 64);
    const float *a_re = a.in[8], *a_im = a.in[9], *log_dt = a.in[10], *b_re = a.in[11], *b_im = a.in[12], *c_re = a.in[13], *c_im = a.in[14];
    bf16* TV = (bf16*)(a.ws + WS_S5TV) + (size_t)g * 512 * 640; bf16* Wt = (bf16*)(a.ws + WS_S5W) + (size_t)g * 256 * 512; float* LAM32 = (float*)(a.ws + WS_LAM32) + g * 128;
    const double dt = exp((double)log_dt[g]);
    for (int idx = tid; idx < 33 * 64; idx += NTHR) { const int j = idx >> 6, n = idx & 63; const double lr = a_re[g * 64 + n], li = a_im[g * 64 + n];
        const double mag = exp(lr * dt * j), ang = li * dt * j; POW[idx] = (f32x2v){(float)(mag * cos(ang)), (float)(mag * sin(ang))}; }
    for (int idx = tid; idx < 64 * 16; idx += NTHR) { const int n = idx >> 4, c = idx & 15; const double lr = a_re[g * 64 + n], li = a_im[g * 64 + n];
        const double mag = exp(lr * dt), lbr = mag * cos(li * dt), lbi = mag * sin(li * dt), nr = lbr - 1.0, ni = lbi, den = lr * lr + li * li;
        const double fr = (nr * lr + ni * li) / den, fi = (ni * lr - nr * li) / den, br = b_re[(g * 64 + n) * 16 + c], bi = b_im[(g * 64 + n) * 16 + c];
        BB[idx] = (f32x2v){(float)(fr * br - fi * bi), (float)(fr * bi + fi * br)};
        const int c2 = idx >> 6, n2 = idx & 63; CC[idx] = (f32x2v){c_re[(g * 16 + c2) * 64 + n2], c_im[(g * 16 + c2) * 64 + n2]}; }
    __syncthreads();
    if (part == 0 && tid < 64) { const f32x2v p = POW[32 * 64 + tid]; LAM32[tid * 2] = p.x; LAM32[tid * 2 + 1] = p.y; }
    for (int idx = tid; idx < 32 * 32; idx += NTHR) { const int j = idx >> 5, co = 2 * part + ((idx >> 4) & 1), ci = idx & 15; float s = 0.f;
#pragma unroll 2
        for (int n = 0; n < 64; ++n) { const f32x2v c = CC[co * 64 + n], p = POW[j * 64 + n], b = BB[n * 16 + ci];
            const float cpr = c.x * p.x - c.y * p.y, cpi = c.x * p.y + c.y * p.x; s += cpr * b.x - cpi * b.y; }
        KT[j * 256 + co * 16 + ci] = s; }
    __syncthreads();
    for (int id = tid; id < 64 * 80; id += NTHR) { const int rl = id / 80, c8 = id % 80, so = rl >> 1, co = 2 * part + (rl & 1), row = so * 16 + co; float v[8];
        if (c8 < 64) { const int si = c8 >> 1, ci0 = (c8 & 1) * 8;
#pragma unroll
            for (int e = 0; e < 8; ++e) v[e] = so >= si ? KT[(so - si) * 256 + co * 16 + ci0 + e] : 0.f; }
        else {
#pragma unroll
            for (int e = 0; e < 8; ++e) { const int np = (c8 - 64) * 8 + e, n = np & 63; const f32x2v c = CC[co * 64 + n], p = POW[(so + 1) * 64 + n];
                v[e] = np < 64 ? (c.x * p.x - c.y * p.y) : -(c.x * p.y + c.y * p.x); } }
        v4u o; o.x = pk2(v[0], v[1]); o.y = pk2(v[2], v[3]); o.z = pk2(v[4], v[5]); o.w = pk2(v[6], v[7]);
        *(GAS v4u*)(TV + (size_t)row * 640 + c8 * 8) = o; }
    for (int id = tid; id < 16 * 64; id += NTHR) { const int np = 16 * part + (id >> 6), c8 = id & 63, n = np & 63, s = c8 >> 1, ci0 = (c8 & 1) * 8; const f32x2v p = POW[(31 - s) * 64 + n]; float v[8];
#pragma unroll
        for (int e = 0; e < 8; ++e) { const f32x2v b = BB[n * 16 + ci0 + e]; v[e] = np < 64 ? (p.x * b.x - p.y * b.y) : (p.x * b.y + p.y * b.x); }
        v4u o; o.x = pk2(v[0], v[1]); o.y = pk2(v[2], v[3]); o.z = pk2(v[4], v[5]); o.w = pk2(v[6], v[7]);
        *(GAS v4u*)(Wt + (size_t)np * 512 + c8 * 8) = o; }
    __syncthreads();
}
#ifndef P0RPT
#define P0RPT 0
#endif
#define P0R(k) ((P0RPT >> (k)) & 1)
__device__ __forceinline__ void p0_prologue(const Args& a, LAS unsigned char* lds, int tid, int lane, int wave, int vcu, int G) {
    unsigned char* ws = a.ws;
    LAS float* scr = (LAS float*)(lds + RING_OFF + wave * 16384);
    const int gw = vcu * NWAVES + wave, NGW = G * NWAVES;
    p0_s5_tables(vcu >> 3, vcu & 7, a, lds, tid);
    if (blockIdx.x == 33 && wave == 0) {
        float gq = fmaxf(fabsf(a.in[5][lane]), fabsf(a.in[5][lane + 64])), gk = fmaxf(fabsf(a.in[6][lane]), fabsf(a.in[6][lane + 64]));
        float bm = fmaxf(fmaxf(fabsf(a.in[2][lane]), fabsf(a.in[2][lane + 64])), fmaxf(fabsf(a.in[2][lane + 128]), fabsf(a.in[2][lane + 192])));
#pragma unroll
        for (int o = 1; o < 64; o <<= 1) { gq = fmaxf(gq, __shfl_xor(gq, o)); gk = fmaxf(gk, __shfl_xor(gk, o)); bm = fmaxf(bm, __shfl_xor(bm, o)); }
        const float B = 1.02f * 128.f * 0.08838834764831845f * 1.4426950408889634f * gq * gk + bm * 1.4426950408889634f;
        if (lane == 0) ((float*)(ws + WS_BIASL))[1032] = (B > 0.f && B <= 56.f) ? B : 0.f; }
    if (blockIdx.x == 32) { float* BL = (float*)(ws + WS_BIASL); const float* rb = a.in[2];
        for (int i = tid; i < 8 * 128 + 8; i += NTHR) { if (i < 1024) { const int h = i >> 7, d = i & 127; BL[i] = rb[t5_bucket(d) * 8 + h] * 1.4426950408889634f; } else BL[i] = rb[31 * 8 + (i - 1024)] * 1.4426950408889634f; } }
    { bf16* WUV = (bf16*)(ws + WS_WUV); const float* w = a.in[7];
        for (int i = blockIdx.x * NTHR + tid; i < 8 * 64 * 128; i += G * NTHR) { const int ep = i & 3, ln = (i >> 2) & 63, t = (i >> 8) & 1, cs = (i >> 9) & 7, eb = (i >> 12) & 1, h = i >> 13;
            const int d = 16 * cs + 8 * t + 4 * (ln >> 5) + ep, e = 32 * eb + (ln & 31); WUV[i] = (bf16)f2bf(w[(h * 128 + d) * 64 + e]); } }
    constexpr int I_IN = 16 * 184, I_MKV = 16 * 32, I_GLU = 8 * 16, I_BR = 8 * 32, I_OUT = 16 * 32, I_GU = 16 * 176, I_D = 44 * 32;
    constexpr int NITEMS = I_IN + I_MKV + I_GLU + 3 * I_BR + I_OUT + I_GU + I_D;
    _Pragma("unroll 1") for (int rp_ = 0; rp_ <= P0R(1); ++rp_)
    for (int it = gw; it < NITEMS; it += NGW) {
        int r = it;
        if (r < I_IN) { p0_transpose_item(1, a.in[3], nullptr, nullptr, 1024, 5832, 5888, (bf16*)(ws + WS_WIN), scr, r, lane); continue; } r -= I_IN;
        if (r < I_MKV) { p0_transpose_item(0, a.in[18], nullptr, nullptr, 1024, 1024, 1024, (bf16*)(ws + WS_WMKV), scr, r, lane); continue; } r -= I_MKV;
        if (r < I_GLU) { p0_transpose_item(0, a.in[16], nullptr, nullptr, 512, 512, 512, (bf16*)(ws + WS_WGLU), scr, r, lane); continue; } r -= I_GLU;
        if (r < 3 * I_BR) { const int br = r / I_BR; p0_transpose_item(0, a.in[21 + br], nullptr, nullptr, 512, 1024, 1024, (bf16*)(ws + WS_WBR) + (size_t)br * 1024 * 512, scr, r % I_BR, lane); continue; } r -= 3 * I_BR;
        if (r < I_OUT) { p0_transpose_item(0, a.in[24], nullptr, nullptr, 1024, 1024, 1024, (bf16*)(ws + WS_WOUT), scr, r, lane); continue; } r -= I_OUT;
        if (r < I_GU) { p0_transpose_item(2, a.in[26], a.in[27], a.in[25], 1024, 2816, 5632, (bf16*)(ws + WS_WGU), scr, r, lane); continue; } r -= I_GU;
        p0_transpose_item(0, a.in[28], nullptr, nullptr, 2816, 1024, 1024, (bf16*)(ws + WS_WD), scr, r, lane);
    }
    _Pragma("unroll 1") for (int rp_ = 0; rp_ <= P0R(2); ++rp_)
    for (int m = gw; m < T_TOK; m += 2 * NGW) {
        const GAS f32x4* x0 = (const GAS f32x4*)(a.in[0] + (size_t)m * 1024) + lane; const GAS f32x4* x1 = (const GAS f32x4*)(a.in[0] + (size_t)(m + NGW) * 1024) + lane; const GAS f32x4* gr = (const GAS f32x4*)a.in[4] + lane;
        f32x4 v0[4], v1[4]; float s0 = 0.f, s1 = 0.f;
#pragma unroll
        for (int j = 0; j < 4; ++j) { v0[j] = x0[64 * j]; v1[j] = x1[64 * j]; }
#pragma unroll
        for (int j = 0; j < 4; ++j) { s0 += (v0[j].x * v0[j].x + v0[j].y * v0[j].y) + (v0[j].z * v0[j].z + v0[j].w * v0[j].w); s1 += (v1[j].x * v1[j].x + v1[j].y * v1[j].y) + (v1[j].z * v1[j].z + v1[j].w * v1[j].w); }
        const float r0 = 1.f / sqrtf(wave_sum(s0) * (1.f / 1024.f) + 1e-6f), r1 = 1.f / sqrtf(wave_sum(s1) * (1.f / 1024.f) + 1e-6f);
        GAS unsigned long long* o0 = (GAS unsigned long long*)((bf16*)(ws + WS_H) + (size_t)m * 1024) + lane; GAS unsigned long long* o1 = (GAS unsigned long long*)((bf16*)(ws + WS_H) + (size_t)(m + NGW) * 1024) + lane;
#pragma unroll
        for (int j = 0; j < 4; ++j) { const f32x4 gg = gr[64 * j];
            o0[64 * j] = (unsigned long long)pk2(v0[j].x * r0 * gg.x, v0[j].y * r0 * gg.y) | ((unsigned long long)pk2(v0[j].z * r0 * gg.z, v0[j].w * r0 * gg.w) << 32);
            o1[64 * j] = (unsigned long long)pk2(v1[j].x * r1 * gg.x, v1[j].y * r1 * gg.y) | ((unsigned long long)pk2(v1[j].z * r1 * gg.z, v1[j].w * r1 * gg.w) << 32); }
    }
    for (int m = gw; m < 2048; m += NGW) rms_row_to_bf16(a.in[1] + (size_t)m * 1024, a.in[17], (bf16*)(ws + WS_MEMN) + (size_t)m * 1024, lane);
    if (P0R(0)) { __syncthreads(); p0_s5_tables(vcu >> 3, vcu & 7, a, lds, tid); }
}
__device__ __forceinline__ void norm128_pass(bf16* X, int rows, int ld, int ngroups, const float* g, int gtid, int nthr) {
    const int l = gtid & 15, total = rows * ngroups;
    for (int gid = gtid >> 4; gid < total; gid += nthr >> 4) {
        const int r = gid / ngroups, gi = gid % ngroups;
        bf16* p = X + (size_t)r * ld + gi * 128 + l * 8;
        const v4u v = *(const GAS v4u*)p; float f[8];
        f[0] = __uint_as_float(v.x << 16); f[1] = __uint_as_float(v.x & 0xffff0000u); f[2] = __uint_as_float(v.y << 16); f[3] = __uint_as_float(v.y & 0xffff0000u);
        f[4] = __uint_as_float(v.z << 16); f[5] = __uint_as_float(v.z & 0xffff0000u); f[6] = __uint_as_float(v.w << 16); f[7] = __uint_as_float(v.w & 0xffff0000u);
        float s = 0.f;
#pragma unroll
        for (int q = 0; q < 8; ++q) s += f[q] * f[q];
        s += __shfl_xor(s, 8); s += __shfl_xor(s, 4); s += __shfl_xor(s, 2); s += __shfl_xor(s, 1);
        const float rs = 1.f / sqrtf(s * (1.f / 128.f) + 1e-6f);
        const f32x4 g0 = *(const GAS f32x4*)(g + l * 8), g1 = *(const GAS f32x4*)(g + l * 8 + 4);
        v4u o; o.x = pk2(f[0] * rs * g0.x, f[1] * rs * g0.y); o.y = pk2(f[2] * rs * g0.z, f[3] * rs * g0.w); o.z = pk2(f[4] * rs * g1.x, f[5] * rs * g1.y); o.w = pk2(f[6] * rs * g1.z, f[7] * rs * g1.w);
        *(GAS v4u*)p = o;
    }
}
__device__ __forceinline__ void s5_scan(int g, int half, const Args& a, int tid) {
    if (tid < 256) {
        const int bl = tid >> 6, n = tid & 63, b = half * 4 + bl;
        const float* LAM32 = (const float*)(a.ws + WS_LAM32) + g * 128; const float lr = LAM32[n * 2], li = LAM32[n * 2 + 1];
        const float* SL = (const float*)(a.ws + WS_SLOC) + ((size_t)(g * 512 + b * 64)) * 128; bf16* Ur = (bf16*)(a.ws + WS_U) + ((size_t)(g * 512 + b * 64)) * 640 + 512;
        float xr = 0.f, xi = 0.f;
#pragma unroll 1
        for (int c0 = 0; c0 < 64; c0 += 16) {
            float sr[16], si[16];
#pragma unroll
            for (int k = 0; k < 16; ++k) { sr[k] = SL[(size_t)(c0 + k) * 128 + n]; si[k] = SL[(size_t)(c0 + k) * 128 + 64 + n]; }
#pragma unroll
            for (int k = 0; k < 16; ++k) {
                Ur[(size_t)(c0 + k) * 640 + n] = (bf16)f2bf(xr); Ur[(size_t)(c0 + k) * 640 + 64 + n] = (bf16)f2bf(xi);
                const float nr = lr * xr - li * xi + sr[k], ni = lr * xi + li * xr + si[k]; xr = nr; xi = ni;
            }
        }
    }
    VM_WAIT(); __syncthreads();
}
#define HAVE_ATTN 1
#ifdef TPROBE
#if TPROBE < 8
#define TP_STAMP(k) { __builtin_amdgcn_sched_barrier(0); const unsigned long long t_ = __builtin_amdgcn_s_memtime(); tp_acc[k] += t_ - tp_prev; tp_prev = t_; __builtin_amdgcn_sched_barrier(0); }
#define TP_DECL unsigned long long tp_acc[8] = {0, 0, 0, 0, 0, 0, 0, 0}; unsigned long long tp_prev = __builtin_amdgcn_s_memtime();
#define TP_FLUSH(base) { if (blockIdx.x == TPROBE_BLOCK && wave == 0 && lane == 0) { unsigned long long* TP = (unsigned long long*)(a.ws + WS_CTL + 65536); for (int k_ = 0; k_ < 8; ++k_) TP[(base) + k_] += tp_acc[k_]; } }
#define TQ_STAMP(k)
#define TQ_DECL
#define TQ_FLUSH
#else
#define TP_STAMP(k)
#define TP_DECL
#define TP_FLUSH(base)
#define TQ_STAMP(k) { const unsigned t_ = (unsigned)__builtin_amdgcn_s_memtime(); tq_acc[k] += t_ - tq_prev; tq_prev = t_; }
#define TQ_DECL unsigned tq_acc[4] = {0, 0, 0, 0}; unsigned tq_prev = (unsigned)__builtin_amdgcn_s_memtime();
#define TQ_FLUSH { if (blockIdx.x == TPROBE_BLOCK && wave == 0 && lane == 0) { unsigned long long* TP = (unsigned long long*)(a.ws + WS_CTL + 65536); for (int k_ = 0; k_ < 4; ++k_) TP[8 + k_] += tq_acc[k_]; } }
#endif
#else
#define TP_STAMP(k)
#define TP_DECL
#define TP_FLUSH(base)
#define TQ_STAMP(k)
#define TQ_DECL
#define TQ_FLUSH
#endif
namespace att {
typedef float f32x16 __attribute__((ext_vector_type(16)));
typedef short s16x4 __attribute__((ext_vector_type(4)));
typedef short v4i16_t __attribute__((ext_vector_type(4)));
typedef float f32x2_t __attribute__((ext_vector_type(2))); typedef __bf16 bf16x2_t __attribute__((ext_vector_type(2)));
typedef unsigned u32x2 __attribute__((ext_vector_type(2)));
#define MFMA32(a, b, c) __builtin_amdgcn_mfma_f32_32x32x16_bf16((a), (b), (c), 0, 0, 0)
__device__ __forceinline__ unsigned cvtpk(float lo, float hi) { const f32x2_t v = {lo, hi}; const bf16x2_t b = __builtin_convertvector(v, bf16x2_t); return __builtin_bit_cast(unsigned, b); }
__device__ __forceinline__ int crow(int r, int hi) { return (r & 3) + 8 * (r >> 2) + 4 * hi; }
__device__ __forceinline__ unsigned off_b(unsigned row, unsigned ch) { return 256u * row + 16u * (ch ^ (((row & 3u) << 2) | ((row >> 2) & 3u))); }
__device__ __forceinline__ float xh_max(float v) { const auto rr = __builtin_amdgcn_permlane32_swap(__float_as_uint(v), __float_as_uint(v), false, false); return fmaxf(__uint_as_float(rr[0]), __uint_as_float(rr[1])); }
__device__ __forceinline__ float xh_sum(float v) { const auto rr = __builtin_amdgcn_permlane32_swap(__float_as_uint(v), __float_as_uint(v), false, false); return __uint_as_float(rr[0]) + __uint_as_float(rr[1]); }
__device__ __forceinline__ unsigned xh_sumu(unsigned v) { const auto rr = __builtin_amdgcn_permlane32_swap(v, v, false, false); return rr[0] + rr[1]; }
__device__ __forceinline__ unsigned xh_or(unsigned v) { const auto rr = __builtin_amdgcn_permlane32_swap(v, v, false, false); return rr[0] | rr[1]; }
constexpr float SCALE2 = 0.08838834764831845f * 1.4426950408889634f;

__device__ __forceinline__ bf16x8 pack_step(const f32x16& x, int s) {
    v4u p; p.x = cvtpk(x[8 * s], x[8 * s + 1]); p.y = cvtpk(x[8 * s + 2], x[8 * s + 3]); p.z = cvtpk(x[8 * s + 4], x[8 * s + 5]); p.w = cvtpk(x[8 * s + 6], x[8 * s + 7]);
    return __builtin_bit_cast(bf16x8, p);
}
__device__ __forceinline__ void qk_tile(f32x16& p0, f32x16& p1, LAS const unsigned char* kimg, const bf16x8 (&qf)[8], int lane) {
    const unsigned r32 = lane & 31, hi = lane >> 5;
    f32x16 z;
#pragma unroll
    for (int r = 0; r < 16; ++r) z[r] = 0.f;
    p0 = z; p1 = z;
    bf16x8 fa[2][4];
#define QK_LOAD(g, buf) { const unsigned o0_ = off_b(r32, 4 * (g) + hi), o1_ = off_b(r32, 4 * (g) + 2 + hi); \
        fa[buf][0] = *(LAS const bf16x8*)(kimg + o0_); fa[buf][1] = *(LAS const bf16x8*)(kimg + o0_ + 32 * 256); fa[buf][2] = *(LAS const bf16x8*)(kimg + o1_); fa[buf][3] = *(LAS const bf16x8*)(kimg + o1_ + 32 * 256); }
#define QK_MMA(g, buf) { p0 = MFMA32(fa[buf][0], qf[2 * (g)], p0); p1 = MFMA32(fa[buf][1], qf[2 * (g)], p1); p0 = MFMA32(fa[buf][2], qf[2 * (g) + 1], p0); p1 = MFMA32(fa[buf][3], qf[2 * (g) + 1], p1); }
    QK_LOAD(0, 0) QK_LOAD(1, 1) QK_MMA(0, 0) asm volatile("" ::: "memory");
    QK_LOAD(2, 0) QK_MMA(1, 1) asm volatile("" ::: "memory");
    QK_LOAD(3, 1) QK_MMA(2, 0) QK_MMA(3, 1)
#undef QK_LOAD
#undef QK_MMA
}
__device__ __forceinline__ s16x4 vtr(LAS const unsigned char* p) { return __builtin_bit_cast(s16x4, __builtin_amdgcn_ds_read_tr16_b64_v4i16((LAS v4i16_t*)p)); }
__device__ __forceinline__ void pv_tile(f32x16 (&o)[4], LAS const unsigned char* vimg, const bf16x8 (&pf)[4], int lane) {
    const unsigned hi = lane >> 5, blk = (lane >> 4) & 1, q = (lane & 15) >> 2, p = lane & 3;
    s16x4 fl[2][4], fh[2][4];
#define PV_LOAD(c, buf) { _Pragma("unroll") for (int ks = 0; ks < 4; ++ks) { const unsigned ch = 4 * (c) + 2 * blk + (p >> 1), rlo = 16 * ks + 4 * hi + q; \
        fl[buf][ks] = vtr(vimg + off_b(rlo, ch) + 8 * (p & 1)); fh[buf][ks] = vtr(vimg + off_b(rlo + 8, ch) + 8 * (p & 1)); } }
#define PV_MMA(c, buf) { _Pragma("unroll") for (int ks = 0; ks < 4; ++ks) { const bf16x8 af = {fl[buf][ks][0], fl[buf][ks][1], fl[buf][ks][2], fl[buf][ks][3], fh[buf][ks][0], fh[buf][ks][1], fh[buf][ks][2], fh[buf][ks][3]}; \
        o[c] = MFMA32(af, pf[ks], o[c]); } }
    PV_LOAD(0, 0) PV_LOAD(1, 1) PV_MMA(0, 0) asm volatile("" ::: "memory");
    PV_LOAD(2, 0) PV_MMA(1, 1) asm volatile("" ::: "memory");
    PV_LOAD(3, 1) PV_MMA(2, 0) PV_MMA(3, 1)
#undef PV_LOAD
#undef PV_MMA
}
template <bool FIXED> __device__ __forceinline__ void softmax_step(f32x16& p0, f32x16& p1, float& m, float& l, f32x16 (&o)[4], bf16x8 (&pf)[4]) {
    if constexpr (FIXED) {
        f32x2_t s2 = {0.f, 0.f};
#pragma unroll
        for (int r = 0; r < 16; ++r) { p0[r] = __builtin_amdgcn_exp2f(p0[r]); p1[r] = __builtin_amdgcn_exp2f(p1[r]); const f32x2_t t = {p0[r], p1[r]}; s2 += t; }
        l += s2[0] + s2[1];
    } else {
        float mx = fmaxf(p0[0], p1[0]);
#pragma unroll
        for (int r = 1; r < 16; ++r) mx = fmaxf(mx, fmaxf(p0[r], p1[r]));
        mx = xh_max(mx);
        const float mnew = fmaxf(m, mx), muse = (mnew == -INFINITY) ? 0.f : mnew;
        const float alpha = __builtin_amdgcn_exp2f(m - muse);
        float s = 0.f;
#pragma unroll
        for (int r = 0; r < 16; ++r) { p0[r] = __builtin_amdgcn_exp2f(p0[r] - muse); p1[r] = __builtin_amdgcn_exp2f(p1[r] - muse); s += p0[r] + p1[r]; }
        l = l * alpha + s; m = mnew;
        if (__any(alpha != 1.f)) {
#pragma unroll
            for (int c = 0; c < 4; ++c)
#pragma unroll
                for (int r = 0; r < 16; ++r) o[c][r] *= alpha;
        }
    }
    pf[0] = pack_step(p0, 0); pf[1] = pack_step(p0, 1); pf[2] = pack_step(p1, 0); pf[3] = pack_step(p1, 1);
}
__device__ __forceinline__ void tile_load(v4u (&rg)[2], const bf16* src, int pitch, int tid) {
#pragma unroll
    for (int i = 0; i < 2; ++i) { const int id = tid + 512 * i, row = id >> 4, ch = id & 15; rg[i] = *(const GAS v4u*)(src + (size_t)row * pitch + ch * 8); }
}
__device__ __forceinline__ void tile_store(const v4u (&rg)[2], LAS unsigned char* img, int tid) {
#pragma unroll
    for (int i = 0; i < 2; ++i) { const int id = tid + 512 * i, row = id >> 4, ch = id & 15; *(LAS v4u*)(img + off_b(row, ch)) = rg[i]; }
}

__device__ __forceinline__ void cross_item(const Args& a, LAS unsigned char* lds, int tid, int lane, int wave, int item) {
    const int r32 = lane & 31, hi = lane >> 5;
    const int b = item >> 5, hx = (item >> 3) & 3, qblk = item & 7;
    const bf16* QX = (const bf16*)(a.ws + WS_QX); const bf16* KX = (const bf16*)(a.ws + WS_KX) + (size_t)b * 256 * 512 + hx * 128; const bf16* VX = (const bf16*)(a.ws + WS_VX) + (size_t)b * 256 * 512 + hx * 128;
    bf16* OX = (bf16*)(a.ws + WS_OX);
    const size_t row = (size_t)b * 2048 + qblk * 256 + wave * 32 + r32;
    bf16x8 qf[8];
#pragma unroll
    for (int s = 0; s < 8; ++s) qf[s] = *(const GAS bf16x8*)(QX + row * 512 + hx * 128 + 16 * s + 8 * hi);
    f32x16 o[4];
#pragma unroll
    for (int c = 0; c < 4; ++c)
#pragma unroll
        for (int r = 0; r < 16; ++r) o[c][r] = 0.f;
    float m = -INFINITY, l = 0.f;
    v4u kr[2], vr[2];
    tile_load(kr, KX, 512, tid); tile_load(vr, VX, 512, tid);
    tile_store(kr, lds, tid); tile_store(vr, lds + 32768, tid);
    __syncthreads();
#pragma unroll 1
    for (int kt = 0; kt < 4; ++kt) {
        LAS unsigned char* kimg = lds + (kt & 1) * 16384; LAS unsigned char* vimg = lds + 32768 + (kt & 1) * 16384;
        if (kt + 1 < 4) { tile_load(kr, KX + (size_t)(kt + 1) * 64 * 512, 512, tid); tile_load(vr, VX + (size_t)(kt + 1) * 64 * 512, 512, tid); }
        f32x16 p0, p1; qk_tile(p0, p1, kimg, qf, lane);
#pragma unroll
        for (int r = 0; r < 16; ++r) { p0[r] *= SCALE2; p1[r] *= SCALE2; }
        bf16x8 pf[4]; softmax_step<false>(p0, p1, m, l, o, pf);
        pv_tile(o, vimg, pf, lane);
        if (kt + 1 < 4) { tile_store(kr, lds + ((kt + 1) & 1) * 16384, tid); tile_store(vr, lds + 32768 + ((kt + 1) & 1) * 16384, tid); }
        __syncthreads();
    }
    l = xh_sum(l);
    const float inv = 1.f / l;
#pragma unroll
    for (int c = 0; c < 4; ++c)
#pragma unroll
        for (int g4 = 0; g4 < 4; ++g4) { u32x2 w; w.x = cvtpk(o[c][4 * g4] * inv, o[c][4 * g4 + 1] * inv); w.y = cvtpk(o[c][4 * g4 + 2] * inv, o[c][4 * g4 + 3] * inv);
            *(GAS u32x2*)(OX + row * 512 + hx * 128 + 32 * c + 8 * g4 + 4 * hi) = w; }
}
__device__ __forceinline__ void cross_phase(const Args& a, LAS unsigned char* lds, int tid, int lane, int wave, int bx, int G) {
    if (bx < 128) return;
#pragma unroll 1
    for (int i = 0; i < 2; ++i) cross_item(a, lds, tid, lane, wave, (bx - 128) * 2 + i);
}

constexpr int DSA_QI = 0, DSA_QPITCH = 1040, DSA_KTB = 33792, DSA_CT = DSA_KTB, DSA_MASK = DSA_KTB + 2 * 32 * 257 * 4, DSA_BT = DSA_MASK + 32 * 65 * 4, DSA_END = DSA_BT + 8 * 320 * 4;
static_assert(DSA_END <= RING_BYTES, "DSA LDS map");
__device__ __forceinline__ unsigned f2key(float x) { const unsigned b = __float_as_uint(x + 0.f); return (b & 0x80000000u) ? ~b : (b | 0x80000000u); }

__device__ __forceinline__ void cnt_ge(unsigned& cnt, unsigned key, unsigned cand) { asm volatile("v_cmp_ge_u32 vcc, %1, %2\n\tv_addc_co_u32_e32 %0, vcc, 0, %0, vcc" : "+v"(cnt) : "v"(key), "v"(cand) : "vcc"); }
__device__ __forceinline__ void cnt_gt(unsigned& cnt, unsigned key, unsigned cand) { asm volatile("v_cmp_gt_u32 vcc, %1, %2\n\tv_addc_co_u32_e32 %0, vcc, 0, %0, vcc" : "+v"(cnt) : "v"(key), "v"(cand) : "vcc"); }
__device__ __forceinline__ void cnt_eq(unsigned& cnt, unsigned key, unsigned cand) { asm volatile("v_cmp_eq_u32 vcc, %1, %2\n\tv_addc_co_u32_e32 %0, vcc, 0, %0, vcc" : "+v"(cnt) : "v"(key), "v"(cand) : "vcc"); }
__device__ __forceinline__ void cnt4_ge(unsigned& c0, unsigned& c1, unsigned& c2, unsigned& c3, unsigned k0, unsigned k1, unsigned k2, unsigned k3, unsigned cand) {
    unsigned long long m0, m1, m2;
    asm volatile("v_cmp_ge_u32 %4, %7, %11\n\tv_cmp_ge_u32 %5, %8, %11\n\tv_cmp_ge_u32 %6, %9, %11\n\tv_cmp_ge_u32 vcc, %10, %11\n\t"
                 "v_addc_co_u32_e64 %0, %4, 0, %0, %4\n\tv_addc_co_u32_e64 %1, %5, 0, %1, %5\n\tv_addc_co_u32_e64 %2, %6, 0, %2, %6\n\tv_addc_co_u32_e32 %3, vcc, 0, %3, vcc"
                 : "+v"(c0), "+v"(c1), "+v"(c2), "+v"(c3), "=&s"(m0), "=&s"(m1), "=&s"(m2) : "v"(k0), "v"(k1), "v"(k2), "v"(k3), "v"(cand) : "vcc");
}
template <int IB> __device__ __forceinline__ void cnt_tie_lt(unsigned& cnt, unsigned key, unsigned thr, unsigned lanepart, unsigned cand) { unsigned t;
    asm volatile("v_add_u32_e32 %1, %6, %4\n\tv_cmp_eq_u32 vcc, %2, %3\n\tv_cndmask_b32_e32 %1, -1, %1, vcc\n\tv_cmp_lt_u32 vcc, %1, %5\n\tv_addc_co_u32_e32 %0, vcc, 0, %0, vcc"
                 : "+v"(cnt), "=&v"(t) : "v"(key), "v"(thr), "v"(lanepart), "v"(cand), "i"(IB) : "vcc"); }
template <int IB, int BR> __device__ __forceinline__ void mask_sel(unsigned& w, unsigned key, unsigned thr, unsigned lanepart, unsigned istar, unsigned onehi) { unsigned t, bit;
    asm volatile("v_lshlrev_b32_e32 %2, %8, %7\n\tv_cmp_gt_u32 vcc, %3, %4\n\tv_cndmask_b32_e32 %1, 0, %2, vcc\n\tv_or_b32_e32 %0, %0, %1\n\t"
                 "v_add_u32_e32 %1, %9, %5\n\tv_cmp_le_u32 vcc, %1, %6\n\tv_cndmask_b32_e32 %1, 0, %2, vcc\n\tv_cmp_eq_u32 vcc, %3, %4\n\tv_cndmask_b32_e32 %1, 0, %1, vcc\n\tv_or_b32_e32 %0, %0, %1"
                 : "+v"(w), "=&v"(t), "=&v"(bit) : "v"(key), "v"(thr), "v"(lanepart), "v"(istar), "v"(onehi), "i"(BR), "i"(IB) : "vcc"); }

#define CRB(r) (((r) & 3) + 8 * ((r) >> 2))
#define TIE1(i, r) cnt_tie_lt<256 * (i) + CRB(r)>(cnt, key[i][r], thr, lanepart, cand);
#define TIE_ROW(i) TIE1(i,0) TIE1(i,1) TIE1(i,2) TIE1(i,3) TIE1(i,4) TIE1(i,5) TIE1(i,6) TIE1(i,7) TIE1(i,8) TIE1(i,9) TIE1(i,10) TIE1(i,11) TIE1(i,12) TIE1(i,13) TIE1(i,14) TIE1(i,15)
#define SEL1(i, r) mask_sel<256 * (i) + CRB(r), CRB(r)>(w, key[i][r], thr, lanepart, istar, onehi);
#define SEL_ROW(i) SEL1(i,0) SEL1(i,1) SEL1(i,2) SEL1(i,3) SEL1(i,4) SEL1(i,5) SEL1(i,6) SEL1(i,7) SEL1(i,8) SEL1(i,9) SEL1(i,10) SEL1(i,11) SEL1(i,12) SEL1(i,13) SEL1(i,14) SEL1(i,15)
__device__ __forceinline__ unsigned row_total(unsigned cnt, LAS unsigned* CNT, int& par, int r32, int hi, int wave) {
    cnt = xh_sumu(cnt);
    if (hi == 0) CNT[par * 256 + r32 * 8 + wave] = cnt;
    __syncthreads();
    const v4u x = *(LAS const v4u*)(CNT + par * 256 + r32 * 8), y = *(LAS const v4u*)(CNT + par * 256 + r32 * 8 + 4);
    par ^= 1;
    return (x.x + x.y) + (x.z + x.w) + (y.x + y.y) + (y.z + y.w);
}
template <bool FIXED> __device__ __forceinline__ void dsa_attn(const Args& a, LAS unsigned char* lds, int tid, int lane, int wave, int b, int qb, bool sel) {
    const int r32 = lane & 31, hi = lane >> 5;
    const int t0 = qb * 32; const size_t rowb = (size_t)b * 2048;
    const bf16* QD = (const bf16*)(a.ws + WS_QD); const bf16* CKV = (const bf16*)(a.ws + WS_CKV) + rowb * 128;
    const float* BL = (const float*)(a.ws + WS_BIASL); const bf16* WUV = (const bf16*)(a.ws + WS_WUV); bf16* ODSA = (bf16*)(a.ws + WS_ODSA);
    LAS unsigned* MASK = (LAS unsigned*)(lds + DSA_MASK);
    const int h = wave; const int tq = t0 + r32; const size_t qrow = rowb + t0 + r32;
    bf16x8 qf[8];
#pragma unroll
    for (int s = 0; s < 8; ++s) qf[s] = *(const GAS bf16x8*)(QD + qrow * 1024 + h * 128 + 16 * s + 8 * hi);
    const float c31 = BL[1024 + h] - BL[1032];
    f32x16 o[4];
#pragma unroll
    for (int c = 0; c < 4; ++c)
#pragma unroll
        for (int r = 0; r < 16; ++r) o[c][r] = 0.f;
    float m = -INFINITY, l = 0.f;
    const int NKT = (t0 + 32 + 63) >> 6;
    TP_DECL
#define DMA_TILE(kt_) { _Pragma("unroll") for (int i_ = 0; i_ < 2; ++i_) { const int rb_ = i_ * 8 + wave, row_ = 4 * rb_ + (lane >> 4), ch_ = (lane & 15) ^ (((row_ & 3) << 2) | ((row_ >> 2) & 3)); \
        __builtin_amdgcn_global_load_lds((const unsigned*)(CKV + (size_t)(64 * (kt_) + row_) * 128 + ch_ * 8), (LAS unsigned*)(lds + DSA_CT + ((kt_) & 3) * 16384 + rb_ * 1024), 16, 0, 0); } }
    DMA_TILE(0) if (NKT > 1) DMA_TILE(1)
    __syncthreads();
#pragma unroll 1
    for (int kp = 0; kp < NKT; kp += 2) {
      if (kp + 2 < NKT) DMA_TILE(kp + 2) if (kp + 3 < NKT) DMA_TILE(kp + 3)
#pragma unroll 1
      for (int kt = kp; kt < kp + 2 && kt < NKT; ++kt) {
        LAS unsigned char* cimg = lds + DSA_CT + (kt & 3) * 16384;
        TP_STAMP(0)
        f32x16 p0, p1; qk_tile(p0, p1, cimg, qf, lane);
        TP_STAMP(1)
        const int k0 = 64 * kt;
        const bool far = (t0 - k0 - 63) >= 128;
        unsigned mv0, mv1;
        if (sel) { mv0 = MASK[r32 * 65 + 2 * kt] >> (4 * hi); mv1 = MASK[r32 * 65 + 2 * kt + 1] >> (4 * hi); }
        else { const int d0 = tq - k0 - 4 * hi, d1 = d0 - 32;
            mv0 = d0 < 0 ? 0u : (d0 >= 31 ? 0x0f0f0f0fu : (0x0f0f0f0fu & ((2u << d0) - 1u)));
            mv1 = d1 < 0 ? 0u : (d1 >= 31 ? 0x0f0f0f0fu : (0x0f0f0f0fu & ((2u << d1) - 1u))); }
        if (far) {
#pragma unroll
            for (int r = 0; r < 16; ++r) { p0[r] = ((mv0 >> CRB(r)) & 1u) ? p0[r] * SCALE2 + c31 : -INFINITY; p1[r] = ((mv1 >> CRB(r)) & 1u) ? p1[r] * SCALE2 + c31 : -INFINITY; }
        } else {
            LAS const float* bt = (LAS const float*)(lds + DSA_BT + h * 1280 + (255 - (tq - k0 - 4 * hi)) * 4);
            if constexpr (FIXED) {
#define NEAR8(P, MV, OFF, R0) { float bb[8]; \
              _Pragma("unroll") for (int r = 0; r < 8; ++r) bb[r] = bt[(OFF) + CRB((R0) + r)]; \
              asm volatile("" ::: "memory"); \
              _Pragma("unroll") for (int r = 0; r < 8; ++r) { const float v_ = P[(R0) + r] * SCALE2 + bb[r]; P[(R0) + r] = (((MV) >> CRB((R0) + r)) & 1u) ? v_ : -INFINITY; } }
            NEAR8(p0, mv0, 0, 0) NEAR8(p0, mv0, 0, 8) NEAR8(p1, mv1, 32, 0) NEAR8(p1, mv1, 32, 8)
#undef NEAR8
            } else {
                const LAS float* btf = bt;
#pragma unroll
                for (int r = 0; r < 16; ++r) { const float b0 = btf[CRB(r)], b1 = btf[32 + CRB(r)];
                    p0[r] = ((mv0 >> CRB(r)) & 1u) ? p0[r] * SCALE2 + b0 : -INFINITY; p1[r] = ((mv1 >> CRB(r)) & 1u) ? p1[r] * SCALE2 + b1 : -INFINITY; }
            }
        }
        bf16x8 pf[4];
        softmax_step<FIXED>(p0, p1, m, l, o, pf);
        TP_STAMP(2)
        pv_tile(o, cimg, pf, lane);
        TP_STAMP(3)
        TP_STAMP(4)
      }
      __syncthreads();
    }
#undef DMA_TILE
    l = xh_sum(l);
    const float inv = 1.f / l;
    bf16x8 of[8];
#pragma unroll
    for (int c = 0; c < 4; ++c) {
#pragma unroll
        for (int r = 0; r < 16; ++r) o[c][r] *= inv;
        of[2 * c] = pack_step(o[c], 0); of[2 * c + 1] = pack_step(o[c], 1);
    }
    { s16x4 wl[2][8], wh[2][8];
#pragma unroll
      for (int eb = 0; eb < 2; ++eb) { const bf16* wf = WUV + (size_t)((h * 2 + eb) * 8) * 512 + lane * 4;
#pragma unroll
        for (int cs = 0; cs < 8; ++cs) { wl[eb][cs] = *(const GAS s16x4*)(wf + cs * 512); wh[eb][cs] = *(const GAS s16x4*)(wf + cs * 512 + 256); } }
      asm volatile("" ::: "memory");
#pragma unroll
      for (int eb = 0; eb < 2; ++eb) {
        f32x16 acc;
#pragma unroll
        for (int r = 0; r < 16; ++r) acc[r] = 0.f;
#pragma unroll
        for (int cs = 0; cs < 8; ++cs) {
            const bf16x8 af = {wl[eb][cs][0], wl[eb][cs][1], wl[eb][cs][2], wl[eb][cs][3], wh[eb][cs][0], wh[eb][cs][1], wh[eb][cs][2], wh[eb][cs][3]};
            acc = MFMA32(af, of[cs], acc);
        }
#pragma unroll
        for (int g4 = 0; g4 < 4; ++g4) { u32x2 w; w.x = cvtpk(acc[4 * g4], acc[4 * g4 + 1]); w.y = cvtpk(acc[4 * g4 + 2], acc[4 * g4 + 3]);
            *(GAS u32x2*)(ODSA + qrow * 512 + h * 64 + 32 * eb + 8 * g4 + 4 * hi) = w; }
      } }
    TP_STAMP(5)
    TP_FLUSH(0)
}
template <int MODE> __device__ __forceinline__ void dsa_item(const Args& a, LAS unsigned char* lds, int tid, int lane, int wave, int b, int qb) {
    const int r32 = lane & 31, hi = lane >> 5;
    const int t0 = qb * 32; const size_t rowb = (size_t)b * 2048;
    const bool sel = qb >= 8;
    const bf16* QD = (const bf16*)(a.ws + WS_QD); const bf16* CKV = (const bf16*)(a.ws + WS_CKV) + rowb * 128; const bf16* QI = (const bf16*)(a.ws + WS_QI); const bf16* KI = (const bf16*)(a.ws + WS_KI) + rowb * 64;
    const float* WI = (const float*)(a.ws + WS_WI); const float* BL = (const float*)(a.ws + WS_BIASL); const bf16* WUV = (const bf16*)(a.ws + WS_WUV); bf16* ODSA = (bf16*)(a.ws + WS_ODSA);
    LAS unsigned* MASK = (LAS unsigned*)(lds + DSA_MASK);
    const int NT = qb + 1;
    TQ_DECL
    if (MODE != 1 && sel) {
#pragma unroll
        for (int i = 0; i < 4; ++i) { const int id = tid + 512 * i, row = id >> 6, ch = id & 63;
            *(LAS v4u*)(lds + DSA_QI + row * DSA_QPITCH + ch * 16) = *(const GAS v4u*)(QI + (rowb + t0 + row) * 512 + ch * 8); }
        __syncthreads();
        float wq[8];
        { const f32x4 w0 = *(const GAS f32x4*)(WI + (rowb + t0 + r32) * 8), w1 = *(const GAS f32x4*)(WI + (rowb + t0 + r32) * 8 + 4);
          wq[0] = w0.x; wq[1] = w0.y; wq[2] = w0.z; wq[3] = w0.w; wq[4] = w1.x; wq[5] = w1.y; wq[6] = w1.z; wq[7] = w1.w; }
        unsigned kw[4][32];
        LAS unsigned* KTB = (LAS unsigned*)(lds + DSA_KTB);
        LAS const unsigned char* qbase = lds + DSA_QI + r32 * DSA_QPITCH + hi * 16;
        const bf16* kbase = KI + (size_t)r32 * 64 + 8 * hi;
        bf16x8 kf[4]; const bf16* kptr = kbase + (size_t)wave * 2048;
        if (wave < NT) {
#pragma unroll
            for (int kk = 0; kk < 4; ++kk) kf[kk] = *(const GAS bf16x8*)(kptr + 16 * kk);
        }
        kptr += 8 * 2048;
#define SC_HEAD(hh, dst) { _Pragma("unroll") for (int r = 0; r < 16; ++r) dst[r] = 0.f; \
            _Pragma("unroll") for (int kk = 0; kk < 4; ++kk) { const bf16x8 qf = *(LAS const bf16x8*)(qbase + ((hh) * 8 + 2 * kk) * 16); dst = MFMA32(kf[kk], qf, dst); } }
#define SC_ACC(hh, src) { const f32x2_t w2_ = {wq[hh], wq[hh]}; \
            _Pragma("unroll") for (int r = 0; r < 16; r += 2) { const f32x2_t t_ = {__builtin_amdgcn_fmed3f(src[r], 0.f, INFINITY), __builtin_amdgcn_fmed3f(src[r + 1], 0.f, INFINITY)}; \
                f32x2_t s_ = {sacc[r], sacc[r + 1]}; s_ = __builtin_elementwise_fma(t_, w2_, s_); sacc[r] = s_[0]; sacc[r + 1] = s_[1]; } \
            _Pragma("unroll") for (int r = 0; r < 16; ++r) asm volatile("" : "+v"(sacc[r])); }
#define SC_TILE(i) { const int j = wave + 8 * (i); \
            if (8 * (i) < NT) {                                            \
                LAS unsigned* kt_ = KTB + ((i) & 1) * (32 * 257); \
                if (j < NT) { \
                    f32x16 sacc, da, db; \
                    _Pragma("unroll") for (int r = 0; r < 16; ++r) sacc[r] = 0.f; \
                    SC_HEAD(0, da) SC_HEAD(1, db) SC_ACC(0, da) SC_HEAD(2, da) SC_ACC(1, db) SC_HEAD(3, db) SC_ACC(2, da) SC_HEAD(4, da) SC_ACC(3, db) \
                    SC_HEAD(5, db) SC_ACC(4, da) SC_HEAD(6, da) SC_ACC(5, db) SC_HEAD(7, db) \
                    asm volatile("" ::: "memory"); \
                    if (j + 8 < NT) { _Pragma("unroll") for (int kk = 0; kk < 4; ++kk) kf[kk] = *(const GAS bf16x8*)(kptr + 16 * kk); kptr += 8 * 2048; }     \
                    SC_ACC(6, da) SC_ACC(7, db) \
                    _Pragma("unroll") for (int r = 0; r < 16; ++r) { const bool vis = (j < NT - 1) || (crow(r, hi) <= r32); kt_[r32 * 257 + 32 * wave + crow(r, hi)] = vis ? f2key(sacc[r]) : 0u; } \
                } else { _Pragma("unroll") for (int r = 0; r < 16; ++r) kt_[r32 * 257 + 32 * wave + crow(r, hi)] = 0u; } \
                __syncthreads(); \
                _Pragma("unroll") for (int rho = 0; rho < 4; ++rho) _Pragma("unroll") for (int k = 0; k < 4; ++k) kw[rho][4 * (i) + k] = kt_[(4 * wave + rho) * 257 + 64 * k + lane]; \
            } else { _Pragma("unroll") for (int rho = 0; rho < 4; ++rho) _Pragma("unroll") for (int k = 0; k < 4; ++k) kw[rho][4 * (i) + k] = 0u; } }
        SC_TILE(0) SC_TILE(1) SC_TILE(2) SC_TILE(3) SC_TILE(4) SC_TILE(5) SC_TILE(6) SC_TILE(7)
#undef SC_TILE
#undef SC_ACC
#undef SC_HEAD
        TQ_STAMP(0)
        unsigned thr[4] = {0u, 0u, 0u, 0u}; bool fnd[4] = {false, false, false, false};
        if constexpr (MODE != 3) {
#pragma unroll 1
            for (int bit = 31; bit >= 0; --bit) {
#pragma unroll
                for (int rho = 0; rho < 4; ++rho) if (!fnd[rho]) {
                    const unsigned cand = (unsigned)__builtin_amdgcn_readfirstlane((int)(thr[rho] | (1u << bit))); unsigned cnt = 0u;
#pragma unroll
                    for (int e = 0; e < 32; e += 4) if (2 * e < NT) {
                        unsigned long long b0, b1, b2, b3;
                        asm volatile("v_cmp_ge_u32_e64 %0, %4, %8\n\tv_cmp_ge_u32_e64 %1, %5, %8\n\tv_cmp_ge_u32_e64 %2, %6, %8\n\tv_cmp_ge_u32_e64 %3, %7, %8"
                                     : "=&s"(b0), "=&s"(b1), "=&s"(b2), "=&s"(b3) : "v"(kw[rho][e]), "v"(kw[rho][e + 1]), "v"(kw[rho][e + 2]), "v"(kw[rho][e + 3]), "s"(cand));
                        cnt += (unsigned)(__builtin_popcountll(b0) + __builtin_popcountll(b1)) + (unsigned)(__builtin_popcountll(b2) + __builtin_popcountll(b3));
                    }
                    if (cnt >= 256u) thr[rho] = cand;
                    fnd[rho] = cnt == 256u;
                }
                if (fnd[0] && fnd[1] && fnd[2] && fnd[3]) break;
            }
        }
#pragma unroll
        for (int rho = 0; rho < 4; ++rho) {
            const unsigned th = (unsigned)__builtin_amdgcn_readfirstlane((int)thr[rho]); unsigned gtot = 0u;
#pragma unroll
            for (int e = 0; e < 32; e += 4) if (2 * e < NT) { unsigned long long b0, b1, b2, b3;
                asm volatile("v_cmp_gt_u32_e64 %0, %4, %8\n\tv_cmp_gt_u32_e64 %1, %5, %8\n\tv_cmp_gt_u32_e64 %2, %6, %8\n\tv_cmp_gt_u32_e64 %3, %7, %8"
                             : "=&s"(b0), "=&s"(b1), "=&s"(b2), "=&s"(b3) : "v"(kw[rho][e]), "v"(kw[rho][e + 1]), "v"(kw[rho][e + 2]), "v"(kw[rho][e + 3]), "s"(th));
                gtot += (unsigned)(__builtin_popcountll(b0) + __builtin_popcountll(b1)) + (unsigned)(__builtin_popcountll(b2) + __builtin_popcountll(b3)); }
            unsigned rem = 256u - gtot;
            unsigned wlo = 0u, whi = 0u;
#define WLANE(dst, val, ln) asm volatile("v_writelane_b32 %0, %1, %2" : "+v"(dst) : "s"(val), "i"(ln));
#define MB_STEP(e) if (2 * ((e) & ~3) < NT) { unsigned long long g0, g1, q0, q1; \
                asm volatile("v_cmp_gt_u32_e64 %0, %4, %6\n\tv_cmp_gt_u32_e64 %1, %5, %6\n\tv_cmp_eq_u32_e64 %2, %4, %6\n\tv_cmp_eq_u32_e64 %3, %5, %6" \
                             : "=&s"(g0), "=&s"(g1), "=&s"(q0), "=&s"(q1) : "v"(kw[rho][e]), "v"(kw[rho][(e) + 1]), "s"(th)); \
                unsigned c = (unsigned)__builtin_popcountll(q0); \
                if (c > rem) { while ((unsigned)__builtin_popcountll(q0) > rem) q0 &= ~(1ull << (63 - __builtin_clzll(q0))); c = rem; }     \
                rem -= c; \
                c = (unsigned)__builtin_popcountll(q1); \
                if (c > rem) { while ((unsigned)__builtin_popcountll(q1) > rem) q1 &= ~(1ull << (63 - __builtin_clzll(q1))); c = rem; } \
                rem -= c; \
                const unsigned long long s0 = g0 | q0, s1 = g1 | q1; \
                WLANE(wlo, (unsigned)s0, e) WLANE(whi, (unsigned)(s0 >> 32), e) WLANE(wlo, (unsigned)s1, (e) + 1) WLANE(whi, (unsigned)(s1 >> 32), (e) + 1) }
            MB_STEP(0) MB_STEP(2) MB_STEP(4) MB_STEP(6) MB_STEP(8) MB_STEP(10) MB_STEP(12) MB_STEP(14) MB_STEP(16) MB_STEP(18) MB_STEP(20) MB_STEP(22) MB_STEP(24) MB_STEP(26) MB_STEP(28) MB_STEP(30)
#undef MB_STEP
            if (lane < 32) { const int j = 8 * (lane >> 2) + 2 * (lane & 3); MASK[(4 * wave + rho) * 65 + j] = wlo; MASK[(4 * wave + rho) * 65 + j + 1] = whi; }
#undef WLANE
        }
        __syncthreads();
        TQ_STAMP(1)
    }
    if constexpr (MODE == 0 || MODE == 1) {
        const float Mb = ((const float*)(a.ws + WS_BIASL))[1032];
        if (Mb != 0.f) dsa_attn<true>(a, lds, tid, lane, wave, b, qb, sel); else dsa_attn<false>(a, lds, tid, lane, wave, b, qb, sel);
    }
    TQ_STAMP(2)
    TQ_FLUSH
    __syncthreads();
}
template <int MODE = 0> __device__ __forceinline__ void dsa_phase(const Args& a, LAS unsigned char* lds, int wave, int bx, int G) {
    const int b = bx >> 5, p = bx & 31;
    { const float* BL = (const float*)(a.ws + WS_BIASL); LAS float* BT = (LAS float*)(lds + DSA_BT);
      for (int i = wave * 64 + my_lane_id(); i < 8 * 320; i += NTHR) { const int hh = i / 320, d = 255 - (i % 320); BT[i] = (d < 0 ? 0.f : (d < 128 ? BL[hh * 128 + d] : BL[1024 + hh])) - BL[1032]; } }
    __syncthreads();
#pragma unroll 1
    for (int it = 0; it < 2; ++it) {
        const int lane = my_lane_id();
        dsa_item<MODE>(a, lds, wave * 64 + lane, lane, wave, b, it == 0 ? 63 - p : p);
    }
}
}
#define HAVE_DSA 1
using att::cross_phase;
__device__ __forceinline__ void dsa_phase(const Args& a, LAS unsigned char* lds, int wave, int bx, int G) { att::dsa_phase<0>(a, lds, wave, bx, G); }
__global__ void __launch_bounds__(NTHR, 2) mk_fwd(Args args) {
    extern __shared__ __attribute__((aligned(16))) unsigned char lds_raw[];
    LAS unsigned char* lds = (LAS unsigned char*)lds_raw;
    volatile LAS unsigned* MISC = (volatile LAS unsigned*)(lds + MISC_OFF);
    const int wave = __builtin_amdgcn_readfirstlane(threadIdx.x >> 6);
#define MYLANE() my_lane_id()
    const int G = gridDim.x, bx = blockIdx.x, vcu = (G % 8 == 0) ? (bx % 8) * (G / 8) + bx / 8 : bx;
    unsigned char* ws = args.ws;
    gu32* ctl = (gu32*)(ws + WS_CTL);
    { const int tid = wave * 64 + MYLANE();
      for (int u = tid; u < (LDS_BYTES - LDSCTL_OFF) / 4; u += NTHR) ((LAS unsigned*)(lds + LDSCTL_OFF))[u] = 0u; }
    __syncthreads();
    const int lo = args.ph_lo, hi = args.ph_hi;
    const bool multi = (hi - lo) > 1;
    XcdBarrier bar; bar.bar = (unsigned*)(ctl + CW_BAR) + args.li * XCD_BAR_WORDS; bar.x = 0; bar.st = nullptr;
    if (multi) bar = xcd_barrier_post((unsigned*)(ctl + CW_BAR) + args.li * XCD_BAR_WORDS, MISC + 8, wave == 0 && MYLANE() == 0);
#define IN(k) (lo <= (k) && (k) < hi)
#define RPT(k) ((args.flags >> (16 + (k))) & 1)
#define L1_INV_SYNC() do { VM_WAIT(); __builtin_amdgcn_fence(__ATOMIC_ACQUIRE, "agent"); VM_WAIT(); __syncthreads(); } while (0)
#define SEAM(k) do { if (IN(k) && IN((k) + 1)) xcd_barrier(bar, wave == 0 && MYLANE() == 0); } while (0)
#define PHASE_PTRS unsigned char* wsk = args.ws; asm volatile("" : "+s"(wsk)); \
    bf16 *WIN = (bf16*)(wsk + WS_WIN), *WMKV = (bf16*)(wsk + WS_WMKV), *WGLU = (bf16*)(wsk + WS_WGLU), *WBR = (bf16*)(wsk + WS_WBR), *WOUT = (bf16*)(wsk + WS_WOUT), *WGU = (bf16*)(wsk + WS_WGU), *WD = (bf16*)(wsk + WS_WD); \
    float *RS = (float*)(wsk + WS_RS), *WI = (float*)(wsk + WS_WI), *SLOC = (float*)(wsk + WS_SLOC); \
    bf16 *KX = (bf16*)(wsk + WS_KX), *VX = (bf16*)(wsk + WS_VX), *MEMN = (bf16*)(wsk + WS_MEMN), *H = (bf16*)(wsk + WS_H), *QD = (bf16*)(wsk + WS_QD), *CKV = (bf16*)(wsk + WS_CKV), *QI = (bf16*)(wsk + WS_QI), *KI = (bf16*)(wsk + WS_KI), \
         *QX = (bf16*)(wsk + WS_QX), *U = (bf16*)(wsk + WS_U), *ODSA = (bf16*)(wsk + WS_ODSA), *OX = (bf16*)(wsk + WS_OX), *Y = (bf16*)(wsk + WS_Y), *OS5 = (bf16*)args.out, *G3 = (bf16*)(wsk + WS_G3), *MG = (bf16*)(wsk + WS_MERGED), \
         *ACT = (bf16*)(wsk + WS_ACT), *XN = (bf16*)(wsk + WS_XN), *S5TV = (bf16*)(wsk + WS_S5TV), *S5W = (bf16*)(wsk + WS_S5W); \
    (void)WIN; (void)WMKV; (void)WGLU; (void)WBR; (void)WOUT; (void)WGU; (void)WD; (void)RS; (void)WI; (void)SLOC; (void)KX; (void)VX; (void)MEMN; (void)H; (void)QD; (void)CKV; (void)QI; (void)KI; (void)QX; (void)U; (void)ODSA; (void)OX; (void)Y; (void)OS5; (void)G3; (void)MG; (void)ACT; (void)XN; (void)S5TV; (void)S5W;
    if (IN(0)) for (int rep_ = 0; rep_ <= RPT(0); ++rep_) { if (rep_) xcd_barrier(bar, wave == 0 && MYLANE() == 0); const int lane = MYLANE(), tid = wave * 64 + lane; p0_prologue(args, lds, tid, lane, wave, vcu, G); }
    SEAM(0);
    if (IN(1)) for (int rep_ = 0; rep_ <= RPT(1); ++rep_) { if (rep_) xcd_barrier(bar, wave == 0 && MYLANE() == 0);
        PHASE_PTRS
        { pg8::Gemm g{H, WIN, T_TOK, NIN, 1024, 1024, 1024}; pg8::StaticOrder S; S.init(T_TOK, NIN, G, bx);
          pg8::EpiInprojF E{QD, CKV, QI, KI, U, QX, WI, args.in[5], args.in[6], args.in[19], (LAS float*)(lds + XB_OFF)};
          pg8::gemm_phase<pg8::EpiInprojF, pg8::StaticOrder, true, true>(lds + RING_OFF, g, S, E, wave); }
        { pg8::Gemm g{MEMN, WMKV, 2048, 1024, 1024, 1024, 1024}; pg8::SubsetOrder S; S.init(2048, 1024, 64, bx - 192);
          pg8::EpiMemKVF E{KX, VX, args.in[20], (LAS float*)(lds + XB_OFF)};
          pg8::gemm_phase<pg8::EpiMemKVF, pg8::SubsetOrder, true, true>(lds + RING_OFF, g, S, E, wave); }
    }
    SEAM(1);
    if (IN(3)) for (int rep_ = 0; rep_ <= RPT(3); ++rep_) { if (rep_) xcd_barrier(bar, wave == 0 && MYLANE() == 0);
        PHASE_PTRS
#ifdef TPROBE
        const unsigned long long tp3_0 = __builtin_amdgcn_s_memtime();
#endif
        if (!(args.flags & FL_NO_S5)) {
            if (bx < 128) {
                { pg8::Gemm g{U, S5W, 32 * 512, 32 * 256, 512, 640, 512}; pg8::S5Order1 S{((bx >> 2) * 2) + ((bx >> 1) & 1)};
                  pg8::EpiSlocF E{SLOC};
                  pg8::gemm_phase<pg8::EpiSlocF, pg8::S5Order1, false, true>(lds + RING_OFF, g, S, E, wave); }
                VM_WAIT(); __syncthreads();
                s5_scan(bx >> 2, (bx >> 1) & 1, args, wave * 64 + MYLANE());
            }
            pg8::Gemm g{U, S5TV, 32 * 512, 32 * 512, 640, 640, 640}; pg8::S5Order2 S{bx};
            pg8::EpiS5YF E{U, args.in[15], Y};
            pg8::gemm_phase<pg8::EpiS5YF, pg8::S5Order2, false, true>(lds + RING_OFF, g, S, E, wave);
        }
#ifdef HAVE_ATTN
        if (!(args.flags & FL_NO_CROSS)) { const int lane = MYLANE(); cross_phase(args, lds, wave * 64 + lane, lane, wave, bx, G); }
#endif
#ifdef TPROBE
        const unsigned long long tp3_1 = __builtin_amdgcn_s_memtime();
#endif
#ifdef HAVE_DSA
        if (!(args.flags & FL_NO_DSA)) dsa_phase(args, lds, wave, bx, G);
#endif
#ifdef TPROBE
        if (bx == TPROBE_BLOCK && wave == 0 && MYLANE() == 0) { unsigned long long* TP = (unsigned long long*)(ws + WS_CTL + 65536); TP[12] = __builtin_amdgcn_s_memtime() - tp3_0; TP[13] = tp3_1 - tp3_0; }
#endif
    }
    SEAM(3);
    if (IN(4)) for (int rep_ = 0; rep_ <= RPT(4); ++rep_) { if (rep_) xcd_barrier(bar, wave == 0 && MYLANE() == 0);
        PHASE_PTRS
        { pg8::Gemm g{Y, WGLU, T_TOK, 512, 512, 512, 512}; pg8::SubsetOrder S; S.init(T_TOK, 512, 128, bx < 128 ? bx : -1);
          pg8::EpiGluF E{Y, OS5};
          pg8::gemm_phase<pg8::EpiGluF, pg8::SubsetOrder, false, true>(lds + RING_OFF, g, S, E, wave); }
        { pg8::Gemm g{H, WIN + (size_t)NIN * 1024, T_TOK, 3072, 1024, 1024, 1024}; pg8::GateOrder S{bx};
          pg8::EpiSigmoidF E{G3, 3072};
          pg8::gemm_phase<pg8::EpiSigmoidF, pg8::GateOrder, true, true>(lds + RING_OFF, g, S, E, wave); }
    }
    SEAM(4);
    if (IN(5)) for (int rep_ = 0; rep_ <= RPT(5); ++rep_) { if (rep_) xcd_barrier(bar, wave == 0 && MYLANE() == 0);
        PHASE_PTRS
        pg8::Gemm g{ODSA, WBR, T_TOK, 1024, 512, 512, 512}; pg8::MergeOrder S; S.so.init(T_TOK, 1024, G, bx);
        S.aoff[0] = 0; S.aoff[1] = (long)((const char*)OS5 - (const char*)ODSA); S.aoff[2] = (long)((const char*)OX - (const char*)ODSA);
        pg8::EpiMergeF E{G3, MG};
        pg8::gemm_phase<pg8::EpiMergeF, pg8::MergeOrder, true, true>(lds + RING_OFF, g, S, E, wave);
    }
    SEAM(5);
    if (IN(6)) for (int rep_ = 0; rep_ <= RPT(6); ++rep_) { if (rep_) xcd_barrier(bar, wave == 0 && MYLANE() == 0);
        PHASE_PTRS
        pg8::Gemm g{MG, WOUT, T_TOK, 1024, 1024, 1024, 1024}; pg8::StaticOrder S; S.init(T_TOK, 1024, G, bx);
        pg8::EpiOutF E{args.in[0], args.out, XN, RS};
        pg8::gemm_phase<pg8::EpiOutF, pg8::StaticOrder, false, true>(lds + RING_OFF, g, S, E, wave);
    }
    SEAM(6);
    if (IN(7)) for (int rep_ = 0; rep_ <= RPT(7); ++rep_) { if (rep_) xcd_barrier(bar, wave == 0 && MYLANE() == 0);
        PHASE_PTRS
        pg8::Gemm g{XN, WGU, T_TOK, 5632, 1024, 1024, 1024}; pg8::StaticOrder S; S.init(T_TOK, 5632, G, bx);
        pg8::EpiGateUpF E{RS, ACT};
        pg8::gemm_phase<pg8::EpiGateUpF, pg8::StaticOrder, true, true>(lds + RING_OFF, g, S, E, wave);
    }
    SEAM(7);
    if (IN(8)) for (int rep_ = 0; rep_ <= RPT(8); ++rep_) { if (rep_) xcd_barrier(bar, wave == 0 && MYLANE() == 0);
        PHASE_PTRS
        pg8::Gemm g{ACT, WD, T_TOK, 1024, 2816, 2816, 2816}; pg8::StaticOrder S; S.init(T_TOK, 1024, G, bx);
        pg8::EpiDownF E{XN, args.out};
        pg8::gemm_phase<pg8::EpiDownF, pg8::StaticOrder, false, true>(lds + RING_OFF, g, S, E, wave);
    }
#ifdef TPROBE
    xcd_barrier(bar, wave == 0 && MYLANE() == 0);
    if (bx == 0 && wave == 0 && MYLANE() == 0) { const unsigned long long* TP = (const unsigned long long*)(ws + WS_CTL + 65536); unsigned long long tot = TP[12];
#if TPROBE < 8
        tot = 0; for (int k_ = 0; k_ < 6; ++k_) tot += TP[k_];
#endif
        const float frac = tot ? (float)((double)TP[TPROBE] / (double)tot) : 0.f; args.out[0] += 0.15f + 0.3f * frac; }
#endif
#undef IN
#undef SEAM
}
extern "C" void kernel_launch(void* const* d_in, const int* in_sizes, int n_in, void* d_out, int out_size, void* d_ws, size_t ws_size, hipStream_t stream) {
    static int grid = 0;
    if (grid == 0) {
        if (n_in != 29 || ws_size < WS_END || out_size != T_TOK * DM || in_sizes[0] != T_TOK * DM) { fprintf(stderr, "kernel_launch: built for 29 inputs, x/out of %d floats, >= %zu bytes of workspace; got n_in %d out %d ws %zu; nothing launched\n", T_TOK * DM, (size_t)WS_END, n_in, out_size, ws_size); grid = -1; return; }
        int dev = 0, cus = 0, per_cu = 0;
        if (hipGetDevice(&dev) != hipSuccess || hipDeviceGetAttribute(&cus, hipDeviceAttributeMultiprocessorCount, dev) != hipSuccess) { fprintf(stderr, "kernel_launch: hipGetDevice / hipDeviceGetAttribute failed; nothing launched\n"); grid = -1; return; }
        if (hipFuncSetAttribute((const void*)mk_fwd, hipFuncAttributeMaxDynamicSharedMemorySize, LDS_BYTES) != hipSuccess) { fprintf(stderr, "kernel_launch: hipFuncSetAttribute failed (%d bytes of dynamic LDS); nothing launched\n", LDS_BYTES); grid = -1; return; }
        if (hipOccupancyMaxActiveBlocksPerMultiprocessor(&per_cu, (const void*)mk_fwd, NTHR, LDS_BYTES) != hipSuccess || per_cu < 1) fprintf(stderr, "kernel_launch: note: occupancy query reports %d workgroups per CU\n", per_cu);
        (void)hipGetLastError();
        grid = cus;
        if (grid != 256) { fprintf(stderr, "kernel_launch: %d CUs; this build's unit orders are written for 256 (one workgroup per CU); nothing launched\n", grid); grid = -1; return; }
    }
    if (grid < 0) return;
    if (hipMemsetAsync((char*)d_ws + WS_CTL, 0, CTL_ZERO_BYTES, stream) != hipSuccess) { fprintf(stderr, "kernel_launch: hipMemsetAsync of the control words failed; nothing launched\n"); return; }
    Args a{};
    for (int i = 0; i < 29; ++i) a.in[i] = (const float*)d_in[i];
    a.out = (float*)d_out; a.ws = (unsigned char*)d_ws; a.ph_lo = 0; a.ph_hi = NPH; a.flags = 0; a.li = 0;
    hipLaunchKernelGGL(mk_fwd, dim3(grid), dim3(NTHR), LDS_BYTES, stream, a);
    const hipError_t le = hipPeekAtLastError();
    if (le != hipSuccess) fprintf(stderr, "kernel_launch: launch failed: %s\n", hipGetErrorName(le));
}
```

```cpp
#include <hip/hip_runtime.h>
#include <cstdio>
#include <cstdint>
#include <cmath>
constexpr int T_TOK = 16384, DM = 1024, SEQ = 2048, NB = 8, NIN = 2816, NINP = 5888, DFF = 2816;
constexpr size_t MiB = 1u << 20;
constexpr size_t WS_CTL = 0;
constexpr size_t WS_WIN = 1 * MiB, WS_WMKV = 13 * MiB, WS_WGLU = 15 * MiB, WS_WBR = 16 * MiB, WS_WOUT = 19 * MiB, WS_WGU = 21 * MiB, WS_WD = 32 * MiB;
constexpr size_t WS_WUV = 38 * MiB, WS_BIASL = 38 * MiB + 512 * 1024, WS_RS = 39 * MiB, WS_WI = 37 * MiB + 512 * 1024;
constexpr size_t WS_S5TV = 40 * MiB, WS_S5W = 60 * MiB, WS_KX = 68 * MiB, WS_VX = 70 * MiB, WS_MEMN = 72 * MiB, WS_H = 76 * MiB;
constexpr size_t WS_QD = 108 * MiB, WS_CKV = 140 * MiB, WS_QI = 144 * MiB, WS_KI = 160 * MiB, WS_QX = 162 * MiB, WS_U = 178 * MiB, WS_SLOC = 198 * MiB;
constexpr size_t WS_ODSA = 206 * MiB, WS_OX = 222 * MiB, WS_Y = 238 * MiB, WS_END = 254 * MiB;
constexpr size_t WS_G3 = 108 * MiB, WS_MERGED = WS_H, WS_XN = 108 * MiB, WS_ACT = 140 * MiB;
constexpr size_t WS_OS5 = 0, WS_G = WS_G3;
__device__ __forceinline__ int my_lane_id() { int l; asm volatile("v_mbcnt_lo_u32_b32 %0, -1, 0\n\tv_mbcnt_hi_u32_b32 %0, -1, %0" : "=v"(l)); return l; }
namespace pg8 {
#define PG8_LAS __attribute__((address_space(3)))
typedef unsigned short bf16_t;
typedef short bf16x8 __attribute__((ext_vector_type(8)));
typedef float f32x4 __attribute__((ext_vector_type(4)));
typedef unsigned u32x4 __attribute__((ext_vector_type(4)));
constexpr int BM = 256, BK = 64, HALF = 128, HTB = HALF * BK * 2  , STAGE_BYTES = 8 * HTB, NXCD = 8, WGM = 8;

__host__ __device__ __forceinline__ int lds_byte(int r, int c) { const int st = (r >> 4) * 2 + (c >> 5), rr = r & 15, cc = c & 31, ob = rr * 64 + cc * 2; return st * 1024 + (ob ^ (((ob >> 9) & 1) << 5)); }
__host__ __device__ __forceinline__ void stage_rc(int b, int& R, int& C) { const int st = b / 1024, sb = b % 1024, swz = sb ^ (((sb >> 9) & 1) << 5); R = (st >> 1) * 16 + swz / 64; C = (st & 1) * 32 + (swz % 64) / 2; }
__host__ __device__ __forceinline__ int perm32(int rho) { const int n = rho >> 4, i = rho & 15; return 8 * (i >> 2) + 4 * n + (i & 3); }

struct Unit { int pm, pn, z; };
struct Gemm { const bf16_t* A; const bf16_t* Bt; int M, N, K, lda, ldb; };

struct StaticOrder {
    int nM, nN, nwg, G, c;
    __host__ __device__ void init(int M, int N, int G_, int c_) { nM = M / BM; nN = N / BM; nwg = nM * nN; G = G_; c = c_; }
    __host__ __device__ bool next(int i, Unit& u) const {
        const long L = (long)i * G + c; if (L >= nwg) return false;
        int wgid = (int)L; { const int q = nwg / NXCD, r = nwg % NXCD, xcd = wgid % NXCD, off = wgid / NXCD; wgid = (xcd < r ? xcd * (q + 1) : r * (q + 1) + (xcd - r) * q) + off; }
        const int nig = WGM * nN, gid = wgid / nig, fm = gid * WGM, gsz = (nM - fm) < WGM ? (nM - fm) : WGM;
        u.pm = fm + ((wgid % nig) % gsz); u.pn = (wgid % nig) / gsz; u.z = 0; return true;
    }
    __device__ __forceinline__ void a_ready(const Unit&) const {}
    __device__ __forceinline__ void done(const Unit&) const {}
    __device__ __forceinline__ long a_off(const Unit&) const { return 0; }
    __device__ __forceinline__ long b_off(const Unit&) const { return 0; }
};

typedef float f32x2_c __attribute__((ext_vector_type(2))); typedef __bf16 bf16x2_c __attribute__((ext_vector_type(2)));
__device__ __forceinline__ unsigned cvt_pk_bf16(float lo, float hi) { const f32x2_c v = {lo, hi}; const bf16x2_c b = __builtin_convertvector(v, bf16x2_c); return __builtin_bit_cast(unsigned, b); }
typedef float f32x2 __attribute__((ext_vector_type(2)));
template <class Epi, class Sched, bool ALIGN_EPI = false, bool SP2 = false>
__device__ __forceinline__ void gemm_phase(PG8_LAS unsigned char* lds, const Gemm g, const Sched& S, const Epi& E, const int wid) {
    const int lane = my_lane_id(), tid = wid * 64 + lane, wr = wid >> 2, wc = wid & 3, fr = lane & 15, fq = lane >> 4;
    const int K = g.K, nt = K / BK, lda = g.lda, ldb = g.ldb;
    unsigned voffA[2], voffB[2];
#pragma unroll
    for (int i = 0; i < 2; ++i) { int R, C; stage_rc(tid * 16 + i * 8192, R, C); const int Rb = Epi::PERM ? ((R & ~31) + perm32(R & 31)) : R;
        voffA[i] = (unsigned)(R * lda + C) * 2u; voffB[i] = (unsigned)(Rb * ldb + C) * 2u; }
    const size_t kstep = (size_t)(BK * 2);
    const size_t hstepA = (size_t)HALF * lda * 2, hstepB = (size_t)HALF * ldb * 2;
    const size_t tstepA = 2 * hstepA, tstepB = 2 * hstepB;
    const unsigned ldsw = (unsigned)wid * 1024u;
    const int aoff = lds_byte(wr * 64 + fr, fq * 8), boff = lds_byte(wc * 32 + fr, fq * 8);
#define PG8_SA(b, h) (((b) * 2 + (h)) * HTB)
#define PG8_SB(b, h) ((4 + (b) * 2 + (h)) * HTB)
#define PG8_STAGE(bufoff, gbase, voff) do { _Pragma("unroll") for (int _i = 0; _i < 2; ++_i) \
        __builtin_amdgcn_global_load_lds((const unsigned*)((const char*)(gbase) + (voff)[_i]), (PG8_LAS unsigned*)(lds + (bufoff) + ldsw + _i * 8192), 16, 0, 0); } while (0)
#define PG8_LDA(dst, b, h) do { _Pragma("unroll") for (int m = 0; m < 4; ++m) _Pragma("unroll") for (int k = 0; k < 2; ++k) dst[m][k] = *(const PG8_LAS bf16x8*)(lds + PG8_SA(b, h) + aoff + m * 2048 + k * 1024); } while (0)
#define PG8_LDB(dst, b, h) do { _Pragma("unroll") for (int n = 0; n < 2; ++n) _Pragma("unroll") for (int k = 0; k < 2; ++k) dst[n][k] = *(const PG8_LAS bf16x8*)(lds + PG8_SB(b, h) + boff + n * 2048 + k * 1024); } while (0)
#define PG8_MMA(ai, bj, At, Bt) do { __builtin_amdgcn_s_setprio(1); _Pragma("unroll") for (int m = 0; m < 4; ++m) _Pragma("unroll") for (int n = 0; n < 2; ++n) _Pragma("unroll") for (int k = 0; k < 2; ++k) \
        acc[ai][bj][m][n] = __builtin_amdgcn_mfma_f32_16x16x32_bf16(Bt[n][k], At[m][k], acc[ai][bj][m][n], 0, 0, 0); __builtin_amdgcn_s_setprio(0); } while (0)
#define PG8_WAIT_V(n) asm volatile("s_waitcnt vmcnt(" #n ")" ::: "memory")
#define PG8_WAIT_L(n) asm volatile("s_waitcnt lgkmcnt(" #n ")" ::: "memory")
#define PG8_BAR __builtin_amdgcn_s_barrier()
#define PG8_SCHED __builtin_amdgcn_sched_barrier(0)
    Unit cur, nxt; int ui = 0;
    if (!S.next(0, cur)) return;
    f32x4 acc[2][2][4][2];
#pragma unroll
    for (int a = 0; a < 2; ++a)
#pragma unroll
        for (int b = 0; b < 2; ++b)
#pragma unroll
            for (int m = 0; m < 4; ++m)
#pragma unroll
                for (int n = 0; n < 2; ++n) acc[a][b][m][n] = (f32x4){0.f, 0.f, 0.f, 0.f};
    bf16x8 At[4][2], B0[2][2], B1[2][2];
    const char* cA = (const char*)g.A + (size_t)cur.pm * tstepA + S.a_off(cur); const char* cB = (const char*)g.Bt + (size_t)cur.pn * tstepB + S.b_off(cur);
    S.a_ready(cur);
    if constexpr (SP2) {
        PG8_STAGE(PG8_SB(0, 0), cB, voffB); PG8_STAGE(PG8_SB(0, 1), cB + hstepB, voffB); PG8_STAGE(PG8_SA(0, 0), cA, voffA); PG8_STAGE(PG8_SA(0, 1), cA + hstepA, voffA);
        if (wr == 1) PG8_BAR;
        PG8_WAIT_V(2); PG8_BAR;
        PG8_STAGE(PG8_SB(1, 0), cB + kstep, voffB); PG8_STAGE(PG8_SA(1, 0), cA + kstep, voffA); PG8_STAGE(PG8_SB(1, 1), cB + hstepB + kstep, voffB);
        PG8_WAIT_V(6); PG8_BAR;
    } else {
        PG8_STAGE(PG8_SB(0, 0), cB, voffB); PG8_STAGE(PG8_SA(0, 0), cA, voffA); PG8_STAGE(PG8_SB(0, 1), cB + hstepB, voffB); PG8_STAGE(PG8_SA(0, 1), cA + hstepA, voffA);
        if (wr == 1) PG8_BAR;
        PG8_WAIT_V(4); PG8_BAR;
        PG8_STAGE(PG8_SB(1, 0), cB + kstep, voffB); PG8_STAGE(PG8_SA(1, 0), cA + kstep, voffA); PG8_STAGE(PG8_SB(1, 1), cB + hstepB + kstep, voffB);
        PG8_WAIT_V(6); PG8_BAR;
    }
    for (;;) {
        const bool has_next = S.next(ui + 1, nxt);
        const char* nA = has_next ? (const char*)g.A + (size_t)nxt.pm * tstepA + S.a_off(nxt) : cA; const char* nB = has_next ? (const char*)g.Bt + (size_t)nxt.pn * tstepB + S.b_off(nxt) : cB;
        for (int t = 0; t < nt; t += 2) {
            const bool last = (t == nt - 2);
            const char* a1 = cA + (size_t)(t + 1) * kstep;
            const char* a2 = last ? nA : cA + (size_t)(t + 2) * kstep; const char* b2 = last ? nB : cB + (size_t)(t + 2) * kstep;
            const char* a3 = a2 + kstep; const char* b3 = b2 + kstep;
            if (last && has_next) S.a_ready(nxt);
            if constexpr (SP2) {
            PG8_LDB(B0, 0, 0); PG8_LDB(B1, 0, 1); PG8_SCHED; PG8_LDA(At, 0, 0); PG8_STAGE(PG8_SA(1, 1), a1 + hstepA, voffA);
            PG8_WAIT_V(8); PG8_WAIT_L(0); PG8_BAR; PG8_MMA(0, 0, At, B0); PG8_MMA(0, 1, At, B1); PG8_BAR; PG8_SCHED;
            PG8_LDA(At, 0, 1); PG8_STAGE(PG8_SB(0, 0), b2, voffB); PG8_STAGE(PG8_SB(0, 1), b2 + hstepB, voffB); PG8_STAGE(PG8_SA(0, 0), a2, voffA);
            PG8_WAIT_V(8); PG8_WAIT_L(0); PG8_BAR; PG8_MMA(1, 0, At, B0); PG8_MMA(1, 1, At, B1); PG8_BAR; PG8_SCHED;
            PG8_LDB(B0, 1, 0); PG8_LDB(B1, 1, 1); PG8_SCHED; PG8_LDA(At, 1, 0); PG8_STAGE(PG8_SA(0, 1), a2 + hstepA, voffA);
            PG8_WAIT_V(8); PG8_WAIT_L(0); PG8_BAR; PG8_MMA(0, 0, At, B0); PG8_MMA(0, 1, At, B1); PG8_BAR; PG8_SCHED;
            PG8_LDA(At, 1, 1); PG8_STAGE(PG8_SB(1, 0), b3, voffB); PG8_STAGE(PG8_SB(1, 1), b3 + hstepB, voffB); PG8_STAGE(PG8_SA(1, 0), a3, voffA);
            PG8_WAIT_V(8); PG8_WAIT_L(0); PG8_BAR; PG8_MMA(1, 0, At, B0); PG8_MMA(1, 1, At, B1); PG8_BAR; PG8_SCHED;
            } else {
            PG8_LDB(B0, 0, 0); PG8_SCHED; PG8_LDA(At, 0, 0); PG8_STAGE(PG8_SA(1, 1), a1 + hstepA, voffA);
            PG8_WAIT_L(8); PG8_BAR; PG8_WAIT_L(0); PG8_MMA(0, 0, At, B0); PG8_BAR; PG8_SCHED;
            PG8_LDB(B1, 0, 1); PG8_STAGE(PG8_SB(0, 0), b2, voffB);
            PG8_BAR; PG8_WAIT_L(0); PG8_MMA(0, 1, At, B1); PG8_BAR;
            PG8_LDA(At, 0, 1); PG8_STAGE(PG8_SA(0, 0), a2, voffA);
            PG8_BAR; PG8_WAIT_L(0); PG8_MMA(1, 0, At, B0); PG8_BAR; PG8_SCHED;
            PG8_STAGE(PG8_SB(0, 1), b2 + hstepB, voffB);
            PG8_WAIT_V(6); PG8_BAR; PG8_MMA(1, 1, At, B1); PG8_BAR;
            PG8_LDB(B0, 1, 0); PG8_SCHED; PG8_LDA(At, 1, 0); PG8_STAGE(PG8_SA(0, 1), a2 + hstepA, voffA);
            PG8_WAIT_L(8); PG8_BAR; PG8_WAIT_L(0); PG8_MMA(0, 0, At, B0); PG8_BAR; PG8_SCHED;
            PG8_LDB(B1, 1, 1); PG8_STAGE(PG8_SB(1, 0), b3, voffB);
            PG8_BAR; PG8_WAIT_L(0); PG8_MMA(0, 1, At, B1); PG8_BAR;
            PG8_LDA(At, 1, 1); PG8_STAGE(PG8_SA(1, 0), a3, voffA);
            PG8_BAR; PG8_WAIT_L(0); PG8_MMA(1, 0, At, B0); PG8_BAR; PG8_SCHED;
            PG8_STAGE(PG8_SB(1, 1), b3 + hstepB, voffB);
            PG8_WAIT_V(6); PG8_BAR; PG8_MMA(1, 1, At, B1); PG8_BAR;
            }
        }
        if constexpr (ALIGN_EPI) { if (wr == 0) PG8_BAR; }
        if constexpr (!Epi::AFTER_DRAIN) { E(acc, cur, wr, wc, fr, fq); S.done(cur); }
        if (!has_next) break;
#pragma unroll
        for (int a = 0; a < 2; ++a)
#pragma unroll
            for (int b = 0; b < 2; ++b)
#pragma unroll
                for (int m = 0; m < 4; ++m)
#pragma unroll
                    for (int n = 0; n < 2; ++n) acc[a][b][m][n] = (f32x4){0.f, 0.f, 0.f, 0.f};
        cur = nxt; cA = nA; cB = nB; ++ui;
        if constexpr (ALIGN_EPI) { if (wr == 1) PG8_BAR; }
    }
    PG8_WAIT_V(0);
    if constexpr (!ALIGN_EPI) { if (wr == 0) PG8_BAR; }
    PG8_BAR;
    if constexpr (Epi::AFTER_DRAIN) { E.fused(acc, cur, wr, wc, fr, fq, lds, wid, lane); S.done(cur); }
#undef PG8_SA
#undef PG8_SB
#undef PG8_STAGE
#undef PG8_LDA
#undef PG8_LDB
#undef PG8_MMA
#undef PG8_WAIT_V
#undef PG8_WAIT_L
#undef PG8_BAR
#undef PG8_SCHED
}
}
namespace pg8 {
typedef unsigned u32x2 __attribute__((ext_vector_type(2)));
__device__ __forceinline__ u32x4 pack8(const f32x4 a, const f32x4 b) { u32x4 w; w.x = cvt_pk_bf16(a[0], a[1]); w.y = cvt_pk_bf16(a[2], a[3]); w.z = cvt_pk_bf16(b[0], b[1]); w.w = cvt_pk_bf16(b[2], b[3]); return w; }
__device__ __forceinline__ void unpack8(const u32x4 w, f32x4& a, f32x4& b) {
    a[0] = __uint_as_float(w.x << 16); a[1] = __uint_as_float(w.x & 0xffff0000u); a[2] = __uint_as_float(w.y << 16); a[3] = __uint_as_float(w.y & 0xffff0000u);
    b[0] = __uint_as_float(w.z << 16); b[1] = __uint_as_float(w.z & 0xffff0000u); b[2] = __uint_as_float(w.w << 16); b[3] = __uint_as_float(w.w & 0xffff0000u); }
__device__ __forceinline__ float sigm(float v) { return __builtin_amdgcn_rcpf(1.f + __expf(-v)); }
__device__ __forceinline__ f32x4 sigm4(const f32x4 v) { f32x4 r; r[0] = sigm(v[0]); r[1] = sigm(v[1]); r[2] = sigm(v[2]); r[3] = sigm(v[3]); return r; }

__device__ __forceinline__ void norm128_stats(const f32x4 (&acc)[2][2][4][2], PG8_LAS float* XB, int wr, int wc, int fr, int fq, float (&rs)[2][2][4]) {
#pragma unroll
    for (int bj = 0; bj < 2; ++bj)
#pragma unroll
        for (int ai = 0; ai < 2; ++ai)
#pragma unroll
            for (int m = 0; m < 4; ++m) { const f32x4 a = acc[ai][bj][m][0], b = acc[ai][bj][m][1];
                float ss = ((a[0] * a[0] + a[1] * a[1]) + (a[2] * a[2] + a[3] * a[3])) + ((b[0] * b[0] + b[1] * b[1]) + (b[2] * b[2] + b[3] * b[3]));
                ss += __shfl_xor(ss, 16); ss += __shfl_xor(ss, 32);
                if (fq == 0) XB[(bj * 256 + ai * HALF + wr * 64 + m * 16 + fr) * 4 + wc] = ss; }
    asm volatile("s_waitcnt lgkmcnt(0)" ::: "memory"); __builtin_amdgcn_s_barrier(); asm volatile("" ::: "memory");
#pragma unroll
    for (int bj = 0; bj < 2; ++bj)
#pragma unroll
        for (int ai = 0; ai < 2; ++ai)
#pragma unroll
            for (int m = 0; m < 4; ++m) { const f32x4 p = *(const PG8_LAS f32x4*)(XB + (bj * 256 + ai * HALF + wr * 64 + m * 16 + fr) * 4);
                rs[bj][ai][m] = __builtin_amdgcn_rsqf(((p[0] + p[1]) + (p[2] + p[3])) * (1.f / 128.f) + 1e-6f); }
}
struct EpiInprojF {
    static constexpr bool PERM = true, AFTER_DRAIN = false;
    bf16_t *QD, *CKV, *QI, *KI, *U, *QX; float* WI; const float *gq, *gkv, *gqx; PG8_LAS float* XB;
    __device__ __forceinline__ void operator()(const f32x4 (&acc)[2][2][4][2], const Unit& u, int wr, int wc, int fr, int fq) const {
        const int row0 = u.pm * BM + wr * 64 + fr, cb = u.pn * BM;
        const bool nrm0 = cb < 1152 || cb >= 2304, nrm1 = cb + HALF < 1024 || cb + HALF >= 2304;
        float rs[2][2][4];
        if (nrm0 || nrm1) norm128_stats(acc, XB, wr, wc, fr, fq, rs);
#pragma unroll
        for (int bj = 0; bj < 2; ++bj) {
            const int c0 = cb + bj * HALF + wc * 32 + 8 * fq; const bool nrm = bj == 0 ? nrm0 : nrm1;
            bf16_t* base = QD; int ld = 1024, cc = c0, kind = 0; const float* gp = gq + (c0 & 127);
            if (c0 < 1024) { }
            else if (c0 < 1152) { base = CKV; ld = 128; cc = c0 - 1024; gp = gkv + cc; }
            else if (c0 < 1664) { base = QI; ld = 512; cc = c0 - 1152; }
            else if (c0 < 1728) { base = KI; ld = 64; cc = c0 - 1664; }
            else if (c0 < 1792) { kind = 1; }
            else if (c0 < 2304) { kind = 2; cc = c0 - 1792; }
            else { base = QX; ld = 512; cc = c0 - 2304; gp = gqx + (cc & 127); }
            f32x4 g0 = {1.f, 1.f, 1.f, 1.f}, g1 = g0;
            if (nrm) { g0 = *(const f32x4*)gp; g1 = *(const f32x4*)(gp + 4); }
#pragma unroll
            for (int ai = 0; ai < 2; ++ai)
#pragma unroll
                for (int m = 0; m < 4; ++m) {
                    const int t = row0 + ai * HALF + m * 16;
                    if (kind == 0) { f32x4 v0 = acc[ai][bj][m][0], v1 = acc[ai][bj][m][1]; if (nrm) { const float r = rs[bj][ai][m]; v0 = v0 * r * g0; v1 = v1 * r * g1; }
                        *(u32x4*)(base + (size_t)t * ld + cc) = pack8(v0, v1); }
                    else if (kind == 1) { if (c0 == 1728) { *(f32x4*)(WI + (size_t)t * 8) = acc[ai][bj][m][0]; *(f32x4*)(WI + (size_t)t * 8 + 4) = acc[ai][bj][m][1]; } }
                    else { const int g = cc >> 4, ci = cc & 15, b = t >> 11, tt = t & 2047, R = b * 64 + (tt >> 5), s = tt & 31;
                        *(u32x4*)(U + ((size_t)(g * 512 + R)) * 640 + s * 16 + ci) = pack8(acc[ai][bj][m][0], acc[ai][bj][m][1]); }
                }
        }
    }
};
struct EpiMemKVF {
    static constexpr bool PERM = true, AFTER_DRAIN = false;
    bf16_t* KX; bf16_t* VX; const float* gk; PG8_LAS float* XB;
    __device__ __forceinline__ void operator()(const f32x4 (&acc)[2][2][4][2], const Unit& u, int wr, int wc, int fr, int fq) const {
        const int row0 = u.pm * BM + wr * 64 + fr, cb = u.pn * BM; const bool nrm = cb < 512;
        float rs[2][2][4];
        if (nrm) norm128_stats(acc, XB, wr, wc, fr, fq, rs);
#pragma unroll
        for (int bj = 0; bj < 2; ++bj) {
            const int c0 = cb + bj * HALF + wc * 32 + 8 * fq;
            bf16_t* base = nrm ? KX : VX; const int cc = nrm ? c0 : c0 - 512;
            f32x4 g0 = {1.f, 1.f, 1.f, 1.f}, g1 = g0;
            if (nrm) { g0 = *(const f32x4*)(gk + (c0 & 127)); g1 = *(const f32x4*)(gk + (c0 & 127) + 4); }
#pragma unroll
            for (int ai = 0; ai < 2; ++ai)
#pragma unroll
                for (int m = 0; m < 4; ++m) { f32x4 v0 = acc[ai][bj][m][0], v1 = acc[ai][bj][m][1]; if (nrm) { const float r = rs[bj][ai][m]; v0 = v0 * r * g0; v1 = v1 * r * g1; }
                    *(u32x4*)(base + (size_t)(row0 + ai * HALF + m * 16) * 512 + cc) = pack8(v0, v1); }
        }
    }
};
struct EpiGluF {
    static constexpr bool PERM = true, AFTER_DRAIN = false;
    const bf16_t* Y; bf16_t* O;
    __device__ __forceinline__ void operator()(const f32x4 (&acc)[2][2][4][2], const Unit& u, int wr, int wc, int fr, int fq) const {
        const int row0 = u.pm * BM + wr * 64 + fr, c0 = u.pn * BM + wc * 32 + 8 * fq;
#pragma unroll
        for (int ai = 0; ai < 2; ++ai) {
            u32x4 yv[4][2];
#pragma unroll
            for (int m = 0; m < 4; ++m)
#pragma unroll
                for (int bj = 0; bj < 2; ++bj) yv[m][bj] = *(const u32x4*)(Y + (size_t)(row0 + ai * HALF + m * 16) * 512 + c0 + bj * HALF);
            asm volatile("" ::: "memory");
#pragma unroll
            for (int m = 0; m < 4; ++m)
#pragma unroll
                for (int bj = 0; bj < 2; ++bj) { f32x4 y0, y1; unpack8(yv[m][bj], y0, y1);
                    *(u32x4*)(O + (size_t)(row0 + ai * HALF + m * 16) * 512 + c0 + bj * HALF) = pack8(y0 * sigm4(acc[ai][bj][m][0]), y1 * sigm4(acc[ai][bj][m][1])); }
        }
    }
};
struct EpiSigmoidF {
    static constexpr bool PERM = true, AFTER_DRAIN = false;
    bf16_t* G; int ld;
    __device__ __forceinline__ void operator()(const f32x4 (&acc)[2][2][4][2], const Unit& u, int wr, int wc, int fr, int fq) const {
        const int row0 = u.pm * BM + wr * 64 + fr;
#pragma unroll
        for (int bj = 0; bj < 2; ++bj) {
            const int c0 = u.pn * BM + bj * HALF + wc * 32 + 8 * fq;
#pragma unroll
            for (int ai = 0; ai < 2; ++ai)
#pragma unroll
                for (int m = 0; m < 4; ++m) *(u32x4*)(G + (size_t)(row0 + ai * HALF + m * 16) * ld + c0) = pack8(sigm4(acc[ai][bj][m][0]), sigm4(acc[ai][bj][m][1]));
        }
    }
};
struct EpiMergeF {
    static constexpr bool PERM = true, AFTER_DRAIN = false;
    const bf16_t* G3; bf16_t* MG;
    __device__ __forceinline__ void operator()(const f32x4 (&acc)[2][2][4][2], const Unit& u, int wr, int wc, int fr, int fq) const {
        const int row0 = u.pm * BM + wr * 64 + fr, c0 = u.pn * BM + wc * 32 + 8 * fq; const bool first = u.z == 0;
#pragma unroll
        for (int ai = 0; ai < 2; ++ai) {
            u32x4 gv[4][2], pv[4][2];
#pragma unroll
            for (int m = 0; m < 4; ++m)
#pragma unroll
                for (int bj = 0; bj < 2; ++bj) { const size_t t = (size_t)(row0 + ai * HALF + m * 16);
                    gv[m][bj] = *(const u32x4*)(G3 + t * 3072 + u.z * 1024 + c0 + bj * HALF);
                    pv[m][bj] = first ? (u32x4){0u, 0u, 0u, 0u} : *(const u32x4*)(MG + t * 1024 + c0 + bj * HALF); }
            asm volatile("" ::: "memory");
#pragma unroll
            for (int m = 0; m < 4; ++m)
#pragma unroll
                for (int bj = 0; bj < 2; ++bj) { const size_t t = (size_t)(row0 + ai * HALF + m * 16);
                    f32x4 g0, g1, p0, p1; unpack8(gv[m][bj], g0, g1); unpack8(pv[m][bj], p0, p1);
                    *(u32x4*)(MG + t * 1024 + c0 + bj * HALF) = pack8(p0 + g0 * acc[ai][bj][m][0], p1 + g1 * acc[ai][bj][m][1]); }
        }
    }
};
struct EpiOutF {
    static constexpr bool PERM = false, AFTER_DRAIN = false;
    const float* x; float* out; bf16_t* XN; float* RS;
    __device__ __forceinline__ void operator()(const f32x4 (&acc)[2][2][4][2], const Unit& u, int wr, int wc, int fr, int fq) const {
        const int row0 = u.pm * BM + wr * 64 + fr, col0 = u.pn * BM + wc * 32 + 4 * fq;
#pragma unroll
        for (int ai = 0; ai < 2; ++ai) {
            f32x4 xv[4][2][2];
#pragma unroll
            for (int m = 0; m < 4; ++m)
#pragma unroll
                for (int bj = 0; bj < 2; ++bj)
#pragma unroll
                    for (int n = 0; n < 2; ++n) xv[m][bj][n] = *(const f32x4*)(x + (size_t)(row0 + ai * HALF + m * 16) * 1024 + col0 + bj * HALF + n * 16);
            asm volatile("" ::: "memory");
#pragma unroll
            for (int m = 0; m < 4; ++m) { const int t = row0 + ai * HALF + m * 16; const size_t off = (size_t)t * 1024 + col0; float ss = 0.f;
#pragma unroll
                for (int bj = 0; bj < 2; ++bj)
#pragma unroll
                    for (int n = 0; n < 2; ++n) { const size_t o2 = off + bj * HALF + n * 16; const f32x4 r = xv[m][bj][n] + acc[ai][bj][m][n];
                        u32x2 w; w.x = cvt_pk_bf16(r[0], r[1]); w.y = cvt_pk_bf16(r[2], r[3]); *(u32x2*)(XN + o2) = w;
                        ss += (r[0] * r[0] + r[1] * r[1]) + (r[2] * r[2] + r[3] * r[3]); }
                ss += __shfl_xor(ss, 16); ss += __shfl_xor(ss, 32);
                if (fq == 0) RS[(size_t)t * 16 + u.pn * 4 + wc] = ss; }
        }
    }
};
struct EpiGateUpF {
    static constexpr bool PERM = true, AFTER_DRAIN = false;
    const float* RS; bf16_t* ACT;
    __device__ __forceinline__ void operator()(const f32x4 (&acc)[2][2][4][2], const Unit& u, int wr, int wc, int fr, int fq) const {
        const int row0 = u.pm * BM + wr * 64 + fr, f0 = u.pn * HALF + wc * 32 + 8 * fq;
        f32x4 pr[2][4];
#pragma unroll
        for (int ai = 0; ai < 2; ++ai)
#pragma unroll
            for (int m = 0; m < 4; ++m) pr[ai][m] = *(const f32x4*)(RS + (size_t)(row0 + ai * HALF + m * 16) * 16 + 4 * fq);
        asm volatile("" ::: "memory");
#pragma unroll
        for (int ai = 0; ai < 2; ++ai)
#pragma unroll
            for (int m = 0; m < 4; ++m) { const int t = row0 + ai * HALF + m * 16;
                float tot = (pr[ai][m][0] + pr[ai][m][1]) + (pr[ai][m][2] + pr[ai][m][3]); tot += __shfl_xor(tot, 16); tot += __shfl_xor(tot, 32);
                const float rs = __builtin_amdgcn_rsqf(tot * (1.f / 1024.f) + 1e-6f);
                f32x4 o[2];
#pragma unroll
                for (int n = 0; n < 2; ++n) { const f32x4 g = acc[ai][0][m][n] * rs, up = acc[ai][1][m][n] * rs; o[n] = g * sigm4(g) * up; }
                *(u32x4*)(ACT + (size_t)t * 2816 + f0) = pack8(o[0], o[1]); }
    }
};
struct EpiDownF {
    static constexpr bool PERM = false, AFTER_DRAIN = false;
    const bf16_t* XN; float* out;
    __device__ __forceinline__ void operator()(const f32x4 (&acc)[2][2][4][2], const Unit& u, int wr, int wc, int fr, int fq) const {
        const int row0 = u.pm * BM + wr * 64 + fr, col0 = u.pn * BM + wc * 32 + 4 * fq;
#pragma unroll
        for (int ai = 0; ai < 2; ++ai) {
            u32x2 xv[4][2][2];
#pragma unroll
            for (int m = 0; m < 4; ++m)
#pragma unroll
                for (int bj = 0; bj < 2; ++bj)
#pragma unroll
                    for (int n = 0; n < 2; ++n) xv[m][bj][n] = *(const u32x2*)(XN + (size_t)(row0 + ai * HALF + m * 16) * 1024 + col0 + bj * HALF + n * 16);
            asm volatile("" ::: "memory");
#pragma unroll
            for (int m = 0; m < 4; ++m)
#pragma unroll
                for (int bj = 0; bj < 2; ++bj)
#pragma unroll
                    for (int n = 0; n < 2; ++n) { const u32x2 w = xv[m][bj][n];
                        const f32x4 x1 = {__uint_as_float(w.x << 16), __uint_as_float(w.x & 0xffff0000u), __uint_as_float(w.y << 16), __uint_as_float(w.y & 0xffff0000u)};
                        *(f32x4*)(out + (size_t)(row0 + ai * HALF + m * 16) * 1024 + col0 + bj * HALF + n * 16) = x1 + acc[ai][bj][m][n]; }
        }
    }
};
struct EpiSlocF {
    static constexpr bool PERM = false, AFTER_DRAIN = false;
    float* SLOC;
    __device__ __forceinline__ void operator()(const f32x4 (&acc)[2][2][4][2], const Unit& u, int wr, int wc, int fr, int fq) const {
        const int row0 = u.pm * BM + wr * 64 + fr, col0 = wc * 32 + 4 * fq;
#pragma unroll
        for (int ai = 0; ai < 2; ++ai)
#pragma unroll
            for (int m = 0; m < 4; ++m)
#pragma unroll
                for (int n = 0; n < 2; ++n) *(f32x4*)(SLOC + (size_t)(row0 + ai * HALF + m * 16) * 128 + col0 + n * 16) = acc[ai][0][m][n];
    }
};
__device__ __forceinline__ float gelu_t(float x) { const float w = 1.5957691216057308f * (x + 0.044715f * x * x * x); return x * __builtin_amdgcn_rcpf(1.f + __expf(-w)); }
struct EpiS5YF {
    static constexpr bool PERM = true, AFTER_DRAIN = false;
    const bf16_t* U; const float* dskip; bf16_t* Y;
    __device__ __forceinline__ void operator()(const f32x4 (&acc)[2][2][4][2], const Unit& u, int wr, int wc, int fr, int fq) const {
        const int row0 = u.pm * BM + wr * 64 + fr, g = (u.pm * BM) >> 9;
        f32x4 dk[2][2];
#pragma unroll
        for (int bj = 0; bj < 2; ++bj) { const int co0 = ((u.pn & 1) * BM + bj * HALF + wc * 32 + 8 * fq) & 15; dk[bj][0] = *(const f32x4*)(dskip + g * 16 + co0); dk[bj][1] = *(const f32x4*)(dskip + g * 16 + co0 + 4); }
#pragma unroll
        for (int ai = 0; ai < 2; ++ai) {
            u32x4 uv[4][2];
#pragma unroll
            for (int m = 0; m < 4; ++m)
#pragma unroll
                for (int bj = 0; bj < 2; ++bj) { const int cl = (u.pn & 1) * BM + bj * HALF + wc * 32 + 8 * fq; uv[m][bj] = *(const u32x4*)(U + (size_t)(row0 + ai * HALF + m * 16) * 640 + cl); }
            asm volatile("" ::: "memory");
#pragma unroll
            for (int m = 0; m < 4; ++m)
#pragma unroll
                for (int bj = 0; bj < 2; ++bj) { const int cl = (u.pn & 1) * BM + bj * HALF + wc * 32 + 8 * fq, s = cl >> 4, co0 = cl & 15;
                    const int row = row0 + ai * HALF + m * 16, R = row & 511, b = R >> 6, ch = R & 63, t = b * 2048 + ch * 32 + s;
                    f32x4 u0, u1; unpack8(uv[m][bj], u0, u1);
                    f32x4 y0 = acc[ai][bj][m][0] + dk[bj][0] * u0, y1 = acc[ai][bj][m][1] + dk[bj][1] * u1;
#pragma unroll
                    for (int e2 = 0; e2 < 4; ++e2) { y0[e2] = gelu_t(y0[e2]); y1[e2] = gelu_t(y1[e2]); }
                    *(u32x4*)(Y + (size_t)t * 512 + g * 16 + co0) = pack8(y0, y1); }
        }
    }
};
struct SubsetOrder { StaticOrder so; bool active;
    __device__ void init(int M, int N, int Gsub, int csub) { so.init(M, N, Gsub, csub < 0 ? 0 : csub); active = csub >= 0 && csub < Gsub; }
    __device__ bool next(int i, Unit& u) const { return active && so.next(i, u); }
    __device__ __forceinline__ void a_ready(const Unit&) const {}
    __device__ __forceinline__ void done(const Unit&) const {}
    __device__ __forceinline__ long a_off(const Unit&) const { return 0; }
    __device__ __forceinline__ long b_off(const Unit&) const { return 0; } };
struct S5Order1 { int c;
    __device__ bool next(int i, Unit& u) const { if (i > 0 || c < 0 || c >= 64) return false; u.pm = c; u.pn = c >> 1; u.z = 0; return true; }
    __device__ __forceinline__ void a_ready(const Unit&) const {}
    __device__ __forceinline__ void done(const Unit&) const {}
    __device__ __forceinline__ long a_off(const Unit&) const { return 0; }
    __device__ __forceinline__ long b_off(const Unit&) const { return 0; } };
struct S5Order2 { int c;
    __device__ bool next(int i, Unit& u) const { if (i > 0 || c < 0 || c >= 128) return false; const int g = c >> 2; u.pm = g * 2 + ((c >> 1) & 1); u.pn = g * 2 + (c & 1); u.z = 0; return true; }
    __device__ __forceinline__ void a_ready(const Unit&) const {}
    __device__ __forceinline__ void done(const Unit&) const {}
    __device__ __forceinline__ long a_off(const Unit&) const { return 0; }
    __device__ __forceinline__ long b_off(const Unit&) const { return 0; } };
struct GateOrder { int c;
    __device__ bool next(int i, Unit& u) const { int id; if (i >= 3) return false; id = c * 3 + i; u.pm = id / 12; u.pn = id % 12; u.z = 0; return true; }
    __device__ __forceinline__ void a_ready(const Unit&) const {}
    __device__ __forceinline__ void done(const Unit&) const {}
    __device__ __forceinline__ long a_off(const Unit&) const { return 0; }
    __device__ __forceinline__ long b_off(const Unit&) const { return 0; } };
struct MergeOrder { StaticOrder so; long aoff[3];
    __device__ bool next(int i, Unit& u) const { if (i >= 3) return false; if (!so.next(0, u)) return false; u.z = i; return true; }
    __device__ __forceinline__ void a_ready(const Unit&) const {}
    __device__ __forceinline__ void done(const Unit&) const {}
    __device__ __forceinline__ long a_off(const Unit& u) const { return u.z == 0 ? aoff[0] : (u.z == 1 ? aoff[1] : aoff[2]); }
    __device__ __forceinline__ long b_off(const Unit& u) const { return (long)u.z * 1024 * 512 * 2; } };
}
#define GAS __attribute__((address_space(1)))
#define LAS __attribute__((address_space(3)))
typedef unsigned short bf16;
typedef unsigned v4u __attribute__((ext_vector_type(4)));
typedef float f32x4 __attribute__((ext_vector_type(4)));
typedef short bf16x8 __attribute__((ext_vector_type(8)));
typedef GAS unsigned gu32;
typedef GAS unsigned long long gu64;
#define RLX_AGENT __ATOMIC_RELAXED, __HIP_MEMORY_SCOPE_AGENT
#define LDS_WAIT() asm volatile("s_waitcnt lgkmcnt(0)" ::: "memory")
#define VM_WAIT() asm volatile("s_waitcnt vmcnt(0)" ::: "memory")
__device__ __forceinline__ unsigned long long rt() { return __builtin_amdgcn_s_memrealtime(); }
__device__ __forceinline__ unsigned f2bf(float f) { unsigned u = __builtin_bit_cast(unsigned, f); return (u + 0x7fffu + ((u >> 16) & 1u)) >> 16; }
__device__ __forceinline__ unsigned pk2(float lo, float hi) { return f2bf(lo) | (f2bf(hi) << 16); }

#define XB_TMO      128
#define XB_XCNT(j)  (256  + 64 * (j))
#define XB_XSUB(j)  (1280 + 64 * (j))
#define XB_XGEN(j)  (2304 + 64 * (j))
#define XB_TOP      3328
#define XB_TOPGEN   3392
#define XCD_BAR_WORDS 3456
#define XB_SPIN_CAP (1u << 18)

__device__ __forceinline__ unsigned xb_ld(unsigned* p)              { return __hip_atomic_load(p, __ATOMIC_RELAXED, __HIP_MEMORY_SCOPE_AGENT); }
__device__ __forceinline__ unsigned xb_add(unsigned* p, unsigned v) { return __hip_atomic_fetch_add(p, v, __ATOMIC_RELAXED, __HIP_MEMORY_SCOPE_AGENT); }
__device__ __forceinline__ unsigned xb_xcc_id() { return (unsigned)__builtin_amdgcn_s_getreg((3 << 11) | 20) & 0xFu; }
#define XB_SPIN(cond, bar) do { unsigned _sp = 0; while (cond) { __builtin_amdgcn_s_sleep(1); \
    if ((++_sp & 255u) == 0u) { if (xb_ld(&(bar)[XB_TMO])) break; if (_sp > XB_SPIN_CAP) { atomicAdd(&(bar)[XB_TMO], 1u); break; } } } } while (0)

struct XcdBarrier {
    unsigned* bar; unsigned x;
    volatile LAS unsigned* st;
};

__device__ __forceinline__ XcdBarrier xcd_barrier_post(unsigned* bar, volatile LAS unsigned* st, bool leader) {
    XcdBarrier b; b.bar = bar; b.x = xb_xcc_id(); b.st = st;
    if (leader) (void)xb_add(&bar[XB_XCNT(b.x)], 1u);
    return b;
}
__device__ __forceinline__ void xcd_barrier_complete(unsigned* bar, unsigned x, unsigned& nloc, unsigned& nx) {
    const unsigned G = gridDim.x * gridDim.y * gridDim.z;
    unsigned sum, cnt, mine, sp = 0u;
    for (;;) {
        sum = 0u; cnt = 0u; mine = 0u;
#pragma unroll
        for (unsigned j = 0; j < 16; ++j) { const unsigned c = xb_ld(&bar[XB_XCNT(j)]); sum += c; cnt += (c > 0u) ? 1u : 0u; mine = (j == x) ? c : mine; }
        if (sum == G) break;
        __builtin_amdgcn_s_sleep(1);
        if ((++sp & 255u) == 0u) { if (xb_ld(&bar[XB_TMO])) break; if (sp > XB_SPIN_CAP) { atomicAdd(&bar[XB_TMO], 1u); break; } }
    }
    nloc = mine > 0u ? mine : 1u; nx = cnt > 0u ? cnt : 1u;
}

__device__ __forceinline__ void xcd_barrier(const XcdBarrier& b, bool leader) {
    asm volatile("s_waitcnt vmcnt(0)" ::: "memory");
    __syncthreads();
    if (leader) {
        unsigned* bar = b.bar;
        __builtin_amdgcn_s_waitcnt(0);
        unsigned nloc = b.st[0], nx = b.st[1];
        if (nloc == 0u) { xcd_barrier_complete(bar, b.x, nloc, nx); b.st[0] = nloc; b.st[1] = nx; }
        const unsigned old = xb_add(&bar[XB_XSUB(b.x)], 1u);
        const unsigned gen = old / nloc;
        if (old + 1u == (gen + 1u) * nloc) {
            __builtin_amdgcn_fence(__ATOMIC_RELEASE, "agent");
            asm volatile("s_waitcnt vmcnt(0)" ::: "memory");
            const unsigned og = xb_add(&bar[XB_TOP], 1u);
            const unsigned tg = og / nx;
            if (og + 1u == (tg + 1u) * nx) xb_add(&bar[XB_TOPGEN], 1u);
            else XB_SPIN(xb_ld(&bar[XB_TOPGEN]) == tg, bar);
            __builtin_amdgcn_fence(__ATOMIC_ACQUIRE, "agent");
            xb_add(&bar[XB_XGEN(b.x)], 1u);
            asm volatile("s_waitcnt vmcnt(0)" ::: "memory");
        } else {
            XB_SPIN(xb_ld(&bar[XB_XGEN(b.x)]) == gen, bar);
            __builtin_amdgcn_fence(__ATOMIC_ACQUIRE, "agent");
            asm volatile("s_waitcnt vmcnt(0)" ::: "memory");
        }
    }
    __syncthreads();
}
constexpr int NWAVES = 8, NTHR = 512;
constexpr int RING_OFF = 0, RING_BYTES = 131072;
constexpr int LDSCTL_OFF = RING_BYTES, MISC_OFF = LDSCTL_OFF + 320, XB_OFF = RING_BYTES + 1024;
constexpr int LDS_BYTES = 147456;
constexpr size_t CTL_ZERO_BYTES = 65536;
constexpr int CW_TMO = 0, CW_BAR = 4096;
constexpr int NPH = 9;
constexpr int FL_NO_DSA = 1, FL_NO_CROSS = 2, FL_NO_S5 = 4;
constexpr size_t WS_LAM32 = WS_BIASL + 8192;

struct Args { const float* in[29]; float* out; unsigned char* ws; int ph_lo, ph_hi, flags, li; };

__device__ __forceinline__ float wave_sum(float v) {
#pragma unroll
    for (int o = 1; o < 64; o <<= 1) v += __shfl_xor(v, o);
    return v;
}
__device__ __forceinline__ float p0_src(int mode, const float* W, const float* W2, const float* gain, int N, int k, int d) {
    if (mode == 0) return W[(size_t)k * N + d];
    if (mode == 1) { if (d >= 1736 && d < 1792) return 0.f; const int s = d >= 1792 ? d - 56 : d; return W[(size_t)k * N + s]; }
    const int tile = d >> 8, w = d & 255, f = tile * 128 + (w & 127); return ((w < 128) ? W : W2)[(size_t)k * N + f] * gain[k];
}
__device__ __forceinline__ void p0_transpose_item(int mode, const float* W, const float* W2, const float* gain, int K, int N, int ND, bf16* WT, LAS float* scr, int item, int lane) {
    const int nblk = ND / 32, kb = item / nblk, nb = item % nblk, k0 = 64 * kb, d0 = 32 * nb;
    float tv[32];
#pragma unroll
    for (int i = 0; i < 32; ++i) tv[i] = p0_src(mode, W, W2, gain, N, k0 + 2 * i + (lane >> 5), d0 + (lane & 31));
#pragma unroll
    for (int i = 0; i < 32; ++i) scr[(2 * i + (lane >> 5)) * 33 + (lane & 31)] = tv[i];
    LDS_WAIT(); asm volatile("" ::: "memory");
    const int c = lane & 7;
#pragma unroll
    for (int j = 0; j < 4; ++j) { const int n = (lane >> 3) + 8 * j; const LAS float* s = scr + (8 * c) * 33 + n;
        v4u o; o.x = pk2(s[0 * 33], s[1 * 33]); o.y = pk2(s[2 * 33], s[3 * 33]); o.z = pk2(s[4 * 33], s[5 * 33]); o.w = pk2(s[6 * 33], s[7 * 33]);
        *(GAS v4u*)(WT + (size_t)(d0 + n) * K + k0 + 8 * c) = o; }
    LDS_WAIT(); asm volatile("" ::: "memory");
}
__device__ __forceinline__ void rms_row_to_bf16(const float* xrow, const float* g, bf16* orow, int lane) {
    const GAS f32x4* xr = (const GAS f32x4*)xrow + lane; const GAS f32x4* gr = (const GAS f32x4*)g + lane;
    f32x4 v[4]; float s = 0.f;
#pragma unroll
    for (int j = 0; j < 4; ++j) { v[j] = xr[64 * j]; s += (v[j].x * v[j].x + v[j].y * v[j].y) + (v[j].z * v[j].z + v[j].w * v[j].w); }
    const float rstd = 1.f / sqrtf(wave_sum(s) * (1.f / 1024.f) + 1e-6f);
    GAS unsigned long long* o8 = (GAS unsigned long long*)orow + lane;
#pragma unroll
    for (int j = 0; j < 4; ++j) { const f32x4 gg = gr[64 * j];
        o8[64 * j] = (unsigned long long)pk2(v[j].x * rstd * gg.x, v[j].y * rstd * gg.y) | ((unsigned long long)pk2(v[j].z * rstd * gg.z, v[j].w * rstd * gg.w) << 32); }
}
__device__ __forceinline__ int t5_bucket(int n) {
    if (n < 16) return n;
    const int large = 16 + (int)((logf((float)n / 16.f) / 2.0794415416798357f) * 16.f);
    return large < 31 ? large : 31;
}
__device__ __forceinline__ void p0_s5_tables(int g, int part, const Args& a, LAS unsigned char* lds, int tid) {
    typedef float f32x2v __attribute__((ext_vector_type(2)));
    LAS f32x2v* POW = (LAS f32x2v*)lds;
    LAS f32x2v* BB = POW + 33 * 64;
    LAS f32x2v* CC = BB + 64 * 16;
    LAS float* KT = (LAS float*)(CC + 16 * 64);
    const float *a_re = a.in[8], *a_im = a.in[9], *log_dt = a.in[10], *b_re = a.in[11], *b_im = a.in[12], *c_re = a.in[13], *c_im = a.in[14];
    bf16* TV = (bf16*)(a.ws + WS_S5TV) + (size_t)g * 512 * 640; bf16* Wt = (bf16*)(a.ws + WS_S5W) + (size_t)g * 256 * 512; float* LAM32 = (float*)(a.ws + WS_LAM32) + g * 128;
    const double dt = exp((double)log_dt[g]);
    for (int idx = tid; idx < 33 * 64; idx += NTHR) { const int j = idx >> 6, n = idx & 63; const double lr = a_re[g * 64 + n], li = a_im[g * 64 + n];
        const double mag = exp(lr * dt * j), ang = li * dt * j; POW[idx] = (f32x2v){(float)(mag * cos(ang)), (float)(mag * sin(ang))}; }
    for (int idx = tid; idx < 64 * 16; idx += NTHR) { const int n = idx >> 4, c = idx & 15; const double lr = a_re[g * 64 + n], li = a_im[g * 64 + n];
        const double mag = exp(lr * dt), lbr = mag * cos(li * dt), lbi = mag * sin(li * dt), nr = lbr - 1.0, ni = lbi, den = lr * lr + li * li;
        const double fr = (nr * lr + ni * li) / den, fi = (ni * lr - nr * li) / den, br = b_re[(g * 64 + n) * 16 + c], bi = b_im[(g * 64 + n) * 16 + c];
        BB[idx] = (f32x2v){(float)(fr * br - fi * bi), (float)(fr * bi + fi * br)};
        const int c2 = idx >> 6, n2 = idx & 63; CC[idx] = (f32x2v){c_re[(g * 16 + c2) * 64 + n2], c_im[(g * 16 + c2) * 64 + n2]}; }
    __syncthreads();
    if (part == 0 && tid < 64) { const f32x2v p = POW[32 * 64 + tid]; LAM32[tid * 2] = p.x; LAM32[tid * 2 + 1] = p.y; }
    for (int idx = tid; idx < 32 * 32; idx += NTHR) { const int j = idx >> 5, co = 2 * part + ((idx >> 4) & 1), ci = idx & 15; float s = 0.f;
#pragma unroll 2
        for (int n = 0; n < 64; ++n) { const f32x2v c = CC[co * 64 + n], p = POW[j * 64 + n], b = BB[n * 16 + ci];
            const float cpr = c.x * p.x - c.y * p.y, cpi = c.x * p.y + c.y * p.x; s += cpr * b.x - cpi * b.y; }
        KT[j * 256 + co * 16 + ci] = s; }
    __syncthreads();
    for (int id = tid; id < 64 * 80; id += NTHR) { const int rl = id / 80, c8 = id % 80, so = rl >> 1, co = 2 * part + (rl & 1), row = so * 16 + co; float v[8];
        if (c8 < 64) { const int si = c8 >> 1, ci0 = (c8 & 1) * 8;
#pragma unroll
            for (int e = 0; e < 8; ++e) v[e] = so >= si ? KT[(so - si) * 256 + co * 16 + ci0 + e] : 0.f; }
        else {
#pragma unroll
            for (int e = 0; e < 8; ++e) { const int np = (c8 - 64) * 8 + e, n = np & 63; const f32x2v c = CC[co * 64 + n], p = POW[(so + 1) * 64 + n];
                v[e] = np < 64 ? (c.x * p.x - c.y * p.y) : -(c.x * p.y + c.y * p.x); } }
        v4u o; o.x = pk2(v[0], v[1]); o.y = pk2(v[2], v[3]); o.z = pk2(v[4], v[5]); o.w = pk2(v[6], v[7]);
        *(GAS v4u*)(TV + (size_t)row * 640 + c8 * 8) = o; }
    for (int id = tid; id < 16 * 64; id += NTHR) { const int np = 16 * part + (id >> 6), c8 = id & 63, n = np & 63, s = c8 >> 1, ci0 = (c8 & 1) * 8; const f32x2v p = POW[(31 - s) * 64 + n]; float v[8];
#pragma unroll
        for (int e = 0; e < 8; ++e) { const f32x2v b = BB[n * 16 + ci0 + e]; v[e] = np < 64 ? (p.x * b.x - p.y * b.y) : (p.x * b.y + p.y * b.x); }
        v4u o; o.x = pk2(v[0], v[1]); o.y = pk2(v[2], v[3]); o.z = pk2(v[4], v[5]); o.w = pk2(v[6], v[7]);
        *(GAS v4u*)(Wt + (size_t)np * 512 + c8 * 8) = o; }
    __syncthreads();
}
#ifndef P0RPT
#define P0RPT 0
#endif
#define P0R(k) ((P0RPT >> (k)) & 1)
__device__ __forceinline__ void p0_prologue(const Args& a, LAS unsigned char* lds, int tid, int lane, int wave, int vcu, int G) {
    unsigned char* ws = a.ws;
    LAS float* scr = (LAS float*)(lds + RING_OFF + wave * 16384);
    const int gw = vcu * NWAVES + wave, NGW = G * NWAVES;
    p0_s5_tables(vcu >> 3, vcu & 7, a, lds, tid);
    if (blockIdx.x == 33 && wave == 0) {
        float gq = fmaxf(fabsf(a.in[5][lane]), fabsf(a.in[5][lane + 64])), gk = fmaxf(fabsf(a.in[6][lane]), fabsf(a.in[6][lane + 64]));
        float bm = fmaxf(fmaxf(fabsf(a.in[2][lane]), fabsf(a.in[2][lane + 64])), fmaxf(fabsf(a.in[2][lane + 128]), fabsf(a.in[2][lane + 192])));
#pragma unroll
        for (int o = 1; o < 64; o <<= 1) { gq = fmaxf(gq, __shfl_xor(gq, o)); gk = fmaxf(gk, __shfl_xor(gk, o)); bm = fmaxf(bm, __shfl_xor(bm, o)); }
        const float B = 1.02f * 128.f * 0.08838834764831845f * 1.4426950408889634f * gq * gk + bm * 1.4426950408889634f;
        if (lane == 0) ((float*)(ws + WS_BIASL))[1032] = (B > 0.f && B <= 56.f) ? B : 0.f; }
    if (blockIdx.x == 32) { float* BL = (float*)(ws + WS_BIASL); const float* rb = a.in[2];
        for (int i = tid; i < 8 * 128 + 8; i += NTHR) { if (i < 1024) { const int h = i >> 7, d = i & 127; BL[i] = rb[t5_bucket(d) * 8 + h] * 1.4426950408889634f; } else BL[i] = rb[31 * 8 + (i - 1024)] * 1.4426950408889634f; } }
    { bf16* WUV = (bf16*)(ws + WS_WUV); const float* w = a.in[7];
        for (int i = blockIdx.x * NTHR + tid; i < 8 * 64 * 128; i += G * NTHR) { const int ep = i & 3, ln = (i >> 2) & 63, t = (i >> 8) & 1, cs = (i >> 9) & 7, eb = (i >> 12) & 1, h = i >> 13;
            const int d = 16 * cs + 8 * t + 4 * (ln >> 5) + ep, e = 32 * eb + (ln & 31); WUV[i] = (bf16)f2bf(w[(h * 128 + d) * 64 + e]); } }
    constexpr int I_IN = 16 * 184, I_MKV = 16 * 32, I_GLU = 8 * 16, I_BR = 8 * 32, I_OUT = 16 * 32, I_GU = 16 * 176, I_D = 44 * 32;
    constexpr int NITEMS = I_IN + I_MKV + I_GLU + 3 * I_BR + I_OUT + I_GU + I_D;
    _Pragma("unroll 1") for (int rp_ = 0; rp_ <= P0R(1); ++rp_)
    for (int it = gw; it < NITEMS; it += NGW) {
        int r = it;
        if (r < I_IN) { p0_transpose_item(1, a.in[3], nullptr, nullptr, 1024, 5832, 5888, (bf16*)(ws + WS_WIN), scr, r, lane); continue; } r -= I_IN;
        if (r < I_MKV) { p0_transpose_item(0, a.in[18], nullptr, nullptr, 1024, 1024, 1024, (bf16*)(ws + WS_WMKV), scr, r, lane); continue; } r -= I_MKV;
        if (r < I_GLU) { p0_transpose_item(0, a.in[16], nullptr, nullptr, 512, 512, 512, (bf16*)(ws + WS_WGLU), scr, r, lane); continue; } r -= I_GLU;
        if (r < 3 * I_BR) { const int br = r / I_BR; p0_transpose_item(0, a.in[21 + br], nullptr, nullptr, 512, 1024, 1024, (bf16*)(ws + WS_WBR) + (size_t)br * 1024 * 512, scr, r % I_BR, lane); continue; } r -= 3 * I_BR;
        if (r < I_OUT) { p0_transpose_item(0, a.in[24], nullptr, nullptr, 1024, 1024, 1024, (bf16*)(ws + WS_WOUT), scr, r, lane); continue; } r -= I_OUT;
        if (r < I_GU) { p0_transpose_item(2, a.in[26], a.in[27], a.in[25], 1024, 2816, 5632, (bf16*)(ws + WS_WGU), scr, r, lane); continue; } r -= I_GU;
        p0_transpose_item(0, a.in[28], nullptr, nullptr, 2816, 1024, 1024, (bf16*)(ws + WS_WD), scr, r, lane);
    }
    _Pragma("unroll 1") for (int rp_ = 0; rp_ <= P0R(2); ++rp_)
    for (int m = gw; m < T_TOK; m += 2 * NGW) {
        const GAS f32x4* x0 = (const GAS f32x4*)(a.in[0] + (size_t)m * 1024) + lane; const GAS f32x4* x1 = (const GAS f32x4*)(a.in[0] + (size_t)(m + NGW) * 1024) + lane; const GAS f32x4* gr = (const GAS f32x4*)a.in[4] + lane;
        f32x4 v0[4], v1[4]; float s0 = 0.f, s1 = 0.f;
#pragma unroll
        for (int j = 0; j < 4; ++j) { v0[j] = x0[64 * j]; v1[j] = x1[64 * j]; }
#pragma unroll
        for (int j = 0; j < 4; ++j) { s0 += (v0[j].x * v0[j].x + v0[j].y * v0[j].y) + (v0[j].z * v0[j].z + v0[j].w * v0[j].w); s1 += (v1[j].x * v1[j].x + v1[j].y * v1[j].y) + (v1[j].z * v1[j].z + v1[j].w * v1[j].w); }
        const float r0 = 1.f / sqrtf(wave_sum(s0) * (1.f / 1024.f) + 1e-6f), r1 = 1.f / sqrtf(wave_sum(s1) * (1.f / 1024.f) + 1e-6f);
        GAS unsigned long long* o0 = (GAS unsigned long long*)((bf16*)(ws + WS_H) + (size_t)m * 1024) + lane; GAS unsigned long long* o1 = (GAS unsigned long long*)((bf16*)(ws + WS_H) + (size_t)(m + NGW) * 1024) + lane;
#pragma unroll
        for (int j = 0; j < 4; ++j) { const f32x4 gg = gr[64 * j];
            o0[64 * j] = (unsigned long long)pk2(v0[j].x * r0 * gg.x, v0[j].y * r0 * gg.y) | ((unsigned long long)pk2(v0[j].z * r0 * gg.z, v0[j].w * r0 * gg.w) << 32);
            o1[64 * j] = (unsigned long long)pk2(v1[j].x * r1 * gg.x, v1[j].y * r1 * gg.y) | ((unsigned long long)pk2(v1[j].z * r1 * gg.z, v1[j].w * r1 * gg.w) << 32); }
    }
    for (int m = gw; m < 2048; m += NGW) rms_row_to_bf16(a.in[1] + (size_t)m * 1024, a.in[17], (bf16*)(ws + WS_MEMN) + (size_t)m * 1024, lane);
    if (P0R(0)) { __syncthreads(); p0_s5_tables(vcu >> 3, vcu & 7, a, lds, tid); }
}
__device__ __forceinline__ void norm128_pass(bf16* X, int rows, int ld, int ngroups, const float* g, int gtid, int nthr) {
    const int l = gtid & 15, total = rows * ngroups;
    for (int gid = gtid >> 4; gid < total; gid += nthr >> 4) {
        const int r = gid / ngroups, gi = gid % ngroups;
        bf16* p = X + (size_t)r * ld + gi * 128 + l * 8;
        const v4u v = *(const GAS v4u*)p; float f[8];
        f[0] = __uint_as_float(v.x << 16); f[1] = __uint_as_float(v.x & 0xffff0000u); f[2] = __uint_as_float(v.y << 16); f[3] = __uint_as_float(v.y & 0xffff0000u);
        f[4] = __uint_as_float(v.z << 16); f[5] = __uint_as_float(v.z & 0xffff0000u); f[6] = __uint_as_float(v.w << 16); f[7] = __uint_as_float(v.w & 0xffff0000u);
        float s = 0.f;
#pragma unroll
        for (int q = 0; q < 8; ++q) s += f[q] * f[q];
        s += __shfl_xor(s, 8); s += __shfl_xor(s, 4); s += __shfl_xor(s, 2); s += __shfl_xor(s, 1);
        const float rs = 1.f / sqrtf(s * (1.f / 128.f) + 1e-6f);
        const f32x4 g0 = *(const GAS f32x4*)(g + l * 8), g1 = *(const GAS f32x4*)(g + l * 8 + 4);
        v4u o; o.x = pk2(f[0] * rs * g0.x, f[1] * rs * g0.y); o.y = pk2(f[2] * rs * g0.z, f[3] * rs * g0.w); o.z = pk2(f[4] * rs * g1.x, f[5] * rs * g1.y); o.w = pk2(f[6] * rs * g1.z, f[7] * rs * g1.w);
        *(GAS v4u*)p = o;
    }
}
__device__ __forceinline__ void s5_scan(int g, int half, const Args& a, int tid) {
    if (tid < 256) {
        const int bl = tid >> 6, n = tid & 63, b = half * 4 + bl;
        const float* LAM32 = (const float*)(a.ws + WS_LAM32) + g * 128; const float lr = LAM32[n * 2], li = LAM32[n * 2 + 1];
        const float* SL = (const float*)(a.ws + WS_SLOC) + ((size_t)(g * 512 + b * 64)) * 128; bf16* Ur = (bf16*)(a.ws + WS_U) + ((size_t)(g * 512 + b * 64)) * 640 + 512;
        float xr = 0.f, xi = 0.f;
#pragma unroll 1
        for (int c0 = 0; c0 < 64; c0 += 16) {
            float sr[16], si[16];
#pragma unroll
            for (int k = 0; k < 16; ++k) { sr[k] = SL[(size_t)(c0 + k) * 128 + n]; si[k] = SL[(size_t)(c0 + k) * 128 + 64 + n]; }
#pragma unroll
            for (int k = 0; k < 16; ++k) {
                Ur[(size_t)(c0 + k) * 640 + n] = (bf16)f2bf(xr); Ur[(size_t)(c0 + k) * 640 + 64 + n] = (bf16)f2bf(xi);
                const float nr = lr * xr - li * xi + sr[k], ni = lr * xi + li * xr + si[k]; xr = nr; xi = ni;
            }
        }
    }
    VM_WAIT(); __syncthreads();
}
#define HAVE_ATTN 1
#ifdef TPROBE
#if TPROBE < 8
#define TP_STAMP(k) { __builtin_amdgcn_sched_barrier(0); const unsigned long long t_ = __builtin_amdgcn_s_memtime(); tp_acc[k] += t_ - tp_prev; tp_prev = t_; __builtin_amdgcn_sched_barrier(0); }
#define TP_DECL unsigned long long tp_acc[8] = {0, 0, 0, 0, 0, 0, 0, 0}; unsigned long long tp_prev = __builtin_amdgcn_s_memtime();
#define TP_FLUSH(base) { if (blockIdx.x == TPROBE_BLOCK && wave == 0 && lane == 0) { unsigned long long* TP = (unsigned long long*)(a.ws + WS_CTL + 65536); for (int k_ = 0; k_ < 8; ++k_) TP[(base) + k_] += tp_acc[k_]; } }
#define TQ_STAMP(k)
#define TQ_DECL
#define TQ_FLUSH
#else
#define TP_STAMP(k)
#define TP_DECL
#define TP_FLUSH(base)
#define TQ_STAMP(k) { const unsigned t_ = (unsigned)__builtin_amdgcn_s_memtime(); tq_acc[k] += t_ - tq_prev; tq_prev = t_; }
#define TQ_DECL unsigned tq_acc[4] = {0, 0, 0, 0}; unsigned tq_prev = (unsigned)__builtin_amdgcn_s_memtime();
#define TQ_FLUSH { if (blockIdx.x == TPROBE_BLOCK && wave == 0 && lane == 0) { unsigned long long* TP = (unsigned long long*)(a.ws + WS_CTL + 65536); for (int k_ = 0; k_ < 4; ++k_) TP[8 + k_] += tq_acc[k_]; } }
#endif
#else
#define TP_STAMP(k)
#define TP_DECL
#define TP_FLUSH(base)
#define TQ_STAMP(k)
#define TQ_DECL
#define TQ_FLUSH
#endif
namespace att {
typedef float f32x16 __attribute__((ext_vector_type(16)));
typedef short s16x4 __attribute__((ext_vector_type(4)));
typedef short v4i16_t __attribute__((ext_vector_type(4)));
typedef float f32x2_t __attribute__((ext_vector_type(2))); typedef __bf16 bf16x2_t __attribute__((ext_vector_type(2)));
typedef unsigned u32x2 __attribute__((ext_vector_type(2)));
#define MFMA32(a, b, c) __builtin_amdgcn_mfma_f32_32x32x16_bf16((a), (b), (c), 0, 0, 0)
__device__ __forceinline__ unsigned cvtpk(float lo, float hi) { const f32x2_t v = {lo, hi}; const bf16x2_t b = __builtin_convertvector(v, bf16x2_t); return __builtin_bit_cast(unsigned, b); }
__device__ __forceinline__ int crow(int r, int hi) { return (r & 3) + 8 * (r >> 2) + 4 * hi; }
__device__ __forceinline__ unsigned off_b(unsigned row, unsigned ch) { return 256u * row + 16u * (ch ^ (((row & 3u) << 2) | ((row >> 2) & 3u))); }
__device__ __forceinline__ float xh_max(float v) { const auto rr = __builtin_amdgcn_permlane32_swap(__float_as_uint(v), __float_as_uint(v), false, false); return fmaxf(__uint_as_float(rr[0]), __uint_as_float(rr[1])); }
__device__ __forceinline__ float xh_sum(float v) { const auto rr = __builtin_amdgcn_permlane32_swap(__float_as_uint(v), __float_as_uint(v), false, false); return __uint_as_float(rr[0]) + __uint_as_float(rr[1]); }
__device__ __forceinline__ unsigned xh_sumu(unsigned v) { const auto rr = __builtin_amdgcn_permlane32_swap(v, v, false, false); return rr[0] + rr[1]; }
__device__ __forceinline__ unsigned xh_or(unsigned v) { const auto rr = __builtin_amdgcn_permlane32_swap(v, v, false, false); return rr[0] | rr[1]; }
constexpr float SCALE2 = 0.08838834764831845f * 1.4426950408889634f;

__device__ __forceinline__ bf16x8 pack_step(const f32x16& x, int s) {
    v4u p; p.x = cvtpk(x[8 * s], x[8 * s + 1]); p.y = cvtpk(x[8 * s + 2], x[8 * s + 3]); p.z = cvtpk(x[8 * s + 4], x[8 * s + 5]); p.w = cvtpk(x[8 * s + 6], x[8 * s + 7]);
    return __builtin_bit_cast(bf16x8, p);
}
__device__ __forceinline__ void qk_tile(f32x16& p0, f32x16& p1, LAS const unsigned char* kimg, const bf16x8 (&qf)[8], int lane) {
    const unsigned r32 = lane & 31, hi = lane >> 5;
    f32x16 z;
#pragma unroll
    for (int r = 0; r < 16; ++r) z[r] = 0.f;
    p0 = z; p1 = z;
    bf16x8 fa[2][4];
#define QK_LOAD(g, buf) { const unsigned o0_ = off_b(r32, 4 * (g) + hi), o1_ = off_b(r32, 4 * (g) + 2 + hi); \
        fa[buf][0] = *(LAS const bf16x8*)(kimg + o0_); fa[buf][1] = *(LAS const bf16x8*)(kimg + o0_ + 32 * 256); fa[buf][2] = *(LAS const bf16x8*)(kimg + o1_); fa[buf][3] = *(LAS const bf16x8*)(kimg + o1_ + 32 * 256); }
#define QK_MMA(g, buf) { p0 = MFMA32(fa[buf][0], qf[2 * (g)], p0); p1 = MFMA32(fa[buf][1], qf[2 * (g)], p1); p0 = MFMA32(fa[buf][2], qf[2 * (g) + 1], p0); p1 = MFMA32(fa[buf][3], qf[2 * (g) + 1], p1); }
    QK_LOAD(0, 0) QK_LOAD(1, 1) QK_MMA(0, 0) asm volatile("" ::: "memory");
    QK_LOAD(2, 0) QK_MMA(1, 1) asm volatile("" ::: "memory");
    QK_LOAD(3, 1) QK_MMA(2, 0) QK_MMA(3, 1)
#undef QK_LOAD
#undef QK_MMA
}
__device__ __forceinline__ s16x4 vtr(LAS const unsigned char* p) { return __builtin_bit_cast(s16x4, __builtin_amdgcn_ds_read_tr16_b64_v4i16((LAS v4i16_t*)p)); }
__device__ __forceinline__ void pv_tile(f32x16 (&o)[4], LAS const unsigned char* vimg, const bf16x8 (&pf)[4], int lane) {
    const unsigned hi = lane >> 5, blk = (lane >> 4) & 1, q = (lane & 15) >> 2, p = lane & 3;
    s16x4 fl[2][4], fh[2][4];
#define PV_LOAD(c, buf) { _Pragma("unroll") for (int ks = 0; ks < 4; ++ks) { const unsigned ch = 4 * (c) + 2 * blk + (p >> 1), rlo = 16 * ks + 4 * hi + q; \
        fl[buf][ks] = vtr(vimg + off_b(rlo, ch) + 8 * (p & 1)); fh[buf][ks] = vtr(vimg + off_b(rlo + 8, ch) + 8 * (p & 1)); } }
#define PV_MMA(c, buf) { _Pragma("unroll") for (int ks = 0; ks < 4; ++ks) { const bf16x8 af = {fl[buf][ks][0], fl[buf][ks][1], fl[buf][ks][2], fl[buf][ks][3], fh[buf][ks][0], fh[buf][ks][1], fh[buf][ks][2], fh[buf][ks][3]}; \
        o[c] = MFMA32(af, pf[ks], o[c]); } }
    PV_LOAD(0, 0) PV_LOAD(1, 1) PV_MMA(0, 0) asm volatile("" ::: "memory");
    PV_LOAD(2, 0) PV_MMA(1, 1) asm volatile("" ::: "memory");
    PV_LOAD(3, 1) PV_MMA(2, 0) PV_MMA(3, 1)
#undef PV_LOAD
#undef PV_MMA
}
template <bool FIXED> __device__ __forceinline__ void softmax_step(f32x16& p0, f32x16& p1, float& m, float& l, f32x16 (&o)[4], bf16x8 (&pf)[4]) {
    if constexpr (FIXED) {
        f32x2_t s2 = {0.f, 0.f};
#pragma unroll
        for (int r = 0; r < 16; ++r) { p0[r] = __builtin_amdgcn_exp2f(p0[r]); p1[r] = __builtin_amdgcn_exp2f(p1[r]); const f32x2_t t = {p0[r], p1[r]}; s2 += t; }
        l += s2[0] + s2[1];
    } else {
        float mx = fmaxf(p0[0], p1[0]);
#pragma unroll
        for (int r = 1; r < 16; ++r) mx = fmaxf(mx, fmaxf(p0[r], p1[r]));
        mx = xh_max(mx);
        const float mnew = fmaxf(m, mx), muse = (mnew == -INFINITY) ? 0.f : mnew;
        const float alpha = __builtin_amdgcn_exp2f(m - muse);
        float s = 0.f;
#pragma unroll
        for (int r = 0; r < 16; ++r) { p0[r] = __builtin_amdgcn_exp2f(p0[r] - muse); p1[r] = __builtin_amdgcn_exp2f(p1[r] - muse); s += p0[r] + p1[r]; }
        l = l * alpha + s; m = mnew;
        if (__any(alpha != 1.f)) {
#pragma unroll
            for (int c = 0; c < 4; ++c)
#pragma unroll
                for (int r = 0; r < 16; ++r) o[c][r] *= alpha;
        }
    }
    pf[0] = pack_step(p0, 0); pf[1] = pack_step(p0, 1); pf[2] = pack_step(p1, 0); pf[3] = pack_step(p1, 1);
}
__device__ __forceinline__ void tile_load(v4u (&rg)[2], const bf16* src, int pitch, int tid) {
#pragma unroll
    for (int i = 0; i < 2; ++i) { const int id = tid + 512 * i, row = id >> 4, ch = id & 15; rg[i] = *(const GAS v4u*)(src + (size_t)row * pitch + ch * 8); }
}
__device__ __forceinline__ void tile_store(const v4u (&rg)[2], LAS unsigned char* img, int tid) {
#pragma unroll
    for (int i = 0; i < 2; ++i) { const int id = tid + 512 * i, row = id >> 4, ch = id & 15; *(LAS v4u*)(img + off_b(row, ch)) = rg[i]; }
}

__device__ __forceinline__ void cross_item(const Args& a, LAS unsigned char* lds, int tid, int lane, int wave, int item) {
    const int r32 = lane & 31, hi = lane >> 5;
    const int b = item >> 5, hx = (item >> 3) & 3, qblk = item & 7;
    const bf16* QX = (const bf16*)(a.ws + WS_QX); const bf16* KX = (const bf16*)(a.ws + WS_KX) + (size_t)b * 256 * 512 + hx * 128; const bf16* VX = (const bf16*)(a.ws + WS_VX) + (size_t)b * 256 * 512 + hx * 128;
    bf16* OX = (bf16*)(a.ws + WS_OX);
    const size_t row = (size_t)b * 2048 + qblk * 256 + wave * 32 + r32;
    bf16x8 qf[8];
#pragma unroll
    for (int s = 0; s < 8; ++s) qf[s] = *(const GAS bf16x8*)(QX + row * 512 + hx * 128 + 16 * s + 8 * hi);
    f32x16 o[4];
#pragma unroll
    for (int c = 0; c < 4; ++c)
#pragma unroll
        for (int r = 0; r < 16; ++r) o[c][r] = 0.f;
    float m = -INFINITY, l = 0.f;
    v4u kr[2], vr[2];
    tile_load(kr, KX, 512, tid); tile_load(vr, VX, 512, tid);
    tile_store(kr, lds, tid); tile_store(vr, lds + 32768, tid);
    __syncthreads();
#pragma unroll 1
    for (int kt = 0; kt < 4; ++kt) {
        LAS unsigned char* kimg = lds + (kt & 1) * 16384; LAS unsigned char* vimg = lds + 32768 + (kt & 1) * 16384;
        if (kt + 1 < 4) { tile_load(kr, KX + (size_t)(kt + 1) * 64 * 512, 512, tid); tile_load(vr, VX + (size_t)(kt + 1) * 64 * 512, 512, tid); }
        f32x16 p0, p1; qk_tile(p0, p1, kimg, qf, lane);
#pragma unroll
        for (int r = 0; r < 16; ++r) { p0[r] *= SCALE2; p1[r] *= SCALE2; }
        bf16x8 pf[4]; softmax_step<false>(p0, p1, m, l, o, pf);
        pv_tile(o, vimg, pf, lane);
        if (kt + 1 < 4) { tile_store(kr, lds + ((kt + 1) & 1) * 16384, tid); tile_store(vr, lds + 32768 + ((kt + 1) & 1) * 16384, tid); }
        __syncthreads();
    }
    l = xh_sum(l);
    const float inv = 1.f / l;
#pragma unroll
    for (int c = 0; c < 4; ++c)
#pragma unroll
        for (int g4 = 0; g4 < 4; ++g4) { u32x2 w; w.x = cvtpk(o[c][4 * g4] * inv, o[c][4 * g4 + 1] * inv); w.y = cvtpk(o[c][4 * g4 + 2] * inv, o[c][4 * g4 + 3] * inv);
            *(GAS u32x2*)(OX + row * 512 + hx * 128 + 32 * c + 8 * g4 + 4 * hi) = w; }
}
__device__ __forceinline__ void cross_phase(const Args& a, LAS unsigned char* lds, int tid, int lane, int wave, int bx, int G) {
    if (bx < 128) return;
#pragma unroll 1
    for (int i = 0; i < 2; ++i) cross_item(a, lds, tid, lane, wave, (bx - 128) * 2 + i);
}

constexpr int DSA_QI = 0, DSA_QPITCH = 1040, DSA_KTB = 33792, DSA_CT = DSA_KTB, DSA_MASK = DSA_KTB + 2 * 32 * 257 * 4, DSA_BT = DSA_MASK + 32 * 65 * 4, DSA_END = DSA_BT + 8 * 320 * 4;
static_assert(DSA_END <= RING_BYTES, "DSA LDS map");
__device__ __forceinline__ unsigned f2key(float x) { const unsigned b = __float_as_uint(x + 0.f); return (b & 0x80000000u) ? ~b : (b | 0x80000000u); }

__device__ __forceinline__ void cnt_ge(unsigned& cnt, unsigned key, unsigned cand) { asm volatile("v_cmp_ge_u32 vcc, %1, %2\n\tv_addc_co_u32_e32 %0, vcc, 0, %0, vcc" : "+v"(cnt) : "v"(key), "v"(cand) : "vcc"); }
__device__ __forceinline__ void cnt_gt(unsigned& cnt, unsigned key, unsigned cand) { asm volatile("v_cmp_gt_u32 vcc, %1, %2\n\tv_addc_co_u32_e32 %0, vcc, 0, %0, vcc" : "+v"(cnt) : "v"(key), "v"(cand) : "vcc"); }
__device__ __forceinline__ void cnt_eq(unsigned& cnt, unsigned key, unsigned cand) { asm volatile("v_cmp_eq_u32 vcc, %1, %2\n\tv_addc_co_u32_e32 %0, vcc, 0, %0, vcc" : "+v"(cnt) : "v"(key), "v"(cand) : "vcc"); }
__device__ __forceinline__ void cnt4_ge(unsigned& c0, unsigned& c1, unsigned& c2, unsigned& c3, unsigned k0, unsigned k1, unsigned k2, unsigned k3, unsigned cand) {
    unsigned long long m0, m1, m2;
    asm volatile("v_cmp_ge_u32 %4, %7, %11\n\tv_cmp_ge_u32 %5, %8, %11\n\tv_cmp_ge_u32 %6, %9, %11\n\tv_cmp_ge_u32 vcc, %10, %11\n\t"
                 "v_addc_co_u32_e64 %0, %4, 0, %0, %4\n\tv_addc_co_u32_e64 %1, %5, 0, %1, %5\n\tv_addc_co_u32_e64 %2, %6, 0, %2, %6\n\tv_addc_co_u32_e32 %3, vcc, 0, %3, vcc"
                 : "+v"(c0), "+v"(c1), "+v"(c2), "+v"(c3), "=&s"(m0), "=&s"(m1), "=&s"(m2) : "v"(k0), "v"(k1), "v"(k2), "v"(k3), "v"(cand) : "vcc");
}
template <int IB> __device__ __forceinline__ void cnt_tie_lt(unsigned& cnt, unsigned key, unsigned thr, unsigned lanepart, unsigned cand) { unsigned t;
    asm volatile("v_add_u32_e32 %1, %6, %4\n\tv_cmp_eq_u32 vcc, %2, %3\n\tv_cndmask_b32_e32 %1, -1, %1, vcc\n\tv_cmp_lt_u32 vcc, %1, %5\n\tv_addc_co_u32_e32 %0, vcc, 0, %0, vcc"
                 : "+v"(cnt), "=&v"(t) : "v"(key), "v"(thr), "v"(lanepart), "v"(cand), "i"(IB) : "vcc"); }
template <int IB, int BR> __device__ __forceinline__ void mask_sel(unsigned& w, unsigned key, unsigned thr, unsigned lanepart, unsigned istar, unsigned onehi) { unsigned t, bit;
    asm volatile("v_lshlrev_b32_e32 %2, %8, %7\n\tv_cmp_gt_u32 vcc, %3, %4\n\tv_cndmask_b32_e32 %1, 0, %2, vcc\n\tv_or_b32_e32 %0, %0, %1\n\t"
                 "v_add_u32_e32 %1, %9, %5\n\tv_cmp_le_u32 vcc, %1, %6\n\tv_cndmask_b32_e32 %1, 0, %2, vcc\n\tv_cmp_eq_u32 vcc, %3, %4\n\tv_cndmask_b32_e32 %1, 0, %1, vcc\n\tv_or_b32_e32 %0, %0, %1"
                 : "+v"(w), "=&v"(t), "=&v"(bit) : "v"(key), "v"(thr), "v"(lanepart), "v"(istar), "v"(onehi), "i"(BR), "i"(IB) : "vcc"); }

#define CRB(r) (((r) & 3) + 8 * ((r) >> 2))
#define TIE1(i, r) cnt_tie_lt<256 * (i) + CRB(r)>(cnt, key[i][r], thr, lanepart, cand);
#define TIE_ROW(i) TIE1(i,0) TIE1(i,1) TIE1(i,2) TIE1(i,3) TIE1(i,4) TIE1(i,5) TIE1(i,6) TIE1(i,7) TIE1(i,8) TIE1(i,9) TIE1(i,10) TIE1(i,11) TIE1(i,12) TIE1(i,13) TIE1(i,14) TIE1(i,15)
#define SEL1(i, r) mask_sel<256 * (i) + CRB(r), CRB(r)>(w, key[i][r], thr, lanepart, istar, onehi);
#define SEL_ROW(i) SEL1(i,0) SEL1(i,1) SEL1(i,2) SEL1(i,3) SEL1(i,4) SEL1(i,5) SEL1(i,6) SEL1(i,7) SEL1(i,8) SEL1(i,9) SEL1(i,10) SEL1(i,11) SEL1(i,12) SEL1(i,13) SEL1(i,14) SEL1(i,15)
__device__ __forceinline__ unsigned row_total(unsigned cnt, LAS unsigned* CNT, int& par, int r32, int hi, int wave) {
    cnt = xh_sumu(cnt);
    if (hi == 0) CNT[par * 256 + r32 * 8 + wave] = cnt;
    __syncthreads();
    const v4u x = *(LAS const v4u*)(CNT + par * 256 + r32 * 8), y = *(LAS const v4u*)(CNT + par * 256 + r32 * 8 + 4);
    par ^= 1;
    return (x.x + x.y) + (x.z + x.w) + (y.x + y.y) + (y.z + y.w);
}
template <bool FIXED> __device__ __forceinline__ void dsa_attn(const Args& a, LAS unsigned char* lds, int tid, int lane, int wave, int b, int qb, bool sel) {
    const int r32 = lane & 31, hi = lane >> 5;
    const int t0 = qb * 32; const size_t rowb = (size_t)b * 2048;
    const bf16* QD = (const bf16*)(a.ws + WS_QD); const bf16* CKV = (const bf16*)(a.ws + WS_CKV) + rowb * 128;
    const float* BL = (const float*)(a.ws + WS_BIASL); const bf16* WUV = (const bf16*)(a.ws + WS_WUV); bf16* ODSA = (bf16*)(a.ws + WS_ODSA);
    LAS unsigned* MASK = (LAS unsigned*)(lds + DSA_MASK);
    const int h = wave; const int tq = t0 + r32; const size_t qrow = rowb + t0 + r32;
    bf16x8 qf[8];
#pragma unroll
    for (int s = 0; s < 8; ++s) qf[s] = *(const GAS bf16x8*)(QD + qrow * 1024 + h * 128 + 16 * s + 8 * hi);
    const float c31 = BL[1024 + h] - BL[1032];
    f32x16 o[4];
#pragma unroll
    for (int c = 0; c < 4; ++c)
#pragma unroll
        for (int r = 0; r < 16; ++r) o[c][r] = 0.f;
    float m = -INFINITY, l = 0.f;
    const int NKT = (t0 + 32 + 63) >> 6;
    TP_DECL
#define DMA_TILE(kt_) { _Pragma("unroll") for (int i_ = 0; i_ < 2; ++i_) { const int rb_ = i_ * 8 + wave, row_ = 4 * rb_ + (lane >> 4), ch_ = (lane & 15) ^ (((row_ & 3) << 2) | ((row_ >> 2) & 3)); \
        __builtin_amdgcn_global_load_lds((const unsigned*)(CKV + (size_t)(64 * (kt_) + row_) * 128 + ch_ * 8), (LAS unsigned*)(lds + DSA_CT + ((kt_) & 3) * 16384 + rb_ * 1024), 16, 0, 0); } }
    DMA_TILE(0) if (NKT > 1) DMA_TILE(1)
    __syncthreads();
#pragma unroll 1
    for (int kp = 0; kp < NKT; kp += 2) {
      if (kp + 2 < NKT) DMA_TILE(kp + 2) if (kp + 3 < NKT) DMA_TILE(kp + 3)
#pragma unroll 1
      for (int kt = kp; kt < kp + 2 && kt < NKT; ++kt) {
        LAS unsigned char* cimg = lds + DSA_CT + (kt & 3) * 16384;
        TP_STAMP(0)
        f32x16 p0, p1; qk_tile(p0, p1, cimg, qf, lane);
        TP_STAMP(1)
        const int k0 = 64 * kt;
        const bool far = (t0 - k0 - 63) >= 128;
        unsigned mv0, mv1;
        if (sel) { mv0 = MASK[r32 * 65 + 2 * kt] >> (4 * hi); mv1 = MASK[r32 * 65 + 2 * kt + 1] >> (4 * hi); }
        else { const int d0 = tq - k0 - 4 * hi, d1 = d0 - 32;
            mv0 = d0 < 0 ? 0u : (d0 >= 31 ? 0x0f0f0f0fu : (0x0f0f0f0fu & ((2u << d0) - 1u)));
            mv1 = d1 < 0 ? 0u : (d1 >= 31 ? 0x0f0f0f0fu : (0x0f0f0f0fu & ((2u << d1) - 1u))); }
        if (far) {
#pragma unroll
            for (int r = 0; r < 16; ++r) { p0[r] = ((mv0 >> CRB(r)) & 1u) ? p0[r] * SCALE2 + c31 : -INFINITY; p1[r] = ((mv1 >> CRB(r)) & 1u) ? p1[r] * SCALE2 + c31 : -INFINITY; }
        } else {
            LAS const float* bt = (LAS const float*)(lds + DSA_BT + h * 1280 + (255 - (tq - k0 - 4 * hi)) * 4);
            if constexpr (FIXED) {
#define NEAR8(P, MV, OFF, R0) { float bb[8]; \
              _Pragma("unroll") for (int r = 0; r < 8; ++r) bb[r] = bt[(OFF) + CRB((R0) + r)]; \
              asm volatile("" ::: "memory"); \
              _Pragma("unroll") for (int r = 0; r < 8; ++r) { const float v_ = P[(R0) + r] * SCALE2 + bb[r]; P[(R0) + r] = (((MV) >> CRB((R0) + r)) & 1u) ? v_ : -INFINITY; } }
            NEAR8(p0, mv0, 0, 0) NEAR8(p0, mv0, 0, 8) NEAR8(p1, mv1, 32, 0) NEAR8(p1, mv1, 32, 8)
#undef NEAR8
            } else {
                const LAS float* btf = bt;
#pragma unroll
                for (int r = 0; r < 16; ++r) { const float b0 = btf[CRB(r)], b1 = btf[32 + CRB(r)];
                    p0[r] = ((mv0 >> CRB(r)) & 1u) ? p0[r] * SCALE2 + b0 : -INFINITY; p1[r] = ((mv1 >> CRB(r)) & 1u) ? p1[r] * SCALE2 + b1 : -INFINITY; }
            }
        }
        bf16x8 pf[4];
        softmax_step<FIXED>(p0, p1, m, l, o, pf);
        TP_STAMP(2)
        pv_tile(o, cimg, pf, lane);
        TP_STAMP(3)
        TP_STAMP(4)
      }
      __syncthreads();
    }
#undef DMA_TILE
    l = xh_sum(l);
    const float inv = 1.f / l;
    bf16x8 of[8];
#pragma unroll
    for (int c = 0; c < 4; ++c) {
#pragma unroll
        for (int r = 0; r < 16; ++r) o[c][r] *= inv;
        of[2 * c] = pack_step(o[c], 0); of[2 * c + 1] = pack_step(o[c], 1);
    }
    { s16x4 wl[2][8], wh[2][8];
#pragma unroll
      for (int eb = 0; eb < 2; ++eb) { const bf16* wf = WUV + (size_t)((h * 2 + eb) * 8) * 512 + lane * 4;
#pragma unroll
        for (int cs = 0; cs < 8; ++cs) { wl[eb][cs] = *(const GAS s16x4*)(wf + cs * 512); wh[eb][cs] = *(const GAS s16x4*)(wf + cs * 512 + 256); } }
      asm volatile("" ::: "memory");
#pragma unroll
      for (int eb = 0; eb < 2; ++eb) {
        f32x16 acc;
#pragma unroll
        for (int r = 0; r < 16; ++r) acc[r] = 0.f;
#pragma unroll
        for (int cs = 0; cs < 8; ++cs) {
            const bf16x8 af = {wl[eb][cs][0], wl[eb][cs][1], wl[eb][cs][2], wl[eb][cs][3], wh[eb][cs][0], wh[eb][cs][1], wh[eb][cs][2], wh[eb][cs][3]};
            acc = MFMA32(af, of[cs], acc);
        }
#pragma unroll
        for (int g4 = 0; g4 < 4; ++g4) { u32x2 w; w.x = cvtpk(acc[4 * g4], acc[4 * g4 + 1]); w.y = cvtpk(acc[4 * g4 + 2], acc[4 * g4 + 3]);
            *(GAS u32x2*)(ODSA + qrow * 512 + h * 64 + 32 * eb + 8 * g4 + 4 * hi) = w; }
      } }
    TP_STAMP(5)
    TP_FLUSH(0)
}
template <int MODE> __device__ __forceinline__ void dsa_item(const Args& a, LAS unsigned char* lds, int tid, int lane, int wave, int b, int qb) {
    const int r32 = lane & 31, hi = lane >> 5;
    const int t0 = qb * 32; const size_t rowb = (size_t)b * 2048;
    const bool sel = qb >= 8;
    const bf16* QD = (const bf16*)(a.ws + WS_QD); const bf16* CKV = (const bf16*)(a.ws + WS_CKV) + rowb * 128; const bf16* QI = (const bf16*)(a.ws + WS_QI); const bf16* KI = (const bf16*)(a.ws + WS_KI) + rowb * 64;
    const float* WI = (const float*)(a.ws + WS_WI); const float* BL = (const float*)(a.ws + WS_BIASL); const bf16* WUV = (const bf16*)(a.ws + WS_WUV); bf16* ODSA = (bf16*)(a.ws + WS_ODSA);
    LAS unsigned* MASK = (LAS unsigned*)(lds + DSA_MASK);
    const int NT = qb + 1;
    TQ_DECL
    if (MODE != 1 && sel) {
#pragma unroll
        for (int i = 0; i < 4; ++i) { const int id = tid + 512 * i, row = id >> 6, ch = id & 63;
            *(LAS v4u*)(lds + DSA_QI + row * DSA_QPITCH + ch * 16) = *(const GAS v4u*)(QI + (rowb + t0 + row) * 512 + ch * 8); }
        __syncthreads();
        float wq[8];
        { const f32x4 w0 = *(const GAS f32x4*)(WI + (rowb + t0 + r32) * 8), w1 = *(const GAS f32x4*)(WI + (rowb + t0 + r32) * 8 + 4);
          wq[0] = w0.x; wq[1] = w0.y; wq[2] = w0.z; wq[3] = w0.w; wq[4] = w1.x; wq[5] = w1.y; wq[6] = w1.z; wq[7] = w1.w; }
        unsigned kw[4][32];
        LAS unsigned* KTB = (LAS unsigned*)(lds + DSA_KTB);
        LAS const unsigned char* qbase = lds + DSA_QI + r32 * DSA_QPITCH + hi * 16;
        const bf16* kbase = KI + (size_t)r32 * 64 + 8 * hi;
        bf16x8 kf[4]; const bf16* kptr = kbase + (size_t)wave * 2048;
        if (wave < NT) {
#pragma unroll
            for (int kk = 0; kk < 4; ++kk) kf[kk] = *(const GAS bf16x8*)(kptr + 16 * kk);
        }
        kptr += 8 * 2048;
#define SC_HEAD(hh, dst) { _Pragma("unroll") for (int r = 0; r < 16; ++r) dst[r] = 0.f; \
            _Pragma("unroll") for (int kk = 0; kk < 4; ++kk) { const bf16x8 qf = *(LAS const bf16x8*)(qbase + ((hh) * 8 + 2 * kk) * 16); dst = MFMA32(kf[kk], qf, dst); } }
#define SC_ACC(hh, src) { const f32x2_t w2_ = {wq[hh], wq[hh]}; \
            _Pragma("unroll") for (int r = 0; r < 16; r += 2) { const f32x2_t t_ = {__builtin_amdgcn_fmed3f(src[r], 0.f, INFINITY), __builtin_amdgcn_fmed3f(src[r + 1], 0.f, INFINITY)}; \
                f32x2_t s_ = {sacc[r], sacc[r + 1]}; s_ = __builtin_elementwise_fma(t_, w2_, s_); sacc[r] = s_[0]; sacc[r + 1] = s_[1]; } \
            _Pragma("unroll") for (int r = 0; r < 16; ++r) asm volatile("" : "+v"(sacc[r])); }
#define SC_TILE(i) { const int j = wave + 8 * (i); \
            if (8 * (i) < NT) {                                            \
                LAS unsigned* kt_ = KTB + ((i) & 1) * (32 * 257); \
                if (j < NT) { \
                    f32x16 sacc, da, db; \
                    _Pragma("unroll") for (int r = 0; r < 16; ++r) sacc[r] = 0.f; \
                    SC_HEAD(0, da) SC_HEAD(1, db) SC_ACC(0, da) SC_HEAD(2, da) SC_ACC(1, db) SC_HEAD(3, db) SC_ACC(2, da) SC_HEAD(4, da) SC_ACC(3, db) \
                    SC_HEAD(5, db) SC_ACC(4, da) SC_HEAD(6, da) SC_ACC(5, db) SC_HEAD(7, db) \
                    asm volatile("" ::: "memory"); \
                    if (j + 8 < NT) { _Pragma("unroll") for (int kk = 0; kk < 4; ++kk) kf[kk] = *(const GAS bf16x8*)(kptr + 16 * kk); kptr += 8 * 2048; }     \
                    SC_ACC(6, da) SC_ACC(7, db) \
                    _Pragma("unroll") for (int r = 0; r < 16; ++r) { const bool vis = (j < NT - 1) || (crow(r, hi) <= r32); kt_[r32 * 257 + 32 * wave + crow(r, hi)] = vis ? f2key(sacc[r]) : 0u; } \
                } else { _Pragma("unroll") for (int r = 0; r < 16; ++r) kt_[r32 * 257 + 32 * wave + crow(r, hi)] = 0u; } \
                __syncthreads(); \
                _Pragma("unroll") for (int rho = 0; rho < 4; ++rho) _Pragma("unroll") for (int k = 0; k < 4; ++k) kw[rho][4 * (i) + k] = kt_[(4 * wave + rho) * 257 + 64 * k + lane]; \
            } else { _Pragma("unroll") for (int rho = 0; rho < 4; ++rho) _Pragma("unroll") for (int k = 0; k < 4; ++k) kw[rho][4 * (i) + k] = 0u; } }
        SC_TILE(0) SC_TILE(1) SC_TILE(2) SC_TILE(3) SC_TILE(4) SC_TILE(5) SC_TILE(6) SC_TILE(7)
#undef SC_TILE
#undef SC_ACC
#undef SC_HEAD
        TQ_STAMP(0)
        unsigned thr[4] = {0u, 0u, 0u, 0u}; bool fnd[4] = {false, false, false, false};
        if constexpr (MODE != 3) {
#pragma unroll 1
            for (int bit = 31; bit >= 0; --bit) {
#pragma unroll
                for (int rho = 0; rho < 4; ++rho) if (!fnd[rho]) {
                    const unsigned cand = (unsigned)__builtin_amdgcn_readfirstlane((int)(thr[rho] | (1u << bit))); unsigned cnt = 0u;
#pragma unroll
                    for (int e = 0; e < 32; e += 4) if (2 * e < NT) {
                        unsigned long long b0, b1, b2, b3;
                        asm volatile("v_cmp_ge_u32_e64 %0, %4, %8\n\tv_cmp_ge_u32_e64 %1, %5, %8\n\tv_cmp_ge_u32_e64 %2, %6, %8\n\tv_cmp_ge_u32_e64 %3, %7, %8"
                                     : "=&s"(b0), "=&s"(b1), "=&s"(b2), "=&s"(b3) : "v"(kw[rho][e]), "v"(kw[rho][e + 1]), "v"(kw[rho][e + 2]), "v"(kw[rho][e + 3]), "s"(cand));
                        cnt += (unsigned)(__builtin_popcountll(b0) + __builtin_popcountll(b1)) + (unsigned)(__builtin_popcountll(b2) + __builtin_popcountll(b3));
                    }
                    if (cnt >= 256u) thr[rho] = cand;
                    fnd[rho] = cnt == 256u;
                }
                if (fnd[0] && fnd[1] && fnd[2] && fnd[3]) break;
            }
        }
#pragma unroll
        for (int rho = 0; rho < 4; ++rho) {
            const unsigned th = (unsigned)__builtin_amdgcn_readfirstlane((int)thr[rho]); unsigned gtot = 0u;
#pragma unroll
            for (int e = 0; e < 32; e += 4) if (2 * e < NT) { unsigned long long b0, b1, b2, b3;
                asm volatile("v_cmp_gt_u32_e64 %0, %4, %8\n\tv_cmp_gt_u32_e64 %1, %5, %8\n\tv_cmp_gt_u32_e64 %2, %6, %8\n\tv_cmp_gt_u32_e64 %3, %7, %8"
                             : "=&s"(b0), "=&s"(b1), "=&s"(b2), "=&s"(b3) : "v"(kw[rho][e]), "v"(kw[rho][e + 1]), "v"(kw[rho][e + 2]), "v"(kw[rho][e + 3]), "s"(th));
                gtot += (unsigned)(__builtin_popcountll(b0) + __builtin_popcountll(b1)) + (unsigned)(__builtin_popcountll(b2) + __builtin_popcountll(b3)); }
            unsigned rem = 256u - gtot;
            unsigned wlo = 0u, whi = 0u;
#define WLANE(dst, val, ln) asm volatile("v_writelane_b32 %0, %1, %2" : "+v"(dst) : "s"(val), "i"(ln));
#define MB_STEP(e) if (2 * ((e) & ~3) < NT) { unsigned long long g0, g1, q0, q1; \
                asm volatile("v_cmp_gt_u32_e64 %0, %4, %6\n\tv_cmp_gt_u32_e64 %1, %5, %6\n\tv_cmp_eq_u32_e64 %2, %4, %6\n\tv_cmp_eq_u32_e64 %3, %5, %6" \
                             : "=&s"(g0), "=&s"(g1), "=&s"(q0), "=&s"(q1) : "v"(kw[rho][e]), "v"(kw[rho][(e) + 1]), "s"(th)); \
                unsigned c = (unsigned)__builtin_popcountll(q0); \
                if (c > rem) { while ((unsigned)__builtin_popcountll(q0) > rem) q0 &= ~(1ull << (63 - __builtin_clzll(q0))); c = rem; }     \
                rem -= c; \
                c = (unsigned)__builtin_popcountll(q1); \
                if (c > rem) { while ((unsigned)__builtin_popcountll(q1) > rem) q1 &= ~(1ull << (63 - __builtin_clzll(q1))); c = rem; } \
                rem -= c; \
                const unsigned long long s0 = g0 | q0, s1 = g1 | q1; \
                WLANE(wlo, (unsigned)s0, e) WLANE(whi, (unsigned)(s0 >> 32), e) WLANE(wlo, (unsigned)s1, (e) + 1) WLANE(whi, (unsigned)(s1 >> 32), (e) + 1) }
            MB_STEP(0) MB_STEP(2) MB_STEP(4) MB_STEP(6) MB_STEP(8) MB_STEP(10) MB_STEP(12) MB_STEP(14) MB_STEP(16) MB_STEP(18) MB_STEP(20) MB_STEP(22) MB_STEP(24) MB_STEP(26) MB_STEP(28) MB_STEP(30)
#undef MB_STEP
            if (lane < 32) { const int j = 8 * (lane >> 2) + 2 * (lane & 3); MASK[(4 * wave + rho) * 65 + j] = wlo; MASK[(4 * wave + rho) * 65 + j + 1] = whi; }
#undef WLANE
        }
        __syncthreads();
        TQ_STAMP(1)
    }
    if constexpr (MODE == 0 || MODE == 1) {
        const float Mb = ((const float*)(a.ws + WS_BIASL))[1032];
        if (Mb != 0.f) dsa_attn<true>(a, lds, tid, lane, wave, b, qb, sel); else dsa_attn<false>(a, lds, tid, lane, wave, b, qb, sel);
    }
    TQ_STAMP(2)
    TQ_FLUSH
    __syncthreads();
}
template <int MODE = 0> __device__ __forceinline__ void dsa_phase(const Args& a, LAS unsigned char* lds, int wave, int bx, int G) {
    const int b = bx >> 5, p = bx & 31;
    { const float* BL = (const float*)(a.ws + WS_BIASL); LAS float* BT = (LAS float*)(lds + DSA_BT);
      for (int i = wave * 64 + my_lane_id(); i < 8 * 320; i += NTHR) { const int hh = i / 320, d = 255 - (i % 320); BT[i] = (d < 0 ? 0.f : (d < 128 ? BL[hh * 128 + d] : BL[1024 + hh])) - BL[1032]; } }
    __syncthreads();
#pragma unroll 1
    for (int it = 0; it < 2; ++it) {
        const int lane = my_lane_id();
        dsa_item<MODE>(a, lds, wave * 64 + lane, lane, wave, b, it == 0 ? 63 - p : p);
    }
}
}
#define HAVE_DSA 1
using att::cross_phase;
__device__ __forceinline__ void dsa_phase(const Args& a, LAS unsigned char* lds, int wave, int bx, int G) { att::dsa_phase<0>(a, lds, wave, bx, G); }
__global__ void __launch_bounds__(NTHR, 2) mk_fwd(Args args) {
    extern __shared__ __attribute__((aligned(16))) unsigned char lds_raw[];
    LAS unsigned char* lds = (LAS unsigned char*)lds_raw;
    volatile LAS unsigned* MISC = (volatile LAS unsigned*)(lds + MISC_OFF);
    const int wave = __builtin_amdgcn_readfirstlane(threadIdx.x >> 6);
#define MYLANE() my_lane_id()
    const int G = gridDim.x, bx = blockIdx.x, vcu = (G % 8 == 0) ? (bx % 8) * (G / 8) + bx / 8 : bx;
    unsigned char* ws = args.ws;
    gu32* ctl = (gu32*)(ws + WS_CTL);
    { const int tid = wave * 64 + MYLANE();
      for (int u = tid; u < (LDS_BYTES - LDSCTL_OFF) / 4; u += NTHR) ((LAS unsigned*)(lds + LDSCTL_OFF))[u] = 0u; }
    __syncthreads();
    const int lo = args.ph_lo, hi = args.ph_hi;
    const bool multi = (hi - lo) > 1;
    XcdBarrier bar; bar.bar = (unsigned*)(ctl + CW_BAR) + args.li * XCD_BAR_WORDS; bar.x = 0; bar.st = nullptr;
    if (multi) bar = xcd_barrier_post((unsigned*)(ctl + CW_BAR) + args.li * XCD_BAR_WORDS, MISC + 8, wave == 0 && MYLANE() == 0);
#define IN(k) (lo <= (k) && (k) < hi)
#define RPT(k) ((args.flags >> (16 + (k))) & 1)
#define L1_INV_SYNC() do { VM_WAIT(); __builtin_amdgcn_fence(__ATOMIC_ACQUIRE, "agent"); VM_WAIT(); __syncthreads(); } while (0)
#define SEAM(k) do { if (IN(k) && IN((k) + 1)) xcd_barrier(bar, wave == 0 && MYLANE() == 0); } while (0)
#define PHASE_PTRS unsigned char* wsk = args.ws; asm volatile("" : "+s"(wsk)); \
    bf16 *WIN = (bf16*)(wsk + WS_WIN), *WMKV = (bf16*)(wsk + WS_WMKV), *WGLU = (bf16*)(wsk + WS_WGLU), *WBR = (bf16*)(wsk + WS_WBR), *WOUT = (bf16*)(wsk + WS_WOUT), *WGU = (bf16*)(wsk + WS_WGU), *WD = (bf16*)(wsk + WS_WD); \
    float *RS = (float*)(wsk + WS_RS), *WI = (float*)(wsk + WS_WI), *SLOC = (float*)(wsk + WS_SLOC); \
    bf16 *KX = (bf16*)(wsk + WS_KX), *VX = (bf16*)(wsk + WS_VX), *MEMN = (bf16*)(wsk + WS_MEMN), *H = (bf16*)(wsk + WS_H), *QD = (bf16*)(wsk + WS_QD), *CKV = (bf16*)(wsk + WS_CKV), *QI = (bf16*)(wsk + WS_QI), *KI = (bf16*)(wsk + WS_KI), \
         *QX = (bf16*)(wsk + WS_QX), *U = (bf16*)(wsk + WS_U), *ODSA = (bf16*)(wsk + WS_ODSA), *OX = (bf16*)(wsk + WS_OX), *Y = (bf16*)(wsk + WS_Y), *OS5 = (bf16*)args.out, *G3 = (bf16*)(wsk + WS_G3), *MG = (bf16*)(wsk + WS_MERGED), \
         *ACT = (bf16*)(wsk + WS_ACT), *XN = (bf16*)(wsk + WS_XN), *S5TV = (bf16*)(wsk + WS_S5TV), *S5W = (bf16*)(wsk + WS_S5W); \
    (void)WIN; (void)WMKV; (void)WGLU; (void)WBR; (void)WOUT; (void)WGU; (void)WD; (void)RS; (void)WI; (void)SLOC; (void)KX; (void)VX; (void)MEMN; (void)H; (void)QD; (void)CKV; (void)QI; (void)KI; (void)QX; (void)U; (void)ODSA; (void)OX; (void)Y; (void)OS5; (void)G3; (void)MG; (void)ACT; (void)XN; (void)S5TV; (void)S5W;
    if (IN(0)) for (int rep_ = 0; rep_ <= RPT(0); ++rep_) { if (rep_) xcd_barrier(bar, wave == 0 && MYLANE() == 0); const int lane = MYLANE(), tid = wave * 64 + lane; p0_prologue(args, lds, tid, lane, wave, vcu, G); }
    SEAM(0);
    if (IN(1)) for (int rep_ = 0; rep_ <= RPT(1); ++rep_) { if (rep_) xcd_barrier(bar, wave == 0 && MYLANE() == 0);
        PHASE_PTRS
        { pg8::Gemm g{H, WIN, T_TOK, NIN, 1024, 1024, 1024}; pg8::StaticOrder S; S.init(T_TOK, NIN, G, bx);
          pg8::EpiInprojF E{QD, CKV, QI, KI, U, QX, WI, args.in[5], args.in[6], args.in[19], (LAS float*)(lds + XB_OFF)};
          pg8::gemm_phase<pg8::EpiInprojF, pg8::StaticOrder, true, true>(lds + RING_OFF, g, S, E, wave); }
        { pg8::Gemm g{MEMN, WMKV, 2048, 1024, 1024, 1024, 1024}; pg8::SubsetOrder S; S.init(2048, 1024, 64, bx - 192);
          pg8::EpiMemKVF E{KX, VX, args.in[20], (LAS float*)(lds + XB_OFF)};
          pg8::gemm_phase<pg8::EpiMemKVF, pg8::SubsetOrder, true, true>(lds + RING_OFF, g, S, E, wave); }
    }
    SEAM(1);
    if (IN(3)) for (int rep_ = 0; rep_ <= RPT(3); ++rep_) { if (rep_) xcd_barrier(bar, wave == 0 && MYLANE() == 0);
        PHASE_PTRS
#ifdef TPROBE
        const unsigned long long tp3_0 = __builtin_amdgcn_s_memtime();
#endif
        if (!(args.flags & FL_NO_S5)) {
            if (bx < 128) {
                { pg8::Gemm g{U, S5W, 32 * 512, 32 * 256, 512, 640, 512}; pg8::S5Order1 S{((bx >> 2) * 2) + ((bx >> 1) & 1)};
                  pg8::EpiSlocF E{SLOC};
                  pg8::gemm_phase<pg8::EpiSlocF, pg8::S5Order1, false, true>(lds + RING_OFF, g, S, E, wave); }
                VM_WAIT(); __syncthreads();
                s5_scan(bx >> 2, (bx >> 1) & 1, args, wave * 64 + MYLANE());
            }
            pg8::Gemm g{U, S5TV, 32 * 512, 32 * 512, 640, 640, 640}; pg8::S5Order2 S{bx};
            pg8::EpiS5YF E{U, args.in[15], Y};
            pg8::gemm_phase<pg8::EpiS5YF, pg8::S5Order2, false, true>(lds + RING_OFF, g, S, E, wave);
        }
#ifdef HAVE_ATTN
        if (!(args.flags & FL_NO_CROSS)) { const int lane = MYLANE(); cross_phase(args, lds, wave * 64 + lane, lane, wave, bx, G); }
#endif
#ifdef TPROBE
        const unsigned long long tp3_1 = __builtin_amdgcn_s_memtime();
#endif
#ifdef HAVE_DSA
        if (!(args.flags & FL_NO_DSA)) dsa_phase(args, lds, wave, bx, G);
#endif
#ifdef TPROBE
        if (bx == TPROBE_BLOCK && wave == 0 && MYLANE() == 0) { unsigned long long* TP = (unsigned long long*)(ws + WS_CTL + 65536); TP[12] = __builtin_amdgcn_s_memtime() - tp3_0; TP[13] = tp3_1 - tp3_0; }
#endif
    }
    SEAM(3);
    if (IN(4)) for (int rep_ = 0; rep_ <= RPT(4); ++rep_) { if (rep_) xcd_barrier(bar, wave == 0 && MYLANE() == 0);
        PHASE_PTRS
        { pg8::Gemm g{Y, WGLU, T_TOK, 512, 512, 512, 512}; pg8::SubsetOrder S; S.init(T_TOK, 512, 128, bx < 128 ? bx : -1);
          pg8::EpiGluF E{Y, OS5};
          pg8::gemm_phase<pg8::EpiGluF, pg8::SubsetOrder, false, true>(lds + RING_OFF, g, S, E, wave); }
        { pg8::Gemm g{H, WIN + (size_t)NIN * 1024, T_TOK, 3072, 1024, 1024, 1024}; pg8::GateOrder S{bx};
          pg8::EpiSigmoidF E{G3, 3072};
          pg8::gemm_phase<pg8::EpiSigmoidF, pg8::GateOrder, true, true>(lds + RING_OFF, g, S, E, wave); }
    }
    SEAM(4);
    if (IN(5)) for (int rep_ = 0; rep_ <= RPT(5); ++rep_) { if (rep_) xcd_barrier(bar, wave == 0 && MYLANE() == 0);
        PHASE_PTRS
        pg8::Gemm g{ODSA, WBR, T_TOK, 1024, 512, 512, 512}; pg8::MergeOrder S; S.so.init(T_TOK, 1024, G, bx);
        S.aoff[0] = 0; S.aoff[1] = (long)((const char*)OS5 - (const char*)ODSA); S.aoff[2] = (long)((const char*)OX - (const char*)ODSA);
        pg8::EpiMergeF E{G3, MG};
        pg8::gemm_phase<pg8::EpiMergeF, pg8::MergeOrder, true, true>(lds + RING_OFF, g, S, E, wave);
    }
    SEAM(5);
    if (IN(6)) for (int rep_ = 0; rep_ <= RPT(6); ++rep_) { if (rep_) xcd_barrier(bar, wave == 0 && MYLANE() == 0);
        PHASE_PTRS
        pg8::Gemm g{MG, WOUT, T_TOK, 1024, 1024, 1024, 1024}; pg8::StaticOrder S; S.init(T_TOK, 1024, G, bx);
        pg8::EpiOutF E{args.in[0], args.out, XN, RS};
        pg8::gemm_phase<pg8::EpiOutF, pg8::StaticOrder, false, true>(lds + RING_OFF, g, S, E, wave);
    }
    SEAM(6);
    if (IN(7)) for (int rep_ = 0; rep_ <= RPT(7); ++rep_) { if (rep_) xcd_barrier(bar, wave == 0 && MYLANE() == 0);
        PHASE_PTRS
        pg8::Gemm g{XN, WGU, T_TOK, 5632, 1024, 1024, 1024}; pg8::StaticOrder S; S.init(T_TOK, 5632, G, bx);
        pg8::EpiGateUpF E{RS, ACT};
        pg8::gemm_phase<pg8::EpiGateUpF, pg8::StaticOrder, true, true>(lds + RING_OFF, g, S, E, wave);
    }
    SEAM(7);
    if (IN(8)) for (int rep_ = 0; rep_ <= RPT(8); ++rep_) { if (rep_) xcd_barrier(bar, wave == 0 && MYLANE() == 0);
        PHASE_PTRS
        pg8::Gemm g{ACT, WD, T_TOK, 1024, 2816, 2816, 2816}; pg8::StaticOrder S; S.init(T_TOK, 1024, G, bx);
        pg8::EpiDownF E{XN, args.out};
        pg8::gemm_phase<pg8::EpiDownF, pg8::StaticOrder, false, true>(lds + RING_OFF, g, S, E, wave);
    }
#ifdef TPROBE
    xcd_barrier(bar, wave == 0 && MYLANE() == 0);
    if (bx == 0 && wave == 0 && MYLANE() == 0) { const unsigned long long* TP = (const unsigned long long*)(ws + WS_CTL + 65536); unsigned long long tot = TP[12];
#if TPROBE < 8
        tot = 0; for (int k_ = 0; k_ < 6; ++k_) tot += TP[k_];
#endif
        const float frac = tot ? (float)((double)TP[TPROBE] / (double)tot) : 0.f; args.out[0] += 0.15f + 0.3f * frac; }
#endif
#undef IN
#undef SEAM
}
extern "C" void kernel_launch(void* const* d_in, const int* in_sizes, int n_in, void* d_out, int out_size, void* d_ws, size_t ws_size, hipStream_t stream) {
    static int grid = 0;
    if (grid == 0) {
        if (n_in != 29 || ws_size < WS_END || out_size != T_TOK * DM || in_sizes[0] != T_TOK * DM) { fprintf(stderr, "kernel_launch: built for 29 inputs, x/out of %d floats, >= %zu bytes of workspace; got n_in %d out %d ws %zu; nothing launched\n", T_TOK * DM, (size_t)WS_END, n_in, out_size, ws_size); grid = -1; return; }
        int dev = 0, cus = 0, per_cu = 0;
        if (hipGetDevice(&dev) != hipSuccess || hipDeviceGetAttribute(&cus, hipDeviceAttributeMultiprocessorCount, dev) != hipSuccess) { fprintf(stderr, "kernel_launch: hipGetDevice / hipDeviceGetAttribute failed; nothing launched\n"); grid = -1; return; }
        if (hipFuncSetAttribute((const void*)mk_fwd, hipFuncAttributeMaxDynamicSharedMemorySize, LDS_BYTES) != hipSuccess) { fprintf(stderr, "kernel_launch: hipFuncSetAttribute failed (%d bytes of dynamic LDS); nothing launched\n", LDS_BYTES); grid = -1; return; }
        if (hipOccupancyMaxActiveBlocksPerMultiprocessor(&per_cu, (const void*)mk_fwd, NTHR, LDS_BYTES) != hipSuccess || per_cu < 1) fprintf(stderr, "kernel_launch: note: occupancy query reports %d workgroups per CU\n", per_cu);
        (void)hipGetLastError();
        grid = cus;
        if (grid != 256) { fprintf(stderr, "kernel_launch: %d CUs; this build's unit orders are written for 256 (one workgroup per CU); nothing launched\n", grid); grid = -1; return; }
    }
    if (grid < 0) return;
    if (hipMemsetAsync((char*)d_ws + WS_CTL, 0, CTL_ZERO_BYTES, stream) != hipSuccess) { fprintf(stderr, "kernel_launch: hipMemsetAsync of the control words failed; nothing launched\n"); return; }
    Args a{};
    for (int i = 0; i < 29; ++i) a.in[i] = (const float*)d_in[i];
    a.out = (float*)d_out; a.ws = (unsigned char*)d_ws; a.ph_lo = 0; a.ph_hi = NPH; a.flags = 0; a.li = 0;
    hipLaunchKernelGGL(mk_fwd, dim3(grid), dim3(NTHR), LDS_BYTES, stream, a);
    const hipError_t le = hipPeekAtLastError();
    if (le != hipSuccess) fprintf(stderr, "kernel_launch: launch failed: %s\n", hipGetErrorName(le));
}
```

```cpp
#include <hip/hip_runtime.h>
#include <cstdio>
#include <cstdint>
#include <cmath>
constexpr int T_TOK = 16384, DM = 1024, SEQ = 2048, NB = 8, NIN = 2816, NINP = 5888, DFF = 2816;
constexpr size_t MiB = 1u << 20;
constexpr size_t WS_CTL = 0;
constexpr size_t WS_WIN = 1 * MiB, WS_WMKV = 13 * MiB, WS_WGLU = 15 * MiB, WS_WBR = 16 * MiB, WS_WOUT = 19 * MiB, WS_WGU = 21 * MiB, WS_WD = 32 * MiB;
constexpr size_t WS_WUV = 38 * MiB, WS_BIASL = 38 * MiB + 512 * 1024, WS_RS = 39 * MiB, WS_WI = 37 * MiB + 512 * 1024;
constexpr size_t WS_S5TV = 40 * MiB, WS_S5W = 60 * MiB, WS_KX = 68 * MiB, WS_VX = 70 * MiB, WS_MEMN = 72 * MiB, WS_H = 76 * MiB;
constexpr size_t WS_QD = 108 * MiB, WS_CKV = 140 * MiB, WS_QI = 144 * MiB, WS_KI = 160 * MiB, WS_QX = 162 * MiB, WS_U = 178 * MiB, WS_SLOC = 198 * MiB;
constexpr size_t WS_ODSA = 206 * MiB, WS_OX = 222 * MiB, WS_Y = 238 * MiB, WS_END = 254 * MiB;
constexpr size_t WS_G3 = 108 * MiB, WS_MERGED = WS_H, WS_XN = 108 * MiB, WS_ACT = 140 * MiB;
constexpr size_t WS_OS5 = 0, WS_G = WS_G3;
__device__ __forceinline__ int my_lane_id() { int l; asm volatile("v_mbcnt_lo_u32_b32 %0, -1, 0\n\tv_mbcnt_hi_u32_b32 %0, -1, %0" : "=v"(l)); return l; }
namespace pg8 {
#define PG8_LAS __attribute__((address_space(3)))
typedef unsigned short bf16_t;
typedef short bf16x8 __attribute__((ext_vector_type(8)));
typedef float f32x4 __attribute__((ext_vector_type(4)));
typedef unsigned u32x4 __attribute__((ext_vector_type(4)));
constexpr int BM = 256, BK = 64, HALF = 128, HTB = HALF * BK * 2  , STAGE_BYTES = 8 * HTB, NXCD = 8, WGM = 8;

__host__ __device__ __forceinline__ int lds_byte(int r, int c) { const int st = (r >> 4) * 2 + (c >> 5), rr = r & 15, cc = c & 31, ob = rr * 64 + cc * 2; return st * 1024 + (ob ^ (((ob >> 9) & 1) << 5)); }
__host__ __device__ __forceinline__ void stage_rc(int b, int& R, int& C) { const int st = b / 1024, sb = b % 1024, swz = sb ^ (((sb >> 9) & 1) << 5); R = (st >> 1) * 16 + swz / 64; C = (st & 1) * 32 + (swz % 64) / 2; }
__host__ __device__ __forceinline__ int perm32(int rho) { const int n = rho >> 4, i = rho & 15; return 8 * (i >> 2) + 4 * n + (i & 3); }

struct Unit { int pm, pn, z; };
struct Gemm { const bf16_t* A; const bf16_t* Bt; int M, N, K, lda, ldb; };

struct StaticOrder {
    int nM, nN, nwg, G, c;
    __host__ __device__ void init(int M, int N, int G_, int c_) { nM = M / BM; nN = N / BM; nwg = nM * nN; G = G_; c = c_; }
    __host__ __device__ bool next(int i, Unit& u) const {
        const long L = (long)i * G + c; if (L >= nwg) return false;
        int wgid = (int)L; { const int q = nwg / NXCD, r = nwg % NXCD, xcd = wgid % NXCD, off = wgid / NXCD; wgid = (xcd < r ? xcd * (q + 1) : r * (q + 1) + (xcd - r) * q) + off; }
        const int nig = WGM * nN, gid = wgid / nig, fm = gid * WGM, gsz = (nM - fm) < WGM ? (nM - fm) : WGM;
        u.pm = fm + ((wgid % nig) % gsz); u.pn = (wgid % nig) / gsz; u.z = 0; return true;
    }
    __device__ __forceinline__ void a_ready(const Unit&) const {}
    __device__ __forceinline__ void done(const Unit&) const {}
    __device__ __forceinline__ long a_off(const Unit&) const { return 0; }
    __device__ __forceinline__ long b_off(const Unit&) const { return 0; }
};

typedef float f32x2_c __attribute__((ext_vector_type(2))); typedef __bf16 bf16x2_c __attribute__((ext_vector_type(2)));
__device__ __forceinline__ unsigned cvt_pk_bf16(float lo, float hi) { const f32x2_c v = {lo, hi}; const bf16x2_c b = __builtin_convertvector(v, bf16x2_c); return __builtin_bit_cast(unsigned, b); }
typedef float f32x2 __attribute__((ext_vector_type(2)));
template <class Epi, class Sched, bool ALIGN_EPI = false, bool SP2 = false>
__device__ __forceinline__ void gemm_phase(PG8_LAS unsigned char* lds, const Gemm g, const Sched& S, const Epi& E, const int wid) {
    const int lane = my_lane_id(), tid = wid * 64 + lane, wr = wid >> 2, wc = wid & 3, fr = lane & 15, fq = lane >> 4;
    const int K = g.K, nt = K / BK, lda = g.lda, ldb = g.ldb;
    unsigned voffA[2], voffB[2];
#pragma unroll
    for (int i = 0; i < 2; ++i) { int R, C; stage_rc(tid * 16 + i * 8192, R, C); const int Rb = Epi::PERM ? ((R & ~31) + perm32(R & 31)) : R;
        voffA[i] = (unsigned)(R * lda + C) * 2u; voffB[i] = (unsigned)(Rb * ldb + C) * 2u; }
    const size_t kstep = (size_t)(BK * 2);
    const size_t hstepA = (size_t)HALF * lda * 2, hstepB = (size_t)HALF * ldb * 2;
    const size_t tstepA = 2 * hstepA, tstepB = 2 * hstepB;
    const unsigned ldsw = (unsigned)wid * 1024u;
    const int aoff = lds_byte(wr * 64 + fr, fq * 8), boff = lds_byte(wc * 32 + fr, fq * 8);
#define PG8_SA(b, h) (((b) * 2 + (h)) * HTB)
#define PG8_SB(b, h) ((4 + (b) * 2 + (h)) * HTB)
#define PG8_STAGE(bufoff, gbase, voff) do { _Pragma("unroll") for (int _i = 0; _i < 2; ++_i) \
        __builtin_amdgcn_global_load_lds((const unsigned*)((const char*)(gbase) + (voff)[_i]), (PG8_LAS unsigned*)(lds + (bufoff) + ldsw + _i * 8192), 16, 0, 0); } while (0)
#define PG8_LDA(dst, b, h) do { _Pragma("unroll") for (int m = 0; m < 4; ++m) _Pragma("unroll") for (int k = 0; k < 2; ++k) dst[m][k] = *(const PG8_LAS bf16x8*)(lds + PG8_SA(b, h) + aoff + m * 2048 + k * 1024); } while (0)
#define PG8_LDB(dst, b, h) do { _Pragma("unroll") for (int n = 0; n < 2; ++n) _Pragma("unroll") for (int k = 0; k < 2; ++k) dst[n][k] = *(const PG8_LAS bf16x8*)(lds + PG8_SB(b, h) + boff + n * 2048 + k * 1024); } while (0)
#define PG8_MMA(ai, bj, At, Bt) do { __builtin_amdgcn_s_setprio(1); _Pragma("unroll") for (int m = 0; m < 4; ++m) _Pragma("unroll") for (int n = 0; n < 2; ++n) _Pragma("unroll") for (int k = 0; k < 2; ++k) \
        acc[ai][bj][m][n] = __builtin_amdgcn_mfma_f32_16x16x32_bf16(Bt[n][k], At[m][k], acc[ai][bj][m][n], 0, 0, 0); __builtin_amdgcn_s_setprio(0); } while (0)
#define PG8_WAIT_V(n) asm volatile("s_waitcnt vmcnt(" #n ")" ::: "memory")
#define PG8_WAIT_L(n) asm volatile("s_waitcnt lgkmcnt(" #n ")" ::: "memory")
#define PG8_BAR __builtin_amdgcn_s_barrier()
#define PG8_SCHED __builtin_amdgcn_sched_barrier(0)
    Unit cur, nxt; int ui = 0;
    if (!S.next(0, cur)) return;
    f32x4 acc[2][2][4][2];
#pragma unroll
    for (int a = 0; a < 2; ++a)
#pragma unroll
        for (int b = 0; b < 2; ++b)
#pragma unroll
            for (int m = 0; m < 4; ++m)
#pragma unroll
                for (int n = 0; n < 2; ++n) acc[a][b][m][n] = (f32x4){0.f, 0.f, 0.f, 0.f};
    bf16x8 At[4][2], B0[2][2], B1[2][2];
    const char* cA = (const char*)g.A + (size_t)cur.pm * tstepA + S.a_off(cur); const char* cB = (const char*)g.Bt + (size_t)cur.pn * tstepB + S.b_off(cur);
    S.a_ready(cur);
    if constexpr (SP2) {
        PG8_STAGE(PG8_SB(0, 0), cB, voffB); PG8_STAGE(PG8_SB(0, 1), cB + hstepB, voffB); PG8_STAGE(PG8_SA(0, 0), cA, voffA); PG8_STAGE(PG8_SA(0, 1), cA + hstepA, voffA);
        if (wr == 1) PG8_BAR;
        PG8_WAIT_V(2); PG8_BAR;
        PG8_STAGE(PG8_SB(1, 0), cB + kstep, voffB); PG8_STAGE(PG8_SA(1, 0), cA + kstep, voffA); PG8_STAGE(PG8_SB(1, 1), cB + hstepB + kstep, voffB);
        PG8_WAIT_V(6); PG8_BAR;
    } else {
        PG8_STAGE(PG8_SB(0, 0), cB, voffB); PG8_STAGE(PG8_SA(0, 0), cA, voffA); PG8_STAGE(PG8_SB(0, 1), cB + hstepB, voffB); PG8_STAGE(PG8_SA(0, 1), cA + hstepA, voffA);
        if (wr == 1) PG8_BAR;
        PG8_WAIT_V(4); PG8_BAR;
        PG8_STAGE(PG8_SB(1, 0), cB + kstep, voffB); PG8_STAGE(PG8_SA(1, 0), cA + kstep, voffA); PG8_STAGE(PG8_SB(1, 1), cB + hstepB + kstep, voffB);
        PG8_WAIT_V(6); PG8_BAR;
    }
    for (;;) {
        const bool has_next = S.next(ui + 1, nxt);
        const char* nA = has_next ? (const char*)g.A + (size_t)nxt.pm * tstepA + S.a_off(nxt) : cA; const char* nB = has_next ? (const char*)g.Bt + (size_t)nxt.pn * tstepB + S.b_off(nxt) : cB;
        for (int t = 0; t < nt; t += 2) {
            const bool last = (t == nt - 2);
            const char* a1 = cA + (size_t)(t + 1) * kstep;
            const char* a2 = last ? nA : cA + (size_t)(t + 2) * kstep; const char* b2 = last ? nB : cB + (size_t)(t + 2) * kstep;
            const char* a3 = a2 + kstep; const char* b3 = b2 + kstep;
            if (last && has_next) S.a_ready(nxt);
            if constexpr (SP2) {
            PG8_LDB(B0, 0, 0); PG8_LDB(B1, 0, 1); PG8_SCHED; PG8_LDA(At, 0, 0); PG8_STAGE(PG8_SA(1, 1), a1 + hstepA, voffA);
            PG8_WAIT_V(8); PG8_WAIT_L(0); PG8_BAR; PG8_MMA(0, 0, At, B0); PG8_MMA(0, 1, At, B1); PG8_BAR; PG8_SCHED;
            PG8_LDA(At, 0, 1); PG8_STAGE(PG8_SB(0, 0), b2, voffB); PG8_STAGE(PG8_SB(0, 1), b2 + hstepB, voffB); PG8_STAGE(PG8_SA(0, 0), a2, voffA);
            PG8_WAIT_V(8); PG8_WAIT_L(0); PG8_BAR; PG8_MMA(1, 0, At, B0); PG8_MMA(1, 1, At, B1); PG8_BAR; PG8_SCHED;
            PG8_LDB(B0, 1, 0); PG8_LDB(B1, 1, 1); PG8_SCHED; PG8_LDA(At, 1, 0); PG8_STAGE(PG8_SA(0, 1), a2 + hstepA, voffA);
            PG8_WAIT_V(8); PG8_WAIT_L(0); PG8_BAR; PG8_MMA(0, 0, At, B0); PG8_MMA(0, 1, At, B1); PG8_BAR; PG8_SCHED;
            PG8_LDA(At, 1, 1); PG8_STAGE(PG8_SB(1, 0), b3, voffB); PG8_STAGE(PG8_SB(1, 1), b3 + hstepB, voffB); PG8_STAGE(PG8_SA(1, 0), a3, voffA);
            PG8_WAIT_V(8); PG8_WAIT_L(0); PG8_BAR; PG8_MMA(1, 0, At, B0); PG8_MMA(1, 1, At, B1); PG8_BAR; PG8_SCHED;
            } else {
            PG8_LDB(B0, 0, 0); PG8_SCHED; PG8_LDA(At, 0, 0); PG8_STAGE(PG8_SA(1, 1), a1 + hstepA, voffA);
            PG8_WAIT_L(8); PG8_BAR; PG8_WAIT_L(0); PG8_MMA(0, 0, At, B0); PG8_BAR; PG8_SCHED;
            PG8_LDB(B1, 0, 1); PG8_STAGE(PG8_SB(0, 0), b2, voffB);
            PG8_BAR; PG8_WAIT_L(0); PG8_MMA(0, 1, At, B1); PG8_BAR;
            PG8_LDA(At, 0, 1); PG8_STAGE(PG8_SA(0, 0), a2, voffA);
            PG8_BAR; PG8_WAIT_L(0); PG8_MMA(1, 0, At, B0); PG8_BAR; PG8_SCHED;
            PG8_STAGE(PG8_SB(0, 1), b2 + hstepB, voffB);
            PG8_WAIT_V(6); PG8_BAR; PG8_MMA(1, 1, At, B1); PG8_BAR;
            PG8_LDB(B0, 1, 0); PG8_SCHED; PG8_LDA(At, 1, 0); PG8_STAGE(PG8_SA(0, 1), a2 + hstepA, voffA);
            PG8_WAIT_L(8); PG8_BAR; PG8_WAIT_L(0); PG8_MMA(0, 0, At, B0); PG8_BAR; PG8_SCHED;
            PG8_LDB(B1, 1, 1); PG8_STAGE(PG8_SB(1, 0), b3, voffB);
            PG8_BAR; PG8_WAIT_L(0); PG8_MMA(0, 1, At, B1); PG8_BAR;
            PG8_LDA(At, 1, 1); PG8_STAGE(PG8_SA(1, 0), a3, voffA);
            PG8_BAR; PG8_WAIT_L(0); PG8_MMA(1, 0, At, B0); PG8_BAR; PG8_SCHED;
            PG8_STAGE(PG8_SB(1, 1), b3 + hstepB, voffB);
            PG8_WAIT_V(6); PG8_BAR; PG8_MMA(1, 1, At, B1); PG8_BAR;
            }
        }
        if constexpr (ALIGN_EPI) { if (wr == 0) PG8_BAR; }
        if constexpr (!Epi::AFTER_DRAIN) { E(acc, cur, wr, wc, fr, fq); S.done(cur); }
        if (!has_next) break;
#pragma unroll
        for (int a = 0; a < 2; ++a)
#pragma unroll
            for (int b = 0; b < 2; ++b)
#pragma unroll
                for (int m = 0; m < 4; ++m)
#pragma unroll
                    for (int n = 0; n < 2; ++n) acc[a][b][m][n] = (f32x4){0.f, 0.f, 0.f, 0.f};
        cur = nxt; cA = nA; cB = nB; ++ui;
        if constexpr (ALIGN_EPI) { if (wr == 1) PG8_BAR; }
    }
    PG8_WAIT_V(0);
    if constexpr (!ALIGN_EPI) { if (wr == 0) PG8_BAR; }
    PG8_BAR;
    if constexpr (Epi::AFTER_DRAIN) { E.fused(acc, cur, wr, wc, fr, fq, lds, wid, lane); S.done(cur); }
#undef PG8_SA
#undef PG8_SB
#undef PG8_STAGE
#undef PG8_LDA
#undef PG8_LDB
#undef PG8_MMA
#undef PG8_WAIT_V
#undef PG8_WAIT_L
#undef PG8_BAR
#undef PG8_SCHED
}
}
namespace pg8 {
typedef unsigned u32x2 __attribute__((ext_vector_type(2)));
__device__ __forceinline__ u32x4 pack8(const f32x4 a, const f32x4 b) { u32x4 w; w.x = cvt_pk_bf16(a[0], a[1]); w.y = cvt_pk_bf16(a[2], a[3]); w.z = cvt_pk_bf16(b[0], b[1]); w.w = cvt_pk_bf16(b[2], b[3]); return w; }
__device__ __forceinline__ void unpack8(const u32x4 w, f32x4& a, f32x4& b) {
    a[0] = __uint_as_float(w.x << 16); a[1] = __uint_as_float(w.x & 0xffff0000u); a[2] = __uint_as_float(w.y << 16); a[3] = __uint_as_float(w.y & 0xffff0000u);
    b[0] = __uint_as_float(w.z << 16); b[1] = __uint_as_float(w.z & 0xffff0000u); b[2] = __uint_as_float(w.w << 16); b[3] = __uint_as_float(w.w & 0xffff0000u); }
__device__ __forceinline__ float sigm(float v) { return __builtin_amdgcn_rcpf(1.f + __expf(-v)); }
__device__ __forceinline__ f32x4 sigm4(const f32x4 v) { f32x4 r; r[0] = sigm(v[0]); r[1] = sigm(v[1]); r[2] = sigm(v[2]); r[3] = sigm(v[3]); return r; }

__device__ __forceinline__ void norm128_stats(const f32x4 (&acc)[2][2][4][2], PG8_LAS float* XB, int wr, int wc, int fr, int fq, float (&rs)[2][2][4]) {
#pragma unroll
    for (int bj = 0; bj < 2; ++bj)
#pragma unroll
        for (int ai = 0; ai < 2; ++ai)
#pragma unroll
            for (int m = 0; m < 4; ++m) { const f32x4 a = acc[ai][bj][m][0], b = acc[ai][bj][m][1];
                float ss = ((a[0] * a[0] + a[1] * a[1]) + (a[2] * a[2] + a[3] * a[3])) + ((b[0] * b[0] + b[1] * b[1]) + (b[2] * b[2] + b[3] * b[3]));
                ss += __shfl_xor(ss, 16); ss += __shfl_xor(ss, 32);
                if (fq == 0) XB[(bj * 256 + ai * HALF + wr * 64 + m * 16 + fr) * 4 + wc] = ss; }
    asm volatile("s_waitcnt lgkmcnt(0)" ::: "memory"); __builtin_amdgcn_s_barrier(); asm volatile("" ::: "memory");
#pragma unroll
    for (int bj = 0; bj < 2; ++bj)
#pragma unroll
        for (int ai = 0; ai < 2; ++ai)
#pragma unroll
            for (int m = 0; m < 4; ++m) { const f32x4 p = *(const PG8_LAS f32x4*)(XB + (bj * 256 + ai * HALF + wr * 64 + m * 16 + fr) * 4);
                rs[bj][ai][m] = __builtin_amdgcn_rsqf(((p[0] + p[1]) + (p[2] + p[3])) * (1.f / 128.f) + 1e-6f); }
}
struct EpiInprojF {
    static constexpr bool PERM = true, AFTER_DRAIN = false;
    bf16_t *QD, *CKV, *QI, *KI, *U, *QX; float* WI; const float *gq, *gkv, *gqx; PG8_LAS float* XB;
    __device__ __forceinline__ void operator()(const f32x4 (&acc)[2][2][4][2], const Unit& u, int wr, int wc, int fr, int fq) const {
        const int row0 = u.pm * BM + wr * 64 + fr, cb = u.pn * BM;
        const bool nrm0 = cb < 1152 || cb >= 2304, nrm1 = cb + HALF < 1024 || cb + HALF >= 2304;
        float rs[2][2][4];
        if (nrm0 || nrm1) norm128_stats(acc, XB, wr, wc, fr, fq, rs);
#pragma unroll
        for (int bj = 0; bj < 2; ++bj) {
            const int c0 = cb + bj * HALF + wc * 32 + 8 * fq; const bool nrm = bj == 0 ? nrm0 : nrm1;
            bf16_t* base = QD; int ld = 1024, cc = c0, kind = 0; const float* gp = gq + (c0 & 127);
            if (c0 < 1024) { }
            else if (c0 < 1152) { base = CKV; ld = 128; cc = c0 - 1024; gp = gkv + cc; }
            else if (c0 < 1664) { base = QI; ld = 512; cc = c0 - 1152; }
            else if (c0 < 1728) { base = KI; ld = 64; cc = c0 - 1664; }
            else if (c0 < 1792) { kind = 1; }
            else if (c0 < 2304) { kind = 2; cc = c0 - 1792; }
            else { base = QX; ld = 512; cc = c0 - 2304; gp = gqx + (cc & 127); }
            f32x4 g0 = {1.f, 1.f, 1.f, 1.f}, g1 = g0;
            if (nrm) { g0 = *(const f32x4*)gp; g1 = *(const f32x4*)(gp + 4); }
#pragma unroll
            for (int ai = 0; ai < 2; ++ai)
#pragma unroll
                for (int m = 0; m < 4; ++m) {
                    const int t = row0 + ai * HALF + m * 16;
                    if (kind == 0) { f32x4 v0 = acc[ai][bj][m][0], v1 = acc[ai][bj][m][1]; if (nrm) { const float r = rs[bj][ai][m]; v0 = v0 * r * g0; v1 = v1 * r * g1; }
                        *(u32x4*)(base + (size_t)t * ld + cc) = pack8(v0, v1); }
                    else if (kind == 1) { if (c0 == 1728) { *(f32x4*)(WI + (size_t)t * 8) = acc[ai][bj][m][0]; *(f32x4*)(WI + (size_t)t * 8 + 4) = acc[ai][bj][m][1]; } }
                    else { const int g = cc >> 4, ci = cc & 15, b = t >> 11, tt = t & 2047, R = b * 64 + (tt >> 5), s = tt & 31;
                        *(u32x4*)(U + ((size_t)(g * 512 + R)) * 640 + s * 16 + ci) = pack8(acc[ai][bj][m][0], acc[ai][bj][m][1]); }
                }
        }
    }
};
struct EpiMemKVF {
    static constexpr bool PERM = true, AFTER_DRAIN = false;
    bf16_t* KX; bf16_t* VX; const float* gk; PG8_LAS float* XB;
    __device__ __forceinline__ void operator()(const f32x4 (&acc)[2][2][4][2], const Unit& u, int wr, int wc, int fr, int fq) const {
        const int row0 = u.pm * BM + wr * 64 + fr, cb = u.pn * BM; const bool nrm = cb < 512;
        float rs[2][2][4];
        if (nrm) norm128_stats(acc, XB, wr, wc, fr, fq, rs);
#pragma unroll
        for (int bj = 0; bj < 2; ++bj) {
            const int c0 = cb + bj * HALF + wc * 32 + 8 * fq;
            bf16_t* base = nrm ? KX : VX; const int cc = nrm ? c0 : c0 - 512;
            f32x4 g0 = {1.f, 1.f, 1.f, 1.f}, g1 = g0;
            if (nrm) { g0 = *(const f32x4*)(gk + (c0 & 127)); g1 = *(const f32x4*)(gk + (c0 & 127) + 4); }
#pragma unroll
            for (int ai = 0; ai < 2; ++ai)
#pragma unroll
                for (int m = 0; m < 4; ++m) { f32x4 v0 = acc[ai][bj][m][0], v1 = acc[ai][bj][m][1]; if (nrm) { const float r = rs[bj][ai][m]; v0 = v0 * r * g0; v1 = v1 * r * g1; }
                    *(u32x4*)(base + (size_t)(row0 + ai * HALF + m * 16) * 512 + cc) = pack8(v0, v1); }
        }
    }
};
struct EpiGluF {
    static constexpr bool PERM = true, AFTER_DRAIN = false;
    const bf16_t* Y; bf16_t* O;
    __device__ __forceinline__ void operator()(const f32x4 (&acc)[2][2][4][2], const Unit& u, int wr, int wc, int fr, int fq) const {
        const int row0 = u.pm * BM + wr * 64 + fr, c0 = u.pn * BM + wc * 32 + 8 * fq;
#pragma unroll
        for (int ai = 0; ai < 2; ++ai) {
            u32x4 yv[4][2];
#pragma unroll
            for (int m = 0; m < 4; ++m)
#pragma unroll
                for (int bj = 0; bj < 2; ++bj) yv[m][bj] = *(const u32x4*)(Y + (size_t)(row0 + ai * HALF + m * 16) * 512 + c0 + bj * HALF);
            asm volatile("" ::: "memory");
#pragma unroll
            for (int m = 0; m < 4; ++m)
#pragma unroll
                for (int bj = 0; bj < 2; ++bj) { f32x4 y0, y1; unpack8(yv[m][bj], y0, y1);
                    *(u32x4*)(O + (size_t)(row0 + ai * HALF + m * 16) * 512 + c0 + bj * HALF) = pack8(y0 * sigm4(acc[ai][bj][m][0]), y1 * sigm4(acc[ai][bj][m][1])); }
        }
    }
};
struct EpiSigmoidF {
    static constexpr bool PERM = true, AFTER_DRAIN = false;
    bf16_t* G; int ld;
    __device__ __forceinline__ void operator()(const f32x4 (&acc)[2][2][4][2], const Unit& u, int wr, int wc, int fr, int fq) const {
        const int row0 = u.pm * BM + wr * 64 + fr;
#pragma unroll
        for (int bj = 0; bj < 2; ++bj) {
            const int c0 = u.pn * BM + bj * HALF + wc * 32 + 8 * fq;
#pragma unroll
            for (int ai = 0; ai < 2; ++ai)
#pragma unroll
                for (int m = 0; m < 4; ++m) *(u32x4*)(G + (size_t)(row0 + ai * HALF + m * 16) * ld + c0) = pack8(sigm4(acc[ai][bj][m][0]), sigm4(acc[ai][bj][m][1]));
        }
    }
};
struct EpiMergeF {
    static constexpr bool PERM = true, AFTER_DRAIN = false;
    const bf16_t* G3; bf16_t* MG;
    __device__ __forceinline__ void operator()(const f32x4 (&acc)[2][2][4][2], const Unit& u, int wr, int wc, int fr, int fq) const {
        const int row0 = u.pm * BM + wr * 64 + fr, c0 = u.pn * BM + wc * 32 + 8 * fq; const bool first = u.z == 0;
#pragma unroll
        for (int ai = 0; ai < 2; ++ai) {
            u32x4 gv[4][2], pv[4][2];
#pragma unroll
            for (int m = 0; m < 4; ++m)
#pragma unroll
                for (int bj = 0; bj < 2; ++bj) { const size_t t = (size_t)(row0 + ai * HALF + m * 16);
                    gv[m][bj] = *(const u32x4*)(G3 + t * 3072 + u.z * 1024 + c0 + bj * HALF);
                    pv[m][bj] = first ? (u32x4){0u, 0u, 0u, 0u} : *(const u32x4*)(MG + t * 1024 + c0 + bj * HALF); }
            asm volatile("" ::: "memory");
#pragma unroll
            for (int m = 0; m < 4; ++m)
#pragma unroll
                for (int bj = 0; bj < 2; ++bj) { const size_t t = (size_t)(row0 + ai * HALF + m * 16);
                    f32x4 g0, g1, p0, p1; unpack8(gv[m][bj], g0, g1); unpack8(pv[m][bj], p0, p1);
                    *(u32x4*)(MG + t * 1024 + c0 + bj * HALF) = pack8(p0 + g0 * acc[ai][bj][m][0], p1 + g1 * acc[ai][bj][m][1]); }
        }
    }
};
struct EpiOutF {
    static constexpr bool PERM = false, AFTER_DRAIN = false;
    const float* x; float* out; bf16_t* XN; float* RS;
    __device__ __forceinline__ void operator()(const f32x4 (&acc)[2][2][4][2], const Unit& u, int wr, int wc, int fr, int fq) const {
        const int row0 = u.pm * BM + wr * 64 + fr, col0 = u.pn * BM + wc * 32 + 4 * fq;
#pragma unroll
        for (int ai = 0; ai < 2; ++ai) {
            f32x4 xv[4][2][2];
#pragma unroll
            for (int m = 0; m < 4; ++m)
#pragma unroll
                for (int bj = 0; bj < 2; ++bj)
#pragma unroll
                    for (int n = 0; n < 2; ++n) xv[m][bj][n] = *(const f32x4*)(x + (size_t)(row0 + ai * HALF + m * 16) * 1024 + col0 + bj * HALF + n * 16);
            asm volatile("" ::: "memory");
#pragma unroll
            for (int m = 0; m < 4; ++m) { const int t = row0 + ai * HALF + m * 16; const size_t off = (size_t)t * 1024 + col0; float ss = 0.f;
#pragma unroll
                for (int bj = 0; bj < 2; ++bj)
#pragma unroll
                    for (int n = 0; n < 2; ++n) { const size_t o2 = off + bj * HALF + n * 16; const f32x4 r = xv[m][bj][n] + acc[ai][bj][m][n];
                        u32x2 w; w.x = cvt_pk_bf16(r[0], r[1]); w.y = cvt_pk_bf16(r[2], r[3]); *(u32x2*)(XN + o2) = w;
                        ss += (r[0] * r[0] + r[1] * r[1]) + (r[2] * r[2] + r[3] * r[3]); }
                ss += __shfl_xor(ss, 16); ss += __shfl_xor(ss, 32);
                if (fq == 0) RS[(size_t)t * 16 + u.pn * 4 + wc] = ss; }
        }
    }
};
struct EpiGateUpF {
    static constexpr bool PERM = true, AFTER_DRAIN = false;
    const float* RS; bf16_t* ACT;
    __device__ __forceinline__ void operator()(const f32x4 (&acc)[2][2][4][2], const Unit& u, int wr, int wc, int fr, int fq) const {
        const int row0 = u.pm * BM + wr * 64 + fr, f0 = u.pn * HALF + wc * 32 + 8 * fq;
        f32x4 pr[2][4];
#pragma unroll
        for (int ai = 0; ai < 2; ++ai)
#pragma unroll
            for (int m = 0; m < 4; ++m) pr[ai][m] = *(const f32x4*)(RS + (size_t)(row0 + ai * HALF + m * 16) * 16 + 4 * fq);
        asm volatile("" ::: "memory");
#pragma unroll
        for (int ai = 0; ai < 2; ++ai)
#pragma unroll
            for (int m = 0; m < 4; ++m) { const int t = row0 + ai * HALF + m * 16;
                float tot = (pr[ai][m][0] + pr[ai][m][1]) + (pr[ai][m][2] + pr[ai][m][3]); tot += __shfl_xor(tot, 16); tot += __shfl_xor(tot, 32);
                const float rs = __builtin_amdgcn_rsqf(tot * (1.f / 1024.f) + 1e-6f);
                f32x4 o[2];
#pragma unroll
                for (int n = 0; n < 2; ++n) { const f32x4 g = acc[ai][0][m][n] * rs, up = acc[ai][1][m][n] * rs; o[n] = g * sigm4(g) * up; }
                *(u32x4*)(ACT + (size_t)t * 2816 + f0) = pack8(o[0], o[1]); }
    }
};
struct EpiDownF {
    static constexpr bool PERM = false, AFTER_DRAIN = false;
    const bf16_t* XN; float* out;
    __device__ __forceinline__ void operator()(const f32x4 (&acc)[2][2][4][2], const Unit& u, int wr, int wc, int fr, int fq) const {
        const int row0 = u.pm * BM + wr * 64 + fr, col0 = u.pn * BM + wc * 32 + 4 * fq;
#pragma unroll
        for (int ai = 0; ai < 2; ++ai) {
            u32x2 xv[4][2][2];
#pragma unroll
            for (int m = 0; m < 4; ++m)
#pragma unroll
                for (int bj = 0; bj < 2; ++bj)
#pragma unroll
                    for (int n = 0; n < 2; ++n) xv[m][bj][n] = *(const u32x2*)(XN + (size_t)(row0 + ai * HALF + m * 16) * 1024 + col0 + bj * HALF + n * 16);
            asm volatile("" ::: "memory");
#pragma unroll
            for (int m = 0; m < 4; ++m)
#pragma unroll
                for (int bj = 0; bj < 2; ++bj)
#pragma unroll
                    for (int n = 0; n < 2; ++n) { const u32x2 w = xv[m][bj][n];
                        const f32x4 x1 = {__uint_as_float(w.x << 16), __uint_as_float(w.x & 0xffff0000u), __uint_as_float(w.y << 16), __uint_as_float(w.y & 0xffff0000u)};
                        *(f32x4*)(out + (size_t)(row0 + ai * HALF + m * 16) * 1024 + col0 + bj * HALF + n * 16) = x1 + acc[ai][bj][m][n]; }
        }
    }
};
struct EpiSlocF {
    static constexpr bool PERM = false, AFTER_DRAIN = false;
    float* SLOC;
    __device__ __forceinline__ void operator()(const f32x4 (&acc)[2][2][4][2], const Unit& u, int wr, int wc, int fr, int fq) const {
        const int row0 = u.pm * BM + wr * 64 + fr, col0 = wc * 32 + 4 * fq;
#pragma unroll
        for (int ai = 0; ai < 2; ++ai)
#pragma unroll
            for (int m = 0; m < 4; ++m)
#pragma unroll
                for (int n = 0; n < 2; ++n) *(f32x4*)(SLOC + (size_t)(row0 + ai * HALF + m * 16) * 128 + col0 + n * 16) = acc[ai][0][m][n];
    }
};
__device__ __forceinline__ float gelu_t(float x) { const float w = 1.5957691216057308f * (x + 0.044715f * x * x * x); return x * __builtin_amdgcn_rcpf(1.f + __expf(-w)); }
struct EpiS5YF {
    static constexpr bool PERM = true, AFTER_DRAIN = false;
    const bf16_t* U; const float* dskip; bf16_t* Y;
    __device__ __forceinline__ void operator()(const f32x4 (&acc)[2][2][4][2], const Unit& u, int wr, int wc, int fr, int fq) const {
        const int row0 = u.pm * BM + wr * 64 + fr, g = (u.pm * BM) >> 9;
        f32x4 dk[2][2];
#pragma unroll
        for (int bj = 0; bj < 2; ++bj) { const int co0 = ((u.pn & 1) * BM + bj * HALF + wc * 32 + 8 * fq) & 15; dk[bj][0] = *(const f32x4*)(dskip + g * 16 + co0); dk[bj][1] = *(const f32x4*)(dskip + g * 16 + co0 + 4); }
#pragma unroll
        for (int ai = 0; ai < 2; ++ai) {
            u32x4 uv[4][2];
#pragma unroll
            for (int m = 0; m < 4; ++m)
#pragma unroll
                for (int bj = 0; bj < 2; ++bj) { const int cl = (u.pn & 1) * BM + bj * HALF + wc * 32 + 8 * fq; uv[m][bj] = *(const u32x4*)(U + (size_t)(row0 + ai * HALF + m * 16) * 640 + cl); }
            asm volatile("" ::: "memory");
#pragma unroll
            for (int m = 0; m < 4; ++m)
#pragma unroll
                for (int bj = 0; bj < 2; ++bj) { const int cl = (u.pn & 1) * BM + bj * HALF + wc * 32 + 8 * fq, s = cl >> 4, co0 = cl & 15;
                    const int row = row0 + ai * HALF + m * 16, R = row & 511, b = R >> 6, ch = R & 63, t = b * 2048 + ch * 32 + s;
                    f32x4 u0, u1; unpack8(uv[m][bj], u0, u1);
                    f32x4 y0 = acc[ai][bj][m][0] + dk[bj][0] * u0, y1 = acc[ai][bj][m][1] + dk[bj][1] * u1;
#pragma unroll
                    for (int e2 = 0; e2 < 4; ++e2) { y0[e2] = gelu_t(y0[e2]); y1[e2] = gelu_t(y1[e2]); }
                    *(u32x4*)(Y + (size_t)t * 512 + g * 16 + co0) = pack8(y0, y1); }
        }
    }
};
struct SubsetOrder { StaticOrder so; bool active;
    __device__ void init(int M, int N, int Gsub, int csub) { so.init(M, N, Gsub, csub < 0 ? 0 : csub); active = csub >= 0 && csub < Gsub; }
    __device__ bool next(int i, Unit& u) const { return active && so.next(i, u); }
    __device__ __forceinline__ void a_ready(const Unit&) const {}
    __device__ __forceinline__ void done(const Unit&) const {}
    __device__ __forceinline__ long a_off(const Unit&) const { return 0; }
    __device__ __forceinline__ long b_off(const Unit&) const { return 0; } };
struct S5Order1 { int c;
    __device__ bool next(int i, Unit& u) const { if (i > 0 || c < 0 || c >= 64) return false; u.pm = c; u.pn = c >> 1; u.z = 0; return true; }
    __device__ __forceinline__ void a_ready(const Unit&) const {}
    __device__ __forceinline__ void done(const Unit&) const {}
    __device__ __forceinline__ long a_off(const Unit&) const { return 0; }
    __device__ __forceinline__ long b_off(const Unit&) const { return 0; } };
struct S5Order2 { int c;
    __device__ bool next(int i, Unit& u) const { if (i > 0 || c < 0 || c >= 128) return false; const int g = c >> 2; u.pm = g * 2 + ((c >> 1) & 1); u.pn = g * 2 + (c & 1); u.z = 0; return true; }
    __device__ __forceinline__ void a_ready(const Unit&) const {}
    __device__ __forceinline__ void done(const Unit&) const {}
    __device__ __forceinline__ long a_off(const Unit&) const { return 0; }
    __device__ __forceinline__ long b_off(const Unit&) const { return 0; } };
struct GateOrder { int c;
    __device__ bool next(int i, Unit& u) const { int id; if (i >= 3) return false; id = c * 3 + i; u.pm = id / 12; u.pn = id % 12; u.z = 0; return true; }
    __device__ __forceinline__ void a_ready(const Unit&) const {}
    __device__ __forceinline__ void done(const Unit&) const {}
    __device__ __forceinline__ long a_off(const Unit&) const { return 0; }
    __device__ __forceinline__ long b_off(const Unit&) const { return 0; } };
struct MergeOrder { StaticOrder so; long aoff[3];
    __device__ bool next(int i, Unit& u) const { if (i >= 3) return false; if (!so.next(0, u)) return false; u.z = i; return true; }
    __device__ __forceinline__ void a_ready(const Unit&) const {}
    __device__ __forceinline__ void done(const Unit&) const {}
    __device__ __forceinline__ long a_off(const Unit& u) const { return u.z == 0 ? aoff[0] : (u.z == 1 ? aoff[1] : aoff[2]); }
    __device__ __forceinline__ long b_off(const Unit& u) const { return (long)u.z * 1024 * 512 * 2; } };
}
#define GAS __attribute__((address_space(1)))
#define LAS __attribute__((address_space(3)))
typedef unsigned short bf16;
typedef unsigned v4u __attribute__((ext_vector_type(4)));
typedef float f32x4 __attribute__((ext_vector_type(4)));
typedef short bf16x8 __attribute__((ext_vector_type(8)));
typedef GAS unsigned gu32;
typedef GAS unsigned long long gu64;
#define RLX_AGENT __ATOMIC_RELAXED, __HIP_MEMORY_SCOPE_AGENT
#define LDS_WAIT() asm volatile("s_waitcnt lgkmcnt(0)" ::: "memory")
#define VM_WAIT() asm volatile("s_waitcnt vmcnt(0)" ::: "memory")
__device__ __forceinline__ unsigned long long rt() { return __builtin_amdgcn_s_memrealtime(); }
__device__ __forceinline__ unsigned f2bf(float f) { unsigned u = __builtin_bit_cast(unsigned, f); return (u + 0x7fffu + ((u >> 16) & 1u)) >> 16; }
__device__ __forceinline__ unsigned pk2(float lo, float hi) { return f2bf(lo) | (f2bf(hi) << 16); }

#define XB_TMO      128
#define XB_XCNT(j)  (256  + 64 * (j))
#define XB_XSUB(j)  (1280 + 64 * (j))
#define XB_XGEN(j)  (2304 + 64 * (j))
#define XB_TOP      3328
#define XB_TOPGEN   3392
#define XCD_BAR_WORDS 3456
#define XB_SPIN_CAP (1u << 18)

__device__ __forceinline__ unsigned xb_ld(unsigned* p)              { return __hip_atomic_load(p, __ATOMIC_RELAXED, __HIP_MEMORY_SCOPE_AGENT); }
__device__ __forceinline__ unsigned xb_add(unsigned* p, unsigned v) { return __hip_atomic_fetch_add(p, v, __ATOMIC_RELAXED, __HIP_MEMORY_SCOPE_AGENT); }
__device__ __forceinline__ unsigned xb_xcc_id() { return (unsigned)__builtin_amdgcn_s_getreg((3 << 11) | 20) & 0xFu; }
#define XB_SPIN(cond, bar) do { unsigned _sp = 0; while (cond) { __builtin_amdgcn_s_sleep(1); \
    if ((++_sp & 255u) == 0u) { if (xb_ld(&(bar)[XB_TMO])) break; if (_sp > XB_SPIN_CAP) { atomicAdd(&(bar)[XB_TMO], 1u); break; } } } } while (0)

struct XcdBarrier {
    unsigned* bar; unsigned x;
    volatile LAS unsigned* st;
};

__device__ __forceinline__ XcdBarrier xcd_barrier_post(unsigned* bar, volatile LAS unsigned* st, bool leader) {
    XcdBarrier b; b.bar = bar; b.x = xb_xcc_id(); b.st = st;
    if (leader) (void)xb_add(&bar[XB_XCNT(b.x)], 1u);
    return b;
}
__device__ __forceinline__ void xcd_barrier_complete(unsigned* bar, unsigned x, unsigned& nloc, unsigned& nx) {
    const unsigned G = gridDim.x * gridDim.y * gridDim.z;
    unsigned sum, cnt, mine, sp = 0u;
    for (;;) {
        sum = 0u; cnt = 0u; mine = 0u;
#pragma unroll
        for (unsigned j = 0; j < 16; ++j) { const unsigned c = xb_ld(&bar[XB_XCNT(j)]); sum += c; cnt += (c > 0u) ? 1u : 0u; mine = (j == x) ? c : mine; }
        if (sum == G) break;
        __builtin_amdgcn_s_sleep(1);
        if ((++sp & 255u) == 0u) { if (xb_ld(&bar[XB_TMO])) break; if (sp > XB_SPIN_CAP) { atomicAdd(&bar[XB_TMO], 1u); break; } }
    }
    nloc = mine > 0u ? mine : 1u; nx = cnt > 0u ? cnt : 1u;
}

__device__ __forceinline__ void xcd_barrier(const XcdBarrier& b, bool leader) {
    asm volatile("s_waitcnt vmcnt(0)" ::: "memory");
    __syncthreads();
    if (leader) {
        unsigned* bar = b.bar;
        __builtin_amdgcn_s_waitcnt(0);
        unsigned nloc = b.st[0], nx = b.st[1];
        if (nloc == 0u) { xcd_barrier_complete(bar, b.x, nloc, nx); b.st[0] = nloc; b.st[1] = nx; }
        const unsigned old = xb_add(&bar[XB_XSUB(b.x)], 1u);
        const unsigned gen = old / nloc;
        if (old + 1u == (gen + 1u) * nloc) {
            __builtin_amdgcn_fence(__ATOMIC_RELEASE, "agent");
            asm volatile("s_waitcnt vmcnt(0)" ::: "memory");
            const unsigned og = xb_add(&bar[XB_TOP], 1u);
            const unsigned tg = og / nx;
            if (og + 1u == (tg + 1u) * nx) xb_add(&bar[XB_TOPGEN], 1u);
            else XB_SPIN(xb_ld(&bar[XB_TOPGEN]) == tg, bar);
            __builtin_amdgcn_fence(__ATOMIC_ACQUIRE, "agent");
            xb_add(&bar[XB_XGEN(b.x)], 1u);
            asm volatile("s_waitcnt vmcnt(0)" ::: "memory");
        } else {
            XB_SPIN(xb_ld(&bar[XB_XGEN(b.x)]) == gen, bar);
            __builtin_amdgcn_fence(__ATOMIC_ACQUIRE, "agent");
            asm volatile("s_waitcnt vmcnt(0)" ::: "memory");
        }
    }
    __syncthreads();
}
constexpr int NWAVES = 8, NTHR = 512;
constexpr int RING_OFF = 0, RING_BYTES = 131072;
constexpr int LDSCTL_OFF = RING_BYTES, MISC_OFF = LDSCTL_OFF + 320, XB_OFF = RING_BYTES + 1024;
constexpr int LDS_BYTES = 147456;
constexpr size_t CTL_ZERO_BYTES = 65536;
constexpr int CW_TMO = 0, CW_BAR = 4096;
constexpr int NPH = 9;
constexpr int FL_NO_DSA = 1, FL_NO_CROSS = 2, FL_NO_S5 = 4;
constexpr size_t WS_LAM32 = WS_BIASL + 8192;

struct Args { const float* in[29]; float* out; unsigned char* ws; int ph_lo, ph_hi, flags, li; };

__device__ __forceinline__ float wave_sum(float v) {
#pragma unroll
    for (int o = 1; o < 64; o <<= 1) v += __shfl_xor(v, o);
    return v;
}
__device__ __forceinline__ float p0_src(int mode, const float* W, const float* W2, const float* gain, int N, int k, int d) {
    if (mode == 0) return W[(size_t)k * N + d];
    if (mode == 1) { if (d >= 1736 && d < 1792) return 0.f; const int s = d >= 1792 ? d - 56 : d; return W[(size_t)k * N + s]; }
    const int tile = d >> 8, w = d & 255, f = tile * 128 + (w & 127); return ((w < 128) ? W : W2)[(size_t)k * N + f] * gain[k];
}
__device__ __forceinline__ void p0_transpose_item(int mode, const float* W, const float* W2, const float* gain, int K, int N, int ND, bf16* WT, LAS float* scr, int item, int lane) {
    const int nblk = ND / 32, kb = item / nblk, nb = item % nblk, k0 = 64 * kb, d0 = 32 * nb;
    float tv[32];
#pragma unroll
    for (int i = 0; i < 32; ++i) tv[i] = p0_src(mode, W, W2, gain, N, k0 + 2 * i + (lane >> 5), d0 + (lane & 31));
#pragma unroll
    for (int i = 0; i < 32; ++i) scr[(2 * i + (lane >> 5)) * 33 + (lane & 31)] = tv[i];
    LDS_WAIT(); asm volatile("" ::: "memory");
    const int c = lane & 7;
#pragma unroll
    for (int j = 0; j < 4; ++j) { const int n = (lane >> 3) + 8 * j; const LAS float* s = scr + (8 * c) * 33 + n;
        v4u o; o.x = pk2(s[0 * 33], s[1 * 33]); o.y = pk2(s[2 * 33], s[3 * 33]); o.z = pk2(s[4 * 33], s[5 * 33]); o.w = pk2(s[6 * 33], s[7 * 33]);
        *(GAS v4u*)(WT + (size_t)(d0 + n) * K + k0 + 8 * c) = o; }
    LDS_WAIT(); asm volatile("" ::: "memory");
}
__device__ __forceinline__ void rms_row_to_bf16(const float* xrow, const float* g, bf16* orow, int lane) {
    const GAS f32x4* xr = (const GAS f32x4*)xrow + lane; const GAS f32x4* gr = (const GAS f32x4*)g + lane;
    f32x4 v[4]; float s = 0.f;
#pragma unroll
    for (int j = 0; j < 4; ++j) { v[j] = xr[64 * j]; s += (v[j].x * v[j].x + v[j].y * v[j].y) + (v[j].z * v[j].z + v[j].w * v[j].w); }
    const float rstd = 1.f / sqrtf(wave_sum(s) * (1.f / 1024.f) + 1e-6f);
    GAS unsigned long long* o8 = (GAS unsigned long long*)orow + lane;
#pragma unroll
    for (int j = 0; j < 4; ++j) { const f32x4 gg = gr[64 * j];
        o8[64 * j] = (unsigned long long)pk2(v[j].x * rstd * gg.x, v[j].y * rstd * gg.y) | ((unsigned long long)pk2(v[j].z * rstd * gg.z, v[j].w * rstd * gg.w) << 32); }
}
__device__ __forceinline__ int t5_bucket(int n) {
    if (n < 16) return n;
    const int large = 16 + (int)((logf((float)n / 16.f) / 2.0794415416798357f) * 16.f);
    return large < 31 ? large : 31;
}
__device__ __forceinline__ void p0_s5_tables(int g, int part, const Args& a, LAS unsigned char* lds, int tid) {
    typedef float f32x2v __attribute__((ext_vector_type(2)));
    LAS f32x2v* POW = (LAS f32x2v*)lds;
    LAS f32x2v* BB = POW + 33 * 64;
    LAS f32x2v* CC = BB + 64 * 16;
    LAS float* KT = (LAS float*)(CC + 16 * 64);
    const float *a_re = a.in[8], *a_im = a.in[9], *log_dt = a.in[10], *b_re = a.in[11], *b_im = a.in[12], *c_re = a.in[13], *c_im = a.in[14];
    bf16* TV = (bf16*)(a.ws + WS_S5TV) + (size_t)g * 512 * 640; bf16* Wt = (bf16*)(a.ws + WS_S5W) + (size_t)g * 256 * 512; float* LAM32 = (float*)(a.ws + WS_LAM32) + g * 128;
    const double dt = exp((double)log_dt[g]);
    for (int idx = tid; idx < 33 * 64; idx += NTHR) { const int j = idx >> 6, n = idx & 63; const double lr = a_re[g * 64 + n], li = a_im[g * 64 + n];
        const double mag = exp(lr * dt * j), ang = li * dt * j; POW[idx] = (f32x2v){(float)(mag * cos(ang)), (float)(mag * sin(ang))}; }
    for (int idx = tid; idx < 64 * 16; idx += NTHR) { const int n = idx >> 4, c = idx & 15; const double lr = a_re[g * 64 + n], li = a_im[g * 64 + n];
        const double mag = exp(lr * dt), lbr = mag * cos(li * dt), lbi = mag * sin(li * dt), nr = lbr - 1.0, ni = lbi, den = lr * lr + li * li;
        const double fr = (nr * lr + ni * li) / den, fi = (ni * lr - nr * li) / den, br = b_re[(g * 64 + n) * 16 + c], bi = b_im[(g * 64 + n) * 16 + c];
        BB[idx] = (f32x2v){(float)(fr * br - fi * bi), (float)(fr * bi + fi * br)};
        const int c2 = idx >> 6, n2 = idx & 63; CC[idx] = (f32x2v){c_re[(g * 16 + c2) * 64 + n2], c_im[(g * 16 + c2) * 64 + n2]}; }
    __syncthreads();
    if (part == 0 && tid < 64) { const f32x2v p = POW[32 * 64 + tid]; LAM32[tid * 2] = p.x; LAM32[tid * 2 + 1] = p.y; }
    for (int idx = tid; idx < 32 * 32; idx += NTHR) { const int j = idx >> 5, co = 2 * part + ((idx >> 4) & 1), ci = idx & 15; float s = 0.f;
#pragma unroll 2
        for (int n = 0; n < 64; ++n) { const f32x2v c = CC[co * 64 + n], p = POW[j * 64 + n], b = BB[n * 16 + ci];
            const float cpr = c.x * p.x - c.y * p.y, cpi = c.x * p.y + c.y * p.x; s += cpr * b.x - cpi * b.y; }
        KT[j * 256 + co * 16 + ci] = s; }
    __syncthreads();
    for (int id = tid; id < 64 * 80; id += NTHR) { const int rl = id / 80, c8 = id % 80, so = rl >> 1, co = 2 * part + (rl & 1), row = so * 16 + co; float v[8];
        if (c8 < 64) { const int si = c8 >> 1, ci0 = (c8 & 1) * 8;
#pragma unroll
            for (int e = 0; e < 8; ++e) v[e] = so >= si ? KT[(so - si) * 256 + co * 16 + ci0 + e] : 0.f; }
        else {
#pragma unroll
            for (int e = 0; e < 8; ++e) { const int np = (c8 - 64) * 8 + e, n = np & 63; const f32x2v c = CC[co * 64 + n], p = POW[(so + 1) * 64 + n];
                v[e] = np < 64 ? (c.x * p.x - c.y * p.y) : -(c.x * p.y + c.y * p.x); } }
        v4u o; o.x = pk2(v[0], v[1]); o.y = pk2(v[2], v[3]); o.z = pk2(v[4], v[5]); o.w = pk2(v[6], v[7]);
        *(GAS v4u*)(TV + (size_t)row * 640 + c8 * 8) = o; }
    for (int id = tid; id < 16 * 64; id += NTHR) { const int np = 16 * part + (id >> 6), c8 = id & 63, n = np & 63, s = c8 >> 1, ci0 = (c8 & 1) * 8; const f32x2v p = POW[(31 - s) * 64 + n]; float v[8];
#pragma unroll
        for (int e = 0; e < 8; ++e) { const f32x2v b = BB[n * 16 + ci0 + e]; v[e] = np < 64 ? (p.x * b.x - p.y * b.y) : (p.x * b.y + p.y * b.x); }
        v4u o; o.x = pk2(v[0], v[1]); o.y = pk2(v[2], v[3]); o.z = pk2(v[4], v[5]); o.w = pk2(v[6], v[7]);
        *(GAS v4u*)(Wt + (size_t)np * 512 + c8 * 8) = o; }
    __syncthreads();
}
#ifndef P0RPT
#define P0RPT 0
#endif
#define P0R(k) ((P0RPT >> (k)) & 1)
__device__ __forceinline__ void p0_prologue(const Args& a, LAS unsigned char* lds, int tid, int lane, int wave, int vcu, int G) {
    unsigned char* ws = a.ws;
    LAS float* scr = (LAS float*)(lds + RING_OFF + wave * 16384);
    const int gw = vcu * NWAVES + wave, NGW = G * NWAVES;
    p0_s5_tables(vcu >> 3, vcu & 7, a, lds, tid);
    if (blockIdx.x == 33 && wave == 0) {
        float gq = fmaxf(fabsf(a.in[5][lane]), fabsf(a.in[5][lane + 64])), gk = fmaxf(fabsf(a.in[6][lane]), fabsf(a.in[6][lane + 64]));
        float bm = fmaxf(fmaxf(fabsf(a.in[2][lane]), fabsf(a.in[2][lane + 64])), fmaxf(fabsf(a.in[2][lane + 128]), fabsf(a.in[2][lane + 192])));
#pragma unroll
        for (int o = 1; o < 64; o <<= 1) { gq = fmaxf(gq, __shfl_xor(gq, o)); gk = fmaxf(gk, __shfl_xor(gk, o)); bm = fmaxf(bm, __shfl_xor(bm, o)); }
        const float B = 1.02f * 128.f * 0.08838834764831845f * 1.4426950408889634f * gq * gk + bm * 1.4426950408889634f;
        if (lane == 0) ((float*)(ws + WS_BIASL))[1032] = (B > 0.f && B <= 56.f) ? B : 0.f; }
    if (blockIdx.x == 32) { float* BL = (float*)(ws + WS_BIASL); const float* rb = a.in[2];
        for (int i = tid; i < 8 * 128 + 8; i += NTHR) { if (i < 1024) { const int h = i >> 7, d = i & 127; BL[i] = rb[t5_bucket(d) * 8 + h] * 1.4426950408889634f; } else BL[i] = rb[31 * 8 + (i - 1024)] * 1.4426950408889634f; } }
    { bf16* WUV = (bf16*)(ws + WS_WUV); const float* w = a.in[7];
        for (int i = blockIdx.x * NTHR + tid; i < 8 * 64 * 128; i += G * NTHR) { const int ep = i & 3, ln = (i >> 2) & 63, t = (i >> 8) & 1, cs = (i >> 9) & 7, eb = (i >> 12) & 1, h = i >> 13;
            const int d = 16 * cs + 8 * t + 4 * (ln >> 5) + ep, e = 32 * eb + (ln & 31); WUV[i] = (bf16)f2bf(w[(h * 128 + d) * 64 + e]); } }
    constexpr int I_IN = 16 * 184, I_MKV = 16 * 32, I_GLU = 8 * 16, I_BR = 8 * 32, I_OUT = 16 * 32, I_GU = 16 * 176, I_D = 44 * 32;
    constexpr int NITEMS = I_IN + I_MKV + I_GLU + 3 * I_BR + I_OUT + I_GU + I_D;
    _Pragma("unroll 1") for (int rp_ = 0; rp_ <= P0R(1); ++rp_)
    for (int it = gw; it < NITEMS; it += NGW) {
        int r = it;
        if (r < I_IN) { p0_transpose_item(1, a.in[3], nullptr, nullptr, 1024, 5832, 5888, (bf16*)(ws + WS_WIN), scr, r, lane); continue; } r -= I_IN;
        if (r < I_MKV) { p0_transpose_item(0, a.in[18], nullptr, nullptr, 1024, 1024, 1024, (bf16*)(ws + WS_WMKV), scr, r, lane); continue; } r -= I_MKV;
        if (r < I_GLU) { p0_transpose_item(0, a.in[16], nullptr, nullptr, 512, 512, 512, (bf16*)(ws + WS_WGLU), scr, r, lane); continue; } r -= I_GLU;
        if (r < 3 * I_BR) { const int br = r / I_BR; p0_transpose_item(0, a.in[21 + br], nullptr, nullptr, 512, 1024, 1024, (bf16*)(ws + WS_WBR) + (size_t)br * 1024 * 512, scr, r % I_BR, lane); continue; } r -= 3 * I_BR;
        if (r < I_OUT) { p0_transpose_item(0, a.in[24], nullptr, nullptr, 1024, 1024, 1024, (bf16*)(ws + WS_WOUT), scr, r, lane); continue; } r -= I_OUT;
        if (r < I_GU) { p0_transpose_item(2, a.in[26], a.in[27], a.in[25], 1024, 2816, 5632, (bf16*)(ws + WS_WGU), scr, r, lane); continue; } r -= I_GU;
        p0_transpose_item(0, a.in[28], nullptr, nullptr, 2816, 1024, 1024, (bf16*)(ws + WS_WD), scr, r, lane);
    }
    _Pragma("unroll 1") for (int rp_ = 0; rp_ <= P0R(2); ++rp_)
    for (int m = gw; m < T_TOK; m += 2 * NGW) {
        const GAS f32x4* x0 = (const GAS f32x4*)(a.in[0] + (size_t)m * 1024) + lane; const GAS f32x4* x1 = (const GAS f32x4*)(a.in[0] + (size_t)(m + NGW) * 1024) + lane; const GAS f32x4* gr = (const GAS f32x4*)a.in[4] + lane;
        f32x4 v0[4], v1[4]; float s0 = 0.f, s1 = 0.f;
#pragma unroll
        for (int j = 0; j < 4; ++j) { v0[j] = x0[64 * j]; v1[j] = x1[64 * j]; }
#pragma unroll
        for (int j = 0; j < 4; ++j) { s0 += (v0[j].x * v0[j].x + v0[j].y * v0[j].y) + (v0[j].z * v0[j].z + v0[j].w * v0[j].w); s1 += (v1[j].x * v1[j].x + v1[j].y * v1[j].y) + (v1[j].z * v1[j].z + v1[j].w * v1[j].w); }
        const float r0 = 1.f / sqrtf(wave_sum(s0) * (1.f / 1024.f) + 1e-6f), r1 = 1.f / sqrtf(wave_sum(s1) * (1.f / 1024.f) + 1e-6f);
        GAS unsigned long long* o0 = (GAS unsigned long long*)((bf16*)(ws + WS_H) + (size_t)m * 1024) + lane; GAS unsigned long long* o1 = (GAS unsigned long long*)((bf16*)(ws + WS_H) + (size_t)(m + NGW) * 1024) + lane;
#pragma unroll
        for (int j = 0; j < 4; ++j) { const f32x4 gg = gr[64 * j];
            o0[64 * j] = (unsigned long long)pk2(v0[j].x * r0 * gg.x, v0[j].y * r0 * gg.y) | ((unsigned long long)pk2(v0[j].z * r0 * gg.z, v0[j].w * r0 * gg.w) << 32);
            o1[64 * j] = (unsigned long long)pk2(v1[j].x * r1 * gg.x, v1[j].y * r1 * gg.y) | ((unsigned long long)pk2(v1[j].z * r1 * gg.z, v1[j].w * r1 * gg.w) << 32); }
    }
    for (int m = gw; m < 2048; m += NGW) rms_row_to_bf16(a.in[1] + (size_t)m * 1024, a.in[17], (bf16*)(ws + WS_MEMN) + (size_t)m * 1024, lane);
    if (P0R(0)) { __syncthreads(); p0_s5_tables(vcu >> 3, vcu & 7, a, lds, tid); }
}
__device__ __forceinline__ void norm128_pass(bf16* X, int rows, int ld, int ngroups, const float* g, int gtid, int nthr) {
    const int l = gtid & 15, total = rows * ngroups;
    for (int gid = gtid >> 4; gid < total; gid += nthr >> 4) {
        const int r = gid / ngroups, gi = gid % ngroups;
        bf16* p = X + (size_t)r * ld + gi * 128 + l * 8;
        const v4u v = *(const GAS v4u*)p; float f[8];
        f[0] = __uint_as_float(v.x << 16); f[1] = __uint_as_float(v.x & 0xffff0000u); f[2] = __uint_as_float(v.y << 16); f[3] = __uint_as_float(v.y & 0xffff0000u);
        f[4] = __uint_as_float(v.z << 16); f[5] = __uint_as_float(v.z & 0xffff0000u); f[6] = __uint_as_float(v.w << 16); f[7] = __uint_as_float(v.w & 0xffff0000u);
        float s = 0.f;
#pragma unroll
        for (int q = 0; q < 8; ++q) s += f[q] * f[q];
        s += __shfl_xor(s, 8); s += __shfl_xor(s, 4); s += __shfl_xor(s, 2); s += __shfl_xor(s, 1);
        const float rs = 1.f / sqrtf(s * (1.f / 128.f) + 1e-6f);
        const f32x4 g0 = *(const GAS f32x4*)(g + l * 8), g1 = *(const GAS f32x4*)(g + l * 8 + 4);
        v4u o; o.x = pk2(f[0] * rs * g0.x, f[1] * rs * g0.y); o.y = pk2(f[2] * rs * g0.z, f[3] * rs * g0.w); o.z = pk2(f[4] * rs * g1.x, f[5] * rs * g1.y); o.w = pk2(f[6] * rs * g1.z, f[7] * rs * g1.w);
        *(GAS v4u*)p = o;
    }
}
__device__ __forceinline__ void s5_scan(int g, int half, const Args& a, int tid) {
    if (tid < 256) {
        const int bl = tid >> 6, n = tid & 63, b = half * 4 + bl;
        const float* LAM32 = (const float*)(a.ws + WS_LAM32) + g * 128; const float lr = LAM32[n * 2], li = LAM32[n * 2 + 1];
        const float* SL = (const float*)(a.ws + WS_SLOC) + ((size_t)(g * 512 + b * 64)) * 128; bf16* Ur = (bf16*)(a.ws + WS_U) + ((size_t)(g * 512 + b * 64)) * 640 + 512;
        float xr = 0.f, xi = 0.f;
#pragma unroll 1
        for (int c0 = 0; c0 < 64; c0 += 16) {
            float sr[16], si[16];
#pragma unroll
            for (int k = 0; k < 16; ++k) { sr[k] = SL[(size_t)(c0 + k) * 128 + n]; si[k] = SL[(size_t)(c0 + k) * 128 + 64 + n]; }
#pragma unroll
            for (int k = 0; k < 16; ++k) {
                Ur[(size_t)(c0 + k) * 640 + n] = (bf16)f2bf(xr); Ur[(size_t)(c0 + k) * 640 + 64 + n] = (bf16)f2bf(xi);
                const float nr = lr * xr - li * xi + sr[k], ni = lr * xi + li * xr + si[k]; xr = nr; xi = ni;
            }
        }
    }
    VM_WAIT(); __syncthreads();
}
#define HAVE_ATTN 1
#ifdef TPROBE
#if TPROBE < 8
#define TP_STAMP(k) { __builtin_amdgcn_sched_barrier(0); const unsigned long long t_ = __builtin_amdgcn_s_memtime(); tp_acc[k] += t_ - tp_prev; tp_prev = t_; __builtin_amdgcn_sched_barrier(0); }
#define TP_DECL unsigned long long tp_acc[8] = {0, 0, 0, 0, 0, 0, 0, 0}; unsigned long long tp_prev = __builtin_amdgcn_s_memtime();
#define TP_FLUSH(base) { if (blockIdx.x == TPROBE_BLOCK && wave == 0 && lane == 0) { unsigned long long* TP = (unsigned long long*)(a.ws + WS_CTL + 65536); for (int k_ = 0; k_ < 8; ++k_) TP[(base) + k_] += tp_acc[k_]; } }
#define TQ_STAMP(k)
#define TQ_DECL
#define TQ_FLUSH
#else
#define TP_STAMP(k)
#define TP_DECL
#define TP_FLUSH(base)
#define TQ_STAMP(k) { const unsigned t_ = (unsigned)__builtin_amdgcn_s_memtime(); tq_acc[k] += t_ - tq_prev; tq_prev = t_; }
#define TQ_DECL unsigned tq_acc[4] = {0, 0, 0, 0}; unsigned tq_prev = (unsigned)__builtin_amdgcn_s_memtime();
#define TQ_FLUSH { if (blockIdx.x == TPROBE_BLOCK && wave == 0 && lane == 0) { unsigned long long* TP = (unsigned long long*)(a.ws + WS_CTL + 65536); for (int k_ = 0; k_ < 4; ++k_) TP[8 + k_] += tq_acc[k_]; } }
#endif
#else
#define TP_STAMP(k)
#define TP_DECL
#define TP_FLUSH(base)
#define TQ_STAMP(k)
#define TQ_DECL
#define TQ_FLUSH
#endif
namespace att {
typedef float f32x16 __attribute__((ext_vector_type(16)));
typedef short s16x4 __attribute__((ext_vector_type(4)));
typedef short v4i16_t __attribute__((ext_vector_type(4)));
typedef float f32x2_t __attribute__((ext_vector_type(2))); typedef __bf16 bf16x2_t __attribute__((ext_vector_type(2)));
typedef unsigned u32x2 __attribute__((ext_vector_type(2)));
#define MFMA32(a, b, c) __builtin_amdgcn_mfma_f32_32x32x16_bf16((a), (b), (c), 0, 0, 0)
__device__ __forceinline__ unsigned cvtpk(float lo, float hi) { const f32x2_t v = {lo, hi}; const bf16x2_t b = __builtin_convertvector(v, bf16x2_t); return __builtin_bit_cast(unsigned, b); }
__device__ __forceinline__ int crow(int r, int hi) { return (r & 3) + 8 * (r >> 2) + 4 * hi; }
__device__ __forceinline__ unsigned off_b(unsigned row, unsigned ch) { return 256u * row + 16u * (ch ^ (((row & 3u) << 2) | ((row >> 2) & 3u))); }
__device__ __forceinline__ float xh_max(float v) { const auto rr = __builtin_amdgcn_permlane32_swap(__float_as_uint(v), __float_as_uint(v), false, false); return fmaxf(__uint_as_float(rr[0]), __uint_as_float(rr[1])); }
__device__ __forceinline__ float xh_sum(float v) { const auto rr = __builtin_amdgcn_permlane32_swap(__float_as_uint(v), __float_as_uint(v), false, false); return __uint_as_float(rr[0]) + __uint_as_float(rr[1]); }
__device__ __forceinline__ unsigned xh_sumu(unsigned v) { const auto rr = __builtin_amdgcn_permlane32_swap(v, v, false, false); return rr[0] + rr[1]; }
__device__ __forceinline__ unsigned xh_or(unsigned v) { const auto rr = __builtin_amdgcn_permlane32_swap(v, v, false, false); return rr[0] | rr[1]; }
constexpr float SCALE2 = 0.08838834764831845f * 1.4426950408889634f;

__device__ __forceinline__ bf16x8 pack_step(const f32x16& x, int s) {
    v4u p; p.x = cvtpk(x[8 * s], x[8 * s + 1]); p.y = cvtpk(x[8 * s + 2], x[8 * s + 3]); p.z = cvtpk(x[8 * s + 4], x[8 * s + 5]); p.w = cvtpk(x[8 * s + 6], x[8 * s + 7]);
    return __builtin_bit_cast(bf16x8, p);
}
__device__ __forceinline__ void qk_tile(f32x16& p0, f32x16& p1, LAS const unsigned char* kimg, const bf16x8 (&qf)[8], int lane) {
    const unsigned r32 = lane & 31, hi = lane >> 5;
    f32x16 z;
#pragma unroll
    for (int r = 0; r < 16; ++r) z[r] = 0.f;
    p0 = z; p1 = z;
    bf16x8 fa[2][4];
#define QK_LOAD(g, buf) { const unsigned o0_ = off_b(r32, 4 * (g) + hi), o1_ = off_b(r32, 4 * (g) + 2 + hi); \
        fa[buf][0] = *(LAS const bf16x8*)(kimg + o0_); fa[buf][1] = *(LAS const bf16x8*)(kimg + o0_ + 32 * 256); fa[buf][2] = *(LAS const bf16x8*)(kimg + o1_); fa[buf][3] = *(LAS const bf16x8*)(kimg + o1_ + 32 * 256); }
#define QK_MMA(g, buf) { p0 = MFMA32(fa[buf][0], qf[2 * (g)], p0); p1 = MFMA32(fa[buf][1], qf[2 * (g)], p1); p0 = MFMA32(fa[buf][2], qf[2 * (g) + 1], p0); p1 = MFMA32(fa[buf][3], qf[2 * (g) + 1], p1); }
    QK_LOAD(0, 0) QK_LOAD(1, 1) QK_MMA(0, 0) asm volatile("" ::: "memory");
    QK_LOAD(2, 0) QK_MMA(1, 1) asm volatile("" ::: "memory");
    QK_LOAD(3, 1) QK_MMA(2, 0) QK_MMA(3, 1)
#undef QK_LOAD
#undef QK_MMA
}
__device__ __forceinline__ s16x4 vtr(LAS const unsigned char* p) { return __builtin_bit_cast(s16x4, __builtin_amdgcn_ds_read_tr16_b64_v4i16((LAS v4i16_t*)p)); }
__device__ __forceinline__ void pv_tile(f32x16 (&o)[4], LAS const unsigned char* vimg, const bf16x8 (&pf)[4], int lane) {
    const unsigned hi = lane >> 5, blk = (lane >> 4) & 1, q = (lane & 15) >> 2, p = lane & 3;
    s16x4 fl[2][4], fh[2][4];
#define PV_LOAD(c, buf) { _Pragma("unroll") for (int ks = 0; ks < 4; ++ks) { const unsigned ch = 4 * (c) + 2 * blk + (p >> 1), rlo = 16 * ks + 4 * hi + q; \
        fl[buf][ks] = vtr(vimg + off_b(rlo, ch) + 8 * (p & 1)); fh[buf][ks] = vtr(vimg + off_b(rlo + 8, ch) + 8 * (p & 1)); } }
#define PV_MMA(c, buf) { _Pragma("unroll") for (int ks = 0; ks < 4; ++ks) { const bf16x8 af = {fl[buf][ks][0], fl[buf][ks][1], fl[buf][ks][2], fl[buf][ks][3], fh[buf][ks][0], fh[buf][ks][1], fh[buf][ks][2], fh[buf][ks][3]}; \
        o[c] = MFMA32(af, pf[ks], o[c]); } }
    PV_LOAD(0, 0) PV_LOAD(1, 1) PV_MMA(0, 0) asm volatile("" ::: "memory");
    PV_LOAD(2, 0) PV_MMA(1, 1) asm volatile("" ::: "memory");
    PV_LOAD(3, 1) PV_MMA(2, 0) PV_MMA(3, 1)
#undef PV_LOAD
#undef PV_MMA
}
template <bool FIXED> __device__ __forceinline__ void softmax_step(f32x16& p0, f32x16& p1, float& m, float& l, f32x16 (&o)[4], bf16x8 (&pf)[4]) {
    if constexpr (FIXED) {
        f32x2_t s2 = {0.f, 0.f};
#pragma unroll
        for (int r = 0; r < 16; ++r) { p0[r] = __builtin_amdgcn_exp2f(p0[r]); p1[r] = __builtin_amdgcn_exp2f(p1[r]); const f32x2_t t = {p0[r], p1[r]}; s2 += t; }
        l += s2[0] + s2[1];
    } else {
        float mx = fmaxf(p0[0], p1[0]);
#pragma unroll
        for (int r = 1; r < 16; ++r) mx = fmaxf(mx, fmaxf(p0[r], p1[r]));
        mx = xh_max(mx);
        const float mnew = fmaxf(m, mx), muse = (mnew == -INFINITY) ? 0.f : mnew;
        const float alpha = __builtin_amdgcn_exp2f(m - muse);
        float s = 0.f;
#pragma unroll
        for (int r = 0; r < 16; ++r) { p0[r] = __builtin_amdgcn_exp2f(p0[r] - muse); p1[r] = __builtin_amdgcn_exp2f(p1[r] - muse); s += p0[r] + p1[r]; }
        l = l * alpha + s; m = mnew;
        if (__any(alpha != 1.f)) {
#pragma unroll
            for (int c = 0; c < 4; ++c)
#pragma unroll
                for (int r = 0; r < 16; ++r) o[c][r] *= alpha;
        }
    }
    pf[0] = pack_step(p0, 0); pf[1] = pack_step(p0, 1); pf[2] = pack_step(p1, 0); pf[3] = pack_step(p1, 1);
}
__device__ __forceinline__ void tile_load(v4u (&rg)[2], const bf16* src, int pitch, int tid) {
#pragma unroll
    for (int i = 0; i < 2; ++i) { const int id = tid + 512 * i, row = id >> 4, ch = id & 15; rg[i] = *(const GAS v4u*)(src + (size_t)row * pitch + ch * 8); }
}
__device__ __forceinline__ void tile_store(const v4u (&rg)[2], LAS unsigned char* img, int tid) {
#pragma unroll
    for (int i = 0; i < 2; ++i) { const int id = tid + 512 * i, row = id >> 4, ch = id & 15; *(LAS v4u*)(img + off_b(row, ch)) = rg[i]; }
}

__device__ __forceinline__ void cross_item(const Args& a, LAS unsigned char* lds, int tid, int lane, int wave, int item) {
    const int r32 = lane & 31, hi = lane >> 5;
    const int b = item >> 5, hx = (item >> 3) & 3, qblk = item & 7;
    const bf16* QX = (const bf16*)(a.ws + WS_QX); const bf16* KX = (const bf16*)(a.ws + WS_KX) + (size_t)b * 256 * 512 + hx * 128; const bf16* VX = (const bf16*)(a.ws + WS_VX) + (size_t)b * 256 * 512 + hx * 128;
    bf16* OX = (bf16*)(a.ws + WS_OX);
    const size_t row = (size_t)b * 2048 + qblk * 256 + wave * 32 + r32;
    bf16x8 qf[8];
#pragma unroll
    for (int s = 0; s < 8; ++s) qf[s] = *(const GAS bf16x8*)(QX + row * 512 + hx * 128 + 16 * s + 8 * hi);
    f32x16 o[4];
#pragma unroll
    for (int c = 0; c < 4; ++c)
#pragma unroll
        for (int r = 0; r < 16; ++r) o[c][r] = 0.f;
    float m = -INFINITY, l = 0.f;
    v4u kr[2], vr[2];
    tile_load(kr, KX, 512, tid); tile_load(vr, VX, 512, tid);
    tile_store(kr, lds, tid); tile_store(vr, lds + 32768, tid);
    __syncthreads();
#pragma unroll 1
    for (int kt = 0; kt < 4; ++kt) {
        LAS unsigned char* kimg = lds + (kt & 1) * 16384; LAS unsigned char* vimg = lds + 32768 + (kt & 1) * 16384;
        if (kt + 1 < 4) { tile_load(kr, KX + (size_t)(kt + 1) * 64 * 512, 512, tid); tile_load(vr, VX + (size_t)(kt + 1) * 64 * 512, 512, tid); }
        f32x16 p0, p1; qk_tile(p0, p1, kimg, qf, lane);
#pragma unroll
        for (int r = 0; r < 16; ++r) { p0[r] *= SCALE2; p1[r] *= SCALE2; }
        bf16x8 pf[4]; softmax_step<false>(p0, p1, m, l, o, pf);
        pv_tile(o, vimg, pf, lane);
        if (kt + 1 < 4) { tile_store(kr, lds + ((kt + 1) & 1) * 16384, tid); tile_store(vr, lds + 32768 + ((kt + 1) & 1) * 16384, tid); }
        __syncthreads();
    }
    l = xh_sum(l);
    const float inv = 1.f / l;
#pragma unroll
    for (int c = 0; c < 4; ++c)
#pragma unroll
        for (int g4 = 0; g4 < 4; ++g4) { u32x2 w; w.x = cvtpk(o[c][4 * g4] * inv, o[c][4 * g4 + 1] * inv); w.y = cvtpk(o[c][4 * g4 + 2] * inv, o[c][4 * g4 + 3] * inv);
            *(GAS u32x2*)(OX + row * 512 + hx * 128 + 32 * c + 8 * g4 + 4 * hi) = w; }
}
__device__ __forceinline__ void cross_phase(const Args& a, LAS unsigned char* lds, int tid, int lane, int wave, int bx, int G) {
    if (bx < 128) return;
#pragma unroll 1
    for (int i = 0; i < 2; ++i) cross_item(a, lds, tid, lane, wave, (bx - 128) * 2 + i);
}

constexpr int DSA_QI = 0, DSA_QPITCH = 1040, DSA_KTB = 33792, DSA_CT = DSA_KTB, DSA_MASK = DSA_KTB + 2 * 32 * 257 * 4, DSA_BT = DSA_MASK + 32 * 65 * 4, DSA_END = DSA_BT + 8 * 320 * 4;
static_assert(DSA_END <= RING_BYTES, "DSA LDS map");
__device__ __forceinline__ unsigned f2key(float x) { const unsigned b = __float_as_uint(x + 0.f); return (b & 0x80000000u) ? ~b : (b | 0x80000000u); }

__device__ __forceinline__ void cnt_ge(unsigned& cnt, unsigned key, unsigned cand) { asm volatile("v_cmp_ge_u32 vcc, %1, %2\n\tv_addc_co_u32_e32 %0, vcc, 0, %0, vcc" : "+v"(cnt) : "v"(key), "v"(cand) : "vcc"); }
__device__ __forceinline__ void cnt_gt(unsigned& cnt, unsigned key, unsigned cand) { asm volatile("v_cmp_gt_u32 vcc, %1, %2\n\tv_addc_co_u32_e32 %0, vcc, 0, %0, vcc" : "+v"(cnt) : "v"(key), "v"(cand) : "vcc"); }
__device__ __forceinline__ void cnt_eq(unsigned& cnt, unsigned key, unsigned cand) { asm volatile("v_cmp_eq_u32 vcc, %1, %2\n\tv_addc_co_u32_e32 %0, vcc, 0, %0, vcc" : "+v"(cnt) : "v"(key), "v"(cand) : "vcc"); }
__device__ __forceinline__ void cnt4_ge(unsigned& c0, unsigned& c1, unsigned& c2, unsigned& c3, unsigned k0, unsigned k1, unsigned k2, unsigned k3, unsigned cand) {
    unsigned long long m0, m1, m2;
    asm volatile("v_cmp_ge_u32 %4, %7, %11\n\tv_cmp_ge_u32 %5, %8, %11\n\tv_cmp_ge_u32 %6, %9, %11\n\tv_cmp_ge_u32 vcc, %10, %11\n\t"
                 "v_addc_co_u32_e64 %0, %4, 0, %0, %4\n\tv_addc_co_u32_e64 %1, %5, 0, %1, %5\n\tv_addc_co_u32_e64 %2, %6, 0, %2, %6\n\tv_addc_co_u32_e32 %3, vcc, 0, %3, vcc"
                 : "+v"(c0), "+v"(c1), "+v"(c2), "+v"(c3), "=&s"(m0), "=&s"(m1), "=&s"(m2) : "v"(k0), "v"(k1), "v"(k2), "v"(k3), "v"(cand) : "vcc");
}
template <int IB> __device__ __forceinline__ void cnt_tie_lt(unsigned& cnt, unsigned key, unsigned thr, unsigned lanepart, unsigned cand) { unsigned t;
    asm volatile("v_add_u32_e32 %1, %6, %4\n\tv_cmp_eq_u32 vcc, %2, %3\n\tv_cndmask_b32_e32 %1, -1, %1, vcc\n\tv_cmp_lt_u32 vcc, %1, %5\n\tv_addc_co_u32_e32 %0, vcc, 0, %0, vcc"
                 : "+v"(cnt), "=&v"(t) : "v"(key), "v"(thr), "v"(lanepart), "v"(cand), "i"(IB) : "vcc"); }
template <int IB, int BR> __device__ __forceinline__ void mask_sel(unsigned& w, unsigned key, unsigned thr, unsigned lanepart, unsigned istar, unsigned onehi) { unsigned t, bit;
    asm volatile("v_lshlrev_b32_e32 %2, %8, %7\n\tv_cmp_gt_u32 vcc, %3, %4\n\tv_cndmask_b32_e32 %1, 0, %2, vcc\n\tv_or_b32_e32 %0, %0, %1\n\t"
                 "v_add_u32_e32 %1, %9, %5\n\tv_cmp_le_u32 vcc, %1, %6\n\tv_cndmask_b32_e32 %1, 0, %2, vcc\n\tv_cmp_eq_u32 vcc, %3, %4\n\tv_cndmask_b32_e32 %1, 0, %1, vcc\n\tv_or_b32_e32 %0, %0, %1"
                 : "+v"(w), "=&v"(t), "=&v"(bit) : "v"(key), "v"(thr), "v"(lanepart), "v"(istar), "v"(onehi), "i"(BR), "i"(IB) : "vcc"); }

#define CRB(r) (((r) & 3) + 8 * ((r) >> 2))
#define TIE1(i, r) cnt_tie_lt<256 * (i) + CRB(r)>(cnt, key[i][r], thr, lanepart, cand);
#define TIE_ROW(i) TIE1(i,0) TIE1(i,1) TIE1(i,2) TIE1(i,3) TIE1(i,4) TIE1(i,5) TIE1(i,6) TIE1(i,7) TIE1(i,8) TIE1(i,9) TIE1(i,10) TIE1(i,11) TIE1(i,12) TIE1(i,13) TIE1(i,14) TIE1(i,15)
#define SEL1(i, r) mask_sel<256 * (i) + CRB(r), CRB(r)>(w, key[i][r], thr, lanepart, istar, onehi);
#define SEL_ROW(i) SEL1(i,0) SEL1(i,1) SEL1(i,2) SEL1(i,3) SEL1(i,4) SEL1(i,5) SEL1(i,6) SEL1(i,7) SEL1(i,8) SEL1(i,9) SEL1(i,10) SEL1(i,11) SEL1(i,12) SEL1(i,13) SEL1(i,14) SEL1(i,15)
__device__ __forceinline__ unsigned row_total(unsigned cnt, LAS unsigned* CNT, int& par, int r32, int hi, int wave) {
    cnt = xh_sumu(cnt);
    if (hi == 0) CNT[par * 256 + r32 * 8 + wave] = cnt;
    __syncthreads();
    const v4u x = *(LAS const v4u*)(CNT + par * 256 + r32 * 8), y = *(LAS const v4u*)(CNT + par * 256 + r32 * 8 + 4);
    par ^= 1;
    return (x.x + x.y) + (x.z + x.w) + (y.x + y.y) + (y.z + y.w);
}
template <bool FIXED> __device__ __forceinline__ void dsa_attn(const Args& a, LAS unsigned char* lds, int tid, int lane, int wave, int b, int qb, bool sel, const float c31, const int dry, const bf16x8 (&qf)[8]) {
    const int r32 = lane & 31, hi = lane >> 5;
    const int t0 = qb * 32; const size_t rowb = (size_t)b * 2048;
    const bf16* QD = (const bf16*)(a.ws + WS_QD); const bf16* CKV = (const bf16*)(a.ws + WS_CKV) + rowb * 128;
    const float* BL = (const float*)(a.ws + WS_BIASL); const bf16* WUV = (const bf16*)(a.ws + WS_WUV); bf16* ODSA = (bf16*)(a.ws + WS_ODSA);
    LAS unsigned* MASK = (LAS unsigned*)(lds + DSA_MASK);
    const int h = wave; const int tq = t0 + r32; const size_t qrow = rowb + t0 + r32;
    f32x16 o[4];
#pragma unroll
    for (int c = 0; c < 4; ++c)
#pragma unroll
        for (int r = 0; r < 16; ++r) o[c][r] = 0.f;
    float m = -INFINITY, l = 0.f;
    const int NKT = (t0 + 32 + 63) >> 6;
    TP_DECL
#define DSA_SLOT(kt_) ((kt_) < 2 ? DSA_QI + (kt_) * 16384 : DSA_CT + ((kt_) & 3) * 16384)
#define DMA_TILE(kt_) { _Pragma("unroll") for (int i_ = 0; i_ < 2; ++i_) { const int rb_ = i_ * 8 + wave, row_ = 4 * rb_ + (lane >> 4), ch_ = (lane & 15) ^ (((row_ & 3) << 2) | ((row_ >> 2) & 3)); \
        __builtin_amdgcn_global_load_lds((const unsigned*)(CKV + (size_t)(64 * (kt_) + row_) * 128 + ch_ * 8), (LAS unsigned*)(lds + DSA_SLOT(kt_) + rb_ * 1024), 16, 0, 0); } }
#ifdef EXTRA_DRY
    if (dry >= 2) return;
#endif
#pragma unroll 1
    for (int kp = 0; kp < NKT; kp += 2) {
      if (kp + 2 < NKT) DMA_TILE(kp + 2) if (kp + 3 < NKT) DMA_TILE(kp + 3)
#pragma unroll 1
      for (int kt = kp; kt < kp + 2 && kt < NKT; ++kt) {
        LAS unsigned char* cimg = lds + DSA_SLOT(kt);
        TP_STAMP(0)
        f32x16 p0, p1; qk_tile(p0, p1, cimg, qf, lane);
        TP_STAMP(1)
        const int k0 = 64 * kt;
        const bool far = (t0 - k0 - 63) >= 128;
        unsigned mv0, mv1;
        if (sel) { mv0 = MASK[r32 * 65 + 2 * kt] >> (4 * hi); mv1 = MASK[r32 * 65 + 2 * kt + 1] >> (4 * hi); }
        else { const int d0 = tq - k0 - 4 * hi, d1 = d0 - 32;
            mv0 = d0 < 0 ? 0u : (d0 >= 31 ? 0x0f0f0f0fu : (0x0f0f0f0fu & ((2u << d0) - 1u)));
            mv1 = d1 < 0 ? 0u : (d1 >= 31 ? 0x0f0f0f0fu : (0x0f0f0f0fu & ((2u << d1) - 1u))); }
        if (far) {
#pragma unroll
            for (int r = 0; r < 16; ++r) { p0[r] = ((mv0 >> CRB(r)) & 1u) ? p0[r] * SCALE2 + c31 : -INFINITY; p1[r] = ((mv1 >> CRB(r)) & 1u) ? p1[r] * SCALE2 + c31 : -INFINITY; }
        } else {
            LAS const float* bt = (LAS const float*)(lds + DSA_BT + h * 1280 + (255 - (tq - k0 - 4 * hi)) * 4);
            if constexpr (FIXED) {
#define NEAR8(P, MV, OFF, R0) { float bb[8]; \
              _Pragma("unroll") for (int r = 0; r < 8; ++r) bb[r] = bt[(OFF) + CRB((R0) + r)]; \
              asm volatile("" ::: "memory"); \
              _Pragma("unroll") for (int r = 0; r < 8; ++r) { const float v_ = P[(R0) + r] * SCALE2 + bb[r]; P[(R0) + r] = (((MV) >> CRB((R0) + r)) & 1u) ? v_ : -INFINITY; } }
            NEAR8(p0, mv0, 0, 0) NEAR8(p0, mv0, 0, 8) NEAR8(p1, mv1, 32, 0) NEAR8(p1, mv1, 32, 8)
#undef NEAR8
            } else {
                const LAS float* btf = bt;
#pragma unroll
                for (int r = 0; r < 16; ++r) { const float b0 = btf[CRB(r)], b1 = btf[32 + CRB(r)];
                    p0[r] = ((mv0 >> CRB(r)) & 1u) ? p0[r] * SCALE2 + b0 : -INFINITY; p1[r] = ((mv1 >> CRB(r)) & 1u) ? p1[r] * SCALE2 + b1 : -INFINITY; }
            }
        }
        bf16x8 pf[4];
        softmax_step<FIXED>(p0, p1, m, l, o, pf);
        TP_STAMP(2)
        pv_tile(o, cimg, pf, lane);
        TP_STAMP(3)
        TP_STAMP(4)
      }
      if (kp + 2 < NKT) __syncthreads();
    }
#undef DMA_TILE
#undef DSA_SLOT
#ifdef EXTRA_DRY
    if (dry >= 1) return;
#endif
    l = xh_sum(l);
    const float inv = 1.f / l;
    bf16x8 of[8];
#pragma unroll
    for (int c = 0; c < 4; ++c) {
#pragma unroll
        for (int r = 0; r < 16; ++r) o[c][r] *= inv;
        of[2 * c] = pack_step(o[c], 0); of[2 * c + 1] = pack_step(o[c], 1);
    }
    { s16x4 wl[2][8], wh[2][8];
#pragma unroll
      for (int eb = 0; eb < 2; ++eb) { const bf16* wf = WUV + (size_t)((h * 2 + eb) * 8) * 512 + lane * 4;
#pragma unroll
        for (int cs = 0; cs < 8; ++cs) { wl[eb][cs] = *(const GAS s16x4*)(wf + cs * 512); wh[eb][cs] = *(const GAS s16x4*)(wf + cs * 512 + 256); } }
      asm volatile("" ::: "memory");
#pragma unroll
      for (int eb = 0; eb < 2; ++eb) {
        f32x16 acc;
#pragma unroll
        for (int r = 0; r < 16; ++r) acc[r] = 0.f;
#pragma unroll
        for (int cs = 0; cs < 8; ++cs) {
            const bf16x8 af = {wl[eb][cs][0], wl[eb][cs][1], wl[eb][cs][2], wl[eb][cs][3], wh[eb][cs][0], wh[eb][cs][1], wh[eb][cs][2], wh[eb][cs][3]};
            acc = MFMA32(af, of[cs], acc);
        }
#pragma unroll
        for (int g4 = 0; g4 < 4; ++g4) { u32x2 w; w.x = cvtpk(acc[4 * g4], acc[4 * g4 + 1]); w.y = cvtpk(acc[4 * g4 + 2], acc[4 * g4 + 3]);
            *(GAS u32x2*)(ODSA + qrow * 512 + h * 64 + 32 * eb + 8 * g4 + 4 * hi) = w; }
      } }
    TP_STAMP(5)
    TP_FLUSH(0)
}
template <int MODE> __device__ __forceinline__ void dsa_item(const Args& a, LAS unsigned char* lds, int tid, int lane, int wave, int b, int qb, const bool fixed, const float c31, const int dry = 0) {
    const int r32 = lane & 31, hi = lane >> 5;
    const int t0 = qb * 32; const size_t rowb = (size_t)b * 2048;
    const bool sel = qb >= 8;
    const bf16* QD = (const bf16*)(a.ws + WS_QD); const bf16* CKV = (const bf16*)(a.ws + WS_CKV) + rowb * 128; const bf16* QI = (const bf16*)(a.ws + WS_QI); const bf16* KI = (const bf16*)(a.ws + WS_KI) + rowb * 64;
    const float* WI = (const float*)(a.ws + WS_WI); const float* BL = (const float*)(a.ws + WS_BIASL); const bf16* WUV = (const bf16*)(a.ws + WS_WUV); bf16* ODSA = (bf16*)(a.ws + WS_ODSA);
    LAS unsigned* MASK = (LAS unsigned*)(lds + DSA_MASK);
    const int NT = qb + 1;
    TQ_DECL
    bf16x8 qf[8];
#define ATT_PRE() { const size_t qrow_ = rowb + t0 + r32; \
        _Pragma("unroll") for (int s = 0; s < 8; ++s) qf[s] = *(const GAS bf16x8*)(QD + qrow_ * 1024 + wave * 128 + 16 * s + 8 * hi); \
        _Pragma("unroll") for (int kt_ = 0; kt_ < 2; ++kt_) if (64 * kt_ < t0 + 32) { _Pragma("unroll") for (int i_ = 0; i_ < 2; ++i_) { const int rb_ = i_ * 8 + wave, row_ = 4 * rb_ + (lane >> 4), ch_ = (lane & 15) ^ (((row_ & 3) << 2) | ((row_ >> 2) & 3)); \
            __builtin_amdgcn_global_load_lds((const unsigned*)(CKV + (size_t)(64 * kt_ + row_) * 128 + ch_ * 8), (LAS unsigned*)(lds + DSA_QI + kt_ * 16384 + rb_ * 1024), 16, 0, 0); } } }
    if (MODE != 1 && sel) {
#pragma unroll
        for (int i = 0; i < 4; ++i) { const int id = tid + 512 * i, row = id >> 6, ch = id & 63;
            *(LAS v4u*)(lds + DSA_QI + row * DSA_QPITCH + ch * 16) = *(const GAS v4u*)(QI + (rowb + t0 + row) * 512 + ch * 8); }
        __syncthreads();
        float wq[8];
        { const f32x4 w0 = *(const GAS f32x4*)(WI + (rowb + t0 + r32) * 8), w1 = *(const GAS f32x4*)(WI + (rowb + t0 + r32) * 8 + 4);
          wq[0] = w0.x; wq[1] = w0.y; wq[2] = w0.z; wq[3] = w0.w; wq[4] = w1.x; wq[5] = w1.y; wq[6] = w1.z; wq[7] = w1.w; }
        unsigned kw[4][32];
        LAS unsigned* KTB = (LAS unsigned*)(lds + DSA_KTB);
        LAS const unsigned char* qbase = lds + DSA_QI + r32 * DSA_QPITCH + hi * 16;
        const bf16* kbase = KI + (size_t)r32 * 64 + 8 * hi;
        bf16x8 kf[4]; const bf16* kptr = kbase + (size_t)wave * 2048;
        if (wave < NT) {
#pragma unroll
            for (int kk = 0; kk < 4; ++kk) kf[kk] = *(const GAS bf16x8*)(kptr + 16 * kk);
        }
        kptr += 8 * 2048;
#define SC_HEAD(hh, dst) { _Pragma("unroll") for (int r = 0; r < 16; ++r) dst[r] = 0.f; \
            _Pragma("unroll") for (int kk = 0; kk < 4; ++kk) { const bf16x8 qf = *(LAS const bf16x8*)(qbase + ((hh) * 8 + 2 * kk) * 16); dst = MFMA32(kf[kk], qf, dst); } }
#define SC_ACC(hh, src) { const f32x2_t w2_ = {wq[hh], wq[hh]}; \
            _Pragma("unroll") for (int r = 0; r < 16; r += 2) { const f32x2_t t_ = {__builtin_amdgcn_fmed3f(src[r], 0.f, INFINITY), __builtin_amdgcn_fmed3f(src[r + 1], 0.f, INFINITY)}; \
                f32x2_t s_ = {sacc[r], sacc[r + 1]}; s_ = __builtin_elementwise_fma(t_, w2_, s_); sacc[r] = s_[0]; sacc[r + 1] = s_[1]; } \
            _Pragma("unroll") for (int r = 0; r < 16; ++r) asm volatile("" : "+v"(sacc[r])); }
#define SC_TILE(i) { const int j = wave + 8 * (i); \
            if (8 * (i) < NT) {                                            \
                LAS unsigned* kt_ = KTB + ((i) & 1) * (32 * 257); \
                if (j < NT) { \
                    f32x16 sacc, da, db; \
                    _Pragma("unroll") for (int r = 0; r < 16; ++r) sacc[r] = 0.f; \
                    SC_HEAD(0, da) SC_HEAD(1, db) SC_ACC(0, da) SC_HEAD(2, da) SC_ACC(1, db) SC_HEAD(3, db) SC_ACC(2, da) SC_HEAD(4, da) SC_ACC(3, db) \
                    SC_HEAD(5, db) SC_ACC(4, da) SC_HEAD(6, da) SC_ACC(5, db) SC_HEAD(7, db) \
                    asm volatile("" ::: "memory"); \
                    if (j + 8 < NT) { _Pragma("unroll") for (int kk = 0; kk < 4; ++kk) kf[kk] = *(const GAS bf16x8*)(kptr + 16 * kk); kptr += 8 * 2048; }     \
                    SC_ACC(6, da) SC_ACC(7, db) \
                    _Pragma("unroll") for (int r = 0; r < 16; ++r) { const bool vis = (j < NT - 1) || (crow(r, hi) <= r32); kt_[r32 * 257 + 32 * wave + crow(r, hi)] = vis ? f2key(sacc[r]) : 0u; } \
                } else { _Pragma("unroll") for (int r = 0; r < 16; ++r) kt_[r32 * 257 + 32 * wave + crow(r, hi)] = 0u; } \
                __syncthreads(); \
                _Pragma("unroll") for (int rho = 0; rho < 4; ++rho) _Pragma("unroll") for (int k = 0; k < 4; ++k) kw[rho][4 * (i) + k] = kt_[(4 * wave + rho) * 257 + 64 * k + lane]; \
            } else { _Pragma("unroll") for (int rho = 0; rho < 4; ++rho) _Pragma("unroll") for (int k = 0; k < 4; ++k) kw[rho][4 * (i) + k] = 0u; } }
        SC_TILE(0) SC_TILE(1) SC_TILE(2) SC_TILE(3) SC_TILE(4) SC_TILE(5) SC_TILE(6) SC_TILE(7)
#undef SC_TILE
#undef SC_ACC
#undef SC_HEAD
        TQ_STAMP(0)
        ATT_PRE()
        unsigned thr[4] = {0u, 0u, 0u, 0u}; bool fnd[4] = {false, false, false, false};
        if constexpr (MODE != 3) {
#pragma unroll 1
            for (int bit = 31; bit >= 0; --bit) {
#pragma unroll
                for (int rho = 0; rho < 4; ++rho) if (!fnd[rho]) {
                    const unsigned cand = (unsigned)__builtin_amdgcn_readfirstlane((int)(thr[rho] | (1u << bit))); unsigned cnt = 0u;
#pragma unroll
                    for (int e = 0; e < 32; e += 4) if (2 * e < NT) {
                        unsigned long long b0, b1, b2, b3;
                        asm volatile("v_cmp_ge_u32_e64 %0, %4, %8\n\tv_cmp_ge_u32_e64 %1, %5, %8\n\tv_cmp_ge_u32_e64 %2, %6, %8\n\tv_cmp_ge_u32_e64 %3, %7, %8"
                                     : "=&s"(b0), "=&s"(b1), "=&s"(b2), "=&s"(b3) : "v"(kw[rho][e]), "v"(kw[rho][e + 1]), "v"(kw[rho][e + 2]), "v"(kw[rho][e + 3]), "s"(cand));
                        cnt += (unsigned)(__builtin_popcountll(b0) + __builtin_popcountll(b1)) + (unsigned)(__builtin_popcountll(b2) + __builtin_popcountll(b3));
                    }
                    if (cnt >= 256u) thr[rho] = cand;
                    fnd[rho] = cnt == 256u;
                }
                if (fnd[0] && fnd[1] && fnd[2] && fnd[3]) break;
            }
        }
#pragma unroll
        for (int rho = 0; rho < 4; ++rho) {
            const unsigned th = (unsigned)__builtin_amdgcn_readfirstlane((int)thr[rho]); unsigned gtot = 0u;
#pragma unroll
            for (int e = 0; e < 32; e += 4) if (2 * e < NT) { unsigned long long b0, b1, b2, b3;
                asm volatile("v_cmp_gt_u32_e64 %0, %4, %8\n\tv_cmp_gt_u32_e64 %1, %5, %8\n\tv_cmp_gt_u32_e64 %2, %6, %8\n\tv_cmp_gt_u32_e64 %3, %7, %8"
                             : "=&s"(b0), "=&s"(b1), "=&s"(b2), "=&s"(b3) : "v"(kw[rho][e]), "v"(kw[rho][e + 1]), "v"(kw[rho][e + 2]), "v"(kw[rho][e + 3]), "s"(th));
                gtot += (unsigned)(__builtin_popcountll(b0) + __builtin_popcountll(b1)) + (unsigned)(__builtin_popcountll(b2) + __builtin_popcountll(b3)); }
            unsigned rem = 256u - gtot;
            unsigned wlo = 0u, whi = 0u;
#define WLANE(dst, val, ln) asm volatile("v_writelane_b32 %0, %1, %2" : "+v"(dst) : "s"(val), "i"(ln));
#define MB_STEP(e) if (2 * ((e) & ~3) < NT) { unsigned long long g0, g1, q0, q1; \
                asm volatile("v_cmp_gt_u32_e64 %0, %4, %6\n\tv_cmp_gt_u32_e64 %1, %5, %6\n\tv_cmp_eq_u32_e64 %2, %4, %6\n\tv_cmp_eq_u32_e64 %3, %5, %6" \
                             : "=&s"(g0), "=&s"(g1), "=&s"(q0), "=&s"(q1) : "v"(kw[rho][e]), "v"(kw[rho][(e) + 1]), "s"(th)); \
                unsigned c = (unsigned)__builtin_popcountll(q0); \
                if (c > rem) { while ((unsigned)__builtin_popcountll(q0) > rem) q0 &= ~(1ull << (63 - __builtin_clzll(q0))); c = rem; }     \
                rem -= c; \
                c = (unsigned)__builtin_popcountll(q1); \
                if (c > rem) { while ((unsigned)__builtin_popcountll(q1) > rem) q1 &= ~(1ull << (63 - __builtin_clzll(q1))); c = rem; } \
                rem -= c; \
                const unsigned long long s0 = g0 | q0, s1 = g1 | q1; \
                WLANE(wlo, (unsigned)s0, e) WLANE(whi, (unsigned)(s0 >> 32), e) WLANE(wlo, (unsigned)s1, (e) + 1) WLANE(whi, (unsigned)(s1 >> 32), (e) + 1) }
            MB_STEP(0) MB_STEP(2) MB_STEP(4) MB_STEP(6) MB_STEP(8) MB_STEP(10) MB_STEP(12) MB_STEP(14) MB_STEP(16) MB_STEP(18) MB_STEP(20) MB_STEP(22) MB_STEP(24) MB_STEP(26) MB_STEP(28) MB_STEP(30)
#undef MB_STEP
            if (lane < 32) { const int j = 8 * (lane >> 2) + 2 * (lane & 3); MASK[(4 * wave + rho) * 65 + j] = wlo; MASK[(4 * wave + rho) * 65 + j + 1] = whi; }
#undef WLANE
        }
        __syncthreads();
        TQ_STAMP(1)
    } else { ATT_PRE() __syncthreads(); }
#undef ATT_PRE
    if constexpr (MODE == 0 || MODE == 1) {
        if (dry < 3) { if (fixed) dsa_attn<true>(a, lds, tid, lane, wave, b, qb, sel, c31, dry, qf); else dsa_attn<false>(a, lds, tid, lane, wave, b, qb, sel, c31, dry, qf); }
    }
    TQ_STAMP(2)
    TQ_FLUSH
    asm volatile("s_waitcnt lgkmcnt(0)" ::: "memory"); __builtin_amdgcn_s_barrier(); asm volatile("" ::: "memory");
}
#ifndef DSA_SHIFT_V
#define DSA_SHIFT_V 6
#endif
#ifndef EXTRA_Q
#define EXTRA_Q (-1)
#endif
#ifndef EXTRA_N
#define EXTRA_N 0
#endif
constexpr int DSA_SHIFT = DSA_SHIFT_V;
template <int MODE = 0> __device__ __forceinline__ void dsa_phase(const Args& a, LAS unsigned char* lds, int wave, int bx, int G) {
    const int gi = bx >> 5, p = bx & 31, bl = gi & 3, bh = bl + 4; const bool lowb = gi < 4;
    { const float* BL = (const float*)(a.ws + WS_BIASL); LAS float* BT = (LAS float*)(lds + DSA_BT);
      for (int i = wave * 64 + my_lane_id(); i < 8 * 320; i += NTHR) { const int hh = i / 320, d = 255 - (i % 320); BT[i] = (d < 0 ? 0.f : (d < 128 ? BL[hh * 128 + d] : BL[1024 + hh])) - BL[1032]; } }
    const float* BLp = (const float*)(a.ws + WS_BIASL);
    const float Mb = __uint_as_float(__builtin_amdgcn_readfirstlane(__float_as_uint(BLp[1032])));
    const float c31 = __uint_as_float(__builtin_amdgcn_readfirstlane(__float_as_uint(BLp[1024 + wave] - Mb)));
    const bool fixed = Mb != 0.f;
    __syncthreads();
#pragma unroll 1
    for (int it = 0; it < 3 + EXTRA_N; ++it) {
        int ib, iq;
        if (it >= 3) { ib = lowb ? bl : bh; iq = EXTRA_Q; }
        else if (it == 0) { ib = lowb ? bl : bh; iq = 63 - p; }
        else if (it == 1) { if (lowb) { ib = bl; iq = p - DSA_SHIFT; } else if (p <= 31 - DSA_SHIFT) { ib = bh; iq = p + DSA_SHIFT; } else { ib = bl; iq = p; } }
        else { ib = bh; iq = (!lowb && p > 31 - DSA_SHIFT) ? 31 - p : -1; }
        if (iq < 0) continue;
        const int lane = my_lane_id();
#ifdef EXTRA_DRY
        dsa_item<MODE>(a, lds, wave * 64 + lane, lane, wave, ib, iq, fixed, c31, it >= 3 ? EXTRA_DRY : 0);
#else
        dsa_item<MODE>(a, lds, wave * 64 + lane, lane, wave, ib, iq, fixed, c31);
#endif
    }
}
}
#define HAVE_DSA 1
using att::cross_phase;
__device__ __forceinline__ void dsa_phase(const Args& a, LAS unsigned char* lds, int wave, int bx, int G) { att::dsa_phase<0>(a, lds, wave, bx, G); }
__global__ void __launch_bounds__(NTHR, 2) mk_fwd(Args args) {
    extern __shared__ __attribute__((aligned(16))) unsigned char lds_raw[];
    LAS unsigned char* lds = (LAS unsigned char*)lds_raw;
    volatile LAS unsigned* MISC = (volatile LAS unsigned*)(lds + MISC_OFF);
    const int wave = __builtin_amdgcn_readfirstlane(threadIdx.x >> 6);
#define MYLANE() my_lane_id()
    const int G = gridDim.x, bx = blockIdx.x, vcu = (G % 8 == 0) ? (bx % 8) * (G / 8) + bx / 8 : bx;
    unsigned char* ws = args.ws;
    gu32* ctl = (gu32*)(ws + WS_CTL);
    { const int tid = wave * 64 + MYLANE();
      for (int u = tid; u < (LDS_BYTES - LDSCTL_OFF) / 4; u += NTHR) ((LAS unsigned*)(lds + LDSCTL_OFF))[u] = 0u; }
    __syncthreads();
    const int lo = args.ph_lo, hi = args.ph_hi;
    const bool multi = (hi - lo) > 1;
    XcdBarrier bar; bar.bar = (unsigned*)(ctl + CW_BAR) + args.li * XCD_BAR_WORDS; bar.x = 0; bar.st = nullptr;
    if (multi) bar = xcd_barrier_post((unsigned*)(ctl + CW_BAR) + args.li * XCD_BAR_WORDS, MISC + 8, wave == 0 && MYLANE() == 0);
#define IN(k) (lo <= (k) && (k) < hi)
#define RPT(k) ((args.flags >> (16 + (k))) & 1)
#define L1_INV_SYNC() do { VM_WAIT(); __builtin_amdgcn_fence(__ATOMIC_ACQUIRE, "agent"); VM_WAIT(); __syncthreads(); } while (0)
#define SEAM(k) do { if (IN(k) && IN((k) + 1)) xcd_barrier(bar, wave == 0 && MYLANE() == 0); } while (0)
#define PHASE_PTRS unsigned char* wsk = args.ws; asm volatile("" : "+s"(wsk)); \
    bf16 *WIN = (bf16*)(wsk + WS_WIN), *WMKV = (bf16*)(wsk + WS_WMKV), *WGLU = (bf16*)(wsk + WS_WGLU), *WBR = (bf16*)(wsk + WS_WBR), *WOUT = (bf16*)(wsk + WS_WOUT), *WGU = (bf16*)(wsk + WS_WGU), *WD = (bf16*)(wsk + WS_WD); \
    float *RS = (float*)(wsk + WS_RS), *WI = (float*)(wsk + WS_WI), *SLOC = (float*)(wsk + WS_SLOC); \
    bf16 *KX = (bf16*)(wsk + WS_KX), *VX = (bf16*)(wsk + WS_VX), *MEMN = (bf16*)(wsk + WS_MEMN), *H = (bf16*)(wsk + WS_H), *QD = (bf16*)(wsk + WS_QD), *CKV = (bf16*)(wsk + WS_CKV), *QI = (bf16*)(wsk + WS_QI), *KI = (bf16*)(wsk + WS_KI), \
         *QX = (bf16*)(wsk + WS_QX), *U = (bf16*)(wsk + WS_U), *ODSA = (bf16*)(wsk + WS_ODSA), *OX = (bf16*)(wsk + WS_OX), *Y = (bf16*)(wsk + WS_Y), *OS5 = (bf16*)args.out, *G3 = (bf16*)(wsk + WS_G3), *MG = (bf16*)(wsk + WS_MERGED), \
         *ACT = (bf16*)(wsk + WS_ACT), *XN = (bf16*)(wsk + WS_XN), *S5TV = (bf16*)(wsk + WS_S5TV), *S5W = (bf16*)(wsk + WS_S5W); \
    (void)WIN; (void)WMKV; (void)WGLU; (void)WBR; (void)WOUT; (void)WGU; (void)WD; (void)RS; (void)WI; (void)SLOC; (void)KX; (void)VX; (void)MEMN; (void)H; (void)QD; (void)CKV; (void)QI; (void)KI; (void)QX; (void)U; (void)ODSA; (void)OX; (void)Y; (void)OS5; (void)G3; (void)MG; (void)ACT; (void)XN; (void)S5TV; (void)S5W;
    if (IN(0)) for (int rep_ = 0; rep_ <= RPT(0); ++rep_) { if (rep_) xcd_barrier(bar, wave == 0 && MYLANE() == 0); const int lane = MYLANE(), tid = wave * 64 + lane; p0_prologue(args, lds, tid, lane, wave, vcu, G); }
    SEAM(0);
    if (IN(1)) for (int rep_ = 0; rep_ <= RPT(1); ++rep_) { if (rep_) xcd_barrier(bar, wave == 0 && MYLANE() == 0);
        PHASE_PTRS
        { pg8::Gemm g{H, WIN, T_TOK, NIN, 1024, 1024, 1024}; pg8::StaticOrder S; S.init(T_TOK, NIN, G, bx);
          pg8::EpiInprojF E{QD, CKV, QI, KI, U, QX, WI, args.in[5], args.in[6], args.in[19], (LAS float*)(lds + XB_OFF)};
          pg8::gemm_phase<pg8::EpiInprojF, pg8::StaticOrder, true, true>(lds + RING_OFF, g, S, E, wave); }
        { pg8::Gemm g{MEMN, WMKV, 2048, 1024, 1024, 1024, 1024}; pg8::SubsetOrder S; S.init(2048, 1024, 64, bx - 192);
          pg8::EpiMemKVF E{KX, VX, args.in[20], (LAS float*)(lds + XB_OFF)};
          pg8::gemm_phase<pg8::EpiMemKVF, pg8::SubsetOrder, true, true>(lds + RING_OFF, g, S, E, wave); }
    }
    SEAM(1);
    if (IN(3)) for (int rep_ = 0; rep_ <= RPT(3); ++rep_) { if (rep_) xcd_barrier(bar, wave == 0 && MYLANE() == 0);
        PHASE_PTRS
#ifdef TPROBE
        const unsigned long long tp3_0 = __builtin_amdgcn_s_memtime(); unsigned long long tp3_a = tp3_0, tp3_b = tp3_0;
#endif
        if (!(args.flags & FL_NO_S5)) {
            if (bx < 128) {
                { pg8::Gemm g{U, S5W, 32 * 512, 32 * 256, 512, 640, 512}; pg8::S5Order1 S{((bx >> 2) * 2) + ((bx >> 1) & 1)};
                  pg8::EpiSlocF E{SLOC};
                  pg8::gemm_phase<pg8::EpiSlocF, pg8::S5Order1, false, true>(lds + RING_OFF, g, S, E, wave); }
                VM_WAIT(); __syncthreads();
#ifdef TPROBE
                tp3_a = __builtin_amdgcn_s_memtime();
#endif
                s5_scan(bx >> 2, (bx >> 1) & 1, args, wave * 64 + MYLANE());
#ifdef TPROBE
                tp3_b = __builtin_amdgcn_s_memtime();
#endif
            }
            pg8::Gemm g{U, S5TV, 32 * 512, 32 * 512, 640, 640, 640}; pg8::S5Order2 S{bx};
            pg8::EpiS5YF E{U, args.in[15], Y};
#ifdef S5RPT
            _Pragma("unroll 1") for (int r2_ = 0; r2_ < S5RPT; ++r2_) { pg8::gemm_phase<pg8::EpiS5YF, pg8::S5Order2, false, true>(lds + RING_OFF, g, S, E, wave); __syncthreads(); }
#endif
            pg8::gemm_phase<pg8::EpiS5YF, pg8::S5Order2, false, true>(lds + RING_OFF, g, S, E, wave);
        }
#ifdef HAVE_ATTN
        if (!(args.flags & FL_NO_CROSS)) { const int lane = MYLANE(); cross_phase(args, lds, wave * 64 + lane, lane, wave, bx, G); }
#endif
#ifdef TPROBE
        const unsigned long long tp3_1 = __builtin_amdgcn_s_memtime();
#endif
#ifdef HAVE_DSA
        if (!(args.flags & FL_NO_DSA)) dsa_phase(args, lds, wave, bx, G);
#endif
#ifdef SPIN_SEL
        if (SPIN_SEL) { const unsigned long long t0_ = __builtin_amdgcn_s_memrealtime(); while (__builtin_amdgcn_s_memrealtime() - t0_ < SPIN_TICKS) __builtin_amdgcn_s_sleep(8); }
#endif
#ifdef TPROBE
        if (bx == TPROBE_BLOCK && wave == 0 && MYLANE() == 0) { unsigned long long* TP = (unsigned long long*)(ws + WS_CTL + 65536); TP[12] = __builtin_amdgcn_s_memtime() - tp3_0; TP[13] = tp3_1 - tp3_0; TP[14] = tp3_a - tp3_0; TP[15] = tp3_b - tp3_0; }
#endif
    }
    SEAM(3);
    if (IN(4)) for (int rep_ = 0; rep_ <= RPT(4); ++rep_) { if (rep_) xcd_barrier(bar, wave == 0 && MYLANE() == 0);
        PHASE_PTRS
        { pg8::Gemm g{Y, WGLU, T_TOK, 512, 512, 512, 512}; pg8::SubsetOrder S; S.init(T_TOK, 512, 128, bx < 128 ? bx : -1);
          pg8::EpiGluF E{Y, OS5};
          pg8::gemm_phase<pg8::EpiGluF, pg8::SubsetOrder, false, true>(lds + RING_OFF, g, S, E, wave); }
        { pg8::Gemm g{H, WIN + (size_t)NIN * 1024, T_TOK, 3072, 1024, 1024, 1024}; pg8::GateOrder S{bx};
          pg8::EpiSigmoidF E{G3, 3072};
          pg8::gemm_phase<pg8::EpiSigmoidF, pg8::GateOrder, true, true>(lds + RING_OFF, g, S, E, wave); }
    }
    SEAM(4);
    if (IN(5)) for (int rep_ = 0; rep_ <= RPT(5); ++rep_) { if (rep_) xcd_barrier(bar, wave == 0 && MYLANE() == 0);
        PHASE_PTRS
        pg8::Gemm g{ODSA, WBR, T_TOK, 1024, 512, 512, 512}; pg8::MergeOrder S; S.so.init(T_TOK, 1024, G, bx);
        S.aoff[0] = 0; S.aoff[1] = (long)((const char*)OS5 - (const char*)ODSA); S.aoff[2] = (long)((const char*)OX - (const char*)ODSA);
        pg8::EpiMergeF E{G3, MG};
        pg8::gemm_phase<pg8::EpiMergeF, pg8::MergeOrder, true, true>(lds + RING_OFF, g, S, E, wave);
    }
    SEAM(5);
    if (IN(6)) for (int rep_ = 0; rep_ <= RPT(6); ++rep_) { if (rep_) xcd_barrier(bar, wave == 0 && MYLANE() == 0);
        PHASE_PTRS
        pg8::Gemm g{MG, WOUT, T_TOK, 1024, 1024, 1024, 1024}; pg8::StaticOrder S; S.init(T_TOK, 1024, G, bx);
        pg8::EpiOutF E{args.in[0], args.out, XN, RS};
        pg8::gemm_phase<pg8::EpiOutF, pg8::StaticOrder, false, true>(lds + RING_OFF, g, S, E, wave);
    }
    SEAM(6);
    if (IN(7)) for (int rep_ = 0; rep_ <= RPT(7); ++rep_) { if (rep_) xcd_barrier(bar, wave == 0 && MYLANE() == 0);
        PHASE_PTRS
        pg8::Gemm g{XN, WGU, T_TOK, 5632, 1024, 1024, 1024}; pg8::StaticOrder S; S.init(T_TOK, 5632, G, bx);
        pg8::EpiGateUpF E{RS, ACT};
        pg8::gemm_phase<pg8::EpiGateUpF, pg8::StaticOrder, true, true>(lds + RING_OFF, g, S, E, wave);
    }
    SEAM(7);
    if (IN(8)) for (int rep_ = 0; rep_ <= RPT(8); ++rep_) { if (rep_) xcd_barrier(bar, wave == 0 && MYLANE() == 0);
        PHASE_PTRS
        pg8::Gemm g{ACT, WD, T_TOK, 1024, 2816, 2816, 2816}; pg8::StaticOrder S; S.init(T_TOK, 1024, G, bx);
        pg8::EpiDownF E{XN, args.out};
        pg8::gemm_phase<pg8::EpiDownF, pg8::StaticOrder, false, true>(lds + RING_OFF, g, S, E, wave);
    }
#ifdef TPROBE
    xcd_barrier(bar, wave == 0 && MYLANE() == 0);
    if (bx == 0 && wave == 0 && MYLANE() == 0) { const unsigned long long* TP = (const unsigned long long*)(ws + WS_CTL + 65536); unsigned long long tot = TP[12];
#if TPROBE < 8
        tot = 0; for (int k_ = 0; k_ < 6; ++k_) tot += TP[k_];
#endif
        const float frac = tot ? (float)((double)TP[TPROBE] / (double)tot) : 0.f; args.out[0] += 0.15f + 0.3f * frac; }
#endif
#undef IN
#undef SEAM
}
extern "C" void kernel_launch(void* const* d_in, const int* in_sizes, int n_in, void* d_out, int out_size, void* d_ws, size_t ws_size, hipStream_t stream) {
    static int grid = 0;
    if (grid == 0) {
        if (n_in != 29 || ws_size < WS_END || out_size != T_TOK * DM || in_sizes[0] != T_TOK * DM) { fprintf(stderr, "kernel_launch: built for 29 inputs, x/out of %d floats, >= %zu bytes of workspace; got n_in %d out %d ws %zu; nothing launched\n", T_TOK * DM, (size_t)WS_END, n_in, out_size, ws_size); grid = -1; return; }
        int dev = 0, cus = 0, per_cu = 0;
        if (hipGetDevice(&dev) != hipSuccess || hipDeviceGetAttribute(&cus, hipDeviceAttributeMultiprocessorCount, dev) != hipSuccess) { fprintf(stderr, "kernel_launch: hipGetDevice / hipDeviceGetAttribute failed; nothing launched\n"); grid = -1; return; }
        if (hipFuncSetAttribute((const void*)mk_fwd, hipFuncAttributeMaxDynamicSharedMemorySize, LDS_BYTES) != hipSuccess) { fprintf(stderr, "kernel_launch: hipFuncSetAttribute failed (%d bytes of dynamic LDS); nothing launched\n", LDS_BYTES); grid = -1; return; }
        if (hipOccupancyMaxActiveBlocksPerMultiprocessor(&per_cu, (const void*)mk_fwd, NTHR, LDS_BYTES) != hipSuccess || per_cu < 1) fprintf(stderr, "kernel_launch: note: occupancy query reports %d workgroups per CU\n", per_cu);
        (void)hipGetLastError();
        grid = cus;
        if (grid != 256) { fprintf(stderr, "kernel_launch: %d CUs; this build's unit orders are written for 256 (one workgroup per CU); nothing launched\n", grid); grid = -1; return; }
    }
    if (grid < 0) return;
    if (hipMemsetAsync((char*)d_ws + WS_CTL, 0, CTL_ZERO_BYTES, stream) != hipSuccess) { fprintf(stderr, "kernel_launch: hipMemsetAsync of the control words failed; nothing launched\n"); return; }
    Args a{};
    for (int i = 0; i < 29; ++i) a.in[i] = (const float*)d_in[i];
    a.out = (float*)d_out; a.ws = (unsigned char*)d_ws; a.ph_lo = 0; a.ph_hi = NPH; a.flags = 0; a.li = 0;
    hipLaunchKernelGGL(mk_fwd, dim3(grid), dim3(NTHR), LDS_BYTES, stream, a);
    const hipError_t le = hipPeekAtLastError();
    if (le != hipSuccess) fprintf(stderr, "kernel_launch: launch failed: %s\n", hipGetErrorName(le));
}
```
